# Optimizing an MI355X kernel written in HIP

```python
import jax, jax.numpy as jnp
from jax import lax
import numpy as np

D_MODEL = 1024
BATCH = 8
SEQ = 2048
DEPTH = 1

GRID_W = 64
CTX_LEN = 256
D_MIX = D_MODEL
D_SGU = D_MIX // 2
SGU_HEADS = 4
SGU_HEAD_DIM = D_SGU // SGU_HEADS
CHUNK = 128
D_LRU = D_MIX - D_SGU
LRU_HEADS = 8
LRU_HEAD_DIM = D_LRU // LRU_HEADS
CONV_W = 4
CONV_PAD = (1, 2)
RG_C = 8.0
N_EXPERTS = 16
EC_FACTOR = 2
D_EXPERT = 2048
N_MOD = 6
D_IN = 2 * D_SGU + 2 * D_LRU
EPS = 1e-6

kernel_name = "hybrid_sgu_rglru_ecmoe_dit"


def rmsnorm(x, g):
    xf = x.astype(jnp.float32)
    y = xf * lax.rsqrt(jnp.mean(xf * xf, axis=-1, keepdims=True) + EPS)
    return (y * g.astype(jnp.float32)).astype(x.dtype)


def spatial_gating(u, v, g, w_s, b_s):
    bn, L, _ = u.shape
    u = jax.nn.gelu(u)
    vh = jax.nn.gelu(v).reshape(bn, L, SGU_HEADS, SGU_HEAD_DIM)
    vh = rmsnorm(vh, g.reshape(SGU_HEADS, SGU_HEAD_DIM))
    vc = vh.reshape(bn, L // CHUNK, CHUNK, SGU_HEADS, SGU_HEAD_DIM)
    s = jnp.einsum('hpq,bnqhc->bnphc', w_s, vc) + jnp.swapaxes(b_s, 0, 1)[None, None, :, :, None]
    return u * s.reshape(bn, L, D_SGU)


def depthwise_conv(x, w, b):
    ch = x.shape[-1]
    y = lax.conv_general_dilated(x, w[:, None, :].astype(x.dtype), window_strides=(1,),
                                 padding=[CONV_PAD], dimension_numbers=('NWC', 'WIO', 'NWC'),
                                 feature_group_count=ch)
    return y + b


def rglru_coeffs(xb, wa, ba, wi, bi, lam):
    bn, L, _ = xb.shape
    xh = xb.reshape(bn, L, LRU_HEADS, LRU_HEAD_DIM)
    r = jax.nn.sigmoid(jnp.einsum('blhi,hij->blhj', xh, wa).reshape(bn, L, D_LRU) + ba)
    i = jax.nn.sigmoid(jnp.einsum('blhi,hij->blhj', xh, wi).reshape(bn, L, D_LRU) + bi)
    log_a = RG_C * r.astype(jnp.float32) * jax.nn.log_sigmoid(lam.astype(jnp.float32))
    a = jnp.exp(log_a)
    drive = jnp.sqrt(-jnp.expm1(2.0 * log_a)) * (i * xb).astype(jnp.float32)
    return a, drive


def linear_scan(a, b, h0):
    if h0 is not None:
        b = b.at[:, 0].add(a[:, 0] * h0)

    def combine(left, right):
        a_l, b_l = left
        a_r, b_r = right
        return a_l * a_r, a_r * b_l + b_r

    _, h = lax.associative_scan(combine, (a, b), axis=1)
    return h


def token_mixer(hx, hc, w_in, sgu_g, sgu_w, sgu_b, conv_w, conv_b,
                rg_wa, rg_ba, rg_wi, rg_bi, rg_lam, w_out, ctx_out):
    bn, n, _ = hx.shape
    rows = n // GRID_W
    splits = [D_SGU, 2 * D_SGU, 2 * D_SGU + D_LRU]
    ux, vx, xx, gx = jnp.split(hx @ w_in, splits, axis=-1)
    uc, vc, xc, gc = jnp.split(hc @ w_in, splits, axis=-1)

    cx = depthwise_conv(xx.reshape(bn * rows, GRID_W, D_LRU), conv_w, conv_b).reshape(bn, n, D_LRU)
    cc = depthwise_conv(xc, conv_w, conv_b)

    a_cf, b_cf = rglru_coeffs(cc, rg_wa[0], rg_ba[0], rg_wi[0], rg_bi[0], rg_lam[0])
    h_cf = linear_scan(a_cf, b_cf, None)
    a_xf, b_xf = rglru_coeffs(cx, rg_wa[0], rg_ba[0], rg_wi[0], rg_bi[0], rg_lam[0])
    h_xf = linear_scan(a_xf, b_xf, h_cf[:, -1])

    a_cb, b_cb = rglru_coeffs(jnp.flip(cc, 1), rg_wa[1], rg_ba[1], rg_wi[1], rg_bi[1], rg_lam[1])
    h_cb = linear_scan(a_cb, b_cb, None)
    a_xb, b_xb = rglru_coeffs(jnp.flip(cx, 1), rg_wa[1], rg_ba[1], rg_wi[1], rg_bi[1], rg_lam[1])
    h_xb = jnp.flip(linear_scan(a_xb, b_xb, h_cb[:, -1]), 1)

    rec_x = jax.nn.gelu(gx) * (h_xf + h_xb).astype(hx.dtype)
    yx = jnp.concatenate([spatial_gating(ux, vx, sgu_g, sgu_w, sgu_b), rec_x], axis=-1) @ w_out
    if ctx_out:
        rec_c = jax.nn.gelu(gc) * (h_cf + jnp.flip(h_cb, 1)).astype(hc.dtype)
        yc = jnp.concatenate([spatial_gating(uc, vc, sgu_g, sgu_w, sgu_b), rec_c], axis=-1) @ w_out
    else:
        yc = None
    return yx, yc


def expert_choice_ffn(h, w_r, w1, w3, w2):
    bn, n, _ = h.shape
    cap = EC_FACTOR * n // N_EXPERTS
    aff = jax.nn.softmax((h @ w_r).astype(jnp.float32), axis=-1)
    gate, idx = lax.top_k(jnp.swapaxes(aff, 1, 2), cap)
    bidx = jnp.arange(bn)[:, None, None]
    xe = h[bidx, idx]
    hid = jax.nn.silu(jnp.einsum('becd,edf->becf', xe, w1)) * jnp.einsum('becd,edf->becf', xe, w3)
    ye = jnp.einsum('becf,efd->becd', hid, w2) * gate[..., None].astype(h.dtype)
    return jnp.zeros_like(h).at[bidx, idx].add(ye)


def setup_inputs(seed: int = 0) -> dict:
    key = jax.random.key(seed)
    ks = jax.random.split(key, 32)
    f32 = jnp.float32

    def nrm(k, shape, scale):
        return jax.random.normal(k, shape, f32) * scale

    a0 = jax.random.uniform(ks[20], (DEPTH, 2, D_LRU), f32, 0.9, 0.999)
    p = a0 ** (1.0 / RG_C)
    rg_lam = jnp.log(p) - jnp.log1p(-p)
    return {
        "x": nrm(ks[0], (BATCH, SEQ, D_MODEL), 1.0),
        "c": nrm(ks[1], (BATCH, D_MODEL), 1.0),
        "ctx": nrm(ks[2], (BATCH, CTX_LEN, D_MODEL), 1.0),
        "c_ctx": nrm(ks[3], (D_MODEL,), 1.0),
        "w_mod": nrm(ks[4], (DEPTH, D_MODEL, N_MOD * D_MODEL), 0.5 * D_MODEL ** -0.5),
        "b_mod": nrm(ks[5], (DEPTH, N_MOD * D_MODEL), 0.02),
        "norm1_g": 1.0 + nrm(ks[6], (DEPTH, D_MODEL), 0.02),
        "norm2_g": 1.0 + nrm(ks[7], (DEPTH, D_MODEL), 0.02),
        "w_in": nrm(ks[8], (DEPTH, D_MODEL, D_IN), D_MODEL ** -0.5),
        "sgu_g": 1.0 + nrm(ks[9], (DEPTH, D_SGU), 0.02),
        "sgu_w": nrm(ks[10], (DEPTH, SGU_HEADS, CHUNK, CHUNK), CHUNK ** -0.5),
        "sgu_b": 1.0 + nrm(ks[11], (DEPTH, SGU_HEADS, CHUNK), 0.02),
        "conv_w": nrm(ks[12], (DEPTH, CONV_W, D_LRU), CONV_W ** -0.5),
        "conv_b": nrm(ks[13], (DEPTH, D_LRU), 0.02),
        "rg_wa": nrm(ks[14], (DEPTH, 2, LRU_HEADS, LRU_HEAD_DIM, LRU_HEAD_DIM), LRU_HEAD_DIM ** -0.5),
        "rg_ba": nrm(ks[15], (DEPTH, 2, D_LRU), 0.02),
        "rg_wi": nrm(ks[16], (DEPTH, 2, LRU_HEADS, LRU_HEAD_DIM, LRU_HEAD_DIM), LRU_HEAD_DIM ** -0.5),
        "rg_bi": nrm(ks[17], (DEPTH, 2, D_LRU), 0.02),
        "rg_lam": rg_lam,
        "w_out": nrm(ks[18], (DEPTH, D_MIX, D_MODEL), D_MIX ** -0.5),
        "w_router": nrm(ks[19], (DEPTH, D_MODEL, N_EXPERTS), D_MODEL ** -0.5),
        "w1": nrm(ks[21], (DEPTH, N_EXPERTS, D_MODEL, D_EXPERT), D_MODEL ** -0.5),
        "w3": nrm(ks[22], (DEPTH, N_EXPERTS, D_MODEL, D_EXPERT), D_MODEL ** -0.5),
        "w2": nrm(ks[23], (DEPTH, N_EXPERTS, D_EXPERT, D_MODEL), D_EXPERT ** -0.5),
        "final_g": 1.0 + nrm(ks[24], (D_MODEL,), 0.02),
    }


def reference(x, c, ctx, c_ctx, w_mod, b_mod, norm1_g, norm2_g, w_in, sgu_g, sgu_w, sgu_b,
              conv_w, conv_b, rg_wa, rg_ba, rg_wi, rg_bi, rg_lam, w_out, w_router, w1, w3, w2,
              final_g):
    h_ctx = ctx
    for l in range(DEPTH):
        last = l == DEPTH - 1
        mod_x = jax.nn.silu(c) @ w_mod[l] + b_mod[l]
        mod_c = jax.nn.silu(c_ctx) @ w_mod[l] + b_mod[l]
        sh1x, sc1x, g1x, sh2x, sc2x, g2x = jnp.split(mod_x[:, None, :], N_MOD, axis=-1)
        sh1c, sc1c, g1c, sh2c, sc2c, g2c = jnp.split(mod_c, N_MOD, axis=-1)

        hx = rmsnorm(x, norm1_g[l]) * (1.0 + sc1x) + sh1x
        hc = rmsnorm(h_ctx, norm1_g[l]) * (1.0 + sc1c) + sh1c
        yx, yc = token_mixer(hx, hc, w_in[l], sgu_g[l], sgu_w[l], sgu_b[l], conv_w[l], conv_b[l],
                             rg_wa[l], rg_ba[l], rg_wi[l], rg_bi[l], rg_lam[l], w_out[l],
                             not last)
        x = x + g1x * yx
        hx2 = rmsnorm(x, norm2_g[l]) * (1.0 + sc2x) + sh2x
        x = x + g2x * expert_choice_ffn(hx2, w_router[l], w1[l], w3[l], w2[l])

        if not last:
            h_ctx = h_ctx + g1c * yc
            hc2 = rmsnorm(h_ctx, norm2_g[l]) * (1.0 + sc2c) + sh2c
            h_ctx = h_ctx + g2c * expert_choice_ffn(hc2, w_router[l], w1[l], w3[l], w2[l])
    return rmsnorm(x, final_g)
```

```cpp
#include <hip/hip_runtime.h>
#include <hip/hip_cooperative_groups.h>
#include <cstdio>
#include <cstdint>
namespace cg = cooperative_groups;

#ifndef MK_N_LAUNCHES
#define MK_N_LAUNCHES 1
#endif
#ifndef XCD_BAR
#define XCD_BAR 1
#endif
#ifndef LRU1_MFMA
#define LRU1_MFMA 1
#endif
#ifndef SGU_MFMA
#define SGU_MFMA 1
#endif
#ifndef P6_FAST
#define P6_FAST 1
#endif
#ifndef DUP_MASK
#define DUP_MASK 0
#endif
#ifndef LRU2_FAST
#define LRU2_FAST 1
#endif
#ifndef MOE_FP8
#define MOE_FP8 1
#endif
#ifndef CONV_CUS
#define CONV_CUS 1
#endif
#ifndef NCONV
#define NCONV 64
#endif
#ifndef LRU1_V2
#define LRU1_V2 1
#endif
#ifndef SGU_CONV_TASKS
#define SGU_CONV_TASKS 128
#endif
#ifndef LRU2_PARTS
#define LRU2_PARTS 8
#endif
#ifndef USE_PG8
#define USE_PG8 1
#endif

namespace pg8 {
#define PG8_LAS __attribute__((address_space(3)))
typedef unsigned short bf16_t;
typedef short bf16x8 __attribute__((ext_vector_type(8)));
typedef float f32x4 __attribute__((ext_vector_type(4)));
typedef unsigned u32x4 __attribute__((ext_vector_type(4)));
typedef int v4i_t __attribute__((ext_vector_type(4)));
typedef int v8i_t __attribute__((ext_vector_type(8)));
typedef unsigned v2u_t __attribute__((ext_vector_type(2)));
constexpr int BM = 256, BK = 64, HALF = 128, HTB = HALF * BK * 2  , STAGE_BYTES = 8 * HTB;

__host__ __device__ __forceinline__ int lds_byte(int r, int c) { const int st = (r >> 4) * 2 + (c >> 5), rr = r & 15, cc = c & 31, ob = rr * 64 + cc * 2; return st * 1024 + (ob ^ (((ob >> 9) & 1) << 5)); }
__host__ __device__ __forceinline__ void stage_rc(int b, int& R, int& C) { const int st = b / 1024, sb = b % 1024, swz = sb ^ (((sb >> 9) & 1) << 5); R = (st >> 1) * 16 + swz / 64; C = (st & 1) * 32 + (swz % 64) / 2; }

struct Unit { int pm, pn, pnB; };
struct Gemm { const bf16_t* A; const bf16_t* Bt; int K; };

template <class Epi>
__device__ __forceinline__ void run_epi8(const Epi& E, const f32x4 (&acc)[2][2][4][2], const Unit& u, int wr, int wc, int fr, int fq) {
#pragma unroll
    for (int ai = 0; ai < 2; ++ai)
#pragma unroll
        for (int m = 0; m < 4; ++m) { const int row = ai * HALF + wr * 64 + m * 16 + fr;
            if constexpr (Epi::PAIRED) E.st2x8(u, row, wc * 32 + 8 * fq, acc[ai][0][m][0], acc[ai][0][m][1], acc[ai][1][m][0], acc[ai][1][m][1]);
            else {
#pragma unroll
                for (int bj = 0; bj < 2; ++bj) E.st8(u, row, bj * HALF + wc * 32 + 8 * fq, acc[ai][bj][m][0], acc[ai][bj][m][1]);
            } }
}
template <class Epi>
__device__ __forceinline__ void run_epi(const Epi& E, const f32x4 (&acc)[2][2][4][2], const Unit& u, int wr, int wc, int fr, int fq) {
#pragma unroll
    for (int ai = 0; ai < 2; ++ai)
#pragma unroll
        for (int m = 0; m < 4; ++m) { const int row = ai * HALF + wr * 64 + m * 16 + fr;
            if constexpr (Epi::PAIRED) {
#pragma unroll
                for (int n = 0; n < 2; ++n) E.st2(u, row, wc * 32 + n * 16 + 4 * fq, acc[ai][0][m][n], acc[ai][1][m][n]);
            } else {
#pragma unroll
                for (int bj = 0; bj < 2; ++bj)
#pragma unroll
                    for (int n = 0; n < 2; ++n) E.st(u, row, bj * HALF + wc * 32 + n * 16 + 4 * fq, acc[ai][bj][m][n]);
            } }
}

template <class Epi, class Sched, bool ALIGN_EPI = false, bool SP2 = false>
__device__ __forceinline__ void gemm_phase(PG8_LAS unsigned char* lds, const Gemm g, const Sched& S, const Epi& E) {
    const int tid = threadIdx.x, wid = __builtin_amdgcn_readfirstlane(tid >> 6), lane = tid & 63, wr = wid >> 2, wc = wid & 3, fr = lane & 15, fq = lane >> 4;
    const int K = g.K, nt = K / BK;
    unsigned voffA[2], voffB[2];
#pragma unroll
    for (int i = 0; i < 2; ++i) { int R, C; stage_rc(tid * 16 + i * 8192, R, C); const int rho = R & 31, Rb = (R & ~31) + 8 * ((rho & 15) >> 2) + 4 * (rho >> 4) + (rho & 3);
        voffA[i] = (unsigned)(R * K + C) * 2u; voffB[i] = (unsigned)(Rb * K + C) * 2u; }
    const size_t kstep = (size_t)(BK * 2);
    const size_t hstep = (size_t)HALF * K * 2;
    const size_t tstep = 2 * hstep;
    const unsigned ldsw = (unsigned)wid * 1024u;
    const int aoff = lds_byte(wr * 64 + fr, fq * 8), boff = lds_byte(wc * 32 + fr, fq * 8);
#define PG8_SA(b, h) (((b) * 2 + (h)) * HTB)
#define PG8_SB(b, h) ((4 + (b) * 2 + (h)) * HTB)
#define PG8_STAGE(bufoff, gbase, voff) do { _Pragma("unroll") for (int _i = 0; _i < 2; ++_i) \
        __builtin_amdgcn_global_load_lds((const unsigned*)((const char*)(gbase) + (voff)[_i]), (PG8_LAS unsigned*)(lds + (bufoff) + ldsw + _i * 8192), 16, 0, 0); } while (0)
#define PG8_LDA(dst, b, h) do { _Pragma("unroll") for (int m = 0; m < 4; ++m) _Pragma("unroll") for (int k = 0; k < 2; ++k) dst[m][k] = *(const PG8_LAS bf16x8*)(lds + PG8_SA(b, h) + aoff + m * 2048 + k * 1024); } while (0)
#define PG8_LDB(dst, b, h) do { _Pragma("unroll") for (int n = 0; n < 2; ++n) _Pragma("unroll") for (int k = 0; k < 2; ++k) dst[n][k] = *(const PG8_LAS bf16x8*)(lds + PG8_SB(b, h) + boff + n * 2048 + k * 1024); } while (0)
#define PG8_MMA(ai, bj, At, Bt) do { __builtin_amdgcn_s_setprio(1); _Pragma("unroll") for (int m = 0; m < 4; ++m) _Pragma("unroll") for (int n = 0; n < 2; ++n) _Pragma("unroll") for (int k = 0; k < 2; ++k) \
        acc[ai][bj][m][n] = __builtin_amdgcn_mfma_f32_16x16x32_bf16(Bt[n][k], At[m][k], acc[ai][bj][m][n], 0, 0, 0); __builtin_amdgcn_s_setprio(0); } while (0)
#define PG8_WAIT_V(n) asm volatile("s_waitcnt vmcnt(" #n ")" ::: "memory")
#define PG8_WAIT_L(n) asm volatile("s_waitcnt lgkmcnt(" #n ")" ::: "memory")
#define PG8_BAR __builtin_amdgcn_s_barrier()
#define PG8_SCHED __builtin_amdgcn_sched_barrier(0)
    Unit cur, nxt; int ui = 0;
    if (!S.next(0, cur)) return;
    f32x4 acc[2][2][4][2];
#pragma unroll
    for (int a = 0; a < 2; ++a)
#pragma unroll
        for (int b = 0; b < 2; ++b)
#pragma unroll
            for (int m = 0; m < 4; ++m)
#pragma unroll
                for (int n = 0; n < 2; ++n) acc[a][b][m][n] = (f32x4){0.f, 0.f, 0.f, 0.f};
    bf16x8 At[4][2], B0[2][2], B1[2][2];
    const char* cA = (const char*)g.A + (size_t)cur.pm * tstep; const char* cB = (const char*)g.Bt + (size_t)cur.pnB * tstep;

    if constexpr (SP2) {
        PG8_STAGE(PG8_SB(0, 0), cB, voffB); PG8_STAGE(PG8_SB(0, 1), cB + hstep, voffB); PG8_STAGE(PG8_SA(0, 0), cA, voffA); PG8_STAGE(PG8_SA(0, 1), cA + hstep, voffA);
        if (wr == 1) PG8_BAR;
        PG8_WAIT_V(2); PG8_BAR;
        PG8_STAGE(PG8_SB(1, 0), cB + kstep, voffB); PG8_STAGE(PG8_SA(1, 0), cA + kstep, voffA); PG8_STAGE(PG8_SB(1, 1), cB + hstep + kstep, voffB);
        PG8_WAIT_V(6); PG8_BAR;
    } else {
        PG8_STAGE(PG8_SB(0, 0), cB, voffB); PG8_STAGE(PG8_SA(0, 0), cA, voffA); PG8_STAGE(PG8_SB(0, 1), cB + hstep, voffB); PG8_STAGE(PG8_SA(0, 1), cA + hstep, voffA);
        if (wr == 1) PG8_BAR;
        PG8_WAIT_V(4); PG8_BAR;
        PG8_STAGE(PG8_SB(1, 0), cB + kstep, voffB); PG8_STAGE(PG8_SA(1, 0), cA + kstep, voffA); PG8_STAGE(PG8_SB(1, 1), cB + hstep + kstep, voffB);
        PG8_WAIT_V(6); PG8_BAR;
    }
    for (;;) {
        const bool has_next = S.next(ui + 1, nxt);
        const char* nA = has_next ? (const char*)g.A + (size_t)nxt.pm * tstep : cA; const char* nB = has_next ? (const char*)g.Bt + (size_t)nxt.pnB * tstep : cB;
        for (int t = 0; t < nt; t += 2) {
            const bool last = (t == nt - 2);
            const char* a1 = cA + (size_t)(t + 1) * kstep;
            const char* a2 = last ? nA : cA + (size_t)(t + 2) * kstep; const char* b2 = last ? nB : cB + (size_t)(t + 2) * kstep;
            const char* a3 = a2 + kstep; const char* b3 = b2 + kstep;

            if constexpr (SP2) {
            PG8_LDB(B0, 0, 0); PG8_LDB(B1, 0, 1); PG8_SCHED; PG8_LDA(At, 0, 0); PG8_STAGE(PG8_SA(1, 1), a1 + hstep, voffA);
            PG8_WAIT_V(8); PG8_WAIT_L(0); PG8_BAR; PG8_MMA(0, 0, At, B0); PG8_MMA(0, 1, At, B1); PG8_BAR; PG8_SCHED;
            PG8_LDA(At, 0, 1); PG8_STAGE(PG8_SB(0, 0), b2, voffB); PG8_STAGE(PG8_SB(0, 1), b2 + hstep, voffB); PG8_STAGE(PG8_SA(0, 0), a2, voffA);
            PG8_WAIT_V(8); PG8_WAIT_L(0); PG8_BAR; PG8_MMA(1, 0, At, B0); PG8_MMA(1, 1, At, B1); PG8_BAR; PG8_SCHED;
            PG8_LDB(B0, 1, 0); PG8_LDB(B1, 1, 1); PG8_SCHED; PG8_LDA(At, 1, 0); PG8_STAGE(PG8_SA(0, 1), a2 + hstep, voffA);
            PG8_WAIT_V(8); PG8_WAIT_L(0); PG8_BAR; PG8_MMA(0, 0, At, B0); PG8_MMA(0, 1, At, B1); PG8_BAR; PG8_SCHED;
            PG8_LDA(At, 1, 1); PG8_STAGE(PG8_SB(1, 0), b3, voffB); PG8_STAGE(PG8_SB(1, 1), b3 + hstep, voffB); PG8_STAGE(PG8_SA(1, 0), a3, voffA);
            PG8_WAIT_V(8); PG8_WAIT_L(0); PG8_BAR; PG8_MMA(1, 0, At, B0); PG8_MMA(1, 1, At, B1); PG8_BAR; PG8_SCHED;
            } else {
            PG8_LDB(B0, 0, 0); PG8_SCHED; PG8_LDA(At, 0, 0); PG8_STAGE(PG8_SA(1, 1), a1 + hstep, voffA);
            PG8_WAIT_L(8); PG8_BAR; PG8_WAIT_L(0); PG8_MMA(0, 0, At, B0); PG8_BAR; PG8_SCHED;
            PG8_LDB(B1, 0, 1); PG8_STAGE(PG8_SB(0, 0), b2, voffB);
            PG8_BAR; PG8_WAIT_L(0); PG8_MMA(0, 1, At, B1); PG8_BAR;
            PG8_LDA(At, 0, 1); PG8_STAGE(PG8_SA(0, 0), a2, voffA);
            PG8_BAR; PG8_WAIT_L(0); PG8_MMA(1, 0, At, B0); PG8_BAR; PG8_SCHED;
            PG8_STAGE(PG8_SB(0, 1), b2 + hstep, voffB);
            PG8_WAIT_V(6); PG8_BAR; PG8_MMA(1, 1, At, B1); PG8_BAR;
            PG8_LDB(B0, 1, 0); PG8_SCHED; PG8_LDA(At, 1, 0); PG8_STAGE(PG8_SA(0, 1), a2 + hstep, voffA);
            PG8_WAIT_L(8); PG8_BAR; PG8_WAIT_L(0); PG8_MMA(0, 0, At, B0); PG8_BAR; PG8_SCHED;
            PG8_LDB(B1, 1, 1); PG8_STAGE(PG8_SB(1, 0), b3, voffB);
            PG8_BAR; PG8_WAIT_L(0); PG8_MMA(0, 1, At, B1); PG8_BAR;
            PG8_LDA(At, 1, 1); PG8_STAGE(PG8_SA(1, 0), a3, voffA);
            PG8_BAR; PG8_WAIT_L(0); PG8_MMA(1, 0, At, B0); PG8_BAR; PG8_SCHED;
            PG8_STAGE(PG8_SB(1, 1), b3 + hstep, voffB);
            PG8_WAIT_V(6); PG8_BAR; PG8_MMA(1, 1, At, B1); PG8_BAR;
            }
        }
        if constexpr (ALIGN_EPI) { if (wr == 0) PG8_BAR; }
        if constexpr (!Epi::FUSED) run_epi8(E, acc, cur, wr, wc, fr, fq);
        if (!has_next) break;
#pragma unroll
        for (int a = 0; a < 2; ++a)
#pragma unroll
            for (int b = 0; b < 2; ++b)
#pragma unroll
                for (int m = 0; m < 4; ++m)
#pragma unroll
                    for (int n = 0; n < 2; ++n) acc[a][b][m][n] = (f32x4){0.f, 0.f, 0.f, 0.f};
        cur = nxt; cA = nA; cB = nB; ++ui;
        if constexpr (ALIGN_EPI) { if (wr == 1) PG8_BAR; }
    }
    PG8_WAIT_V(0);
    if constexpr (!ALIGN_EPI) { if (wr == 0) PG8_BAR; }
    PG8_BAR;
    if constexpr (Epi::FUSED) E.fused(acc, cur, wr, wc, fr, fq, lds, wid, lane);

#undef PG8_SA
#undef PG8_SB
#undef PG8_STAGE
#undef PG8_LDA
#undef PG8_LDB
#undef PG8_MMA
#undef PG8_WAIT_V
#undef PG8_WAIT_L
#undef PG8_BAR
#undef PG8_SCHED
}

template <class Epi, class Sched, bool ALIGN_EPI = false, bool SP2 = false>
__device__ __forceinline__ void gemm_phase_f8(PG8_LAS unsigned char* lds, const Gemm g, const Sched& S, const Epi& E) {
    const int tid = threadIdx.x, wid = __builtin_amdgcn_readfirstlane(tid >> 6), lane = tid & 63, wr = wid >> 2, wc = wid & 3, fr = lane & 15, fq = lane >> 4;
    const int RP = g.K, nt = RP / 128;
    unsigned voffA[2], voffB[2];
#pragma unroll
    for (int i = 0; i < 2; ++i) { const int b_ = tid * 16 + i * 8192, R = b_ >> 7, pp = (b_ >> 4) & 7, rr_ = R & 15, ff = ((rr_ >> 1) & 1) | (((rr_ >> 3) & 1) << 2);
        const int rho = R & 31, Rb = (R & ~31) + 8 * ((rho & 15) >> 2) + 4 * (rho >> 4) + (rho & 3);
        voffA[i] = (unsigned)(R * RP + ((pp ^ ff) * 16)); voffB[i] = (unsigned)(Rb * RP + ((pp ^ ff) * 16)); }
    const size_t kstep = (size_t)(BK * 2);
    const size_t hstep = (size_t)HALF * RP;
    const size_t tstep = 2 * hstep;
    const unsigned ldsw = (unsigned)wid * 1024u;
    const int ffr = ((fr >> 1) & 1) | (((fr >> 3) & 1) << 2);
    const int aoff = (wr * 64 + fr) * 128 + (((2 * fq) ^ ffr) * 16), boff = (wc * 32 + fr) * 128 + (((2 * fq) ^ ffr) * 16), hoff = (ffr & 1) ? -16 : 16;
#define PG8_SA(b, h) (((b) * 2 + (h)) * HTB)
#define PG8_SB(b, h) ((4 + (b) * 2 + (h)) * HTB)
#define PG8_STAGE(bufoff, gbase, voff) do { _Pragma("unroll") for (int _i = 0; _i < 2; ++_i) \
        __builtin_amdgcn_global_load_lds((const unsigned*)((const char*)(gbase) + (voff)[_i]), (PG8_LAS unsigned*)(lds + (bufoff) + ldsw + _i * 8192), 16, 0, 0); } while (0)
#define PG8_LDA(dst, b, h) do { _Pragma("unroll") for (int m = 0; m < 4; ++m) { dst[m].lo = *(const PG8_LAS v4i_t*)(lds + PG8_SA(b, h) + aoff + m * 2048); dst[m].hi = *(const PG8_LAS v4i_t*)(lds + PG8_SA(b, h) + aoff + m * 2048 + hoff); } } while (0)
#define PG8_LDB(dst, b, h) do { _Pragma("unroll") for (int n = 0; n < 2; ++n) { dst[n].lo = *(const PG8_LAS v4i_t*)(lds + PG8_SB(b, h) + boff + n * 2048); dst[n].hi = *(const PG8_LAS v4i_t*)(lds + PG8_SB(b, h) + boff + n * 2048 + hoff); } } while (0)
#define PG8_MMA(ai, bj, At, Bt) do { __builtin_amdgcn_s_setprio(1); _Pragma("unroll") for (int m = 0; m < 4; ++m) _Pragma("unroll") for (int n = 0; n < 2; ++n) \
        asm volatile("v_mfma_f32_16x16x128_f8f6f4 %0, %1, %2, %0" : "+v"(acc[ai][bj][m][n]) : "v"(Bt[n]), "v"(At[m])); __builtin_amdgcn_s_setprio(0); } while (0)
#define PG8_WAIT_V(n) asm volatile("s_waitcnt vmcnt(" #n ")" ::: "memory")
#define PG8_WAIT_L(n) asm volatile("s_waitcnt lgkmcnt(" #n ")" ::: "memory")
#define PG8_BAR __builtin_amdgcn_s_barrier()
#define PG8_SCHED __builtin_amdgcn_sched_barrier(0)
    Unit cur, nxt; int ui = 0;
    if (!S.next(0, cur)) return;
    f32x4 acc[2][2][4][2];
#pragma unroll
    for (int a = 0; a < 2; ++a)
#pragma unroll
        for (int b = 0; b < 2; ++b)
#pragma unroll
            for (int m = 0; m < 4; ++m)
#pragma unroll
                for (int n = 0; n < 2; ++n) acc[a][b][m][n] = (f32x4){0.f, 0.f, 0.f, 0.f};
    v8i_t At[4], B0[2], B1[2];
    const char* cA = (const char*)g.A + (size_t)cur.pm * tstep; const char* cB = (const char*)g.Bt + (size_t)cur.pnB * tstep;

    if constexpr (SP2) {
        PG8_STAGE(PG8_SB(0, 0), cB, voffB); PG8_STAGE(PG8_SB(0, 1), cB + hstep, voffB); PG8_STAGE(PG8_SA(0, 0), cA, voffA); PG8_STAGE(PG8_SA(0, 1), cA + hstep, voffA);
        if (wr == 1) PG8_BAR;
        PG8_WAIT_V(2); PG8_BAR;
        PG8_STAGE(PG8_SB(1, 0), cB + kstep, voffB); PG8_STAGE(PG8_SA(1, 0), cA + kstep, voffA); PG8_STAGE(PG8_SB(1, 1), cB + hstep + kstep, voffB);
        PG8_WAIT_V(6); PG8_BAR;
    } else {
        PG8_STAGE(PG8_SB(0, 0), cB, voffB); PG8_STAGE(PG8_SA(0, 0), cA, voffA); PG8_STAGE(PG8_SB(0, 1), cB + hstep, voffB); PG8_STAGE(PG8_SA(0, 1), cA + hstep, voffA);
        if (wr == 1) PG8_BAR;
        PG8_WAIT_V(4); PG8_BAR;
        PG8_STAGE(PG8_SB(1, 0), cB + kstep, voffB); PG8_STAGE(PG8_SA(1, 0), cA + kstep, voffA); PG8_STAGE(PG8_SB(1, 1), cB + hstep + kstep, voffB);
        PG8_WAIT_V(6); PG8_BAR;
    }
    for (;;) {
        const bool has_next = S.next(ui + 1, nxt);
        const char* nA = has_next ? (const char*)g.A + (size_t)nxt.pm * tstep : cA; const char* nB = has_next ? (const char*)g.Bt + (size_t)nxt.pnB * tstep : cB;
        for (int t = 0; t < nt; t += 2) {
            const bool last = (t == nt - 2);
            const char* a1 = cA + (size_t)(t + 1) * kstep;
            const char* a2 = last ? nA : cA + (size_t)(t + 2) * kstep; const char* b2 = last ? nB : cB + (size_t)(t + 2) * kstep;
            const char* a3 = a2 + kstep; const char* b3 = b2 + kstep;

            if constexpr (SP2) {
            PG8_LDB(B0, 0, 0); PG8_LDB(B1, 0, 1); PG8_SCHED; PG8_LDA(At, 0, 0); PG8_STAGE(PG8_SA(1, 1), a1 + hstep, voffA);
            PG8_WAIT_V(8); PG8_WAIT_L(0); PG8_BAR; PG8_MMA(0, 0, At, B0); PG8_MMA(0, 1, At, B1); PG8_BAR; PG8_SCHED;
            PG8_LDA(At, 0, 1); PG8_STAGE(PG8_SB(0, 0), b2, voffB); PG8_STAGE(PG8_SB(0, 1), b2 + hstep, voffB); PG8_STAGE(PG8_SA(0, 0), a2, voffA);
            PG8_WAIT_V(8); PG8_WAIT_L(0); PG8_BAR; PG8_MMA(1, 0, At, B0); PG8_MMA(1, 1, At, B1); PG8_BAR; PG8_SCHED;
            PG8_LDB(B0, 1, 0); PG8_LDB(B1, 1, 1); PG8_SCHED; PG8_LDA(At, 1, 0); PG8_STAGE(PG8_SA(0, 1), a2 + hstep, voffA);
            PG8_WAIT_V(8); PG8_WAIT_L(0); PG8_BAR; PG8_MMA(0, 0, At, B0); PG8_MMA(0, 1, At, B1); PG8_BAR; PG8_SCHED;
            PG8_LDA(At, 1, 1); PG8_STAGE(PG8_SB(1, 0), b3, voffB); PG8_STAGE(PG8_SB(1, 1), b3 + hstep, voffB); PG8_STAGE(PG8_SA(1, 0), a3, voffA);
            PG8_WAIT_V(8); PG8_WAIT_L(0); PG8_BAR; PG8_MMA(1, 0, At, B0); PG8_MMA(1, 1, At, B1); PG8_BAR; PG8_SCHED;
            } else {
            PG8_LDB(B0, 0, 0); PG8_SCHED; PG8_LDA(At, 0, 0); PG8_STAGE(PG8_SA(1, 1), a1 + hstep, voffA);
            PG8_WAIT_L(8); PG8_BAR; PG8_WAIT_L(0); PG8_MMA(0, 0, At, B0); PG8_BAR; PG8_SCHED;
            PG8_LDB(B1, 0, 1); PG8_STAGE(PG8_SB(0, 0), b2, voffB);
            PG8_BAR; PG8_WAIT_L(0); PG8_MMA(0, 1, At, B1); PG8_BAR;
            PG8_LDA(At, 0, 1); PG8_STAGE(PG8_SA(0, 0), a2, voffA);
            PG8_BAR; PG8_WAIT_L(0); PG8_MMA(1, 0, At, B0); PG8_BAR; PG8_SCHED;
            PG8_STAGE(PG8_SB(0, 1), b2 + hstep, voffB);
            PG8_WAIT_V(6); PG8_BAR; PG8_MMA(1, 1, At, B1); PG8_BAR;
            PG8_LDB(B0, 1, 0); PG8_SCHED; PG8_LDA(At, 1, 0); PG8_STAGE(PG8_SA(0, 1), a2 + hstep, voffA);
            PG8_WAIT_L(8); PG8_BAR; PG8_WAIT_L(0); PG8_MMA(0, 0, At, B0); PG8_BAR; PG8_SCHED;
            PG8_LDB(B1, 1, 1); PG8_STAGE(PG8_SB(1, 0), b3, voffB);
            PG8_BAR; PG8_WAIT_L(0); PG8_MMA(0, 1, At, B1); PG8_BAR;
            PG8_LDA(At, 1, 1); PG8_STAGE(PG8_SA(1, 0), a3, voffA);
            PG8_BAR; PG8_WAIT_L(0); PG8_MMA(1, 0, At, B0); PG8_BAR; PG8_SCHED;
            PG8_STAGE(PG8_SB(1, 1), b3 + hstep, voffB);
            PG8_WAIT_V(6); PG8_BAR; PG8_MMA(1, 1, At, B1); PG8_BAR;
            }
        }
        asm volatile("s_nop 15\n\ts_nop 15" ::: "memory");
        if constexpr (ALIGN_EPI) { if (wr == 0) PG8_BAR; }
        run_epi8(E, acc, cur, wr, wc, fr, fq);
        if (!has_next) break;
#pragma unroll
        for (int a = 0; a < 2; ++a)
#pragma unroll
            for (int b = 0; b < 2; ++b)
#pragma unroll
                for (int m = 0; m < 4; ++m)
#pragma unroll
                    for (int n = 0; n < 2; ++n) acc[a][b][m][n] = (f32x4){0.f, 0.f, 0.f, 0.f};
        cur = nxt; cA = nA; cB = nB; ++ui;
        if constexpr (ALIGN_EPI) { if (wr == 1) PG8_BAR; }
    }
    PG8_WAIT_V(0);
    if constexpr (!ALIGN_EPI) { if (wr == 0) PG8_BAR; }
    PG8_BAR;

#undef PG8_SA
#undef PG8_SB
#undef PG8_STAGE
#undef PG8_LDA
#undef PG8_LDB
#undef PG8_MMA
#undef PG8_WAIT_V
#undef PG8_WAIT_L
#undef PG8_BAR
#undef PG8_SCHED
}

template <class Epi, class Sched, bool ALIGN_EPI = false, bool SP2 = false>
__device__ __forceinline__ void gemm_phase_f8g(PG8_LAS unsigned char* lds, const Gemm g, const Sched& S, const Epi& E, const int* tok) {
    const int tid = threadIdx.x, wid = __builtin_amdgcn_readfirstlane(tid >> 6), lane = tid & 63, wr = wid >> 2, wc = wid & 3, fr = lane & 15, fq = lane >> 4;
    const int RP = g.K, nt = RP / 128;
    unsigned voffA[2], voffB[2]; int rowA[2];
#pragma unroll
    for (int i = 0; i < 2; ++i) { const int b_ = tid * 16 + i * 8192, R = b_ >> 7, pp = (b_ >> 4) & 7, rr_ = R & 15, ff = ((rr_ >> 1) & 1) | (((rr_ >> 3) & 1) << 2);
        const int rho = R & 31, Rb = (R & ~31) + 8 * ((rho & 15) >> 2) + 4 * (rho >> 4) + (rho & 3);
        voffA[i] = (unsigned)((pp ^ ff) * 16); rowA[i] = R; voffB[i] = (unsigned)(Rb * RP + ((pp ^ ff) * 16)); }
    const size_t kstep = (size_t)(BK * 2);
    const size_t hstep = (size_t)HALF * RP;
    const size_t tstep = 2 * hstep;
    const unsigned ldsw = (unsigned)wid * 1024u;
    const int ffr = ((fr >> 1) & 1) | (((fr >> 3) & 1) << 2);
    const int aoff = (wr * 64 + fr) * 128 + (((2 * fq) ^ ffr) * 16), boff = (wc * 32 + fr) * 128 + (((2 * fq) ^ ffr) * 16), hoff = (ffr & 1) ? -16 : 16;
#define PG8_SA(b, h) (((b) * 2 + (h)) * HTB)
#define PG8_SB(b, h) ((4 + (b) * 2 + (h)) * HTB)
#define PG8_STAGE(bufoff, gbase, voff) do { _Pragma("unroll") for (int _i = 0; _i < 2; ++_i) \
        __builtin_amdgcn_global_load_lds((const unsigned*)((const char*)(gbase) + (voff)[_i]), (PG8_LAS unsigned*)(lds + (bufoff) + ldsw + _i * 8192), 16, 0, 0); } while (0)
#define PG8_LDA(dst, b, h) do { _Pragma("unroll") for (int m = 0; m < 4; ++m) { dst[m].lo = *(const PG8_LAS v4i_t*)(lds + PG8_SA(b, h) + aoff + m * 2048); dst[m].hi = *(const PG8_LAS v4i_t*)(lds + PG8_SA(b, h) + aoff + m * 2048 + hoff); } } while (0)
#define PG8_LDB(dst, b, h) do { _Pragma("unroll") for (int n = 0; n < 2; ++n) { dst[n].lo = *(const PG8_LAS v4i_t*)(lds + PG8_SB(b, h) + boff + n * 2048); dst[n].hi = *(const PG8_LAS v4i_t*)(lds + PG8_SB(b, h) + boff + n * 2048 + hoff); } } while (0)
#define PG8_MMA(ai, bj, At, Bt) do { __builtin_amdgcn_s_setprio(1); _Pragma("unroll") for (int m = 0; m < 4; ++m) _Pragma("unroll") for (int n = 0; n < 2; ++n) \
        asm volatile("v_mfma_f32_16x16x128_f8f6f4 %0, %1, %2, %0" : "+v"(acc[ai][bj][m][n]) : "v"(Bt[n]), "v"(At[m])); __builtin_amdgcn_s_setprio(0); } while (0)
#define PG8_WAIT_V(n) asm volatile("s_waitcnt vmcnt(" #n ")" ::: "memory")
#define PG8_WAIT_L(n) asm volatile("s_waitcnt lgkmcnt(" #n ")" ::: "memory")
#define PG8_BAR __builtin_amdgcn_s_barrier()
#define PG8_SCHED __builtin_amdgcn_sched_barrier(0)
    Unit cur, nxt; int ui = 0;
    if (!S.next(0, cur)) return;
    f32x4 acc[2][2][4][2];
#pragma unroll
    for (int a = 0; a < 2; ++a)
#pragma unroll
        for (int b = 0; b < 2; ++b)
#pragma unroll
            for (int m = 0; m < 4; ++m)
#pragma unroll
                for (int n = 0; n < 2; ++n) acc[a][b][m][n] = (f32x4){0.f, 0.f, 0.f, 0.f};
    v8i_t At[4], B0[2], B1[2];
    const char* cA = (const char*)g.A; const char* cB = (const char*)g.Bt + (size_t)cur.pnB * tstep;
    unsigned vC[2][2], vN[2][2] = {{0u, 0u}, {0u, 0u}};
#define PG8_TOKOFF(dst, pm_) do { _Pragma("unroll") for (int h_ = 0; h_ < 2; ++h_) _Pragma("unroll") for (int i_ = 0; i_ < 2; ++i_) dst[h_][i_] = (unsigned)tok[(pm_) * 256 + h_ * 128 + rowA[i_]] * (unsigned)RP + voffA[i_]; } while (0)
    PG8_TOKOFF(vC, cur.pm);

    if constexpr (SP2) {
        PG8_STAGE(PG8_SB(0, 0), cB, voffB); PG8_STAGE(PG8_SB(0, 1), cB + hstep, voffB); PG8_STAGE(PG8_SA(0, 0), cA, vC[0]); PG8_STAGE(PG8_SA(0, 1), cA, vC[1]);
        if (wr == 1) PG8_BAR;
        PG8_WAIT_V(2); PG8_BAR;
        PG8_STAGE(PG8_SB(1, 0), cB + kstep, voffB); PG8_STAGE(PG8_SA(1, 0), cA + kstep, vC[0]); PG8_STAGE(PG8_SB(1, 1), cB + hstep + kstep, voffB);
        PG8_WAIT_V(6); PG8_BAR;
    } else {
        PG8_STAGE(PG8_SB(0, 0), cB, voffB); PG8_STAGE(PG8_SA(0, 0), cA, vC[0]); PG8_STAGE(PG8_SB(0, 1), cB + hstep, voffB); PG8_STAGE(PG8_SA(0, 1), cA, vC[1]);
        if (wr == 1) PG8_BAR;
        PG8_WAIT_V(4); PG8_BAR;
        PG8_STAGE(PG8_SB(1, 0), cB + kstep, voffB); PG8_STAGE(PG8_SA(1, 0), cA + kstep, vC[0]); PG8_STAGE(PG8_SB(1, 1), cB + hstep + kstep, voffB);
        PG8_WAIT_V(6); PG8_BAR;
    }
    for (;;) {
        const bool has_next = S.next(ui + 1, nxt);
        const char* nB = has_next ? (const char*)g.Bt + (size_t)nxt.pnB * tstep : cB;
        int tkN[2][2] = {{0, 0}, {0, 0}};
        if (has_next) { _Pragma("unroll") for (int h_ = 0; h_ < 2; ++h_) _Pragma("unroll") for (int i_ = 0; i_ < 2; ++i_) tkN[h_][i_] = tok[nxt.pm * 256 + h_ * 128 + rowA[i_]]; }
        for (int t = 0; t < nt; t += 2) {
            const bool last = (t == nt - 2);
            const char* a1 = cA + (size_t)(t + 1) * kstep;
            const char* a2 = last ? cA : cA + (size_t)(t + 2) * kstep; const char* b2 = last ? nB : cB + (size_t)(t + 2) * kstep;
            unsigned vs0[2] = {vC[0][0], vC[0][1]}, vs1[2] = {vC[1][0], vC[1][1]};
            if (last && has_next) { asm volatile("" : "+v"(tkN[0][0]), "+v"(tkN[0][1]), "+v"(tkN[1][0]), "+v"(tkN[1][1]));
                _Pragma("unroll") for (int h_ = 0; h_ < 2; ++h_) _Pragma("unroll") for (int i_ = 0; i_ < 2; ++i_) vN[h_][i_] = (unsigned)tkN[h_][i_] * (unsigned)RP + voffA[i_];
                vs0[0] = vN[0][0]; vs0[1] = vN[0][1]; vs1[0] = vN[1][0]; vs1[1] = vN[1][1]; }
            const char* a3 = a2 + kstep; const char* b3 = b2 + kstep;

            if constexpr (SP2) {
            PG8_LDB(B0, 0, 0); PG8_LDB(B1, 0, 1); PG8_SCHED; PG8_LDA(At, 0, 0); PG8_STAGE(PG8_SA(1, 1), a1, vC[1]);
            PG8_WAIT_V(8); PG8_WAIT_L(0); PG8_BAR; PG8_MMA(0, 0, At, B0); PG8_MMA(0, 1, At, B1); PG8_BAR; PG8_SCHED;
            PG8_LDA(At, 0, 1); PG8_STAGE(PG8_SB(0, 0), b2, voffB); PG8_STAGE(PG8_SB(0, 1), b2 + hstep, voffB); PG8_STAGE(PG8_SA(0, 0), a2, vs0);
            PG8_WAIT_V(8); PG8_WAIT_L(0); PG8_BAR; PG8_MMA(1, 0, At, B0); PG8_MMA(1, 1, At, B1); PG8_BAR; PG8_SCHED;
            PG8_LDB(B0, 1, 0); PG8_LDB(B1, 1, 1); PG8_SCHED; PG8_LDA(At, 1, 0); PG8_STAGE(PG8_SA(0, 1), a2, vs1);
            PG8_WAIT_V(8); PG8_WAIT_L(0); PG8_BAR; PG8_MMA(0, 0, At, B0); PG8_MMA(0, 1, At, B1); PG8_BAR; PG8_SCHED;
            PG8_LDA(At, 1, 1); PG8_STAGE(PG8_SB(1, 0), b3, voffB); PG8_STAGE(PG8_SB(1, 1), b3 + hstep, voffB); PG8_STAGE(PG8_SA(1, 0), a3, vs0);
            PG8_WAIT_V(8); PG8_WAIT_L(0); PG8_BAR; PG8_MMA(1, 0, At, B0); PG8_MMA(1, 1, At, B1); PG8_BAR; PG8_SCHED;
            } else {
            PG8_LDB(B0, 0, 0); PG8_SCHED; PG8_LDA(At, 0, 0); PG8_STAGE(PG8_SA(1, 1), a1, vC[1]);
            PG8_WAIT_L(8); PG8_BAR; PG8_WAIT_L(0); PG8_MMA(0, 0, At, B0); PG8_BAR; PG8_SCHED;
            PG8_LDB(B1, 0, 1); PG8_STAGE(PG8_SB(0, 0), b2, voffB);
            PG8_BAR; PG8_WAIT_L(0); PG8_MMA(0, 1, At, B1); PG8_BAR;
            PG8_LDA(At, 0, 1); PG8_STAGE(PG8_SA(0, 0), a2, vs0);
            PG8_BAR; PG8_WAIT_L(0); PG8_MMA(1, 0, At, B0); PG8_BAR; PG8_SCHED;
            PG8_STAGE(PG8_SB(0, 1), b2 + hstep, voffB);
            PG8_WAIT_V(6); PG8_BAR; PG8_MMA(1, 1, At, B1); PG8_BAR;
            PG8_LDB(B0, 1, 0); PG8_SCHED; PG8_LDA(At, 1, 0); PG8_STAGE(PG8_SA(0, 1), a2, vs1);
            PG8_WAIT_L(8); PG8_BAR; PG8_WAIT_L(0); PG8_MMA(0, 0, At, B0); PG8_BAR; PG8_SCHED;
            PG8_LDB(B1, 1, 1); PG8_STAGE(PG8_SB(1, 0), b3, voffB);
            PG8_BAR; PG8_WAIT_L(0); PG8_MMA(0, 1, At, B1); PG8_BAR;
            PG8_LDA(At, 1, 1); PG8_STAGE(PG8_SA(1, 0), a3, vs0);
            PG8_BAR; PG8_WAIT_L(0); PG8_MMA(1, 0, At, B0); PG8_BAR; PG8_SCHED;
            PG8_STAGE(PG8_SB(1, 1), b3 + hstep, voffB);
            PG8_WAIT_V(6); PG8_BAR; PG8_MMA(1, 1, At, B1); PG8_BAR;
            }
        }
        asm volatile("s_nop 15\n\ts_nop 15" ::: "memory");
        if constexpr (ALIGN_EPI) { if (wr == 0) PG8_BAR; }
        if constexpr (Epi::STAGED) {
            PG8_LAS unsigned char* stg = lds + STAGE_BYTES; const int tid_ = wid * 64 + lane;
#pragma unroll
            for (int ai = 0; ai < 2; ++ai) {
#pragma unroll
                for (int m = 0; m < 4; ++m) { const int rl = wr * 64 + m * 16 + fr, pc = 4 * wc + fq;
                    const v2u_t w = E.pack8(acc[ai][0][m][0], acc[ai][0][m][1], acc[ai][1][m][0], acc[ai][1][m][1]);
                    *(PG8_LAS v2u_t*)(stg + rl * 128 + ((pc ^ (rl & 15)) * 8)) = w; }
                asm volatile("s_waitcnt lgkmcnt(0)" ::: "memory"); PG8_BAR;
                { const int rl = tid_ >> 2, q = tid_ & 3, sw = rl & 15; const PG8_LAS unsigned char* rp = stg + rl * 128;
                  const v2u_t p0 = *(const PG8_LAS v2u_t*)(rp + (((4 * q + 0) ^ sw) * 8)), p1 = *(const PG8_LAS v2u_t*)(rp + (((4 * q + 1) ^ sw) * 8));
                  const v2u_t p2 = *(const PG8_LAS v2u_t*)(rp + (((4 * q + 2) ^ sw) * 8)), p3 = *(const PG8_LAS v2u_t*)(rp + (((4 * q + 3) ^ sw) * 8));
                  E.store32(cur, ai * HALF + rl, 32 * q, (u32x4){p0.x, p0.y, p1.x, p1.y}, (u32x4){p2.x, p2.y, p3.x, p3.y}); }
                asm volatile("s_waitcnt lgkmcnt(0)" ::: "memory"); PG8_BAR;
            }
        } else run_epi8(E, acc, cur, wr, wc, fr, fq);
        if (!has_next) break;
#pragma unroll
        for (int a = 0; a < 2; ++a)
#pragma unroll
            for (int b = 0; b < 2; ++b)
#pragma unroll
                for (int m = 0; m < 4; ++m)
#pragma unroll
                    for (int n = 0; n < 2; ++n) acc[a][b][m][n] = (f32x4){0.f, 0.f, 0.f, 0.f};
        cur = nxt; cB = nB; ++ui; vC[0][0] = vN[0][0]; vC[0][1] = vN[0][1]; vC[1][0] = vN[1][0]; vC[1][1] = vN[1][1];
        if constexpr (ALIGN_EPI) { if (wr == 1) PG8_BAR; }
    }
    PG8_WAIT_V(0);
    if constexpr (!ALIGN_EPI) { if (wr == 0) PG8_BAR; }
    PG8_BAR;

#undef PG8_TOKOFF
#undef PG8_SA
#undef PG8_SB
#undef PG8_STAGE
#undef PG8_LDA
#undef PG8_LDB
#undef PG8_MMA
#undef PG8_WAIT_V
#undef PG8_WAIT_L
#undef PG8_BAR
#undef PG8_SCHED
}
}

constexpr int D = 1024, BATCH = 8, SEQ = 2048, CTXL = 256;
constexpr int M = BATCH * SEQ;
constexpr int MC = BATCH * CTXL;
constexpr int MT = M + MC;
constexpr int DIN = 2048, DSGU = 512, DLRU = 512, NE = 16, CAP = 256, DE = 2048, NMOD = 6 * D;
constexpr int NSEG = 36;
constexpr float EPS = 1e-6f;
constexpr int NWAVES = 8, NTHREADS = 512;
constexpr int LDS_BYTES = 147456 + 256;
constexpr int NPH = 11;

constexpr size_t MiB = 1u << 20;
constexpr size_t WS_CTL = 0;
constexpr size_t WS_MOD = 1 * MiB;
constexpr size_t WS_SUM = 1 * MiB + 512 * 1024;
constexpr size_t WS_AFF = 4 * MiB;
constexpr size_t WS_SLOT = 5 * MiB;
constexpr size_t WS_GATE = 6 * MiB;
constexpr size_t WS_TOK = 6 * MiB + 128 * 1024;
constexpr size_t WS_GWT = 6 * MiB + 512 * 1024;
constexpr size_t WS_SWB = 7 * MiB;
constexpr size_t WS_WIN = 8 * MiB;
constexpr size_t WS_WOUT = 12 * MiB;
constexpr size_t WS_WG = 14 * MiB;
constexpr size_t WS_W2 = 142 * MiB;
constexpr size_t WS_X1 = 206 * MiB;
constexpr size_t WS_HS = 206 * MiB, WS_PF = 222 * MiB, WS_PB = 238 * MiB;
constexpr size_t WS_HX2 = 270 * MiB;
constexpr size_t WS_XCH = 286 * MiB;
constexpr size_t WS_CB = 1 * MiB + 256 * 1024;
constexpr size_t WS_XE = 302 * MiB;
constexpr size_t WS_A2 = 302 * MiB, WS_YE = 302 * MiB;
constexpr size_t WS_HID = 366 * MiB;
constexpr size_t WS_HX = 366 * MiB;
constexpr size_t WS_UV = 402 * MiB;
constexpr size_t WS_XC = 466 * MiB;
constexpr size_t WS_END = 494 * MiB;

#define GAS __attribute__((address_space(1)))
#define LAS __attribute__((address_space(3)))
typedef unsigned short bf16;
typedef unsigned v4u __attribute__((ext_vector_type(4)));
typedef unsigned v2u __attribute__((ext_vector_type(2)));
typedef float f32x4 __attribute__((ext_vector_type(4)));
typedef short bf16x8 __attribute__((ext_vector_type(8)));
#define LDS_WAIT() asm volatile("s_waitcnt lgkmcnt(0)" ::: "memory")

__device__ __forceinline__ float bf2f(bf16 b) { return __uint_as_float(((unsigned)b) << 16); }
__device__ __forceinline__ unsigned f2bf(float f) { unsigned u = __float_as_uint(f); return (u + 0x7fffu + ((u >> 16) & 1u)) >> 16; }
typedef __bf16 bf16x2_hw __attribute__((ext_vector_type(2)));
typedef float f32x2_hw __attribute__((ext_vector_type(2)));
__device__ __forceinline__ unsigned pk2(float lo, float hi) { const f32x2_hw v = {lo, hi}; return __builtin_bit_cast(unsigned, __builtin_convertvector(v, bf16x2_hw)); }
__device__ __forceinline__ float bflo(unsigned w) { return __uint_as_float(w << 16); }
__device__ __forceinline__ float bfhi(unsigned w) { return __uint_as_float(w & 0xffff0000u); }
__device__ __forceinline__ float rcpf_(float x) { return __builtin_amdgcn_rcpf(x); }
__device__ __forceinline__ float exp2f_(float x) { return __builtin_amdgcn_exp2f(x); }
__device__ __forceinline__ float sigmoidf_(float x) { return rcpf_(1.f + exp2f_(-1.4426950408889634f * x)); }
__device__ __forceinline__ float siluf_(float x) { return x * rcpf_(1.f + exp2f_(-1.4426950408889634f * x)); }
__device__ __forceinline__ float geluf_(float x) { const float u = x * (0.7978845608028654f + 0.035677408136300125f * x * x); return x * rcpf_(1.f + exp2f_(-2.8853900817779268f * u)); }
__device__ __forceinline__ void decay_pair(float la, float& a, float& s) {
    const float x = 2.f * la;
    const float p1 = la * (1.f + la * (0.5f + la * (0.16666667f + la * (0.041666668f + la * 0.0083333333f))));
    const float p2 = x * (1.f + x * (0.5f + x * (0.16666667f + x * (0.041666668f + x * (0.0083333333f + x * 0.0013888889f)))));
    const float e1 = exp2f_(1.4426950408889634f * la);
    const bool small = la > -0.15f;
    a = small ? 1.f + p1 : e1;
    s = __builtin_amdgcn_sqrtf(small ? -p2 : 1.f - e1 * e1);
}
typedef float f32x2p __attribute__((ext_vector_type(2)));
__device__ __forceinline__ f32x2p sigmoid2_(f32x2p x) { const f32x2p t = x * -1.4426950408889634f; f32x2p e; e.x = exp2f_(t.x); e.y = exp2f_(t.y); e = e + 1.f; f32x2p r; r.x = rcpf_(e.x); r.y = rcpf_(e.y); return r; }
__device__ __forceinline__ f32x2p gelu2_(f32x2p x) { const f32x2p u = x * (x * x * 0.035677408136300125f + 0.7978845608028654f), t = u * -2.8853900817779268f; f32x2p e; e.x = exp2f_(t.x); e.y = exp2f_(t.y); e = e + 1.f;
    f32x2p r; r.x = rcpf_(e.x); r.y = rcpf_(e.y); return x * r; }
__device__ __forceinline__ void decay_pair2(f32x2p la, f32x2p& a, f32x2p& s) {
    const f32x2p x = la * 2.f;
    const f32x2p p1 = la * (la * (la * (la * (la * 0.0083333333f + 0.041666668f) + 0.16666667f) + 0.5f) + 1.f);
    const f32x2p p2 = x * (x * (x * (x * (x * (x * 0.0013888889f + 0.0083333333f) + 0.041666668f) + 0.16666667f) + 0.5f) + 1.f);
    const f32x2p tt = la * 1.4426950408889634f; f32x2p e1; e1.x = exp2f_(tt.x); e1.y = exp2f_(tt.y);
    const f32x2p big = 1.f - e1 * e1, one = p1 + 1.f;
    a.x = la.x > -0.15f ? one.x : e1.x; a.y = la.y > -0.15f ? one.y : e1.y;
    s.x = __builtin_amdgcn_sqrtf(la.x > -0.15f ? -p2.x : big.x); s.y = __builtin_amdgcn_sqrtf(la.y > -0.15f ? -p2.y : big.y);
}
__device__ __forceinline__ unsigned pk4_fp8(float a, float b, float c, float d) {
    unsigned w = 0u; w = __builtin_amdgcn_cvt_pk_fp8_f32(a, b, w, false); w = __builtin_amdgcn_cvt_pk_fp8_f32(c, d, w, true); return w; }
constexpr float WSCALE = 32.f, WSCALE_INV = 1.f / 32.f;
__device__ __forceinline__ float wave_sum(float v) {
#pragma unroll
    for (int o = 1; o < 64; o <<= 1) v += __shfl_xor(v, o);
    return v;
}


#define XB_TMO      128
#define XB_XCNT(j)  (256  + 64 * (j))
#define XB_XSUB(j)  (1280 + 64 * (j))
#define XB_XGEN(j)  (2304 + 64 * (j))
#define XB_TOP      3328
#define XB_TOPGEN   3392
#define XCD_BAR_WORDS 3456
#define XB_SPIN_CAP (1u << 18)
__device__ __forceinline__ unsigned xb_ld(unsigned* p)              { return __hip_atomic_load(p, __ATOMIC_RELAXED, __HIP_MEMORY_SCOPE_AGENT); }
__device__ __forceinline__ unsigned xb_add(unsigned* p, unsigned v) { return __hip_atomic_fetch_add(p, v, __ATOMIC_RELAXED, __HIP_MEMORY_SCOPE_AGENT); }
__device__ __forceinline__ unsigned xb_xcc_id() { return (unsigned)__builtin_amdgcn_s_getreg((3 << 11) | 20) & 0xFu; }
#define XB_SPIN(cond, bar) do { unsigned _sp = 0; while (cond) { __builtin_amdgcn_s_sleep(1); \
    if ((++_sp & 255u) == 0u) { if (xb_ld(&(bar)[XB_TMO])) break; if (_sp > XB_SPIN_CAP) { atomicAdd(&(bar)[XB_TMO], 1u); break; } } } } while (0)
struct XcdBarrier { unsigned* bar; unsigned x; volatile LAS unsigned* st; unsigned total; };
__device__ __forceinline__ XcdBarrier xcd_barrier_post(unsigned* bar, volatile LAS unsigned* st, unsigned total) {
    XcdBarrier b; b.bar = bar; b.x = xb_xcc_id(); b.st = st; b.total = total;
    if (threadIdx.x == 0) (void)xb_add(&bar[XB_XCNT(b.x)], 1u);
    return b;
}
__device__ __forceinline__ void xcd_barrier_complete(unsigned* bar, unsigned x, unsigned G, unsigned& nloc, unsigned& nx) {
    unsigned sum, cnt, mine, sp = 0u;
    for (;;) {
        sum = 0u; cnt = 0u; mine = 0u;
#pragma unroll
        for (unsigned j = 0; j < 16; ++j) { const unsigned c = xb_ld(&bar[XB_XCNT(j)]); sum += c; cnt += (c > 0u) ? 1u : 0u; mine = (j == x) ? c : mine; }
        if (sum == G) break;
        __builtin_amdgcn_s_sleep(1);
        if ((++sp & 255u) == 0u) { if (xb_ld(&bar[XB_TMO])) break; if (sp > XB_SPIN_CAP) { atomicAdd(&bar[XB_TMO], 1u); break; } }
    }
    nloc = mine > 0u ? mine : 1u; nx = cnt > 0u ? cnt : 1u;
}
__device__ __forceinline__ void xcd_barrier(const XcdBarrier& b) {
    asm volatile("s_waitcnt vmcnt(0)" ::: "memory");
    __syncthreads();
    if (threadIdx.x == 0) {
        unsigned* bar = b.bar;
        __builtin_amdgcn_s_waitcnt(0);
        unsigned nloc = b.st[0], nx = b.st[1];
        if (nloc == 0u) { xcd_barrier_complete(bar, b.x, b.total, nloc, nx); b.st[0] = nloc; b.st[1] = nx; }
        const unsigned old = xb_add(&bar[XB_XSUB(b.x)], 1u);
        const unsigned gen = old / nloc;
        if (old + 1u == (gen + 1u) * nloc) {
            __builtin_amdgcn_fence(__ATOMIC_RELEASE, "agent");
            asm volatile("s_waitcnt vmcnt(0)" ::: "memory");
            const unsigned og = xb_add(&bar[XB_TOP], 1u);
            const unsigned tg = og / nx;
            if (og + 1u == (tg + 1u) * nx) xb_add(&bar[XB_TOPGEN], 1u);
            else XB_SPIN(xb_ld(&bar[XB_TOPGEN]) == tg, bar);
            __builtin_amdgcn_fence(__ATOMIC_ACQUIRE, "agent");
            xb_add(&bar[XB_XGEN(b.x)], 1u);
            asm volatile("s_waitcnt vmcnt(0)" ::: "memory");
        } else {
            XB_SPIN(xb_ld(&bar[XB_XGEN(b.x)]) == gen, bar);
            __builtin_amdgcn_fence(__ATOMIC_ACQUIRE, "agent");
            asm volatile("s_waitcnt vmcnt(0)" ::: "memory");
        }
    }
    __syncthreads();
}

struct P {
    const float *x, *c, *ctx, *c_ctx, *w_mod, *b_mod, *norm1_g, *norm2_g, *w_in, *sgu_g, *sgu_w, *sgu_b, *conv_w, *conv_b,
                *rg_wa, *rg_ba, *rg_wi, *rg_bi, *rg_lam, *w_out, *w_router, *w1, *w3, *w2, *final_g;
    float* out; unsigned char* ws; int ph_lo, ph_hi;
};

struct SchedG1 { int G, c;
    __device__ __forceinline__ bool next(int i, pg8::Unit& u) const { const int L = i * G + c; if (L >= 528) return false;
        if (L < 512) { u.pm = L >> 3; u.pn = L & 7; } else { const int r = L - 512; u.pm = 64 + (r >> 1); u.pn = 4 + (r & 1); } u.pnB = u.pn; return true; } };
struct SchedG2 { int G, c;
    __device__ __forceinline__ bool next(int i, pg8::Unit& u) const { const int L = i * G + c; if (L >= 256) return false; u.pm = L >> 2; u.pn = L & 3; u.pnB = u.pn; return true; } };
struct SchedG3 { int G, c;
    __device__ __forceinline__ bool next(int i, pg8::Unit& u) const { const int L = i * G + c; if (L >= 2048) return false; const int e = L >> 7, loc = L & 127;
        u.pm = e * 8 + (loc & 7); u.pn = loc >> 3; u.pnB = e * 16 + u.pn; return true; } };
struct SchedG4 { int G, c;
    __device__ __forceinline__ bool next(int i, pg8::Unit& u) const { const int L = i * G + c; if (L >= 512) return false; const int e = L >> 5, loc = L & 31;
        u.pm = e * 8 + (loc & 7); u.pn = loc >> 3; u.pnB = e * 4 + u.pn; return true; } };

struct EpiG1 { static constexpr bool PAIRED = false, FUSED = false; bf16* UV; bf16* XC;
    __device__ __forceinline__ void st8(const pg8::Unit& u, int row, int col, f32x4 v0, f32x4 v1) const {
        const int grow = u.pm * 256 + row, gcol = u.pn * 256 + col;
        if (u.pm < 64) {
            if (gcol < 1024 || gcol >= 1536) { const f32x2p a = gelu2_((f32x2p){v0[0], v0[1]}), b = gelu2_((f32x2p){v0[2], v0[3]}), c = gelu2_((f32x2p){v1[0], v1[1]}), d = gelu2_((f32x2p){v1[2], v1[3]});
                v0 = (f32x4){a.x, a.y, b.x, b.y}; v1 = (f32x4){c.x, c.y, d.x, d.y}; }
            *(v4u*)(UV + (size_t)grow * DIN + gcol) = (v4u){pk2(v0[0], v0[1]), pk2(v0[2], v0[3]), pk2(v1[0], v1[1]), pk2(v1[2], v1[3])};
        } else *(v4u*)(XC + (size_t)(grow - M) * DLRU + (gcol - 1024)) = (v4u){pk2(v0[0], v0[1]), pk2(v0[2], v0[3]), pk2(v1[0], v1[1]), pk2(v1[2], v1[3])};
    } };
struct EpiG2 { static constexpr bool PAIRED = false, FUSED = false; const float* x; const float* MOD; float* X1;
    __device__ __forceinline__ void st8(const pg8::Unit& u, int row, int col, f32x4 v0, f32x4 v1) const {
        const int grow = u.pm * 256 + row, gcol = u.pn * 256 + col, b = grow >> 11;
        const f32x4* xp = (const f32x4*)(x + (size_t)grow * D + gcol); const f32x4* gp = (const f32x4*)(MOD + b * NMOD + 2 * D + gcol); f32x4* op = (f32x4*)(X1 + (size_t)grow * D + gcol);
        op[0] = xp[0] + gp[0] * v0; op[1] = xp[1] + gp[1] * v1;
    } };
#if MOE_FP8
typedef float f32x2v __attribute__((ext_vector_type(2)));
__device__ __forceinline__ f32x2v swiglu_scaled2(f32x2v g, f32x2v u) {
    constexpr float K1 = -1.4426950408889634f * WSCALE_INV, S2 = WSCALE * WSCALE;
    const f32x2v t = g * K1; f32x2v e; e.x = exp2f_(t.x); e.y = exp2f_(t.y);
    const f32x2v d = e * S2 + S2; f32x2v r; r.x = rcpf_(d.x); r.y = rcpf_(d.y);
    return (g * u) * r;
}
struct EpiG3 { static constexpr bool PAIRED = true, STAGED = true; unsigned char* HID;
    __device__ __forceinline__ pg8::v2u_t pack8(f32x4 g0, f32x4 g1, f32x4 u0, f32x4 u1) const {
        const f32x2v a = swiglu_scaled2((f32x2v){g0[0], g0[1]}, (f32x2v){u0[0], u0[1]}), b = swiglu_scaled2((f32x2v){g0[2], g0[3]}, (f32x2v){u0[2], u0[3]});
        const f32x2v c = swiglu_scaled2((f32x2v){g1[0], g1[1]}, (f32x2v){u1[0], u1[1]}), d = swiglu_scaled2((f32x2v){g1[2], g1[3]}, (f32x2v){u1[2], u1[3]});
        pg8::v2u_t w; w.x = pk4_fp8(a.x, a.y, b.x, b.y); w.y = pk4_fp8(c.x, c.y, d.x, d.y); return w; }
    __device__ __forceinline__ void store32(const pg8::Unit& u, int row, int colb, pg8::u32x4 lo, pg8::u32x4 hi) const {
        unsigned char* o = HID + (size_t)(u.pm * 256 + row) * DE + u.pn * 128 + colb; *(pg8::u32x4*)o = lo; *(pg8::u32x4*)(o + 16) = hi; }
    __device__ __forceinline__ void st2x8(const pg8::Unit& u, int row, int col, f32x4 g0, f32x4 g1, f32x4 u0, f32x4 u1) const {
        *(pg8::v2u_t*)(HID + (size_t)(u.pm * 256 + row) * DE + u.pn * 128 + col) = pack8(g0, g1, u0, u1); } };
struct EpiG4 { static constexpr bool PAIRED = false; const float* GATE; unsigned char* YE;
    __device__ __forceinline__ void st8(const pg8::Unit& u, int row, int col, f32x4 v0, f32x4 v1) const {
        const int grow = u.pm * 256 + row, gcol = u.pn * 256 + col; const float gt = GATE[grow];
        v2u w; w.x = pk4_fp8(v0[0] * gt, v0[1] * gt, v0[2] * gt, v0[3] * gt); w.y = pk4_fp8(v1[0] * gt, v1[1] * gt, v1[2] * gt, v1[3] * gt);
        *(v2u*)(YE + (size_t)grow * D + gcol) = w;
    } };
#else
struct EpiG3 { static constexpr bool PAIRED = true; bf16* HID;
    __device__ __forceinline__ void st2(const pg8::Unit& u, int row, int col, f32x4 g, f32x4 up) const {
        const int grow = u.pm * 256 + row, hc = u.pn * 128 + col;
        v2u w; w.x = pk2(siluf_(g[0]) * up[0], siluf_(g[1]) * up[1]); w.y = pk2(siluf_(g[2]) * up[2], siluf_(g[3]) * up[3]);
        *(v2u*)(HID + (size_t)grow * DE + hc) = w;
    } };
struct EpiG4 { static constexpr bool PAIRED = false; const float* GATE; bf16* YE;
    __device__ __forceinline__ void st(const pg8::Unit& u, int row, int col, f32x4 v) const {
        const int grow = u.pm * 256 + row, gcol = u.pn * 256 + col; const float gt = GATE[grow];
        v2u w; w.x = pk2(v[0] * gt, v[1] * gt); w.y = pk2(v[2] * gt, v[3] * gt); *(v2u*)(YE + (size_t)grow * D + gcol) = w;
    } };

#endif


struct EpiG2F { static constexpr bool PAIRED = false, FUSED = true;
    const float* x; const float* MOD; float* X1; const float* w_router; const float* norm2_g; const float* CB; float* XCH; unsigned* cnt; unsigned* tmo; unsigned char* HX8; float* AFF;
    __device__ __forceinline__ void fused(f32x4 (&acc)[2][2][4][2], const pg8::Unit& u, int wr, int wc, int fr, int fq, LAS unsigned char* lds, int wid, int lane) const {
        const int tid = wid * 64 + lane, b = u.pm >> 3, grow0 = u.pm * 256, gcol0 = u.pn * 256;
        LAS float* LQ = (LAS float*)lds;
        LAS float* RINV = (LAS float*)(lds + 81920);
        const float* MODb = MOD + b * NMOD;
        float gsc[2][8], shv[2][8], wrv[2][8];
#pragma unroll
        for (int bj = 0; bj < 2; ++bj)
#pragma unroll
            for (int j = 0; j < 8; ++j) { const int c = gcol0 + bj * 128 + wc * 32 + 8 * fq + j; gsc[bj][j] = norm2_g[c] * (1.f + MODb[4 * D + c]); shv[bj][j] = MODb[3 * D + c]; wrv[bj][j] = w_router[c * NE + fr]; }
#pragma unroll
        for (int ai = 0; ai < 2; ++ai)
#pragma unroll
            for (int m = 0; m < 4; ++m) { const int row = ai * 128 + wr * 64 + m * 16 + fr;
#pragma unroll
                for (int bj = 0; bj < 2; ++bj) { const int col = gcol0 + bj * 128 + wc * 32 + 8 * fq; const size_t o = (size_t)(grow0 + row) * D + col;
                    const f32x4 x0 = *(const f32x4*)(x + o), x1v = *(const f32x4*)(x + o + 4), g0 = *(const f32x4*)(MODb + 2 * D + col), g1 = *(const f32x4*)(MODb + 2 * D + col + 4);
                    acc[ai][bj][m][0] = x0 + g0 * acc[ai][bj][m][0]; acc[ai][bj][m][1] = x1v + g1 * acc[ai][bj][m][1];
                    *(f32x4*)(X1 + o) = acc[ai][bj][m][0]; *(f32x4*)(X1 + o + 4) = acc[ai][bj][m][1]; } }
        float tw[2][2][4];
#pragma unroll
        for (int bj = 0; bj < 2; ++bj)
#pragma unroll
            for (int n = 0; n < 2; ++n)
#pragma unroll
                for (int r = 0; r < 4; ++r) tw[bj][n][r] = wrv[bj][4 * n + r] * gsc[bj][4 * n + r];
#pragma unroll
        for (int ai = 0; ai < 2; ++ai)
#pragma unroll
            for (int m = 0; m < 4; ++m) { const int row = ai * 128 + wr * 64 + m * 16 + fr;
                f32x4 q = (f32x4){0.f, 0.f, 0.f, 0.f}; float s2 = 0.f;
#pragma unroll
                for (int bj = 0; bj < 2; ++bj)
#pragma unroll
                    for (int n = 0; n < 2; ++n)
#pragma unroll
                        for (int r = 0; r < 4; ++r) { const float v = acc[ai][bj][m][n][r]; q = __builtin_amdgcn_mfma_f32_16x16x4f32(tw[bj][n][r], v, q, 0, 0, 0); s2 += v * v; }
                s2 += __shfl_xor(s2, 16); s2 += __shfl_xor(s2, 32);
                LAS float* o = LQ + (row * 4 + wc) * 20;
                o[4 * fq + 0] = q[0]; o[4 * fq + 1] = q[1]; o[4 * fq + 2] = q[2]; o[4 * fq + 3] = q[3]; if (fq == 0) o[16] = s2; }
        __syncthreads();
        float* xo = XCH + (size_t)((u.pm * 4 + u.pn) * 256) * 20;
        for (int i = tid; i < 256 * 9; i += NTHREADS) { const int row = i / 9, q2 = 2 * (i - row * 9); const LAS float* s = LQ + row * 80 + q2;
            const float v0 = (s[0] + s[20]) + (s[40] + s[60]), v1 = q2 < 16 ? (s[1] + s[21]) + (s[41] + s[61]) : 0.f;
            __hip_atomic_store((unsigned long long*)(xo + row * 20 + q2), ((unsigned long long)__float_as_uint(v1) << 32) | __float_as_uint(v0), __ATOMIC_RELAXED, __HIP_MEMORY_SCOPE_AGENT); }
        asm volatile("s_waitcnt vmcnt(0)" ::: "memory");
        __syncthreads();
        if (tid == 0) {
            __hip_atomic_fetch_add(cnt + 16 * u.pm, 1u, __ATOMIC_RELAXED, __HIP_MEMORY_SCOPE_AGENT);
            XB_SPIN(xb_ld(cnt + 16 * u.pm) < 4u, tmo);
        }
        __syncthreads();
        const float* xp = XCH + (size_t)(u.pm * 4 * 256) * 20;
#define XLD(ptr) __hip_atomic_load((ptr), __ATOMIC_RELAXED, __HIP_MEMORY_SCOPE_AGENT)
        if (tid < 256) { const int row = tid; const float S2 = (XLD(xp + row * 20 + 16) + XLD(xp + 5120 + row * 20 + 16)) + (XLD(xp + 10240 + row * 20 + 16) + XLD(xp + 15360 + row * 20 + 16)); RINV[row] = rsqrtf(S2 * (1.f / D) + EPS); }
        else if (tid < 320) { const int row = 64 * u.pn + (tid - 256); const float* r0 = xp + row * 20;
            const float S2 = (XLD(r0 + 16) + XLD(r0 + 5120 + 16)) + (XLD(r0 + 10240 + 16) + XLD(r0 + 15360 + 16)), rinv = rsqrtf(S2 * (1.f / D) + EPS);
            float lg[16]; float mx = -3.0e38f;
#pragma unroll
            for (int e = 0; e < 16; ++e) { lg[e] = rinv * ((XLD(r0 + e) + XLD(r0 + 5120 + e)) + (XLD(r0 + 10240 + e) + XLD(r0 + 15360 + e))) + CB[b * NE + e]; mx = fmaxf(mx, lg[e]); }
            float den = 0.f;
#pragma unroll
            for (int e = 0; e < 16; ++e) { lg[e] = expf(lg[e] - mx); den += lg[e]; }
            const float rd = 1.f / den; const int t = (u.pm & 7) * 256 + row;
#pragma unroll
            for (int e = 0; e < 16; ++e) AFF[(size_t)(b * NE + e) * SEQ + t] = lg[e] * rd; }
#undef XLD
        __syncthreads();
#pragma unroll
        for (int ai = 0; ai < 2; ++ai)
#pragma unroll
            for (int m = 0; m < 4; ++m) { const int row = ai * 128 + wr * 64 + m * 16 + fr; const float rinv = RINV[row];
#pragma unroll
                for (int bj = 0; bj < 2; ++bj) { const f32x4 a0 = acc[ai][bj][m][0], a1 = acc[ai][bj][m][1]; v2u w;
                    w.x = pk4_fp8(a0[0] * rinv * gsc[bj][0] + shv[bj][0], a0[1] * rinv * gsc[bj][1] + shv[bj][1], a0[2] * rinv * gsc[bj][2] + shv[bj][2], a0[3] * rinv * gsc[bj][3] + shv[bj][3]);
                    w.y = pk4_fp8(a1[0] * rinv * gsc[bj][4] + shv[bj][4], a1[1] * rinv * gsc[bj][5] + shv[bj][5], a1[2] * rinv * gsc[bj][6] + shv[bj][6], a1[3] * rinv * gsc[bj][7] + shv[bj][7]);
                    *(v2u*)(HX8 + (size_t)(grow0 + row) * D + gcol0 + bj * 128 + wc * 32 + 8 * fq) = w; } }
    }
    __device__ __forceinline__ void st8(const pg8::Unit&, int, int, f32x4, f32x4) const {}
};

template <class Epi, class Sched>
__device__ __forceinline__ void naive_gemm_phase(LAS unsigned char* lds, const pg8::Gemm g, const Sched& S, const Epi& E) {
    LAS float* As = (LAS float*)lds; LAS float* Bs = (LAS float*)(lds + 4352);
    const int tid = threadIdx.x, ty = tid >> 5, tx = tid & 31, K = g.K, lr = tid >> 1, lh = 8 * (tid & 1);
    pg8::Unit u;
    for (int i = 0; S.next(i, u); ++i)
        for (int sub = 0; sub < 4; ++sub) {
            f32x4 ag[4], au[4];
#pragma unroll
            for (int r = 0; r < 4; ++r) { ag[r] = (f32x4){0.f, 0.f, 0.f, 0.f}; au[r] = (f32x4){0.f, 0.f, 0.f, 0.f}; }
            const bf16* arow = g.A + ((size_t)u.pm * 256 + sub * 64 + (lr & 63)) * K + lh;
            const bf16* brow = g.Bt + ((size_t)u.pnB * 256 + lr) * K + lh;
            for (int k0 = 0; k0 < K; k0 += 16) {
                const v4u bv = *(const v4u*)(brow + k0); v4u av = (v4u){0u, 0u, 0u, 0u}; if (tid < 128) av = *(const v4u*)(arow + k0);
                __syncthreads();
                Bs[(lh + 0) * 260 + lr] = bflo(bv.x); Bs[(lh + 1) * 260 + lr] = bfhi(bv.x); Bs[(lh + 2) * 260 + lr] = bflo(bv.y); Bs[(lh + 3) * 260 + lr] = bfhi(bv.y);
                Bs[(lh + 4) * 260 + lr] = bflo(bv.z); Bs[(lh + 5) * 260 + lr] = bfhi(bv.z); Bs[(lh + 6) * 260 + lr] = bflo(bv.w); Bs[(lh + 7) * 260 + lr] = bfhi(bv.w);
                if (tid < 128) {
                    As[(lh + 0) * 68 + lr] = bflo(av.x); As[(lh + 1) * 68 + lr] = bfhi(av.x); As[(lh + 2) * 68 + lr] = bflo(av.y); As[(lh + 3) * 68 + lr] = bfhi(av.y);
                    As[(lh + 4) * 68 + lr] = bflo(av.z); As[(lh + 5) * 68 + lr] = bfhi(av.z); As[(lh + 6) * 68 + lr] = bflo(av.w); As[(lh + 7) * 68 + lr] = bfhi(av.w); }
                __syncthreads();
#pragma unroll
                for (int kk = 0; kk < 16; ++kk) {
                    const f32x4 a = *(const LAS f32x4*)(As + kk * 68 + 4 * ty), b0 = *(const LAS f32x4*)(Bs + kk * 260 + 4 * tx), b1 = *(const LAS f32x4*)(Bs + kk * 260 + 128 + 4 * tx);
#pragma unroll
                    for (int r = 0; r < 4; ++r) { ag[r] += a[r] * b0; au[r] += a[r] * b1; }
                }
            }
#pragma unroll
            for (int r = 0; r < 4; ++r) { const int row = sub * 64 + 4 * ty + r;
                if constexpr (Epi::PAIRED) E.st2(u, row, 4 * tx, ag[r], au[r]);
                else { E.st(u, row, 4 * tx, ag[r]); E.st(u, row, 128 + 4 * tx, au[r]); } }
        }
    __syncthreads();
}
template <class Epi, class Sched>
__device__ __forceinline__ void gemm_any(LAS unsigned char* lds, const pg8::Gemm g, const Sched& S, const Epi& E) {
#if USE_PG8
    pg8::gemm_phase<Epi, Sched, true, true>(lds, g, S, E);
#else
    naive_gemm_phase<Epi, Sched>(lds, g, S, E);
#endif
}

__device__ __forceinline__ void transpose_item(const float* W, int N, int K, bf16* WT, int k0, int n0, size_t drow0, LAS unsigned char* scr, int lane) {
    const int lc = lane & 15, lr = lane >> 4;
    f32x4 v[16];
#pragma unroll
    for (int i = 0; i < 16; ++i) v[i] = *(const f32x4*)(W + (size_t)(k0 + 4 * i + lr) * N + n0 + 4 * lc);
#pragma unroll
    for (int i = 0; i < 16; ++i) { const int k = 4 * i + lr;
#pragma unroll
        for (int j = 0; j < 4; ++j) *(LAS bf16*)(scr + (4 * lc + j) * 136 + k * 2) = (bf16)f2bf(v[i][j]); }
    LDS_WAIT(); asm volatile("" ::: "memory");
    const int c = lane & 7;
#pragma unroll
    for (int j = 0; j < 8; ++j) { const int n = (lane >> 3) + 8 * j;
        const v2u lo = *(const LAS v2u*)(scr + n * 136 + c * 16), hi = *(const LAS v2u*)(scr + n * 136 + c * 16 + 8);
        *(v4u*)(WT + (drow0 + n) * (size_t)K + k0 + 8 * c) = (v4u){lo.x, lo.y, hi.x, hi.y}; }
    LDS_WAIT(); asm volatile("" ::: "memory");
}
__device__ __forceinline__ void conv_load(const float* src, int N, int lane, f32x4 (&v)[16]);
struct P;
__device__ __forceinline__ void conv_desc(const P& p, int it, const float*& src, unsigned char*& dst, int& N, int& K);
__device__ __forceinline__ void conv_store(const f32x4 (&v)[16], unsigned char* dst, int K, LAS unsigned char* scr, int lane);
__device__ __forceinline__ void transpose_item_f8(const float* W, int N, int K, unsigned char* WT, int k0, int n0, size_t drow0, LAS unsigned char* scr, int lane) {
    f32x4 v[16]; conv_load(W + (size_t)k0 * N + n0, N, lane, v); conv_store(v, WT + drow0 * (size_t)K + k0, K, scr, lane);
}
constexpr int CONV_ITEMS = 16 * 32 + 16 * 16 + 3 * 512 * NE, CONV_CUT = CONV_ITEMS - 6144;
__device__ __forceinline__ void convert_items(const P& p, LAS unsigned char* lds, int lane, int wave, int first, int last, int gw, int NGW) {
    LAS unsigned char* scr = lds + wave * 16384;
    constexpr int I_IN = 16 * 32, I_OUT = 16 * 16, I_E = 512 * NE;
    for (int it = first + gw; it < last; it += NGW) {
        int r = it;
        if (r < I_IN) { const int kb = r >> 5, nb = r & 31; transpose_item(p.w_in, DIN, D, (bf16*)(p.ws + WS_WIN), 64 * kb, 64 * nb, (size_t)(64 * nb), scr, lane); continue; } r -= I_IN;
        if (r < I_OUT) { const int kb = r >> 4, nb = r & 15; transpose_item(p.w_out, D, D, (bf16*)(p.ws + WS_WOUT), 64 * kb, 64 * nb, (size_t)(64 * nb), scr, lane); continue; } r -= I_OUT;
#if MOE_FP8
        { const float* src_; unsigned char* dst_; int N_, K_; f32x4 v_[16]; conv_desc(p, it, src_, dst_, N_, K_); conv_load(src_, N_, lane, v_); conv_store(v_, dst_, K_, scr, lane); }
#else
        if (r < 2 * I_E) { const int which = r >= I_E; if (which) r -= I_E; const int e = r >> 9, q = r & 511, kb = q >> 5, nb = q & 31, n0 = 64 * nb;
            const float* W = (which ? p.w3 : p.w1) + (size_t)e * D * DE;
#if MOE_FP8
            transpose_item_f8(W, DE, D, p.ws + WS_WG, 64 * kb, n0, (size_t)e * 4096 + (size_t)(n0 >> 7) * 256 + (n0 & 127) + (which ? 128 : 0), scr, lane); continue; } r -= 2 * I_E;
#else
            transpose_item(W, DE, D, (bf16*)(p.ws + WS_WG), 64 * kb, n0, (size_t)e * 4096 + (size_t)(n0 >> 7) * 256 + (n0 & 127) + (which ? 128 : 0), scr, lane); continue; } r -= 2 * I_E;
#endif
        { const int e = r >> 9, q = r & 511, kb = q >> 4, nb = q & 15, n0 = 64 * nb;
#if MOE_FP8
            transpose_item_f8(p.w2 + (size_t)e * DE * D, D, DE, p.ws + WS_W2, 64 * kb, n0, (size_t)e * 1024 + n0, scr, lane); }
#else
            transpose_item(p.w2 + (size_t)e * DE * D, D, DE, (bf16*)(p.ws + WS_W2), 64 * kb, n0, (size_t)e * 1024 + n0, scr, lane); }
#endif
#endif
    }
}

#if MOE_FP8
constexpr int CONV_HEAD = 16 * 32 + 16 * 16;
__device__ __forceinline__ void conv_desc(const P& p, int it, const float*& src, unsigned char*& dst, int& N, int& K) {
    constexpr int I_E = 512 * NE; const int r0 = it - CONV_HEAD;
    const bool isw2 = r0 >= 2 * I_E, which = (!isw2) && r0 >= I_E; const int r = isw2 ? r0 - 2 * I_E : (which ? r0 - I_E : r0);
    const int e = r >> 9, q = r & 511, kb = isw2 ? (q >> 5) : (q >> 6), nb = isw2 ? (q & 31) : (q & 63), n0 = 32 * nb;
    N = isw2 ? D : DE; K = isw2 ? DE : D;
    const float* base = isw2 ? p.w2 : (which ? p.w3 : p.w1);
    src = base + (size_t)e * D * DE + (size_t)(128 * kb) * N + n0;
    const size_t drow = isw2 ? ((size_t)e * 1024 + n0) : ((size_t)e * 4096 + (size_t)(n0 >> 7) * 256 + (n0 & 127) + (which ? 128 : 0));
    dst = p.ws + (isw2 ? WS_W2 : WS_WG) + drow * (size_t)K + 128 * kb;
}
__device__ __forceinline__ void conv_load(const float* src, int N, int lane, f32x4 (&v)[16]) {
    const int lc = lane & 7, lr = lane >> 3;
#pragma unroll
    for (int i = 0; i < 16; ++i) v[i] = __builtin_nontemporal_load((const f32x4*)(src + (size_t)(16 * lr + i) * N + 4 * lc));
}
__device__ __forceinline__ void conv_store(const f32x4 (&v)[16], unsigned char* dst, int K, LAS unsigned char* scr, int lane) {
    const int lc = lane & 7, lr = lane >> 3; (void)scr;
#pragma unroll
    for (int j = 0; j < 4; ++j) { v4u o;
        o.x = pk4_fp8(v[0][j] * WSCALE, v[1][j] * WSCALE, v[2][j] * WSCALE, v[3][j] * WSCALE);
        o.y = pk4_fp8(v[4][j] * WSCALE, v[5][j] * WSCALE, v[6][j] * WSCALE, v[7][j] * WSCALE);
        o.z = pk4_fp8(v[8][j] * WSCALE, v[9][j] * WSCALE, v[10][j] * WSCALE, v[11][j] * WSCALE);
        o.w = pk4_fp8(v[12][j] * WSCALE, v[13][j] * WSCALE, v[14][j] * WSCALE, v[15][j] * WSCALE);
        *(v4u*)(dst + (size_t)(4 * lc + j) * K + 16 * lr) = o; }
}
__device__ __forceinline__ void convert_pipelined(const P& p, LAS unsigned char* lds, int lane, int wave, int first, int last, int gw, int NGW) {
    LAS unsigned char* scr = lds + wave * 16384;
    f32x4 va[16], vb[16], vc[16]; const float* s0; unsigned char* da; unsigned char* db; unsigned char* dc; int N0, Ka, Kb, Kc;
    int it = first + gw; if (it >= last) return;
    const int itl = it + ((last - 1 - it) / NGW) * NGW;
    conv_desc(p, it, s0, da, N0, Ka); conv_load(s0, N0, lane, va);
    { const int i1 = min(it + NGW, itl); conv_desc(p, i1, s0, db, N0, Kb); conv_load(s0, N0, lane, vb); }
    for (; it <= itl; it += 3 * NGW) {
        { const int i2 = min(it + 2 * NGW, itl); conv_desc(p, i2, s0, dc, N0, Kc); conv_load(s0, N0, lane, vc); }
        conv_store(va, da, Ka, scr, lane);
        { const int i3 = min(it + 3 * NGW, itl); conv_desc(p, i3, s0, da, N0, Ka); conv_load(s0, N0, lane, va); }
        conv_store(vb, db, Kb, scr, lane);
        { const int i4 = min(it + 4 * NGW, itl); conv_desc(p, i4, s0, db, N0, Kb); conv_load(s0, N0, lane, vb); }
        conv_store(vc, dc, Kc, scr, lane);
    }
}
#endif
__device__ __forceinline__ void p0_small_copies(const P& p, int tid, int vcu, int G) {
    bf16* GWT = (bf16*)(p.ws + WS_GWT); bf16* SWB = (bf16*)(p.ws + WS_SWB); const int gt = vcu * NTHREADS + tid, NT = G * NTHREADS;
    for (int o = gt; o < 131072; o += NT) { const int i = o & 63, j = (o >> 6) & 63, h = (o >> 12) & 7, g = (o >> 15) & 1, d = o >> 16;
        GWT[o] = (bf16)f2bf((g ? p.rg_wi : p.rg_wa)[(size_t)((d * 8 + h) * 64 + i) * 64 + j]); }
    for (int o = gt; o < 65536; o += NT) SWB[o] = (bf16)f2bf(p.sgu_w[o]);
}
__device__ __forceinline__ void phase_p0(const P& p, LAS unsigned char* lds, int tid, int lane, int wave, int vcu, int G, int conv_last, bool small = true) {
    float* MOD = (float*)(p.ws + WS_MOD);
    {
        LAS float* sc = (LAS float*)lds; LAS float* part = (LAS float*)(lds + 36864);
        if (vcu < 192) {
            float cv[18];
#pragma unroll
            for (int i = 0; i < 18; ++i) { const int e = tid + i * NTHREADS, j = e >> 10, k = e & 1023; cv[i] = j < 8 ? p.c[j * D + k] : p.c_ctx[k]; }
#pragma unroll
            for (int i = 0; i < 18; ++i) sc[tid + i * NTHREADS] = siluf_(cv[i]);
        }
        __syncthreads();
        for (int t = vcu; t < 192; t += G) {
            const int col = lane & 31, kh = lane >> 5, n = t * 32 + col, kbase = wave * 128 + kh * 64; float acc[9];
#pragma unroll
            for (int j = 0; j < 9; ++j) acc[j] = 0.f;
            for (int k0 = 0; k0 < 64; k0 += 16) { float w[16];
#pragma unroll
                for (int i = 0; i < 16; ++i) w[i] = p.w_mod[(size_t)(kbase + k0 + i) * NMOD + n];
#pragma unroll
                for (int i = 0; i < 16; ++i)
#pragma unroll
                    for (int j = 0; j < 9; ++j) acc[j] += sc[j * D + kbase + k0 + i] * w[i]; }
#pragma unroll
            for (int j = 0; j < 9; ++j) { acc[j] += __shfl_xor(acc[j], 32); if (lane < 32) part[(wave * 9 + j) * 32 + lane] = acc[j]; }
            __syncthreads();
            for (int i = tid; i < 9 * 32; i += NTHREADS) { const int j = i >> 5, l = i & 31; float s2 = p.b_mod[t * 32 + l];
#pragma unroll
                for (int w = 0; w < 8; ++w) s2 += part[(w * 9 + j) * 32 + l];
                MOD[j * NMOD + t * 32 + l] = s2; }
            __syncthreads();
        }
    }
    convert_items(p, lds, lane, wave, 0, conv_last, vcu * NWAVES + wave, G * NWAVES);
    if (small) p0_small_copies(p, tid, vcu, G);
}

__device__ __forceinline__ void phase_p1(const P& p, int lane, int wave, int vcu, int G) {
    const float* MOD = (const float*)(p.ws + WS_MOD); bf16* HX = (bf16*)(p.ws + WS_HX);
    const int gw = vcu * NWAVES + wave, NGW = G * NWAVES;
    for (int i = gw; i < BATCH * NE; i += NGW) { const int b = i >> 4, e = i & 15; float a = 0.f;
        for (int k = lane; k < D; k += 64) a += MOD[b * NMOD + 3 * D + k] * p.w_router[k * NE + e];
        a = wave_sum(a); if (lane == 0) ((float*)(p.ws + WS_CB))[i] = a; }
    f32x4 nx[4];
    { const int m = gw; if (m < MT) { const f32x4* xr = (const f32x4*)(m < M ? p.x + (size_t)m * D : p.ctx + (size_t)(m - M) * D) + lane;
#pragma unroll
        for (int jj = 0; jj < 4; ++jj) nx[jj] = xr[64 * jj]; } }
    for (int m = gw; m < MT; m += NGW) {
        const int j = m < M ? (m >> 11) : 8;
        f32x4 v[4]; float s = 0.f;
#pragma unroll
        for (int jj = 0; jj < 4; ++jj) { v[jj] = nx[jj]; s += (v[jj].x * v[jj].x + v[jj].y * v[jj].y) + (v[jj].z * v[jj].z + v[jj].w * v[jj].w); }
        { const int m2 = m + NGW; if (m2 < MT) { const f32x4* xr = (const f32x4*)(m2 < M ? p.x + (size_t)m2 * D : p.ctx + (size_t)(m2 - M) * D) + lane;
#pragma unroll
            for (int jj = 0; jj < 4; ++jj) nx[jj] = xr[64 * jj]; } }
        const float rinv = rsqrtf(wave_sum(s) * (1.f / D) + EPS);
        v2u* o = (v2u*)(HX + (size_t)m * D) + lane;
#pragma unroll
        for (int jj = 0; jj < 4; ++jj) { const int k = 4 * (lane + 64 * jj);
            const f32x4 g = *(const f32x4*)(p.norm1_g + k), sh = *(const f32x4*)(MOD + j * NMOD + k), sc = *(const f32x4*)(MOD + j * NMOD + D + k);
            const f32x4 h = v[jj] * rinv * g * (sc + 1.f) + sh; v2u w; w.x = pk2(h.x, h.y); w.y = pk2(h.z, h.w); o[64 * jj] = w; }
    }
}

__device__ __forceinline__ void phase_lru1(const P& p, LAS unsigned char* lds, int tid, int vcu, int G) {
    LAS float* xt = (LAS float*)lds;
    LAS float* cx = (LAS float*)(lds + 17152);
    LAS float* af = (LAS float*)(lds + 33536);
    LAS float* df = (LAS float*)(lds + 49920);
    LAS float* ab = (LAS float*)(lds + 66304);
    LAS float* db = (LAS float*)(lds + 82688);
    const bf16* UV = (const bf16*)(p.ws + WS_UV); const bf16* XC = (const bf16*)(p.ws + WS_XC);
    bf16* HS = (bf16*)(p.ws + WS_HS); bf16* PF = (bf16*)(p.ws + WS_PF); bf16* PB = (bf16*)(p.ws + WS_PB); float* SUM = (float*)(p.ws + WS_SUM);
    for (int T = vcu; T < BATCH * NSEG * 8; T += G) {
        const int b = T / (NSEG * 8), rem = T % (NSEG * 8), seg = rem >> 3, h = rem & 7;
        for (int i = tid; i < 67 * 64; i += NTHREADS) { const int r = (i >> 6) - 1, ch = i & 63; float v = 0.f;
            if (seg < 4) { const int pos = seg * 64 + r; if (pos >= 0 && pos < CTXL) v = bf2f(XC[(size_t)(b * CTXL + pos) * DLRU + h * 64 + ch]); }
            else { if (r >= 0 && r < 64) v = bf2f(UV[(size_t)(b * SEQ + (seg - 4) * 64 + r) * DIN + 1024 + h * 64 + ch]); }
            xt[i] = v; }
        __syncthreads();
        for (int i = tid; i < 4096; i += NTHREADS) { const int r = i >> 6, ch = i & 63, cch = h * 64 + ch; float v = p.conv_b[cch];
#pragma unroll
            for (int j = 0; j < 4; ++j) v += p.conv_w[j * DLRU + cch] * xt[(r + j) * 64 + ch];
            cx[i] = v; }
        __syncthreads();
        { const int jj = tid & 63, r0 = tid >> 6, cch = h * 64 + jj;
#pragma unroll
          for (int d = 0; d < 2; ++d) {
            float aa[8], ai[8];
#pragma unroll
            for (int q = 0; q < 8; ++q) { aa[q] = 0.f; ai[q] = 0.f; }
            const float* wa = p.rg_wa + (size_t)((d * 8 + h) * 64) * 64 + jj; const float* wi = p.rg_wi + (size_t)((d * 8 + h) * 64) * 64 + jj;
#pragma unroll 2
            for (int i = 0; i < 64; ++i) { const float wav = wa[i * 64], wiv = wi[i * 64];
#pragma unroll
                for (int q = 0; q < 8; ++q) { const float cv = cx[(r0 + 8 * q) * 64 + i]; aa[q] += cv * wav; ai[q] += cv * wiv; } }
            const float ba = p.rg_ba[d * DLRU + cch], bi = p.rg_bi[d * DLRU + cch], c8 = -8.f * log1pf(expf(-p.rg_lam[d * DLRU + cch]));
            LAS float* ao = d ? ab : af; LAS float* dout = d ? db : df;
#pragma unroll
            for (int q = 0; q < 8; ++q) { const int r = r0 + 8 * q; const float rg = sigmoidf_(aa[q] + ba), ig = sigmoidf_(ai[q] + bi), la = c8 * rg;
                ao[r * 64 + jj] = expf(la); dout[r * 64 + jj] = sqrtf(-expm1f(2.f * la)) * ig * cx[r * 64 + jj]; }
          } }
        __syncthreads();
        if (tid < 128) { const int d = tid >> 6, ch = tid & 63; float hh = 0.f, pp = 1.f;
            if (d == 0) {
#pragma unroll 4
                for (int r = 0; r < 64; ++r) { const float a = af[r * 64 + ch]; hh = a * hh + df[r * 64 + ch]; pp *= a; df[r * 64 + ch] = hh; af[r * 64 + ch] = pp; } }
            else {
#pragma unroll 4
                for (int r = 63; r >= 0; --r) { const float a = ab[r * 64 + ch]; hh = a * hh + db[r * 64 + ch]; pp *= a; db[r * 64 + ch] = hh; ab[r * 64 + ch] = pp; } }
            float* s = SUM + ((size_t)((b * NSEG + seg) * 2 + d) * DLRU + h * 64 + ch) * 2; s[0] = pp; s[1] = hh; }
        __syncthreads();
        if (seg >= 4) for (int i = tid; i < 4096; i += NTHREADS) { const int r = i >> 6, ch = i & 63; const size_t o = (size_t)(b * SEQ + (seg - 4) * 64 + r) * DLRU + h * 64 + ch;
            HS[o] = (bf16)f2bf(df[i] + db[i]); PF[o] = (bf16)f2bf(af[i]); PB[o] = (bf16)f2bf(ab[i]); }
        __syncthreads();
    }
}

__device__ __forceinline__ void phase_sgu(const P& p, LAS unsigned char* lds, int tid, int vcu, int G) {
    LAS float* vn = (LAS float*)lds;
    LAS float* wsl = (LAS float*)(lds + 65536);
    const bf16* UV = (const bf16*)(p.ws + WS_UV); bf16* A2 = (bf16*)(p.ws + WS_A2);
    for (int T = vcu; T < 512; T += G) {
        const int b = T >> 6, n = (T >> 2) & 15, h = T & 3; const size_t t0 = (size_t)b * SEQ + n * 128;
        for (int i = tid; i < 16384; i += NTHREADS) { const int q = i >> 7, c = i & 127; vn[i] = bf2f(UV[(t0 + q) * DIN + 512 + h * 128 + c]); wsl[i] = p.sgu_w[h * 16384 + i]; }
        __syncthreads();
        { const int q = tid >> 2, part = tid & 3; float s = 0.f;
          for (int c = part * 32; c < part * 32 + 32; ++c) { const float v = vn[q * 128 + c]; s += v * v; }
          s += __shfl_xor(s, 1); s += __shfl_xor(s, 2);
          const float rinv = rsqrtf(s * (1.f / 128.f) + EPS);
          for (int c = part * 32; c < part * 32 + 32; ++c) vn[q * 128 + c] *= rinv * p.sgu_g[h * 128 + c]; }
        __syncthreads();
        { const int c = tid & 127, p0 = tid >> 7; float acc[32];
#pragma unroll
          for (int i = 0; i < 32; ++i) acc[i] = 0.f;
          for (int q = 0; q < 128; ++q) { const float vq = vn[q * 128 + c];
#pragma unroll
              for (int i = 0; i < 32; ++i) acc[i] += wsl[(p0 + 4 * i) * 128 + q] * vq; }
#pragma unroll
          for (int i = 0; i < 32; ++i) { const int pp = p0 + 4 * i; const float s = acc[i] + p.sgu_b[h * 128 + pp];
              const float uu = bf2f(UV[(t0 + pp) * DIN + h * 128 + c]); A2[(t0 + pp) * D + h * 128 + c] = (bf16)f2bf(uu * s); } }
        __syncthreads();
    }
}


__device__ __forceinline__ void phase_lru1_mfma(const P& p, LAS unsigned char* lds, int tid, int lane, int wave, int vcu, int G) {
    LAS float* xt = (LAS float*)lds;
    LAS float* cxf = (LAS float*)(lds + 17152);
    LAS unsigned char* cxb = lds + 33536;
    LAS float* AD = (LAS float*)(lds + 42752);
    LAS float* SS = (LAS float*)(lds + 108288);
    const bf16* UV = (const bf16*)(p.ws + WS_UV); const bf16* XC = (const bf16*)(p.ws + WS_XC); const bf16* GWT = (const bf16*)(p.ws + WS_GWT);
    bf16* HS = (bf16*)(p.ws + WS_HS); bf16* PF = (bf16*)(p.ws + WS_PF); bf16* PB = (bf16*)(p.ws + WS_PB); float* SUM = (float*)(p.ws + WS_SUM);
    const int fr = lane & 15, fq = lane >> 4;
    const int wd = wave >> 2, jt = wave & 3, wj = 16 * jt + fr, cch_c = tid & 63;
    int hcur = -1; bf16x8 bfr[2][2]; float ba = 0.f, bi = 0.f, c8 = 0.f, cw0 = 0.f, cw1 = 0.f, cw2 = 0.f, cw3 = 0.f, cbias = 0.f;
    auto load_piece = [&](int T, int i) -> v4u { const int b = T / (NSEG * 8), rem = T % (NSEG * 8), seg = rem >> 3, h = rem & 7, r = (i >> 3) - 1, c0 = (i & 7) * 8; v4u w = (v4u){0u, 0u, 0u, 0u};
        if (seg < 4) { const int pos = seg * 64 + r; if (pos >= 0 && pos < CTXL) w = *(const v4u*)(XC + (size_t)(b * CTXL + pos) * DLRU + h * 64 + c0); }
        else { if (r >= 0 && r < 64) w = *(const v4u*)(UV + (size_t)(b * SEQ + (seg - 4) * 64 + r) * DIN + 1024 + h * 64 + c0); }
        return w; };
    v4u pre0 = (v4u){0u, 0u, 0u, 0u}, pre1 = (v4u){0u, 0u, 0u, 0u};
    if (vcu < BATCH * NSEG * 8) { pre0 = load_piece(vcu, tid); if (tid < 24) pre1 = load_piece(vcu, tid + 512); }
    for (int T = vcu; T < BATCH * NSEG * 8; T += G) {
        const int b = T / (NSEG * 8), rem = T % (NSEG * 8), seg = rem >> 3, h = rem & 7;
        { LAS float* o = xt + (tid >> 3) * 64 + (tid & 7) * 8;
          *(LAS f32x4*)o = (f32x4){bflo(pre0.x), bfhi(pre0.x), bflo(pre0.y), bfhi(pre0.y)}; *(LAS f32x4*)(o + 4) = (f32x4){bflo(pre0.z), bfhi(pre0.z), bflo(pre0.w), bfhi(pre0.w)};
          if (tid < 24) { LAS float* o1 = xt + ((tid + 512) >> 3) * 64 + (tid & 7) * 8;
              *(LAS f32x4*)o1 = (f32x4){bflo(pre1.x), bfhi(pre1.x), bflo(pre1.y), bfhi(pre1.y)}; *(LAS f32x4*)(o1 + 4) = (f32x4){bflo(pre1.z), bfhi(pre1.z), bflo(pre1.w), bfhi(pre1.w)}; } }
        if (h != hcur) { hcur = h;
#pragma unroll
            for (int g = 0; g < 2; ++g)
#pragma unroll
                for (int ks = 0; ks < 2; ++ks) bfr[g][ks] = *(const bf16x8*)(GWT + (size_t)((((wd * 2 + g) * 8 + h) * 64 + wj) * 64 + 32 * ks + 8 * fq));
            ba = p.rg_ba[wd * DLRU + h * 64 + wj]; bi = p.rg_bi[wd * DLRU + h * 64 + wj]; c8 = -8.f * log1pf(expf(-p.rg_lam[wd * DLRU + h * 64 + wj]));
            cw0 = p.conv_w[h * 64 + cch_c]; cw1 = p.conv_w[DLRU + h * 64 + cch_c]; cw2 = p.conv_w[2 * DLRU + h * 64 + cch_c]; cw3 = p.conv_w[3 * DLRU + h * 64 + cch_c]; cbias = p.conv_b[h * 64 + cch_c]; }
        __syncthreads();
        if (T + G < BATCH * NSEG * 8) { pre0 = load_piece(T + G, tid); if (tid < 24) pre1 = load_piece(T + G, tid + 512); }
        for (int i = tid; i < 4096; i += NTHREADS) { const int r = i >> 6, ch = i & 63;
            const float v = cbias + cw0 * xt[r * 64 + ch] + cw1 * xt[(r + 1) * 64 + ch] + cw2 * xt[(r + 2) * 64 + ch] + cw3 * xt[(r + 3) * 64 + ch];
            cxf[i] = v; *(LAS bf16*)(cxb + r * 144 + ch * 2) = (bf16)f2bf(v); }
        __syncthreads();
        { const int d = wd, j = wj;
          LAS float* Ad = AD + d * 8192; LAS float* Dd = Ad + 4096;
#pragma unroll
          for (int pt = 0; pt < 4; ++pt) {
              const bf16x8 a0 = *(const LAS bf16x8*)(cxb + (16 * pt + fr) * 144 + 16 * fq), a1 = *(const LAS bf16x8*)(cxb + (16 * pt + fr) * 144 + 64 + 16 * fq);
              f32x4 ca = (f32x4){0.f, 0.f, 0.f, 0.f}, ci = (f32x4){0.f, 0.f, 0.f, 0.f};
              ca = __builtin_amdgcn_mfma_f32_16x16x32_bf16(a0, bfr[0][0], ca, 0, 0, 0); ca = __builtin_amdgcn_mfma_f32_16x16x32_bf16(a1, bfr[0][1], ca, 0, 0, 0);
              ci = __builtin_amdgcn_mfma_f32_16x16x32_bf16(a0, bfr[1][0], ci, 0, 0, 0); ci = __builtin_amdgcn_mfma_f32_16x16x32_bf16(a1, bfr[1][1], ci, 0, 0, 0);
#pragma unroll
              for (int r = 0; r < 4; ++r) { const int pos = 16 * pt + 4 * fq + r; const float rg = sigmoidf_(ca[r] + ba), ig = sigmoidf_(ci[r] + bi), la = c8 * rg;
                  float av, sv; decay_pair(la, av, sv); Ad[pos * 64 + j] = av; Dd[pos * 64 + j] = sv * ig * cxf[pos * 64 + j]; }
          } }
        __syncthreads();
        { const int sub = tid >> 7, d = (tid >> 6) & 1, ch = tid & 63;
          LAS float* Ad = AD + d * 8192; LAS float* Dd = Ad + 4096;
          float hl[16], pc[16]; float hh = 0.f, pp = 1.f;
#pragma unroll
          for (int t = 0; t < 16; ++t) { const int pos = d ? 16 * sub + 15 - t : 16 * sub + t; const float a = Ad[pos * 64 + ch]; hh = a * hh + Dd[pos * 64 + ch]; pp *= a; hl[t] = hh; pc[t] = pp; }
          SS[((sub * 2 + d) * 64 + ch) * 2] = pp; SS[((sub * 2 + d) * 64 + ch) * 2 + 1] = hh;
          __syncthreads();
          float cin = 0.f, cp = 1.f;
          if (d == 0) { for (int s2 = 0; s2 < sub; ++s2) { const float A = SS[((s2 * 2) * 64 + ch) * 2], B = SS[((s2 * 2) * 64 + ch) * 2 + 1]; cin = A * cin + B; cp *= A; } }
          else { for (int s2 = 3; s2 > sub; --s2) { const float A = SS[((s2 * 2 + 1) * 64 + ch) * 2], B = SS[((s2 * 2 + 1) * 64 + ch) * 2 + 1]; cin = A * cin + B; cp *= A; } }
#pragma unroll
          for (int t = 0; t < 16; ++t) { const int pos = d ? 16 * sub + 15 - t : 16 * sub + t; Dd[pos * 64 + ch] = hl[t] + pc[t] * cin; Ad[pos * 64 + ch] = pc[t] * cp; }
          if ((d == 0 && sub == 3) || (d == 1 && sub == 0)) { float* so = SUM + ((size_t)((b * NSEG + seg) * 2 + d) * DLRU + h * 64 + ch) * 2; so[0] = pc[15] * cp; so[1] = hl[15] + pc[15] * cin; }
        }
        __syncthreads();
        if (seg >= 4) { const int pos = tid >> 3, c0 = (tid & 7) * 8; const LAS float* q0 = AD + pos * 64 + c0;
            const f32x4 a0l = *(const LAS f32x4*)(q0), a0h = *(const LAS f32x4*)(q0 + 4), d0l = *(const LAS f32x4*)(q0 + 4096), d0h = *(const LAS f32x4*)(q0 + 4100);
            const f32x4 a1l = *(const LAS f32x4*)(q0 + 8192), a1h = *(const LAS f32x4*)(q0 + 8196), d1l = *(const LAS f32x4*)(q0 + 12288), d1h = *(const LAS f32x4*)(q0 + 12292);
            const f32x4 sl = d0l + d1l, sh = d0h + d1h; const size_t o = (size_t)(b * SEQ + (seg - 4) * 64 + pos) * DLRU + h * 64 + c0;
            *(v4u*)(HS + o) = (v4u){pk2(sl.x, sl.y), pk2(sl.z, sl.w), pk2(sh.x, sh.y), pk2(sh.z, sh.w)};
            *(v4u*)(PF + o) = (v4u){pk2(a0l.x, a0l.y), pk2(a0l.z, a0l.w), pk2(a0h.x, a0h.y), pk2(a0h.z, a0h.w)};
            *(v4u*)(PB + o) = (v4u){pk2(a1l.x, a1l.y), pk2(a1l.z, a1l.w), pk2(a1h.x, a1h.y), pk2(a1h.z, a1h.w)}; }
        __syncthreads();
    }
}


template <int WD>
__device__ __forceinline__ void lru_scan(const float (&ga)[4][4], const float (&gb)[4][4], LAS float* EX, int lane, int fr, int fq, int wj, float& Pin, float& Hin) {
    const int cq = WD ? 3 - fq : fq, l16 = (WD ? lane + 16 : lane - 16) & 63, l32 = (WD ? lane + 32 : lane - 32) & 63, llast = WD ? fr : fr + 48;
    LAS float* Pd = EX + WD * 8192; LAS float* Hd = Pd + 4096;
#pragma unroll
    for (int ptc = 0; ptc < 4; ++ptc) { constexpr int dummy = 0; (void)dummy; const int pt = WD ? 3 - ptc : ptc;
        float pr[4], hr[4]; float hh = 0.f, pp = 1.f;
#pragma unroll
        for (int rc = 0; rc < 4; ++rc) { const int r = WD ? 3 - rc : rc; hh = ga[pt][r] * hh + gb[pt][r]; pp *= ga[pt][r]; pr[r] = pp; hr[r] = hh; }
        float A = pp, B = hh;
        { const float tA = __shfl(A, l16), tB = __shfl(B, l16); if (cq >= 1) { B = A * tB + B; A = tA * A; } }
        { const float tA = __shfl(A, l32), tB = __shfl(B, l32); if (cq >= 2) { B = A * tB + B; A = tA * A; } }
        float eA = __shfl(A, l16), eB = __shfl(B, l16); if (cq == 0) { eA = 1.f; eB = 0.f; }
        const float tAt = __shfl(A, llast), tBt = __shfl(B, llast);
        const float Hc = eA * Hin + eB, Pc = Pin * eA;
#pragma unroll
        for (int r = 0; r < 4; ++r) { const int pos = 16 * pt + 4 * fq + r; Hd[pos * 64 + wj] = pr[r] * Hc + hr[r]; Pd[pos * 64 + wj] = Pc * pr[r]; }
        Hin = tAt * Hin + tBt; Pin *= tAt;
    }
}

__device__ __forceinline__ void phase_lru1_v2(const P& p, LAS unsigned char* lds, int tid, int lane, int wave, int vcu, int G) {
    LAS float* xt = (LAS float*)lds;
    LAS float* cxf = (LAS float*)(lds + 17152);
    LAS unsigned char* cxb = lds + 33536;
    LAS float* EX = (LAS float*)(lds + 42752);
    const bf16* UV = (const bf16*)(p.ws + WS_UV); const bf16* XC = (const bf16*)(p.ws + WS_XC); const bf16* GWT = (const bf16*)(p.ws + WS_GWT);
    bf16* HS = (bf16*)(p.ws + WS_HS); bf16* PF = (bf16*)(p.ws + WS_PF); bf16* PB = (bf16*)(p.ws + WS_PB); float* SUM = (float*)(p.ws + WS_SUM);
    const int fr = lane & 15, fq = lane >> 4;
    const int wd = wave >> 2, jt = wave & 3, wj = 16 * jt + fr, cch_c = tid & 63;
    int hcur = -1; bf16x8 bfr[2][2]; float ba = 0.f, bi = 0.f, c8 = 0.f, cw0 = 0.f, cw1 = 0.f, cw2 = 0.f, cw3 = 0.f, cbias = 0.f;
    auto load_piece = [&](int T, int i) -> v4u { const int b = T / (NSEG * 8), rem = T % (NSEG * 8), seg = rem >> 3, h = rem & 7, r = (i >> 3) - 1, c0 = (i & 7) * 8; v4u w = (v4u){0u, 0u, 0u, 0u};
        if (seg < 4) { const int pos = seg * 64 + r; if (pos >= 0 && pos < CTXL) w = *(const v4u*)(XC + (size_t)(b * CTXL + pos) * DLRU + h * 64 + c0); }
        else { if (r >= 0 && r < 64) w = *(const v4u*)(UV + (size_t)(b * SEQ + (seg - 4) * 64 + r) * DIN + 1024 + h * 64 + c0); }
        return w; };
    v4u pre0 = (v4u){0u, 0u, 0u, 0u}, pre1 = (v4u){0u, 0u, 0u, 0u};
    if (vcu < BATCH * NSEG * 8) { pre0 = load_piece(vcu, tid); if (tid < 24) pre1 = load_piece(vcu, tid + 512); }
    for (int T = vcu; T < BATCH * NSEG * 8; T += G) {
        const int b = T / (NSEG * 8), rem = T % (NSEG * 8), seg = rem >> 3, h = rem & 7;
        { LAS float* o = xt + (tid >> 3) * 64 + (tid & 7) * 8;
          *(LAS f32x4*)o = (f32x4){bflo(pre0.x), bfhi(pre0.x), bflo(pre0.y), bfhi(pre0.y)}; *(LAS f32x4*)(o + 4) = (f32x4){bflo(pre0.z), bfhi(pre0.z), bflo(pre0.w), bfhi(pre0.w)};
          if (tid < 24) { LAS float* o1 = xt + ((tid + 512) >> 3) * 64 + (tid & 7) * 8;
              *(LAS f32x4*)o1 = (f32x4){bflo(pre1.x), bfhi(pre1.x), bflo(pre1.y), bfhi(pre1.y)}; *(LAS f32x4*)(o1 + 4) = (f32x4){bflo(pre1.z), bfhi(pre1.z), bflo(pre1.w), bfhi(pre1.w)}; } }
        if (h != hcur) { hcur = h;
#pragma unroll
            for (int g = 0; g < 2; ++g)
#pragma unroll
                for (int ks = 0; ks < 2; ++ks) bfr[g][ks] = *(const bf16x8*)(GWT + (size_t)((((wd * 2 + g) * 8 + h) * 64 + wj) * 64 + 32 * ks + 8 * fq));
            ba = p.rg_ba[wd * DLRU + h * 64 + wj]; bi = p.rg_bi[wd * DLRU + h * 64 + wj]; c8 = -8.f * log1pf(expf(-p.rg_lam[wd * DLRU + h * 64 + wj]));
            cw0 = p.conv_w[h * 64 + cch_c]; cw1 = p.conv_w[DLRU + h * 64 + cch_c]; cw2 = p.conv_w[2 * DLRU + h * 64 + cch_c]; cw3 = p.conv_w[3 * DLRU + h * 64 + cch_c]; cbias = p.conv_b[h * 64 + cch_c]; }
        __syncthreads();
        if (T + G < BATCH * NSEG * 8) { pre0 = load_piece(T + G, tid); if (tid < 24) pre1 = load_piece(T + G, tid + 512); }
        for (int i = tid; i < 4096; i += NTHREADS) { const int r = i >> 6, ch = i & 63;
            const float v = cbias + cw0 * xt[r * 64 + ch] + cw1 * xt[(r + 1) * 64 + ch] + cw2 * xt[(r + 2) * 64 + ch] + cw3 * xt[(r + 3) * 64 + ch];
            cxf[i] = v; *(LAS bf16*)(cxb + r * 144 + ch * 2) = (bf16)f2bf(v); }
        __syncthreads();
        {
            float ga[4][4], gb[4][4];
#pragma unroll
            for (int pt = 0; pt < 4; ++pt) {
                const bf16x8 a0 = *(const LAS bf16x8*)(cxb + (16 * pt + fr) * 144 + 16 * fq), a1 = *(const LAS bf16x8*)(cxb + (16 * pt + fr) * 144 + 64 + 16 * fq);
                f32x4 ca = (f32x4){0.f, 0.f, 0.f, 0.f}, ci = (f32x4){0.f, 0.f, 0.f, 0.f};
                ca = __builtin_amdgcn_mfma_f32_16x16x32_bf16(a0, bfr[0][0], ca, 0, 0, 0); ca = __builtin_amdgcn_mfma_f32_16x16x32_bf16(a1, bfr[0][1], ca, 0, 0, 0);
                ci = __builtin_amdgcn_mfma_f32_16x16x32_bf16(a0, bfr[1][0], ci, 0, 0, 0); ci = __builtin_amdgcn_mfma_f32_16x16x32_bf16(a1, bfr[1][1], ci, 0, 0, 0);
#pragma unroll
                for (int r = 0; r < 4; r += 2) { const int pos = 16 * pt + 4 * fq + r;
                    const f32x2p rg = sigmoid2_((f32x2p){ca[r], ca[r + 1]} + ba), ig = sigmoid2_((f32x2p){ci[r], ci[r + 1]} + bi); f32x2p av, sv; decay_pair2(rg * c8, av, sv);
                    const f32x2p dv = sv * ig * (f32x2p){cxf[pos * 64 + wj], cxf[(pos + 1) * 64 + wj]}; ga[pt][r] = av.x; ga[pt][r + 1] = av.y; gb[pt][r] = dv.x; gb[pt][r + 1] = dv.y; }
            }
            float Pin = 1.f, Hin = 0.f;
            if (wd == 0) lru_scan<0>(ga, gb, EX, lane, fr, fq, wj, Pin, Hin); else lru_scan<1>(ga, gb, EX, lane, fr, fq, wj, Pin, Hin);
            if (fq == 0) { float* so = SUM + ((size_t)((b * NSEG + seg) * 2 + wd) * DLRU + h * 64 + wj) * 2; so[0] = Pin; so[1] = Hin; }
        }
        __syncthreads();
        if (seg >= 4) { const int pos = tid >> 3, c0 = (tid & 7) * 8; const LAS float* q0 = EX + pos * 64 + c0;
            const f32x4 a0l = *(const LAS f32x4*)(q0), a0h = *(const LAS f32x4*)(q0 + 4), d0l = *(const LAS f32x4*)(q0 + 4096), d0h = *(const LAS f32x4*)(q0 + 4100);
            const f32x4 a1l = *(const LAS f32x4*)(q0 + 8192), a1h = *(const LAS f32x4*)(q0 + 8196), d1l = *(const LAS f32x4*)(q0 + 12288), d1h = *(const LAS f32x4*)(q0 + 12292);
            const f32x4 sl = d0l + d1l, sh = d0h + d1h; const size_t o = (size_t)(b * SEQ + (seg - 4) * 64 + pos) * DLRU + h * 64 + c0;
            *(v4u*)(HS + o) = (v4u){pk2(sl.x, sl.y), pk2(sl.z, sl.w), pk2(sh.x, sh.y), pk2(sh.z, sh.w)};
            *(v4u*)(PF + o) = (v4u){pk2(a0l.x, a0l.y), pk2(a0l.z, a0l.w), pk2(a0h.x, a0h.y), pk2(a0h.z, a0h.w)};
            *(v4u*)(PB + o) = (v4u){pk2(a1l.x, a1l.y), pk2(a1l.z, a1l.w), pk2(a1h.x, a1h.y), pk2(a1h.z, a1h.w)}; }
    }
    __syncthreads();
}

__device__ __forceinline__ void phase_sgu_mfma(const P& p, LAS unsigned char* lds, int tid, int lane, int wave, int vcu, int G, int first = 0, int last = 512) {
    LAS unsigned char* vnT = lds;
    const bf16* UV = (const bf16*)(p.ws + WS_UV); const bf16* SWB = (const bf16*)(p.ws + WS_SWB); bf16* A2 = (bf16*)(p.ws + WS_A2);
    const int fr = lane & 15, fq = lane >> 4;
    for (int T = first + vcu; T < last; T += G) {
        const int b = T >> 6, n = (T >> 2) & 15, h = T & 3; const size_t t0 = (size_t)b * SEQ + n * 128;
        { const int q = tid >> 2, part = tid & 3; const v4u* src = (const v4u*)(UV + (t0 + q) * DIN + 512 + h * 128 + part * 32);
          float v[32]; float s = 0.f;
#pragma unroll
          for (int i = 0; i < 4; ++i) { const v4u w = src[i]; v[8 * i] = bflo(w.x); v[8 * i + 1] = bfhi(w.x); v[8 * i + 2] = bflo(w.y); v[8 * i + 3] = bfhi(w.y); v[8 * i + 4] = bflo(w.z); v[8 * i + 5] = bfhi(w.z); v[8 * i + 6] = bflo(w.w); v[8 * i + 7] = bfhi(w.w); }
#pragma unroll
          for (int i = 0; i < 32; ++i) s += v[i] * v[i];
          s += __shfl_xor(s, 1); s += __shfl_xor(s, 2);
          const float rinv = rsqrtf(s * (1.f / 128.f) + EPS);
#pragma unroll
          for (int i = 0; i < 32; ++i) { const int c = part * 32 + i; *(LAS bf16*)(vnT + c * 272 + q * 2) = (bf16)f2bf(v[i] * rinv * p.sgu_g[h * 128 + c]); } }
        __syncthreads();
        { bf16x8 afr[4];
#pragma unroll
          for (int ks = 0; ks < 4; ++ks) afr[ks] = *(const bf16x8*)(SWB + (size_t)((h * 128 + 16 * wave + fr) * 128 + 32 * ks + 8 * fq));
          float bs[4];
#pragma unroll
          for (int r = 0; r < 4; ++r) bs[r] = p.sgu_b[h * 128 + 16 * wave + 4 * fq + r];
#pragma unroll
          for (int ct = 0; ct < 8; ++ct) { f32x4 acc = (f32x4){0.f, 0.f, 0.f, 0.f};
#pragma unroll
              for (int ks = 0; ks < 4; ++ks) { const bf16x8 bv = *(const LAS bf16x8*)(vnT + (16 * ct + fr) * 272 + 64 * ks + 16 * fq); acc = __builtin_amdgcn_mfma_f32_16x16x32_bf16(afr[ks], bv, acc, 0, 0, 0); }
#pragma unroll
              for (int r = 0; r < 4; ++r) { const int pp = 16 * wave + 4 * fq + r, c = 16 * ct + fr;
                  const float uu = bf2f(UV[(t0 + pp) * DIN + h * 128 + c]); A2[(t0 + pp) * D + h * 128 + c] = (bf16)f2bf(uu * (acc[r] + bs[r])); } } }
        __syncthreads();
    }
}

__device__ __forceinline__ void phase_lru2(const P& p, LAS unsigned char* lds, int tid, int vcu, int G) {
    LAS float* carry = (LAS float*)lds;
    const bf16* UV = (const bf16*)(p.ws + WS_UV); const bf16* HS = (const bf16*)(p.ws + WS_HS); const bf16* PF = (const bf16*)(p.ws + WS_PF); const bf16* PB = (const bf16*)(p.ws + WS_PB);
    const float* SUM = (const float*)(p.ws + WS_SUM); bf16* A2 = (bf16*)(p.ws + WS_A2);
    for (int T = vcu; T < BATCH * 32 * 8; T += G) {
        const int b = T >> 8, gr = (T >> 3) & 31, h = T & 7;
        if (tid < 128) { const int d = tid >> 6, ch = tid & 63; float hc = 0.f;
            const float* S = SUM + ((size_t)b * NSEG * 2 * DLRU + (size_t)d * DLRU + h * 64 + ch) * 2;
            if (d == 0) { for (int s = 0; s < 4 + gr; ++s) { const float A = S[(size_t)s * 2048], B = S[(size_t)s * 2048 + 1]; hc = A * hc + B; } }
            else { for (int s = 3; s >= 0; --s) { const float A = S[(size_t)s * 2048], B = S[(size_t)s * 2048 + 1]; hc = A * hc + B; }
                   for (int s = NSEG - 1; s > 4 + gr; --s) { const float A = S[(size_t)s * 2048], B = S[(size_t)s * 2048 + 1]; hc = A * hc + B; } }
            carry[tid] = hc; }
        __syncthreads();
        for (int i = tid; i < 4096; i += NTHREADS) { const int r = i >> 6, ch = i & 63; const size_t row = (size_t)b * SEQ + gr * 64 + r, o = row * DLRU + h * 64 + ch;
            const float val = bf2f(HS[o]) + bf2f(PF[o]) * carry[ch] + bf2f(PB[o]) * carry[64 + ch];
            A2[row * D + 512 + h * 64 + ch] = (bf16)f2bf(bf2f(UV[row * DIN + 1536 + h * 64 + ch]) * val); }
        __syncthreads();
    }
}


__device__ __forceinline__ void phase_lru2_fast(const P& p, LAS unsigned char* lds, int tid, int vcu, int G) {
    LAS float* carry = (LAS float*)lds;
    constexpr int NQ = LRU2_PARTS, GR = 32 / NQ, GSH = (NQ == 8) ? 2 : 3;
    const bf16* UV = (const bf16*)(p.ws + WS_UV); const bf16* HS = (const bf16*)(p.ws + WS_HS); const bf16* PF = (const bf16*)(p.ws + WS_PF); const bf16* PB = (const bf16*)(p.ws + WS_PB);
    const float* SUM = (const float*)(p.ws + WS_SUM); bf16* A2 = (bf16*)(p.ws + WS_A2);
    typedef float f32x2 __attribute__((ext_vector_type(2)));
    for (int T = vcu; T < 64 * NQ; T += G) {
        const int b = T / (8 * NQ), h = (T / NQ) & 7, qt = T % NQ;
        v4u hsv[GR], pfv[GR], pbv[GR], ggv[GR];
#pragma unroll
        for (int it = 0; it < GR; ++it) { const int v = it * NTHREADS + tid, pos = v >> 3, c0 = (v & 7) * 8; const size_t row = (size_t)b * SEQ + qt * (64 * GR) + pos, o = row * DLRU + h * 64 + c0;
            hsv[it] = *(const v4u*)(HS + o); pfv[it] = *(const v4u*)(PF + o); pbv[it] = *(const v4u*)(PB + o); ggv[it] = *(const v4u*)(UV + row * DIN + 1536 + h * 64 + c0); }
        if (tid < 128) { const int d = tid >> 6, ch = tid & 63;
            const f32x2* S = (const f32x2*)SUM + ((size_t)b * NSEG * 2 + d) * DLRU + h * 64 + ch;
            f32x2 ab[NSEG];
#pragma unroll
            for (int s2 = 0; s2 < NSEG; ++s2) ab[s2] = S[(size_t)s2 * 2 * DLRU];
            float hc = 0.f;
            if (d == 0) {
#pragma unroll
                for (int s2 = 0; s2 < NSEG; ++s2) { if (s2 >= 4 && ((s2 - 4) >> GSH) == qt) carry[(((s2 - 4) & (GR - 1)) * 2 + 0) * 64 + ch] = hc; hc = ab[s2].x * hc + ab[s2].y; }
            } else {
#pragma unroll
                for (int s2 = 3; s2 >= 0; --s2) hc = ab[s2].x * hc + ab[s2].y;
#pragma unroll
                for (int s2 = NSEG - 1; s2 >= 4; --s2) { if (((s2 - 4) >> GSH) == qt) carry[(((s2 - 4) & (GR - 1)) * 2 + 1) * 64 + ch] = hc; hc = ab[s2].x * hc + ab[s2].y; }
            } }
        __syncthreads();
#pragma unroll
        for (int it = 0; it < GR; ++it) { const int v = it * NTHREADS + tid, pos = v >> 3, c0 = (v & 7) * 8, grl = pos >> 6;
            const size_t row = (size_t)b * SEQ + qt * (64 * GR) + pos;
            const v4u hs = hsv[it], pf = pfv[it], pb = pbv[it], gg = ggv[it];
            const f32x4 cf0 = *(const LAS f32x4*)(carry + (grl * 2) * 64 + c0), cf1 = *(const LAS f32x4*)(carry + (grl * 2) * 64 + c0 + 4);
            const f32x4 cb0 = *(const LAS f32x4*)(carry + (grl * 2 + 1) * 64 + c0), cb1 = *(const LAS f32x4*)(carry + (grl * 2 + 1) * 64 + c0 + 4);
            v4u out;
            out.x = pk2(bflo(gg.x) * (bflo(hs.x) + bflo(pf.x) * cf0.x + bflo(pb.x) * cb0.x), bfhi(gg.x) * (bfhi(hs.x) + bfhi(pf.x) * cf0.y + bfhi(pb.x) * cb0.y));
            out.y = pk2(bflo(gg.y) * (bflo(hs.y) + bflo(pf.y) * cf0.z + bflo(pb.y) * cb0.z), bfhi(gg.y) * (bfhi(hs.y) + bfhi(pf.y) * cf0.w + bfhi(pb.y) * cb0.w));
            out.z = pk2(bflo(gg.z) * (bflo(hs.z) + bflo(pf.z) * cf1.x + bflo(pb.z) * cb1.x), bfhi(gg.z) * (bfhi(hs.z) + bfhi(pf.z) * cf1.y + bfhi(pb.z) * cb1.y));
            out.w = pk2(bflo(gg.w) * (bflo(hs.w) + bflo(pf.w) * cf1.z + bflo(pb.w) * cb1.z), bfhi(gg.w) * (bfhi(hs.w) + bfhi(pf.w) * cf1.w + bfhi(pb.w) * cb1.w));
            *(v4u*)(A2 + row * D + 512 + h * 64 + c0) = out; }
        __syncthreads();
    }
}

__device__ __forceinline__ void phase_p5(const P& p, LAS unsigned char* lds, int tid, int lane, int wave, int vcu, int G) {
    LAS float* wrT = (LAS float*)lds;
    const float* MOD = (const float*)(p.ws + WS_MOD); const float* X1 = (const float*)(p.ws + WS_X1); bf16* HX2 = (bf16*)(p.ws + WS_HX2); float* AFF = (float*)(p.ws + WS_AFF);
    for (int i = tid; i < D * NE; i += NTHREADS) wrT[(i & 15) * D + (i >> 4)] = p.w_router[i];
    __syncthreads();
    const int gw = vcu * NWAVES + wave, NGW = G * NWAVES;
    f32x4 nx[4];
    if (gw < M) { const f32x4* xr = (const f32x4*)(X1 + (size_t)gw * D) + lane;
#pragma unroll
        for (int jj = 0; jj < 4; ++jj) nx[jj] = xr[64 * jj]; }
    for (int m = gw; m < M; m += NGW) {
        const int b = m >> 11, t = m & 2047;
        f32x4 v[4]; float s = 0.f;
#pragma unroll
        for (int jj = 0; jj < 4; ++jj) { v[jj] = nx[jj]; s += (v[jj].x * v[jj].x + v[jj].y * v[jj].y) + (v[jj].z * v[jj].z + v[jj].w * v[jj].w); }
        if (m + NGW < M) { const f32x4* xr = (const f32x4*)(X1 + (size_t)(m + NGW) * D) + lane;
#pragma unroll
            for (int jj = 0; jj < 4; ++jj) nx[jj] = xr[64 * jj]; }
        const float rinv = rsqrtf(wave_sum(s) * (1.f / D) + EPS);
        v2u* o = (v2u*)(HX2 + (size_t)m * D) + lane;
#pragma unroll
        for (int jj = 0; jj < 4; ++jj) { const int k = 4 * (lane + 64 * jj);
            const f32x4 g = *(const f32x4*)(p.norm2_g + k), sh = *(const f32x4*)(MOD + b * NMOD + 3 * D + k), sc = *(const f32x4*)(MOD + b * NMOD + 4 * D + k);
            v[jj] = v[jj] * rinv * g * (sc + 1.f) + sh;
#if MOE_FP8
            ((unsigned*)(p.ws + WS_HX2) + (size_t)m * (D / 4))[lane + 64 * jj] = pk4_fp8(v[jj].x, v[jj].y, v[jj].z, v[jj].w); }
#else
            v2u w; w.x = pk2(v[jj].x, v[jj].y); w.y = pk2(v[jj].z, v[jj].w); o[64 * jj] = w; }
#endif
        float pa[16];
#pragma unroll
        for (int e = 0; e < 16; ++e) { float a = 0.f;
#pragma unroll
            for (int jj = 0; jj < 4; ++jj) { const f32x4 w = *(const LAS f32x4*)(wrT + e * D + 4 * (lane + 64 * jj)); a += (v[jj].x * w.x + v[jj].y * w.y) + (v[jj].z * w.z + v[jj].w * w.w); }
            pa[e] = a; if (e & 1) asm volatile("" ::: "memory"); }
        { const bool h5 = (lane & 32) != 0; float q8[8];
#pragma unroll
          for (int i = 0; i < 8; ++i) { const float keep = h5 ? pa[8 + i] : pa[i], give = h5 ? pa[i] : pa[8 + i]; q8[i] = keep + __shfl_xor(give, 32); }
          const bool h4 = (lane & 16) != 0; float q4[4];
#pragma unroll
          for (int i = 0; i < 4; ++i) { const float keep = h4 ? q8[4 + i] : q8[i], give = h4 ? q8[i] : q8[4 + i]; q4[i] = keep + __shfl_xor(give, 16); }
          const bool h3 = (lane & 8) != 0; float q2[2];
#pragma unroll
          for (int i = 0; i < 2; ++i) { const float keep = h3 ? q4[2 + i] : q4[i], give = h3 ? q4[i] : q4[2 + i]; q2[i] = keep + __shfl_xor(give, 8); }
          const bool h2 = (lane & 4) != 0;
          float lgt = (h2 ? q2[1] : q2[0]) + __shfl_xor(h2 ? q2[0] : q2[1], 4);
          lgt += __shfl_xor(lgt, 2); lgt += __shfl_xor(lgt, 1);
          float mx = lgt;
#pragma unroll
          for (int o2 = 4; o2 < 64; o2 <<= 1) mx = fmaxf(mx, __shfl_xor(mx, o2));
          const float ex = expf(lgt - mx); float den = ex;
#pragma unroll
          for (int o2 = 4; o2 < 64; o2 <<= 1) den += __shfl_xor(den, o2);
          if ((lane & 3) == 0) AFF[(size_t)(b * NE + (lane >> 2)) * SEQ + t] = ex / den; }
    }
    __syncthreads();
}

__device__ __forceinline__ void phase_p6(const P& p, LAS unsigned char* lds, int tid, int lane, int wave, int vcu, int G) {
    LAS float* a = (LAS float*)lds; LAS int* tok = (LAS int*)(lds + 8192);
    const float* AFF = (const float*)(p.ws + WS_AFF); int* SLOT = (int*)(p.ws + WS_SLOT); float* GATE = (float*)(p.ws + WS_GATE);
    const bf16* HX2 = (const bf16*)(p.ws + WS_HX2); bf16* XE = (bf16*)(p.ws + WS_XE);
    for (int T = vcu; T < BATCH * NE; T += G) {
        const int b = T >> 4, e = T & 15;
        for (int i = tid; i < SEQ; i += NTHREADS) a[i] = AFF[(size_t)(b * NE + e) * SEQ + i];
        __syncthreads();
        float at[4]; int rk[4];
#pragma unroll
        for (int i = 0; i < 4; ++i) { at[i] = a[tid + 512 * i]; rk[i] = 0; }
        for (int t2 = 0; t2 < SEQ; ++t2) { const float av = a[t2];
#pragma unroll
            for (int i = 0; i < 4; ++i) rk[i] += (av > at[i] || (av == at[i] && t2 < tid + 512 * i)) ? 1 : 0; }
#pragma unroll
        for (int i = 0; i < 4; ++i) { const int t = tid + 512 * i; SLOT[(size_t)(b * SEQ + t) * NE + e] = rk[i] < CAP ? rk[i] : -1;
            if (rk[i] < CAP) { tok[rk[i]] = t; GATE[e * 2048 + b * CAP + rk[i]] = at[i]; } }
        __syncthreads();
        for (int r = wave; r < CAP; r += NWAVES) { const v4u* src = (const v4u*)(HX2 + (size_t)(b * SEQ + tok[r]) * D); v4u* dst = (v4u*)(XE + (size_t)(e * 2048 + b * CAP + r) * D);
            dst[lane] = src[lane]; dst[lane + 64] = src[lane + 64]; }
        __syncthreads();
    }
}


__device__ __forceinline__ unsigned block_sum_u(unsigned v, LAS unsigned* red, int lane, int wave) {
    v = (unsigned)wave_sum((float)v);
    if (lane == 0) red[wave] = v;
    __syncthreads();
    unsigned s = 0;
#pragma unroll
    for (int w = 0; w < 8; ++w) s += red[w];
    return s;
}
__device__ __forceinline__ unsigned block_excl_scan(unsigned c, unsigned& total, LAS unsigned* red, int lane, int wave) {
    unsigned inc = c;
#pragma unroll
    for (int o = 1; o < 64; o <<= 1) { const unsigned t = __shfl_up(inc, o); if (lane >= o) inc += t; }
    if (lane == 63) red[wave] = inc;
    __syncthreads();
    unsigned off = 0, tot = 0;
#pragma unroll
    for (int w = 0; w < 8; ++w) { const unsigned x = red[w]; off += (w < wave) ? x : 0u; tot += x; }
    total = tot; return off + inc - c;
}
__device__ __forceinline__ void phase_p6_fast(const P& p, LAS unsigned char* lds, int tid, int lane, int wave, int vcu, int G) {
    LAS unsigned* red = (LAS unsigned*)lds;
    LAS int* tok = (LAS int*)(lds + 2048);
    const float* AFF = (const float*)(p.ws + WS_AFF); int* SLOT = (int*)(p.ws + WS_SLOT); float* GATE = (float*)(p.ws + WS_GATE);
    const bf16* HX2 = (const bf16*)(p.ws + WS_HX2); bf16* XE = (bf16*)(p.ws + WS_XE);
    for (int T = vcu; T < BATCH * NE * 2; T += G) {
        const int half = T & 1, e = (T >> 1) & 15, b = T >> 5;
        const f32x4 av = *(const f32x4*)(AFF + (size_t)(b * NE + e) * SEQ + 4 * tid);
        unsigned bits[4] = {__float_as_uint(av.x), __float_as_uint(av.y), __float_as_uint(av.z), __float_as_uint(av.w)};
        unsigned lo = 0u, hi = 0x3f800000u; int rb = 0;
        while (lo < hi) {
            const unsigned span = hi - lo, q = (span + 3u) >> 2, t1 = lo + q, t2 = min(lo + 2u * q, hi), t3 = min(lo + 3u * q, hi);
            unsigned w = 0;
#pragma unroll
            for (int i = 0; i < 4; ++i) w += (bits[i] >= t1 ? 1u : 0u) + (bits[i] >= t2 ? (1u << 10) : 0u) + (bits[i] >= t3 ? (1u << 20) : 0u);
#pragma unroll
            for (int o = 1; o < 64; o <<= 1) w += __shfl_xor(w, o);
            LAS unsigned* rd = red + 8 * rb; rb = (rb + 1) % 36;
            if (lane == 0) rd[wave] = w;
            __syncthreads();
            unsigned c1 = 0, c2 = 0, c3 = 0;
#pragma unroll
            for (int ww = 0; ww < 8; ++ww) { const unsigned x = rd[ww]; c1 += x & 1023u; c2 += (x >> 10) & 1023u; c3 += x >> 20; }
            if (c3 >= (unsigned)CAP) lo = t3; else if (c2 >= (unsigned)CAP) { lo = t2; hi = t3 - 1u; } else if (c1 >= (unsigned)CAP) { lo = t1; hi = t2 - 1u; } else hi = t1 - 1u;
        }
        const unsigned Tb = lo;
        unsigned cg = 0, ct = 0;
#pragma unroll
        for (int i = 0; i < 4; ++i) { cg += (bits[i] > Tb) ? 1u : 0u; ct += (bits[i] == Tb) ? 1u : 0u; }
        unsigned ngt; const unsigned need = (unsigned)CAP - (ngt = block_sum_u(cg, red + 8 * 36, lane, wave));
        unsigned ttot; unsigned tpre = block_excl_scan(ct, ttot, red + 8 * 37, lane, wave);
        unsigned sel[4], cs = 0;
#pragma unroll
        for (int i = 0; i < 4; ++i) { const bool tie = bits[i] == Tb; sel[i] = (bits[i] > Tb || (tie && tpre < need)) ? 1u : 0u; tpre += tie ? 1u : 0u; cs += sel[i]; }
        unsigned stot; unsigned spre = block_excl_scan(cs, stot, red + 8 * 38, lane, wave);
#pragma unroll
        for (int i = 0; i < 4; ++i) { const int t = 4 * tid + i;
            if ((t >> 10) == half) SLOT[(size_t)(b * SEQ + t) * NE + e] = sel[i] ? (int)spre : -1;
            if (sel[i]) { tok[spre] = t; if ((int)(spre >> 7) == half) GATE[e * 2048 + b * CAP + spre] = __uint_as_float(bits[i]); spre += 1u; } }
        __syncthreads();
#if MOE_FP8
        if (tid < 128) ((int*)(p.ws + WS_TOK))[e * 2048 + b * CAP + half * 128 + tid] = b * SEQ + tok[half * 128 + tid];
#else
        for (int r = half * 128 + wave; r < half * 128 + 128; r += NWAVES) { const v4u* src = (const v4u*)(HX2 + (size_t)(b * SEQ + tok[r]) * D); v4u* dst = (v4u*)(XE + (size_t)(e * 2048 + b * CAP + r) * D);
            dst[lane] = src[lane]; dst[lane + 64] = src[lane + 64]; }
#endif
        __syncthreads();
    }
}

__device__ __forceinline__ void phase_p9(const P& p, int lane, int wave, int vcu, int G) {
    const float* MOD = (const float*)(p.ws + WS_MOD); const float* X1 = (const float*)(p.ws + WS_X1); const int* SLOT = (const int*)(p.ws + WS_SLOT); const bf16* YE = (const bf16*)(p.ws + WS_YE);
    const int gw = vcu * NWAVES + wave, NGW = G * NWAVES;
    f32x4 nx[4]; int nslot = -1;
    if (gw < M) { const f32x4* xr = (const f32x4*)(X1 + (size_t)gw * D) + lane;
#pragma unroll
        for (int jj = 0; jj < 4; ++jj) nx[jj] = xr[64 * jj];
        nslot = SLOT[(size_t)gw * NE + (lane & 15)]; }
    for (int m = gw; m < M; m += NGW) {
        const int b = m >> 11;
        f32x4 v[4], acc[4]; const int myslot = nslot;
#pragma unroll
        for (int jj = 0; jj < 4; ++jj) { v[jj] = nx[jj]; acc[jj] = (f32x4){0.f, 0.f, 0.f, 0.f}; }
        if (m + NGW < M) { const f32x4* xr = (const f32x4*)(X1 + (size_t)(m + NGW) * D) + lane;
#pragma unroll
            for (int jj = 0; jj < 4; ++jj) nx[jj] = xr[64 * jj];
            nslot = SLOT[(size_t)(m + NGW) * NE + (lane & 15)]; }
#pragma unroll
        for (int e = 0; e < NE; ++e) { const int sl = __builtin_amdgcn_readlane(myslot, e);
#if MOE_FP8
            if (sl >= 0) { const unsigned* y = (const unsigned*)((const unsigned char*)YE + (size_t)(e * 2048 + b * CAP + sl) * D) + lane;
#pragma unroll
                for (int jj = 0; jj < 4; ++jj) { const unsigned w = y[64 * jj]; const auto lo = __builtin_amdgcn_cvt_pk_f32_fp8((int)w, false), hi = __builtin_amdgcn_cvt_pk_f32_fp8((int)w, true);
                    acc[jj] += (f32x4){lo[0], lo[1], hi[0], hi[1]}; } } }
#else
            if (sl >= 0) { const v2u* y = (const v2u*)(YE + (size_t)(e * 2048 + b * CAP + sl) * D) + lane;
#pragma unroll
                for (int jj = 0; jj < 4; ++jj) { const v2u w = y[64 * jj]; acc[jj] += (f32x4){bflo(w.x), bfhi(w.x), bflo(w.y), bfhi(w.y)}; } } }
#endif
        float s = 0.f;
#pragma unroll
        for (int jj = 0; jj < 4; ++jj) { const int k = 4 * (lane + 64 * jj); const f32x4 g2 = *(const f32x4*)(MOD + b * NMOD + 5 * D + k); v[jj] += g2 * acc[jj] * (MOE_FP8 ? WSCALE_INV : 1.f);
            s += (v[jj].x * v[jj].x + v[jj].y * v[jj].y) + (v[jj].z * v[jj].z + v[jj].w * v[jj].w); }
        const float rinv = rsqrtf(wave_sum(s) * (1.f / D) + EPS);
        f32x4* o = (f32x4*)(p.out + (size_t)m * D) + lane;
#pragma unroll
        for (int jj = 0; jj < 4; ++jj) { const int k = 4 * (lane + 64 * jj); o[64 * jj] = v[jj] * rinv * *(const f32x4*)(p.final_g + k); }
    }
}

#if CONV_CUS && MOE_FP8 && XCD_BAR && LRU1_MFMA && SGU_MFMA && LRU2_FAST && P6_FAST && USE_PG8 && (MK_N_LAUNCHES == 1)
__global__ void __launch_bounds__(NTHREADS, 2) fwd_megakernel(P p) {
    extern __shared__ __attribute__((aligned(16))) unsigned char lds_raw[];
    LAS unsigned char* lds = (LAS unsigned char*)lds_raw;
    const int tid = threadIdx.x, lane = tid & 63, wave = __builtin_amdgcn_readfirstlane(tid >> 6);
    const int G = gridDim.x, bx = blockIdx.x, xg = bx & 7, xl = bx >> 3;
    const int vcu = (G % 8 == 0) ? xg * (G / 8) + xl : bx;
    constexpr int CSH = (NCONV == 64) ? 2 : 3, CPG = 32 >> CSH, WPG = 32 - CPG;
    const bool split = (G == 256), is_conv = split && ((xl & ((1 << CSH) - 1)) == (1 << CSH) - 1);
    const int GW = split ? 8 * WPG : G, wvcu = split ? xg * WPG + (xl - (xl >> CSH)) : vcu, cvcu = xg * CPG + (xl >> CSH);
    volatile LAS unsigned* bst = (volatile LAS unsigned*)(lds + LDS_BYTES - 16);
    if (tid < 4) bst[tid] = 0u;
    __syncthreads();
    unsigned* ctl = (unsigned*)(p.ws + WS_CTL);
    const XcdBarrier barA = xcd_barrier_post(ctl + 4096, bst, (unsigned)G);
    XcdBarrier barW = barA;
    if (split && !is_conv) barW = xcd_barrier_post(ctl + 4096 + XCD_BAR_WORDS, bst + 2, (unsigned)GW);

    if (is_conv) {
        convert_pipelined(p, lds, lane, wave, CONV_HEAD, CONV_ITEMS, cvcu * NWAVES + wave, 8 * CPG * NWAVES);
        if (tid == 0) { XB_SPIN(xb_ld(ctl + 64) == 0u, ctl + 4096); __builtin_amdgcn_fence(__ATOMIC_ACQUIRE, "agent"); asm volatile("s_waitcnt vmcnt(0)" ::: "memory"); }
        __syncthreads();
        phase_sgu_mfma(p, lds, tid, lane, wave, cvcu, 8 * CPG, 0, SGU_CONV_TASKS);
    } else {
        phase_p0(p, lds, tid, lane, wave, wvcu, GW, split ? 16 * 32 : CONV_ITEMS, !split);
        xcd_barrier(barW);
        phase_p1(p, lane, wave, wvcu, GW);
        if (split) { convert_items(p, lds, lane, wave, 16 * 32, CONV_HEAD, wvcu * NWAVES + wave, GW * NWAVES); p0_small_copies(p, tid, wvcu, GW); }
        xcd_barrier(barW);
        { pg8::Gemm g{(const bf16*)(p.ws + WS_HX), (const bf16*)(p.ws + WS_WIN), D}; SchedG1 S{GW, wvcu}; EpiG1 E{(bf16*)(p.ws + WS_UV), (bf16*)(p.ws + WS_XC)};
          pg8::gemm_phase<EpiG1, SchedG1, true, true>(lds, g, S, E); }
        xcd_barrier(barW);
        if (split && wvcu == 0 && tid == 0) __hip_atomic_store(ctl + 64, 1u, __ATOMIC_RELAXED, __HIP_MEMORY_SCOPE_AGENT);
#if LRU1_V2
        phase_lru1_v2(p, lds, tid, lane, wave, wvcu, GW);
#else
        phase_lru1_mfma(p, lds, tid, lane, wave, wvcu, GW);
#endif
        phase_sgu_mfma(p, lds, tid, lane, wave, wvcu, GW, split ? SGU_CONV_TASKS : 0, 512);
        xcd_barrier(barW);
        phase_lru2_fast(p, lds, tid, wvcu, GW);
    }
    xcd_barrier(barA);
    if (split) {
        pg8::Gemm g{(const bf16*)(p.ws + WS_A2), (const bf16*)(p.ws + WS_WOUT), D}; SchedG2 S{G, vcu};
        EpiG2F E{p.x, (const float*)(p.ws + WS_MOD), (float*)(p.ws + WS_X1), p.w_router, p.norm2_g, (const float*)(p.ws + WS_CB), (float*)(p.ws + WS_XCH), ctl + 2048, ctl + 4096, p.ws + WS_HX2, (float*)(p.ws + WS_AFF)};
        pg8::gemm_phase<EpiG2F, SchedG2, true, true>(lds, g, S, E);
    } else {
        { pg8::Gemm g{(const bf16*)(p.ws + WS_A2), (const bf16*)(p.ws + WS_WOUT), D}; SchedG2 S{G, vcu}; EpiG2 E{p.x, (const float*)(p.ws + WS_MOD), (float*)(p.ws + WS_X1)};
          pg8::gemm_phase<EpiG2, SchedG2, true, true>(lds, g, S, E); }
        xcd_barrier(barA);
        phase_p5(p, lds, tid, lane, wave, vcu, G);
    }
    xcd_barrier(barA);
    phase_p6_fast(p, lds, tid, lane, wave, vcu, G);
    xcd_barrier(barA);
    { pg8::Gemm g{(const bf16*)(p.ws + WS_HX2), (const bf16*)(p.ws + WS_WG), D}; SchedG3 S{G, vcu}; EpiG3 E{p.ws + WS_HID};
      pg8::gemm_phase_f8g<EpiG3, SchedG3, true, true>(lds, g, S, E, (const int*)(p.ws + WS_TOK)); }
    xcd_barrier(barA);
    { pg8::Gemm g{(const bf16*)(p.ws + WS_HID), (const bf16*)(p.ws + WS_W2), DE}; SchedG4 S{G, vcu}; EpiG4 E{(const float*)(p.ws + WS_GATE), p.ws + WS_YE};
      pg8::gemm_phase_f8<EpiG4, SchedG4, true, true>(lds, g, S, E); }
    xcd_barrier(barA);
    phase_p9(p, lane, wave, vcu, G);
}
#else
__global__ void __launch_bounds__(NTHREADS, 2) fwd_megakernel(P p) {
    extern __shared__ __attribute__((aligned(16))) unsigned char lds_raw[];
    LAS unsigned char* lds = (LAS unsigned char*)lds_raw;
    const int tid = threadIdx.x, lane = tid & 63, wave = __builtin_amdgcn_readfirstlane(tid >> 6);
    const int G = gridDim.x, bx = blockIdx.x, vcu = (G % 8 == 0) ? (bx % 8) * (G / 8) + bx / 8 : bx;
    const int lo = p.ph_lo, hi = p.ph_hi;
#if XCD_BAR
    volatile LAS unsigned* bst = (volatile LAS unsigned*)(lds + LDS_BYTES - 16);
    if (tid < 2) bst[tid] = 0u;
    __syncthreads();
    XcdBarrier bar; bar.bar = (unsigned*)(p.ws + WS_CTL) + 4096; bar.x = 0; bar.st = bst; bar.total = (unsigned)G;
    if (hi - lo > 1) bar = xcd_barrier_post((unsigned*)(p.ws + WS_CTL) + 4096, bst, (unsigned)G);
#define GRID_SYNC() xcd_barrier(bar)
#else
    cg::grid_group grid = cg::this_grid();
#define GRID_SYNC() grid.sync()
#endif
#define IN(k) (lo <= (k) && (k) < hi)
#define SEAM(k) do { if (IN(k) && IN((k) + 1)) GRID_SYNC(); } while (0)
#define REP(k) for (int rep_ = 0; rep_ < 1 + ((DUP_MASK >> (k)) & 1); ++rep_)
    if (IN(0)) { REP(0) { phase_p0(p, lds, tid, lane, wave, vcu, G, CONV_CUT); __syncthreads(); } SEAM(0); }
    if (IN(1)) { REP(1) phase_p1(p, lane, wave, vcu, G); SEAM(1); }
    if ((DUP_MASK >> 12) & 1) { for (int xb = 0; xb < 8; ++xb) GRID_SYNC(); }
    if (IN(2)) { pg8::Gemm g{(const bf16*)(p.ws + WS_HX), (const bf16*)(p.ws + WS_WIN), D}; SchedG1 S{G, vcu}; EpiG1 E{(bf16*)(p.ws + WS_UV), (bf16*)(p.ws + WS_XC)};
        REP(2) { gemm_any(lds, g, S, E); if (G > 16 && vcu >= 16) convert_items(p, lds, lane, wave, CONV_CUT, CONV_ITEMS, (vcu - 16) * NWAVES + wave, (G - 16) * NWAVES); }
        if (G <= 16) convert_items(p, lds, lane, wave, CONV_CUT, CONV_ITEMS, vcu * NWAVES + wave, G * NWAVES);
        SEAM(2); }
    if (IN(3)) { REP(3) {
#if LRU1_MFMA
        phase_lru1_mfma(p, lds, tid, lane, wave, vcu, G);
#else
        phase_lru1(p, lds, tid, vcu, G);
#endif
        } REP(11) {
#if SGU_MFMA
        phase_sgu_mfma(p, lds, tid, lane, wave, vcu, G);
#else
        phase_sgu(p, lds, tid, vcu, G);
#endif
        } SEAM(3); }
    if (IN(4)) { REP(4) {
#if LRU2_FAST
        phase_lru2_fast(p, lds, tid, vcu, G);
#else
        phase_lru2(p, lds, tid, vcu, G);
#endif
        } SEAM(4); }
    if (IN(5)) { pg8::Gemm g{(const bf16*)(p.ws + WS_A2), (const bf16*)(p.ws + WS_WOUT), D}; SchedG2 S{G, vcu}; EpiG2 E{p.x, (const float*)(p.ws + WS_MOD), (float*)(p.ws + WS_X1)};
        REP(5) gemm_any(lds, g, S, E); SEAM(5); }
    if (IN(6)) { REP(6) phase_p5(p, lds, tid, lane, wave, vcu, G); SEAM(6); }
    if (IN(7)) { REP(7) {
#if P6_FAST
        phase_p6_fast(p, lds, tid, lane, wave, vcu, G);
#else
        phase_p6(p, lds, tid, lane, wave, vcu, G);
#endif
        } SEAM(7); }
#if MOE_FP8
    if (IN(8)) { pg8::Gemm g{(const bf16*)(p.ws + WS_XE), (const bf16*)(p.ws + WS_WG), D}; SchedG3 S{G, vcu}; EpiG3 E{p.ws + WS_HID};
        REP(8) pg8::gemm_phase_f8<EpiG3, SchedG3, true, true>(lds, g, S, E); SEAM(8); }
    if (IN(9)) { pg8::Gemm g{(const bf16*)(p.ws + WS_HID), (const bf16*)(p.ws + WS_W2), DE}; SchedG4 S{G, vcu}; EpiG4 E{(const float*)(p.ws + WS_GATE), p.ws + WS_YE};
        REP(9) pg8::gemm_phase_f8<EpiG4, SchedG4, true, true>(lds, g, S, E); SEAM(9); }
#else
    if (IN(8)) { pg8::Gemm g{(const bf16*)(p.ws + WS_XE), (const bf16*)(p.ws + WS_WG), D}; SchedG3 S{G, vcu}; EpiG3 E{(bf16*)(p.ws + WS_HID)};
        REP(8) gemm_any(lds, g, S, E); SEAM(8); }
    if (IN(9)) { pg8::Gemm g{(const bf16*)(p.ws + WS_HID), (const bf16*)(p.ws + WS_W2), DE}; SchedG4 S{G, vcu}; EpiG4 E{(const float*)(p.ws + WS_GATE), (bf16*)(p.ws + WS_YE)};
        REP(9) gemm_any(lds, g, S, E); SEAM(9); }
#endif
    if (IN(10)) { REP(10) phase_p9(p, lane, wave, vcu, G); }
#undef IN
#undef REP
#undef SEAM
#undef GRID_SYNC
}

#endif

extern "C" void kernel_launch(void* const* d_in, const int* in_sizes, int n_in, void* d_out, int out_size, void* d_ws, size_t ws_size, hipStream_t stream) {
    static int grid = 0;
    if (grid == 0) {
        if (n_in != 25 || in_sizes[0] != M * D || out_size != M * D || ws_size < WS_END) { fprintf(stderr, "kernel_launch: unexpected shapes (n_in %d, in0 %d, out %d, ws %zu < %zu)\n", n_in, n_in > 0 ? in_sizes[0] : -1, out_size, ws_size, (size_t)WS_END); grid = -1; return; }
        int dev = 0, cus = 0, per_cu = 0;
        if (hipGetDevice(&dev) != hipSuccess || hipDeviceGetAttribute(&cus, hipDeviceAttributeMultiprocessorCount, dev) != hipSuccess) { grid = -1; return; }
        if (hipFuncSetAttribute((const void*)fwd_megakernel, hipFuncAttributeMaxDynamicSharedMemorySize, LDS_BYTES) != hipSuccess) { fprintf(stderr, "kernel_launch: hipFuncSetAttribute failed\n"); grid = -1; return; }
        if (hipOccupancyMaxActiveBlocksPerMultiprocessor(&per_cu, (const void*)fwd_megakernel, NTHREADS, LDS_BYTES) != hipSuccess || per_cu < 1) { fprintf(stderr, "kernel_launch: occupancy query failed (%d)\n", per_cu); (void)hipGetLastError(); grid = -1; return; }
        grid = cus * per_cu;
    }
    if (grid < 0) return;
#if XCD_BAR
    if (hipMemsetAsync((char*)d_ws + WS_CTL, 0, 65536, stream) != hipSuccess) { fprintf(stderr, "kernel_launch: hipMemsetAsync failed\n"); return; }
#endif
    P p{};
    const float** f = (const float**)&p;
    for (int i = 0; i < 25; ++i) f[i] = (const float*)d_in[i];
    p.out = (float*)d_out; p.ws = (unsigned char*)d_ws;
#if MK_N_LAUNCHES == 1
    p.ph_lo = 0; p.ph_hi = NPH; void* args[] = {&p};
    hipError_t e = hipLaunchCooperativeKernel((const void*)fwd_megakernel, dim3(grid), dim3(NTHREADS), args, LDS_BYTES, stream);
    if (e != hipSuccess) fprintf(stderr, "kernel_launch: cooperative launch failed: %s (grid %d)\n", hipGetErrorString(e), grid);
#else
    for (int ph = 0; ph < NPH; ++ph) { p.ph_lo = ph; p.ph_hi = ph + 1; hipLaunchKernelGGL(fwd_megakernel, dim3(grid), dim3(NTHREADS), LDS_BYTES, stream, p); }
#endif
}
```

```cpp
#include <hip/hip_runtime.h>
#include <hip/hip_cooperative_groups.h>
#include <cstdio>
#include <cstdint>
namespace cg = cooperative_groups;

#ifndef MK_N_LAUNCHES
#define MK_N_LAUNCHES 1
#endif
#ifndef XCD_BAR
#define XCD_BAR 1
#endif
#ifndef LRU1_MFMA
#define LRU1_MFMA 1
#endif
#ifndef SGU_MFMA
#define SGU_MFMA 1
#endif
#ifndef P6_FAST
#define P6_FAST 1
#endif
#ifndef DUP_MASK
#define DUP_MASK 0
#endif
#ifndef LRU2_FAST
#define LRU2_FAST 1
#endif
#ifndef MOE_FP8
#define MOE_FP8 1
#endif
#ifndef CONV_CUS
#define CONV_CUS 1
#endif
#ifndef NCONV
#define NCONV 64
#endif
#ifndef LRU1_V2
#define LRU1_V2 1
#endif
#ifndef SGU_CONV_TASKS
#define SGU_CONV_TASKS 128
#endif
#ifndef LRU2_PARTS
#define LRU2_PARTS 8
#endif
#ifndef USE_PG8
#define USE_PG8 1
#endif

namespace pg8 {
#define PG8_LAS __attribute__((address_space(3)))
typedef unsigned short bf16_t;
typedef short bf16x8 __attribute__((ext_vector_type(8)));
typedef float f32x4 __attribute__((ext_vector_type(4)));
typedef unsigned u32x4 __attribute__((ext_vector_type(4)));
typedef int v4i_t __attribute__((ext_vector_type(4)));
typedef int v8i_t __attribute__((ext_vector_type(8)));
constexpr int BM = 256, BK = 64, HALF = 128, HTB = HALF * BK * 2  , STAGE_BYTES = 8 * HTB;

__host__ __device__ __forceinline__ int lds_byte(int r, int c) { const int st = (r >> 4) * 2 + (c >> 5), rr = r & 15, cc = c & 31, ob = rr * 64 + cc * 2; return st * 1024 + (ob ^ (((ob >> 9) & 1) << 5)); }
__host__ __device__ __forceinline__ void stage_rc(int b, int& R, int& C) { const int st = b / 1024, sb = b % 1024, swz = sb ^ (((sb >> 9) & 1) << 5); R = (st >> 1) * 16 + swz / 64; C = (st & 1) * 32 + (swz % 64) / 2; }

struct Unit { int pm, pn, pnB; };
struct Gemm { const bf16_t* A; const bf16_t* Bt; int K; };

template <class Epi>
__device__ __forceinline__ void run_epi8(const Epi& E, const f32x4 (&acc)[2][2][4][2], const Unit& u, int wr, int wc, int fr, int fq) {
#pragma unroll
    for (int ai = 0; ai < 2; ++ai)
#pragma unroll
        for (int m = 0; m < 4; ++m) { const int row = ai * HALF + wr * 64 + m * 16 + fr;
            if constexpr (Epi::PAIRED) E.st2x8(u, row, wc * 32 + 8 * fq, acc[ai][0][m][0], acc[ai][0][m][1], acc[ai][1][m][0], acc[ai][1][m][1]);
            else {
#pragma unroll
                for (int bj = 0; bj < 2; ++bj) E.st8(u, row, bj * HALF + wc * 32 + 8 * fq, acc[ai][bj][m][0], acc[ai][bj][m][1]);
            } }
}
template <class Epi>
__device__ __forceinline__ void run_epi(const Epi& E, const f32x4 (&acc)[2][2][4][2], const Unit& u, int wr, int wc, int fr, int fq) {
#pragma unroll
    for (int ai = 0; ai < 2; ++ai)
#pragma unroll
        for (int m = 0; m < 4; ++m) { const int row = ai * HALF + wr * 64 + m * 16 + fr;
            if constexpr (Epi::PAIRED) {
#pragma unroll
                for (int n = 0; n < 2; ++n) E.st2(u, row, wc * 32 + n * 16 + 4 * fq, acc[ai][0][m][n], acc[ai][1][m][n]);
            } else {
#pragma unroll
                for (int bj = 0; bj < 2; ++bj)
#pragma unroll
                    for (int n = 0; n < 2; ++n) E.st(u, row, bj * HALF + wc * 32 + n * 16 + 4 * fq, acc[ai][bj][m][n]);
            } }
}

template <class Epi, class Sched, bool ALIGN_EPI = false, bool SP2 = false>
__device__ __forceinline__ void gemm_phase(PG8_LAS unsigned char* lds, const Gemm g, const Sched& S, const Epi& E) {
    const int tid = threadIdx.x, wid = __builtin_amdgcn_readfirstlane(tid >> 6), lane = tid & 63, wr = wid >> 2, wc = wid & 3, fr = lane & 15, fq = lane >> 4;
    const int K = g.K, nt = K / BK;
    unsigned voffA[2], voffB[2];
#pragma unroll
    for (int i = 0; i < 2; ++i) { int R, C; stage_rc(tid * 16 + i * 8192, R, C); const int rho = R & 31, Rb = (R & ~31) + 8 * ((rho & 15) >> 2) + 4 * (rho >> 4) + (rho & 3);
        voffA[i] = (unsigned)(R * K + C) * 2u; voffB[i] = (unsigned)(Rb * K + C) * 2u; }
    const size_t kstep = (size_t)(BK * 2);
    const size_t hstep = (size_t)HALF * K * 2;
    const size_t tstep = 2 * hstep;
    const unsigned ldsw = (unsigned)wid * 1024u;
    const int aoff = lds_byte(wr * 64 + fr, fq * 8), boff = lds_byte(wc * 32 + fr, fq * 8);
#define PG8_SA(b, h) (((b) * 2 + (h)) * HTB)
#define PG8_SB(b, h) ((4 + (b) * 2 + (h)) * HTB)
#define PG8_STAGE(bufoff, gbase, voff) do { _Pragma("unroll") for (int _i = 0; _i < 2; ++_i) \
        __builtin_amdgcn_global_load_lds((const unsigned*)((const char*)(gbase) + (voff)[_i]), (PG8_LAS unsigned*)(lds + (bufoff) + ldsw + _i * 8192), 16, 0, 0); } while (0)
#define PG8_LDA(dst, b, h) do { _Pragma("unroll") for (int m = 0; m < 4; ++m) _Pragma("unroll") for (int k = 0; k < 2; ++k) dst[m][k] = *(const PG8_LAS bf16x8*)(lds + PG8_SA(b, h) + aoff + m * 2048 + k * 1024); } while (0)
#define PG8_LDB(dst, b, h) do { _Pragma("unroll") for (int n = 0; n < 2; ++n) _Pragma("unroll") for (int k = 0; k < 2; ++k) dst[n][k] = *(const PG8_LAS bf16x8*)(lds + PG8_SB(b, h) + boff + n * 2048 + k * 1024); } while (0)
#define PG8_MMA(ai, bj, At, Bt) do { __builtin_amdgcn_s_setprio(1); _Pragma("unroll") for (int m = 0; m < 4; ++m) _Pragma("unroll") for (int n = 0; n < 2; ++n) _Pragma("unroll") for (int k = 0; k < 2; ++k) \
        acc[ai][bj][m][n] = __builtin_amdgcn_mfma_f32_16x16x32_bf16(Bt[n][k], At[m][k], acc[ai][bj][m][n], 0, 0, 0); __builtin_amdgcn_s_setprio(0); } while (0)
#define PG8_WAIT_V(n) asm volatile("s_waitcnt vmcnt(" #n ")" ::: "memory")
#define PG8_WAIT_L(n) asm volatile("s_waitcnt lgkmcnt(" #n ")" ::: "memory")
#define PG8_BAR __builtin_amdgcn_s_barrier()
#define PG8_SCHED __builtin_amdgcn_sched_barrier(0)
    Unit cur, nxt; int ui = 0;
    if (!S.next(0, cur)) return;
    f32x4 acc[2][2][4][2];
#pragma unroll
    for (int a = 0; a < 2; ++a)
#pragma unroll
        for (int b = 0; b < 2; ++b)
#pragma unroll
            for (int m = 0; m < 4; ++m)
#pragma unroll
                for (int n = 0; n < 2; ++n) acc[a][b][m][n] = (f32x4){0.f, 0.f, 0.f, 0.f};
    bf16x8 At[4][2], B0[2][2], B1[2][2];
    const char* cA = (const char*)g.A + (size_t)cur.pm * tstep; const char* cB = (const char*)g.Bt + (size_t)cur.pnB * tstep;

    if constexpr (SP2) {
        PG8_STAGE(PG8_SB(0, 0), cB, voffB); PG8_STAGE(PG8_SB(0, 1), cB + hstep, voffB); PG8_STAGE(PG8_SA(0, 0), cA, voffA); PG8_STAGE(PG8_SA(0, 1), cA + hstep, voffA);
        if (wr == 1) PG8_BAR;
        PG8_WAIT_V(2); PG8_BAR;
        PG8_STAGE(PG8_SB(1, 0), cB + kstep, voffB); PG8_STAGE(PG8_SA(1, 0), cA + kstep, voffA); PG8_STAGE(PG8_SB(1, 1), cB + hstep + kstep, voffB);
        PG8_WAIT_V(6); PG8_BAR;
    } else {
        PG8_STAGE(PG8_SB(0, 0), cB, voffB); PG8_STAGE(PG8_SA(0, 0), cA, voffA); PG8_STAGE(PG8_SB(0, 1), cB + hstep, voffB); PG8_STAGE(PG8_SA(0, 1), cA + hstep, voffA);
        if (wr == 1) PG8_BAR;
        PG8_WAIT_V(4); PG8_BAR;
        PG8_STAGE(PG8_SB(1, 0), cB + kstep, voffB); PG8_STAGE(PG8_SA(1, 0), cA + kstep, voffA); PG8_STAGE(PG8_SB(1, 1), cB + hstep + kstep, voffB);
        PG8_WAIT_V(6); PG8_BAR;
    }
    for (;;) {
        const bool has_next = S.next(ui + 1, nxt);
        const char* nA = has_next ? (const char*)g.A + (size_t)nxt.pm * tstep : cA; const char* nB = has_next ? (const char*)g.Bt + (size_t)nxt.pnB * tstep : cB;
        for (int t = 0; t < nt; t += 2) {
            const bool last = (t == nt - 2);
            const char* a1 = cA + (size_t)(t + 1) * kstep;
            const char* a2 = last ? nA : cA + (size_t)(t + 2) * kstep; const char* b2 = last ? nB : cB + (size_t)(t + 2) * kstep;
            const char* a3 = a2 + kstep; const char* b3 = b2 + kstep;

            if constexpr (SP2) {
            PG8_LDB(B0, 0, 0); PG8_LDB(B1, 0, 1); PG8_SCHED; PG8_LDA(At, 0, 0); PG8_STAGE(PG8_SA(1, 1), a1 + hstep, voffA);
            PG8_WAIT_V(8); PG8_WAIT_L(0); PG8_BAR; PG8_MMA(0, 0, At, B0); PG8_MMA(0, 1, At, B1); PG8_BAR; PG8_SCHED;
            PG8_LDA(At, 0, 1); PG8_STAGE(PG8_SB(0, 0), b2, voffB); PG8_STAGE(PG8_SB(0, 1), b2 + hstep, voffB); PG8_STAGE(PG8_SA(0, 0), a2, voffA);
            PG8_WAIT_V(8); PG8_WAIT_L(0); PG8_BAR; PG8_MMA(1, 0, At, B0); PG8_MMA(1, 1, At, B1); PG8_BAR; PG8_SCHED;
            PG8_LDB(B0, 1, 0); PG8_LDB(B1, 1, 1); PG8_SCHED; PG8_LDA(At, 1, 0); PG8_STAGE(PG8_SA(0, 1), a2 + hstep, voffA);
            PG8_WAIT_V(8); PG8_WAIT_L(0); PG8_BAR; PG8_MMA(0, 0, At, B0); PG8_MMA(0, 1, At, B1); PG8_BAR; PG8_SCHED;
            PG8_LDA(At, 1, 1); PG8_STAGE(PG8_SB(1, 0), b3, voffB); PG8_STAGE(PG8_SB(1, 1), b3 + hstep, voffB); PG8_STAGE(PG8_SA(1, 0), a3, voffA);
            PG8_WAIT_V(8); PG8_WAIT_L(0); PG8_BAR; PG8_MMA(1, 0, At, B0); PG8_MMA(1, 1, At, B1); PG8_BAR; PG8_SCHED;
            } else {
            PG8_LDB(B0, 0, 0); PG8_SCHED; PG8_LDA(At, 0, 0); PG8_STAGE(PG8_SA(1, 1), a1 + hstep, voffA);
            PG8_WAIT_L(8); PG8_BAR; PG8_WAIT_L(0); PG8_MMA(0, 0, At, B0); PG8_BAR; PG8_SCHED;
            PG8_LDB(B1, 0, 1); PG8_STAGE(PG8_SB(0, 0), b2, voffB);
            PG8_BAR; PG8_WAIT_L(0); PG8_MMA(0, 1, At, B1); PG8_BAR;
            PG8_LDA(At, 0, 1); PG8_STAGE(PG8_SA(0, 0), a2, voffA);
            PG8_BAR; PG8_WAIT_L(0); PG8_MMA(1, 0, At, B0); PG8_BAR; PG8_SCHED;
            PG8_STAGE(PG8_SB(0, 1), b2 + hstep, voffB);
            PG8_WAIT_V(6); PG8_BAR; PG8_MMA(1, 1, At, B1); PG8_BAR;
            PG8_LDB(B0, 1, 0); PG8_SCHED; PG8_LDA(At, 1, 0); PG8_STAGE(PG8_SA(0, 1), a2 + hstep, voffA);
            PG8_WAIT_L(8); PG8_BAR; PG8_WAIT_L(0); PG8_MMA(0, 0, At, B0); PG8_BAR; PG8_SCHED;
            PG8_LDB(B1, 1, 1); PG8_STAGE(PG8_SB(1, 0), b3, voffB);
            PG8_BAR; PG8_WAIT_L(0); PG8_MMA(0, 1, At, B1); PG8_BAR;
            PG8_LDA(At, 1, 1); PG8_STAGE(PG8_SA(1, 0), a3, voffA);
            PG8_BAR; PG8_WAIT_L(0); PG8_MMA(1, 0, At, B0); PG8_BAR; PG8_SCHED;
            PG8_STAGE(PG8_SB(1, 1), b3 + hstep, voffB);
            PG8_WAIT_V(6); PG8_BAR; PG8_MMA(1, 1, At, B1); PG8_BAR;
            }
        }
        if constexpr (ALIGN_EPI) { if (wr == 0) PG8_BAR; }
        if constexpr (!Epi::FUSED) run_epi8(E, acc, cur, wr, wc, fr, fq);
        if (!has_next) break;
#pragma unroll
        for (int a = 0; a < 2; ++a)
#pragma unroll
            for (int b = 0; b < 2; ++b)
#pragma unroll
                for (int m = 0; m < 4; ++m)
#pragma unroll
                    for (int n = 0; n < 2; ++n) acc[a][b][m][n] = (f32x4){0.f, 0.f, 0.f, 0.f};
        cur = nxt; cA = nA; cB = nB; ++ui;
        if constexpr (ALIGN_EPI) { if (wr == 1) PG8_BAR; }
    }
    PG8_WAIT_V(0);
    if constexpr (!ALIGN_EPI) { if (wr == 0) PG8_BAR; }
    PG8_BAR;
    if constexpr (Epi::FUSED) E.fused(acc, cur, wr, wc, fr, fq, lds, wid, lane);

#undef PG8_SA
#undef PG8_SB
#undef PG8_STAGE
#undef PG8_LDA
#undef PG8_LDB
#undef PG8_MMA
#undef PG8_WAIT_V
#undef PG8_WAIT_L
#undef PG8_BAR
#undef PG8_SCHED
}

template <class Epi, class Sched, bool ALIGN_EPI = false, bool SP2 = false>
__device__ __forceinline__ void gemm_phase_f8(PG8_LAS unsigned char* lds, const Gemm g, const Sched& S, const Epi& E) {
    const int tid = threadIdx.x, wid = __builtin_amdgcn_readfirstlane(tid >> 6), lane = tid & 63, wr = wid >> 2, wc = wid & 3, fr = lane & 15, fq = lane >> 4;
    const int RP = g.K, nt = RP / 128;
    unsigned voffA[2], voffB[2];
#pragma unroll
    for (int i = 0; i < 2; ++i) { const int b_ = tid * 16 + i * 8192, R = b_ >> 7, pp = (b_ >> 4) & 7, rr_ = R & 15, ff = ((rr_ >> 1) & 1) | (((rr_ >> 3) & 1) << 2);
        const int rho = R & 31, Rb = (R & ~31) + 8 * ((rho & 15) >> 2) + 4 * (rho >> 4) + (rho & 3);
        voffA[i] = (unsigned)(R * RP + ((pp ^ ff) * 16)); voffB[i] = (unsigned)(Rb * RP + ((pp ^ ff) * 16)); }
    const size_t kstep = (size_t)(BK * 2);
    const size_t hstep = (size_t)HALF * RP;
    const size_t tstep = 2 * hstep;
    const unsigned ldsw = (unsigned)wid * 1024u;
    const int ffr = ((fr >> 1) & 1) | (((fr >> 3) & 1) << 2);
    const int aoff = (wr * 64 + fr) * 128 + (((2 * fq) ^ ffr) * 16), boff = (wc * 32 + fr) * 128 + (((2 * fq) ^ ffr) * 16), hoff = (ffr & 1) ? -16 : 16;
#define PG8_SA(b, h) (((b) * 2 + (h)) * HTB)
#define PG8_SB(b, h) ((4 + (b) * 2 + (h)) * HTB)
#define PG8_STAGE(bufoff, gbase, voff) do { _Pragma("unroll") for (int _i = 0; _i < 2; ++_i) \
        __builtin_amdgcn_global_load_lds((const unsigned*)((const char*)(gbase) + (voff)[_i]), (PG8_LAS unsigned*)(lds + (bufoff) + ldsw + _i * 8192), 16, 0, 0); } while (0)
#define PG8_LDA(dst, b, h) do { _Pragma("unroll") for (int m = 0; m < 4; ++m) { dst[m].lo = *(const PG8_LAS v4i_t*)(lds + PG8_SA(b, h) + aoff + m * 2048); dst[m].hi = *(const PG8_LAS v4i_t*)(lds + PG8_SA(b, h) + aoff + m * 2048 + hoff); } } while (0)
#define PG8_LDB(dst, b, h) do { _Pragma("unroll") for (int n = 0; n < 2; ++n) { dst[n].lo = *(const PG8_LAS v4i_t*)(lds + PG8_SB(b, h) + boff + n * 2048); dst[n].hi = *(const PG8_LAS v4i_t*)(lds + PG8_SB(b, h) + boff + n * 2048 + hoff); } } while (0)
#define PG8_MMA(ai, bj, At, Bt) do { __builtin_amdgcn_s_setprio(1); _Pragma("unroll") for (int m = 0; m < 4; ++m) _Pragma("unroll") for (int n = 0; n < 2; ++n) \
        asm volatile("v_mfma_f32_16x16x128_f8f6f4 %0, %1, %2, %0" : "+v"(acc[ai][bj][m][n]) : "v"(Bt[n]), "v"(At[m])); __builtin_amdgcn_s_setprio(0); } while (0)
#define PG8_WAIT_V(n) asm volatile("s_waitcnt vmcnt(" #n ")" ::: "memory")
#define PG8_WAIT_L(n) asm volatile("s_waitcnt lgkmcnt(" #n ")" ::: "memory")
#define PG8_BAR __builtin_amdgcn_s_barrier()
#define PG8_SCHED __builtin_amdgcn_sched_barrier(0)
    Unit cur, nxt; int ui = 0;
    if (!S.next(0, cur)) return;
    f32x4 acc[2][2][4][2];
#pragma unroll
    for (int a = 0; a < 2; ++a)
#pragma unroll
        for (int b = 0; b < 2; ++b)
#pragma unroll
            for (int m = 0; m < 4; ++m)
#pragma unroll
                for (int n = 0; n < 2; ++n) acc[a][b][m][n] = (f32x4){0.f, 0.f, 0.f, 0.f};
    v8i_t At[4], B0[2], B1[2];
    const char* cA = (const char*)g.A + (size_t)cur.pm * tstep; const char* cB = (const char*)g.Bt + (size_t)cur.pnB * tstep;

    if constexpr (SP2) {
        PG8_STAGE(PG8_SB(0, 0), cB, voffB); PG8_STAGE(PG8_SB(0, 1), cB + hstep, voffB); PG8_STAGE(PG8_SA(0, 0), cA, voffA); PG8_STAGE(PG8_SA(0, 1), cA + hstep, voffA);
        if (wr == 1) PG8_BAR;
        PG8_WAIT_V(2); PG8_BAR;
        PG8_STAGE(PG8_SB(1, 0), cB + kstep, voffB); PG8_STAGE(PG8_SA(1, 0), cA + kstep, voffA); PG8_STAGE(PG8_SB(1, 1), cB + hstep + kstep, voffB);
        PG8_WAIT_V(6); PG8_BAR;
    } else {
        PG8_STAGE(PG8_SB(0, 0), cB, voffB); PG8_STAGE(PG8_SA(0, 0), cA, voffA); PG8_STAGE(PG8_SB(0, 1), cB + hstep, voffB); PG8_STAGE(PG8_SA(0, 1), cA + hstep, voffA);
        if (wr == 1) PG8_BAR;
        PG8_WAIT_V(4); PG8_BAR;
        PG8_STAGE(PG8_SB(1, 0), cB + kstep, voffB); PG8_STAGE(PG8_SA(1, 0), cA + kstep, voffA); PG8_STAGE(PG8_SB(1, 1), cB + hstep + kstep, voffB);
        PG8_WAIT_V(6); PG8_BAR;
    }
    for (;;) {
        const bool has_next = S.next(ui + 1, nxt);
        const char* nA = has_next ? (const char*)g.A + (size_t)nxt.pm * tstep : cA; const char* nB = has_next ? (const char*)g.Bt + (size_t)nxt.pnB * tstep : cB;
        for (int t = 0; t < nt; t += 2) {
            const bool last = (t == nt - 2);
            const char* a1 = cA + (size_t)(t + 1) * kstep;
            const char* a2 = last ? nA : cA + (size_t)(t + 2) * kstep; const char* b2 = last ? nB : cB + (size_t)(t + 2) * kstep;
            const char* a3 = a2 + kstep; const char* b3 = b2 + kstep;

            if constexpr (SP2) {
            PG8_LDB(B0, 0, 0); PG8_LDB(B1, 0, 1); PG8_SCHED; PG8_LDA(At, 0, 0); PG8_STAGE(PG8_SA(1, 1), a1 + hstep, voffA);
            PG8_WAIT_V(8); PG8_WAIT_L(0); PG8_BAR; PG8_MMA(0, 0, At, B0); PG8_MMA(0, 1, At, B1); PG8_BAR; PG8_SCHED;
            PG8_LDA(At, 0, 1); PG8_STAGE(PG8_SB(0, 0), b2, voffB); PG8_STAGE(PG8_SB(0, 1), b2 + hstep, voffB); PG8_STAGE(PG8_SA(0, 0), a2, voffA);
            PG8_WAIT_V(8); PG8_WAIT_L(0); PG8_BAR; PG8_MMA(1, 0, At, B0); PG8_MMA(1, 1, At, B1); PG8_BAR; PG8_SCHED;
            PG8_LDB(B0, 1, 0); PG8_LDB(B1, 1, 1); PG8_SCHED; PG8_LDA(At, 1, 0); PG8_STAGE(PG8_SA(0, 1), a2 + hstep, voffA);
            PG8_WAIT_V(8); PG8_WAIT_L(0); PG8_BAR; PG8_MMA(0, 0, At, B0); PG8_MMA(0, 1, At, B1); PG8_BAR; PG8_SCHED;
            PG8_LDA(At, 1, 1); PG8_STAGE(PG8_SB(1, 0), b3, voffB); PG8_STAGE(PG8_SB(1, 1), b3 + hstep, voffB); PG8_STAGE(PG8_SA(1, 0), a3, voffA);
            PG8_WAIT_V(8); PG8_WAIT_L(0); PG8_BAR; PG8_MMA(1, 0, At, B0); PG8_MMA(1, 1, At, B1); PG8_BAR; PG8_SCHED;
            } else {
            PG8_LDB(B0, 0, 0); PG8_SCHED; PG8_LDA(At, 0, 0); PG8_STAGE(PG8_SA(1, 1), a1 + hstep, voffA);
            PG8_WAIT_L(8); PG8_BAR; PG8_WAIT_L(0); PG8_MMA(0, 0, At, B0); PG8_BAR; PG8_SCHED;
            PG8_LDB(B1, 0, 1); PG8_STAGE(PG8_SB(0, 0), b2, voffB);
            PG8_BAR; PG8_WAIT_L(0); PG8_MMA(0, 1, At, B1); PG8_BAR;
            PG8_LDA(At, 0, 1); PG8_STAGE(PG8_SA(0, 0), a2, voffA);
            PG8_BAR; PG8_WAIT_L(0); PG8_MMA(1, 0, At, B0); PG8_BAR; PG8_SCHED;
            PG8_STAGE(PG8_SB(0, 1), b2 + hstep, voffB);
            PG8_WAIT_V(6); PG8_BAR; PG8_MMA(1, 1, At, B1); PG8_BAR;
            PG8_LDB(B0, 1, 0); PG8_SCHED; PG8_LDA(At, 1, 0); PG8_STAGE(PG8_SA(0, 1), a2 + hstep, voffA);
            PG8_WAIT_L(8); PG8_BAR; PG8_WAIT_L(0); PG8_MMA(0, 0, At, B0); PG8_BAR; PG8_SCHED;
            PG8_LDB(B1, 1, 1); PG8_STAGE(PG8_SB(1, 0), b3, voffB);
            PG8_BAR; PG8_WAIT_L(0); PG8_MMA(0, 1, At, B1); PG8_BAR;
            PG8_LDA(At, 1, 1); PG8_STAGE(PG8_SA(1, 0), a3, voffA);
            PG8_BAR; PG8_WAIT_L(0); PG8_MMA(1, 0, At, B0); PG8_BAR; PG8_SCHED;
            PG8_STAGE(PG8_SB(1, 1), b3 + hstep, voffB);
            PG8_WAIT_V(6); PG8_BAR; PG8_MMA(1, 1, At, B1); PG8_BAR;
            }
        }
        asm volatile("s_nop 15\n\ts_nop 15" ::: "memory");
        if constexpr (ALIGN_EPI) { if (wr == 0) PG8_BAR; }
        run_epi8(E, acc, cur, wr, wc, fr, fq);
        if (!has_next) break;
#pragma unroll
        for (int a = 0; a < 2; ++a)
#pragma unroll
            for (int b = 0; b < 2; ++b)
#pragma unroll
                for (int m = 0; m < 4; ++m)
#pragma unroll
                    for (int n = 0; n < 2; ++n) acc[a][b][m][n] = (f32x4){0.f, 0.f, 0.f, 0.f};
        cur = nxt; cA = nA; cB = nB; ++ui;
        if constexpr (ALIGN_EPI) { if (wr == 1) PG8_BAR; }
    }
    PG8_WAIT_V(0);
    if constexpr (!ALIGN_EPI) { if (wr == 0) PG8_BAR; }
    PG8_BAR;

#undef PG8_SA
#undef PG8_SB
#undef PG8_STAGE
#undef PG8_LDA
#undef PG8_LDB
#undef PG8_MMA
#undef PG8_WAIT_V
#undef PG8_WAIT_L
#undef PG8_BAR
#undef PG8_SCHED
}

template <class Epi, class Sched, bool ALIGN_EPI = false, bool SP2 = false>
__device__ __forceinline__ void gemm_phase_f8g(PG8_LAS unsigned char* lds, const Gemm g, const Sched& S, const Epi& E, const int* tok) {
    const int tid = threadIdx.x, wid = __builtin_amdgcn_readfirstlane(tid >> 6), lane = tid & 63, wr = wid >> 2, wc = wid & 3, fr = lane & 15, fq = lane >> 4;
    const int RP = g.K, nt = RP / 128;
    unsigned voffA[2], voffB[2]; int rowA[2];
#pragma unroll
    for (int i = 0; i < 2; ++i) { const int b_ = tid * 16 + i * 8192, R = b_ >> 7, pp = (b_ >> 4) & 7, rr_ = R & 15, ff = ((rr_ >> 1) & 1) | (((rr_ >> 3) & 1) << 2);
        const int rho = R & 31, Rb = (R & ~31) + 8 * ((rho & 15) >> 2) + 4 * (rho >> 4) + (rho & 3);
        voffA[i] = (unsigned)((pp ^ ff) * 16); rowA[i] = R; voffB[i] = (unsigned)(Rb * RP + ((pp ^ ff) * 16)); }
    const size_t kstep = (size_t)(BK * 2);
    const size_t hstep = (size_t)HALF * RP;
    const size_t tstep = 2 * hstep;
    const unsigned ldsw = (unsigned)wid * 1024u;
    const int ffr = ((fr >> 1) & 1) | (((fr >> 3) & 1) << 2);
    const int aoff = (wr * 64 + fr) * 128 + (((2 * fq) ^ ffr) * 16), boff = (wc * 32 + fr) * 128 + (((2 * fq) ^ ffr) * 16), hoff = (ffr & 1) ? -16 : 16;
#define PG8_SA(b, h) (((b) * 2 + (h)) * HTB)
#define PG8_SB(b, h) ((4 + (b) * 2 + (h)) * HTB)
#define PG8_STAGE(bufoff, gbase, voff) do { _Pragma("unroll") for (int _i = 0; _i < 2; ++_i) \
        __builtin_amdgcn_global_load_lds((const unsigned*)((const char*)(gbase) + (voff)[_i]), (PG8_LAS unsigned*)(lds + (bufoff) + ldsw + _i * 8192), 16, 0, 0); } while (0)
#define PG8_LDA(dst, b, h) do { _Pragma("unroll") for (int m = 0; m < 4; ++m) { dst[m].lo = *(const PG8_LAS v4i_t*)(lds + PG8_SA(b, h) + aoff + m * 2048); dst[m].hi = *(const PG8_LAS v4i_t*)(lds + PG8_SA(b, h) + aoff + m * 2048 + hoff); } } while (0)
#define PG8_LDB(dst, b, h) do { _Pragma("unroll") for (int n = 0; n < 2; ++n) { dst[n].lo = *(const PG8_LAS v4i_t*)(lds + PG8_SB(b, h) + boff + n * 2048); dst[n].hi = *(const PG8_LAS v4i_t*)(lds + PG8_SB(b, h) + boff + n * 2048 + hoff); } } while (0)
#define PG8_MMA(ai, bj, At, Bt) do { __builtin_amdgcn_s_setprio(1); _Pragma("unroll") for (int m = 0; m < 4; ++m) _Pragma("unroll") for (int n = 0; n < 2; ++n) \
        asm volatile("v_mfma_f32_16x16x128_f8f6f4 %0, %1, %2, %0" : "+v"(acc[ai][bj][m][n]) : "v"(Bt[n]), "v"(At[m])); __builtin_amdgcn_s_setprio(0); } while (0)
#define PG8_WAIT_V(n) asm volatile("s_waitcnt vmcnt(" #n ")" ::: "memory")
#define PG8_WAIT_L(n) asm volatile("s_waitcnt lgkmcnt(" #n ")" ::: "memory")
#define PG8_BAR __builtin_amdgcn_s_barrier()
#define PG8_SCHED __builtin_amdgcn_sched_barrier(0)
    Unit cur, nxt; int ui = 0;
    if (!S.next(0, cur)) return;
    f32x4 acc[2][2][4][2];
#pragma unroll
    for (int a = 0; a < 2; ++a)
#pragma unroll
        for (int b = 0; b < 2; ++b)
#pragma unroll
            for (int m = 0; m < 4; ++m)
#pragma unroll
                for (int n = 0; n < 2; ++n) acc[a][b][m][n] = (f32x4){0.f, 0.f, 0.f, 0.f};
    v8i_t At[4], B0[2], B1[2];
    const char* cA = (const char*)g.A; const char* cB = (const char*)g.Bt + (size_t)cur.pnB * tstep;
    unsigned vC[2][2], vN[2][2] = {{0u, 0u}, {0u, 0u}};
#define PG8_TOKOFF(dst, pm_) do { _Pragma("unroll") for (int h_ = 0; h_ < 2; ++h_) _Pragma("unroll") for (int i_ = 0; i_ < 2; ++i_) dst[h_][i_] = (unsigned)tok[(pm_) * 256 + h_ * 128 + rowA[i_]] * (unsigned)RP + voffA[i_]; } while (0)
    PG8_TOKOFF(vC, cur.pm);

    if constexpr (SP2) {
        PG8_STAGE(PG8_SB(0, 0), cB, voffB); PG8_STAGE(PG8_SB(0, 1), cB + hstep, voffB); PG8_STAGE(PG8_SA(0, 0), cA, vC[0]); PG8_STAGE(PG8_SA(0, 1), cA, vC[1]);
        if (wr == 1) PG8_BAR;
        PG8_WAIT_V(2); PG8_BAR;
        PG8_STAGE(PG8_SB(1, 0), cB + kstep, voffB); PG8_STAGE(PG8_SA(1, 0), cA + kstep, vC[0]); PG8_STAGE(PG8_SB(1, 1), cB + hstep + kstep, voffB);
        PG8_WAIT_V(6); PG8_BAR;
    } else {
        PG8_STAGE(PG8_SB(0, 0), cB, voffB); PG8_STAGE(PG8_SA(0, 0), cA, vC[0]); PG8_STAGE(PG8_SB(0, 1), cB + hstep, voffB); PG8_STAGE(PG8_SA(0, 1), cA, vC[1]);
        if (wr == 1) PG8_BAR;
        PG8_WAIT_V(4); PG8_BAR;
        PG8_STAGE(PG8_SB(1, 0), cB + kstep, voffB); PG8_STAGE(PG8_SA(1, 0), cA + kstep, vC[0]); PG8_STAGE(PG8_SB(1, 1), cB + hstep + kstep, voffB);
        PG8_WAIT_V(6); PG8_BAR;
    }
    for (;;) {
        const bool has_next = S.next(ui + 1, nxt);
        const char* nB = has_next ? (const char*)g.Bt + (size_t)nxt.pnB * tstep : cB;
        int tkN[2][2] = {{0, 0}, {0, 0}};
        if (has_next) { _Pragma("unroll") for (int h_ = 0; h_ < 2; ++h_) _Pragma("unroll") for (int i_ = 0; i_ < 2; ++i_) tkN[h_][i_] = tok[nxt.pm * 256 + h_ * 128 + rowA[i_]]; }
        for (int t = 0; t < nt; t += 2) {
            const bool last = (t == nt - 2);
            const char* a1 = cA + (size_t)(t + 1) * kstep;
            const char* a2 = last ? cA : cA + (size_t)(t + 2) * kstep; const char* b2 = last ? nB : cB + (size_t)(t + 2) * kstep;
            unsigned vs0[2] = {vC[0][0], vC[0][1]}, vs1[2] = {vC[1][0], vC[1][1]};
            if (last && has_next) { asm volatile("" : "+v"(tkN[0][0]), "+v"(tkN[0][1]), "+v"(tkN[1][0]), "+v"(tkN[1][1]));
                _Pragma("unroll") for (int h_ = 0; h_ < 2; ++h_) _Pragma("unroll") for (int i_ = 0; i_ < 2; ++i_) vN[h_][i_] = (unsigned)tkN[h_][i_] * (unsigned)RP + voffA[i_];
                vs0[0] = vN[0][0]; vs0[1] = vN[0][1]; vs1[0] = vN[1][0]; vs1[1] = vN[1][1]; }
            const char* a3 = a2 + kstep; const char* b3 = b2 + kstep;

            if constexpr (SP2) {
            PG8_LDB(B0, 0, 0); PG8_LDB(B1, 0, 1); PG8_SCHED; PG8_LDA(At, 0, 0); PG8_STAGE(PG8_SA(1, 1), a1, vC[1]);
            PG8_WAIT_V(8); PG8_WAIT_L(0); PG8_BAR; PG8_MMA(0, 0, At, B0); PG8_MMA(0, 1, At, B1); PG8_BAR; PG8_SCHED;
            PG8_LDA(At, 0, 1); PG8_STAGE(PG8_SB(0, 0), b2, voffB); PG8_STAGE(PG8_SB(0, 1), b2 + hstep, voffB); PG8_STAGE(PG8_SA(0, 0), a2, vs0);
            PG8_WAIT_V(8); PG8_WAIT_L(0); PG8_BAR; PG8_MMA(1, 0, At, B0); PG8_MMA(1, 1, At, B1); PG8_BAR; PG8_SCHED;
            PG8_LDB(B0, 1, 0); PG8_LDB(B1, 1, 1); PG8_SCHED; PG8_LDA(At, 1, 0); PG8_STAGE(PG8_SA(0, 1), a2, vs1);
            PG8_WAIT_V(8); PG8_WAIT_L(0); PG8_BAR; PG8_MMA(0, 0, At, B0); PG8_MMA(0, 1, At, B1); PG8_BAR; PG8_SCHED;
            PG8_LDA(At, 1, 1); PG8_STAGE(PG8_SB(1, 0), b3, voffB); PG8_STAGE(PG8_SB(1, 1), b3 + hstep, voffB); PG8_STAGE(PG8_SA(1, 0), a3, vs0);
            PG8_WAIT_V(8); PG8_WAIT_L(0); PG8_BAR; PG8_MMA(1, 0, At, B0); PG8_MMA(1, 1, At, B1); PG8_BAR; PG8_SCHED;
            } else {
            PG8_LDB(B0, 0, 0); PG8_SCHED; PG8_LDA(At, 0, 0); PG8_STAGE(PG8_SA(1, 1), a1, vC[1]);
            PG8_WAIT_L(8); PG8_BAR; PG8_WAIT_L(0); PG8_MMA(0, 0, At, B0); PG8_BAR; PG8_SCHED;
            PG8_LDB(B1, 0, 1); PG8_STAGE(PG8_SB(0, 0), b2, voffB);
            PG8_BAR; PG8_WAIT_L(0); PG8_MMA(0, 1, At, B1); PG8_BAR;
            PG8_LDA(At, 0, 1); PG8_STAGE(PG8_SA(0, 0), a2, vs0);
            PG8_BAR; PG8_WAIT_L(0); PG8_MMA(1, 0, At, B0); PG8_BAR; PG8_SCHED;
            PG8_STAGE(PG8_SB(0, 1), b2 + hstep, voffB);
            PG8_WAIT_V(6); PG8_BAR; PG8_MMA(1, 1, At, B1); PG8_BAR;
            PG8_LDB(B0, 1, 0); PG8_SCHED; PG8_LDA(At, 1, 0); PG8_STAGE(PG8_SA(0, 1), a2, vs1);
            PG8_WAIT_L(8); PG8_BAR; PG8_WAIT_L(0); PG8_MMA(0, 0, At, B0); PG8_BAR; PG8_SCHED;
            PG8_LDB(B1, 1, 1); PG8_STAGE(PG8_SB(1, 0), b3, voffB);
            PG8_BAR; PG8_WAIT_L(0); PG8_MMA(0, 1, At, B1); PG8_BAR;
            PG8_LDA(At, 1, 1); PG8_STAGE(PG8_SA(1, 0), a3, vs0);
            PG8_BAR; PG8_WAIT_L(0); PG8_MMA(1, 0, At, B0); PG8_BAR; PG8_SCHED;
            PG8_STAGE(PG8_SB(1, 1), b3 + hstep, voffB);
            PG8_WAIT_V(6); PG8_BAR; PG8_MMA(1, 1, At, B1); PG8_BAR;
            }
        }
        asm volatile("s_nop 15\n\ts_nop 15" ::: "memory");
        if constexpr (ALIGN_EPI) { if (wr == 0) PG8_BAR; }
        run_epi8(E, acc, cur, wr, wc, fr, fq);
        if (!has_next) break;
#pragma unroll
        for (int a = 0; a < 2; ++a)
#pragma unroll
            for (int b = 0; b < 2; ++b)
#pragma unroll
                for (int m = 0; m < 4; ++m)
#pragma unroll
                    for (int n = 0; n < 2; ++n) acc[a][b][m][n] = (f32x4){0.f, 0.f, 0.f, 0.f};
        cur = nxt; cB = nB; ++ui; vC[0][0] = vN[0][0]; vC[0][1] = vN[0][1]; vC[1][0] = vN[1][0]; vC[1][1] = vN[1][1];
        if constexpr (ALIGN_EPI) { if (wr == 1) PG8_BAR; }
    }
    PG8_WAIT_V(0);
    if constexpr (!ALIGN_EPI) { if (wr == 0) PG8_BAR; }
    PG8_BAR;

#undef PG8_TOKOFF
#undef PG8_SA
#undef PG8_SB
#undef PG8_STAGE
#undef PG8_LDA
#undef PG8_LDB
#undef PG8_MMA
#undef PG8_WAIT_V
#undef PG8_WAIT_L
#undef PG8_BAR
#undef PG8_SCHED
}
}

constexpr int D = 1024, BATCH = 8, SEQ = 2048, CTXL = 256;
constexpr int M = BATCH * SEQ;
constexpr int MC = BATCH * CTXL;
constexpr int MT = M + MC;
constexpr int DIN = 2048, DSGU = 512, DLRU = 512, NE = 16, CAP = 256, DE = 2048, NMOD = 6 * D;
constexpr int NSEG = 36;
constexpr float EPS = 1e-6f;
constexpr int NWAVES = 8, NTHREADS = 512;
constexpr int LDS_BYTES = 147456;
constexpr int NPH = 11;

constexpr size_t MiB = 1u << 20;
constexpr size_t WS_CTL = 0;
constexpr size_t WS_MOD = 1 * MiB;
constexpr size_t WS_SUM = 1 * MiB + 512 * 1024;
constexpr size_t WS_AFF = 4 * MiB;
constexpr size_t WS_SLOT = 5 * MiB;
constexpr size_t WS_GATE = 6 * MiB;
constexpr size_t WS_TOK = 6 * MiB + 128 * 1024;
constexpr size_t WS_GWT = 6 * MiB + 512 * 1024;
constexpr size_t WS_SWB = 7 * MiB;
constexpr size_t WS_WIN = 8 * MiB;
constexpr size_t WS_WOUT = 12 * MiB;
constexpr size_t WS_WG = 14 * MiB;
constexpr size_t WS_W2 = 142 * MiB;
constexpr size_t WS_X1 = 206 * MiB;
constexpr size_t WS_HS = 206 * MiB, WS_PF = 222 * MiB, WS_PB = 238 * MiB;
constexpr size_t WS_HX2 = 270 * MiB;
constexpr size_t WS_XCH = 286 * MiB;
constexpr size_t WS_CB = 1 * MiB + 256 * 1024;
constexpr size_t WS_XE = 302 * MiB;
constexpr size_t WS_A2 = 302 * MiB, WS_YE = 302 * MiB;
constexpr size_t WS_HID = 366 * MiB;
constexpr size_t WS_HX = 366 * MiB;
constexpr size_t WS_UV = 402 * MiB;
constexpr size_t WS_XC = 466 * MiB;
constexpr size_t WS_END = 494 * MiB;

#define GAS __attribute__((address_space(1)))
#define LAS __attribute__((address_space(3)))
typedef unsigned short bf16;
typedef unsigned v4u __attribute__((ext_vector_type(4)));
typedef unsigned v2u __attribute__((ext_vector_type(2)));
typedef float f32x4 __attribute__((ext_vector_type(4)));
typedef short bf16x8 __attribute__((ext_vector_type(8)));
#define LDS_WAIT() asm volatile("s_waitcnt lgkmcnt(0)" ::: "memory")

__device__ __forceinline__ float bf2f(bf16 b) { return __uint_as_float(((unsigned)b) << 16); }
__device__ __forceinline__ unsigned f2bf(float f) { unsigned u = __float_as_uint(f); return (u + 0x7fffu + ((u >> 16) & 1u)) >> 16; }
typedef __bf16 bf16x2_hw __attribute__((ext_vector_type(2)));
typedef float f32x2_hw __attribute__((ext_vector_type(2)));
__device__ __forceinline__ unsigned pk2(float lo, float hi) { const f32x2_hw v = {lo, hi}; return __builtin_bit_cast(unsigned, __builtin_convertvector(v, bf16x2_hw)); }
__device__ __forceinline__ float bflo(unsigned w) { return __uint_as_float(w << 16); }
__device__ __forceinline__ float bfhi(unsigned w) { return __uint_as_float(w & 0xffff0000u); }
__device__ __forceinline__ float rcpf_(float x) { return __builtin_amdgcn_rcpf(x); }
__device__ __forceinline__ float exp2f_(float x) { return __builtin_amdgcn_exp2f(x); }
__device__ __forceinline__ float sigmoidf_(float x) { return rcpf_(1.f + exp2f_(-1.4426950408889634f * x)); }
__device__ __forceinline__ float siluf_(float x) { return x * rcpf_(1.f + exp2f_(-1.4426950408889634f * x)); }
__device__ __forceinline__ float geluf_(float x) { const float u = x * (0.7978845608028654f + 0.035677408136300125f * x * x); return x * rcpf_(1.f + exp2f_(-2.8853900817779268f * u)); }
__device__ __forceinline__ void decay_pair(float la, float& a, float& s) {
    const float x = 2.f * la;
    const float p1 = la * (1.f + la * (0.5f + la * (0.16666667f + la * (0.041666668f + la * 0.0083333333f))));
    const float p2 = x * (1.f + x * (0.5f + x * (0.16666667f + x * (0.041666668f + x * (0.0083333333f + x * 0.0013888889f)))));
    const float e1 = exp2f_(1.4426950408889634f * la);
    const bool small = la > -0.15f;
    a = small ? 1.f + p1 : e1;
    s = __builtin_amdgcn_sqrtf(small ? -p2 : 1.f - e1 * e1);
}
typedef float f32x2p __attribute__((ext_vector_type(2)));
__device__ __forceinline__ f32x2p sigmoid2_(f32x2p x) { const f32x2p t = x * -1.4426950408889634f; f32x2p e; e.x = exp2f_(t.x); e.y = exp2f_(t.y); e = e + 1.f; f32x2p r; r.x = rcpf_(e.x); r.y = rcpf_(e.y); return r; }
__device__ __forceinline__ f32x2p gelu2_(f32x2p x) { const f32x2p u = x * (x * x * 0.035677408136300125f + 0.7978845608028654f), t = u * -2.8853900817779268f; f32x2p e; e.x = exp2f_(t.x); e.y = exp2f_(t.y); e = e + 1.f;
    f32x2p r; r.x = rcpf_(e.x); r.y = rcpf_(e.y); return x * r; }
__device__ __forceinline__ void decay_pair2(f32x2p la, f32x2p& a, f32x2p& s) {
    const f32x2p x = la * 2.f;
    const f32x2p p1 = la * (la * (la * (la * (la * 0.0083333333f + 0.041666668f) + 0.16666667f) + 0.5f) + 1.f);
    const f32x2p p2 = x * (x * (x * (x * (x * (x * 0.0013888889f + 0.0083333333f) + 0.041666668f) + 0.16666667f) + 0.5f) + 1.f);
    const f32x2p tt = la * 1.4426950408889634f; f32x2p e1; e1.x = exp2f_(tt.x); e1.y = exp2f_(tt.y);
    const f32x2p big = 1.f - e1 * e1, one = p1 + 1.f;
    a.x = la.x > -0.15f ? one.x : e1.x; a.y = la.y > -0.15f ? one.y : e1.y;
    s.x = __builtin_amdgcn_sqrtf(la.x > -0.15f ? -p2.x : big.x); s.y = __builtin_amdgcn_sqrtf(la.y > -0.15f ? -p2.y : big.y);
}
__device__ __forceinline__ unsigned pk4_fp8(float a, float b, float c, float d) {
    unsigned w = 0u; w = __builtin_amdgcn_cvt_pk_fp8_f32(a, b, w, false); w = __builtin_amdgcn_cvt_pk_fp8_f32(c, d, w, true); return w; }
constexpr float WSCALE = 32.f, WSCALE_INV = 1.f / 32.f;
__device__ __forceinline__ float wave_sum(float v) {
#pragma unroll
    for (int o = 1; o < 64; o <<= 1) v += __shfl_xor(v, o);
    return v;
}


#define XB_TMO      128
#define XB_XCNT(j)  (256  + 64 * (j))
#define XB_XSUB(j)  (1280 + 64 * (j))
#define XB_XGEN(j)  (2304 + 64 * (j))
#define XB_TOP      3328
#define XB_TOPGEN   3392
#define XCD_BAR_WORDS 3456
#define XB_SPIN_CAP (1u << 18)
__device__ __forceinline__ unsigned xb_ld(unsigned* p)              { return __hip_atomic_load(p, __ATOMIC_RELAXED, __HIP_MEMORY_SCOPE_AGENT); }
__device__ __forceinline__ unsigned xb_add(unsigned* p, unsigned v) { return __hip_atomic_fetch_add(p, v, __ATOMIC_RELAXED, __HIP_MEMORY_SCOPE_AGENT); }
__device__ __forceinline__ unsigned xb_xcc_id() { return (unsigned)__builtin_amdgcn_s_getreg((3 << 11) | 20) & 0xFu; }
#define XB_SPIN(cond, bar) do { unsigned _sp = 0; while (cond) { __builtin_amdgcn_s_sleep(1); \
    if ((++_sp & 255u) == 0u) { if (xb_ld(&(bar)[XB_TMO])) break; if (_sp > XB_SPIN_CAP) { atomicAdd(&(bar)[XB_TMO], 1u); break; } } } } while (0)
struct XcdBarrier { unsigned* bar; unsigned x; volatile LAS unsigned* st; unsigned total; };
__device__ __forceinline__ XcdBarrier xcd_barrier_post(unsigned* bar, volatile LAS unsigned* st, unsigned total) {
    XcdBarrier b; b.bar = bar; b.x = xb_xcc_id(); b.st = st; b.total = total;
    if (threadIdx.x == 0) (void)xb_add(&bar[XB_XCNT(b.x)], 1u);
    return b;
}
__device__ __forceinline__ void xcd_barrier_complete(unsigned* bar, unsigned x, unsigned G, unsigned& nloc, unsigned& nx) {
    unsigned sum, cnt, mine, sp = 0u;
    for (;;) {
        sum = 0u; cnt = 0u; mine = 0u;
#pragma unroll
        for (unsigned j = 0; j < 16; ++j) { const unsigned c = xb_ld(&bar[XB_XCNT(j)]); sum += c; cnt += (c > 0u) ? 1u : 0u; mine = (j == x) ? c : mine; }
        if (sum == G) break;
        __builtin_amdgcn_s_sleep(1);
        if ((++sp & 255u) == 0u) { if (xb_ld(&bar[XB_TMO])) break; if (sp > XB_SPIN_CAP) { atomicAdd(&bar[XB_TMO], 1u); break; } }
    }
    nloc = mine > 0u ? mine : 1u; nx = cnt > 0u ? cnt : 1u;
}
__device__ __forceinline__ void xcd_barrier(const XcdBarrier& b) {
    asm volatile("s_waitcnt vmcnt(0)" ::: "memory");
    __syncthreads();
    if (threadIdx.x == 0) {
        unsigned* bar = b.bar;
        __builtin_amdgcn_s_waitcnt(0);
        unsigned nloc = b.st[0], nx = b.st[1];
        if (nloc == 0u) { xcd_barrier_complete(bar, b.x, b.total, nloc, nx); b.st[0] = nloc; b.st[1] = nx; }
        const unsigned old = xb_add(&bar[XB_XSUB(b.x)], 1u);
        const unsigned gen = old / nloc;
        if (old + 1u == (gen + 1u) * nloc) {
            __builtin_amdgcn_fence(__ATOMIC_RELEASE, "agent");
            asm volatile("s_waitcnt vmcnt(0)" ::: "memory");
            const unsigned og = xb_add(&bar[XB_TOP], 1u);
            const unsigned tg = og / nx;
            if (og + 1u == (tg + 1u) * nx) xb_add(&bar[XB_TOPGEN], 1u);
            else XB_SPIN(xb_ld(&bar[XB_TOPGEN]) == tg, bar);
            __builtin_amdgcn_fence(__ATOMIC_ACQUIRE, "agent");
            xb_add(&bar[XB_XGEN(b.x)], 1u);
            asm volatile("s_waitcnt vmcnt(0)" ::: "memory");
        } else {
            XB_SPIN(xb_ld(&bar[XB_XGEN(b.x)]) == gen, bar);
            __builtin_amdgcn_fence(__ATOMIC_ACQUIRE, "agent");
            asm volatile("s_waitcnt vmcnt(0)" ::: "memory");
        }
    }
    __syncthreads();
}

struct P {
    const float *x, *c, *ctx, *c_ctx, *w_mod, *b_mod, *norm1_g, *norm2_g, *w_in, *sgu_g, *sgu_w, *sgu_b, *conv_w, *conv_b,
                *rg_wa, *rg_ba, *rg_wi, *rg_bi, *rg_lam, *w_out, *w_router, *w1, *w3, *w2, *final_g;
    float* out; unsigned char* ws; int ph_lo, ph_hi;
};

struct SchedG1 { int G, c;
    __device__ __forceinline__ bool next(int i, pg8::Unit& u) const { const int L = i * G + c; if (L >= 528) return false;
        if (L < 512) { u.pm = L >> 3; u.pn = L & 7; } else { const int r = L - 512; u.pm = 64 + (r >> 1); u.pn = 4 + (r & 1); } u.pnB = u.pn; return true; } };
struct SchedG2 { int G, c;
    __device__ __forceinline__ bool next(int i, pg8::Unit& u) const { const int L = i * G + c; if (L >= 256) return false; u.pm = L >> 2; u.pn = L & 3; u.pnB = u.pn; return true; } };
struct SchedG3 { int G, c;
    __device__ __forceinline__ bool next(int i, pg8::Unit& u) const { const int L = i * G + c; if (L >= 2048) return false; const int e = L >> 7, loc = L & 127;
        u.pm = e * 8 + (loc & 7); u.pn = loc >> 3; u.pnB = e * 16 + u.pn; return true; } };
struct SchedG4 { int G, c;
    __device__ __forceinline__ bool next(int i, pg8::Unit& u) const { const int L = i * G + c; if (L >= 512) return false; const int e = L >> 5, loc = L & 31;
        u.pm = e * 8 + (loc & 7); u.pn = loc >> 3; u.pnB = e * 4 + u.pn; return true; } };

struct EpiG1 { static constexpr bool PAIRED = false, FUSED = false; bf16* UV; bf16* XC;
    __device__ __forceinline__ void st8(const pg8::Unit& u, int row, int col, f32x4 v0, f32x4 v1) const {
        const int grow = u.pm * 256 + row, gcol = u.pn * 256 + col;
        if (u.pm < 64) {
            if (gcol < 1024 || gcol >= 1536) { const f32x2p a = gelu2_((f32x2p){v0[0], v0[1]}), b = gelu2_((f32x2p){v0[2], v0[3]}), c = gelu2_((f32x2p){v1[0], v1[1]}), d = gelu2_((f32x2p){v1[2], v1[3]});
                v0 = (f32x4){a.x, a.y, b.x, b.y}; v1 = (f32x4){c.x, c.y, d.x, d.y}; }
            *(v4u*)(UV + (size_t)grow * DIN + gcol) = (v4u){pk2(v0[0], v0[1]), pk2(v0[2], v0[3]), pk2(v1[0], v1[1]), pk2(v1[2], v1[3])};
        } else *(v4u*)(XC + (size_t)(grow - M) * DLRU + (gcol - 1024)) = (v4u){pk2(v0[0], v0[1]), pk2(v0[2], v0[3]), pk2(v1[0], v1[1]), pk2(v1[2], v1[3])};
    } };
struct EpiG2 { static constexpr bool PAIRED = false, FUSED = false; const float* x; const float* MOD; float* X1;
    __device__ __forceinline__ void st8(const pg8::Unit& u, int row, int col, f32x4 v0, f32x4 v1) const {
        const int grow = u.pm * 256 + row, gcol = u.pn * 256 + col, b = grow >> 11;
        const f32x4* xp = (const f32x4*)(x + (size_t)grow * D + gcol); const f32x4* gp = (const f32x4*)(MOD + b * NMOD + 2 * D + gcol); f32x4* op = (f32x4*)(X1 + (size_t)grow * D + gcol);
        op[0] = xp[0] + gp[0] * v0; op[1] = xp[1] + gp[1] * v1;
    } };
#if MOE_FP8
typedef float f32x2v __attribute__((ext_vector_type(2)));
__device__ __forceinline__ f32x2v swiglu_scaled2(f32x2v g, f32x2v u) {
    constexpr float K1 = -1.4426950408889634f * WSCALE_INV, S2 = WSCALE * WSCALE;
    const f32x2v t = g * K1; f32x2v e; e.x = exp2f_(t.x); e.y = exp2f_(t.y);
    const f32x2v d = e * S2 + S2; f32x2v r; r.x = rcpf_(d.x); r.y = rcpf_(d.y);
    return (g * u) * r;
}
struct EpiG3 { static constexpr bool PAIRED = true; unsigned char* HID;
    __device__ __forceinline__ void st2x8(const pg8::Unit& u, int row, int col, f32x4 g0, f32x4 g1, f32x4 u0, f32x4 u1) const {
        const int grow = u.pm * 256 + row, hc = u.pn * 128 + col;
        const f32x2v a = swiglu_scaled2((f32x2v){g0[0], g0[1]}, (f32x2v){u0[0], u0[1]}), b = swiglu_scaled2((f32x2v){g0[2], g0[3]}, (f32x2v){u0[2], u0[3]});
        const f32x2v c = swiglu_scaled2((f32x2v){g1[0], g1[1]}, (f32x2v){u1[0], u1[1]}), d = swiglu_scaled2((f32x2v){g1[2], g1[3]}, (f32x2v){u1[2], u1[3]});
        v2u w; w.x = pk4_fp8(a.x, a.y, b.x, b.y); w.y = pk4_fp8(c.x, c.y, d.x, d.y);
        *(v2u*)(HID + (size_t)grow * DE + hc) = w;
    } };
struct EpiG4 { static constexpr bool PAIRED = false; const float* GATE; unsigned char* YE;
    __device__ __forceinline__ void st8(const pg8::Unit& u, int row, int col, f32x4 v0, f32x4 v1) const {
        const int grow = u.pm * 256 + row, gcol = u.pn * 256 + col; const float gt = GATE[grow];
        v2u w; w.x = pk4_fp8(v0[0] * gt, v0[1] * gt, v0[2] * gt, v0[3] * gt); w.y = pk4_fp8(v1[0] * gt, v1[1] * gt, v1[2] * gt, v1[3] * gt);
        *(v2u*)(YE + (size_t)grow * D + gcol) = w;
    } };
#else
struct EpiG3 { static constexpr bool PAIRED = true; bf16* HID;
    __device__ __forceinline__ void st2(const pg8::Unit& u, int row, int col, f32x4 g, f32x4 up) const {
        const int grow = u.pm * 256 + row, hc = u.pn * 128 + col;
        v2u w; w.x = pk2(siluf_(g[0]) * up[0], siluf_(g[1]) * up[1]); w.y = pk2(siluf_(g[2]) * up[2], siluf_(g[3]) * up[3]);
        *(v2u*)(HID + (size_t)grow * DE + hc) = w;
    } };
struct EpiG4 { static constexpr bool PAIRED = false; const float* GATE; bf16* YE;
    __device__ __forceinline__ void st(const pg8::Unit& u, int row, int col, f32x4 v) const {
        const int grow = u.pm * 256 + row, gcol = u.pn * 256 + col; const float gt = GATE[grow];
        v2u w; w.x = pk2(v[0] * gt, v[1] * gt); w.y = pk2(v[2] * gt, v[3] * gt); *(v2u*)(YE + (size_t)grow * D + gcol) = w;
    } };

#endif


struct EpiG2F { static constexpr bool PAIRED = false, FUSED = true;
    const float* x; const float* MOD; float* X1; const float* w_router; const float* norm2_g; const float* CB; float* XCH; unsigned* cnt; unsigned* tmo; unsigned char* HX8; float* AFF;
    __device__ __forceinline__ void fused(f32x4 (&acc)[2][2][4][2], const pg8::Unit& u, int wr, int wc, int fr, int fq, LAS unsigned char* lds, int wid, int lane) const {
        const int tid = wid * 64 + lane, b = u.pm >> 3, grow0 = u.pm * 256, gcol0 = u.pn * 256;
        LAS float* LQ = (LAS float*)lds;
        LAS float* RINV = (LAS float*)(lds + 81920);
        const float* MODb = MOD + b * NMOD;
        float gsc[2][8], shv[2][8], wrv[2][8];
#pragma unroll
        for (int bj = 0; bj < 2; ++bj)
#pragma unroll
            for (int j = 0; j < 8; ++j) { const int c = gcol0 + bj * 128 + wc * 32 + 8 * fq + j; gsc[bj][j] = norm2_g[c] * (1.f + MODb[4 * D + c]); shv[bj][j] = MODb[3 * D + c]; wrv[bj][j] = w_router[c * NE + fr]; }
#pragma unroll
        for (int ai = 0; ai < 2; ++ai)
#pragma unroll
            for (int m = 0; m < 4; ++m) { const int row = ai * 128 + wr * 64 + m * 16 + fr;
#pragma unroll
                for (int bj = 0; bj < 2; ++bj) { const int col = gcol0 + bj * 128 + wc * 32 + 8 * fq; const size_t o = (size_t)(grow0 + row) * D + col;
                    const f32x4 x0 = *(const f32x4*)(x + o), x1v = *(const f32x4*)(x + o + 4), g0 = *(const f32x4*)(MODb + 2 * D + col), g1 = *(const f32x4*)(MODb + 2 * D + col + 4);
                    acc[ai][bj][m][0] = x0 + g0 * acc[ai][bj][m][0]; acc[ai][bj][m][1] = x1v + g1 * acc[ai][bj][m][1];
                    *(f32x4*)(X1 + o) = acc[ai][bj][m][0]; *(f32x4*)(X1 + o + 4) = acc[ai][bj][m][1]; } }
        float tw[2][2][4];
#pragma unroll
        for (int bj = 0; bj < 2; ++bj)
#pragma unroll
            for (int n = 0; n < 2; ++n)
#pragma unroll
                for (int r = 0; r < 4; ++r) tw[bj][n][r] = wrv[bj][4 * n + r] * gsc[bj][4 * n + r];
#pragma unroll
        for (int ai = 0; ai < 2; ++ai)
#pragma unroll
            for (int m = 0; m < 4; ++m) { const int row = ai * 128 + wr * 64 + m * 16 + fr;
                f32x4 q = (f32x4){0.f, 0.f, 0.f, 0.f}; float s2 = 0.f;
#pragma unroll
                for (int bj = 0; bj < 2; ++bj)
#pragma unroll
                    for (int n = 0; n < 2; ++n)
#pragma unroll
                        for (int r = 0; r < 4; ++r) { const float v = acc[ai][bj][m][n][r]; q = __builtin_amdgcn_mfma_f32_16x16x4f32(tw[bj][n][r], v, q, 0, 0, 0); s2 += v * v; }
                s2 += __shfl_xor(s2, 16); s2 += __shfl_xor(s2, 32);
                LAS float* o = LQ + (row * 4 + wc) * 20;
                o[4 * fq + 0] = q[0]; o[4 * fq + 1] = q[1]; o[4 * fq + 2] = q[2]; o[4 * fq + 3] = q[3]; if (fq == 0) o[16] = s2; }
        __syncthreads();
        float* xo = XCH + (size_t)((u.pm * 4 + u.pn) * 256) * 20;
        for (int i = tid; i < 256 * 9; i += NTHREADS) { const int row = i / 9, q2 = 2 * (i - row * 9); const LAS float* s = LQ + row * 80 + q2;
            const float v0 = (s[0] + s[20]) + (s[40] + s[60]), v1 = q2 < 16 ? (s[1] + s[21]) + (s[41] + s[61]) : 0.f;
            __hip_atomic_store((unsigned long long*)(xo + row * 20 + q2), ((unsigned long long)__float_as_uint(v1) << 32) | __float_as_uint(v0), __ATOMIC_RELAXED, __HIP_MEMORY_SCOPE_AGENT); }
        asm volatile("s_waitcnt vmcnt(0)" ::: "memory");
        __syncthreads();
        if (tid == 0) {
            __hip_atomic_fetch_add(cnt + 16 * u.pm, 1u, __ATOMIC_RELAXED, __HIP_MEMORY_SCOPE_AGENT);
            XB_SPIN(xb_ld(cnt + 16 * u.pm) < 4u, tmo);
        }
        __syncthreads();
        const float* xp = XCH + (size_t)(u.pm * 4 * 256) * 20;
#define XLD(ptr) __hip_atomic_load((ptr), __ATOMIC_RELAXED, __HIP_MEMORY_SCOPE_AGENT)
        if (tid < 256) { const int row = tid; const float S2 = (XLD(xp + row * 20 + 16) + XLD(xp + 5120 + row * 20 + 16)) + (XLD(xp + 10240 + row * 20 + 16) + XLD(xp + 15360 + row * 20 + 16)); RINV[row] = rsqrtf(S2 * (1.f / D) + EPS); }
        else if (tid < 320) { const int row = 64 * u.pn + (tid - 256); const float* r0 = xp + row * 20;
            const float S2 = (XLD(r0 + 16) + XLD(r0 + 5120 + 16)) + (XLD(r0 + 10240 + 16) + XLD(r0 + 15360 + 16)), rinv = rsqrtf(S2 * (1.f / D) + EPS);
            float lg[16]; float mx = -3.0e38f;
#pragma unroll
            for (int e = 0; e < 16; ++e) { lg[e] = rinv * ((XLD(r0 + e) + XLD(r0 + 5120 + e)) + (XLD(r0 + 10240 + e) + XLD(r0 + 15360 + e))) + CB[b * NE + e]; mx = fmaxf(mx, lg[e]); }
            float den = 0.f;
#pragma unroll
            for (int e = 0; e < 16; ++e) { lg[e] = expf(lg[e] - mx); den += lg[e]; }
            const float rd = 1.f / den; const int t = (u.pm & 7) * 256 + row;
#pragma unroll
            for (int e = 0; e < 16; ++e) AFF[(size_t)(b * NE + e) * SEQ + t] = lg[e] * rd; }
#undef XLD
        __syncthreads();
#pragma unroll
        for (int ai = 0; ai < 2; ++ai)
#pragma unroll
            for (int m = 0; m < 4; ++m) { const int row = ai * 128 + wr * 64 + m * 16 + fr; const float rinv = RINV[row];
#pragma unroll
                for (int bj = 0; bj < 2; ++bj) { const f32x4 a0 = acc[ai][bj][m][0], a1 = acc[ai][bj][m][1]; v2u w;
                    w.x = pk4_fp8(a0[0] * rinv * gsc[bj][0] + shv[bj][0], a0[1] * rinv * gsc[bj][1] + shv[bj][1], a0[2] * rinv * gsc[bj][2] + shv[bj][2], a0[3] * rinv * gsc[bj][3] + shv[bj][3]);
                    w.y = pk4_fp8(a1[0] * rinv * gsc[bj][4] + shv[bj][4], a1[1] * rinv * gsc[bj][5] + shv[bj][5], a1[2] * rinv * gsc[bj][6] + shv[bj][6], a1[3] * rinv * gsc[bj][7] + shv[bj][7]);
                    *(v2u*)(HX8 + (size_t)(grow0 + row) * D + gcol0 + bj * 128 + wc * 32 + 8 * fq) = w; } }
    }
    __device__ __forceinline__ void st8(const pg8::Unit&, int, int, f32x4, f32x4) const {}
};

template <class Epi, class Sched>
__device__ __forceinline__ void naive_gemm_phase(LAS unsigned char* lds, const pg8::Gemm g, const Sched& S, const Epi& E) {
    LAS float* As = (LAS float*)lds; LAS float* Bs = (LAS float*)(lds + 4352);
    const int tid = threadIdx.x, ty = tid >> 5, tx = tid & 31, K = g.K, lr = tid >> 1, lh = 8 * (tid & 1);
    pg8::Unit u;
    for (int i = 0; S.next(i, u); ++i)
        for (int sub = 0; sub < 4; ++sub) {
            f32x4 ag[4], au[4];
#pragma unroll
            for (int r = 0; r < 4; ++r) { ag[r] = (f32x4){0.f, 0.f, 0.f, 0.f}; au[r] = (f32x4){0.f, 0.f, 0.f, 0.f}; }
            const bf16* arow = g.A + ((size_t)u.pm * 256 + sub * 64 + (lr & 63)) * K + lh;
            const bf16* brow = g.Bt + ((size_t)u.pnB * 256 + lr) * K + lh;
            for (int k0 = 0; k0 < K; k0 += 16) {
                const v4u bv = *(const v4u*)(brow + k0); v4u av = (v4u){0u, 0u, 0u, 0u}; if (tid < 128) av = *(const v4u*)(arow + k0);
                __syncthreads();
                Bs[(lh + 0) * 260 + lr] = bflo(bv.x); Bs[(lh + 1) * 260 + lr] = bfhi(bv.x); Bs[(lh + 2) * 260 + lr] = bflo(bv.y); Bs[(lh + 3) * 260 + lr] = bfhi(bv.y);
                Bs[(lh + 4) * 260 + lr] = bflo(bv.z); Bs[(lh + 5) * 260 + lr] = bfhi(bv.z); Bs[(lh + 6) * 260 + lr] = bflo(bv.w); Bs[(lh + 7) * 260 + lr] = bfhi(bv.w);
                if (tid < 128) {
                    As[(lh + 0) * 68 + lr] = bflo(av.x); As[(lh + 1) * 68 + lr] = bfhi(av.x); As[(lh + 2) * 68 + lr] = bflo(av.y); As[(lh + 3) * 68 + lr] = bfhi(av.y);
                    As[(lh + 4) * 68 + lr] = bflo(av.z); As[(lh + 5) * 68 + lr] = bfhi(av.z); As[(lh + 6) * 68 + lr] = bflo(av.w); As[(lh + 7) * 68 + lr] = bfhi(av.w); }
                __syncthreads();
#pragma unroll
                for (int kk = 0; kk < 16; ++kk) {
                    const f32x4 a = *(const LAS f32x4*)(As + kk * 68 + 4 * ty), b0 = *(const LAS f32x4*)(Bs + kk * 260 + 4 * tx), b1 = *(const LAS f32x4*)(Bs + kk * 260 + 128 + 4 * tx);
#pragma unroll
                    for (int r = 0; r < 4; ++r) { ag[r] += a[r] * b0; au[r] += a[r] * b1; }
                }
            }
#pragma unroll
            for (int r = 0; r < 4; ++r) { const int row = sub * 64 + 4 * ty + r;
                if constexpr (Epi::PAIRED) E.st2(u, row, 4 * tx, ag[r], au[r]);
                else { E.st(u, row, 4 * tx, ag[r]); E.st(u, row, 128 + 4 * tx, au[r]); } }
        }
    __syncthreads();
}
template <class Epi, class Sched>
__device__ __forceinline__ void gemm_any(LAS unsigned char* lds, const pg8::Gemm g, const Sched& S, const Epi& E) {
#if USE_PG8
    pg8::gemm_phase<Epi, Sched, true, true>(lds, g, S, E);
#else
    naive_gemm_phase<Epi, Sched>(lds, g, S, E);
#endif
}

__device__ __forceinline__ void transpose_item(const float* W, int N, int K, bf16* WT, int k0, int n0, size_t drow0, LAS unsigned char* scr, int lane) {
    const int lc = lane & 15, lr = lane >> 4;
    f32x4 v[16];
#pragma unroll
    for (int i = 0; i < 16; ++i) v[i] = *(const f32x4*)(W + (size_t)(k0 + 4 * i + lr) * N + n0 + 4 * lc);
#pragma unroll
    for (int i = 0; i < 16; ++i) { const int k = 4 * i + lr;
#pragma unroll
        for (int j = 0; j < 4; ++j) *(LAS bf16*)(scr + (4 * lc + j) * 136 + k * 2) = (bf16)f2bf(v[i][j]); }
    LDS_WAIT(); asm volatile("" ::: "memory");
    const int c = lane & 7;
#pragma unroll
    for (int j = 0; j < 8; ++j) { const int n = (lane >> 3) + 8 * j;
        const v2u lo = *(const LAS v2u*)(scr + n * 136 + c * 16), hi = *(const LAS v2u*)(scr + n * 136 + c * 16 + 8);
        *(v4u*)(WT + (drow0 + n) * (size_t)K + k0 + 8 * c) = (v4u){lo.x, lo.y, hi.x, hi.y}; }
    LDS_WAIT(); asm volatile("" ::: "memory");
}
__device__ __forceinline__ void conv_load(const float* src, int N, int lane, f32x4 (&v)[16]);
struct P;
__device__ __forceinline__ void conv_desc(const P& p, int it, const float*& src, unsigned char*& dst, int& N, int& K);
__device__ __forceinline__ void conv_store(const f32x4 (&v)[16], unsigned char* dst, int K, LAS unsigned char* scr, int lane);
__device__ __forceinline__ void transpose_item_f8(const float* W, int N, int K, unsigned char* WT, int k0, int n0, size_t drow0, LAS unsigned char* scr, int lane) {
    f32x4 v[16]; conv_load(W + (size_t)k0 * N + n0, N, lane, v); conv_store(v, WT + drow0 * (size_t)K + k0, K, scr, lane);
}
constexpr int CONV_ITEMS = 16 * 32 + 16 * 16 + 3 * 512 * NE, CONV_CUT = CONV_ITEMS - 6144;
__device__ __forceinline__ void convert_items(const P& p, LAS unsigned char* lds, int lane, int wave, int first, int last, int gw, int NGW) {
    LAS unsigned char* scr = lds + wave * 16384;
    constexpr int I_IN = 16 * 32, I_OUT = 16 * 16, I_E = 512 * NE;
    for (int it = first + gw; it < last; it += NGW) {
        int r = it;
        if (r < I_IN) { const int kb = r >> 5, nb = r & 31; transpose_item(p.w_in, DIN, D, (bf16*)(p.ws + WS_WIN), 64 * kb, 64 * nb, (size_t)(64 * nb), scr, lane); continue; } r -= I_IN;
        if (r < I_OUT) { const int kb = r >> 4, nb = r & 15; transpose_item(p.w_out, D, D, (bf16*)(p.ws + WS_WOUT), 64 * kb, 64 * nb, (size_t)(64 * nb), scr, lane); continue; } r -= I_OUT;
#if MOE_FP8
        { const float* src_; unsigned char* dst_; int N_, K_; f32x4 v_[16]; conv_desc(p, it, src_, dst_, N_, K_); conv_load(src_, N_, lane, v_); conv_store(v_, dst_, K_, scr, lane); }
#else
        if (r < 2 * I_E) { const int which = r >= I_E; if (which) r -= I_E; const int e = r >> 9, q = r & 511, kb = q >> 5, nb = q & 31, n0 = 64 * nb;
            const float* W = (which ? p.w3 : p.w1) + (size_t)e * D * DE;
#if MOE_FP8
            transpose_item_f8(W, DE, D, p.ws + WS_WG, 64 * kb, n0, (size_t)e * 4096 + (size_t)(n0 >> 7) * 256 + (n0 & 127) + (which ? 128 : 0), scr, lane); continue; } r -= 2 * I_E;
#else
            transpose_item(W, DE, D, (bf16*)(p.ws + WS_WG), 64 * kb, n0, (size_t)e * 4096 + (size_t)(n0 >> 7) * 256 + (n0 & 127) + (which ? 128 : 0), scr, lane); continue; } r -= 2 * I_E;
#endif
        { const int e = r >> 9, q = r & 511, kb = q >> 4, nb = q & 15, n0 = 64 * nb;
#if MOE_FP8
            transpose_item_f8(p.w2 + (size_t)e * DE * D, D, DE, p.ws + WS_W2, 64 * kb, n0, (size_t)e * 1024 + n0, scr, lane); }
#else
            transpose_item(p.w2 + (size_t)e * DE * D, D, DE, (bf16*)(p.ws + WS_W2), 64 * kb, n0, (size_t)e * 1024 + n0, scr, lane); }
#endif
#endif
    }
}

#if MOE_FP8
constexpr int CONV_HEAD = 16 * 32 + 16 * 16;
__device__ __forceinline__ void conv_desc(const P& p, int it, const float*& src, unsigned char*& dst, int& N, int& K) {
    constexpr int I_E = 512 * NE; const int r0 = it - CONV_HEAD;
    const bool isw2 = r0 >= 2 * I_E, which = (!isw2) && r0 >= I_E; const int r = isw2 ? r0 - 2 * I_E : (which ? r0 - I_E : r0);
    const int e = r >> 9, q = r & 511, kb = isw2 ? (q >> 5) : (q >> 6), nb = isw2 ? (q & 31) : (q & 63), n0 = 32 * nb;
    N = isw2 ? D : DE; K = isw2 ? DE : D;
    const float* base = isw2 ? p.w2 : (which ? p.w3 : p.w1);
    src = base + (size_t)e * D * DE + (size_t)(128 * kb) * N + n0;
    const size_t drow = isw2 ? ((size_t)e * 1024 + n0) : ((size_t)e * 4096 + (size_t)(n0 >> 7) * 256 + (n0 & 127) + (which ? 128 : 0));
    dst = p.ws + (isw2 ? WS_W2 : WS_WG) + drow * (size_t)K + 128 * kb;
}
__device__ __forceinline__ void conv_load(const float* src, int N, int lane, f32x4 (&v)[16]) {
    const int lc = lane & 7, lr = lane >> 3;
#pragma unroll
    for (int i = 0; i < 16; ++i) v[i] = __builtin_nontemporal_load((const f32x4*)(src + (size_t)(16 * lr + i) * N + 4 * lc));
}
__device__ __forceinline__ void conv_store(const f32x4 (&v)[16], unsigned char* dst, int K, LAS unsigned char* scr, int lane) {
    const int lc = lane & 7, lr = lane >> 3; (void)scr;
#pragma unroll
    for (int j = 0; j < 4; ++j) { v4u o;
        o.x = pk4_fp8(v[0][j] * WSCALE, v[1][j] * WSCALE, v[2][j] * WSCALE, v[3][j] * WSCALE);
        o.y = pk4_fp8(v[4][j] * WSCALE, v[5][j] * WSCALE, v[6][j] * WSCALE, v[7][j] * WSCALE);
        o.z = pk4_fp8(v[8][j] * WSCALE, v[9][j] * WSCALE, v[10][j] * WSCALE, v[11][j] * WSCALE);
        o.w = pk4_fp8(v[12][j] * WSCALE, v[13][j] * WSCALE, v[14][j] * WSCALE, v[15][j] * WSCALE);
        *(v4u*)(dst + (size_t)(4 * lc + j) * K + 16 * lr) = o; }
}
__device__ __forceinline__ void convert_pipelined(const P& p, LAS unsigned char* lds, int lane, int wave, int first, int last, int gw, int NGW) {
    LAS unsigned char* scr = lds + wave * 16384;
    f32x4 va[16], vb[16], vc[16]; const float* s0; unsigned char* da; unsigned char* db; unsigned char* dc; int N0, Ka, Kb, Kc;
    int it = first + gw; if (it >= last) return;
    const int itl = it + ((last - 1 - it) / NGW) * NGW;
    conv_desc(p, it, s0, da, N0, Ka); conv_load(s0, N0, lane, va);
    { const int i1 = min(it + NGW, itl); conv_desc(p, i1, s0, db, N0, Kb); conv_load(s0, N0, lane, vb); }
    for (; it <= itl; it += 3 * NGW) {
        { const int i2 = min(it + 2 * NGW, itl); conv_desc(p, i2, s0, dc, N0, Kc); conv_load(s0, N0, lane, vc); }
        conv_store(va, da, Ka, scr, lane);
        { const int i3 = min(it + 3 * NGW, itl); conv_desc(p, i3, s0, da, N0, Ka); conv_load(s0, N0, lane, va); }
        conv_store(vb, db, Kb, scr, lane);
        { const int i4 = min(it + 4 * NGW, itl); conv_desc(p, i4, s0, db, N0, Kb); conv_load(s0, N0, lane, vb); }
        conv_store(vc, dc, Kc, scr, lane);
    }
}
#endif
__device__ __forceinline__ void p0_small_copies(const P& p, int tid, int vcu, int G) {
    bf16* GWT = (bf16*)(p.ws + WS_GWT); bf16* SWB = (bf16*)(p.ws + WS_SWB); const int gt = vcu * NTHREADS + tid, NT = G * NTHREADS;
    for (int o = gt; o < 131072; o += NT) { const int i = o & 63, j = (o >> 6) & 63, h = (o >> 12) & 7, g = (o >> 15) & 1, d = o >> 16;
        GWT[o] = (bf16)f2bf((g ? p.rg_wi : p.rg_wa)[(size_t)((d * 8 + h) * 64 + i) * 64 + j]); }
    for (int o = gt; o < 65536; o += NT) SWB[o] = (bf16)f2bf(p.sgu_w[o]);
}
__device__ __forceinline__ void phase_p0(const P& p, LAS unsigned char* lds, int tid, int lane, int wave, int vcu, int G, int conv_last, bool small = true) {
    float* MOD = (float*)(p.ws + WS_MOD);
    {
        LAS float* sc = (LAS float*)lds; LAS float* part = (LAS float*)(lds + 36864);
        if (vcu < 192) {
            float cv[18];
#pragma unroll
            for (int i = 0; i < 18; ++i) { const int e = tid + i * NTHREADS, j = e >> 10, k = e & 1023; cv[i] = j < 8 ? p.c[j * D + k] : p.c_ctx[k]; }
#pragma unroll
            for (int i = 0; i < 18; ++i) sc[tid + i * NTHREADS] = siluf_(cv[i]);
        }
        __syncthreads();
        for (int t = vcu; t < 192; t += G) {
            const int col = lane & 31, kh = lane >> 5, n = t * 32 + col, kbase = wave * 128 + kh * 64; float acc[9];
#pragma unroll
            for (int j = 0; j < 9; ++j) acc[j] = 0.f;
            for (int k0 = 0; k0 < 64; k0 += 16) { float w[16];
#pragma unroll
                for (int i = 0; i < 16; ++i) w[i] = p.w_mod[(size_t)(kbase + k0 + i) * NMOD + n];
#pragma unroll
                for (int i = 0; i < 16; ++i)
#pragma unroll
                    for (int j = 0; j < 9; ++j) acc[j] += sc[j * D + kbase + k0 + i] * w[i]; }
#pragma unroll
            for (int j = 0; j < 9; ++j) { acc[j] += __shfl_xor(acc[j], 32); if (lane < 32) part[(wave * 9 + j) * 32 + lane] = acc[j]; }
            __syncthreads();
            for (int i = tid; i < 9 * 32; i += NTHREADS) { const int j = i >> 5, l = i & 31; float s2 = p.b_mod[t * 32 + l];
#pragma unroll
                for (int w = 0; w < 8; ++w) s2 += part[(w * 9 + j) * 32 + l];
                MOD[j * NMOD + t * 32 + l] = s2; }
            __syncthreads();
        }
    }
    convert_items(p, lds, lane, wave, 0, conv_last, vcu * NWAVES + wave, G * NWAVES);
    if (small) p0_small_copies(p, tid, vcu, G);
}

__device__ __forceinline__ void phase_p1(const P& p, int lane, int wave, int vcu, int G) {
    const float* MOD = (const float*)(p.ws + WS_MOD); bf16* HX = (bf16*)(p.ws + WS_HX);
    const int gw = vcu * NWAVES + wave, NGW = G * NWAVES;
    for (int i = gw; i < BATCH * NE; i += NGW) { const int b = i >> 4, e = i & 15; float a = 0.f;
        for (int k = lane; k < D; k += 64) a += MOD[b * NMOD + 3 * D + k] * p.w_router[k * NE + e];
        a = wave_sum(a); if (lane == 0) ((float*)(p.ws + WS_CB))[i] = a; }
    f32x4 nx[4];
    { const int m = gw; if (m < MT) { const f32x4* xr = (const f32x4*)(m < M ? p.x + (size_t)m * D : p.ctx + (size_t)(m - M) * D) + lane;
#pragma unroll
        for (int jj = 0; jj < 4; ++jj) nx[jj] = xr[64 * jj]; } }
    for (int m = gw; m < MT; m += NGW) {
        const int j = m < M ? (m >> 11) : 8;
        f32x4 v[4]; float s = 0.f;
#pragma unroll
        for (int jj = 0; jj < 4; ++jj) { v[jj] = nx[jj]; s += (v[jj].x * v[jj].x + v[jj].y * v[jj].y) + (v[jj].z * v[jj].z + v[jj].w * v[jj].w); }
        { const int m2 = m + NGW; if (m2 < MT) { const f32x4* xr = (const f32x4*)(m2 < M ? p.x + (size_t)m2 * D : p.ctx + (size_t)(m2 - M) * D) + lane;
#pragma unroll
            for (int jj = 0; jj < 4; ++jj) nx[jj] = xr[64 * jj]; } }
        const float rinv = rsqrtf(wave_sum(s) * (1.f / D) + EPS);
        v2u* o = (v2u*)(HX + (size_t)m * D) + lane;
#pragma unroll
        for (int jj = 0; jj < 4; ++jj) { const int k = 4 * (lane + 64 * jj);
            const f32x4 g = *(const f32x4*)(p.norm1_g + k), sh = *(const f32x4*)(MOD + j * NMOD + k), sc = *(const f32x4*)(MOD + j * NMOD + D + k);
            const f32x4 h = v[jj] * rinv * g * (sc + 1.f) + sh; v2u w; w.x = pk2(h.x, h.y); w.y = pk2(h.z, h.w); o[64 * jj] = w; }
    }
}

__device__ __forceinline__ void phase_lru1(const P& p, LAS unsigned char* lds, int tid, int vcu, int G) {
    LAS float* xt = (LAS float*)lds;
    LAS float* cx = (LAS float*)(lds + 17152);
    LAS float* af = (LAS float*)(lds + 33536);
    LAS float* df = (LAS float*)(lds + 49920);
    LAS float* ab = (LAS float*)(lds + 66304);
    LAS float* db = (LAS float*)(lds + 82688);
    const bf16* UV = (const bf16*)(p.ws + WS_UV); const bf16* XC = (const bf16*)(p.ws + WS_XC);
    bf16* HS = (bf16*)(p.ws + WS_HS); bf16* PF = (bf16*)(p.ws + WS_PF); bf16* PB = (bf16*)(p.ws + WS_PB); float* SUM = (float*)(p.ws + WS_SUM);
    for (int T = vcu; T < BATCH * NSEG * 8; T += G) {
        const int b = T / (NSEG * 8), rem = T % (NSEG * 8), seg = rem >> 3, h = rem & 7;
        for (int i = tid; i < 67 * 64; i += NTHREADS) { const int r = (i >> 6) - 1, ch = i & 63; float v = 0.f;
            if (seg < 4) { const int pos = seg * 64 + r; if (pos >= 0 && pos < CTXL) v = bf2f(XC[(size_t)(b * CTXL + pos) * DLRU + h * 64 + ch]); }
            else { if (r >= 0 && r < 64) v = bf2f(UV[(size_t)(b * SEQ + (seg - 4) * 64 + r) * DIN + 1024 + h * 64 + ch]); }
            xt[i] = v; }
        __syncthreads();
        for (int i = tid; i < 4096; i += NTHREADS) { const int r = i >> 6, ch = i & 63, cch = h * 64 + ch; float v = p.conv_b[cch];
#pragma unroll
            for (int j = 0; j < 4; ++j) v += p.conv_w[j * DLRU + cch] * xt[(r + j) * 64 + ch];
            cx[i] = v; }
        __syncthreads();
        { const int jj = tid & 63, r0 = tid >> 6, cch = h * 64 + jj;
#pragma unroll
          for (int d = 0; d < 2; ++d) {
            float aa[8], ai[8];
#pragma unroll
            for (int q = 0; q < 8; ++q) { aa[q] = 0.f; ai[q] = 0.f; }
            const float* wa = p.rg_wa + (size_t)((d * 8 + h) * 64) * 64 + jj; const float* wi = p.rg_wi + (size_t)((d * 8 + h) * 64) * 64 + jj;
#pragma unroll 2
            for (int i = 0; i < 64; ++i) { const float wav = wa[i * 64], wiv = wi[i * 64];
#pragma unroll
                for (int q = 0; q < 8; ++q) { const float cv = cx[(r0 + 8 * q) * 64 + i]; aa[q] += cv * wav; ai[q] += cv * wiv; } }
            const float ba = p.rg_ba[d * DLRU + cch], bi = p.rg_bi[d * DLRU + cch], c8 = -8.f * log1pf(expf(-p.rg_lam[d * DLRU + cch]));
            LAS float* ao = d ? ab : af; LAS float* dout = d ? db : df;
#pragma unroll
            for (int q = 0; q < 8; ++q) { const int r = r0 + 8 * q; const float rg = sigmoidf_(aa[q] + ba), ig = sigmoidf_(ai[q] + bi), la = c8 * rg;
                ao[r * 64 + jj] = expf(la); dout[r * 64 + jj] = sqrtf(-expm1f(2.f * la)) * ig * cx[r * 64 + jj]; }
          } }
        __syncthreads();
        if (tid < 128) { const int d = tid >> 6, ch = tid & 63; float hh = 0.f, pp = 1.f;
            if (d == 0) {
#pragma unroll 4
                for (int r = 0; r < 64; ++r) { const float a = af[r * 64 + ch]; hh = a * hh + df[r * 64 + ch]; pp *= a; df[r * 64 + ch] = hh; af[r * 64 + ch] = pp; } }
            else {
#pragma unroll 4
                for (int r = 63; r >= 0; --r) { const float a = ab[r * 64 + ch]; hh = a * hh + db[r * 64 + ch]; pp *= a; db[r * 64 + ch] = hh; ab[r * 64 + ch] = pp; } }
            float* s = SUM + ((size_t)((b * NSEG + seg) * 2 + d) * DLRU + h * 64 + ch) * 2; s[0] = pp; s[1] = hh; }
        __syncthreads();
        if (seg >= 4) for (int i = tid; i < 4096; i += NTHREADS) { const int r = i >> 6, ch = i & 63; const size_t o = (size_t)(b * SEQ + (seg - 4) * 64 + r) * DLRU + h * 64 + ch;
            HS[o] = (bf16)f2bf(df[i] + db[i]); PF[o] = (bf16)f2bf(af[i]); PB[o] = (bf16)f2bf(ab[i]); }
        __syncthreads();
    }
}

__device__ __forceinline__ void phase_sgu(const P& p, LAS unsigned char* lds, int tid, int vcu, int G) {
    LAS float* vn = (LAS float*)lds;
    LAS float* wsl = (LAS float*)(lds + 65536);
    const bf16* UV = (const bf16*)(p.ws + WS_UV); bf16* A2 = (bf16*)(p.ws + WS_A2);
    for (int T = vcu; T < 512; T += G) {
        const int b = T >> 6, n = (T >> 2) & 15, h = T & 3; const size_t t0 = (size_t)b * SEQ + n * 128;
        for (int i = tid; i < 16384; i += NTHREADS) { const int q = i >> 7, c = i & 127; vn[i] = bf2f(UV[(t0 + q) * DIN + 512 + h * 128 + c]); wsl[i] = p.sgu_w[h * 16384 + i]; }
        __syncthreads();
        { const int q = tid >> 2, part = tid & 3; float s = 0.f;
          for (int c = part * 32; c < part * 32 + 32; ++c) { const float v = vn[q * 128 + c]; s += v * v; }
          s += __shfl_xor(s, 1); s += __shfl_xor(s, 2);
          const float rinv = rsqrtf(s * (1.f / 128.f) + EPS);
          for (int c = part * 32; c < part * 32 + 32; ++c) vn[q * 128 + c] *= rinv * p.sgu_g[h * 128 + c]; }
        __syncthreads();
        { const int c = tid & 127, p0 = tid >> 7; float acc[32];
#pragma unroll
          for (int i = 0; i < 32; ++i) acc[i] = 0.f;
          for (int q = 0; q < 128; ++q) { const float vq = vn[q * 128 + c];
#pragma unroll
              for (int i = 0; i < 32; ++i) acc[i] += wsl[(p0 + 4 * i) * 128 + q] * vq; }
#pragma unroll
          for (int i = 0; i < 32; ++i) { const int pp = p0 + 4 * i; const float s = acc[i] + p.sgu_b[h * 128 + pp];
              const float uu = bf2f(UV[(t0 + pp) * DIN + h * 128 + c]); A2[(t0 + pp) * D + h * 128 + c] = (bf16)f2bf(uu * s); } }
        __syncthreads();
    }
}


__device__ __forceinline__ void phase_lru1_mfma(const P& p, LAS unsigned char* lds, int tid, int lane, int wave, int vcu, int G) {
    LAS float* xt = (LAS float*)lds;
    LAS float* cxf = (LAS float*)(lds + 17152);
    LAS unsigned char* cxb = lds + 33536;
    LAS float* AD = (LAS float*)(lds + 42752);
    LAS float* SS = (LAS float*)(lds + 108288);
    const bf16* UV = (const bf16*)(p.ws + WS_UV); const bf16* XC = (const bf16*)(p.ws + WS_XC); const bf16* GWT = (const bf16*)(p.ws + WS_GWT);
    bf16* HS = (bf16*)(p.ws + WS_HS); bf16* PF = (bf16*)(p.ws + WS_PF); bf16* PB = (bf16*)(p.ws + WS_PB); float* SUM = (float*)(p.ws + WS_SUM);
    const int fr = lane & 15, fq = lane >> 4;
    const int wd = wave >> 2, jt = wave & 3, wj = 16 * jt + fr, cch_c = tid & 63;
    int hcur = -1; bf16x8 bfr[2][2]; float ba = 0.f, bi = 0.f, c8 = 0.f, cw0 = 0.f, cw1 = 0.f, cw2 = 0.f, cw3 = 0.f, cbias = 0.f;
    auto load_piece = [&](int T, int i) -> v4u { const int b = T / (NSEG * 8), rem = T % (NSEG * 8), seg = rem >> 3, h = rem & 7, r = (i >> 3) - 1, c0 = (i & 7) * 8; v4u w = (v4u){0u, 0u, 0u, 0u};
        if (seg < 4) { const int pos = seg * 64 + r; if (pos >= 0 && pos < CTXL) w = *(const v4u*)(XC + (size_t)(b * CTXL + pos) * DLRU + h * 64 + c0); }
        else { if (r >= 0 && r < 64) w = *(const v4u*)(UV + (size_t)(b * SEQ + (seg - 4) * 64 + r) * DIN + 1024 + h * 64 + c0); }
        return w; };
    v4u pre0 = (v4u){0u, 0u, 0u, 0u}, pre1 = (v4u){0u, 0u, 0u, 0u};
    if (vcu < BATCH * NSEG * 8) { pre0 = load_piece(vcu, tid); if (tid < 24) pre1 = load_piece(vcu, tid + 512); }
    for (int T = vcu; T < BATCH * NSEG * 8; T += G) {
        const int b = T / (NSEG * 8), rem = T % (NSEG * 8), seg = rem >> 3, h = rem & 7;
        { LAS float* o = xt + (tid >> 3) * 64 + (tid & 7) * 8;
          *(LAS f32x4*)o = (f32x4){bflo(pre0.x), bfhi(pre0.x), bflo(pre0.y), bfhi(pre0.y)}; *(LAS f32x4*)(o + 4) = (f32x4){bflo(pre0.z), bfhi(pre0.z), bflo(pre0.w), bfhi(pre0.w)};
          if (tid < 24) { LAS float* o1 = xt + ((tid + 512) >> 3) * 64 + (tid & 7) * 8;
              *(LAS f32x4*)o1 = (f32x4){bflo(pre1.x), bfhi(pre1.x), bflo(pre1.y), bfhi(pre1.y)}; *(LAS f32x4*)(o1 + 4) = (f32x4){bflo(pre1.z), bfhi(pre1.z), bflo(pre1.w), bfhi(pre1.w)}; } }
        if (h != hcur) { hcur = h;
#pragma unroll
            for (int g = 0; g < 2; ++g)
#pragma unroll
                for (int ks = 0; ks < 2; ++ks) bfr[g][ks] = *(const bf16x8*)(GWT + (size_t)((((wd * 2 + g) * 8 + h) * 64 + wj) * 64 + 32 * ks + 8 * fq));
            ba = p.rg_ba[wd * DLRU + h * 64 + wj]; bi = p.rg_bi[wd * DLRU + h * 64 + wj]; c8 = -8.f * log1pf(expf(-p.rg_lam[wd * DLRU + h * 64 + wj]));
            cw0 = p.conv_w[h * 64 + cch_c]; cw1 = p.conv_w[DLRU + h * 64 + cch_c]; cw2 = p.conv_w[2 * DLRU + h * 64 + cch_c]; cw3 = p.conv_w[3 * DLRU + h * 64 + cch_c]; cbias = p.conv_b[h * 64 + cch_c]; }
        __syncthreads();
        if (T + G < BATCH * NSEG * 8) { pre0 = load_piece(T + G, tid); if (tid < 24) pre1 = load_piece(T + G, tid + 512); }
        for (int i = tid; i < 4096; i += NTHREADS) { const int r = i >> 6, ch = i & 63;
            const float v = cbias + cw0 * xt[r * 64 + ch] + cw1 * xt[(r + 1) * 64 + ch] + cw2 * xt[(r + 2) * 64 + ch] + cw3 * xt[(r + 3) * 64 + ch];
            cxf[i] = v; *(LAS bf16*)(cxb + r * 144 + ch * 2) = (bf16)f2bf(v); }
        __syncthreads();
        { const int d = wd, j = wj;
          LAS float* Ad = AD + d * 8192; LAS float* Dd = Ad + 4096;
#pragma unroll
          for (int pt = 0; pt < 4; ++pt) {
              const bf16x8 a0 = *(const LAS bf16x8*)(cxb + (16 * pt + fr) * 144 + 16 * fq), a1 = *(const LAS bf16x8*)(cxb + (16 * pt + fr) * 144 + 64 + 16 * fq);
              f32x4 ca = (f32x4){0.f, 0.f, 0.f, 0.f}, ci = (f32x4){0.f, 0.f, 0.f, 0.f};
              ca = __builtin_amdgcn_mfma_f32_16x16x32_bf16(a0, bfr[0][0], ca, 0, 0, 0); ca = __builtin_amdgcn_mfma_f32_16x16x32_bf16(a1, bfr[0][1], ca, 0, 0, 0);
              ci = __builtin_amdgcn_mfma_f32_16x16x32_bf16(a0, bfr[1][0], ci, 0, 0, 0); ci = __builtin_amdgcn_mfma_f32_16x16x32_bf16(a1, bfr[1][1], ci, 0, 0, 0);
#pragma unroll
              for (int r = 0; r < 4; ++r) { const int pos = 16 * pt + 4 * fq + r; const float rg = sigmoidf_(ca[r] + ba), ig = sigmoidf_(ci[r] + bi), la = c8 * rg;
                  float av, sv; decay_pair(la, av, sv); Ad[pos * 64 + j] = av; Dd[pos * 64 + j] = sv * ig * cxf[pos * 64 + j]; }
          } }
        __syncthreads();
        { const int sub = tid >> 7, d = (tid >> 6) & 1, ch = tid & 63;
          LAS float* Ad = AD + d * 8192; LAS float* Dd = Ad + 4096;
          float hl[16], pc[16]; float hh = 0.f, pp = 1.f;
#pragma unroll
          for (int t = 0; t < 16; ++t) { const int pos = d ? 16 * sub + 15 - t : 16 * sub + t; const float a = Ad[pos * 64 + ch]; hh = a * hh + Dd[pos * 64 + ch]; pp *= a; hl[t] = hh; pc[t] = pp; }
          SS[((sub * 2 + d) * 64 + ch) * 2] = pp; SS[((sub * 2 + d) * 64 + ch) * 2 + 1] = hh;
          __syncthreads();
          float cin = 0.f, cp = 1.f;
          if (d == 0) { for (int s2 = 0; s2 < sub; ++s2) { const float A = SS[((s2 * 2) * 64 + ch) * 2], B = SS[((s2 * 2) * 64 + ch) * 2 + 1]; cin = A * cin + B; cp *= A; } }
          else { for (int s2 = 3; s2 > sub; --s2) { const float A = SS[((s2 * 2 + 1) * 64 + ch) * 2], B = SS[((s2 * 2 + 1) * 64 + ch) * 2 + 1]; cin = A * cin + B; cp *= A; } }
#pragma unroll
          for (int t = 0; t < 16; ++t) { const int pos = d ? 16 * sub + 15 - t : 16 * sub + t; Dd[pos * 64 + ch] = hl[t] + pc[t] * cin; Ad[pos * 64 + ch] = pc[t] * cp; }
          if ((d == 0 && sub == 3) || (d == 1 && sub == 0)) { float* so = SUM + ((size_t)((b * NSEG + seg) * 2 + d) * DLRU + h * 64 + ch) * 2; so[0] = pc[15] * cp; so[1] = hl[15] + pc[15] * cin; }
        }
        __syncthreads();
        if (seg >= 4) { const int pos = tid >> 3, c0 = (tid & 7) * 8; const LAS float* q0 = AD + pos * 64 + c0;
            const f32x4 a0l = *(const LAS f32x4*)(q0), a0h = *(const LAS f32x4*)(q0 + 4), d0l = *(const LAS f32x4*)(q0 + 4096), d0h = *(const LAS f32x4*)(q0 + 4100);
            const f32x4 a1l = *(const LAS f32x4*)(q0 + 8192), a1h = *(const LAS f32x4*)(q0 + 8196), d1l = *(const LAS f32x4*)(q0 + 12288), d1h = *(const LAS f32x4*)(q0 + 12292);
            const f32x4 sl = d0l + d1l, sh = d0h + d1h; const size_t o = (size_t)(b * SEQ + (seg - 4) * 64 + pos) * DLRU + h * 64 + c0;
            *(v4u*)(HS + o) = (v4u){pk2(sl.x, sl.y), pk2(sl.z, sl.w), pk2(sh.x, sh.y), pk2(sh.z, sh.w)};
            *(v4u*)(PF + o) = (v4u){pk2(a0l.x, a0l.y), pk2(a0l.z, a0l.w), pk2(a0h.x, a0h.y), pk2(a0h.z, a0h.w)};
            *(v4u*)(PB + o) = (v4u){pk2(a1l.x, a1l.y), pk2(a1l.z, a1l.w), pk2(a1h.x, a1h.y), pk2(a1h.z, a1h.w)}; }
        __syncthreads();
    }
}


template <int WD>
__device__ __forceinline__ void lru_scan(const float (&ga)[4][4], const float (&gb)[4][4], LAS float* EX, int lane, int fr, int fq, int wj, float& Pin, float& Hin) {
    const int cq = WD ? 3 - fq : fq, l16 = (WD ? lane + 16 : lane - 16) & 63, l32 = (WD ? lane + 32 : lane - 32) & 63, llast = WD ? fr : fr + 48;
    LAS float* Pd = EX + WD * 8192; LAS float* Hd = Pd + 4096;
#pragma unroll
    for (int ptc = 0; ptc < 4; ++ptc) { constexpr int dummy = 0; (void)dummy; const int pt = WD ? 3 - ptc : ptc;
        float pr[4], hr[4]; float hh = 0.f, pp = 1.f;
#pragma unroll
        for (int rc = 0; rc < 4; ++rc) { const int r = WD ? 3 - rc : rc; hh = ga[pt][r] * hh + gb[pt][r]; pp *= ga[pt][r]; pr[r] = pp; hr[r] = hh; }
        float A = pp, B = hh;
        { const float tA = __shfl(A, l16), tB = __shfl(B, l16); if (cq >= 1) { B = A * tB + B; A = tA * A; } }
        { const float tA = __shfl(A, l32), tB = __shfl(B, l32); if (cq >= 2) { B = A * tB + B; A = tA * A; } }
        float eA = __shfl(A, l16), eB = __shfl(B, l16); if (cq == 0) { eA = 1.f; eB = 0.f; }
        const float tAt = __shfl(A, llast), tBt = __shfl(B, llast);
        const float Hc = eA * Hin + eB, Pc = Pin * eA;
#pragma unroll
        for (int r = 0; r < 4; ++r) { const int pos = 16 * pt + 4 * fq + r; Hd[pos * 64 + wj] = pr[r] * Hc + hr[r]; Pd[pos * 64 + wj] = Pc * pr[r]; }
        Hin = tAt * Hin + tBt; Pin *= tAt;
    }
}

__device__ __forceinline__ void phase_lru1_v2(const P& p, LAS unsigned char* lds, int tid, int lane, int wave, int vcu, int G) {
    LAS float* xt = (LAS float*)lds;
    LAS float* cxf = (LAS float*)(lds + 17152);
    LAS unsigned char* cxb = lds + 33536;
    LAS float* EX = (LAS float*)(lds + 42752);
    const bf16* UV = (const bf16*)(p.ws + WS_UV); const bf16* XC = (const bf16*)(p.ws + WS_XC); const bf16* GWT = (const bf16*)(p.ws + WS_GWT);
    bf16* HS = (bf16*)(p.ws + WS_HS); bf16* PF = (bf16*)(p.ws + WS_PF); bf16* PB = (bf16*)(p.ws + WS_PB); float* SUM = (float*)(p.ws + WS_SUM);
    const int fr = lane & 15, fq = lane >> 4;
    const int wd = wave >> 2, jt = wave & 3, wj = 16 * jt + fr, cch_c = tid & 63;
    int hcur = -1; bf16x8 bfr[2][2]; float ba = 0.f, bi = 0.f, c8 = 0.f, cw0 = 0.f, cw1 = 0.f, cw2 = 0.f, cw3 = 0.f, cbias = 0.f;
    auto load_piece = [&](int T, int i) -> v4u { const int b = T / (NSEG * 8), rem = T % (NSEG * 8), seg = rem >> 3, h = rem & 7, r = (i >> 3) - 1, c0 = (i & 7) * 8; v4u w = (v4u){0u, 0u, 0u, 0u};
        if (seg < 4) { const int pos = seg * 64 + r; if (pos >= 0 && pos < CTXL) w = *(const v4u*)(XC + (size_t)(b * CTXL + pos) * DLRU + h * 64 + c0); }
        else { if (r >= 0 && r < 64) w = *(const v4u*)(UV + (size_t)(b * SEQ + (seg - 4) * 64 + r) * DIN + 1024 + h * 64 + c0); }
        return w; };
    v4u pre0 = (v4u){0u, 0u, 0u, 0u}, pre1 = (v4u){0u, 0u, 0u, 0u};
    if (vcu < BATCH * NSEG * 8) { pre0 = load_piece(vcu, tid); if (tid < 24) pre1 = load_piece(vcu, tid + 512); }
    for (int T = vcu; T < BATCH * NSEG * 8; T += G) {
        const int b = T / (NSEG * 8), rem = T % (NSEG * 8), seg = rem >> 3, h = rem & 7;
        { LAS float* o = xt + (tid >> 3) * 64 + (tid & 7) * 8;
          *(LAS f32x4*)o = (f32x4){bflo(pre0.x), bfhi(pre0.x), bflo(pre0.y), bfhi(pre0.y)}; *(LAS f32x4*)(o + 4) = (f32x4){bflo(pre0.z), bfhi(pre0.z), bflo(pre0.w), bfhi(pre0.w)};
          if (tid < 24) { LAS float* o1 = xt + ((tid + 512) >> 3) * 64 + (tid & 7) * 8;
              *(LAS f32x4*)o1 = (f32x4){bflo(pre1.x), bfhi(pre1.x), bflo(pre1.y), bfhi(pre1.y)}; *(LAS f32x4*)(o1 + 4) = (f32x4){bflo(pre1.z), bfhi(pre1.z), bflo(pre1.w), bfhi(pre1.w)}; } }
        if (h != hcur) { hcur = h;
#pragma unroll
            for (int g = 0; g < 2; ++g)
#pragma unroll
                for (int ks = 0; ks < 2; ++ks) bfr[g][ks] = *(const bf16x8*)(GWT + (size_t)((((wd * 2 + g) * 8 + h) * 64 + wj) * 64 + 32 * ks + 8 * fq));
            ba = p.rg_ba[wd * DLRU + h * 64 + wj]; bi = p.rg_bi[wd * DLRU + h * 64 + wj]; c8 = -8.f * log1pf(expf(-p.rg_lam[wd * DLRU + h * 64 + wj]));
            cw0 = p.conv_w[h * 64 + cch_c]; cw1 = p.conv_w[DLRU + h * 64 + cch_c]; cw2 = p.conv_w[2 * DLRU + h * 64 + cch_c]; cw3 = p.conv_w[3 * DLRU + h * 64 + cch_c]; cbias = p.conv_b[h * 64 + cch_c]; }
        __syncthreads();
        if (T + G < BATCH * NSEG * 8) { pre0 = load_piece(T + G, tid); if (tid < 24) pre1 = load_piece(T + G, tid + 512); }
        for (int i = tid; i < 4096; i += NTHREADS) { const int r = i >> 6, ch = i & 63;
            const float v = cbias + cw0 * xt[r * 64 + ch] + cw1 * xt[(r + 1) * 64 + ch] + cw2 * xt[(r + 2) * 64 + ch] + cw3 * xt[(r + 3) * 64 + ch];
            cxf[i] = v; *(LAS bf16*)(cxb + r * 144 + ch * 2) = (bf16)f2bf(v); }
        __syncthreads();
        {
            float ga[4][4], gb[4][4];
#pragma unroll
            for (int pt = 0; pt < 4; ++pt) {
                const bf16x8 a0 = *(const LAS bf16x8*)(cxb + (16 * pt + fr) * 144 + 16 * fq), a1 = *(const LAS bf16x8*)(cxb + (16 * pt + fr) * 144 + 64 + 16 * fq);
                f32x4 ca = (f32x4){0.f, 0.f, 0.f, 0.f}, ci = (f32x4){0.f, 0.f, 0.f, 0.f};
                ca = __builtin_amdgcn_mfma_f32_16x16x32_bf16(a0, bfr[0][0], ca, 0, 0, 0); ca = __builtin_amdgcn_mfma_f32_16x16x32_bf16(a1, bfr[0][1], ca, 0, 0, 0);
                ci = __builtin_amdgcn_mfma_f32_16x16x32_bf16(a0, bfr[1][0], ci, 0, 0, 0); ci = __builtin_amdgcn_mfma_f32_16x16x32_bf16(a1, bfr[1][1], ci, 0, 0, 0);
#pragma unroll
                for (int r = 0; r < 4; r += 2) { const int pos = 16 * pt + 4 * fq + r;
                    const f32x2p rg = sigmoid2_((f32x2p){ca[r], ca[r + 1]} + ba), ig = sigmoid2_((f32x2p){ci[r], ci[r + 1]} + bi); f32x2p av, sv; decay_pair2(rg * c8, av, sv);
                    const f32x2p dv = sv * ig * (f32x2p){cxf[pos * 64 + wj], cxf[(pos + 1) * 64 + wj]}; ga[pt][r] = av.x; ga[pt][r + 1] = av.y; gb[pt][r] = dv.x; gb[pt][r + 1] = dv.y; }
            }
            float Pin = 1.f, Hin = 0.f;
            if (wd == 0) lru_scan<0>(ga, gb, EX, lane, fr, fq, wj, Pin, Hin); else lru_scan<1>(ga, gb, EX, lane, fr, fq, wj, Pin, Hin);
            if (fq == 0) { float* so = SUM + ((size_t)((b * NSEG + seg) * 2 + wd) * DLRU + h * 64 + wj) * 2; so[0] = Pin; so[1] = Hin; }
        }
        __syncthreads();
        if (seg >= 4) { const int pos = tid >> 3, c0 = (tid & 7) * 8; const LAS float* q0 = EX + pos * 64 + c0;
            const f32x4 a0l = *(const LAS f32x4*)(q0), a0h = *(const LAS f32x4*)(q0 + 4), d0l = *(const LAS f32x4*)(q0 + 4096), d0h = *(const LAS f32x4*)(q0 + 4100);
            const f32x4 a1l = *(const LAS f32x4*)(q0 + 8192), a1h = *(const LAS f32x4*)(q0 + 8196), d1l = *(const LAS f32x4*)(q0 + 12288), d1h = *(const LAS f32x4*)(q0 + 12292);
            const f32x4 sl = d0l + d1l, sh = d0h + d1h; const size_t o = (size_t)(b * SEQ + (seg - 4) * 64 + pos) * DLRU + h * 64 + c0;
            *(v4u*)(HS + o) = (v4u){pk2(sl.x, sl.y), pk2(sl.z, sl.w), pk2(sh.x, sh.y), pk2(sh.z, sh.w)};
            *(v4u*)(PF + o) = (v4u){pk2(a0l.x, a0l.y), pk2(a0l.z, a0l.w), pk2(a0h.x, a0h.y), pk2(a0h.z, a0h.w)};
            *(v4u*)(PB + o) = (v4u){pk2(a1l.x, a1l.y), pk2(a1l.z, a1l.w), pk2(a1h.x, a1h.y), pk2(a1h.z, a1h.w)}; }
    }
    __syncthreads();
}

__device__ __forceinline__ void phase_sgu_mfma(const P& p, LAS unsigned char* lds, int tid, int lane, int wave, int vcu, int G, int first = 0, int last = 512) {
    LAS unsigned char* vnT = lds;
    LAS unsigned char* ul = lds + 34816;
    const bf16* UV = (const bf16*)(p.ws + WS_UV); const bf16* SWB = (const bf16*)(p.ws + WS_SWB); bf16* A2 = (bf16*)(p.ws + WS_A2);
    const int fr = lane & 15, fq = lane >> 4;
    for (int T = first + vcu; T < last; T += G) {
        const int b = T >> 6, n = (T >> 2) & 15, h = T & 3; const size_t t0 = (size_t)b * SEQ + n * 128;
        { const int q = tid >> 2, part = tid & 3; const v4u* src = (const v4u*)(UV + (t0 + q) * DIN + 512 + h * 128 + part * 32); const v4u* usrc = (const v4u*)(UV + (t0 + q) * DIN + h * 128 + part * 32);
          float v[32]; float s = 0.f; v4u uw[4];
#pragma unroll
          for (int i = 0; i < 4; ++i) uw[i] = usrc[i];
#pragma unroll
          for (int i = 0; i < 4; ++i) { const v4u w = src[i]; v[8 * i] = bflo(w.x); v[8 * i + 1] = bfhi(w.x); v[8 * i + 2] = bflo(w.y); v[8 * i + 3] = bfhi(w.y); v[8 * i + 4] = bflo(w.z); v[8 * i + 5] = bfhi(w.z); v[8 * i + 6] = bflo(w.w); v[8 * i + 7] = bfhi(w.w); }
#pragma unroll
          for (int i = 0; i < 32; ++i) s += v[i] * v[i];
          s += __shfl_xor(s, 1); s += __shfl_xor(s, 2);
          const float rinv = rsqrtf(s * (1.f / 128.f) + EPS);
#pragma unroll
          for (int i = 0; i < 32; ++i) { const int c = part * 32 + i; *(LAS bf16*)(vnT + c * 272 + q * 2) = (bf16)f2bf(v[i] * rinv * p.sgu_g[h * 128 + c]); }
#pragma unroll
          for (int i = 0; i < 4; ++i) *(LAS v4u*)(ul + q * 272 + part * 64 + i * 16) = uw[i]; }
        __syncthreads();
        { bf16x8 afr[4];
#pragma unroll
          for (int ks = 0; ks < 4; ++ks) afr[ks] = *(const bf16x8*)(SWB + (size_t)((h * 128 + 16 * wave + fr) * 128 + 32 * ks + 8 * fq));
          float bs[4];
#pragma unroll
          for (int r = 0; r < 4; ++r) bs[r] = p.sgu_b[h * 128 + 16 * wave + 4 * fq + r];
#pragma unroll
          for (int ct = 0; ct < 8; ++ct) { f32x4 acc = (f32x4){0.f, 0.f, 0.f, 0.f};
#pragma unroll
              for (int ks = 0; ks < 4; ++ks) { const bf16x8 bv = *(const LAS bf16x8*)(vnT + (16 * ct + fr) * 272 + 64 * ks + 16 * fq); acc = __builtin_amdgcn_mfma_f32_16x16x32_bf16(afr[ks], bv, acc, 0, 0, 0); }
#pragma unroll
              for (int r = 0; r < 4; ++r) { const int pp = 16 * wave + 4 * fq + r, c = 16 * ct + fr; LAS bf16* e = (LAS bf16*)(ul + pp * 272 + c * 2);
                  *e = (bf16)f2bf(bf2f(*e) * (acc[r] + bs[r])); } } }
        __syncthreads();
        { const int q = tid >> 2, part = tid & 3; v4u* dst = (v4u*)(A2 + (t0 + q) * D + h * 128 + part * 32);
#pragma unroll
          for (int i = 0; i < 4; ++i) dst[i] = *(const LAS v4u*)(ul + q * 272 + part * 64 + i * 16); }
        __syncthreads();
    }
}

__device__ __forceinline__ void phase_lru2(const P& p, LAS unsigned char* lds, int tid, int vcu, int G) {
    LAS float* carry = (LAS float*)lds;
    const bf16* UV = (const bf16*)(p.ws + WS_UV); const bf16* HS = (const bf16*)(p.ws + WS_HS); const bf16* PF = (const bf16*)(p.ws + WS_PF); const bf16* PB = (const bf16*)(p.ws + WS_PB);
    const float* SUM = (const float*)(p.ws + WS_SUM); bf16* A2 = (bf16*)(p.ws + WS_A2);
    for (int T = vcu; T < BATCH * 32 * 8; T += G) {
        const int b = T >> 8, gr = (T >> 3) & 31, h = T & 7;
        if (tid < 128) { const int d = tid >> 6, ch = tid & 63; float hc = 0.f;
            const float* S = SUM + ((size_t)b * NSEG * 2 * DLRU + (size_t)d * DLRU + h * 64 + ch) * 2;
            if (d == 0) { for (int s = 0; s < 4 + gr; ++s) { const float A = S[(size_t)s * 2048], B = S[(size_t)s * 2048 + 1]; hc = A * hc + B; } }
            else { for (int s = 3; s >= 0; --s) { const float A = S[(size_t)s * 2048], B = S[(size_t)s * 2048 + 1]; hc = A * hc + B; }
                   for (int s = NSEG - 1; s > 4 + gr; --s) { const float A = S[(size_t)s * 2048], B = S[(size_t)s * 2048 + 1]; hc = A * hc + B; } }
            carry[tid] = hc; }
        __syncthreads();
        for (int i = tid; i < 4096; i += NTHREADS) { const int r = i >> 6, ch = i & 63; const size_t row = (size_t)b * SEQ + gr * 64 + r, o = row * DLRU + h * 64 + ch;
            const float val = bf2f(HS[o]) + bf2f(PF[o]) * carry[ch] + bf2f(PB[o]) * carry[64 + ch];
            A2[row * D + 512 + h * 64 + ch] = (bf16)f2bf(bf2f(UV[row * DIN + 1536 + h * 64 + ch]) * val); }
        __syncthreads();
    }
}


__device__ __forceinline__ void phase_lru2_fast(const P& p, LAS unsigned char* lds, int tid, int vcu, int G) {
    LAS float* carry = (LAS float*)lds;
    constexpr int NQ = LRU2_PARTS, GR = 32 / NQ, GSH = (NQ == 8) ? 2 : 3;
    const bf16* UV = (const bf16*)(p.ws + WS_UV); const bf16* HS = (const bf16*)(p.ws + WS_HS); const bf16* PF = (const bf16*)(p.ws + WS_PF); const bf16* PB = (const bf16*)(p.ws + WS_PB);
    const float* SUM = (const float*)(p.ws + WS_SUM); bf16* A2 = (bf16*)(p.ws + WS_A2);
    typedef float f32x2 __attribute__((ext_vector_type(2)));
    for (int T = vcu; T < 64 * NQ; T += G) {
        const int b = T / (8 * NQ), h = (T / NQ) & 7, qt = T % NQ;
        v4u hsv[GR], pfv[GR], pbv[GR], ggv[GR];
#pragma unroll
        for (int it = 0; it < GR; ++it) { const int v = it * NTHREADS + tid, pos = v >> 3, c0 = (v & 7) * 8; const size_t row = (size_t)b * SEQ + qt * (64 * GR) + pos, o = row * DLRU + h * 64 + c0;
            hsv[it] = *(const v4u*)(HS + o); pfv[it] = *(const v4u*)(PF + o); pbv[it] = *(const v4u*)(PB + o); ggv[it] = *(const v4u*)(UV + row * DIN + 1536 + h * 64 + c0); }
        if (tid < 128) { const int d = tid >> 6, ch = tid & 63;
            const f32x2* S = (const f32x2*)SUM + ((size_t)b * NSEG * 2 + d) * DLRU + h * 64 + ch;
            f32x2 ab[NSEG];
#pragma unroll
            for (int s2 = 0; s2 < NSEG; ++s2) ab[s2] = S[(size_t)s2 * 2 * DLRU];
            float hc = 0.f;
            if (d == 0) {
#pragma unroll
                for (int s2 = 0; s2 < NSEG; ++s2) { if (s2 >= 4 && ((s2 - 4) >> GSH) == qt) carry[(((s2 - 4) & (GR - 1)) * 2 + 0) * 64 + ch] = hc; hc = ab[s2].x * hc + ab[s2].y; }
            } else {
#pragma unroll
                for (int s2 = 3; s2 >= 0; --s2) hc = ab[s2].x * hc + ab[s2].y;
#pragma unroll
                for (int s2 = NSEG - 1; s2 >= 4; --s2) { if (((s2 - 4) >> GSH) == qt) carry[(((s2 - 4) & (GR - 1)) * 2 + 1) * 64 + ch] = hc; hc = ab[s2].x * hc + ab[s2].y; }
            } }
        __syncthreads();
#pragma unroll
        for (int it = 0; it < GR; ++it) { const int v = it * NTHREADS + tid, pos = v >> 3, c0 = (v & 7) * 8, grl = pos >> 6;
            const size_t row = (size_t)b * SEQ + qt * (64 * GR) + pos;
            const v4u hs = hsv[it], pf = pfv[it], pb = pbv[it], gg = ggv[it];
            const f32x4 cf0 = *(const LAS f32x4*)(carry + (grl * 2) * 64 + c0), cf1 = *(const LAS f32x4*)(carry + (grl * 2) * 64 + c0 + 4);
            const f32x4 cb0 = *(const LAS f32x4*)(carry + (grl * 2 + 1) * 64 + c0), cb1 = *(const LAS f32x4*)(carry + (grl * 2 + 1) * 64 + c0 + 4);
            v4u out;
            out.x = pk2(bflo(gg.x) * (bflo(hs.x) + bflo(pf.x) * cf0.x + bflo(pb.x) * cb0.x), bfhi(gg.x) * (bfhi(hs.x) + bfhi(pf.x) * cf0.y + bfhi(pb.x) * cb0.y));
            out.y = pk2(bflo(gg.y) * (bflo(hs.y) + bflo(pf.y) * cf0.z + bflo(pb.y) * cb0.z), bfhi(gg.y) * (bfhi(hs.y) + bfhi(pf.y) * cf0.w + bfhi(pb.y) * cb0.w));
            out.z = pk2(bflo(gg.z) * (bflo(hs.z) + bflo(pf.z) * cf1.x + bflo(pb.z) * cb1.x), bfhi(gg.z) * (bfhi(hs.z) + bfhi(pf.z) * cf1.y + bfhi(pb.z) * cb1.y));
            out.w = pk2(bflo(gg.w) * (bflo(hs.w) + bflo(pf.w) * cf1.z + bflo(pb.w) * cb1.z), bfhi(gg.w) * (bfhi(hs.w) + bfhi(pf.w) * cf1.w + bfhi(pb.w) * cb1.w));
            *(v4u*)(A2 + row * D + 512 + h * 64 + c0) = out; }
        __syncthreads();
    }
}

__device__ __forceinline__ void phase_p5(const P& p, LAS unsigned char* lds, int tid, int lane, int wave, int vcu, int G) {
    LAS float* wrT = (LAS float*)lds;
    const float* MOD = (const float*)(p.ws + WS_MOD); const float* X1 = (const float*)(p.ws + WS_X1); bf16* HX2 = (bf16*)(p.ws + WS_HX2); float* AFF = (float*)(p.ws + WS_AFF);
    for (int i = tid; i < D * NE; i += NTHREADS) wrT[(i & 15) * D + (i >> 4)] = p.w_router[i];
    __syncthreads();
    const int gw = vcu * NWAVES + wave, NGW = G * NWAVES;
    f32x4 nx[4];
    if (gw < M) { const f32x4* xr = (const f32x4*)(X1 + (size_t)gw * D) + lane;
#pragma unroll
        for (int jj = 0; jj < 4; ++jj) nx[jj] = xr[64 * jj]; }
    for (int m = gw; m < M; m += NGW) {
        const int b = m >> 11, t = m & 2047;
        f32x4 v[4]; float s = 0.f;
#pragma unroll
        for (int jj = 0; jj < 4; ++jj) { v[jj] = nx[jj]; s += (v[jj].x * v[jj].x + v[jj].y * v[jj].y) + (v[jj].z * v[jj].z + v[jj].w * v[jj].w); }
        if (m + NGW < M) { const f32x4* xr = (const f32x4*)(X1 + (size_t)(m + NGW) * D) + lane;
#pragma unroll
            for (int jj = 0; jj < 4; ++jj) nx[jj] = xr[64 * jj]; }
        const float rinv = rsqrtf(wave_sum(s) * (1.f / D) + EPS);
        v2u* o = (v2u*)(HX2 + (size_t)m * D) + lane;
#pragma unroll
        for (int jj = 0; jj < 4; ++jj) { const int k = 4 * (lane + 64 * jj);
            const f32x4 g = *(const f32x4*)(p.norm2_g + k), sh = *(const f32x4*)(MOD + b * NMOD + 3 * D + k), sc = *(const f32x4*)(MOD + b * NMOD + 4 * D + k);
            v[jj] = v[jj] * rinv * g * (sc + 1.f) + sh;
#if MOE_FP8
            ((unsigned*)(p.ws + WS_HX2) + (size_t)m * (D / 4))[lane + 64 * jj] = pk4_fp8(v[jj].x, v[jj].y, v[jj].z, v[jj].w); }
#else
            v2u w; w.x = pk2(v[jj].x, v[jj].y); w.y = pk2(v[jj].z, v[jj].w); o[64 * jj] = w; }
#endif
        float pa[16];
#pragma unroll
        for (int e = 0; e < 16; ++e) { float a = 0.f;
#pragma unroll
            for (int jj = 0; jj < 4; ++jj) { const f32x4 w = *(const LAS f32x4*)(wrT + e * D + 4 * (lane + 64 * jj)); a += (v[jj].x * w.x + v[jj].y * w.y) + (v[jj].z * w.z + v[jj].w * w.w); }
            pa[e] = a; if (e & 1) asm volatile("" ::: "memory"); }
        { const bool h5 = (lane & 32) != 0; float q8[8];
#pragma unroll
          for (int i = 0; i < 8; ++i) { const float keep = h5 ? pa[8 + i] : pa[i], give = h5 ? pa[i] : pa[8 + i]; q8[i] = keep + __shfl_xor(give, 32); }
          const bool h4 = (lane & 16) != 0; float q4[4];
#pragma unroll
          for (int i = 0; i < 4; ++i) { const float keep = h4 ? q8[4 + i] : q8[i], give = h4 ? q8[i] : q8[4 + i]; q4[i] = keep + __shfl_xor(give, 16); }
          const bool h3 = (lane & 8) != 0; float q2[2];
#pragma unroll
          for (int i = 0; i < 2; ++i) { const float keep = h3 ? q4[2 + i] : q4[i], give = h3 ? q4[i] : q4[2 + i]; q2[i] = keep + __shfl_xor(give, 8); }
          const bool h2 = (lane & 4) != 0;
          float lgt = (h2 ? q2[1] : q2[0]) + __shfl_xor(h2 ? q2[0] : q2[1], 4);
          lgt += __shfl_xor(lgt, 2); lgt += __shfl_xor(lgt, 1);
          float mx = lgt;
#pragma unroll
          for (int o2 = 4; o2 < 64; o2 <<= 1) mx = fmaxf(mx, __shfl_xor(mx, o2));
          const float ex = expf(lgt - mx); float den = ex;
#pragma unroll
          for (int o2 = 4; o2 < 64; o2 <<= 1) den += __shfl_xor(den, o2);
          if ((lane & 3) == 0) AFF[(size_t)(b * NE + (lane >> 2)) * SEQ + t] = ex / den; }
    }
    __syncthreads();
}

__device__ __forceinline__ void phase_p6(const P& p, LAS unsigned char* lds, int tid, int lane, int wave, int vcu, int G) {
    LAS float* a = (LAS float*)lds; LAS int* tok = (LAS int*)(lds + 8192);
    const float* AFF = (const float*)(p.ws + WS_AFF); int* SLOT = (int*)(p.ws + WS_SLOT); float* GATE = (float*)(p.ws + WS_GATE);
    const bf16* HX2 = (const bf16*)(p.ws + WS_HX2); bf16* XE = (bf16*)(p.ws + WS_XE);
    for (int T = vcu; T < BATCH * NE; T += G) {
        const int b = T >> 4, e = T & 15;
        for (int i = tid; i < SEQ; i += NTHREADS) a[i] = AFF[(size_t)(b * NE + e) * SEQ + i];
        __syncthreads();
        float at[4]; int rk[4];
#pragma unroll
        for (int i = 0; i < 4; ++i) { at[i] = a[tid + 512 * i]; rk[i] = 0; }
        for (int t2 = 0; t2 < SEQ; ++t2) { const float av = a[t2];
#pragma unroll
            for (int i = 0; i < 4; ++i) rk[i] += (av > at[i] || (av == at[i] && t2 < tid + 512 * i)) ? 1 : 0; }
#pragma unroll
        for (int i = 0; i < 4; ++i) { const int t = tid + 512 * i; SLOT[(size_t)(b * SEQ + t) * NE + e] = rk[i] < CAP ? rk[i] : -1;
            if (rk[i] < CAP) { tok[rk[i]] = t; GATE[e * 2048 + b * CAP + rk[i]] = at[i]; } }
        __syncthreads();
        for (int r = wave; r < CAP; r += NWAVES) { const v4u* src = (const v4u*)(HX2 + (size_t)(b * SEQ + tok[r]) * D); v4u* dst = (v4u*)(XE + (size_t)(e * 2048 + b * CAP + r) * D);
            dst[lane] = src[lane]; dst[lane + 64] = src[lane + 64]; }
        __syncthreads();
    }
}


__device__ __forceinline__ unsigned block_sum_u(unsigned v, LAS unsigned* red, int lane, int wave) {
    v = (unsigned)wave_sum((float)v);
    if (lane == 0) red[wave] = v;
    __syncthreads();
    unsigned s = 0;
#pragma unroll
    for (int w = 0; w < 8; ++w) s += red[w];
    return s;
}
__device__ __forceinline__ unsigned block_excl_scan(unsigned c, unsigned& total, LAS unsigned* red, int lane, int wave) {
    unsigned inc = c;
#pragma unroll
    for (int o = 1; o < 64; o <<= 1) { const unsigned t = __shfl_up(inc, o); if (lane >= o) inc += t; }
    if (lane == 63) red[wave] = inc;
    __syncthreads();
    unsigned off = 0, tot = 0;
#pragma unroll
    for (int w = 0; w < 8; ++w) { const unsigned x = red[w]; off += (w < wave) ? x : 0u; tot += x; }
    total = tot; return off + inc - c;
}
__device__ __forceinline__ void phase_p6_fast(const P& p, LAS unsigned char* lds, int tid, int lane, int wave, int vcu, int G) {
    LAS unsigned* red = (LAS unsigned*)lds;
    LAS int* tok = (LAS int*)(lds + 2048);
    const float* AFF = (const float*)(p.ws + WS_AFF); int* SLOT = (int*)(p.ws + WS_SLOT); float* GATE = (float*)(p.ws + WS_GATE);
    const bf16* HX2 = (const bf16*)(p.ws + WS_HX2); bf16* XE = (bf16*)(p.ws + WS_XE);
    for (int T = vcu; T < BATCH * NE * 2; T += G) {
        const int half = T & 1, e = (T >> 1) & 15, b = T >> 5;
        const f32x4 av = *(const f32x4*)(AFF + (size_t)(b * NE + e) * SEQ + 4 * tid);
        unsigned bits[4] = {__float_as_uint(av.x), __float_as_uint(av.y), __float_as_uint(av.z), __float_as_uint(av.w)};
        unsigned lo = 0u, hi = 0x3f800000u; int rb = 0;
        while (lo < hi) {
            const unsigned span = hi - lo, q = (span + 3u) >> 2, t1 = lo + q, t2 = min(lo + 2u * q, hi), t3 = min(lo + 3u * q, hi);
            unsigned w = 0;
#pragma unroll
            for (int i = 0; i < 4; ++i) w += (bits[i] >= t1 ? 1u : 0u) + (bits[i] >= t2 ? (1u << 10) : 0u) + (bits[i] >= t3 ? (1u << 20) : 0u);
#pragma unroll
            for (int o = 1; o < 64; o <<= 1) w += __shfl_xor(w, o);
            LAS unsigned* rd = red + 8 * rb; rb = (rb + 1) % 36;
            if (lane == 0) rd[wave] = w;
            __syncthreads();
            unsigned c1 = 0, c2 = 0, c3 = 0;
#pragma unroll
            for (int ww = 0; ww < 8; ++ww) { const unsigned x = rd[ww]; c1 += x & 1023u; c2 += (x >> 10) & 1023u; c3 += x >> 20; }
            if (c3 >= (unsigned)CAP) lo = t3; else if (c2 >= (unsigned)CAP) { lo = t2; hi = t3 - 1u; } else if (c1 >= (unsigned)CAP) { lo = t1; hi = t2 - 1u; } else hi = t1 - 1u;
        }
        const unsigned Tb = lo;
        unsigned cg = 0, ct = 0;
#pragma unroll
        for (int i = 0; i < 4; ++i) { cg += (bits[i] > Tb) ? 1u : 0u; ct += (bits[i] == Tb) ? 1u : 0u; }
        unsigned ngt; const unsigned need = (unsigned)CAP - (ngt = block_sum_u(cg, red + 8 * 36, lane, wave));
        unsigned ttot; unsigned tpre = block_excl_scan(ct, ttot, red + 8 * 37, lane, wave);
        unsigned sel[4], cs = 0;
#pragma unroll
        for (int i = 0; i < 4; ++i) { const bool tie = bits[i] == Tb; sel[i] = (bits[i] > Tb || (tie && tpre < need)) ? 1u : 0u; tpre += tie ? 1u : 0u; cs += sel[i]; }
        unsigned stot; unsigned spre = block_excl_scan(cs, stot, red + 8 * 38, lane, wave);
#pragma unroll
        for (int i = 0; i < 4; ++i) { const int t = 4 * tid + i;
            if ((t >> 10) == half) SLOT[(size_t)(b * SEQ + t) * NE + e] = sel[i] ? (int)spre : -1;
            if (sel[i]) { tok[spre] = t; if ((int)(spre >> 7) == half) GATE[e * 2048 + b * CAP + spre] = __uint_as_float(bits[i]); spre += 1u; } }
        __syncthreads();
#if MOE_FP8
        if (tid < 128) ((int*)(p.ws + WS_TOK))[e * 2048 + b * CAP + half * 128 + tid] = b * SEQ + tok[half * 128 + tid];
#else
        for (int r = half * 128 + wave; r < half * 128 + 128; r += NWAVES) { const v4u* src = (const v4u*)(HX2 + (size_t)(b * SEQ + tok[r]) * D); v4u* dst = (v4u*)(XE + (size_t)(e * 2048 + b * CAP + r) * D);
            dst[lane] = src[lane]; dst[lane + 64] = src[lane + 64]; }
#endif
        __syncthreads();
    }
}

__device__ __forceinline__ void phase_p9(const P& p, int lane, int wave, int vcu, int G) {
    const float* MOD = (const float*)(p.ws + WS_MOD); const float* X1 = (const float*)(p.ws + WS_X1); const int* SLOT = (const int*)(p.ws + WS_SLOT); const bf16* YE = (const bf16*)(p.ws + WS_YE);
    const int gw = vcu * NWAVES + wave, NGW = G * NWAVES;
    f32x4 nx[4]; int nslot = -1;
    if (gw < M) { const f32x4* xr = (const f32x4*)(X1 + (size_t)gw * D) + lane;
#pragma unroll
        for (int jj = 0; jj < 4; ++jj) nx[jj] = xr[64 * jj];
        nslot = SLOT[(size_t)gw * NE + (lane & 15)]; }
    for (int m = gw; m < M; m += NGW) {
        const int b = m >> 11;
        f32x4 v[4], acc[4]; const int myslot = nslot;
#pragma unroll
        for (int jj = 0; jj < 4; ++jj) { v[jj] = nx[jj]; acc[jj] = (f32x4){0.f, 0.f, 0.f, 0.f}; }
        if (m + NGW < M) { const f32x4* xr = (const f32x4*)(X1 + (size_t)(m + NGW) * D) + lane;
#pragma unroll
            for (int jj = 0; jj < 4; ++jj) nx[jj] = xr[64 * jj];
            nslot = SLOT[(size_t)(m + NGW) * NE + (lane & 15)]; }
#pragma unroll
        for (int e = 0; e < NE; ++e) { const int sl = __builtin_amdgcn_readlane(myslot, e);
#if MOE_FP8
            if (sl >= 0) { const unsigned* y = (const unsigned*)((const unsigned char*)YE + (size_t)(e * 2048 + b * CAP + sl) * D) + lane;
#pragma unroll
                for (int jj = 0; jj < 4; ++jj) { const unsigned w = y[64 * jj]; const auto lo = __builtin_amdgcn_cvt_pk_f32_fp8((int)w, false), hi = __builtin_amdgcn_cvt_pk_f32_fp8((int)w, true);
                    acc[jj] += (f32x4){lo[0], lo[1], hi[0], hi[1]}; } } }
#else
            if (sl >= 0) { const v2u* y = (const v2u*)(YE + (size_t)(e * 2048 + b * CAP + sl) * D) + lane;
#pragma unroll
                for (int jj = 0; jj < 4; ++jj) { const v2u w = y[64 * jj]; acc[jj] += (f32x4){bflo(w.x), bfhi(w.x), bflo(w.y), bfhi(w.y)}; } } }
#endif
        float s = 0.f;
#pragma unroll
        for (int jj = 0; jj < 4; ++jj) { const int k = 4 * (lane + 64 * jj); const f32x4 g2 = *(const f32x4*)(MOD + b * NMOD + 5 * D + k); v[jj] += g2 * acc[jj] * (MOE_FP8 ? WSCALE_INV : 1.f);
            s += (v[jj].x * v[jj].x + v[jj].y * v[jj].y) + (v[jj].z * v[jj].z + v[jj].w * v[jj].w); }
        const float rinv = rsqrtf(wave_sum(s) * (1.f / D) + EPS);
        f32x4* o = (f32x4*)(p.out + (size_t)m * D) + lane;
#pragma unroll
        for (int jj = 0; jj < 4; ++jj) { const int k = 4 * (lane + 64 * jj); o[64 * jj] = v[jj] * rinv * *(const f32x4*)(p.final_g + k); }
    }
}

#if CONV_CUS && MOE_FP8 && XCD_BAR && LRU1_MFMA && SGU_MFMA && LRU2_FAST && P6_FAST && USE_PG8 && (MK_N_LAUNCHES == 1)
__global__ void __launch_bounds__(NTHREADS, 2) fwd_megakernel(P p) {
    extern __shared__ __attribute__((aligned(16))) unsigned char lds_raw[];
    LAS unsigned char* lds = (LAS unsigned char*)lds_raw;
    const int tid = threadIdx.x, lane = tid & 63, wave = __builtin_amdgcn_readfirstlane(tid >> 6);
    const int G = gridDim.x, bx = blockIdx.x, xg = bx & 7, xl = bx >> 3;
    const int vcu = (G % 8 == 0) ? xg * (G / 8) + xl : bx;
    constexpr int CSH = (NCONV == 64) ? 2 : 3, CPG = 32 >> CSH, WPG = 32 - CPG;
    const bool split = (G == 256), is_conv = split && ((xl & ((1 << CSH) - 1)) == (1 << CSH) - 1);
    const int GW = split ? 8 * WPG : G, wvcu = split ? xg * WPG + (xl - (xl >> CSH)) : vcu, cvcu = xg * CPG + (xl >> CSH);
    volatile LAS unsigned* bst = (volatile LAS unsigned*)(lds + LDS_BYTES - 16);
    if (tid < 4) bst[tid] = 0u;
    __syncthreads();
    unsigned* ctl = (unsigned*)(p.ws + WS_CTL);
    const XcdBarrier barA = xcd_barrier_post(ctl + 4096, bst, (unsigned)G);
    XcdBarrier barW = barA;
    if (split && !is_conv) barW = xcd_barrier_post(ctl + 4096 + XCD_BAR_WORDS, bst + 2, (unsigned)GW);

    if (is_conv) {
        convert_pipelined(p, lds, lane, wave, CONV_HEAD, CONV_ITEMS, cvcu * NWAVES + wave, 8 * CPG * NWAVES);
        if (tid == 0) { XB_SPIN(xb_ld(ctl + 64) == 0u, ctl + 4096); __builtin_amdgcn_fence(__ATOMIC_ACQUIRE, "agent"); asm volatile("s_waitcnt vmcnt(0)" ::: "memory"); }
        __syncthreads();
        phase_sgu_mfma(p, lds, tid, lane, wave, cvcu, 8 * CPG, 0, SGU_CONV_TASKS);
    } else {
        phase_p0(p, lds, tid, lane, wave, wvcu, GW, split ? 16 * 32 : CONV_ITEMS, !split);
        xcd_barrier(barW);
        phase_p1(p, lane, wave, wvcu, GW);
        if (split) { convert_items(p, lds, lane, wave, 16 * 32, CONV_HEAD, wvcu * NWAVES + wave, GW * NWAVES); p0_small_copies(p, tid, wvcu, GW); }
        xcd_barrier(barW);
        { pg8::Gemm g{(const bf16*)(p.ws + WS_HX), (const bf16*)(p.ws + WS_WIN), D}; SchedG1 S{GW, wvcu}; EpiG1 E{(bf16*)(p.ws + WS_UV), (bf16*)(p.ws + WS_XC)};
          pg8::gemm_phase<EpiG1, SchedG1, true, true>(lds, g, S, E); }
        xcd_barrier(barW);
        if (split && wvcu == 0 && tid == 0) __hip_atomic_store(ctl + 64, 1u, __ATOMIC_RELAXED, __HIP_MEMORY_SCOPE_AGENT);
#if LRU1_V2
        phase_lru1_v2(p, lds, tid, lane, wave, wvcu, GW);
#else
        phase_lru1_mfma(p, lds, tid, lane, wave, wvcu, GW);
#endif
        phase_sgu_mfma(p, lds, tid, lane, wave, wvcu, GW, split ? SGU_CONV_TASKS : 0, 512);
        xcd_barrier(barW);
        phase_lru2_fast(p, lds, tid, wvcu, GW);
    }
    xcd_barrier(barA);
    if (split) {
        pg8::Gemm g{(const bf16*)(p.ws + WS_A2), (const bf16*)(p.ws + WS_WOUT), D}; SchedG2 S{G, vcu};
        EpiG2F E{p.x, (const float*)(p.ws + WS_MOD), (float*)(p.ws + WS_X1), p.w_router, p.norm2_g, (const float*)(p.ws + WS_CB), (float*)(p.ws + WS_XCH), ctl + 2048, ctl + 4096, p.ws + WS_HX2, (float*)(p.ws + WS_AFF)};
        pg8::gemm_phase<EpiG2F, SchedG2, true, true>(lds, g, S, E);
    } else {
        { pg8::Gemm g{(const bf16*)(p.ws + WS_A2), (const bf16*)(p.ws + WS_WOUT), D}; SchedG2 S{G, vcu}; EpiG2 E{p.x, (const float*)(p.ws + WS_MOD), (float*)(p.ws + WS_X1)};
          pg8::gemm_phase<EpiG2, SchedG2, true, true>(lds, g, S, E); }
        xcd_barrier(barA);
        phase_p5(p, lds, tid, lane, wave, vcu, G);
    }
    xcd_barrier(barA);
    phase_p6_fast(p, lds, tid, lane, wave, vcu, G);
    xcd_barrier(barA);
    { pg8::Gemm g{(const bf16*)(p.ws + WS_HX2), (const bf16*)(p.ws + WS_WG), D}; SchedG3 S{G, vcu}; EpiG3 E{p.ws + WS_HID};
      pg8::gemm_phase_f8g<EpiG3, SchedG3, true, true>(lds, g, S, E, (const int*)(p.ws + WS_TOK)); }
    xcd_barrier(barA);
    { pg8::Gemm g{(const bf16*)(p.ws + WS_HID), (const bf16*)(p.ws + WS_W2), DE}; SchedG4 S{G, vcu}; EpiG4 E{(const float*)(p.ws + WS_GATE), p.ws + WS_YE};
      pg8::gemm_phase_f8<EpiG4, SchedG4, true, true>(lds, g, S, E); }
    xcd_barrier(barA);
    phase_p9(p, lane, wave, vcu, G);
}
#else
__global__ void __launch_bounds__(NTHREADS, 2) fwd_megakernel(P p) {
    extern __shared__ __attribute__((aligned(16))) unsigned char lds_raw[];
    LAS unsigned char* lds = (LAS unsigned char*)lds_raw;
    const int tid = threadIdx.x, lane = tid & 63, wave = __builtin_amdgcn_readfirstlane(tid >> 6);
    const int G = gridDim.x, bx = blockIdx.x, vcu = (G % 8 == 0) ? (bx % 8) * (G / 8) + bx / 8 : bx;
    const int lo = p.ph_lo, hi = p.ph_hi;
#if XCD_BAR
    volatile LAS unsigned* bst = (volatile LAS unsigned*)(lds + LDS_BYTES - 16);
    if (tid < 2) bst[tid] = 0u;
    __syncthreads();
    XcdBarrier bar; bar.bar = (unsigned*)(p.ws + WS_CTL) + 4096; bar.x = 0; bar.st = bst; bar.total = (unsigned)G;
    if (hi - lo > 1) bar = xcd_barrier_post((unsigned*)(p.ws + WS_CTL) + 4096, bst, (unsigned)G);
#define GRID_SYNC() xcd_barrier(bar)
#else
    cg::grid_group grid = cg::this_grid();
#define GRID_SYNC() grid.sync()
#endif
#define IN(k) (lo <= (k) && (k) < hi)
#define SEAM(k) do { if (IN(k) && IN((k) + 1)) GRID_SYNC(); } while (0)
#define REP(k) for (int rep_ = 0; rep_ < 1 + ((DUP_MASK >> (k)) & 1); ++rep_)
    if (IN(0)) { REP(0) { phase_p0(p, lds, tid, lane, wave, vcu, G, CONV_CUT); __syncthreads(); } SEAM(0); }
    if (IN(1)) { REP(1) phase_p1(p, lane, wave, vcu, G); SEAM(1); }
    if ((DUP_MASK >> 12) & 1) { for (int xb = 0; xb < 8; ++xb) GRID_SYNC(); }
    if (IN(2)) { pg8::Gemm g{(const bf16*)(p.ws + WS_HX), (const bf16*)(p.ws + WS_WIN), D}; SchedG1 S{G, vcu}; EpiG1 E{(bf16*)(p.ws + WS_UV), (bf16*)(p.ws + WS_XC)};
        REP(2) { gemm_any(lds, g, S, E); if (G > 16 && vcu >= 16) convert_items(p, lds, lane, wave, CONV_CUT, CONV_ITEMS, (vcu - 16) * NWAVES + wave, (G - 16) * NWAVES); }
        if (G <= 16) convert_items(p, lds, lane, wave, CONV_CUT, CONV_ITEMS, vcu * NWAVES + wave, G * NWAVES);
        SEAM(2); }
    if (IN(3)) { REP(3) {
#if LRU1_MFMA
        phase_lru1_mfma(p, lds, tid, lane, wave, vcu, G);
#else
        phase_lru1(p, lds, tid, vcu, G);
#endif
        } REP(11) {
#if SGU_MFMA
        phase_sgu_mfma(p, lds, tid, lane, wave, vcu, G);
#else
        phase_sgu(p, lds, tid, vcu, G);
#endif
        } SEAM(3); }
    if (IN(4)) { REP(4) {
#if LRU2_FAST
        phase_lru2_fast(p, lds, tid, vcu, G);
#else
        phase_lru2(p, lds, tid, vcu, G);
#endif
        } SEAM(4); }
    if (IN(5)) { pg8::Gemm g{(const bf16*)(p.ws + WS_A2), (const bf16*)(p.ws + WS_WOUT), D}; SchedG2 S{G, vcu}; EpiG2 E{p.x, (const float*)(p.ws + WS_MOD), (float*)(p.ws + WS_X1)};
        REP(5) gemm_any(lds, g, S, E); SEAM(5); }
    if (IN(6)) { REP(6) phase_p5(p, lds, tid, lane, wave, vcu, G); SEAM(6); }
    if (IN(7)) { REP(7) {
#if P6_FAST
        phase_p6_fast(p, lds, tid, lane, wave, vcu, G);
#else
        phase_p6(p, lds, tid, lane, wave, vcu, G);
#endif
        } SEAM(7); }
#if MOE_FP8
    if (IN(8)) { pg8::Gemm g{(const bf16*)(p.ws + WS_XE), (const bf16*)(p.ws + WS_WG), D}; SchedG3 S{G, vcu}; EpiG3 E{p.ws + WS_HID};
        REP(8) pg8::gemm_phase_f8<EpiG3, SchedG3, true, true>(lds, g, S, E); SEAM(8); }
    if (IN(9)) { pg8::Gemm g{(const bf16*)(p.ws + WS_HID), (const bf16*)(p.ws + WS_W2), DE}; SchedG4 S{G, vcu}; EpiG4 E{(const float*)(p.ws + WS_GATE), p.ws + WS_YE};
        REP(9) pg8::gemm_phase_f8<EpiG4, SchedG4, true, true>(lds, g, S, E); SEAM(9); }
#else
    if (IN(8)) { pg8::Gemm g{(const bf16*)(p.ws + WS_XE), (const bf16*)(p.ws + WS_WG), D}; SchedG3 S{G, vcu}; EpiG3 E{(bf16*)(p.ws + WS_HID)};
        REP(8) gemm_any(lds, g, S, E); SEAM(8); }
    if (IN(9)) { pg8::Gemm g{(const bf16*)(p.ws + WS_HID), (const bf16*)(p.ws + WS_W2), DE}; SchedG4 S{G, vcu}; EpiG4 E{(const float*)(p.ws + WS_GATE), (bf16*)(p.ws + WS_YE)};
        REP(9) gemm_any(lds, g, S, E); SEAM(9); }
#endif
    if (IN(10)) { REP(10) phase_p9(p, lane, wave, vcu, G); }
#undef IN
#undef REP
#undef SEAM
#undef GRID_SYNC
}

#endif

extern "C" void kernel_launch(void* const* d_in, const int* in_sizes, int n_in, void* d_out, int out_size, void* d_ws, size_t ws_size, hipStream_t stream) {
    static int grid = 0;
    if (grid == 0) {
        if (n_in != 25 || in_sizes[0] != M * D || out_size != M * D || ws_size < WS_END) { fprintf(stderr, "kernel_launch: unexpected shapes (n_in %d, in0 %d, out %d, ws %zu < %zu)\n", n_in, n_in > 0 ? in_sizes[0] : -1, out_size, ws_size, (size_t)WS_END); grid = -1; return; }
        int dev = 0, cus = 0, per_cu = 0;
        if (hipGetDevice(&dev) != hipSuccess || hipDeviceGetAttribute(&cus, hipDeviceAttributeMultiprocessorCount, dev) != hipSuccess) { grid = -1; return; }
        if (hipFuncSetAttribute((const void*)fwd_megakernel, hipFuncAttributeMaxDynamicSharedMemorySize, LDS_BYTES) != hipSuccess) { fprintf(stderr, "kernel_launch: hipFuncSetAttribute failed\n"); grid = -1; return; }
        if (hipOccupancyMaxActiveBlocksPerMultiprocessor(&per_cu, (const void*)fwd_megakernel, NTHREADS, LDS_BYTES) != hipSuccess || per_cu < 1) { fprintf(stderr, "kernel_launch: occupancy query failed (%d)\n", per_cu); (void)hipGetLastError(); grid = -1; return; }
        grid = cus * per_cu;
    }
    if (grid < 0) return;
#if XCD_BAR
    if (hipMemsetAsync((char*)d_ws + WS_CTL, 0, 65536, stream) != hipSuccess) { fprintf(stderr, "kernel_launch: hipMemsetAsync failed\n"); return; }
#endif
    P p{};
    const float** f = (const float**)&p;
    for (int i = 0; i < 25; ++i) f[i] = (const float*)d_in[i];
    p.out = (float*)d_out; p.ws = (unsigned char*)d_ws;
#if MK_N_LAUNCHES == 1
    p.ph_lo = 0; p.ph_hi = NPH; void* args[] = {&p};
    hipError_t e = hipLaunchCooperativeKernel((const void*)fwd_megakernel, dim3(grid), dim3(NTHREADS), args, LDS_BYTES, stream);
    if (e != hipSuccess) fprintf(stderr, "kernel_launch: cooperative launch failed: %s (grid %d)\n", hipGetErrorString(e), grid);
#else
    for (int ph = 0; ph < NPH; ++ph) { p.ph_lo = ph; p.ph_hi = ph + 1; hipLaunchKernelGGL(fwd_megakernel, dim3(grid), dim3(NTHREADS), LDS_BYTES, stream, p); }
#endif
}
```

```cpp
#include <hip/hip_runtime.h>
#include <hip/hip_cooperative_groups.h>
#include <cstdio>
#include <cstdint>
namespace cg = cooperative_groups;

#ifndef MK_N_LAUNCHES
#define MK_N_LAUNCHES 1
#endif
#ifndef XCD_BAR
#define XCD_BAR 1
#endif
#ifndef LRU1_MFMA
#define LRU1_MFMA 1
#endif
#ifndef SGU_MFMA
#define SGU_MFMA 1
#endif
#ifndef P6_FAST
#define P6_FAST 1
#endif
#ifndef DUP_MASK
#define DUP_MASK 0
#endif
#ifndef LRU2_FAST
#define LRU2_FAST 1
#endif
#ifndef MOE_FP8
#define MOE_FP8 1
#endif
#ifndef CONV_CUS
#define CONV_CUS 1
#endif
#ifndef NCONV
#define NCONV 64
#endif
#ifndef LRU1_V2
#define LRU1_V2 1
#endif
#ifndef SGU_CONV_TASKS
#define SGU_CONV_TASKS 128
#endif
#ifndef LRU2_PARTS
#define LRU2_PARTS 8
#endif
#ifndef USE_PG8
#define USE_PG8 1
#endif

namespace pg8 {
#define PG8_LAS __attribute__((address_space(3)))
typedef unsigned short bf16_t;
typedef short bf16x8 __attribute__((ext_vector_type(8)));
typedef float f32x4 __attribute__((ext_vector_type(4)));
typedef unsigned u32x4 __attribute__((ext_vector_type(4)));
typedef int v4i_t __attribute__((ext_vector_type(4)));
typedef int v8i_t __attribute__((ext_vector_type(8)));
constexpr int BM = 256, BK = 64, HALF = 128, HTB = HALF * BK * 2  , STAGE_BYTES = 8 * HTB;

__host__ __device__ __forceinline__ int lds_byte(int r, int c) { const int st = (r >> 4) * 2 + (c >> 5), rr = r & 15, cc = c & 31, ob = rr * 64 + cc * 2; return st * 1024 + (ob ^ (((ob >> 9) & 1) << 5)); }
__host__ __device__ __forceinline__ void stage_rc(int b, int& R, int& C) { const int st = b / 1024, sb = b % 1024, swz = sb ^ (((sb >> 9) & 1) << 5); R = (st >> 1) * 16 + swz / 64; C = (st & 1) * 32 + (swz % 64) / 2; }

struct Unit { int pm, pn, pnB; };
struct Gemm { const bf16_t* A; const bf16_t* Bt; int K; };

template <class Epi>
__device__ __forceinline__ void run_epi8(const Epi& E, const f32x4 (&acc)[2][2][4][2], const Unit& u, int wr, int wc, int fr, int fq) {
#pragma unroll
    for (int ai = 0; ai < 2; ++ai)
#pragma unroll
        for (int m = 0; m < 4; ++m) { const int row = ai * HALF + wr * 64 + m * 16 + fr;
            if constexpr (Epi::PAIRED) E.st2x8(u, row, wc * 32 + 8 * fq, acc[ai][0][m][0], acc[ai][0][m][1], acc[ai][1][m][0], acc[ai][1][m][1]);
            else {
#pragma unroll
                for (int bj = 0; bj < 2; ++bj) E.st8(u, row, bj * HALF + wc * 32 + 8 * fq, acc[ai][bj][m][0], acc[ai][bj][m][1]);
            } }
}
template <class Epi>
__device__ __forceinline__ void run_epi(const Epi& E, const f32x4 (&acc)[2][2][4][2], const Unit& u, int wr, int wc, int fr, int fq) {
#pragma unroll
    for (int ai = 0; ai < 2; ++ai)
#pragma unroll
        for (int m = 0; m < 4; ++m) { const int row = ai * HALF + wr * 64 + m * 16 + fr;
            if constexpr (Epi::PAIRED) {
#pragma unroll
                for (int n = 0; n < 2; ++n) E.st2(u, row, wc * 32 + n * 16 + 4 * fq, acc[ai][0][m][n], acc[ai][1][m][n]);
            } else {
#pragma unroll
                for (int bj = 0; bj < 2; ++bj)
#pragma unroll
                    for (int n = 0; n < 2; ++n) E.st(u, row, bj * HALF + wc * 32 + n * 16 + 4 * fq, acc[ai][bj][m][n]);
            } }
}

template <class Epi, class Sched, bool ALIGN_EPI = false, bool SP2 = false>
__device__ __forceinline__ void gemm_phase(PG8_LAS unsigned char* lds, const Gemm g, const Sched& S, const Epi& E) {
    const int tid = threadIdx.x, wid = __builtin_amdgcn_readfirstlane(tid >> 6), lane = tid & 63, wr = wid >> 2, wc = wid & 3, fr = lane & 15, fq = lane >> 4;
    const int K = g.K, nt = K / BK;
    unsigned voffA[2], voffB[2];
#pragma unroll
    for (int i = 0; i < 2; ++i) { int R, C; stage_rc(tid * 16 + i * 8192, R, C); const int rho = R & 31, Rb = (R & ~31) + 8 * ((rho & 15) >> 2) + 4 * (rho >> 4) + (rho & 3);
        voffA[i] = (unsigned)(R * K + C) * 2u; voffB[i] = (unsigned)(Rb * K + C) * 2u; }
    const size_t kstep = (size_t)(BK * 2);
    const size_t hstep = (size_t)HALF * K * 2;
    const size_t tstep = 2 * hstep;
    const unsigned ldsw = (unsigned)wid * 1024u;
    const int aoff = lds_byte(wr * 64 + fr, fq * 8), boff = lds_byte(wc * 32 + fr, fq * 8);
#define PG8_SA(b, h) (((b) * 2 + (h)) * HTB)
#define PG8_SB(b, h) ((4 + (b) * 2 + (h)) * HTB)
#define PG8_STAGE(bufoff, gbase, voff) do { _Pragma("unroll") for (int _i = 0; _i < 2; ++_i) \
        __builtin_amdgcn_global_load_lds((const unsigned*)((const char*)(gbase) + (voff)[_i]), (PG8_LAS unsigned*)(lds + (bufoff) + ldsw + _i * 8192), 16, 0, 0); } while (0)
#define PG8_LDA(dst, b, h) do { _Pragma("unroll") for (int m = 0; m < 4; ++m) _Pragma("unroll") for (int k = 0; k < 2; ++k) dst[m][k] = *(const PG8_LAS bf16x8*)(lds + PG8_SA(b, h) + aoff + m * 2048 + k * 1024); } while (0)
#define PG8_LDB(dst, b, h) do { _Pragma("unroll") for (int n = 0; n < 2; ++n) _Pragma("unroll") for (int k = 0; k < 2; ++k) dst[n][k] = *(const PG8_LAS bf16x8*)(lds + PG8_SB(b, h) + boff + n * 2048 + k * 1024); } while (0)
#define PG8_MMA(ai, bj, At, Bt) do { __builtin_amdgcn_s_setprio(1); _Pragma("unroll") for (int m = 0; m < 4; ++m) _Pragma("unroll") for (int n = 0; n < 2; ++n) _Pragma("unroll") for (int k = 0; k < 2; ++k) \
        acc[ai][bj][m][n] = __builtin_amdgcn_mfma_f32_16x16x32_bf16(Bt[n][k], At[m][k], acc[ai][bj][m][n], 0, 0, 0); __builtin_amdgcn_s_setprio(0); } while (0)
#define PG8_WAIT_V(n) asm volatile("s_waitcnt vmcnt(" #n ")" ::: "memory")
#define PG8_WAIT_L(n) asm volatile("s_waitcnt lgkmcnt(" #n ")" ::: "memory")
#define PG8_BAR __builtin_amdgcn_s_barrier()
#define PG8_SCHED __builtin_amdgcn_sched_barrier(0)
    Unit cur, nxt; int ui = 0;
    if (!S.next(0, cur)) return;
    f32x4 acc[2][2][4][2];
#pragma unroll
    for (int a = 0; a < 2; ++a)
#pragma unroll
        for (int b = 0; b < 2; ++b)
#pragma unroll
            for (int m = 0; m < 4; ++m)
#pragma unroll
                for (int n = 0; n < 2; ++n) acc[a][b][m][n] = (f32x4){0.f, 0.f, 0.f, 0.f};
    bf16x8 At[4][2], B0[2][2], B1[2][2];
    const char* cA = (const char*)g.A + (size_t)cur.pm * tstep; const char* cB = (const char*)g.Bt + (size_t)cur.pnB * tstep;

    if constexpr (SP2) {
        PG8_STAGE(PG8_SB(0, 0), cB, voffB); PG8_STAGE(PG8_SB(0, 1), cB + hstep, voffB); PG8_STAGE(PG8_SA(0, 0), cA, voffA); PG8_STAGE(PG8_SA(0, 1), cA + hstep, voffA);
        if (wr == 1) PG8_BAR;
        PG8_WAIT_V(2); PG8_BAR;
        PG8_STAGE(PG8_SB(1, 0), cB + kstep, voffB); PG8_STAGE(PG8_SA(1, 0), cA + kstep, voffA); PG8_STAGE(PG8_SB(1, 1), cB + hstep + kstep, voffB);
        PG8_WAIT_V(6); PG8_BAR;
    } else {
        PG8_STAGE(PG8_SB(0, 0), cB, voffB); PG8_STAGE(PG8_SA(0, 0), cA, voffA); PG8_STAGE(PG8_SB(0, 1), cB + hstep, voffB); PG8_STAGE(PG8_SA(0, 1), cA + hstep, voffA);
        if (wr == 1) PG8_BAR;
        PG8_WAIT_V(4); PG8_BAR;
        PG8_STAGE(PG8_SB(1, 0), cB + kstep, voffB); PG8_STAGE(PG8_SA(1, 0), cA + kstep, voffA); PG8_STAGE(PG8_SB(1, 1), cB + hstep + kstep, voffB);
        PG8_WAIT_V(6); PG8_BAR;
    }
    for (;;) {
        const bool has_next = S.next(ui + 1, nxt);
        const char* nA = has_next ? (const char*)g.A + (size_t)nxt.pm * tstep : cA; const char* nB = has_next ? (const char*)g.Bt + (size_t)nxt.pnB * tstep : cB;
        for (int t = 0; t < nt; t += 2) {
            const bool last = (t == nt - 2);
            const char* a1 = cA + (size_t)(t + 1) * kstep;
            const char* a2 = last ? nA : cA + (size_t)(t + 2) * kstep; const char* b2 = last ? nB : cB + (size_t)(t + 2) * kstep;
            const char* a3 = a2 + kstep; const char* b3 = b2 + kstep;

            if constexpr (SP2) {
            PG8_LDB(B0, 0, 0); PG8_LDB(B1, 0, 1); PG8_SCHED; PG8_LDA(At, 0, 0); PG8_STAGE(PG8_SA(1, 1), a1 + hstep, voffA);
            PG8_WAIT_V(8); PG8_WAIT_L(0); PG8_BAR; PG8_MMA(0, 0, At, B0); PG8_MMA(0, 1, At, B1); PG8_BAR; PG8_SCHED;
            PG8_LDA(At, 0, 1); PG8_STAGE(PG8_SB(0, 0), b2, voffB); PG8_STAGE(PG8_SB(0, 1), b2 + hstep, voffB); PG8_STAGE(PG8_SA(0, 0), a2, voffA);
            PG8_WAIT_V(8); PG8_WAIT_L(0); PG8_BAR; PG8_MMA(1, 0, At, B0); PG8_MMA(1, 1, At, B1); PG8_BAR; PG8_SCHED;
            PG8_LDB(B0, 1, 0); PG8_LDB(B1, 1, 1); PG8_SCHED; PG8_LDA(At, 1, 0); PG8_STAGE(PG8_SA(0, 1), a2 + hstep, voffA);
            PG8_WAIT_V(8); PG8_WAIT_L(0); PG8_BAR; PG8_MMA(0, 0, At, B0); PG8_MMA(0, 1, At, B1); PG8_BAR; PG8_SCHED;
            PG8_LDA(At, 1, 1); PG8_STAGE(PG8_SB(1, 0), b3, voffB); PG8_STAGE(PG8_SB(1, 1), b3 + hstep, voffB); PG8_STAGE(PG8_SA(1, 0), a3, voffA);
            PG8_WAIT_V(8); PG8_WAIT_L(0); PG8_BAR; PG8_MMA(1, 0, At, B0); PG8_MMA(1, 1, At, B1); PG8_BAR; PG8_SCHED;
            } else {
            PG8_LDB(B0, 0, 0); PG8_SCHED; PG8_LDA(At, 0, 0); PG8_STAGE(PG8_SA(1, 1), a1 + hstep, voffA);
            PG8_WAIT_L(8); PG8_BAR; PG8_WAIT_L(0); PG8_MMA(0, 0, At, B0); PG8_BAR; PG8_SCHED;
            PG8_LDB(B1, 0, 1); PG8_STAGE(PG8_SB(0, 0), b2, voffB);
            PG8_BAR; PG8_WAIT_L(0); PG8_MMA(0, 1, At, B1); PG8_BAR;
            PG8_LDA(At, 0, 1); PG8_STAGE(PG8_SA(0, 0), a2, voffA);
            PG8_BAR; PG8_WAIT_L(0); PG8_MMA(1, 0, At, B0); PG8_BAR; PG8_SCHED;
            PG8_STAGE(PG8_SB(0, 1), b2 + hstep, voffB);
            PG8_WAIT_V(6); PG8_BAR; PG8_MMA(1, 1, At, B1); PG8_BAR;
            PG8_LDB(B0, 1, 0); PG8_SCHED; PG8_LDA(At, 1, 0); PG8_STAGE(PG8_SA(0, 1), a2 + hstep, voffA);
            PG8_WAIT_L(8); PG8_BAR; PG8_WAIT_L(0); PG8_MMA(0, 0, At, B0); PG8_BAR; PG8_SCHED;
            PG8_LDB(B1, 1, 1); PG8_STAGE(PG8_SB(1, 0), b3, voffB);
            PG8_BAR; PG8_WAIT_L(0); PG8_MMA(0, 1, At, B1); PG8_BAR;
            PG8_LDA(At, 1, 1); PG8_STAGE(PG8_SA(1, 0), a3, voffA);
            PG8_BAR; PG8_WAIT_L(0); PG8_MMA(1, 0, At, B0); PG8_BAR; PG8_SCHED;
            PG8_STAGE(PG8_SB(1, 1), b3 + hstep, voffB);
            PG8_WAIT_V(6); PG8_BAR; PG8_MMA(1, 1, At, B1); PG8_BAR;
            }
        }
        if constexpr (ALIGN_EPI) { if (wr == 0) PG8_BAR; }
        if constexpr (!Epi::FUSED) run_epi8(E, acc, cur, wr, wc, fr, fq);
        if (!has_next) break;
#pragma unroll
        for (int a = 0; a < 2; ++a)
#pragma unroll
            for (int b = 0; b < 2; ++b)
#pragma unroll
                for (int m = 0; m < 4; ++m)
#pragma unroll
                    for (int n = 0; n < 2; ++n) acc[a][b][m][n] = (f32x4){0.f, 0.f, 0.f, 0.f};
        cur = nxt; cA = nA; cB = nB; ++ui;
        if constexpr (ALIGN_EPI) { if (wr == 1) PG8_BAR; }
    }
    PG8_WAIT_V(0);
    if constexpr (!ALIGN_EPI) { if (wr == 0) PG8_BAR; }
    PG8_BAR;
    if constexpr (Epi::FUSED) E.fused(acc, cur, wr, wc, fr, fq, lds, wid, lane);

#undef PG8_SA
#undef PG8_SB
#undef PG8_STAGE
#undef PG8_LDA
#undef PG8_LDB
#undef PG8_MMA
#undef PG8_WAIT_V
#undef PG8_WAIT_L
#undef PG8_BAR
#undef PG8_SCHED
}

template <class Epi, class Sched, bool ALIGN_EPI = false, bool SP2 = false>
__device__ __forceinline__ void gemm_phase_f8(PG8_LAS unsigned char* lds, const Gemm g, const Sched& S, const Epi& E) {
    const int tid = threadIdx.x, wid = __builtin_amdgcn_readfirstlane(tid >> 6), lane = tid & 63, wr = wid >> 2, wc = wid & 3, fr = lane & 15, fq = lane >> 4;
    const int RP = g.K, nt = RP / 128;
    unsigned voffA[2], voffB[2];
#pragma unroll
    for (int i = 0; i < 2; ++i) { const int b_ = tid * 16 + i * 8192, R = b_ >> 7, pp = (b_ >> 4) & 7, rr_ = R & 15, ff = ((rr_ >> 1) & 1) | (((rr_ >> 3) & 1) << 2);
        const int rho = R & 31, Rb = (R & ~31) + 8 * ((rho & 15) >> 2) + 4 * (rho >> 4) + (rho & 3);
        voffA[i] = (unsigned)(R * RP + ((pp ^ ff) * 16)); voffB[i] = (unsigned)(Rb * RP + ((pp ^ ff) * 16)); }
    const size_t kstep = (size_t)(BK * 2);
    const size_t hstep = (size_t)HALF * RP;
    const size_t tstep = 2 * hstep;
    const unsigned ldsw = (unsigned)wid * 1024u;
    const int ffr = ((fr >> 1) & 1) | (((fr >> 3) & 1) << 2);
    const int aoff = (wr * 64 + fr) * 128 + (((2 * fq) ^ ffr) * 16), boff = (wc * 32 + fr) * 128 + (((2 * fq) ^ ffr) * 16), hoff = (ffr & 1) ? -16 : 16;
#define PG8_SA(b, h) (((b) * 2 + (h)) * HTB)
#define PG8_SB(b, h) ((4 + (b) * 2 + (h)) * HTB)
#define PG8_STAGE(bufoff, gbase, voff) do { _Pragma("unroll") for (int _i = 0; _i < 2; ++_i) \
        __builtin_amdgcn_global_load_lds((const unsigned*)((const char*)(gbase) + (voff)[_i]), (PG8_LAS unsigned*)(lds + (bufoff) + ldsw + _i * 8192), 16, 0, 0); } while (0)
#define PG8_LDA(dst, b, h) do { _Pragma("unroll") for (int m = 0; m < 4; ++m) { dst[m].lo = *(const PG8_LAS v4i_t*)(lds + PG8_SA(b, h) + aoff + m * 2048); dst[m].hi = *(const PG8_LAS v4i_t*)(lds + PG8_SA(b, h) + aoff + m * 2048 + hoff); } } while (0)
#define PG8_LDB(dst, b, h) do { _Pragma("unroll") for (int n = 0; n < 2; ++n) { dst[n].lo = *(const PG8_LAS v4i_t*)(lds + PG8_SB(b, h) + boff + n * 2048); dst[n].hi = *(const PG8_LAS v4i_t*)(lds + PG8_SB(b, h) + boff + n * 2048 + hoff); } } while (0)
#define PG8_MMA(ai, bj, At, Bt) do { __builtin_amdgcn_s_setprio(1); _Pragma("unroll") for (int m = 0; m < 4; ++m) _Pragma("unroll") for (int n = 0; n < 2; ++n) \
        asm volatile("v_mfma_f32_16x16x128_f8f6f4 %0, %1, %2, %0" : "+v"(acc[ai][bj][m][n]) : "v"(Bt[n]), "v"(At[m])); __builtin_amdgcn_s_setprio(0); } while (0)
#define PG8_WAIT_V(n) asm volatile("s_waitcnt vmcnt(" #n ")" ::: "memory")
#define PG8_WAIT_L(n) asm volatile("s_waitcnt lgkmcnt(" #n ")" ::: "memory")
#define PG8_BAR __builtin_amdgcn_s_barrier()
#define PG8_SCHED __builtin_amdgcn_sched_barrier(0)
    Unit cur, nxt; int ui = 0;
    if (!S.next(0, cur)) return;
    f32x4 acc[2][2][4][2];
#pragma unroll
    for (int a = 0; a < 2; ++a)
#pragma unroll
        for (int b = 0; b < 2; ++b)
#pragma unroll
            for (int m = 0; m < 4; ++m)
#pragma unroll
                for (int n = 0; n < 2; ++n) acc[a][b][m][n] = (f32x4){0.f, 0.f, 0.f, 0.f};
    v8i_t At[4], B0[2], B1[2];
    const char* cA = (const char*)g.A + (size_t)cur.pm * tstep; const char* cB = (const char*)g.Bt + (size_t)cur.pnB * tstep;

    if constexpr (SP2) {
        PG8_STAGE(PG8_SB(0, 0), cB, voffB); PG8_STAGE(PG8_SB(0, 1), cB + hstep, voffB); PG8_STAGE(PG8_SA(0, 0), cA, voffA); PG8_STAGE(PG8_SA(0, 1), cA + hstep, voffA);
        if (wr == 1) PG8_BAR;
        PG8_WAIT_V(2); PG8_BAR;
        PG8_STAGE(PG8_SB(1, 0), cB + kstep, voffB); PG8_STAGE(PG8_SA(1, 0), cA + kstep, voffA); PG8_STAGE(PG8_SB(1, 1), cB + hstep + kstep, voffB);
        PG8_WAIT_V(6); PG8_BAR;
    } else {
        PG8_STAGE(PG8_SB(0, 0), cB, voffB); PG8_STAGE(PG8_SA(0, 0), cA, voffA); PG8_STAGE(PG8_SB(0, 1), cB + hstep, voffB); PG8_STAGE(PG8_SA(0, 1), cA + hstep, voffA);
        if (wr == 1) PG8_BAR;
        PG8_WAIT_V(4); PG8_BAR;
        PG8_STAGE(PG8_SB(1, 0), cB + kstep, voffB); PG8_STAGE(PG8_SA(1, 0), cA + kstep, voffA); PG8_STAGE(PG8_SB(1, 1), cB + hstep + kstep, voffB);
        PG8_WAIT_V(6); PG8_BAR;
    }
    for (;;) {
        const bool has_next = S.next(ui + 1, nxt);
        const char* nA = has_next ? (const char*)g.A + (size_t)nxt.pm * tstep : cA; const char* nB = has_next ? (const char*)g.Bt + (size_t)nxt.pnB * tstep : cB;
        for (int t = 0; t < nt; t += 2) {
            const bool last = (t == nt - 2);
            const char* a1 = cA + (size_t)(t + 1) * kstep;
            const char* a2 = last ? nA : cA + (size_t)(t + 2) * kstep; const char* b2 = last ? nB : cB + (size_t)(t + 2) * kstep;
            const char* a3 = a2 + kstep; const char* b3 = b2 + kstep;

            if constexpr (SP2) {
            PG8_LDB(B0, 0, 0); PG8_LDB(B1, 0, 1); PG8_SCHED; PG8_LDA(At, 0, 0); PG8_STAGE(PG8_SA(1, 1), a1 + hstep, voffA);
            PG8_WAIT_V(8); PG8_WAIT_L(0); PG8_BAR; PG8_MMA(0, 0, At, B0); PG8_MMA(0, 1, At, B1); PG8_BAR; PG8_SCHED;
            PG8_LDA(At, 0, 1); PG8_STAGE(PG8_SB(0, 0), b2, voffB); PG8_STAGE(PG8_SB(0, 1), b2 + hstep, voffB); PG8_STAGE(PG8_SA(0, 0), a2, voffA);
            PG8_WAIT_V(8); PG8_WAIT_L(0); PG8_BAR; PG8_MMA(1, 0, At, B0); PG8_MMA(1, 1, At, B1); PG8_BAR; PG8_SCHED;
            PG8_LDB(B0, 1, 0); PG8_LDB(B1, 1, 1); PG8_SCHED; PG8_LDA(At, 1, 0); PG8_STAGE(PG8_SA(0, 1), a2 + hstep, voffA);
            PG8_WAIT_V(8); PG8_WAIT_L(0); PG8_BAR; PG8_MMA(0, 0, At, B0); PG8_MMA(0, 1, At, B1); PG8_BAR; PG8_SCHED;
            PG8_LDA(At, 1, 1); PG8_STAGE(PG8_SB(1, 0), b3, voffB); PG8_STAGE(PG8_SB(1, 1), b3 + hstep, voffB); PG8_STAGE(PG8_SA(1, 0), a3, voffA);
            PG8_WAIT_V(8); PG8_WAIT_L(0); PG8_BAR; PG8_MMA(1, 0, At, B0); PG8_MMA(1, 1, At, B1); PG8_BAR; PG8_SCHED;
            } else {
            PG8_LDB(B0, 0, 0); PG8_SCHED; PG8_LDA(At, 0, 0); PG8_STAGE(PG8_SA(1, 1), a1 + hstep, voffA);
            PG8_WAIT_L(8); PG8_BAR; PG8_WAIT_L(0); PG8_MMA(0, 0, At, B0); PG8_BAR; PG8_SCHED;
            PG8_LDB(B1, 0, 1); PG8_STAGE(PG8_SB(0, 0), b2, voffB);
            PG8_BAR; PG8_WAIT_L(0); PG8_MMA(0, 1, At, B1); PG8_BAR;
            PG8_LDA(At, 0, 1); PG8_STAGE(PG8_SA(0, 0), a2, voffA);
            PG8_BAR; PG8_WAIT_L(0); PG8_MMA(1, 0, At, B0); PG8_BAR; PG8_SCHED;
            PG8_STAGE(PG8_SB(0, 1), b2 + hstep, voffB);
            PG8_WAIT_V(6); PG8_BAR; PG8_MMA(1, 1, At, B1); PG8_BAR;
            PG8_LDB(B0, 1, 0); PG8_SCHED; PG8_LDA(At, 1, 0); PG8_STAGE(PG8_SA(0, 1), a2 + hstep, voffA);
            PG8_WAIT_L(8); PG8_BAR; PG8_WAIT_L(0); PG8_MMA(0, 0, At, B0); PG8_BAR; PG8_SCHED;
            PG8_LDB(B1, 1, 1); PG8_STAGE(PG8_SB(1, 0), b3, voffB);
            PG8_BAR; PG8_WAIT_L(0); PG8_MMA(0, 1, At, B1); PG8_BAR;
            PG8_LDA(At, 1, 1); PG8_STAGE(PG8_SA(1, 0), a3, voffA);
            PG8_BAR; PG8_WAIT_L(0); PG8_MMA(1, 0, At, B0); PG8_BAR; PG8_SCHED;
            PG8_STAGE(PG8_SB(1, 1), b3 + hstep, voffB);
            PG8_WAIT_V(6); PG8_BAR; PG8_MMA(1, 1, At, B1); PG8_BAR;
            }
        }
        asm volatile("s_nop 15\n\ts_nop 15" ::: "memory");
        if constexpr (ALIGN_EPI) { if (wr == 0) PG8_BAR; }
        run_epi8(E, acc, cur, wr, wc, fr, fq);
        if (!has_next) break;
#pragma unroll
        for (int a = 0; a < 2; ++a)
#pragma unroll
            for (int b = 0; b < 2; ++b)
#pragma unroll
                for (int m = 0; m < 4; ++m)
#pragma unroll
                    for (int n = 0; n < 2; ++n) acc[a][b][m][n] = (f32x4){0.f, 0.f, 0.f, 0.f};
        cur = nxt; cA = nA; cB = nB; ++ui;
        if constexpr (ALIGN_EPI) { if (wr == 1) PG8_BAR; }
    }
    PG8_WAIT_V(0);
    if constexpr (!ALIGN_EPI) { if (wr == 0) PG8_BAR; }
    PG8_BAR;

#undef PG8_SA
#undef PG8_SB
#undef PG8_STAGE
#undef PG8_LDA
#undef PG8_LDB
#undef PG8_MMA
#undef PG8_WAIT_V
#undef PG8_WAIT_L
#undef PG8_BAR
#undef PG8_SCHED
}

template <class Epi, class Sched, bool ALIGN_EPI = false, bool SP2 = false>
__device__ __forceinline__ void gemm_phase_f8g(PG8_LAS unsigned char* lds, const Gemm g, const Sched& S, const Epi& E, const int* tok) {
    const int tid = threadIdx.x, wid = __builtin_amdgcn_readfirstlane(tid >> 6), lane = tid & 63, wr = wid >> 2, wc = wid & 3, fr = lane & 15, fq = lane >> 4;
    const int RP = g.K, nt = RP / 128;
    unsigned voffA[2], voffB[2]; int rowA[2];
#pragma unroll
    for (int i = 0; i < 2; ++i) { const int b_ = tid * 16 + i * 8192, R = b_ >> 7, pp = (b_ >> 4) & 7, rr_ = R & 15, ff = ((rr_ >> 1) & 1) | (((rr_ >> 3) & 1) << 2);
        const int rho = R & 31, Rb = (R & ~31) + 8 * ((rho & 15) >> 2) + 4 * (rho >> 4) + (rho & 3);
        voffA[i] = (unsigned)((pp ^ ff) * 16); rowA[i] = R; voffB[i] = (unsigned)(Rb * RP + ((pp ^ ff) * 16)); }
    const size_t kstep = (size_t)(BK * 2);
    const size_t hstep = (size_t)HALF * RP;
    const size_t tstep = 2 * hstep;
    const unsigned ldsw = (unsigned)wid * 1024u;
    const int ffr = ((fr >> 1) & 1) | (((fr >> 3) & 1) << 2);
    const int aoff = (wr * 64 + fr) * 128 + (((2 * fq) ^ ffr) * 16), boff = (wc * 32 + fr) * 128 + (((2 * fq) ^ ffr) * 16), hoff = (ffr & 1) ? -16 : 16;
#define PG8_SA(b, h) (((b) * 2 + (h)) * HTB)
#define PG8_SB(b, h) ((4 + (b) * 2 + (h)) * HTB)
#define PG8_STAGE(bufoff, gbase, voff) do { _Pragma("unroll") for (int _i = 0; _i < 2; ++_i) \
        __builtin_amdgcn_global_load_lds((const unsigned*)((const char*)(gbase) + (voff)[_i]), (PG8_LAS unsigned*)(lds + (bufoff) + ldsw + _i * 8192), 16, 0, 0); } while (0)
#define PG8_LDA(dst, b, h) do { _Pragma("unroll") for (int m = 0; m < 4; ++m) { dst[m].lo = *(const PG8_LAS v4i_t*)(lds + PG8_SA(b, h) + aoff + m * 2048); dst[m].hi = *(const PG8_LAS v4i_t*)(lds + PG8_SA(b, h) + aoff + m * 2048 + hoff); } } while (0)
#define PG8_LDB(dst, b, h) do { _Pragma("unroll") for (int n = 0; n < 2; ++n) { dst[n].lo = *(const PG8_LAS v4i_t*)(lds + PG8_SB(b, h) + boff + n * 2048); dst[n].hi = *(const PG8_LAS v4i_t*)(lds + PG8_SB(b, h) + boff + n * 2048 + hoff); } } while (0)
#define PG8_MMA(ai, bj, At, Bt) do { __builtin_amdgcn_s_setprio(1); _Pragma("unroll") for (int m = 0; m < 4; ++m) _Pragma("unroll") for (int n = 0; n < 2; ++n) \
        asm volatile("v_mfma_f32_16x16x128_f8f6f4 %0, %1, %2, %0" : "+v"(acc[ai][bj][m][n]) : "v"(Bt[n]), "v"(At[m])); __builtin_amdgcn_s_setprio(0); } while (0)
#define PG8_WAIT_V(n) asm volatile("s_waitcnt vmcnt(" #n ")" ::: "memory")
#define PG8_WAIT_L(n) asm volatile("s_waitcnt lgkmcnt(" #n ")" ::: "memory")
#define PG8_BAR __builtin_amdgcn_s_barrier()
#define PG8_SCHED __builtin_amdgcn_sched_barrier(0)
    Unit cur, nxt; int ui = 0;
    if (!S.next(0, cur)) return;
    f32x4 acc[2][2][4][2];
#pragma unroll
    for (int a = 0; a < 2; ++a)
#pragma unroll
        for (int b = 0; b < 2; ++b)
#pragma unroll
            for (int m = 0; m < 4; ++m)
#pragma unroll
                for (int n = 0; n < 2; ++n) acc[a][b][m][n] = (f32x4){0.f, 0.f, 0.f, 0.f};
    v8i_t At[4], B0[2], B1[2];
    const char* cA = (const char*)g.A; const char* cB = (const char*)g.Bt + (size_t)cur.pnB * tstep;
    unsigned vC[2][2], vN[2][2] = {{0u, 0u}, {0u, 0u}};
#define PG8_TOKOFF(dst, pm_) do { _Pragma("unroll") for (int h_ = 0; h_ < 2; ++h_) _Pragma("unroll") for (int i_ = 0; i_ < 2; ++i_) dst[h_][i_] = (unsigned)tok[(pm_) * 256 + h_ * 128 + rowA[i_]] * (unsigned)RP + voffA[i_]; } while (0)
    PG8_TOKOFF(vC, cur.pm);

    if constexpr (SP2) {
        PG8_STAGE(PG8_SB(0, 0), cB, voffB); PG8_STAGE(PG8_SB(0, 1), cB + hstep, voffB); PG8_STAGE(PG8_SA(0, 0), cA, vC[0]); PG8_STAGE(PG8_SA(0, 1), cA, vC[1]);
        if (wr == 1) PG8_BAR;
        PG8_WAIT_V(2); PG8_BAR;
        PG8_STAGE(PG8_SB(1, 0), cB + kstep, voffB); PG8_STAGE(PG8_SA(1, 0), cA + kstep, vC[0]); PG8_STAGE(PG8_SB(1, 1), cB + hstep + kstep, voffB);
        PG8_WAIT_V(6); PG8_BAR;
    } else {
        PG8_STAGE(PG8_SB(0, 0), cB, voffB); PG8_STAGE(PG8_SA(0, 0), cA, vC[0]); PG8_STAGE(PG8_SB(0, 1), cB + hstep, voffB); PG8_STAGE(PG8_SA(0, 1), cA, vC[1]);
        if (wr == 1) PG8_BAR;
        PG8_WAIT_V(4); PG8_BAR;
        PG8_STAGE(PG8_SB(1, 0), cB + kstep, voffB); PG8_STAGE(PG8_SA(1, 0), cA + kstep, vC[0]); PG8_STAGE(PG8_SB(1, 1), cB + hstep + kstep, voffB);
        PG8_WAIT_V(6); PG8_BAR;
    }
    for (;;) {
        const bool has_next = S.next(ui + 1, nxt);
        const char* nB = has_next ? (const char*)g.Bt + (size_t)nxt.pnB * tstep : cB;
        int tkN[2][2] = {{0, 0}, {0, 0}};
        if (has_next) { _Pragma("unroll") for (int h_ = 0; h_ < 2; ++h_) _Pragma("unroll") for (int i_ = 0; i_ < 2; ++i_) tkN[h_][i_] = tok[nxt.pm * 256 + h_ * 128 + rowA[i_]]; }
        for (int t = 0; t < nt; t += 2) {
            const bool last = (t == nt - 2);
            const char* a1 = cA + (size_t)(t + 1) * kstep;
            const char* a2 = last ? cA : cA + (size_t)(t + 2) * kstep; const char* b2 = last ? nB : cB + (size_t)(t + 2) * kstep;
            unsigned vs0[2] = {vC[0][0], vC[0][1]}, vs1[2] = {vC[1][0], vC[1][1]};
            if (last && has_next) { asm volatile("" : "+v"(tkN[0][0]), "+v"(tkN[0][1]), "+v"(tkN[1][0]), "+v"(tkN[1][1]));
                _Pragma("unroll") for (int h_ = 0; h_ < 2; ++h_) _Pragma("unroll") for (int i_ = 0; i_ < 2; ++i_) vN[h_][i_] = (unsigned)tkN[h_][i_] * (unsigned)RP + voffA[i_];
                vs0[0] = vN[0][0]; vs0[1] = vN[0][1]; vs1[0] = vN[1][0]; vs1[1] = vN[1][1]; }
            const char* a3 = a2 + kstep; const char* b3 = b2 + kstep;

            if constexpr (SP2) {
            PG8_LDB(B0, 0, 0); PG8_LDB(B1, 0, 1); PG8_SCHED; PG8_LDA(At, 0, 0); PG8_STAGE(PG8_SA(1, 1), a1, vC[1]);
            PG8_WAIT_V(8); PG8_WAIT_L(0); PG8_BAR; PG8_MMA(0, 0, At, B0); PG8_MMA(0, 1, At, B1); PG8_BAR; PG8_SCHED;
            PG8_LDA(At, 0, 1); PG8_STAGE(PG8_SB(0, 0), b2, voffB); PG8_STAGE(PG8_SB(0, 1), b2 + hstep, voffB); PG8_STAGE(PG8_SA(0, 0), a2, vs0);
            PG8_WAIT_V(8); PG8_WAIT_L(0); PG8_BAR; PG8_MMA(1, 0, At, B0); PG8_MMA(1, 1, At, B1); PG8_BAR; PG8_SCHED;
            PG8_LDB(B0, 1, 0); PG8_LDB(B1, 1, 1); PG8_SCHED; PG8_LDA(At, 1, 0); PG8_STAGE(PG8_SA(0, 1), a2, vs1);
            PG8_WAIT_V(8); PG8_WAIT_L(0); PG8_BAR; PG8_MMA(0, 0, At, B0); PG8_MMA(0, 1, At, B1); PG8_BAR; PG8_SCHED;
            PG8_LDA(At, 1, 1); PG8_STAGE(PG8_SB(1, 0), b3, voffB); PG8_STAGE(PG8_SB(1, 1), b3 + hstep, voffB); PG8_STAGE(PG8_SA(1, 0), a3, vs0);
            PG8_WAIT_V(8); PG8_WAIT_L(0); PG8_BAR; PG8_MMA(1, 0, At, B0); PG8_MMA(1, 1, At, B1); PG8_BAR; PG8_SCHED;
            } else {
            PG8_LDB(B0, 0, 0); PG8_SCHED; PG8_LDA(At, 0, 0); PG8_STAGE(PG8_SA(1, 1), a1, vC[1]);
            PG8_WAIT_L(8); PG8_BAR; PG8_WAIT_L(0); PG8_MMA(0, 0, At, B0); PG8_BAR; PG8_SCHED;
            PG8_LDB(B1, 0, 1); PG8_STAGE(PG8_SB(0, 0), b2, voffB);
            PG8_BAR; PG8_WAIT_L(0); PG8_MMA(0, 1, At, B1); PG8_BAR;
            PG8_LDA(At, 0, 1); PG8_STAGE(PG8_SA(0, 0), a2, vs0);
            PG8_BAR; PG8_WAIT_L(0); PG8_MMA(1, 0, At, B0); PG8_BAR; PG8_SCHED;
            PG8_STAGE(PG8_SB(0, 1), b2 + hstep, voffB);
            PG8_WAIT_V(6); PG8_BAR; PG8_MMA(1, 1, At, B1); PG8_BAR;
            PG8_LDB(B0, 1, 0); PG8_SCHED; PG8_LDA(At, 1, 0); PG8_STAGE(PG8_SA(0, 1), a2, vs1);
            PG8_WAIT_L(8); PG8_BAR; PG8_WAIT_L(0); PG8_MMA(0, 0, At, B0); PG8_BAR; PG8_SCHED;
            PG8_LDB(B1, 1, 1); PG8_STAGE(PG8_SB(1, 0), b3, voffB);
            PG8_BAR; PG8_WAIT_L(0); PG8_MMA(0, 1, At, B1); PG8_BAR;
            PG8_LDA(At, 1, 1); PG8_STAGE(PG8_SA(1, 0), a3, vs0);
            PG8_BAR; PG8_WAIT_L(0); PG8_MMA(1, 0, At, B0); PG8_BAR; PG8_SCHED;
            PG8_STAGE(PG8_SB(1, 1), b3 + hstep, voffB);
            PG8_WAIT_V(6); PG8_BAR; PG8_MMA(1, 1, At, B1); PG8_BAR;
            }
        }
        asm volatile("s_nop 15\n\ts_nop 15" ::: "memory");
        if constexpr (ALIGN_EPI) { if (wr == 0) PG8_BAR; }
        run_epi8(E, acc, cur, wr, wc, fr, fq);
        if (!has_next) break;
#pragma unroll
        for (int a = 0; a < 2; ++a)
#pragma unroll
            for (int b = 0; b < 2; ++b)
#pragma unroll
                for (int m = 0; m < 4; ++m)
#pragma unroll
                    for (int n = 0; n < 2; ++n) acc[a][b][m][n] = (f32x4){0.f, 0.f, 0.f, 0.f};
        cur = nxt; cB = nB; ++ui; vC[0][0] = vN[0][0]; vC[0][1] = vN[0][1]; vC[1][0] = vN[1][0]; vC[1][1] = vN[1][1];
        if constexpr (ALIGN_EPI) { if (wr == 1) PG8_BAR; }
    }
    PG8_WAIT_V(0);
    if constexpr (!ALIGN_EPI) { if (wr == 0) PG8_BAR; }
    PG8_BAR;

#undef PG8_TOKOFF
#undef PG8_SA
#undef PG8_SB
#undef PG8_STAGE
#undef PG8_LDA
#undef PG8_LDB
#undef PG8_MMA
#undef PG8_WAIT_V
#undef PG8_WAIT_L
#undef PG8_BAR
#undef PG8_SCHED
}
}

constexpr int D = 1024, BATCH = 8, SEQ = 2048, CTXL = 256;
constexpr int M = BATCH * SEQ;
constexpr int MC = BATCH * CTXL;
constexpr int MT = M + MC;
constexpr int DIN = 2048, DSGU = 512, DLRU = 512, NE = 16, CAP = 256, DE = 2048, NMOD = 6 * D;
constexpr int NSEG = 36;
constexpr float EPS = 1e-6f;
constexpr int NWAVES = 8, NTHREADS = 512;
constexpr int LDS_BYTES = 147456;
constexpr int NPH = 11;

constexpr size_t MiB = 1u << 20;
constexpr size_t WS_CTL = 0;
constexpr size_t WS_MOD = 1 * MiB;
constexpr size_t WS_SUM = 1 * MiB + 512 * 1024;
constexpr size_t WS_AFF = 4 * MiB;
constexpr size_t WS_SLOT = 5 * MiB;
constexpr size_t WS_GATE = 6 * MiB;
constexpr size_t WS_TOK = 6 * MiB + 128 * 1024;
constexpr size_t WS_GWT = 6 * MiB + 512 * 1024;
constexpr size_t WS_SWB = 7 * MiB;
constexpr size_t WS_WIN = 8 * MiB;
constexpr size_t WS_WOUT = 12 * MiB;
constexpr size_t WS_WG = 14 * MiB;
constexpr size_t WS_W2 = 142 * MiB;
constexpr size_t WS_X1 = 206 * MiB;
constexpr size_t WS_HS = 206 * MiB, WS_PF = 222 * MiB, WS_PB = 238 * MiB;
constexpr size_t WS_HX2 = 270 * MiB;
constexpr size_t WS_XCH = 286 * MiB;
constexpr size_t WS_CB = 1 * MiB + 256 * 1024;
constexpr size_t WS_XE = 302 * MiB;
constexpr size_t WS_A2 = 302 * MiB, WS_YE = 302 * MiB;
constexpr size_t WS_HID = 366 * MiB;
constexpr size_t WS_HX = 366 * MiB;
constexpr size_t WS_UV = 402 * MiB;
constexpr size_t WS_XC = 466 * MiB;
constexpr size_t WS_END = 494 * MiB;

#define GAS __attribute__((address_space(1)))
#define LAS __attribute__((address_space(3)))
typedef unsigned short bf16;
typedef unsigned v4u __attribute__((ext_vector_type(4)));
typedef unsigned v2u __attribute__((ext_vector_type(2)));
typedef float f32x4 __attribute__((ext_vector_type(4)));
typedef short bf16x8 __attribute__((ext_vector_type(8)));
#define LDS_WAIT() asm volatile("s_waitcnt lgkmcnt(0)" ::: "memory")

__device__ __forceinline__ float bf2f(bf16 b) { return __uint_as_float(((unsigned)b) << 16); }
__device__ __forceinline__ unsigned f2bf(float f) { unsigned u = __float_as_uint(f); return (u + 0x7fffu + ((u >> 16) & 1u)) >> 16; }
typedef __bf16 bf16x2_hw __attribute__((ext_vector_type(2)));
typedef float f32x2_hw __attribute__((ext_vector_type(2)));
__device__ __forceinline__ unsigned pk2(float lo, float hi) { const f32x2_hw v = {lo, hi}; return __builtin_bit_cast(unsigned, __builtin_convertvector(v, bf16x2_hw)); }
__device__ __forceinline__ float bflo(unsigned w) { return __uint_as_float(w << 16); }
__device__ __forceinline__ float bfhi(unsigned w) { return __uint_as_float(w & 0xffff0000u); }
__device__ __forceinline__ float rcpf_(float x) { return __builtin_amdgcn_rcpf(x); }
__device__ __forceinline__ float exp2f_(float x) { return __builtin_amdgcn_exp2f(x); }
__device__ __forceinline__ float sigmoidf_(float x) { return rcpf_(1.f + exp2f_(-1.4426950408889634f * x)); }
__device__ __forceinline__ float siluf_(float x) { return x * rcpf_(1.f + exp2f_(-1.4426950408889634f * x)); }
__device__ __forceinline__ float geluf_(float x) { const float u = x * (0.7978845608028654f + 0.035677408136300125f * x * x); return x * rcpf_(1.f + exp2f_(-2.8853900817779268f * u)); }
__device__ __forceinline__ void decay_pair(float la, float& a, float& s) {
    const float x = 2.f * la;
    const float p1 = la * (1.f + la * (0.5f + la * (0.16666667f + la * (0.041666668f + la * 0.0083333333f))));
    const float p2 = x * (1.f + x * (0.5f + x * (0.16666667f + x * (0.041666668f + x * (0.0083333333f + x * 0.0013888889f)))));
    const float e1 = exp2f_(1.4426950408889634f * la);
    const bool small = la > -0.15f;
    a = small ? 1.f + p1 : e1;
    s = __builtin_amdgcn_sqrtf(small ? -p2 : 1.f - e1 * e1);
}
typedef float f32x2p __attribute__((ext_vector_type(2)));
__device__ __forceinline__ f32x2p sigmoid2_(f32x2p x) { const f32x2p t = x * -1.4426950408889634f; f32x2p e; e.x = exp2f_(t.x); e.y = exp2f_(t.y); e = e + 1.f; f32x2p r; r.x = rcpf_(e.x); r.y = rcpf_(e.y); return r; }
__device__ __forceinline__ f32x2p gelu2_(f32x2p x) { const f32x2p u = x * (x * x * 0.035677408136300125f + 0.7978845608028654f), t = u * -2.8853900817779268f; f32x2p e; e.x = exp2f_(t.x); e.y = exp2f_(t.y); e = e + 1.f;
    f32x2p r; r.x = rcpf_(e.x); r.y = rcpf_(e.y); return x * r; }
__device__ __forceinline__ void decay_pair2(f32x2p la, f32x2p& a, f32x2p& s) {
    const f32x2p x = la * 2.f;
    const f32x2p p1 = la * (la * (la * (la * (la * 0.0083333333f + 0.041666668f) + 0.16666667f) + 0.5f) + 1.f);
    const f32x2p p2 = x * (x * (x * (x * (x * (x * 0.0013888889f + 0.0083333333f) + 0.041666668f) + 0.16666667f) + 0.5f) + 1.f);
    const f32x2p tt = la * 1.4426950408889634f; f32x2p e1; e1.x = exp2f_(tt.x); e1.y = exp2f_(tt.y);
    const f32x2p big = 1.f - e1 * e1, one = p1 + 1.f;
    a.x = la.x > -0.15f ? one.x : e1.x; a.y = la.y > -0.15f ? one.y : e1.y;
    s.x = __builtin_amdgcn_sqrtf(la.x > -0.15f ? -p2.x : big.x); s.y = __builtin_amdgcn_sqrtf(la.y > -0.15f ? -p2.y : big.y);
}
__device__ __forceinline__ unsigned pk4_fp8(float a, float b, float c, float d) {
    unsigned w = 0u; w = __builtin_amdgcn_cvt_pk_fp8_f32(a, b, w, false); w = __builtin_amdgcn_cvt_pk_fp8_f32(c, d, w, true); return w; }
constexpr float WSCALE = 32.f, WSCALE_INV = 1.f / 32.f;
__device__ __forceinline__ float wave_sum(float v) {
#pragma unroll
    for (int o = 1; o < 64; o <<= 1) v += __shfl_xor(v, o);
    return v;
}


#define XB_TMO      128
#define XB_XCNT(j)  (256  + 64 * (j))
#define XB_XSUB(j)  (1280 + 64 * (j))
#define XB_XGEN(j)  (2304 + 64 * (j))
#define XB_TOP      3328
#define XB_TOPGEN   3392
#define XCD_BAR_WORDS 3456
#define XB_SPIN_CAP (1u << 18)
__device__ __forceinline__ unsigned xb_ld(unsigned* p)              { return __hip_atomic_load(p, __ATOMIC_RELAXED, __HIP_MEMORY_SCOPE_AGENT); }
__device__ __forceinline__ unsigned xb_add(unsigned* p, unsigned v) { return __hip_atomic_fetch_add(p, v, __ATOMIC_RELAXED, __HIP_MEMORY_SCOPE_AGENT); }
__device__ __forceinline__ unsigned xb_xcc_id() { return (unsigned)__builtin_amdgcn_s_getreg((3 << 11) | 20) & 0xFu; }
#define XB_SPIN(cond, bar) do { unsigned _sp = 0; while (cond) { __builtin_amdgcn_s_sleep(1); \
    if ((++_sp & 255u) == 0u) { if (xb_ld(&(bar)[XB_TMO])) break; if (_sp > XB_SPIN_CAP) { atomicAdd(&(bar)[XB_TMO], 1u); break; } } } } while (0)
struct XcdBarrier { unsigned* bar; unsigned x; volatile LAS unsigned* st; unsigned total; };
__device__ __forceinline__ XcdBarrier xcd_barrier_post(unsigned* bar, volatile LAS unsigned* st, unsigned total) {
    XcdBarrier b; b.bar = bar; b.x = xb_xcc_id(); b.st = st; b.total = total;
    if (threadIdx.x == 0) (void)xb_add(&bar[XB_XCNT(b.x)], 1u);
    return b;
}
__device__ __forceinline__ void xcd_barrier_complete(unsigned* bar, unsigned x, unsigned G, unsigned& nloc, unsigned& nx) {
    unsigned sum, cnt, mine, sp = 0u;
    for (;;) {
        sum = 0u; cnt = 0u; mine = 0u;
#pragma unroll
        for (unsigned j = 0; j < 16; ++j) { const unsigned c = xb_ld(&bar[XB_XCNT(j)]); sum += c; cnt += (c > 0u) ? 1u : 0u; mine = (j == x) ? c : mine; }
        if (sum == G) break;
        __builtin_amdgcn_s_sleep(1);
        if ((++sp & 255u) == 0u) { if (xb_ld(&bar[XB_TMO])) break; if (sp > XB_SPIN_CAP) { atomicAdd(&bar[XB_TMO], 1u); break; } }
    }
    nloc = mine > 0u ? mine : 1u; nx = cnt > 0u ? cnt : 1u;
}
__device__ __forceinline__ void xcd_barrier(const XcdBarrier& b) {
    asm volatile("s_waitcnt vmcnt(0)" ::: "memory");
    __syncthreads();
    if (threadIdx.x == 0) {
        unsigned* bar = b.bar;
        __builtin_amdgcn_s_waitcnt(0);
        unsigned nloc = b.st[0], nx = b.st[1];
        if (nloc == 0u) { xcd_barrier_complete(bar, b.x, b.total, nloc, nx); b.st[0] = nloc; b.st[1] = nx; }
        const unsigned old = xb_add(&bar[XB_XSUB(b.x)], 1u);
        const unsigned gen = old / nloc;
        if (old + 1u == (gen + 1u) * nloc) {
            __builtin_amdgcn_fence(__ATOMIC_RELEASE, "agent");
            asm volatile("s_waitcnt vmcnt(0)" ::: "memory");
            const unsigned og = xb_add(&bar[XB_TOP], 1u);
            const unsigned tg = og / nx;
            if (og + 1u == (tg + 1u) * nx) xb_add(&bar[XB_TOPGEN], 1u);
            else XB_SPIN(xb_ld(&bar[XB_TOPGEN]) == tg, bar);
            __builtin_amdgcn_fence(__ATOMIC_ACQUIRE, "agent");
            xb_add(&bar[XB_XGEN(b.x)], 1u);
            asm volatile("s_waitcnt vmcnt(0)" ::: "memory");
        } else {
            XB_SPIN(xb_ld(&bar[XB_XGEN(b.x)]) == gen, bar);
            __builtin_amdgcn_fence(__ATOMIC_ACQUIRE, "agent");
            asm volatile("s_waitcnt vmcnt(0)" ::: "memory");
        }
    }
    __syncthreads();
}

struct P {
    const float *x, *c, *ctx, *c_ctx, *w_mod, *b_mod, *norm1_g, *norm2_g, *w_in, *sgu_g, *sgu_w, *sgu_b, *conv_w, *conv_b,
                *rg_wa, *rg_ba, *rg_wi, *rg_bi, *rg_lam, *w_out, *w_router, *w1, *w3, *w2, *final_g;
    float* out; unsigned char* ws; int ph_lo, ph_hi;
};

struct SchedG1 { int G, c;
    __device__ __forceinline__ bool next(int i, pg8::Unit& u) const { const int L = i * G + c; if (L >= 528) return false;
        if (L < 512) { u.pm = L >> 3; u.pn = L & 7; } else { const int r = L - 512; u.pm = 64 + (r >> 1); u.pn = 4 + (r & 1); } u.pnB = u.pn; return true; } };
struct SchedG2 { int G, c;
    __device__ __forceinline__ bool next(int i, pg8::Unit& u) const { const int L = i * G + c; if (L >= 256) return false; u.pm = L >> 2; u.pn = L & 3; u.pnB = u.pn; return true; } };
struct SchedG3 { int G, c;
    __device__ __forceinline__ bool next(int i, pg8::Unit& u) const { const int L = i * G + c; if (L >= 2048) return false; const int e = L >> 7, loc = L & 127;
        u.pm = e * 8 + (loc & 7); u.pn = loc >> 3; u.pnB = e * 16 + u.pn; return true; } };
struct SchedG4 { int G, c;
    __device__ __forceinline__ bool next(int i, pg8::Unit& u) const { const int L = i * G + c; if (L >= 512) return false; const int e = L >> 5, loc = L & 31;
        u.pm = e * 8 + (loc & 7); u.pn = loc >> 3; u.pnB = e * 4 + u.pn; return true; } };

struct EpiG1 { static constexpr bool PAIRED = false, FUSED = false; bf16* UV; bf16* XC;
    __device__ __forceinline__ void st8(const pg8::Unit& u, int row, int col, f32x4 v0, f32x4 v1) const {
        const int grow = u.pm * 256 + row, gcol = u.pn * 256 + col;
        if (u.pm < 64) {
            if (gcol < 1024 || gcol >= 1536) { const f32x2p a = gelu2_((f32x2p){v0[0], v0[1]}), b = gelu2_((f32x2p){v0[2], v0[3]}), c = gelu2_((f32x2p){v1[0], v1[1]}), d = gelu2_((f32x2p){v1[2], v1[3]});
                v0 = (f32x4){a.x, a.y, b.x, b.y}; v1 = (f32x4){c.x, c.y, d.x, d.y}; }
            *(v4u*)(UV + (size_t)grow * DIN + gcol) = (v4u){pk2(v0[0], v0[1]), pk2(v0[2], v0[3]), pk2(v1[0], v1[1]), pk2(v1[2], v1[3])};
        } else *(v4u*)(XC + (size_t)(grow - M) * DLRU + (gcol - 1024)) = (v4u){pk2(v0[0], v0[1]), pk2(v0[2], v0[3]), pk2(v1[0], v1[1]), pk2(v1[2], v1[3])};
    } };
struct EpiG2 { static constexpr bool PAIRED = false, FUSED = false; const float* x; const float* MOD; float* X1;
    __device__ __forceinline__ void st8(const pg8::Unit& u, int row, int col, f32x4 v0, f32x4 v1) const {
        const int grow = u.pm * 256 + row, gcol = u.pn * 256 + col, b = grow >> 11;
        const f32x4* xp = (const f32x4*)(x + (size_t)grow * D + gcol); const f32x4* gp = (const f32x4*)(MOD + b * NMOD + 2 * D + gcol); f32x4* op = (f32x4*)(X1 + (size_t)grow * D + gcol);
        op[0] = xp[0] + gp[0] * v0; op[1] = xp[1] + gp[1] * v1;
    } };
#if MOE_FP8
typedef float f32x2v __attribute__((ext_vector_type(2)));
__device__ __forceinline__ f32x2v swiglu_scaled2(f32x2v g, f32x2v u) {
    constexpr float K1 = -1.4426950408889634f * WSCALE_INV, S2 = WSCALE * WSCALE;
    const f32x2v t = g * K1; f32x2v e; e.x = exp2f_(t.x); e.y = exp2f_(t.y);
    const f32x2v d = e * S2 + S2; f32x2v r; r.x = rcpf_(d.x); r.y = rcpf_(d.y);
    return (g * u) * r;
}
struct EpiG3 { static constexpr bool PAIRED = true; unsigned char* HID;
    __device__ __forceinline__ void st2x8(const pg8::Unit& u, int row, int col, f32x4 g0, f32x4 g1, f32x4 u0, f32x4 u1) const {
        const int grow = u.pm * 256 + row, hc = u.pn * 128 + col;
        const f32x2v a = swiglu_scaled2((f32x2v){g0[0], g0[1]}, (f32x2v){u0[0], u0[1]}), b = swiglu_scaled2((f32x2v){g0[2], g0[3]}, (f32x2v){u0[2], u0[3]});
        const f32x2v c = swiglu_scaled2((f32x2v){g1[0], g1[1]}, (f32x2v){u1[0], u1[1]}), d = swiglu_scaled2((f32x2v){g1[2], g1[3]}, (f32x2v){u1[2], u1[3]});
        v2u w; w.x = pk4_fp8(a.x, a.y, b.x, b.y); w.y = pk4_fp8(c.x, c.y, d.x, d.y);
        *(v2u*)(HID + (size_t)grow * DE + hc) = w;
    } };
struct EpiG4 { static constexpr bool PAIRED = false; const float* GATE; unsigned char* YE;
    __device__ __forceinline__ void st8(const pg8::Unit& u, int row, int col, f32x4 v0, f32x4 v1) const {
        const int grow = u.pm * 256 + row, gcol = u.pn * 256 + col; const float gt = GATE[grow];
        v2u w; w.x = pk4_fp8(v0[0] * gt, v0[1] * gt, v0[2] * gt, v0[3] * gt); w.y = pk4_fp8(v1[0] * gt, v1[1] * gt, v1[2] * gt, v1[3] * gt);
        *(v2u*)(YE + (size_t)grow * D + gcol) = w;
    } };
#else
struct EpiG3 { static constexpr bool PAIRED = true; bf16* HID;
    __device__ __forceinline__ void st2(const pg8::Unit& u, int row, int col, f32x4 g, f32x4 up) const {
        const int grow = u.pm * 256 + row, hc = u.pn * 128 + col;
        v2u w; w.x = pk2(siluf_(g[0]) * up[0], siluf_(g[1]) * up[1]); w.y = pk2(siluf_(g[2]) * up[2], siluf_(g[3]) * up[3]);
        *(v2u*)(HID + (size_t)grow * DE + hc) = w;
    } };
struct EpiG4 { static constexpr bool PAIRED = false; const float* GATE; bf16* YE;
    __device__ __forceinline__ void st(const pg8::Unit& u, int row, int col, f32x4 v) const {
        const int grow = u.pm * 256 + row, gcol = u.pn * 256 + col; const float gt = GATE[grow];
        v2u w; w.x = pk2(v[0] * gt, v[1] * gt); w.y = pk2(v[2] * gt, v[3] * gt); *(v2u*)(YE + (size_t)grow * D + gcol) = w;
    } };

#endif


struct EpiG2F { static constexpr bool PAIRED = false, FUSED = true;
    const float* x; const float* MOD; float* X1; const float* w_router; const float* norm2_g; const float* CB; float* XCH; unsigned* cnt; unsigned* tmo; unsigned char* HX8; float* AFF;
    __device__ __forceinline__ void fused(f32x4 (&acc)[2][2][4][2], const pg8::Unit& u, int wr, int wc, int fr, int fq, LAS unsigned char* lds, int wid, int lane) const {
        const int tid = wid * 64 + lane, b = u.pm >> 3, grow0 = u.pm * 256, gcol0 = u.pn * 256;
        LAS float* LQ = (LAS float*)lds;
        LAS float* RINV = (LAS float*)(lds + 81920);
        const float* MODb = MOD + b * NMOD;
        float gsc[2][8], shv[2][8], wrv[2][8];
#pragma unroll
        for (int bj = 0; bj < 2; ++bj)
#pragma unroll
            for (int j = 0; j < 8; ++j) { const int c = gcol0 + bj * 128 + wc * 32 + 8 * fq + j; gsc[bj][j] = norm2_g[c] * (1.f + MODb[4 * D + c]); shv[bj][j] = MODb[3 * D + c]; wrv[bj][j] = w_router[c * NE + fr]; }
#pragma unroll
        for (int ai = 0; ai < 2; ++ai)
#pragma unroll
            for (int m = 0; m < 4; ++m) { const int row = ai * 128 + wr * 64 + m * 16 + fr;
#pragma unroll
                for (int bj = 0; bj < 2; ++bj) { const int col = gcol0 + bj * 128 + wc * 32 + 8 * fq; const size_t o = (size_t)(grow0 + row) * D + col;
                    const f32x4 x0 = *(const f32x4*)(x + o), x1v = *(const f32x4*)(x + o + 4), g0 = *(const f32x4*)(MODb + 2 * D + col), g1 = *(const f32x4*)(MODb + 2 * D + col + 4);
                    acc[ai][bj][m][0] = x0 + g0 * acc[ai][bj][m][0]; acc[ai][bj][m][1] = x1v + g1 * acc[ai][bj][m][1];
                    { v4u w; w.x = pk2(acc[ai][bj][m][0].x, acc[ai][bj][m][0].y); w.y = pk2(acc[ai][bj][m][0].z, acc[ai][bj][m][0].w); w.z = pk2(acc[ai][bj][m][1].x, acc[ai][bj][m][1].y); w.w = pk2(acc[ai][bj][m][1].z, acc[ai][bj][m][1].w);
                      *(v4u*)((bf16*)X1 + o) = w; } } }
        float tw[2][2][4];
#pragma unroll
        for (int bj = 0; bj < 2; ++bj)
#pragma unroll
            for (int n = 0; n < 2; ++n)
#pragma unroll
                for (int r = 0; r < 4; ++r) tw[bj][n][r] = wrv[bj][4 * n + r] * gsc[bj][4 * n + r];
#pragma unroll
        for (int ai = 0; ai < 2; ++ai)
#pragma unroll
            for (int m = 0; m < 4; ++m) { const int row = ai * 128 + wr * 64 + m * 16 + fr;
                f32x4 q = (f32x4){0.f, 0.f, 0.f, 0.f}; float s2 = 0.f;
#pragma unroll
                for (int bj = 0; bj < 2; ++bj)
#pragma unroll
                    for (int n = 0; n < 2; ++n)
#pragma unroll
                        for (int r = 0; r < 4; ++r) { const float v = acc[ai][bj][m][n][r]; q = __builtin_amdgcn_mfma_f32_16x16x4f32(tw[bj][n][r], v, q, 0, 0, 0); s2 += v * v; }
                s2 += __shfl_xor(s2, 16); s2 += __shfl_xor(s2, 32);
                LAS float* o = LQ + (row * 4 + wc) * 20;
                o[4 * fq + 0] = q[0]; o[4 * fq + 1] = q[1]; o[4 * fq + 2] = q[2]; o[4 * fq + 3] = q[3]; if (fq == 0) o[16] = s2; }
        __syncthreads();
        float* xo = XCH + (size_t)((u.pm * 4 + u.pn) * 256) * 20;
        for (int i = tid; i < 256 * 9; i += NTHREADS) { const int row = i / 9, q2 = 2 * (i - row * 9); const LAS float* s = LQ + row * 80 + q2;
            const float v0 = (s[0] + s[20]) + (s[40] + s[60]), v1 = q2 < 16 ? (s[1] + s[21]) + (s[41] + s[61]) : 0.f;
            __hip_atomic_store((unsigned long long*)(xo + row * 20 + q2), ((unsigned long long)__float_as_uint(v1) << 32) | __float_as_uint(v0), __ATOMIC_RELAXED, __HIP_MEMORY_SCOPE_AGENT); }
        asm volatile("s_waitcnt vmcnt(0)" ::: "memory");
        __syncthreads();
        if (tid == 0) {
            __hip_atomic_fetch_add(cnt + 16 * u.pm, 1u, __ATOMIC_RELAXED, __HIP_MEMORY_SCOPE_AGENT);
            XB_SPIN(xb_ld(cnt + 16 * u.pm) < 4u, tmo);
        }
        __syncthreads();
        const float* xp = XCH + (size_t)(u.pm * 4 * 256) * 20;
#define XLD(ptr) __hip_atomic_load((ptr), __ATOMIC_RELAXED, __HIP_MEMORY_SCOPE_AGENT)
        if (tid < 256) { const int row = tid; const float S2 = (XLD(xp + row * 20 + 16) + XLD(xp + 5120 + row * 20 + 16)) + (XLD(xp + 10240 + row * 20 + 16) + XLD(xp + 15360 + row * 20 + 16)); RINV[row] = rsqrtf(S2 * (1.f / D) + EPS); }
        else if (tid < 320) { const int row = 64 * u.pn + (tid - 256); const float* r0 = xp + row * 20;
            const float S2 = (XLD(r0 + 16) + XLD(r0 + 5120 + 16)) + (XLD(r0 + 10240 + 16) + XLD(r0 + 15360 + 16)), rinv = rsqrtf(S2 * (1.f / D) + EPS);
            float lg[16]; float mx = -3.0e38f;
#pragma unroll
            for (int e = 0; e < 16; ++e) { lg[e] = rinv * ((XLD(r0 + e) + XLD(r0 + 5120 + e)) + (XLD(r0 + 10240 + e) + XLD(r0 + 15360 + e))) + CB[b * NE + e]; mx = fmaxf(mx, lg[e]); }
            float den = 0.f;
#pragma unroll
            for (int e = 0; e < 16; ++e) { lg[e] = expf(lg[e] - mx); den += lg[e]; }
            const float rd = 1.f / den; const int t = (u.pm & 7) * 256 + row;
#pragma unroll
            for (int e = 0; e < 16; ++e) AFF[(size_t)(b * NE + e) * SEQ + t] = lg[e] * rd; }
#undef XLD
        __syncthreads();
#pragma unroll
        for (int ai = 0; ai < 2; ++ai)
#pragma unroll
            for (int m = 0; m < 4; ++m) { const int row = ai * 128 + wr * 64 + m * 16 + fr; const float rinv = RINV[row];
#pragma unroll
                for (int bj = 0; bj < 2; ++bj) { const f32x4 a0 = acc[ai][bj][m][0], a1 = acc[ai][bj][m][1]; v2u w;
                    w.x = pk4_fp8(a0[0] * rinv * gsc[bj][0] + shv[bj][0], a0[1] * rinv * gsc[bj][1] + shv[bj][1], a0[2] * rinv * gsc[bj][2] + shv[bj][2], a0[3] * rinv * gsc[bj][3] + shv[bj][3]);
                    w.y = pk4_fp8(a1[0] * rinv * gsc[bj][4] + shv[bj][4], a1[1] * rinv * gsc[bj][5] + shv[bj][5], a1[2] * rinv * gsc[bj][6] + shv[bj][6], a1[3] * rinv * gsc[bj][7] + shv[bj][7]);
                    *(v2u*)(HX8 + (size_t)(grow0 + row) * D + gcol0 + bj * 128 + wc * 32 + 8 * fq) = w; } }
    }
    __device__ __forceinline__ void st8(const pg8::Unit&, int, int, f32x4, f32x4) const {}
};

template <class Epi, class Sched>
__device__ __forceinline__ void naive_gemm_phase(LAS unsigned char* lds, const pg8::Gemm g, const Sched& S, const Epi& E) {
    LAS float* As = (LAS float*)lds; LAS float* Bs = (LAS float*)(lds + 4352);
    const int tid = threadIdx.x, ty = tid >> 5, tx = tid & 31, K = g.K, lr = tid >> 1, lh = 8 * (tid & 1);
    pg8::Unit u;
    for (int i = 0; S.next(i, u); ++i)
        for (int sub = 0; sub < 4; ++sub) {
            f32x4 ag[4], au[4];
#pragma unroll
            for (int r = 0; r < 4; ++r) { ag[r] = (f32x4){0.f, 0.f, 0.f, 0.f}; au[r] = (f32x4){0.f, 0.f, 0.f, 0.f}; }
            const bf16* arow = g.A + ((size_t)u.pm * 256 + sub * 64 + (lr & 63)) * K + lh;
            const bf16* brow = g.Bt + ((size_t)u.pnB * 256 + lr) * K + lh;
            for (int k0 = 0; k0 < K; k0 += 16) {
                const v4u bv = *(const v4u*)(brow + k0); v4u av = (v4u){0u, 0u, 0u, 0u}; if (tid < 128) av = *(const v4u*)(arow + k0);
                __syncthreads();
                Bs[(lh + 0) * 260 + lr] = bflo(bv.x); Bs[(lh + 1) * 260 + lr] = bfhi(bv.x); Bs[(lh + 2) * 260 + lr] = bflo(bv.y); Bs[(lh + 3) * 260 + lr] = bfhi(bv.y);
                Bs[(lh + 4) * 260 + lr] = bflo(bv.z); Bs[(lh + 5) * 260 + lr] = bfhi(bv.z); Bs[(lh + 6) * 260 + lr] = bflo(bv.w); Bs[(lh + 7) * 260 + lr] = bfhi(bv.w);
                if (tid < 128) {
                    As[(lh + 0) * 68 + lr] = bflo(av.x); As[(lh + 1) * 68 + lr] = bfhi(av.x); As[(lh + 2) * 68 + lr] = bflo(av.y); As[(lh + 3) * 68 + lr] = bfhi(av.y);
                    As[(lh + 4) * 68 + lr] = bflo(av.z); As[(lh + 5) * 68 + lr] = bfhi(av.z); As[(lh + 6) * 68 + lr] = bflo(av.w); As[(lh + 7) * 68 + lr] = bfhi(av.w); }
                __syncthreads();
#pragma unroll
                for (int kk = 0; kk < 16; ++kk) {
                    const f32x4 a = *(const LAS f32x4*)(As + kk * 68 + 4 * ty), b0 = *(const LAS f32x4*)(Bs + kk * 260 + 4 * tx), b1 = *(const LAS f32x4*)(Bs + kk * 260 + 128 + 4 * tx);
#pragma unroll
                    for (int r = 0; r < 4; ++r) { ag[r] += a[r] * b0; au[r] += a[r] * b1; }
                }
            }
#pragma unroll
            for (int r = 0; r < 4; ++r) { const int row = sub * 64 + 4 * ty + r;
                if constexpr (Epi::PAIRED) E.st2(u, row, 4 * tx, ag[r], au[r]);
                else { E.st(u, row, 4 * tx, ag[r]); E.st(u, row, 128 + 4 * tx, au[r]); } }
        }
    __syncthreads();
}
template <class Epi, class Sched>
__device__ __forceinline__ void gemm_any(LAS unsigned char* lds, const pg8::Gemm g, const Sched& S, const Epi& E) {
#if USE_PG8
    pg8::gemm_phase<Epi, Sched, true, true>(lds, g, S, E);
#else
    naive_gemm_phase<Epi, Sched>(lds, g, S, E);
#endif
}

__device__ __forceinline__ void transpose_item(const float* W, int N, int K, bf16* WT, int k0, int n0, size_t drow0, LAS unsigned char* scr, int lane) {
    const int lc = lane & 15, lr = lane >> 4;
    f32x4 v[16];
#pragma unroll
    for (int i = 0; i < 16; ++i) v[i] = *(const f32x4*)(W + (size_t)(k0 + 4 * i + lr) * N + n0 + 4 * lc);
#pragma unroll
    for (int i = 0; i < 16; ++i) { const int k = 4 * i + lr;
#pragma unroll
        for (int j = 0; j < 4; ++j) *(LAS bf16*)(scr + (4 * lc + j) * 136 + k * 2) = (bf16)f2bf(v[i][j]); }
    LDS_WAIT(); asm volatile("" ::: "memory");
    const int c = lane & 7;
#pragma unroll
    for (int j = 0; j < 8; ++j) { const int n = (lane >> 3) + 8 * j;
        const v2u lo = *(const LAS v2u*)(scr + n * 136 + c * 16), hi = *(const LAS v2u*)(scr + n * 136 + c * 16 + 8);
        *(v4u*)(WT + (drow0 + n) * (size_t)K + k0 + 8 * c) = (v4u){lo.x, lo.y, hi.x, hi.y}; }
    LDS_WAIT(); asm volatile("" ::: "memory");
}
__device__ __forceinline__ void conv_load(const float* src, int N, int lane, f32x4 (&v)[16]);
struct P;
__device__ __forceinline__ void conv_desc(const P& p, int it, const float*& src, unsigned char*& dst, int& N, int& K);
__device__ __forceinline__ void conv_store(const f32x4 (&v)[16], unsigned char* dst, int K, LAS unsigned char* scr, int lane);
__device__ __forceinline__ void transpose_item_f8(const float* W, int N, int K, unsigned char* WT, int k0, int n0, size_t drow0, LAS unsigned char* scr, int lane) {
    f32x4 v[16]; conv_load(W + (size_t)k0 * N + n0, N, lane, v); conv_store(v, WT + drow0 * (size_t)K + k0, K, scr, lane);
}
constexpr int CONV_ITEMS = 16 * 32 + 16 * 16 + 3 * 512 * NE, CONV_CUT = CONV_ITEMS - 6144;
__device__ __forceinline__ void convert_items(const P& p, LAS unsigned char* lds, int lane, int wave, int first, int last, int gw, int NGW) {
    LAS unsigned char* scr = lds + wave * 16384;
    constexpr int I_IN = 16 * 32, I_OUT = 16 * 16, I_E = 512 * NE;
    for (int it = first + gw; it < last; it += NGW) {
        int r = it;
        if (r < I_IN) { const int kb = r >> 5, nb = r & 31; transpose_item(p.w_in, DIN, D, (bf16*)(p.ws + WS_WIN), 64 * kb, 64 * nb, (size_t)(64 * nb), scr, lane); continue; } r -= I_IN;
        if (r < I_OUT) { const int kb = r >> 4, nb = r & 15; transpose_item(p.w_out, D, D, (bf16*)(p.ws + WS_WOUT), 64 * kb, 64 * nb, (size_t)(64 * nb), scr, lane); continue; } r -= I_OUT;
#if MOE_FP8
        { const float* src_; unsigned char* dst_; int N_, K_; f32x4 v_[16]; conv_desc(p, it, src_, dst_, N_, K_); conv_load(src_, N_, lane, v_); conv_store(v_, dst_, K_, scr, lane); }
#else
        if (r < 2 * I_E) { const int which = r >= I_E; if (which) r -= I_E; const int e = r >> 9, q = r & 511, kb = q >> 5, nb = q & 31, n0 = 64 * nb;
            const float* W = (which ? p.w3 : p.w1) + (size_t)e * D * DE;
#if MOE_FP8
            transpose_item_f8(W, DE, D, p.ws + WS_WG, 64 * kb, n0, (size_t)e * 4096 + (size_t)(n0 >> 7) * 256 + (n0 & 127) + (which ? 128 : 0), scr, lane); continue; } r -= 2 * I_E;
#else
            transpose_item(W, DE, D, (bf16*)(p.ws + WS_WG), 64 * kb, n0, (size_t)e * 4096 + (size_t)(n0 >> 7) * 256 + (n0 & 127) + (which ? 128 : 0), scr, lane); continue; } r -= 2 * I_E;
#endif
        { const int e = r >> 9, q = r & 511, kb = q >> 4, nb = q & 15, n0 = 64 * nb;
#if MOE_FP8
            transpose_item_f8(p.w2 + (size_t)e * DE * D, D, DE, p.ws + WS_W2, 64 * kb, n0, (size_t)e * 1024 + n0, scr, lane); }
#else
            transpose_item(p.w2 + (size_t)e * DE * D, D, DE, (bf16*)(p.ws + WS_W2), 64 * kb, n0, (size_t)e * 1024 + n0, scr, lane); }
#endif
#endif
    }
}

#if MOE_FP8
constexpr int CONV_HEAD = 16 * 32 + 16 * 16;
__device__ __forceinline__ void conv_desc(const P& p, int it, const float*& src, unsigned char*& dst, int& N, int& K) {
    constexpr int I_E = 512 * NE; const int r0 = it - CONV_HEAD;
    const bool isw2 = r0 >= 2 * I_E, which = (!isw2) && r0 >= I_E; const int r = isw2 ? r0 - 2 * I_E : (which ? r0 - I_E : r0);
    const int e = r >> 9, q = r & 511, kb = isw2 ? (q >> 5) : (q >> 6), nb = isw2 ? (q & 31) : (q & 63), n0 = 32 * nb;
    N = isw2 ? D : DE; K = isw2 ? DE : D;
    const float* base = isw2 ? p.w2 : (which ? p.w3 : p.w1);
    src = base + (size_t)e * D * DE + (size_t)(128 * kb) * N + n0;
    const size_t drow = isw2 ? ((size_t)e * 1024 + n0) : ((size_t)e * 4096 + (size_t)(n0 >> 7) * 256 + (n0 & 127) + (which ? 128 : 0));
    dst = p.ws + (isw2 ? WS_W2 : WS_WG) + drow * (size_t)K + 128 * kb;
}
__device__ __forceinline__ void conv_load(const float* src, int N, int lane, f32x4 (&v)[16]) {
    const int lc = lane & 7, lr = lane >> 3;
#pragma unroll
    for (int i = 0; i < 16; ++i) v[i] = __builtin_nontemporal_load((const f32x4*)(src + (size_t)(16 * lr + i) * N + 4 * lc));
}
__device__ __forceinline__ void conv_store(const f32x4 (&v)[16], unsigned char* dst, int K, LAS unsigned char* scr, int lane) {
    const int lc = lane & 7, lr = lane >> 3; (void)scr;
#pragma unroll
    for (int j = 0; j < 4; ++j) { v4u o;
        o.x = pk4_fp8(v[0][j] * WSCALE, v[1][j] * WSCALE, v[2][j] * WSCALE, v[3][j] * WSCALE);
        o.y = pk4_fp8(v[4][j] * WSCALE, v[5][j] * WSCALE, v[6][j] * WSCALE, v[7][j] * WSCALE);
        o.z = pk4_fp8(v[8][j] * WSCALE, v[9][j] * WSCALE, v[10][j] * WSCALE, v[11][j] * WSCALE);
        o.w = pk4_fp8(v[12][j] * WSCALE, v[13][j] * WSCALE, v[14][j] * WSCALE, v[15][j] * WSCALE);
        *(v4u*)(dst + (size_t)(4 * lc + j) * K + 16 * lr) = o; }
}
__device__ __forceinline__ void convert_pipelined(const P& p, LAS unsigned char* lds, int lane, int wave, int first, int last, int gw, int NGW) {
    LAS unsigned char* scr = lds + wave * 16384;
    f32x4 va[16], vb[16], vc[16]; const float* s0; unsigned char* da; unsigned char* db; unsigned char* dc; int N0, Ka, Kb, Kc;
    int it = first + gw; if (it >= last) return;
    const int itl = it + ((last - 1 - it) / NGW) * NGW;
    conv_desc(p, it, s0, da, N0, Ka); conv_load(s0, N0, lane, va);
    { const int i1 = min(it + NGW, itl); conv_desc(p, i1, s0, db, N0, Kb); conv_load(s0, N0, lane, vb); }
    for (; it <= itl; it += 3 * NGW) {
        { const int i2 = min(it + 2 * NGW, itl); conv_desc(p, i2, s0, dc, N0, Kc); conv_load(s0, N0, lane, vc); }
        conv_store(va, da, Ka, scr, lane);
        { const int i3 = min(it + 3 * NGW, itl); conv_desc(p, i3, s0, da, N0, Ka); conv_load(s0, N0, lane, va); }
        conv_store(vb, db, Kb, scr, lane);
        { const int i4 = min(it + 4 * NGW, itl); conv_desc(p, i4, s0, db, N0, Kb); conv_load(s0, N0, lane, vb); }
        conv_store(vc, dc, Kc, scr, lane);
    }
}
#endif
__device__ __forceinline__ void p0_small_copies(const P& p, int tid, int vcu, int G) {
    bf16* GWT = (bf16*)(p.ws + WS_GWT); bf16* SWB = (bf16*)(p.ws + WS_SWB); const int gt = vcu * NTHREADS + tid, NT = G * NTHREADS;
    for (int o = gt; o < 131072; o += NT) { const int i = o & 63, j = (o >> 6) & 63, h = (o >> 12) & 7, g = (o >> 15) & 1, d = o >> 16;
        GWT[o] = (bf16)f2bf((g ? p.rg_wi : p.rg_wa)[(size_t)((d * 8 + h) * 64 + i) * 64 + j]); }
    for (int o = gt; o < 65536; o += NT) SWB[o] = (bf16)f2bf(p.sgu_w[o]);
}
__device__ __forceinline__ void phase_p0(const P& p, LAS unsigned char* lds, int tid, int lane, int wave, int vcu, int G, int conv_last, bool small = true) {
    float* MOD = (float*)(p.ws + WS_MOD);
    {
        LAS float* sc = (LAS float*)lds; LAS float* part = (LAS float*)(lds + 36864);
        if (vcu < 192) {
            float cv[18];
#pragma unroll
            for (int i = 0; i < 18; ++i) { const int e = tid + i * NTHREADS, j = e >> 10, k = e & 1023; cv[i] = j < 8 ? p.c[j * D + k] : p.c_ctx[k]; }
#pragma unroll
            for (int i = 0; i < 18; ++i) sc[tid + i * NTHREADS] = siluf_(cv[i]);
        }
        __syncthreads();
        for (int t = vcu; t < 192; t += G) {
            const int col = lane & 31, kh = lane >> 5, n = t * 32 + col, kbase = wave * 128 + kh * 64; float acc[9];
#pragma unroll
            for (int j = 0; j < 9; ++j) acc[j] = 0.f;
            for (int k0 = 0; k0 < 64; k0 += 16) { float w[16];
#pragma unroll
                for (int i = 0; i < 16; ++i) w[i] = p.w_mod[(size_t)(kbase + k0 + i) * NMOD + n];
#pragma unroll
                for (int i = 0; i < 16; ++i)
#pragma unroll
                    for (int j = 0; j < 9; ++j) acc[j] += sc[j * D + kbase + k0 + i] * w[i]; }
#pragma unroll
            for (int j = 0; j < 9; ++j) { acc[j] += __shfl_xor(acc[j], 32); if (lane < 32) part[(wave * 9 + j) * 32 + lane] = acc[j]; }
            __syncthreads();
            for (int i = tid; i < 9 * 32; i += NTHREADS) { const int j = i >> 5, l = i & 31; float s2 = p.b_mod[t * 32 + l];
#pragma unroll
                for (int w = 0; w < 8; ++w) s2 += part[(w * 9 + j) * 32 + l];
                MOD[j * NMOD + t * 32 + l] = s2; }
            __syncthreads();
        }
    }
    convert_items(p, lds, lane, wave, 0, conv_last, vcu * NWAVES + wave, G * NWAVES);
    if (small) p0_small_copies(p, tid, vcu, G);
}

__device__ __forceinline__ void phase_p1(const P& p, int lane, int wave, int vcu, int G) {
    const float* MOD = (const float*)(p.ws + WS_MOD); bf16* HX = (bf16*)(p.ws + WS_HX);
    const int gw = vcu * NWAVES + wave, NGW = G * NWAVES;
    for (int i = gw; i < BATCH * NE; i += NGW) { const int b = i >> 4, e = i & 15; float a = 0.f;
        for (int k = lane; k < D; k += 64) a += MOD[b * NMOD + 3 * D + k] * p.w_router[k * NE + e];
        a = wave_sum(a); if (lane == 0) ((float*)(p.ws + WS_CB))[i] = a; }
    f32x4 nx[4];
    { const int m = gw; if (m < MT) { const f32x4* xr = (const f32x4*)(m < M ? p.x + (size_t)m * D : p.ctx + (size_t)(m - M) * D) + lane;
#pragma unroll
        for (int jj = 0; jj < 4; ++jj) nx[jj] = xr[64 * jj]; } }
    for (int m = gw; m < MT; m += NGW) {
        const int j = m < M ? (m >> 11) : 8;
        f32x4 v[4]; float s = 0.f;
#pragma unroll
        for (int jj = 0; jj < 4; ++jj) { v[jj] = nx[jj]; s += (v[jj].x * v[jj].x + v[jj].y * v[jj].y) + (v[jj].z * v[jj].z + v[jj].w * v[jj].w); }
        { const int m2 = m + NGW; if (m2 < MT) { const f32x4* xr = (const f32x4*)(m2 < M ? p.x + (size_t)m2 * D : p.ctx + (size_t)(m2 - M) * D) + lane;
#pragma unroll
            for (int jj = 0; jj < 4; ++jj) nx[jj] = xr[64 * jj]; } }
        const float rinv = rsqrtf(wave_sum(s) * (1.f / D) + EPS);
        v2u* o = (v2u*)(HX + (size_t)m * D) + lane;
#pragma unroll
        for (int jj = 0; jj < 4; ++jj) { const int k = 4 * (lane + 64 * jj);
            const f32x4 g = *(const f32x4*)(p.norm1_g + k), sh = *(const f32x4*)(MOD + j * NMOD + k), sc = *(const f32x4*)(MOD + j * NMOD + D + k);
            const f32x4 h = v[jj] * rinv * g * (sc + 1.f) + sh; v2u w; w.x = pk2(h.x, h.y); w.y = pk2(h.z, h.w); o[64 * jj] = w; }
    }
}

__device__ __forceinline__ void phase_lru1(const P& p, LAS unsigned char* lds, int tid, int vcu, int G) {
    LAS float* xt = (LAS float*)lds;
    LAS float* cx = (LAS float*)(lds + 17152);
    LAS float* af = (LAS float*)(lds + 33536);
    LAS float* df = (LAS float*)(lds + 49920);
    LAS float* ab = (LAS float*)(lds + 66304);
    LAS float* db = (LAS float*)(lds + 82688);
    const bf16* UV = (const bf16*)(p.ws + WS_UV); const bf16* XC = (const bf16*)(p.ws + WS_XC);
    bf16* HS = (bf16*)(p.ws + WS_HS); bf16* PF = (bf16*)(p.ws + WS_PF); bf16* PB = (bf16*)(p.ws + WS_PB); float* SUM = (float*)(p.ws + WS_SUM);
    for (int T = vcu; T < BATCH * NSEG * 8; T += G) {
        const int b = T / (NSEG * 8), rem = T % (NSEG * 8), seg = rem >> 3, h = rem & 7;
        for (int i = tid; i < 67 * 64; i += NTHREADS) { const int r = (i >> 6) - 1, ch = i & 63; float v = 0.f;
            if (seg < 4) { const int pos = seg * 64 + r; if (pos >= 0 && pos < CTXL) v = bf2f(XC[(size_t)(b * CTXL + pos) * DLRU + h * 64 + ch]); }
            else { if (r >= 0 && r < 64) v = bf2f(UV[(size_t)(b * SEQ + (seg - 4) * 64 + r) * DIN + 1024 + h * 64 + ch]); }
            xt[i] = v; }
        __syncthreads();
        for (int i = tid; i < 4096; i += NTHREADS) { const int r = i >> 6, ch = i & 63, cch = h * 64 + ch; float v = p.conv_b[cch];
#pragma unroll
            for (int j = 0; j < 4; ++j) v += p.conv_w[j * DLRU + cch] * xt[(r + j) * 64 + ch];
            cx[i] = v; }
        __syncthreads();
        { const int jj = tid & 63, r0 = tid >> 6, cch = h * 64 + jj;
#pragma unroll
          for (int d = 0; d < 2; ++d) {
            float aa[8], ai[8];
#pragma unroll
            for (int q = 0; q < 8; ++q) { aa[q] = 0.f; ai[q] = 0.f; }
            const float* wa = p.rg_wa + (size_t)((d * 8 + h) * 64) * 64 + jj; const float* wi = p.rg_wi + (size_t)((d * 8 + h) * 64) * 64 + jj;
#pragma unroll 2
            for (int i = 0; i < 64; ++i) { const float wav = wa[i * 64], wiv = wi[i * 64];
#pragma unroll
                for (int q = 0; q < 8; ++q) { const float cv = cx[(r0 + 8 * q) * 64 + i]; aa[q] += cv * wav; ai[q] += cv * wiv; } }
            const float ba = p.rg_ba[d * DLRU + cch], bi = p.rg_bi[d * DLRU + cch], c8 = -8.f * log1pf(expf(-p.rg_lam[d * DLRU + cch]));
            LAS float* ao = d ? ab : af; LAS float* dout = d ? db : df;
#pragma unroll
            for (int q = 0; q < 8; ++q) { const int r = r0 + 8 * q; const float rg = sigmoidf_(aa[q] + ba), ig = sigmoidf_(ai[q] + bi), la = c8 * rg;
                ao[r * 64 + jj] = expf(la); dout[r * 64 + jj] = sqrtf(-expm1f(2.f * la)) * ig * cx[r * 64 + jj]; }
          } }
        __syncthreads();
        if (tid < 128) { const int d = tid >> 6, ch = tid & 63; float hh = 0.f, pp = 1.f;
            if (d == 0) {
#pragma unroll 4
                for (int r = 0; r < 64; ++r) { const float a = af[r * 64 + ch]; hh = a * hh + df[r * 64 + ch]; pp *= a; df[r * 64 + ch] = hh; af[r * 64 + ch] = pp; } }
            else {
#pragma unroll 4
                for (int r = 63; r >= 0; --r) { const float a = ab[r * 64 + ch]; hh = a * hh + db[r * 64 + ch]; pp *= a; db[r * 64 + ch] = hh; ab[r * 64 + ch] = pp; } }
            float* s = SUM + ((size_t)((b * NSEG + seg) * 2 + d) * DLRU + h * 64 + ch) * 2; s[0] = pp; s[1] = hh; }
        __syncthreads();
        if (seg >= 4) for (int i = tid; i < 4096; i += NTHREADS) { const int r = i >> 6, ch = i & 63; const size_t o = (size_t)(b * SEQ + (seg - 4) * 64 + r) * DLRU + h * 64 + ch;
            HS[o] = (bf16)f2bf(df[i] + db[i]); PF[o] = (bf16)f2bf(af[i]); PB[o] = (bf16)f2bf(ab[i]); }
        __syncthreads();
    }
}

__device__ __forceinline__ void phase_sgu(const P& p, LAS unsigned char* lds, int tid, int vcu, int G) {
    LAS float* vn = (LAS float*)lds;
    LAS float* wsl = (LAS float*)(lds + 65536);
    const bf16* UV = (const bf16*)(p.ws + WS_UV); bf16* A2 = (bf16*)(p.ws + WS_A2);
    for (int T = vcu; T < 512; T += G) {
        const int b = T >> 6, n = (T >> 2) & 15, h = T & 3; const size_t t0 = (size_t)b * SEQ + n * 128;
        for (int i = tid; i < 16384; i += NTHREADS) { const int q = i >> 7, c = i & 127; vn[i] = bf2f(UV[(t0 + q) * DIN + 512 + h * 128 + c]); wsl[i] = p.sgu_w[h * 16384 + i]; }
        __syncthreads();
        { const int q = tid >> 2, part = tid & 3; float s = 0.f;
          for (int c = part * 32; c < part * 32 + 32; ++c) { const float v = vn[q * 128 + c]; s += v * v; }
          s += __shfl_xor(s, 1); s += __shfl_xor(s, 2);
          const float rinv = rsqrtf(s * (1.f / 128.f) + EPS);
          for (int c = part * 32; c < part * 32 + 32; ++c) vn[q * 128 + c] *= rinv * p.sgu_g[h * 128 + c]; }
        __syncthreads();
        { const int c = tid & 127, p0 = tid >> 7; float acc[32];
#pragma unroll
          for (int i = 0; i < 32; ++i) acc[i] = 0.f;
          for (int q = 0; q < 128; ++q) { const float vq = vn[q * 128 + c];
#pragma unroll
              for (int i = 0; i < 32; ++i) acc[i] += wsl[(p0 + 4 * i) * 128 + q] * vq; }
#pragma unroll
          for (int i = 0; i < 32; ++i) { const int pp = p0 + 4 * i; const float s = acc[i] + p.sgu_b[h * 128 + pp];
              const float uu = bf2f(UV[(t0 + pp) * DIN + h * 128 + c]); A2[(t0 + pp) * D + h * 128 + c] = (bf16)f2bf(uu * s); } }
        __syncthreads();
    }
}


__device__ __forceinline__ void phase_lru1_mfma(const P& p, LAS unsigned char* lds, int tid, int lane, int wave, int vcu, int G) {
    LAS float* xt = (LAS float*)lds;
    LAS float* cxf = (LAS float*)(lds + 17152);
    LAS unsigned char* cxb = lds + 33536;
    LAS float* AD = (LAS float*)(lds + 42752);
    LAS float* SS = (LAS float*)(lds + 108288);
    const bf16* UV = (const bf16*)(p.ws + WS_UV); const bf16* XC = (const bf16*)(p.ws + WS_XC); const bf16* GWT = (const bf16*)(p.ws + WS_GWT);
    bf16* HS = (bf16*)(p.ws + WS_HS); bf16* PF = (bf16*)(p.ws + WS_PF); bf16* PB = (bf16*)(p.ws + WS_PB); float* SUM = (float*)(p.ws + WS_SUM);
    const int fr = lane & 15, fq = lane >> 4;
    const int wd = wave >> 2, jt = wave & 3, wj = 16 * jt + fr, cch_c = tid & 63;
    int hcur = -1; bf16x8 bfr[2][2]; float ba = 0.f, bi = 0.f, c8 = 0.f, cw0 = 0.f, cw1 = 0.f, cw2 = 0.f, cw3 = 0.f, cbias = 0.f;
    auto load_piece = [&](int T, int i) -> v4u { const int b = T / (NSEG * 8), rem = T % (NSEG * 8), seg = rem >> 3, h = rem & 7, r = (i >> 3) - 1, c0 = (i & 7) * 8; v4u w = (v4u){0u, 0u, 0u, 0u};
        if (seg < 4) { const int pos = seg * 64 + r; if (pos >= 0 && pos < CTXL) w = *(const v4u*)(XC + (size_t)(b * CTXL + pos) * DLRU + h * 64 + c0); }
        else { if (r >= 0 && r < 64) w = *(const v4u*)(UV + (size_t)(b * SEQ + (seg - 4) * 64 + r) * DIN + 1024 + h * 64 + c0); }
        return w; };
    v4u pre0 = (v4u){0u, 0u, 0u, 0u}, pre1 = (v4u){0u, 0u, 0u, 0u};
    if (vcu < BATCH * NSEG * 8) { pre0 = load_piece(vcu, tid); if (tid < 24) pre1 = load_piece(vcu, tid + 512); }
    for (int T = vcu; T < BATCH * NSEG * 8; T += G) {
        const int b = T / (NSEG * 8), rem = T % (NSEG * 8), seg = rem >> 3, h = rem & 7;
        { LAS float* o = xt + (tid >> 3) * 64 + (tid & 7) * 8;
          *(LAS f32x4*)o = (f32x4){bflo(pre0.x), bfhi(pre0.x), bflo(pre0.y), bfhi(pre0.y)}; *(LAS f32x4*)(o + 4) = (f32x4){bflo(pre0.z), bfhi(pre0.z), bflo(pre0.w), bfhi(pre0.w)};
          if (tid < 24) { LAS float* o1 = xt + ((tid + 512) >> 3) * 64 + (tid & 7) * 8;
              *(LAS f32x4*)o1 = (f32x4){bflo(pre1.x), bfhi(pre1.x), bflo(pre1.y), bfhi(pre1.y)}; *(LAS f32x4*)(o1 + 4) = (f32x4){bflo(pre1.z), bfhi(pre1.z), bflo(pre1.w), bfhi(pre1.w)}; } }
        if (h != hcur) { hcur = h;
#pragma unroll
            for (int g = 0; g < 2; ++g)
#pragma unroll
                for (int ks = 0; ks < 2; ++ks) bfr[g][ks] = *(const bf16x8*)(GWT + (size_t)((((wd * 2 + g) * 8 + h) * 64 + wj) * 64 + 32 * ks + 8 * fq));
            ba = p.rg_ba[wd * DLRU + h * 64 + wj]; bi = p.rg_bi[wd * DLRU + h * 64 + wj]; c8 = -8.f * log1pf(expf(-p.rg_lam[wd * DLRU + h * 64 + wj]));
            cw0 = p.conv_w[h * 64 + cch_c]; cw1 = p.conv_w[DLRU + h * 64 + cch_c]; cw2 = p.conv_w[2 * DLRU + h * 64 + cch_c]; cw3 = p.conv_w[3 * DLRU + h * 64 + cch_c]; cbias = p.conv_b[h * 64 + cch_c]; }
        __syncthreads();
        if (T + G < BATCH * NSEG * 8) { pre0 = load_piece(T + G, tid); if (tid < 24) pre1 = load_piece(T + G, tid + 512); }
        for (int i = tid; i < 4096; i += NTHREADS) { const int r = i >> 6, ch = i & 63;
            const float v = cbias + cw0 * xt[r * 64 + ch] + cw1 * xt[(r + 1) * 64 + ch] + cw2 * xt[(r + 2) * 64 + ch] + cw3 * xt[(r + 3) * 64 + ch];
            cxf[i] = v; *(LAS bf16*)(cxb + r * 144 + ch * 2) = (bf16)f2bf(v); }
        __syncthreads();
        { const int d = wd, j = wj;
          LAS float* Ad = AD + d * 8192; LAS float* Dd = Ad + 4096;
#pragma unroll
          for (int pt = 0; pt < 4; ++pt) {
              const bf16x8 a0 = *(const LAS bf16x8*)(cxb + (16 * pt + fr) * 144 + 16 * fq), a1 = *(const LAS bf16x8*)(cxb + (16 * pt + fr) * 144 + 64 + 16 * fq);
              f32x4 ca = (f32x4){0.f, 0.f, 0.f, 0.f}, ci = (f32x4){0.f, 0.f, 0.f, 0.f};
              ca = __builtin_amdgcn_mfma_f32_16x16x32_bf16(a0, bfr[0][0], ca, 0, 0, 0); ca = __builtin_amdgcn_mfma_f32_16x16x32_bf16(a1, bfr[0][1], ca, 0, 0, 0);
              ci = __builtin_amdgcn_mfma_f32_16x16x32_bf16(a0, bfr[1][0], ci, 0, 0, 0); ci = __builtin_amdgcn_mfma_f32_16x16x32_bf16(a1, bfr[1][1], ci, 0, 0, 0);
#pragma unroll
              for (int r = 0; r < 4; ++r) { const int pos = 16 * pt + 4 * fq + r; const float rg = sigmoidf_(ca[r] + ba), ig = sigmoidf_(ci[r] + bi), la = c8 * rg;
                  float av, sv; decay_pair(la, av, sv); Ad[pos * 64 + j] = av; Dd[pos * 64 + j] = sv * ig * cxf[pos * 64 + j]; }
          } }
        __syncthreads();
        { const int sub = tid >> 7, d = (tid >> 6) & 1, ch = tid & 63;
          LAS float* Ad = AD + d * 8192; LAS float* Dd = Ad + 4096;
          float hl[16], pc[16]; float hh = 0.f, pp = 1.f;
#pragma unroll
          for (int t = 0; t < 16; ++t) { const int pos = d ? 16 * sub + 15 - t : 16 * sub + t; const float a = Ad[pos * 64 + ch]; hh = a * hh + Dd[pos * 64 + ch]; pp *= a; hl[t] = hh; pc[t] = pp; }
          SS[((sub * 2 + d) * 64 + ch) * 2] = pp; SS[((sub * 2 + d) * 64 + ch) * 2 + 1] = hh;
          __syncthreads();
          float cin = 0.f, cp = 1.f;
          if (d == 0) { for (int s2 = 0; s2 < sub; ++s2) { const float A = SS[((s2 * 2) * 64 + ch) * 2], B = SS[((s2 * 2) * 64 + ch) * 2 + 1]; cin = A * cin + B; cp *= A; } }
          else { for (int s2 = 3; s2 > sub; --s2) { const float A = SS[((s2 * 2 + 1) * 64 + ch) * 2], B = SS[((s2 * 2 + 1) * 64 + ch) * 2 + 1]; cin = A * cin + B; cp *= A; } }
#pragma unroll
          for (int t = 0; t < 16; ++t) { const int pos = d ? 16 * sub + 15 - t : 16 * sub + t; Dd[pos * 64 + ch] = hl[t] + pc[t] * cin; Ad[pos * 64 + ch] = pc[t] * cp; }
          if ((d == 0 && sub == 3) || (d == 1 && sub == 0)) { float* so = SUM + ((size_t)((b * NSEG + seg) * 2 + d) * DLRU + h * 64 + ch) * 2; so[0] = pc[15] * cp; so[1] = hl[15] + pc[15] * cin; }
        }
        __syncthreads();
        if (seg >= 4) { const int pos = tid >> 3, c0 = (tid & 7) * 8; const LAS float* q0 = AD + pos * 64 + c0;
            const f32x4 a0l = *(const LAS f32x4*)(q0), a0h = *(const LAS f32x4*)(q0 + 4), d0l = *(const LAS f32x4*)(q0 + 4096), d0h = *(const LAS f32x4*)(q0 + 4100);
            const f32x4 a1l = *(const LAS f32x4*)(q0 + 8192), a1h = *(const LAS f32x4*)(q0 + 8196), d1l = *(const LAS f32x4*)(q0 + 12288), d1h = *(const LAS f32x4*)(q0 + 12292);
            const f32x4 sl = d0l + d1l, sh = d0h + d1h; const size_t o = (size_t)(b * SEQ + (seg - 4) * 64 + pos) * DLRU + h * 64 + c0;
            *(v4u*)(HS + o) = (v4u){pk2(sl.x, sl.y), pk2(sl.z, sl.w), pk2(sh.x, sh.y), pk2(sh.z, sh.w)};
            *(v4u*)(PF + o) = (v4u){pk2(a0l.x, a0l.y), pk2(a0l.z, a0l.w), pk2(a0h.x, a0h.y), pk2(a0h.z, a0h.w)};
            *(v4u*)(PB + o) = (v4u){pk2(a1l.x, a1l.y), pk2(a1l.z, a1l.w), pk2(a1h.x, a1h.y), pk2(a1h.z, a1h.w)}; }
        __syncthreads();
    }
}


template <int WD>
__device__ __forceinline__ void lru_scan(const float (&ga)[4][4], const float (&gb)[4][4], LAS float* EX, int lane, int fr, int fq, int wj, float& Pin, float& Hin) {
    const int cq = WD ? 3 - fq : fq, l16 = (WD ? lane + 16 : lane - 16) & 63, l32 = (WD ? lane + 32 : lane - 32) & 63, llast = WD ? fr : fr + 48;
    LAS float* Pd = EX + WD * 8192; LAS float* Hd = Pd + 4096;
#pragma unroll
    for (int ptc = 0; ptc < 4; ++ptc) { constexpr int dummy = 0; (void)dummy; const int pt = WD ? 3 - ptc : ptc;
        float pr[4], hr[4]; float hh = 0.f, pp = 1.f;
#pragma unroll
        for (int rc = 0; rc < 4; ++rc) { const int r = WD ? 3 - rc : rc; hh = ga[pt][r] * hh + gb[pt][r]; pp *= ga[pt][r]; pr[r] = pp; hr[r] = hh; }
        float A = pp, B = hh;
        { const float tA = __shfl(A, l16), tB = __shfl(B, l16); if (cq >= 1) { B = A * tB + B; A = tA * A; } }
        { const float tA = __shfl(A, l32), tB = __shfl(B, l32); if (cq >= 2) { B = A * tB + B; A = tA * A; } }
        float eA = __shfl(A, l16), eB = __shfl(B, l16); if (cq == 0) { eA = 1.f; eB = 0.f; }
        const float tAt = __shfl(A, llast), tBt = __shfl(B, llast);
        const float Hc = eA * Hin + eB, Pc = Pin * eA;
#pragma unroll
        for (int r = 0; r < 4; ++r) { const int pos = 16 * pt + 4 * fq + r; Hd[pos * 64 + wj] = pr[r] * Hc + hr[r]; Pd[pos * 64 + wj] = Pc * pr[r]; }
        Hin = tAt * Hin + tBt; Pin *= tAt;
    }
}

__device__ __forceinline__ void phase_lru1_v2(const P& p, LAS unsigned char* lds, int tid, int lane, int wave, int vcu, int G) {
    LAS float* xt = (LAS float*)lds;
    LAS float* cxf = (LAS float*)(lds + 17152);
    LAS unsigned char* cxb = lds + 33536;
    LAS float* EX = (LAS float*)(lds + 42752);
    const bf16* UV = (const bf16*)(p.ws + WS_UV); const bf16* XC = (const bf16*)(p.ws + WS_XC); const bf16* GWT = (const bf16*)(p.ws + WS_GWT);
    bf16* HS = (bf16*)(p.ws + WS_HS); bf16* PF = (bf16*)(p.ws + WS_PF); bf16* PB = (bf16*)(p.ws + WS_PB); float* SUM = (float*)(p.ws + WS_SUM);
    const int fr = lane & 15, fq = lane >> 4;
    const int wd = wave >> 2, jt = wave & 3, wj = 16 * jt + fr, cch_c = tid & 63;
    int hcur = -1; bf16x8 bfr[2][2]; float ba = 0.f, bi = 0.f, c8 = 0.f, cw0 = 0.f, cw1 = 0.f, cw2 = 0.f, cw3 = 0.f, cbias = 0.f;
    auto load_piece = [&](int T, int i) -> v4u { const int b = T / (NSEG * 8), rem = T % (NSEG * 8), seg = rem >> 3, h = rem & 7, r = (i >> 3) - 1, c0 = (i & 7) * 8; v4u w = (v4u){0u, 0u, 0u, 0u};
        if (seg < 4) { const int pos = seg * 64 + r; if (pos >= 0 && pos < CTXL) w = *(const v4u*)(XC + (size_t)(b * CTXL + pos) * DLRU + h * 64 + c0); }
        else { if (r >= 0 && r < 64) w = *(const v4u*)(UV + (size_t)(b * SEQ + (seg - 4) * 64 + r) * DIN + 1024 + h * 64 + c0); }
        return w; };
    v4u pre0 = (v4u){0u, 0u, 0u, 0u}, pre1 = (v4u){0u, 0u, 0u, 0u};
    if (vcu < BATCH * NSEG * 8) { pre0 = load_piece(vcu, tid); if (tid < 24) pre1 = load_piece(vcu, tid + 512); }
    for (int T = vcu; T < BATCH * NSEG * 8; T += G) {
        const int b = T / (NSEG * 8), rem = T % (NSEG * 8), seg = rem >> 3, h = rem & 7;
        { LAS float* o = xt + (tid >> 3) * 64 + (tid & 7) * 8;
          *(LAS f32x4*)o = (f32x4){bflo(pre0.x), bfhi(pre0.x), bflo(pre0.y), bfhi(pre0.y)}; *(LAS f32x4*)(o + 4) = (f32x4){bflo(pre0.z), bfhi(pre0.z), bflo(pre0.w), bfhi(pre0.w)};
          if (tid < 24) { LAS float* o1 = xt + ((tid + 512) >> 3) * 64 + (tid & 7) * 8;
              *(LAS f32x4*)o1 = (f32x4){bflo(pre1.x), bfhi(pre1.x), bflo(pre1.y), bfhi(pre1.y)}; *(LAS f32x4*)(o1 + 4) = (f32x4){bflo(pre1.z), bfhi(pre1.z), bflo(pre1.w), bfhi(pre1.w)}; } }
        if (h != hcur) { hcur = h;
#pragma unroll
            for (int g = 0; g < 2; ++g)
#pragma unroll
                for (int ks = 0; ks < 2; ++ks) bfr[g][ks] = *(const bf16x8*)(GWT + (size_t)((((wd * 2 + g) * 8 + h) * 64 + wj) * 64 + 32 * ks + 8 * fq));
            ba = p.rg_ba[wd * DLRU + h * 64 + wj]; bi = p.rg_bi[wd * DLRU + h * 64 + wj]; c8 = -8.f * log1pf(expf(-p.rg_lam[wd * DLRU + h * 64 + wj]));
            cw0 = p.conv_w[h * 64 + cch_c]; cw1 = p.conv_w[DLRU + h * 64 + cch_c]; cw2 = p.conv_w[2 * DLRU + h * 64 + cch_c]; cw3 = p.conv_w[3 * DLRU + h * 64 + cch_c]; cbias = p.conv_b[h * 64 + cch_c]; }
        __syncthreads();
        if (T + G < BATCH * NSEG * 8) { pre0 = load_piece(T + G, tid); if (tid < 24) pre1 = load_piece(T + G, tid + 512); }
        for (int i = tid; i < 4096; i += NTHREADS) { const int r = i >> 6, ch = i & 63;
            const float v = cbias + cw0 * xt[r * 64 + ch] + cw1 * xt[(r + 1) * 64 + ch] + cw2 * xt[(r + 2) * 64 + ch] + cw3 * xt[(r + 3) * 64 + ch];
            cxf[i] = v; *(LAS bf16*)(cxb + r * 144 + ch * 2) = (bf16)f2bf(v); }
        __syncthreads();
        {
            float ga[4][4], gb[4][4];
#pragma unroll
            for (int pt = 0; pt < 4; ++pt) {
                const bf16x8 a0 = *(const LAS bf16x8*)(cxb + (16 * pt + fr) * 144 + 16 * fq), a1 = *(const LAS bf16x8*)(cxb + (16 * pt + fr) * 144 + 64 + 16 * fq);
                f32x4 ca = (f32x4){0.f, 0.f, 0.f, 0.f}, ci = (f32x4){0.f, 0.f, 0.f, 0.f};
                ca = __builtin_amdgcn_mfma_f32_16x16x32_bf16(a0, bfr[0][0], ca, 0, 0, 0); ca = __builtin_amdgcn_mfma_f32_16x16x32_bf16(a1, bfr[0][1], ca, 0, 0, 0);
                ci = __builtin_amdgcn_mfma_f32_16x16x32_bf16(a0, bfr[1][0], ci, 0, 0, 0); ci = __builtin_amdgcn_mfma_f32_16x16x32_bf16(a1, bfr[1][1], ci, 0, 0, 0);
#pragma unroll
                for (int r = 0; r < 4; r += 2) { const int pos = 16 * pt + 4 * fq + r;
                    const f32x2p rg = sigmoid2_((f32x2p){ca[r], ca[r + 1]} + ba), ig = sigmoid2_((f32x2p){ci[r], ci[r + 1]} + bi); f32x2p av, sv; decay_pair2(rg * c8, av, sv);
                    const f32x2p dv = sv * ig * (f32x2p){cxf[pos * 64 + wj], cxf[(pos + 1) * 64 + wj]}; ga[pt][r] = av.x; ga[pt][r + 1] = av.y; gb[pt][r] = dv.x; gb[pt][r + 1] = dv.y; }
            }
            float Pin = 1.f, Hin = 0.f;
            if (wd == 0) lru_scan<0>(ga, gb, EX, lane, fr, fq, wj, Pin, Hin); else lru_scan<1>(ga, gb, EX, lane, fr, fq, wj, Pin, Hin);
            if (fq == 0) { float* so = SUM + ((size_t)((b * NSEG + seg) * 2 + wd) * DLRU + h * 64 + wj) * 2; so[0] = Pin; so[1] = Hin; }
        }
        __syncthreads();
        if (seg >= 4) { const int pos = tid >> 3, c0 = (tid & 7) * 8; const LAS float* q0 = EX + pos * 64 + c0;
            const f32x4 a0l = *(const LAS f32x4*)(q0), a0h = *(const LAS f32x4*)(q0 + 4), d0l = *(const LAS f32x4*)(q0 + 4096), d0h = *(const LAS f32x4*)(q0 + 4100);
            const f32x4 a1l = *(const LAS f32x4*)(q0 + 8192), a1h = *(const LAS f32x4*)(q0 + 8196), d1l = *(const LAS f32x4*)(q0 + 12288), d1h = *(const LAS f32x4*)(q0 + 12292);
            const f32x4 sl = d0l + d1l, sh = d0h + d1h; const size_t o = (size_t)(b * SEQ + (seg - 4) * 64 + pos) * DLRU + h * 64 + c0;
            *(v4u*)(HS + o) = (v4u){pk2(sl.x, sl.y), pk2(sl.z, sl.w), pk2(sh.x, sh.y), pk2(sh.z, sh.w)};
            *(v4u*)(PF + o) = (v4u){pk2(a0l.x, a0l.y), pk2(a0l.z, a0l.w), pk2(a0h.x, a0h.y), pk2(a0h.z, a0h.w)};
            *(v4u*)(PB + o) = (v4u){pk2(a1l.x, a1l.y), pk2(a1l.z, a1l.w), pk2(a1h.x, a1h.y), pk2(a1h.z, a1h.w)}; }
    }
    __syncthreads();
}

__device__ __forceinline__ void phase_sgu_mfma(const P& p, LAS unsigned char* lds, int tid, int lane, int wave, int vcu, int G, int first = 0, int last = 512) {
    LAS unsigned char* vnT = lds;
    const bf16* UV = (const bf16*)(p.ws + WS_UV); const bf16* SWB = (const bf16*)(p.ws + WS_SWB); bf16* A2 = (bf16*)(p.ws + WS_A2);
    const int fr = lane & 15, fq = lane >> 4;
    for (int T = first + vcu; T < last; T += G) {
        const int b = T >> 6, n = (T >> 2) & 15, h = T & 3; const size_t t0 = (size_t)b * SEQ + n * 128;
        { const int q = tid >> 2, part = tid & 3; const v4u* src = (const v4u*)(UV + (t0 + q) * DIN + 512 + h * 128 + part * 32);
          float v[32]; float s = 0.f;
#pragma unroll
          for (int i = 0; i < 4; ++i) { const v4u w = src[i]; v[8 * i] = bflo(w.x); v[8 * i + 1] = bfhi(w.x); v[8 * i + 2] = bflo(w.y); v[8 * i + 3] = bfhi(w.y); v[8 * i + 4] = bflo(w.z); v[8 * i + 5] = bfhi(w.z); v[8 * i + 6] = bflo(w.w); v[8 * i + 7] = bfhi(w.w); }
#pragma unroll
          for (int i = 0; i < 32; ++i) s += v[i] * v[i];
          s += __shfl_xor(s, 1); s += __shfl_xor(s, 2);
          const float rinv = rsqrtf(s * (1.f / 128.f) + EPS);
#pragma unroll
          for (int i = 0; i < 32; ++i) { const int c = part * 32 + i; *(LAS bf16*)(vnT + c * 272 + q * 2) = (bf16)f2bf(v[i] * rinv * p.sgu_g[h * 128 + c]); } }
        __syncthreads();
        { bf16x8 afr[4];
#pragma unroll
          for (int ks = 0; ks < 4; ++ks) afr[ks] = *(const bf16x8*)(SWB + (size_t)((h * 128 + 16 * wave + fr) * 128 + 32 * ks + 8 * fq));
          float bs[4];
#pragma unroll
          for (int r = 0; r < 4; ++r) bs[r] = p.sgu_b[h * 128 + 16 * wave + 4 * fq + r];
#pragma unroll
          for (int ct = 0; ct < 8; ++ct) { f32x4 acc = (f32x4){0.f, 0.f, 0.f, 0.f};
#pragma unroll
              for (int ks = 0; ks < 4; ++ks) { const bf16x8 bv = *(const LAS bf16x8*)(vnT + (16 * ct + fr) * 272 + 64 * ks + 16 * fq); acc = __builtin_amdgcn_mfma_f32_16x16x32_bf16(afr[ks], bv, acc, 0, 0, 0); }
#pragma unroll
              for (int r = 0; r < 4; ++r) { const int pp = 16 * wave + 4 * fq + r, c = 16 * ct + fr;
                  const float uu = bf2f(UV[(t0 + pp) * DIN + h * 128 + c]); A2[(t0 + pp) * D + h * 128 + c] = (bf16)f2bf(uu * (acc[r] + bs[r])); } } }
        __syncthreads();
    }
}

__device__ __forceinline__ void phase_lru2(const P& p, LAS unsigned char* lds, int tid, int vcu, int G) {
    LAS float* carry = (LAS float*)lds;
    const bf16* UV = (const bf16*)(p.ws + WS_UV); const bf16* HS = (const bf16*)(p.ws + WS_HS); const bf16* PF = (const bf16*)(p.ws + WS_PF); const bf16* PB = (const bf16*)(p.ws + WS_PB);
    const float* SUM = (const float*)(p.ws + WS_SUM); bf16* A2 = (bf16*)(p.ws + WS_A2);
    for (int T = vcu; T < BATCH * 32 * 8; T += G) {
        const int b = T >> 8, gr = (T >> 3) & 31, h = T & 7;
        if (tid < 128) { const int d = tid >> 6, ch = tid & 63; float hc = 0.f;
            const float* S = SUM + ((size_t)b * NSEG * 2 * DLRU + (size_t)d * DLRU + h * 64 + ch) * 2;
            if (d == 0) { for (int s = 0; s < 4 + gr; ++s) { const float A = S[(size_t)s * 2048], B = S[(size_t)s * 2048 + 1]; hc = A * hc + B; } }
            else { for (int s = 3; s >= 0; --s) { const float A = S[(size_t)s * 2048], B = S[(size_t)s * 2048 + 1]; hc = A * hc + B; }
                   for (int s = NSEG - 1; s > 4 + gr; --s) { const float A = S[(size_t)s * 2048], B = S[(size_t)s * 2048 + 1]; hc = A * hc + B; } }
            carry[tid] = hc; }
        __syncthreads();
        for (int i = tid; i < 4096; i += NTHREADS) { const int r = i >> 6, ch = i & 63; const size_t row = (size_t)b * SEQ + gr * 64 + r, o = row * DLRU + h * 64 + ch;
            const float val = bf2f(HS[o]) + bf2f(PF[o]) * carry[ch] + bf2f(PB[o]) * carry[64 + ch];
            A2[row * D + 512 + h * 64 + ch] = (bf16)f2bf(bf2f(UV[row * DIN + 1536 + h * 64 + ch]) * val); }
        __syncthreads();
    }
}


__device__ __forceinline__ void phase_lru2_fast(const P& p, LAS unsigned char* lds, int tid, int vcu, int G) {
    LAS float* carry = (LAS float*)lds;
    constexpr int NQ = LRU2_PARTS, GR = 32 / NQ, GSH = (NQ == 8) ? 2 : 3;
    const bf16* UV = (const bf16*)(p.ws + WS_UV); const bf16* HS = (const bf16*)(p.ws + WS_HS); const bf16* PF = (const bf16*)(p.ws + WS_PF); const bf16* PB = (const bf16*)(p.ws + WS_PB);
    const float* SUM = (const float*)(p.ws + WS_SUM); bf16* A2 = (bf16*)(p.ws + WS_A2);
    typedef float f32x2 __attribute__((ext_vector_type(2)));
    for (int T = vcu; T < 64 * NQ; T += G) {
        const int b = T / (8 * NQ), h = (T / NQ) & 7, qt = T % NQ;
        v4u hsv[GR], pfv[GR], pbv[GR], ggv[GR];
#pragma unroll
        for (int it = 0; it < GR; ++it) { const int v = it * NTHREADS + tid, pos = v >> 3, c0 = (v & 7) * 8; const size_t row = (size_t)b * SEQ + qt * (64 * GR) + pos, o = row * DLRU + h * 64 + c0;
            hsv[it] = *(const v4u*)(HS + o); pfv[it] = *(const v4u*)(PF + o); pbv[it] = *(const v4u*)(PB + o); ggv[it] = *(const v4u*)(UV + row * DIN + 1536 + h * 64 + c0); }
        if (tid < 128) { const int d = tid >> 6, ch = tid & 63;
            const f32x2* S = (const f32x2*)SUM + ((size_t)b * NSEG * 2 + d) * DLRU + h * 64 + ch;
            f32x2 ab[NSEG];
#pragma unroll
            for (int s2 = 0; s2 < NSEG; ++s2) ab[s2] = S[(size_t)s2 * 2 * DLRU];
            float hc = 0.f;
            if (d == 0) {
#pragma unroll
                for (int s2 = 0; s2 < NSEG; ++s2) { if (s2 >= 4 && ((s2 - 4) >> GSH) == qt) carry[(((s2 - 4) & (GR - 1)) * 2 + 0) * 64 + ch] = hc; hc = ab[s2].x * hc + ab[s2].y; }
            } else {
#pragma unroll
                for (int s2 = 3; s2 >= 0; --s2) hc = ab[s2].x * hc + ab[s2].y;
#pragma unroll
                for (int s2 = NSEG - 1; s2 >= 4; --s2) { if (((s2 - 4) >> GSH) == qt) carry[(((s2 - 4) & (GR - 1)) * 2 + 1) * 64 + ch] = hc; hc = ab[s2].x * hc + ab[s2].y; }
            } }
        __syncthreads();
#pragma unroll
        for (int it = 0; it < GR; ++it) { const int v = it * NTHREADS + tid, pos = v >> 3, c0 = (v & 7) * 8, grl = pos >> 6;
            const size_t row = (size_t)b * SEQ + qt * (64 * GR) + pos;
            const v4u hs = hsv[it], pf = pfv[it], pb = pbv[it], gg = ggv[it];
            const f32x4 cf0 = *(const LAS f32x4*)(carry + (grl * 2) * 64 + c0), cf1 = *(const LAS f32x4*)(carry + (grl * 2) * 64 + c0 + 4);
            const f32x4 cb0 = *(const LAS f32x4*)(carry + (grl * 2 + 1) * 64 + c0), cb1 = *(const LAS f32x4*)(carry + (grl * 2 + 1) * 64 + c0 + 4);
            v4u out;
            out.x = pk2(bflo(gg.x) * (bflo(hs.x) + bflo(pf.x) * cf0.x + bflo(pb.x) * cb0.x), bfhi(gg.x) * (bfhi(hs.x) + bfhi(pf.x) * cf0.y + bfhi(pb.x) * cb0.y));
            out.y = pk2(bflo(gg.y) * (bflo(hs.y) + bflo(pf.y) * cf0.z + bflo(pb.y) * cb0.z), bfhi(gg.y) * (bfhi(hs.y) + bfhi(pf.y) * cf0.w + bfhi(pb.y) * cb0.w));
            out.z = pk2(bflo(gg.z) * (bflo(hs.z) + bflo(pf.z) * cf1.x + bflo(pb.z) * cb1.x), bfhi(gg.z) * (bfhi(hs.z) + bfhi(pf.z) * cf1.y + bfhi(pb.z) * cb1.y));
            out.w = pk2(bflo(gg.w) * (bflo(hs.w) + bflo(pf.w) * cf1.z + bflo(pb.w) * cb1.z), bfhi(gg.w) * (bfhi(hs.w) + bfhi(pf.w) * cf1.w + bfhi(pb.w) * cb1.w));
            *(v4u*)(A2 + row * D + 512 + h * 64 + c0) = out; }
        __syncthreads();
    }
}

__device__ __forceinline__ void phase_p5(const P& p, LAS unsigned char* lds, int tid, int lane, int wave, int vcu, int G) {
    LAS float* wrT = (LAS float*)lds;
    const float* MOD = (const float*)(p.ws + WS_MOD); const float* X1 = (const float*)(p.ws + WS_X1); bf16* HX2 = (bf16*)(p.ws + WS_HX2); float* AFF = (float*)(p.ws + WS_AFF);
    for (int i = tid; i < D * NE; i += NTHREADS) wrT[(i & 15) * D + (i >> 4)] = p.w_router[i];
    __syncthreads();
    const int gw = vcu * NWAVES + wave, NGW = G * NWAVES;
    f32x4 nx[4];
    if (gw < M) { const f32x4* xr = (const f32x4*)(X1 + (size_t)gw * D) + lane;
#pragma unroll
        for (int jj = 0; jj < 4; ++jj) nx[jj] = xr[64 * jj]; }
    for (int m = gw; m < M; m += NGW) {
        const int b = m >> 11, t = m & 2047;
        f32x4 v[4]; float s = 0.f;
#pragma unroll
        for (int jj = 0; jj < 4; ++jj) { v[jj] = nx[jj]; s += (v[jj].x * v[jj].x + v[jj].y * v[jj].y) + (v[jj].z * v[jj].z + v[jj].w * v[jj].w); }
        if (m + NGW < M) { const f32x4* xr = (const f32x4*)(X1 + (size_t)(m + NGW) * D) + lane;
#pragma unroll
            for (int jj = 0; jj < 4; ++jj) nx[jj] = xr[64 * jj]; }
        const float rinv = rsqrtf(wave_sum(s) * (1.f / D) + EPS);
        v2u* o = (v2u*)(HX2 + (size_t)m * D) + lane;
#pragma unroll
        for (int jj = 0; jj < 4; ++jj) { const int k = 4 * (lane + 64 * jj);
            const f32x4 g = *(const f32x4*)(p.norm2_g + k), sh = *(const f32x4*)(MOD + b * NMOD + 3 * D + k), sc = *(const f32x4*)(MOD + b * NMOD + 4 * D + k);
            v[jj] = v[jj] * rinv * g * (sc + 1.f) + sh;
#if MOE_FP8
            ((unsigned*)(p.ws + WS_HX2) + (size_t)m * (D / 4))[lane + 64 * jj] = pk4_fp8(v[jj].x, v[jj].y, v[jj].z, v[jj].w); }
#else
            v2u w; w.x = pk2(v[jj].x, v[jj].y); w.y = pk2(v[jj].z, v[jj].w); o[64 * jj] = w; }
#endif
        float pa[16];
#pragma unroll
        for (int e = 0; e < 16; ++e) { float a = 0.f;
#pragma unroll
            for (int jj = 0; jj < 4; ++jj) { const f32x4 w = *(const LAS f32x4*)(wrT + e * D + 4 * (lane + 64 * jj)); a += (v[jj].x * w.x + v[jj].y * w.y) + (v[jj].z * w.z + v[jj].w * w.w); }
            pa[e] = a; if (e & 1) asm volatile("" ::: "memory"); }
        { const bool h5 = (lane & 32) != 0; float q8[8];
#pragma unroll
          for (int i = 0; i < 8; ++i) { const float keep = h5 ? pa[8 + i] : pa[i], give = h5 ? pa[i] : pa[8 + i]; q8[i] = keep + __shfl_xor(give, 32); }
          const bool h4 = (lane & 16) != 0; float q4[4];
#pragma unroll
          for (int i = 0; i < 4; ++i) { const float keep = h4 ? q8[4 + i] : q8[i], give = h4 ? q8[i] : q8[4 + i]; q4[i] = keep + __shfl_xor(give, 16); }
          const bool h3 = (lane & 8) != 0; float q2[2];
#pragma unroll
          for (int i = 0; i < 2; ++i) { const float keep = h3 ? q4[2 + i] : q4[i], give = h3 ? q4[i] : q4[2 + i]; q2[i] = keep + __shfl_xor(give, 8); }
          const bool h2 = (lane & 4) != 0;
          float lgt = (h2 ? q2[1] : q2[0]) + __shfl_xor(h2 ? q2[0] : q2[1], 4);
          lgt += __shfl_xor(lgt, 2); lgt += __shfl_xor(lgt, 1);
          float mx = lgt;
#pragma unroll
          for (int o2 = 4; o2 < 64; o2 <<= 1) mx = fmaxf(mx, __shfl_xor(mx, o2));
          const float ex = expf(lgt - mx); float den = ex;
#pragma unroll
          for (int o2 = 4; o2 < 64; o2 <<= 1) den += __shfl_xor(den, o2);
          if ((lane & 3) == 0) AFF[(size_t)(b * NE + (lane >> 2)) * SEQ + t] = ex / den; }
    }
    __syncthreads();
}

__device__ __forceinline__ void phase_p6(const P& p, LAS unsigned char* lds, int tid, int lane, int wave, int vcu, int G) {
    LAS float* a = (LAS float*)lds; LAS int* tok = (LAS int*)(lds + 8192);
    const float* AFF = (const float*)(p.ws + WS_AFF); int* SLOT = (int*)(p.ws + WS_SLOT); float* GATE = (float*)(p.ws + WS_GATE);
    const bf16* HX2 = (const bf16*)(p.ws + WS_HX2); bf16* XE = (bf16*)(p.ws + WS_XE);
    for (int T = vcu; T < BATCH * NE; T += G) {
        const int b = T >> 4, e = T & 15;
        for (int i = tid; i < SEQ; i += NTHREADS) a[i] = AFF[(size_t)(b * NE + e) * SEQ + i];
        __syncthreads();
        float at[4]; int rk[4];
#pragma unroll
        for (int i = 0; i < 4; ++i) { at[i] = a[tid + 512 * i]; rk[i] = 0; }
        for (int t2 = 0; t2 < SEQ; ++t2) { const float av = a[t2];
#pragma unroll
            for (int i = 0; i < 4; ++i) rk[i] += (av > at[i] || (av == at[i] && t2 < tid + 512 * i)) ? 1 : 0; }
#pragma unroll
        for (int i = 0; i < 4; ++i) { const int t = tid + 512 * i; SLOT[(size_t)(b * SEQ + t) * NE + e] = rk[i] < CAP ? rk[i] : -1;
            if (rk[i] < CAP) { tok[rk[i]] = t; GATE[e * 2048 + b * CAP + rk[i]] = at[i]; } }
        __syncthreads();
        for (int r = wave; r < CAP; r += NWAVES) { const v4u* src = (const v4u*)(HX2 + (size_t)(b * SEQ + tok[r]) * D); v4u* dst = (v4u*)(XE + (size_t)(e * 2048 + b * CAP + r) * D);
            dst[lane] = src[lane]; dst[lane + 64] = src[lane + 64]; }
        __syncthreads();
    }
}


__device__ __forceinline__ unsigned block_sum_u(unsigned v, LAS unsigned* red, int lane, int wave) {
    v = (unsigned)wave_sum((float)v);
    if (lane == 0) red[wave] = v;
    __syncthreads();
    unsigned s = 0;
#pragma unroll
    for (int w = 0; w < 8; ++w) s += red[w];
    return s;
}
__device__ __forceinline__ unsigned block_excl_scan(unsigned c, unsigned& total, LAS unsigned* red, int lane, int wave) {
    unsigned inc = c;
#pragma unroll
    for (int o = 1; o < 64; o <<= 1) { const unsigned t = __shfl_up(inc, o); if (lane >= o) inc += t; }
    if (lane == 63) red[wave] = inc;
    __syncthreads();
    unsigned off = 0, tot = 0;
#pragma unroll
    for (int w = 0; w < 8; ++w) { const unsigned x = red[w]; off += (w < wave) ? x : 0u; tot += x; }
    total = tot; return off + inc - c;
}
__device__ __forceinline__ void phase_p6_fast(const P& p, LAS unsigned char* lds, int tid, int lane, int wave, int vcu, int G) {
    LAS unsigned* red = (LAS unsigned*)lds;
    LAS int* tok = (LAS int*)(lds + 2048);
    const float* AFF = (const float*)(p.ws + WS_AFF); int* SLOT = (int*)(p.ws + WS_SLOT); float* GATE = (float*)(p.ws + WS_GATE);
    const bf16* HX2 = (const bf16*)(p.ws + WS_HX2); bf16* XE = (bf16*)(p.ws + WS_XE);
    for (int T = vcu; T < BATCH * NE * 2; T += G) {
        const int half = T & 1, e = (T >> 1) & 15, b = T >> 5;
        const f32x4 av = *(const f32x4*)(AFF + (size_t)(b * NE + e) * SEQ + 4 * tid);
        unsigned bits[4] = {__float_as_uint(av.x), __float_as_uint(av.y), __float_as_uint(av.z), __float_as_uint(av.w)};
        unsigned lo = 0u, hi = 0x3f800000u; int rb = 0;
        while (lo < hi) {
            const unsigned span = hi - lo, q = (span + 3u) >> 2, t1 = lo + q, t2 = min(lo + 2u * q, hi), t3 = min(lo + 3u * q, hi);
            unsigned w = 0;
#pragma unroll
            for (int i = 0; i < 4; ++i) w += (bits[i] >= t1 ? 1u : 0u) + (bits[i] >= t2 ? (1u << 10) : 0u) + (bits[i] >= t3 ? (1u << 20) : 0u);
#pragma unroll
            for (int o = 1; o < 64; o <<= 1) w += __shfl_xor(w, o);
            LAS unsigned* rd = red + 8 * rb; rb = (rb + 1) % 36;
            if (lane == 0) rd[wave] = w;
            __syncthreads();
            unsigned c1 = 0, c2 = 0, c3 = 0;
#pragma unroll
            for (int ww = 0; ww < 8; ++ww) { const unsigned x = rd[ww]; c1 += x & 1023u; c2 += (x >> 10) & 1023u; c3 += x >> 20; }
            if (c3 >= (unsigned)CAP) lo = t3; else if (c2 >= (unsigned)CAP) { lo = t2; hi = t3 - 1u; } else if (c1 >= (unsigned)CAP) { lo = t1; hi = t2 - 1u; } else hi = t1 - 1u;
        }
        const unsigned Tb = lo;
        unsigned cg = 0, ct = 0;
#pragma unroll
        for (int i = 0; i < 4; ++i) { cg += (bits[i] > Tb) ? 1u : 0u; ct += (bits[i] == Tb) ? 1u : 0u; }
        unsigned ngt; const unsigned need = (unsigned)CAP - (ngt = block_sum_u(cg, red + 8 * 36, lane, wave));
        unsigned ttot; unsigned tpre = block_excl_scan(ct, ttot, red + 8 * 37, lane, wave);
        unsigned sel[4], cs = 0;
#pragma unroll
        for (int i = 0; i < 4; ++i) { const bool tie = bits[i] == Tb; sel[i] = (bits[i] > Tb || (tie && tpre < need)) ? 1u : 0u; tpre += tie ? 1u : 0u; cs += sel[i]; }
        unsigned stot; unsigned spre = block_excl_scan(cs, stot, red + 8 * 38, lane, wave);
#pragma unroll
        for (int i = 0; i < 4; ++i) { const int t = 4 * tid + i;
            if ((t >> 10) == half) SLOT[(size_t)(b * SEQ + t) * NE + e] = sel[i] ? (int)spre : -1;
            if (sel[i]) { tok[spre] = t; if ((int)(spre >> 7) == half) GATE[e * 2048 + b * CAP + spre] = __uint_as_float(bits[i]); spre += 1u; } }
        __syncthreads();
#if MOE_FP8
        if (tid < 128) ((int*)(p.ws + WS_TOK))[e * 2048 + b * CAP + half * 128 + tid] = b * SEQ + tok[half * 128 + tid];
#else
        for (int r = half * 128 + wave; r < half * 128 + 128; r += NWAVES) { const v4u* src = (const v4u*)(HX2 + (size_t)(b * SEQ + tok[r]) * D); v4u* dst = (v4u*)(XE + (size_t)(e * 2048 + b * CAP + r) * D);
            dst[lane] = src[lane]; dst[lane + 64] = src[lane + 64]; }
#endif
        __syncthreads();
    }
}

template <bool X1B>
__device__ __forceinline__ void phase_p9(const P& p, int lane, int wave, int vcu, int G) {
    const float* MOD = (const float*)(p.ws + WS_MOD); const float* X1 = (const float*)(p.ws + WS_X1); const int* SLOT = (const int*)(p.ws + WS_SLOT); const bf16* YE = (const bf16*)(p.ws + WS_YE);
    const int gw = vcu * NWAVES + wave, NGW = G * NWAVES;
    f32x4 nx[4]; int nslot = -1;
    auto ldrow = [&](int mm) {
        if constexpr (X1B) { const v2u* xr = (const v2u*)((const bf16*)X1 + (size_t)mm * D) + lane;
#pragma unroll
            for (int jj = 0; jj < 4; ++jj) { const v2u w = xr[64 * jj]; nx[jj] = (f32x4){bflo(w.x), bfhi(w.x), bflo(w.y), bfhi(w.y)}; } }
        else { const f32x4* xr = (const f32x4*)(X1 + (size_t)mm * D) + lane;
#pragma unroll
            for (int jj = 0; jj < 4; ++jj) nx[jj] = xr[64 * jj]; } };
    if (gw < M) { ldrow(gw);
        nslot = SLOT[(size_t)gw * NE + (lane & 15)]; }
    for (int m = gw; m < M; m += NGW) {
        const int b = m >> 11;
        f32x4 v[4], acc[4]; const int myslot = nslot;
#pragma unroll
        for (int jj = 0; jj < 4; ++jj) { v[jj] = nx[jj]; acc[jj] = (f32x4){0.f, 0.f, 0.f, 0.f}; }
        if (m + NGW < M) { ldrow(m + NGW);
            nslot = SLOT[(size_t)(m + NGW) * NE + (lane & 15)]; }
#pragma unroll
        for (int e = 0; e < NE; ++e) { const int sl = __builtin_amdgcn_readlane(myslot, e);
#if MOE_FP8
            if (sl >= 0) { const unsigned* y = (const unsigned*)((const unsigned char*)YE + (size_t)(e * 2048 + b * CAP + sl) * D) + lane;
#pragma unroll
                for (int jj = 0; jj < 4; ++jj) { const unsigned w = y[64 * jj]; const auto lo = __builtin_amdgcn_cvt_pk_f32_fp8((int)w, false), hi = __builtin_amdgcn_cvt_pk_f32_fp8((int)w, true);
                    acc[jj] += (f32x4){lo[0], lo[1], hi[0], hi[1]}; } } }
#else
            if (sl >= 0) { const v2u* y = (const v2u*)(YE + (size_t)(e * 2048 + b * CAP + sl) * D) + lane;
#pragma unroll
                for (int jj = 0; jj < 4; ++jj) { const v2u w = y[64 * jj]; acc[jj] += (f32x4){bflo(w.x), bfhi(w.x), bflo(w.y), bfhi(w.y)}; } } }
#endif
        float s = 0.f;
#pragma unroll
        for (int jj = 0; jj < 4; ++jj) { const int k = 4 * (lane + 64 * jj); const f32x4 g2 = *(const f32x4*)(MOD + b * NMOD + 5 * D + k); v[jj] += g2 * acc[jj] * (MOE_FP8 ? WSCALE_INV : 1.f);
            s += (v[jj].x * v[jj].x + v[jj].y * v[jj].y) + (v[jj].z * v[jj].z + v[jj].w * v[jj].w); }
        const float rinv = rsqrtf(wave_sum(s) * (1.f / D) + EPS);
        f32x4* o = (f32x4*)(p.out + (size_t)m * D) + lane;
#pragma unroll
        for (int jj = 0; jj < 4; ++jj) { const int k = 4 * (lane + 64 * jj); o[64 * jj] = v[jj] * rinv * *(const f32x4*)(p.final_g + k); }
    }
}

#if CONV_CUS && MOE_FP8 && XCD_BAR && LRU1_MFMA && SGU_MFMA && LRU2_FAST && P6_FAST && USE_PG8 && (MK_N_LAUNCHES == 1)
__global__ void __launch_bounds__(NTHREADS, 2) fwd_megakernel(P p) {
    extern __shared__ __attribute__((aligned(16))) unsigned char lds_raw[];
    LAS unsigned char* lds = (LAS unsigned char*)lds_raw;
    const int tid = threadIdx.x, lane = tid & 63, wave = __builtin_amdgcn_readfirstlane(tid >> 6);
    const int G = gridDim.x, bx = blockIdx.x, xg = bx & 7, xl = bx >> 3;
    const int vcu = (G % 8 == 0) ? xg * (G / 8) + xl : bx;
    constexpr int CSH = (NCONV == 64) ? 2 : 3, CPG = 32 >> CSH, WPG = 32 - CPG;
    const bool split = (G == 256), is_conv = split && ((xl & ((1 << CSH) - 1)) == (1 << CSH) - 1);
    const int GW = split ? 8 * WPG : G, wvcu = split ? xg * WPG + (xl - (xl >> CSH)) : vcu, cvcu = xg * CPG + (xl >> CSH);
    volatile LAS unsigned* bst = (volatile LAS unsigned*)(lds + LDS_BYTES - 16);
    if (tid < 4) bst[tid] = 0u;
    __syncthreads();
    unsigned* ctl = (unsigned*)(p.ws + WS_CTL);
    const XcdBarrier barA = xcd_barrier_post(ctl + 4096, bst, (unsigned)G);
    XcdBarrier barW = barA;
    if (split && !is_conv) barW = xcd_barrier_post(ctl + 4096 + XCD_BAR_WORDS, bst + 2, (unsigned)GW);

    if (is_conv) {
        convert_pipelined(p, lds, lane, wave, CONV_HEAD, CONV_ITEMS, cvcu * NWAVES + wave, 8 * CPG * NWAVES);
        if (tid == 0) { XB_SPIN(xb_ld(ctl + 64) == 0u, ctl + 4096); __builtin_amdgcn_fence(__ATOMIC_ACQUIRE, "agent"); asm volatile("s_waitcnt vmcnt(0)" ::: "memory"); }
        __syncthreads();
        phase_sgu_mfma(p, lds, tid, lane, wave, cvcu, 8 * CPG, 0, SGU_CONV_TASKS);
    } else {
        phase_p0(p, lds, tid, lane, wave, wvcu, GW, split ? 16 * 32 : CONV_ITEMS, !split);
        xcd_barrier(barW);
        phase_p1(p, lane, wave, wvcu, GW);
        if (split) { convert_items(p, lds, lane, wave, 16 * 32, CONV_HEAD, wvcu * NWAVES + wave, GW * NWAVES); p0_small_copies(p, tid, wvcu, GW); }
        xcd_barrier(barW);
        { pg8::Gemm g{(const bf16*)(p.ws + WS_HX), (const bf16*)(p.ws + WS_WIN), D}; SchedG1 S{GW, wvcu}; EpiG1 E{(bf16*)(p.ws + WS_UV), (bf16*)(p.ws + WS_XC)};
          pg8::gemm_phase<EpiG1, SchedG1, true, true>(lds, g, S, E); }
        xcd_barrier(barW);
        if (split && wvcu == 0 && tid == 0) __hip_atomic_store(ctl + 64, 1u, __ATOMIC_RELAXED, __HIP_MEMORY_SCOPE_AGENT);
#if LRU1_V2
        phase_lru1_v2(p, lds, tid, lane, wave, wvcu, GW);
#else
        phase_lru1_mfma(p, lds, tid, lane, wave, wvcu, GW);
#endif
        phase_sgu_mfma(p, lds, tid, lane, wave, wvcu, GW, split ? SGU_CONV_TASKS : 0, 512);
        xcd_barrier(barW);
        phase_lru2_fast(p, lds, tid, wvcu, GW);
    }
    xcd_barrier(barA);
    if (split) {
        pg8::Gemm g{(const bf16*)(p.ws + WS_A2), (const bf16*)(p.ws + WS_WOUT), D}; SchedG2 S{G, vcu};
        EpiG2F E{p.x, (const float*)(p.ws + WS_MOD), (float*)(p.ws + WS_X1), p.w_router, p.norm2_g, (const float*)(p.ws + WS_CB), (float*)(p.ws + WS_XCH), ctl + 2048, ctl + 4096, p.ws + WS_HX2, (float*)(p.ws + WS_AFF)};
        pg8::gemm_phase<EpiG2F, SchedG2, true, true>(lds, g, S, E);
    } else {
        { pg8::Gemm g{(const bf16*)(p.ws + WS_A2), (const bf16*)(p.ws + WS_WOUT), D}; SchedG2 S{G, vcu}; EpiG2 E{p.x, (const float*)(p.ws + WS_MOD), (float*)(p.ws + WS_X1)};
          pg8::gemm_phase<EpiG2, SchedG2, true, true>(lds, g, S, E); }
        xcd_barrier(barA);
        phase_p5(p, lds, tid, lane, wave, vcu, G);
    }
    xcd_barrier(barA);
    phase_p6_fast(p, lds, tid, lane, wave, vcu, G);
    xcd_barrier(barA);
    { pg8::Gemm g{(const bf16*)(p.ws + WS_HX2), (const bf16*)(p.ws + WS_WG), D}; SchedG3 S{G, vcu}; EpiG3 E{p.ws + WS_HID};
      pg8::gemm_phase_f8g<EpiG3, SchedG3, true, true>(lds, g, S, E, (const int*)(p.ws + WS_TOK)); }
    xcd_barrier(barA);
    { pg8::Gemm g{(const bf16*)(p.ws + WS_HID), (const bf16*)(p.ws + WS_W2), DE}; SchedG4 S{G, vcu}; EpiG4 E{(const float*)(p.ws + WS_GATE), p.ws + WS_YE};
      pg8::gemm_phase_f8<EpiG4, SchedG4, true, true>(lds, g, S, E); }
    xcd_barrier(barA);
    if (split) phase_p9<true>(p, lane, wave, vcu, G); else phase_p9<false>(p, lane, wave, vcu, G);
}
#else
__global__ void __launch_bounds__(NTHREADS, 2) fwd_megakernel(P p) {
    extern __shared__ __attribute__((aligned(16))) unsigned char lds_raw[];
    LAS unsigned char* lds = (LAS unsigned char*)lds_raw;
    const int tid = threadIdx.x, lane = tid & 63, wave = __builtin_amdgcn_readfirstlane(tid >> 6);
    const int G = gridDim.x, bx = blockIdx.x, vcu = (G % 8 == 0) ? (bx % 8) * (G / 8) + bx / 8 : bx;
    const int lo = p.ph_lo, hi = p.ph_hi;
#if XCD_BAR
    volatile LAS unsigned* bst = (volatile LAS unsigned*)(lds + LDS_BYTES - 16);
    if (tid < 2) bst[tid] = 0u;
    __syncthreads();
    XcdBarrier bar; bar.bar = (unsigned*)(p.ws + WS_CTL) + 4096; bar.x = 0; bar.st = bst; bar.total = (unsigned)G;
    if (hi - lo > 1) bar = xcd_barrier_post((unsigned*)(p.ws + WS_CTL) + 4096, bst, (unsigned)G);
#define GRID_SYNC() xcd_barrier(bar)
#else
    cg::grid_group grid = cg::this_grid();
#define GRID_SYNC() grid.sync()
#endif
#define IN(k) (lo <= (k) && (k) < hi)
#define SEAM(k) do { if (IN(k) && IN((k) + 1)) GRID_SYNC(); } while (0)
#define REP(k) for (int rep_ = 0; rep_ < 1 + ((DUP_MASK >> (k)) & 1); ++rep_)
    if (IN(0)) { REP(0) { phase_p0(p, lds, tid, lane, wave, vcu, G, CONV_CUT); __syncthreads(); } SEAM(0); }
    if (IN(1)) { REP(1) phase_p1(p, lane, wave, vcu, G); SEAM(1); }
    if ((DUP_MASK >> 12) & 1) { for (int xb = 0; xb < 8; ++xb) GRID_SYNC(); }
    if (IN(2)) { pg8::Gemm g{(const bf16*)(p.ws + WS_HX), (const bf16*)(p.ws + WS_WIN), D}; SchedG1 S{G, vcu}; EpiG1 E{(bf16*)(p.ws + WS_UV), (bf16*)(p.ws + WS_XC)};
        REP(2) { gemm_any(lds, g, S, E); if (G > 16 && vcu >= 16) convert_items(p, lds, lane, wave, CONV_CUT, CONV_ITEMS, (vcu - 16) * NWAVES + wave, (G - 16) * NWAVES); }
        if (G <= 16) convert_items(p, lds, lane, wave, CONV_CUT, CONV_ITEMS, vcu * NWAVES + wave, G * NWAVES);
        SEAM(2); }
    if (IN(3)) { REP(3) {
#if LRU1_MFMA
        phase_lru1_mfma(p, lds, tid, lane, wave, vcu, G);
#else
        phase_lru1(p, lds, tid, vcu, G);
#endif
        } REP(11) {
#if SGU_MFMA
        phase_sgu_mfma(p, lds, tid, lane, wave, vcu, G);
#else
        phase_sgu(p, lds, tid, vcu, G);
#endif
        } SEAM(3); }
    if (IN(4)) { REP(4) {
#if LRU2_FAST
        phase_lru2_fast(p, lds, tid, vcu, G);
#else
        phase_lru2(p, lds, tid, vcu, G);
#endif
        } SEAM(4); }
    if (IN(5)) { pg8::Gemm g{(const bf16*)(p.ws + WS_A2), (const bf16*)(p.ws + WS_WOUT), D}; SchedG2 S{G, vcu}; EpiG2 E{p.x, (const float*)(p.ws + WS_MOD), (float*)(p.ws + WS_X1)};
        REP(5) gemm_any(lds, g, S, E); SEAM(5); }
    if (IN(6)) { REP(6) phase_p5(p, lds, tid, lane, wave, vcu, G); SEAM(6); }
    if (IN(7)) { REP(7) {
#if P6_FAST
        phase_p6_fast(p, lds, tid, lane, wave, vcu, G);
#else
        phase_p6(p, lds, tid, lane, wave, vcu, G);
#endif
        } SEAM(7); }
#if MOE_FP8
    if (IN(8)) { pg8::Gemm g{(const bf16*)(p.ws + WS_XE), (const bf16*)(p.ws + WS_WG), D}; SchedG3 S{G, vcu}; EpiG3 E{p.ws + WS_HID};
        REP(8) pg8::gemm_phase_f8<EpiG3, SchedG3, true, true>(lds, g, S, E); SEAM(8); }
    if (IN(9)) { pg8::Gemm g{(const bf16*)(p.ws + WS_HID), (const bf16*)(p.ws + WS_W2), DE}; SchedG4 S{G, vcu}; EpiG4 E{(const float*)(p.ws + WS_GATE), p.ws + WS_YE};
        REP(9) pg8::gemm_phase_f8<EpiG4, SchedG4, true, true>(lds, g, S, E); SEAM(9); }
#else
    if (IN(8)) { pg8::Gemm g{(const bf16*)(p.ws + WS_XE), (const bf16*)(p.ws + WS_WG), D}; SchedG3 S{G, vcu}; EpiG3 E{(bf16*)(p.ws + WS_HID)};
        REP(8) gemm_any(lds, g, S, E); SEAM(8); }
    if (IN(9)) { pg8::Gemm g{(const bf16*)(p.ws + WS_HID), (const bf16*)(p.ws + WS_W2), DE}; SchedG4 S{G, vcu}; EpiG4 E{(const float*)(p.ws + WS_GATE), (bf16*)(p.ws + WS_YE)};
        REP(9) gemm_any(lds, g, S, E); SEAM(9); }
#endif
    if (IN(10)) { REP(10) phase_p9<false>(p, lane, wave, vcu, G); }
#undef IN
#undef REP
#undef SEAM
#undef GRID_SYNC
}

#endif

extern "C" void kernel_launch(void* const* d_in, const int* in_sizes, int n_in, void* d_out, int out_size, void* d_ws, size_t ws_size, hipStream_t stream) {
    static int grid = 0;
    if (grid == 0) {
        if (n_in != 25 || in_sizes[0] != M * D || out_size != M * D || ws_size < WS_END) { fprintf(stderr, "kernel_launch: unexpected shapes (n_in %d, in0 %d, out %d, ws %zu < %zu)\n", n_in, n_in > 0 ? in_sizes[0] : -1, out_size, ws_size, (size_t)WS_END); grid = -1; return; }
        int dev = 0, cus = 0, per_cu = 0;
        if (hipGetDevice(&dev) != hipSuccess || hipDeviceGetAttribute(&cus, hipDeviceAttributeMultiprocessorCount, dev) != hipSuccess) { grid = -1; return; }
        if (hipFuncSetAttribute((const void*)fwd_megakernel, hipFuncAttributeMaxDynamicSharedMemorySize, LDS_BYTES) != hipSuccess) { fprintf(stderr, "kernel_launch: hipFuncSetAttribute failed\n"); grid = -1; return; }
        if (hipOccupancyMaxActiveBlocksPerMultiprocessor(&per_cu, (const void*)fwd_megakernel, NTHREADS, LDS_BYTES) != hipSuccess || per_cu < 1) { fprintf(stderr, "kernel_launch: occupancy query failed (%d)\n", per_cu); (void)hipGetLastError(); grid = -1; return; }
        grid = cus * per_cu;
    }
    if (grid < 0) return;
#if XCD_BAR
    if (hipMemsetAsync((char*)d_ws + WS_CTL, 0, 65536, stream) != hipSuccess) { fprintf(stderr, "kernel_launch: hipMemsetAsync failed\n"); return; }
#endif
    P p{};
    const float** f = (const float**)&p;
    for (int i = 0; i < 25; ++i) f[i] = (const float*)d_in[i];
    p.out = (float*)d_out; p.ws = (unsigned char*)d_ws;
#if MK_N_LAUNCHES == 1
    p.ph_lo = 0; p.ph_hi = NPH; void* args[] = {&p};
    hipError_t e = hipLaunchCooperativeKernel((const void*)fwd_megakernel, dim3(grid), dim3(NTHREADS), args, LDS_BYTES, stream);
    if (e != hipSuccess) fprintf(stderr, "kernel_launch: cooperative launch failed: %s (grid %d)\n", hipGetErrorString(e), grid);
#else
    for (int ph = 0; ph < NPH; ++ph) { p.ph_lo = ph; p.ph_hi = ph + 1; hipLaunchKernelGGL(fwd_megakernel, dim3(grid), dim3(NTHREADS), LDS_BYTES, stream, p); }
#endif
}
```

```cpp
#include <hip/hip_runtime.h>
#include <hip/hip_cooperative_groups.h>
#include <cstdio>
#include <cstdint>
namespace cg = cooperative_groups;

#ifndef MK_N_LAUNCHES
#define MK_N_LAUNCHES 1
#endif
#ifndef XCD_BAR
#define XCD_BAR 1
#endif
#ifndef LRU1_MFMA
#define LRU1_MFMA 1
#endif
#ifndef SGU_MFMA
#define SGU_MFMA 1
#endif
#ifndef P6_FAST
#define P6_FAST 1
#endif
#ifndef DUP_MASK
#define DUP_MASK 0
#endif
#ifndef LRU2_FAST
#define LRU2_FAST 1
#endif
#ifndef MOE_FP8
#define MOE_FP8 1
#endif
#ifndef CONV_CUS
#define CONV_CUS 1
#endif
#ifndef NCONV
#define NCONV 64
#endif
#ifndef LRU1_V2
#define LRU1_V2 1
#endif
#ifndef SGU_CONV_TASKS
#define SGU_CONV_TASKS 128
#endif
#ifndef LRU2_PARTS
#define LRU2_PARTS 8
#endif
#ifndef USE_PG8
#define USE_PG8 1
#endif

namespace pg8 {
#define PG8_LAS __attribute__((address_space(3)))
typedef unsigned short bf16_t;
typedef short bf16x8 __attribute__((ext_vector_type(8)));
typedef float f32x4 __attribute__((ext_vector_type(4)));
typedef unsigned u32x4 __attribute__((ext_vector_type(4)));
typedef int v4i_t __attribute__((ext_vector_type(4)));
typedef int v8i_t __attribute__((ext_vector_type(8)));
constexpr int BM = 256, BK = 64, HALF = 128, HTB = HALF * BK * 2  , STAGE_BYTES = 8 * HTB;

__host__ __device__ __forceinline__ int lds_byte(int r, int c) { const int st = (r >> 4) * 2 + (c >> 5), rr = r & 15, cc = c & 31, ob = rr * 64 + cc * 2; return st * 1024 + (ob ^ (((ob >> 9) & 1) << 5)); }
__host__ __device__ __forceinline__ void stage_rc(int b, int& R, int& C) { const int st = b / 1024, sb = b % 1024, swz = sb ^ (((sb >> 9) & 1) << 5); R = (st >> 1) * 16 + swz / 64; C = (st & 1) * 32 + (swz % 64) / 2; }

struct Unit { int pm, pn, pnB; };
struct Gemm { const bf16_t* A; const bf16_t* Bt; int K; };

template <class Epi>
__device__ __forceinline__ void run_epi8(const Epi& E, const f32x4 (&acc)[2][2][4][2], const Unit& u, int wr, int wc, int fr, int fq) {
#pragma unroll
    for (int ai = 0; ai < 2; ++ai)
#pragma unroll
        for (int m = 0; m < 4; ++m) { const int row = ai * HALF + wr * 64 + m * 16 + fr;
            if constexpr (Epi::PAIRED) E.st2x8(u, row, wc * 32 + 8 * fq, acc[ai][0][m][0], acc[ai][0][m][1], acc[ai][1][m][0], acc[ai][1][m][1]);
            else {
#pragma unroll
                for (int bj = 0; bj < 2; ++bj) E.st8(u, row, bj * HALF + wc * 32 + 8 * fq, acc[ai][bj][m][0], acc[ai][bj][m][1]);
            } }
}
template <class Epi>
__device__ __forceinline__ void run_epi(const Epi& E, const f32x4 (&acc)[2][2][4][2], const Unit& u, int wr, int wc, int fr, int fq) {
#pragma unroll
    for (int ai = 0; ai < 2; ++ai)
#pragma unroll
        for (int m = 0; m < 4; ++m) { const int row = ai * HALF + wr * 64 + m * 16 + fr;
            if constexpr (Epi::PAIRED) {
#pragma unroll
                for (int n = 0; n < 2; ++n) E.st2(u, row, wc * 32 + n * 16 + 4 * fq, acc[ai][0][m][n], acc[ai][1][m][n]);
            } else {
#pragma unroll
                for (int bj = 0; bj < 2; ++bj)
#pragma unroll
                    for (int n = 0; n < 2; ++n) E.st(u, row, bj * HALF + wc * 32 + n * 16 + 4 * fq, acc[ai][bj][m][n]);
            } }
}

template <class Epi, class Sched, bool ALIGN_EPI = false, bool SP2 = false>
__device__ __forceinline__ void gemm_phase(PG8_LAS unsigned char* lds, const Gemm g, const Sched& S, const Epi& E) {
    const int tid = threadIdx.x, wid = __builtin_amdgcn_readfirstlane(tid >> 6), lane = tid & 63, wr = wid >> 2, wc = wid & 3, fr = lane & 15, fq = lane >> 4;
    const int K = g.K, nt = K / BK;
    unsigned voffA[2], voffB[2];
#pragma unroll
    for (int i = 0; i < 2; ++i) { int R, C; stage_rc(tid * 16 + i * 8192, R, C); const int rho = R & 31, Rb = (R & ~31) + 8 * ((rho & 15) >> 2) + 4 * (rho >> 4) + (rho & 3);
        voffA[i] = (unsigned)(R * K + C) * 2u; voffB[i] = (unsigned)(Rb * K + C) * 2u; }
    const size_t kstep = (size_t)(BK * 2);
    const size_t hstep = (size_t)HALF * K * 2;
    const size_t tstep = 2 * hstep;
    const unsigned ldsw = (unsigned)wid * 1024u;
    const int aoff = lds_byte(wr * 64 + fr, fq * 8), boff = lds_byte(wc * 32 + fr, fq * 8);
#define PG8_SA(b, h) (((b) * 2 + (h)) * HTB)
#define PG8_SB(b, h) ((4 + (b) * 2 + (h)) * HTB)
#define PG8_STAGE(bufoff, gbase, voff) do { _Pragma("unroll") for (int _i = 0; _i < 2; ++_i) \
        __builtin_amdgcn_global_load_lds((const unsigned*)((const char*)(gbase) + (voff)[_i]), (PG8_LAS unsigned*)(lds + (bufoff) + ldsw + _i * 8192), 16, 0, 0); } while (0)
#define PG8_LDA(dst, b, h) do { _Pragma("unroll") for (int m = 0; m < 4; ++m) _Pragma("unroll") for (int k = 0; k < 2; ++k) dst[m][k] = *(const PG8_LAS bf16x8*)(lds + PG8_SA(b, h) + aoff + m * 2048 + k * 1024); } while (0)
#define PG8_LDB(dst, b, h) do { _Pragma("unroll") for (int n = 0; n < 2; ++n) _Pragma("unroll") for (int k = 0; k < 2; ++k) dst[n][k] = *(const PG8_LAS bf16x8*)(lds + PG8_SB(b, h) + boff + n * 2048 + k * 1024); } while (0)
#define PG8_MMA(ai, bj, At, Bt) do { __builtin_amdgcn_s_setprio(1); _Pragma("unroll") for (int m = 0; m < 4; ++m) _Pragma("unroll") for (int n = 0; n < 2; ++n) _Pragma("unroll") for (int k = 0; k < 2; ++k) \
        acc[ai][bj][m][n] = __builtin_amdgcn_mfma_f32_16x16x32_bf16(Bt[n][k], At[m][k], acc[ai][bj][m][n], 0, 0, 0); __builtin_amdgcn_s_setprio(0); } while (0)
#define PG8_WAIT_V(n) asm volatile("s_waitcnt vmcnt(" #n ")" ::: "memory")
#define PG8_WAIT_L(n) asm volatile("s_waitcnt lgkmcnt(" #n ")" ::: "memory")
#define PG8_BAR __builtin_amdgcn_s_barrier()
#define PG8_SCHED __builtin_amdgcn_sched_barrier(0)
    Unit cur, nxt; int ui = 0;
    if (!S.next(0, cur)) return;
    f32x4 acc[2][2][4][2];
#pragma unroll
    for (int a = 0; a < 2; ++a)
#pragma unroll
        for (int b = 0; b < 2; ++b)
#pragma unroll
            for (int m = 0; m < 4; ++m)
#pragma unroll
                for (int n = 0; n < 2; ++n) acc[a][b][m][n] = (f32x4){0.f, 0.f, 0.f, 0.f};
    bf16x8 At[4][2], B0[2][2], B1[2][2];
    const char* cA = (const char*)g.A + (size_t)cur.pm * tstep; const char* cB = (const char*)g.Bt + (size_t)cur.pnB * tstep;

    if constexpr (SP2) {
        PG8_STAGE(PG8_SB(0, 0), cB, voffB); PG8_STAGE(PG8_SB(0, 1), cB + hstep, voffB); PG8_STAGE(PG8_SA(0, 0), cA, voffA); PG8_STAGE(PG8_SA(0, 1), cA + hstep, voffA);
        if (wr == 1) PG8_BAR;
        PG8_WAIT_V(2); PG8_BAR;
        PG8_STAGE(PG8_SB(1, 0), cB + kstep, voffB); PG8_STAGE(PG8_SA(1, 0), cA + kstep, voffA); PG8_STAGE(PG8_SB(1, 1), cB + hstep + kstep, voffB);
        PG8_WAIT_V(6); PG8_BAR;
    } else {
        PG8_STAGE(PG8_SB(0, 0), cB, voffB); PG8_STAGE(PG8_SA(0, 0), cA, voffA); PG8_STAGE(PG8_SB(0, 1), cB + hstep, voffB); PG8_STAGE(PG8_SA(0, 1), cA + hstep, voffA);
        if (wr == 1) PG8_BAR;
        PG8_WAIT_V(4); PG8_BAR;
        PG8_STAGE(PG8_SB(1, 0), cB + kstep, voffB); PG8_STAGE(PG8_SA(1, 0), cA + kstep, voffA); PG8_STAGE(PG8_SB(1, 1), cB + hstep + kstep, voffB);
        PG8_WAIT_V(6); PG8_BAR;
    }
    for (;;) {
        const bool has_next = S.next(ui + 1, nxt);
        const char* nA = has_next ? (const char*)g.A + (size_t)nxt.pm * tstep : cA; const char* nB = has_next ? (const char*)g.Bt + (size_t)nxt.pnB * tstep : cB;
        for (int t = 0; t < nt; t += 2) {
            const bool last = (t == nt - 2);
            const char* a1 = cA + (size_t)(t + 1) * kstep;
            const char* a2 = last ? nA : cA + (size_t)(t + 2) * kstep; const char* b2 = last ? nB : cB + (size_t)(t + 2) * kstep;
            const char* a3 = a2 + kstep; const char* b3 = b2 + kstep;

            if constexpr (SP2) {
            PG8_LDB(B0, 0, 0); PG8_LDB(B1, 0, 1); PG8_SCHED; PG8_LDA(At, 0, 0); PG8_STAGE(PG8_SA(1, 1), a1 + hstep, voffA);
            PG8_WAIT_V(8); PG8_WAIT_L(0); PG8_BAR; PG8_MMA(0, 0, At, B0); PG8_MMA(0, 1, At, B1); PG8_BAR; PG8_SCHED;
            PG8_LDA(At, 0, 1); PG8_STAGE(PG8_SB(0, 0), b2, voffB); PG8_STAGE(PG8_SB(0, 1), b2 + hstep, voffB); PG8_STAGE(PG8_SA(0, 0), a2, voffA);
            PG8_WAIT_V(8); PG8_WAIT_L(0); PG8_BAR; PG8_MMA(1, 0, At, B0); PG8_MMA(1, 1, At, B1); PG8_BAR; PG8_SCHED;
            PG8_LDB(B0, 1, 0); PG8_LDB(B1, 1, 1); PG8_SCHED; PG8_LDA(At, 1, 0); PG8_STAGE(PG8_SA(0, 1), a2 + hstep, voffA);
            PG8_WAIT_V(8); PG8_WAIT_L(0); PG8_BAR; PG8_MMA(0, 0, At, B0); PG8_MMA(0, 1, At, B1); PG8_BAR; PG8_SCHED;
            PG8_LDA(At, 1, 1); PG8_STAGE(PG8_SB(1, 0), b3, voffB); PG8_STAGE(PG8_SB(1, 1), b3 + hstep, voffB); PG8_STAGE(PG8_SA(1, 0), a3, voffA);
            PG8_WAIT_V(8); PG8_WAIT_L(0); PG8_BAR; PG8_MMA(1, 0, At, B0); PG8_MMA(1, 1, At, B1); PG8_BAR; PG8_SCHED;
            } else {
            PG8_LDB(B0, 0, 0); PG8_SCHED; PG8_LDA(At, 0, 0); PG8_STAGE(PG8_SA(1, 1), a1 + hstep, voffA);
            PG8_WAIT_L(8); PG8_BAR; PG8_WAIT_L(0); PG8_MMA(0, 0, At, B0); PG8_BAR; PG8_SCHED;
            PG8_LDB(B1, 0, 1); PG8_STAGE(PG8_SB(0, 0), b2, voffB);
            PG8_BAR; PG8_WAIT_L(0); PG8_MMA(0, 1, At, B1); PG8_BAR;
            PG8_LDA(At, 0, 1); PG8_STAGE(PG8_SA(0, 0), a2, voffA);
            PG8_BAR; PG8_WAIT_L(0); PG8_MMA(1, 0, At, B0); PG8_BAR; PG8_SCHED;
            PG8_STAGE(PG8_SB(0, 1), b2 + hstep, voffB);
            PG8_WAIT_V(6); PG8_BAR; PG8_MMA(1, 1, At, B1); PG8_BAR;
            PG8_LDB(B0, 1, 0); PG8_SCHED; PG8_LDA(At, 1, 0); PG8_STAGE(PG8_SA(0, 1), a2 + hstep, voffA);
            PG8_WAIT_L(8); PG8_BAR; PG8_WAIT_L(0); PG8_MMA(0, 0, At, B0); PG8_BAR; PG8_SCHED;
            PG8_LDB(B1, 1, 1); PG8_STAGE(PG8_SB(1, 0), b3, voffB);
            PG8_BAR; PG8_WAIT_L(0); PG8_MMA(0, 1, At, B1); PG8_BAR;
            PG8_LDA(At, 1, 1); PG8_STAGE(PG8_SA(1, 0), a3, voffA);
            PG8_BAR; PG8_WAIT_L(0); PG8_MMA(1, 0, At, B0); PG8_BAR; PG8_SCHED;
            PG8_STAGE(PG8_SB(1, 1), b3 + hstep, voffB);
            PG8_WAIT_V(6); PG8_BAR; PG8_MMA(1, 1, At, B1); PG8_BAR;
            }
        }
        if constexpr (ALIGN_EPI) { if (wr == 0) PG8_BAR; }
        if constexpr (!Epi::FUSED) run_epi8(E, acc, cur, wr, wc, fr, fq);
        if (!has_next) break;
#pragma unroll
        for (int a = 0; a < 2; ++a)
#pragma unroll
            for (int b = 0; b < 2; ++b)
#pragma unroll
                for (int m = 0; m < 4; ++m)
#pragma unroll
                    for (int n = 0; n < 2; ++n) acc[a][b][m][n] = (f32x4){0.f, 0.f, 0.f, 0.f};
        cur = nxt; cA = nA; cB = nB; ++ui;
        if constexpr (ALIGN_EPI) { if (wr == 1) PG8_BAR; }
    }
    PG8_WAIT_V(0);
    if constexpr (!ALIGN_EPI) { if (wr == 0) PG8_BAR; }
    PG8_BAR;
    if constexpr (Epi::FUSED) E.fused(acc, cur, wr, wc, fr, fq, lds, wid, lane);

#undef PG8_SA
#undef PG8_SB
#undef PG8_STAGE
#undef PG8_LDA
#undef PG8_LDB
#undef PG8_MMA
#undef PG8_WAIT_V
#undef PG8_WAIT_L
#undef PG8_BAR
#undef PG8_SCHED
}

template <class Epi, class Sched, bool ALIGN_EPI = false, bool SP2 = false>
__device__ __forceinline__ void gemm_phase_f8(PG8_LAS unsigned char* lds, const Gemm g, const Sched& S, const Epi& E) {
    const int tid = threadIdx.x, wid = __builtin_amdgcn_readfirstlane(tid >> 6), lane = tid & 63, wr = wid >> 2, wc = wid & 3, fr = lane & 15, fq = lane >> 4;
    const int RP = g.K, nt = RP / 128;
    unsigned voffA[2], voffB[2];
#pragma unroll
    for (int i = 0; i < 2; ++i) { const int b_ = tid * 16 + i * 8192, R = b_ >> 7, pp = (b_ >> 4) & 7, rr_ = R & 15, ff = ((rr_ >> 1) & 1) | (((rr_ >> 3) & 1) << 2);
        const int rho = R & 31, Rb = (R & ~31) + 8 * ((rho & 15) >> 2) + 4 * (rho >> 4) + (rho & 3);
        voffA[i] = (unsigned)(R * RP + ((pp ^ ff) * 16)); voffB[i] = (unsigned)(Rb * RP + ((pp ^ ff) * 16)); }
    const size_t kstep = (size_t)(BK * 2);
    const size_t hstep = (size_t)HALF * RP;
    const size_t tstep = 2 * hstep;
    const unsigned ldsw = (unsigned)wid * 1024u;
    const int ffr = ((fr >> 1) & 1) | (((fr >> 3) & 1) << 2);
    const int aoff = (wr * 64 + fr) * 128 + (((2 * fq) ^ ffr) * 16), boff = (wc * 32 + fr) * 128 + (((2 * fq) ^ ffr) * 16), hoff = (ffr & 1) ? -16 : 16;
#define PG8_SA(b, h) (((b) * 2 + (h)) * HTB)
#define PG8_SB(b, h) ((4 + (b) * 2 + (h)) * HTB)
#define PG8_STAGE(bufoff, gbase, voff) do { _Pragma("unroll") for (int _i = 0; _i < 2; ++_i) \
        __builtin_amdgcn_global_load_lds((const unsigned*)((const char*)(gbase) + (voff)[_i]), (PG8_LAS unsigned*)(lds + (bufoff) + ldsw + _i * 8192), 16, 0, 0); } while (0)
#define PG8_LDA(dst, b, h) do { _Pragma("unroll") for (int m = 0; m < 4; ++m) { dst[m].lo = *(const PG8_LAS v4i_t*)(lds + PG8_SA(b, h) + aoff + m * 2048); dst[m].hi = *(const PG8_LAS v4i_t*)(lds + PG8_SA(b, h) + aoff + m * 2048 + hoff); } } while (0)
#define PG8_LDB(dst, b, h) do { _Pragma("unroll") for (int n = 0; n < 2; ++n) { dst[n].lo = *(const PG8_LAS v4i_t*)(lds + PG8_SB(b, h) + boff + n * 2048); dst[n].hi = *(const PG8_LAS v4i_t*)(lds + PG8_SB(b, h) + boff + n * 2048 + hoff); } } while (0)
#define PG8_MMA(ai, bj, At, Bt) do { __builtin_amdgcn_s_setprio(1); _Pragma("unroll") for (int m = 0; m < 4; ++m) _Pragma("unroll") for (int n = 0; n < 2; ++n) \
        asm volatile("v_mfma_f32_16x16x128_f8f6f4 %0, %1, %2, %0" : "+v"(acc[ai][bj][m][n]) : "v"(Bt[n]), "v"(At[m])); __builtin_amdgcn_s_setprio(0); } while (0)
#define PG8_WAIT_V(n) asm volatile("s_waitcnt vmcnt(" #n ")" ::: "memory")
#define PG8_WAIT_L(n) asm volatile("s_waitcnt lgkmcnt(" #n ")" ::: "memory")
#define PG8_BAR __builtin_amdgcn_s_barrier()
#define PG8_SCHED __builtin_amdgcn_sched_barrier(0)
    Unit cur, nxt; int ui = 0;
    if (!S.next(0, cur)) return;
    f32x4 acc[2][2][4][2];
#pragma unroll
    for (int a = 0; a < 2; ++a)
#pragma unroll
        for (int b = 0; b < 2; ++b)
#pragma unroll
            for (int m = 0; m < 4; ++m)
#pragma unroll
                for (int n = 0; n < 2; ++n) acc[a][b][m][n] = (f32x4){0.f, 0.f, 0.f, 0.f};
    v8i_t At[4], B0[2], B1[2];
    const char* cA = (const char*)g.A + (size_t)cur.pm * tstep; const char* cB = (const char*)g.Bt + (size_t)cur.pnB * tstep;

    if constexpr (SP2) {
        PG8_STAGE(PG8_SB(0, 0), cB, voffB); PG8_STAGE(PG8_SB(0, 1), cB + hstep, voffB); PG8_STAGE(PG8_SA(0, 0), cA, voffA); PG8_STAGE(PG8_SA(0, 1), cA + hstep, voffA);
        if (wr == 1) PG8_BAR;
        PG8_WAIT_V(2); PG8_BAR;
        PG8_STAGE(PG8_SB(1, 0), cB + kstep, voffB); PG8_STAGE(PG8_SA(1, 0), cA + kstep, voffA); PG8_STAGE(PG8_SB(1, 1), cB + hstep + kstep, voffB);
        PG8_WAIT_V(6); PG8_BAR;
    } else {
        PG8_STAGE(PG8_SB(0, 0), cB, voffB); PG8_STAGE(PG8_SA(0, 0), cA, voffA); PG8_STAGE(PG8_SB(0, 1), cB + hstep, voffB); PG8_STAGE(PG8_SA(0, 1), cA + hstep, voffA);
        if (wr == 1) PG8_BAR;
        PG8_WAIT_V(4); PG8_BAR;
        PG8_STAGE(PG8_SB(1, 0), cB + kstep, voffB); PG8_STAGE(PG8_SA(1, 0), cA + kstep, voffA); PG8_STAGE(PG8_SB(1, 1), cB + hstep + kstep, voffB);
        PG8_WAIT_V(6); PG8_BAR;
    }
    for (;;) {
        const bool has_next = S.next(ui + 1, nxt);
        const char* nA = has_next ? (const char*)g.A + (size_t)nxt.pm * tstep : cA; const char* nB = has_next ? (const char*)g.Bt + (size_t)nxt.pnB * tstep : cB;
        for (int t = 0; t < nt; t += 2) {
            const bool last = (t == nt - 2);
            const char* a1 = cA + (size_t)(t + 1) * kstep;
            const char* a2 = last ? nA : cA + (size_t)(t + 2) * kstep; const char* b2 = last ? nB : cB + (size_t)(t + 2) * kstep;
            const char* a3 = a2 + kstep; const char* b3 = b2 + kstep;

            if constexpr (SP2) {
            PG8_LDB(B0, 0, 0); PG8_LDB(B1, 0, 1); PG8_SCHED; PG8_LDA(At, 0, 0); PG8_STAGE(PG8_SA(1, 1), a1 + hstep, voffA);
            PG8_WAIT_V(8); PG8_WAIT_L(0); PG8_BAR; PG8_MMA(0, 0, At, B0); PG8_MMA(0, 1, At, B1); PG8_BAR; PG8_SCHED;
            PG8_LDA(At, 0, 1); PG8_STAGE(PG8_SB(0, 0), b2, voffB); PG8_STAGE(PG8_SB(0, 1), b2 + hstep, voffB); PG8_STAGE(PG8_SA(0, 0), a2, voffA);
            PG8_WAIT_V(8); PG8_WAIT_L(0); PG8_BAR; PG8_MMA(1, 0, At, B0); PG8_MMA(1, 1, At, B1); PG8_BAR; PG8_SCHED;
            PG8_LDB(B0, 1, 0); PG8_LDB(B1, 1, 1); PG8_SCHED; PG8_LDA(At, 1, 0); PG8_STAGE(PG8_SA(0, 1), a2 + hstep, voffA);
            PG8_WAIT_V(8); PG8_WAIT_L(0); PG8_BAR; PG8_MMA(0, 0, At, B0); PG8_MMA(0, 1, At, B1); PG8_BAR; PG8_SCHED;
            PG8_LDA(At, 1, 1); PG8_STAGE(PG8_SB(1, 0), b3, voffB); PG8_STAGE(PG8_SB(1, 1), b3 + hstep, voffB); PG8_STAGE(PG8_SA(1, 0), a3, voffA);
            PG8_WAIT_V(8); PG8_WAIT_L(0); PG8_BAR; PG8_MMA(1, 0, At, B0); PG8_MMA(1, 1, At, B1); PG8_BAR; PG8_SCHED;
            } else {
            PG8_LDB(B0, 0, 0); PG8_SCHED; PG8_LDA(At, 0, 0); PG8_STAGE(PG8_SA(1, 1), a1 + hstep, voffA);
            PG8_WAIT_L(8); PG8_BAR; PG8_WAIT_L(0); PG8_MMA(0, 0, At, B0); PG8_BAR; PG8_SCHED;
            PG8_LDB(B1, 0, 1); PG8_STAGE(PG8_SB(0, 0), b2, voffB);
            PG8_BAR; PG8_WAIT_L(0); PG8_MMA(0, 1, At, B1); PG8_BAR;
            PG8_LDA(At, 0, 1); PG8_STAGE(PG8_SA(0, 0), a2, voffA);
            PG8_BAR; PG8_WAIT_L(0); PG8_MMA(1, 0, At, B0); PG8_BAR; PG8_SCHED;
            PG8_STAGE(PG8_SB(0, 1), b2 + hstep, voffB);
            PG8_WAIT_V(6); PG8_BAR; PG8_MMA(1, 1, At, B1); PG8_BAR;
            PG8_LDB(B0, 1, 0); PG8_SCHED; PG8_LDA(At, 1, 0); PG8_STAGE(PG8_SA(0, 1), a2 + hstep, voffA);
            PG8_WAIT_L(8); PG8_BAR; PG8_WAIT_L(0); PG8_MMA(0, 0, At, B0); PG8_BAR; PG8_SCHED;
            PG8_LDB(B1, 1, 1); PG8_STAGE(PG8_SB(1, 0), b3, voffB);
            PG8_BAR; PG8_WAIT_L(0); PG8_MMA(0, 1, At, B1); PG8_BAR;
            PG8_LDA(At, 1, 1); PG8_STAGE(PG8_SA(1, 0), a3, voffA);
            PG8_BAR; PG8_WAIT_L(0); PG8_MMA(1, 0, At, B0); PG8_BAR; PG8_SCHED;
            PG8_STAGE(PG8_SB(1, 1), b3 + hstep, voffB);
            PG8_WAIT_V(6); PG8_BAR; PG8_MMA(1, 1, At, B1); PG8_BAR;
            }
        }
        asm volatile("s_nop 15\n\ts_nop 15" ::: "memory");
        if constexpr (ALIGN_EPI) { if (wr == 0) PG8_BAR; }
        run_epi8(E, acc, cur, wr, wc, fr, fq);
        if (!has_next) break;
#pragma unroll
        for (int a = 0; a < 2; ++a)
#pragma unroll
            for (int b = 0; b < 2; ++b)
#pragma unroll
                for (int m = 0; m < 4; ++m)
#pragma unroll
                    for (int n = 0; n < 2; ++n) acc[a][b][m][n] = (f32x4){0.f, 0.f, 0.f, 0.f};
        cur = nxt; cA = nA; cB = nB; ++ui;
        if constexpr (ALIGN_EPI) { if (wr == 1) PG8_BAR; }
    }
    PG8_WAIT_V(0);
    if constexpr (!ALIGN_EPI) { if (wr == 0) PG8_BAR; }
    PG8_BAR;

#undef PG8_SA
#undef PG8_SB
#undef PG8_STAGE
#undef PG8_LDA
#undef PG8_LDB
#undef PG8_MMA
#undef PG8_WAIT_V
#undef PG8_WAIT_L
#undef PG8_BAR
#undef PG8_SCHED
}

template <class Epi, class Sched, bool ALIGN_EPI = false, bool SP2 = false>
__device__ __forceinline__ void gemm_phase_f8g(PG8_LAS unsigned char* lds, const Gemm g, const Sched& S, const Epi& E, const int* tok) {
    const int tid = threadIdx.x, wid = __builtin_amdgcn_readfirstlane(tid >> 6), lane = tid & 63, wr = wid >> 2, wc = wid & 3, fr = lane & 15, fq = lane >> 4;
    const int RP = g.K, nt = RP / 128;
    unsigned voffA[2], voffB[2]; int rowA[2];
#pragma unroll
    for (int i = 0; i < 2; ++i) { const int b_ = tid * 16 + i * 8192, R = b_ >> 7, pp = (b_ >> 4) & 7, rr_ = R & 15, ff = ((rr_ >> 1) & 1) | (((rr_ >> 3) & 1) << 2);
        const int rho = R & 31, Rb = (R & ~31) + 8 * ((rho & 15) >> 2) + 4 * (rho >> 4) + (rho & 3);
        voffA[i] = (unsigned)((pp ^ ff) * 16); rowA[i] = R; voffB[i] = (unsigned)(Rb * RP + ((pp ^ ff) * 16)); }
    const size_t kstep = (size_t)(BK * 2);
    const size_t hstep = (size_t)HALF * RP;
    const size_t tstep = 2 * hstep;
    const unsigned ldsw = (unsigned)wid * 1024u;
    const int ffr = ((fr >> 1) & 1) | (((fr >> 3) & 1) << 2);
    const int aoff = (wr * 64 + fr) * 128 + (((2 * fq) ^ ffr) * 16), boff = (wc * 32 + fr) * 128 + (((2 * fq) ^ ffr) * 16), hoff = (ffr & 1) ? -16 : 16;
#define PG8_SA(b, h) (((b) * 2 + (h)) * HTB)
#define PG8_SB(b, h) ((4 + (b) * 2 + (h)) * HTB)
#define PG8_STAGE(bufoff, gbase, voff) do { _Pragma("unroll") for (int _i = 0; _i < 2; ++_i) \
        __builtin_amdgcn_global_load_lds((const unsigned*)((const char*)(gbase) + (voff)[_i]), (PG8_LAS unsigned*)(lds + (bufoff) + ldsw + _i * 8192), 16, 0, 0); } while (0)
#define PG8_LDA(dst, b, h) do { _Pragma("unroll") for (int m = 0; m < 4; ++m) { dst[m].lo = *(const PG8_LAS v4i_t*)(lds + PG8_SA(b, h) + aoff + m * 2048); dst[m].hi = *(const PG8_LAS v4i_t*)(lds + PG8_SA(b, h) + aoff + m * 2048 + hoff); } } while (0)
#define PG8_LDB(dst, b, h) do { _Pragma("unroll") for (int n = 0; n < 2; ++n) { dst[n].lo = *(const PG8_LAS v4i_t*)(lds + PG8_SB(b, h) + boff + n * 2048); dst[n].hi = *(const PG8_LAS v4i_t*)(lds + PG8_SB(b, h) + boff + n * 2048 + hoff); } } while (0)
#define PG8_MMA(ai, bj, At, Bt) do { __builtin_amdgcn_s_setprio(1); _Pragma("unroll") for (int m = 0; m < 4; ++m) _Pragma("unroll") for (int n = 0; n < 2; ++n) \
        asm volatile("v_mfma_f32_16x16x128_f8f6f4 %0, %1, %2, %0" : "+v"(acc[ai][bj][m][n]) : "v"(Bt[n]), "v"(At[m])); __builtin_amdgcn_s_setprio(0); } while (0)
#define PG8_WAIT_V(n) asm volatile("s_waitcnt vmcnt(" #n ")" ::: "memory")
#define PG8_WAIT_L(n) asm volatile("s_waitcnt lgkmcnt(" #n ")" ::: "memory")
#define PG8_BAR __builtin_amdgcn_s_barrier()
#define PG8_SCHED __builtin_amdgcn_sched_barrier(0)
    Unit cur, nxt; int ui = 0;
    if (!S.next(0, cur)) return;
    f32x4 acc[2][2][4][2];
#pragma unroll
    for (int a = 0; a < 2; ++a)
#pragma unroll
        for (int b = 0; b < 2; ++b)
#pragma unroll
            for (int m = 0; m < 4; ++m)
#pragma unroll
                for (int n = 0; n < 2; ++n) acc[a][b][m][n] = (f32x4){0.f, 0.f, 0.f, 0.f};
    v8i_t At[4], B0[2], B1[2];
    const char* cA = (const char*)g.A; const char* cB = (const char*)g.Bt + (size_t)cur.pnB * tstep;
    unsigned vC[2][2], vN[2][2] = {{0u, 0u}, {0u, 0u}};
#define PG8_TOKOFF(dst, pm_) do { _Pragma("unroll") for (int h_ = 0; h_ < 2; ++h_) _Pragma("unroll") for (int i_ = 0; i_ < 2; ++i_) dst[h_][i_] = (unsigned)tok[(pm_) * 256 + h_ * 128 + rowA[i_]] * (unsigned)RP + voffA[i_]; } while (0)
    PG8_TOKOFF(vC, cur.pm);

    if constexpr (SP2) {
        PG8_STAGE(PG8_SB(0, 0), cB, voffB); PG8_STAGE(PG8_SB(0, 1), cB + hstep, voffB); PG8_STAGE(PG8_SA(0, 0), cA, vC[0]); PG8_STAGE(PG8_SA(0, 1), cA, vC[1]);
        if (wr == 1) PG8_BAR;
        PG8_WAIT_V(2); PG8_BAR;
        PG8_STAGE(PG8_SB(1, 0), cB + kstep, voffB); PG8_STAGE(PG8_SA(1, 0), cA + kstep, vC[0]); PG8_STAGE(PG8_SB(1, 1), cB + hstep + kstep, voffB);
        PG8_WAIT_V(6); PG8_BAR;
    } else {
        PG8_STAGE(PG8_SB(0, 0), cB, voffB); PG8_STAGE(PG8_SA(0, 0), cA, vC[0]); PG8_STAGE(PG8_SB(0, 1), cB + hstep, voffB); PG8_STAGE(PG8_SA(0, 1), cA, vC[1]);
        if (wr == 1) PG8_BAR;
        PG8_WAIT_V(4); PG8_BAR;
        PG8_STAGE(PG8_SB(1, 0), cB + kstep, voffB); PG8_STAGE(PG8_SA(1, 0), cA + kstep, vC[0]); PG8_STAGE(PG8_SB(1, 1), cB + hstep + kstep, voffB);
        PG8_WAIT_V(6); PG8_BAR;
    }
    for (;;) {
        const bool has_next = S.next(ui + 1, nxt);
        const char* nB = has_next ? (const char*)g.Bt + (size_t)nxt.pnB * tstep : cB;
        int tkN[2][2] = {{0, 0}, {0, 0}};
        if (has_next) { _Pragma("unroll") for (int h_ = 0; h_ < 2; ++h_) _Pragma("unroll") for (int i_ = 0; i_ < 2; ++i_) tkN[h_][i_] = tok[nxt.pm * 256 + h_ * 128 + rowA[i_]]; }
        for (int t = 0; t < nt; t += 2) {
            const bool last = (t == nt - 2);
            const char* a1 = cA + (size_t)(t + 1) * kstep;
            const char* a2 = last ? cA : cA + (size_t)(t + 2) * kstep; const char* b2 = last ? nB : cB + (size_t)(t + 2) * kstep;
            unsigned vs0[2] = {vC[0][0], vC[0][1]}, vs1[2] = {vC[1][0], vC[1][1]};
            if (last && has_next) { asm volatile("" : "+v"(tkN[0][0]), "+v"(tkN[0][1]), "+v"(tkN[1][0]), "+v"(tkN[1][1]));
                _Pragma("unroll") for (int h_ = 0; h_ < 2; ++h_) _Pragma("unroll") for (int i_ = 0; i_ < 2; ++i_) vN[h_][i_] = (unsigned)tkN[h_][i_] * (unsigned)RP + voffA[i_];
                vs0[0] = vN[0][0]; vs0[1] = vN[0][1]; vs1[0] = vN[1][0]; vs1[1] = vN[1][1]; }
            const char* a3 = a2 + kstep; const char* b3 = b2 + kstep;

            if constexpr (SP2) {
            PG8_LDB(B0, 0, 0); PG8_LDB(B1, 0, 1); PG8_SCHED; PG8_LDA(At, 0, 0); PG8_STAGE(PG8_SA(1, 1), a1, vC[1]);
            PG8_WAIT_V(8); PG8_WAIT_L(0); PG8_BAR; PG8_MMA(0, 0, At, B0); PG8_MMA(0, 1, At, B1); PG8_BAR; PG8_SCHED;
            PG8_LDA(At, 0, 1); PG8_STAGE(PG8_SB(0, 0), b2, voffB); PG8_STAGE(PG8_SB(0, 1), b2 + hstep, voffB); PG8_STAGE(PG8_SA(0, 0), a2, vs0);
            PG8_WAIT_V(8); PG8_WAIT_L(0); PG8_BAR; PG8_MMA(1, 0, At, B0); PG8_MMA(1, 1, At, B1); PG8_BAR; PG8_SCHED;
            PG8_LDB(B0, 1, 0); PG8_LDB(B1, 1, 1); PG8_SCHED; PG8_LDA(At, 1, 0); PG8_STAGE(PG8_SA(0, 1), a2, vs1);
            PG8_WAIT_V(8); PG8_WAIT_L(0); PG8_BAR; PG8_MMA(0, 0, At, B0); PG8_MMA(0, 1, At, B1); PG8_BAR; PG8_SCHED;
            PG8_LDA(At, 1, 1); PG8_STAGE(PG8_SB(1, 0), b3, voffB); PG8_STAGE(PG8_SB(1, 1), b3 + hstep, voffB); PG8_STAGE(PG8_SA(1, 0), a3, vs0);
            PG8_WAIT_V(8); PG8_WAIT_L(0); PG8_BAR; PG8_MMA(1, 0, At, B0); PG8_MMA(1, 1, At, B1); PG8_BAR; PG8_SCHED;
            } else {
            PG8_LDB(B0, 0, 0); PG8_SCHED; PG8_LDA(At, 0, 0); PG8_STAGE(PG8_SA(1, 1), a1, vC[1]);
            PG8_WAIT_L(8); PG8_BAR; PG8_WAIT_L(0); PG8_MMA(0, 0, At, B0); PG8_BAR; PG8_SCHED;
            PG8_LDB(B1, 0, 1); PG8_STAGE(PG8_SB(0, 0), b2, voffB);
            PG8_BAR; PG8_WAIT_L(0); PG8_MMA(0, 1, At, B1); PG8_BAR;
            PG8_LDA(At, 0, 1); PG8_STAGE(PG8_SA(0, 0), a2, vs0);
            PG8_BAR; PG8_WAIT_L(0); PG8_MMA(1, 0, At, B0); PG8_BAR; PG8_SCHED;
            PG8_STAGE(PG8_SB(0, 1), b2 + hstep, voffB);
            PG8_WAIT_V(6); PG8_BAR; PG8_MMA(1, 1, At, B1); PG8_BAR;
            PG8_LDB(B0, 1, 0); PG8_SCHED; PG8_LDA(At, 1, 0); PG8_STAGE(PG8_SA(0, 1), a2, vs1);
            PG8_WAIT_L(8); PG8_BAR; PG8_WAIT_L(0); PG8_MMA(0, 0, At, B0); PG8_BAR; PG8_SCHED;
            PG8_LDB(B1, 1, 1); PG8_STAGE(PG8_SB(1, 0), b3, voffB);
            PG8_BAR; PG8_WAIT_L(0); PG8_MMA(0, 1, At, B1); PG8_BAR;
            PG8_LDA(At, 1, 1); PG8_STAGE(PG8_SA(1, 0), a3, vs0);
            PG8_BAR; PG8_WAIT_L(0); PG8_MMA(1, 0, At, B0); PG8_BAR; PG8_SCHED;
            PG8_STAGE(PG8_SB(1, 1), b3 + hstep, voffB);
            PG8_WAIT_V(6); PG8_BAR; PG8_MMA(1, 1, At, B1); PG8_BAR;
            }
        }
        asm volatile("s_nop 15\n\ts_nop 15" ::: "memory");
        if constexpr (ALIGN_EPI) { if (wr == 0) PG8_BAR; }
        run_epi8(E, acc, cur, wr, wc, fr, fq);
        if (!has_next) break;
#pragma unroll
        for (int a = 0; a < 2; ++a)
#pragma unroll
            for (int b = 0; b < 2; ++b)
#pragma unroll
                for (int m = 0; m < 4; ++m)
#pragma unroll
                    for (int n = 0; n < 2; ++n) acc[a][b][m][n] = (f32x4){0.f, 0.f, 0.f, 0.f};
        cur = nxt; cB = nB; ++ui; vC[0][0] = vN[0][0]; vC[0][1] = vN[0][1]; vC[1][0] = vN[1][0]; vC[1][1] = vN[1][1];
        if constexpr (ALIGN_EPI) { if (wr == 1) PG8_BAR; }
    }
    PG8_WAIT_V(0);
    if constexpr (!ALIGN_EPI) { if (wr == 0) PG8_BAR; }
    PG8_BAR;

#undef PG8_TOKOFF
#undef PG8_SA
#undef PG8_SB
#undef PG8_STAGE
#undef PG8_LDA
#undef PG8_LDB
#undef PG8_MMA
#undef PG8_WAIT_V
#undef PG8_WAIT_L
#undef PG8_BAR
#undef PG8_SCHED
}
}

constexpr int D = 1024, BATCH = 8, SEQ = 2048, CTXL = 256;
constexpr int M = BATCH * SEQ;
constexpr int MC = BATCH * CTXL;
constexpr int MT = M + MC;
constexpr int DIN = 2048, DSGU = 512, DLRU = 512, NE = 16, CAP = 256, DE = 2048, NMOD = 6 * D;
constexpr int NSEG = 36;
constexpr float EPS = 1e-6f;
constexpr int NWAVES = 8, NTHREADS = 512;
constexpr int LDS_BYTES = 147456;
constexpr int NPH = 11;

constexpr size_t MiB = 1u << 20;
constexpr size_t WS_CTL = 0;
constexpr size_t WS_MOD = 1 * MiB;
constexpr size_t WS_SUM = 1 * MiB + 512 * 1024;
constexpr size_t WS_AFF = 4 * MiB;
constexpr size_t WS_SLOT = 5 * MiB;
constexpr size_t WS_GATE = 6 * MiB;
constexpr size_t WS_TOK = 6 * MiB + 128 * 1024;
constexpr size_t WS_GWT = 6 * MiB + 512 * 1024;
constexpr size_t WS_SWB = 7 * MiB;
constexpr size_t WS_WIN = 8 * MiB;
constexpr size_t WS_WOUT = 12 * MiB;
constexpr size_t WS_WG = 14 * MiB;
constexpr size_t WS_W2 = 142 * MiB;
constexpr size_t WS_X1 = 206 * MiB;
constexpr size_t WS_HS = 206 * MiB, WS_PF = 222 * MiB, WS_PB = 238 * MiB;
constexpr size_t WS_HX2 = 270 * MiB;
constexpr size_t WS_XCH = 286 * MiB;
constexpr size_t WS_CB = 1 * MiB + 256 * 1024;
constexpr size_t WS_XE = 302 * MiB;
constexpr size_t WS_A2 = 302 * MiB, WS_YE = 302 * MiB;
constexpr size_t WS_HID = 366 * MiB;
constexpr size_t WS_HX = 366 * MiB;
constexpr size_t WS_UV = 402 * MiB;
constexpr size_t WS_XC = 466 * MiB;
constexpr size_t WS_END = 494 * MiB;

#define GAS __attribute__((address_space(1)))
#define LAS __attribute__((address_space(3)))
typedef unsigned short bf16;
typedef unsigned v4u __attribute__((ext_vector_type(4)));
typedef unsigned v2u __attribute__((ext_vector_type(2)));
typedef float f32x4 __attribute__((ext_vector_type(4)));
typedef short bf16x8 __attribute__((ext_vector_type(8)));
#define LDS_WAIT() asm volatile("s_waitcnt lgkmcnt(0)" ::: "memory")

__device__ __forceinline__ float bf2f(bf16 b) { return __uint_as_float(((unsigned)b) << 16); }
__device__ __forceinline__ unsigned f2bf(float f) { unsigned u = __float_as_uint(f); return (u + 0x7fffu + ((u >> 16) & 1u)) >> 16; }
typedef __bf16 bf16x2_hw __attribute__((ext_vector_type(2)));
typedef float f32x2_hw __attribute__((ext_vector_type(2)));
__device__ __forceinline__ unsigned pk2(float lo, float hi) { const f32x2_hw v = {lo, hi}; return __builtin_bit_cast(unsigned, __builtin_convertvector(v, bf16x2_hw)); }
__device__ __forceinline__ float bflo(unsigned w) { return __uint_as_float(w << 16); }
__device__ __forceinline__ float bfhi(unsigned w) { return __uint_as_float(w & 0xffff0000u); }
__device__ __forceinline__ float rcpf_(float x) { return __builtin_amdgcn_rcpf(x); }
__device__ __forceinline__ float exp2f_(float x) { return __builtin_amdgcn_exp2f(x); }
__device__ __forceinline__ float sigmoidf_(float x) { return rcpf_(1.f + exp2f_(-1.4426950408889634f * x)); }
__device__ __forceinline__ float siluf_(float x) { return x * rcpf_(1.f + exp2f_(-1.4426950408889634f * x)); }
__device__ __forceinline__ float geluf_(float x) { const float u = x * (0.7978845608028654f + 0.035677408136300125f * x * x); return x * rcpf_(1.f + exp2f_(-2.8853900817779268f * u)); }
__device__ __forceinline__ void decay_pair(float la, float& a, float& s) {
    const float x = 2.f * la;
    const float p1 = la * (1.f + la * (0.5f + la * (0.16666667f + la * (0.041666668f + la * 0.0083333333f))));
    const float p2 = x * (1.f + x * (0.5f + x * (0.16666667f + x * (0.041666668f + x * (0.0083333333f + x * 0.0013888889f)))));
    const float e1 = exp2f_(1.4426950408889634f * la);
    const bool small = la > -0.15f;
    a = small ? 1.f + p1 : e1;
    s = __builtin_amdgcn_sqrtf(small ? -p2 : 1.f - e1 * e1);
}
typedef float f32x2p __attribute__((ext_vector_type(2)));
__device__ __forceinline__ f32x2p sigmoid2_(f32x2p x) { const f32x2p t = x * -1.4426950408889634f; f32x2p e; e.x = exp2f_(t.x); e.y = exp2f_(t.y); e = e + 1.f; f32x2p r; r.x = rcpf_(e.x); r.y = rcpf_(e.y); return r; }
__device__ __forceinline__ f32x2p gelu2_(f32x2p x) { const f32x2p u = x * (x * x * 0.035677408136300125f + 0.7978845608028654f), t = u * -2.8853900817779268f; f32x2p e; e.x = exp2f_(t.x); e.y = exp2f_(t.y); e = e + 1.f;
    f32x2p r; r.x = rcpf_(e.x); r.y = rcpf_(e.y); return x * r; }
__device__ __forceinline__ void decay_pair2(f32x2p la, f32x2p& a, f32x2p& s) {
    const f32x2p x = la * 2.f;
    const f32x2p p1 = la * (la * (la * (la * (la * 0.0083333333f + 0.041666668f) + 0.16666667f) + 0.5f) + 1.f);
    const f32x2p p2 = x * (x * (x * (x * (x * (x * 0.0013888889f + 0.0083333333f) + 0.041666668f) + 0.16666667f) + 0.5f) + 1.f);
    const f32x2p tt = la * 1.4426950408889634f; f32x2p e1; e1.x = exp2f_(tt.x); e1.y = exp2f_(tt.y);
    const f32x2p big = 1.f - e1 * e1, one = p1 + 1.f;
    a.x = la.x > -0.15f ? one.x : e1.x; a.y = la.y > -0.15f ? one.y : e1.y;
    s.x = __builtin_amdgcn_sqrtf(la.x > -0.15f ? -p2.x : big.x); s.y = __builtin_amdgcn_sqrtf(la.y > -0.15f ? -p2.y : big.y);
}
__device__ __forceinline__ unsigned pk4_fp8(float a, float b, float c, float d) {
    unsigned w = 0u; w = __builtin_amdgcn_cvt_pk_fp8_f32(a, b, w, false); w = __builtin_amdgcn_cvt_pk_fp8_f32(c, d, w, true); return w; }
constexpr float WSCALE = 32.f, WSCALE_INV = 1.f / 32.f;
__device__ __forceinline__ float wave_sum(float v) {
#pragma unroll
    for (int o = 1; o < 64; o <<= 1) v += __shfl_xor(v, o);
    return v;
}


#define XB_TMO      128
#define XB_XCNT(j)  (256  + 64 * (j))
#define XB_XSUB(j)  (1280 + 64 * (j))
#define XB_XGEN(j)  (2304 + 64 * (j))
#define XB_TOP      3328
#define XB_TOPGEN   3392
#define XCD_BAR_WORDS 3456
#define XB_SPIN_CAP (1u << 18)
__device__ __forceinline__ unsigned xb_ld(unsigned* p)              { return __hip_atomic_load(p, __ATOMIC_RELAXED, __HIP_MEMORY_SCOPE_AGENT); }
__device__ __forceinline__ unsigned xb_add(unsigned* p, unsigned v) { return __hip_atomic_fetch_add(p, v, __ATOMIC_RELAXED, __HIP_MEMORY_SCOPE_AGENT); }
__device__ __forceinline__ unsigned xb_xcc_id() { return (unsigned)__builtin_amdgcn_s_getreg((3 << 11) | 20) & 0xFu; }
#define XB_SPIN(cond, bar) do { unsigned _sp = 0; while (cond) { __builtin_amdgcn_s_sleep(1); \
    if ((++_sp & 255u) == 0u) { if (xb_ld(&(bar)[XB_TMO])) break; if (_sp > XB_SPIN_CAP) { atomicAdd(&(bar)[XB_TMO], 1u); break; } } } } while (0)
struct XcdBarrier { unsigned* bar; unsigned x; volatile LAS unsigned* st; unsigned total; };
__device__ __forceinline__ XcdBarrier xcd_barrier_post(unsigned* bar, volatile LAS unsigned* st, unsigned total) {
    XcdBarrier b; b.bar = bar; b.x = xb_xcc_id(); b.st = st; b.total = total;
    if (threadIdx.x == 0) (void)xb_add(&bar[XB_XCNT(b.x)], 1u);
    return b;
}
__device__ __forceinline__ void xcd_barrier_complete(unsigned* bar, unsigned x, unsigned G, unsigned& nloc, unsigned& nx) {
    unsigned sum, cnt, mine, sp = 0u;
    for (;;) {
        sum = 0u; cnt = 0u; mine = 0u;
#pragma unroll
        for (unsigned j = 0; j < 16; ++j) { const unsigned c = xb_ld(&bar[XB_XCNT(j)]); sum += c; cnt += (c > 0u) ? 1u : 0u; mine = (j == x) ? c : mine; }
        if (sum == G) break;
        __builtin_amdgcn_s_sleep(1);
        if ((++sp & 255u) == 0u) { if (xb_ld(&bar[XB_TMO])) break; if (sp > XB_SPIN_CAP) { atomicAdd(&bar[XB_TMO], 1u); break; } }
    }
    nloc = mine > 0u ? mine : 1u; nx = cnt > 0u ? cnt : 1u;
}
__device__ __forceinline__ void xcd_barrier(const XcdBarrier& b) {
    asm volatile("s_waitcnt vmcnt(0)" ::: "memory");
    __syncthreads();
    if (threadIdx.x == 0) {
        unsigned* bar = b.bar;
        __builtin_amdgcn_s_waitcnt(0);
        unsigned nloc = b.st[0], nx = b.st[1];
        if (nloc == 0u) { xcd_barrier_complete(bar, b.x, b.total, nloc, nx); b.st[0] = nloc; b.st[1] = nx; }
        const unsigned old = xb_add(&bar[XB_XSUB(b.x)], 1u);
        const unsigned gen = old / nloc;
        if (old + 1u == (gen + 1u) * nloc) {
            __builtin_amdgcn_fence(__ATOMIC_RELEASE, "agent");
            asm volatile("s_waitcnt vmcnt(0)" ::: "memory");
            const unsigned og = xb_add(&bar[XB_TOP], 1u);
            const unsigned tg = og / nx;
            if (og + 1u == (tg + 1u) * nx) xb_add(&bar[XB_TOPGEN], 1u);
            else XB_SPIN(xb_ld(&bar[XB_TOPGEN]) == tg, bar);
            __builtin_amdgcn_fence(__ATOMIC_ACQUIRE, "agent");
            xb_add(&bar[XB_XGEN(b.x)], 1u);
            asm volatile("s_waitcnt vmcnt(0)" ::: "memory");
        } else {
            XB_SPIN(xb_ld(&bar[XB_XGEN(b.x)]) == gen, bar);
            __builtin_amdgcn_fence(__ATOMIC_ACQUIRE, "agent");
            asm volatile("s_waitcnt vmcnt(0)" ::: "memory");
        }
    }
    __syncthreads();
}

struct P {
    const float *x, *c, *ctx, *c_ctx, *w_mod, *b_mod, *norm1_g, *norm2_g, *w_in, *sgu_g, *sgu_w, *sgu_b, *conv_w, *conv_b,
                *rg_wa, *rg_ba, *rg_wi, *rg_bi, *rg_lam, *w_out, *w_router, *w1, *w3, *w2, *final_g;
    float* out; unsigned char* ws; int ph_lo, ph_hi;
};

struct SchedG1 { int G, c;
    __device__ __forceinline__ bool next(int i, pg8::Unit& u) const { const int L = i * G + c; if (L >= 528) return false;
        if (L < 512) { u.pm = L >> 3; u.pn = L & 7; } else { const int r = L - 512; u.pm = 64 + (r >> 1); u.pn = 4 + (r & 1); } u.pnB = u.pn; return true; } };
struct SchedG2 { int G, c;
    __device__ __forceinline__ bool next(int i, pg8::Unit& u) const { const int L = i * G + c; if (L >= 256) return false; u.pm = L >> 2; u.pn = L & 3; u.pnB = u.pn; return true; } };
struct SchedG3 { int G, c;
    __device__ __forceinline__ bool next(int i, pg8::Unit& u) const { const int L = i * G + c; if (L >= 2048) return false; const int e = L >> 7, loc = L & 127;
        u.pm = e * 8 + (loc & 7); u.pn = loc >> 3; u.pnB = e * 16 + u.pn; return true; } };
struct SchedG4 { int G, c;
    __device__ __forceinline__ bool next(int i, pg8::Unit& u) const { const int L = i * G + c; if (L >= 512) return false; const int e = L >> 5, loc = L & 31;
        u.pm = e * 8 + (loc & 7); u.pn = loc >> 3; u.pnB = e * 4 + u.pn; return true; } };

struct EpiG1 { static constexpr bool PAIRED = false, FUSED = false; bf16* UV; bf16* XC;
    __device__ __forceinline__ void st8(const pg8::Unit& u, int row, int col, f32x4 v0, f32x4 v1) const {
        const int grow = u.pm * 256 + row, gcol = u.pn * 256 + col;
        if (u.pm < 64) {
            if (gcol < 1024 || gcol >= 1536) { const f32x2p a = gelu2_((f32x2p){v0[0], v0[1]}), b = gelu2_((f32x2p){v0[2], v0[3]}), c = gelu2_((f32x2p){v1[0], v1[1]}), d = gelu2_((f32x2p){v1[2], v1[3]});
                v0 = (f32x4){a.x, a.y, b.x, b.y}; v1 = (f32x4){c.x, c.y, d.x, d.y}; }
            *(v4u*)(UV + (size_t)grow * DIN + gcol) = (v4u){pk2(v0[0], v0[1]), pk2(v0[2], v0[3]), pk2(v1[0], v1[1]), pk2(v1[2], v1[3])};
        } else *(v4u*)(XC + (size_t)(grow - M) * DLRU + (gcol - 1024)) = (v4u){pk2(v0[0], v0[1]), pk2(v0[2], v0[3]), pk2(v1[0], v1[1]), pk2(v1[2], v1[3])};
    } };
struct EpiG2 { static constexpr bool PAIRED = false, FUSED = false; const float* x; const float* MOD; float* X1;
    __device__ __forceinline__ void st8(const pg8::Unit& u, int row, int col, f32x4 v0, f32x4 v1) const {
        const int grow = u.pm * 256 + row, gcol = u.pn * 256 + col, b = grow >> 11;
        const f32x4* xp = (const f32x4*)(x + (size_t)grow * D + gcol); const f32x4* gp = (const f32x4*)(MOD + b * NMOD + 2 * D + gcol); f32x4* op = (f32x4*)(X1 + (size_t)grow * D + gcol);
        op[0] = xp[0] + gp[0] * v0; op[1] = xp[1] + gp[1] * v1;
    } };
#if MOE_FP8
typedef float f32x2v __attribute__((ext_vector_type(2)));
__device__ __forceinline__ f32x2v swiglu_scaled2(f32x2v g, f32x2v u) {
    constexpr float K1 = -1.4426950408889634f * WSCALE_INV, S2 = WSCALE * WSCALE;
    const f32x2v t = g * K1; f32x2v e; e.x = exp2f_(t.x); e.y = exp2f_(t.y);
    const f32x2v d = e * S2 + S2; f32x2v r; r.x = rcpf_(d.x); r.y = rcpf_(d.y);
    return (g * u) * r;
}
struct EpiG3 { static constexpr bool PAIRED = true; unsigned char* HID;
    __device__ __forceinline__ void st2x8(const pg8::Unit& u, int row, int col, f32x4 g0, f32x4 g1, f32x4 u0, f32x4 u1) const {
        const int grow = u.pm * 256 + row, hc = u.pn * 128 + col;
        const f32x2v a = swiglu_scaled2((f32x2v){g0[0], g0[1]}, (f32x2v){u0[0], u0[1]}), b = swiglu_scaled2((f32x2v){g0[2], g0[3]}, (f32x2v){u0[2], u0[3]});
        const f32x2v c = swiglu_scaled2((f32x2v){g1[0], g1[1]}, (f32x2v){u1[0], u1[1]}), d = swiglu_scaled2((f32x2v){g1[2], g1[3]}, (f32x2v){u1[2], u1[3]});
        v2u w; w.x = pk4_fp8(a.x, a.y, b.x, b.y); w.y = pk4_fp8(c.x, c.y, d.x, d.y);
        *(v2u*)(HID + (size_t)grow * DE + hc) = w;
    } };
struct EpiG4 { static constexpr bool PAIRED = false; const float* GATE; unsigned char* YE;
    __device__ __forceinline__ void st8(const pg8::Unit& u, int row, int col, f32x4 v0, f32x4 v1) const {
        const int grow = u.pm * 256 + row, gcol = u.pn * 256 + col; const float gt = GATE[grow];
        v2u w; w.x = pk4_fp8(v0[0] * gt, v0[1] * gt, v0[2] * gt, v0[3] * gt); w.y = pk4_fp8(v1[0] * gt, v1[1] * gt, v1[2] * gt, v1[3] * gt);
        *(v2u*)(YE + (size_t)grow * D + gcol) = w;
    } };
#else
struct EpiG3 { static constexpr bool PAIRED = true; bf16* HID;
    __device__ __forceinline__ void st2(const pg8::Unit& u, int row, int col, f32x4 g, f32x4 up) const {
        const int grow = u.pm * 256 + row, hc = u.pn * 128 + col;
        v2u w; w.x = pk2(siluf_(g[0]) * up[0], siluf_(g[1]) * up[1]); w.y = pk2(siluf_(g[2]) * up[2], siluf_(g[3]) * up[3]);
        *(v2u*)(HID + (size_t)grow * DE + hc) = w;
    } };
struct EpiG4 { static constexpr bool PAIRED = false; const float* GATE; bf16* YE;
    __device__ __forceinline__ void st(const pg8::Unit& u, int row, int col, f32x4 v) const {
        const int grow = u.pm * 256 + row, gcol = u.pn * 256 + col; const float gt = GATE[grow];
        v2u w; w.x = pk2(v[0] * gt, v[1] * gt); w.y = pk2(v[2] * gt, v[3] * gt); *(v2u*)(YE + (size_t)grow * D + gcol) = w;
    } };

#endif


struct EpiG2F { static constexpr bool PAIRED = false, FUSED = true;
    const float* x; const float* MOD; float* X1; const float* w_router; const float* norm2_g; const float* CB; float* XCH; unsigned* cnt; unsigned* tmo; unsigned char* HX8; float* AFF;
    __device__ __forceinline__ void fused(f32x4 (&acc)[2][2][4][2], const pg8::Unit& u, int wr, int wc, int fr, int fq, LAS unsigned char* lds, int wid, int lane) const {
        const int tid = wid * 64 + lane, b = u.pm >> 3, grow0 = u.pm * 256, gcol0 = u.pn * 256;
        LAS float* LQ = (LAS float*)lds;
        LAS float* RINV = (LAS float*)(lds + 81920);
        const float* MODb = MOD + b * NMOD;
        float gsc[2][8], shv[2][8], wrv[2][8];
#pragma unroll
        for (int bj = 0; bj < 2; ++bj)
#pragma unroll
            for (int j = 0; j < 8; ++j) { const int c = gcol0 + bj * 128 + wc * 32 + 8 * fq + j; gsc[bj][j] = norm2_g[c] * (1.f + MODb[4 * D + c]); shv[bj][j] = MODb[3 * D + c]; wrv[bj][j] = w_router[c * NE + fr]; }
#pragma unroll
        for (int ai = 0; ai < 2; ++ai)
#pragma unroll
            for (int m = 0; m < 4; ++m) { const int row = ai * 128 + wr * 64 + m * 16 + fr;
#pragma unroll
                for (int bj = 0; bj < 2; ++bj) { const int col = gcol0 + bj * 128 + wc * 32 + 8 * fq; const size_t o = (size_t)(grow0 + row) * D + col;
                    const f32x4 x0 = *(const f32x4*)(x + o), x1v = *(const f32x4*)(x + o + 4), g0 = *(const f32x4*)(MODb + 2 * D + col), g1 = *(const f32x4*)(MODb + 2 * D + col + 4);
                    acc[ai][bj][m][0] = x0 + g0 * acc[ai][bj][m][0]; acc[ai][bj][m][1] = x1v + g1 * acc[ai][bj][m][1];
                    { v4u w; w.x = pk2(acc[ai][bj][m][0].x, acc[ai][bj][m][0].y); w.y = pk2(acc[ai][bj][m][0].z, acc[ai][bj][m][0].w); w.z = pk2(acc[ai][bj][m][1].x, acc[ai][bj][m][1].y); w.w = pk2(acc[ai][bj][m][1].z, acc[ai][bj][m][1].w);
                      *(v4u*)((bf16*)X1 + o) = w; } } }
        float tw[2][2][4];
#pragma unroll
        for (int bj = 0; bj < 2; ++bj)
#pragma unroll
            for (int n = 0; n < 2; ++n)
#pragma unroll
                for (int r = 0; r < 4; ++r) tw[bj][n][r] = wrv[bj][4 * n + r] * gsc[bj][4 * n + r];
#pragma unroll
        for (int ai = 0; ai < 2; ++ai)
#pragma unroll
            for (int m = 0; m < 4; ++m) { const int row = ai * 128 + wr * 64 + m * 16 + fr;
                f32x4 q = (f32x4){0.f, 0.f, 0.f, 0.f}; float s2 = 0.f;
#pragma unroll
                for (int bj = 0; bj < 2; ++bj)
#pragma unroll
                    for (int n = 0; n < 2; ++n)
#pragma unroll
                        for (int r = 0; r < 4; ++r) { const float v = acc[ai][bj][m][n][r]; q = __builtin_amdgcn_mfma_f32_16x16x4f32(tw[bj][n][r], v, q, 0, 0, 0); s2 += v * v; }
                s2 += __shfl_xor(s2, 16); s2 += __shfl_xor(s2, 32);
                LAS float* o = LQ + (row * 4 + wc) * 20;
                o[4 * fq + 0] = q[0]; o[4 * fq + 1] = q[1]; o[4 * fq + 2] = q[2]; o[4 * fq + 3] = q[3]; if (fq == 0) o[16] = s2; }
        __syncthreads();
        float* xo = XCH + (size_t)((u.pm * 4 + u.pn) * 256) * 20;
        for (int i = tid; i < 256 * 9; i += NTHREADS) { const int row = i / 9, q2 = 2 * (i - row * 9); const LAS float* s = LQ + row * 80 + q2;
            const float v0 = (s[0] + s[20]) + (s[40] + s[60]), v1 = q2 < 16 ? (s[1] + s[21]) + (s[41] + s[61]) : 0.f;
            __hip_atomic_store((unsigned long long*)(xo + row * 20 + q2), ((unsigned long long)__float_as_uint(v1) << 32) | __float_as_uint(v0), __ATOMIC_RELAXED, __HIP_MEMORY_SCOPE_AGENT); }
        asm volatile("s_waitcnt vmcnt(0)" ::: "memory");
        __syncthreads();
        if (tid == 0) {
            __hip_atomic_fetch_add(cnt + 16 * u.pm, 1u, __ATOMIC_RELAXED, __HIP_MEMORY_SCOPE_AGENT);
            XB_SPIN(xb_ld(cnt + 16 * u.pm) < 4u, tmo);
        }
        __syncthreads();
        const float* xp = XCH + (size_t)(u.pm * 4 * 256) * 20;
#define XLD(ptr) __hip_atomic_load((ptr), __ATOMIC_RELAXED, __HIP_MEMORY_SCOPE_AGENT)
        if (tid < 256) { const int row = tid; const float S2 = (XLD(xp + row * 20 + 16) + XLD(xp + 5120 + row * 20 + 16)) + (XLD(xp + 10240 + row * 20 + 16) + XLD(xp + 15360 + row * 20 + 16)); RINV[row] = rsqrtf(S2 * (1.f / D) + EPS); }
        else if (tid < 320) { const int row = 64 * u.pn + (tid - 256); const float* r0 = xp + row * 20;
            const float S2 = (XLD(r0 + 16) + XLD(r0 + 5120 + 16)) + (XLD(r0 + 10240 + 16) + XLD(r0 + 15360 + 16)), rinv = rsqrtf(S2 * (1.f / D) + EPS);
            float lg[16]; float mx = -3.0e38f;
#pragma unroll
            for (int e = 0; e < 16; ++e) { lg[e] = rinv * ((XLD(r0 + e) + XLD(r0 + 5120 + e)) + (XLD(r0 + 10240 + e) + XLD(r0 + 15360 + e))) + CB[b * NE + e]; mx = fmaxf(mx, lg[e]); }
            float den = 0.f;
#pragma unroll
            for (int e = 0; e < 16; ++e) { lg[e] = expf(lg[e] - mx); den += lg[e]; }
            const float rd = 1.f / den; const int t = (u.pm & 7) * 256 + row;
#pragma unroll
            for (int e = 0; e < 16; ++e) AFF[(size_t)(b * NE + e) * SEQ + t] = lg[e] * rd; }
#undef XLD
        __syncthreads();
#pragma unroll
        for (int ai = 0; ai < 2; ++ai)
#pragma unroll
            for (int m = 0; m < 4; ++m) { const int row = ai * 128 + wr * 64 + m * 16 + fr; const float rinv = RINV[row];
#pragma unroll
                for (int bj = 0; bj < 2; ++bj) { const f32x4 a0 = acc[ai][bj][m][0], a1 = acc[ai][bj][m][1]; v2u w;
                    w.x = pk4_fp8(a0[0] * rinv * gsc[bj][0] + shv[bj][0], a0[1] * rinv * gsc[bj][1] + shv[bj][1], a0[2] * rinv * gsc[bj][2] + shv[bj][2], a0[3] * rinv * gsc[bj][3] + shv[bj][3]);
                    w.y = pk4_fp8(a1[0] * rinv * gsc[bj][4] + shv[bj][4], a1[1] * rinv * gsc[bj][5] + shv[bj][5], a1[2] * rinv * gsc[bj][6] + shv[bj][6], a1[3] * rinv * gsc[bj][7] + shv[bj][7]);
                    *(v2u*)(HX8 + (size_t)(grow0 + row) * D + gcol0 + bj * 128 + wc * 32 + 8 * fq) = w; } }
    }
    __device__ __forceinline__ void st8(const pg8::Unit&, int, int, f32x4, f32x4) const {}
};

template <class Epi, class Sched>
__device__ __forceinline__ void naive_gemm_phase(LAS unsigned char* lds, const pg8::Gemm g, const Sched& S, const Epi& E) {
    LAS float* As = (LAS float*)lds; LAS float* Bs = (LAS float*)(lds + 4352);
    const int tid = threadIdx.x, ty = tid >> 5, tx = tid & 31, K = g.K, lr = tid >> 1, lh = 8 * (tid & 1);
    pg8::Unit u;
    for (int i = 0; S.next(i, u); ++i)
        for (int sub = 0; sub < 4; ++sub) {
            f32x4 ag[4], au[4];
#pragma unroll
            for (int r = 0; r < 4; ++r) { ag[r] = (f32x4){0.f, 0.f, 0.f, 0.f}; au[r] = (f32x4){0.f, 0.f, 0.f, 0.f}; }
            const bf16* arow = g.A + ((size_t)u.pm * 256 + sub * 64 + (lr & 63)) * K + lh;
            const bf16* brow = g.Bt + ((size_t)u.pnB * 256 + lr) * K + lh;
            for (int k0 = 0; k0 < K; k0 += 16) {
                const v4u bv = *(const v4u*)(brow + k0); v4u av = (v4u){0u, 0u, 0u, 0u}; if (tid < 128) av = *(const v4u*)(arow + k0);
                __syncthreads();
                Bs[(lh + 0) * 260 + lr] = bflo(bv.x); Bs[(lh + 1) * 260 + lr] = bfhi(bv.x); Bs[(lh + 2) * 260 + lr] = bflo(bv.y); Bs[(lh + 3) * 260 + lr] = bfhi(bv.y);
                Bs[(lh + 4) * 260 + lr] = bflo(bv.z); Bs[(lh + 5) * 260 + lr] = bfhi(bv.z); Bs[(lh + 6) * 260 + lr] = bflo(bv.w); Bs[(lh + 7) * 260 + lr] = bfhi(bv.w);
                if (tid < 128) {
                    As[(lh + 0) * 68 + lr] = bflo(av.x); As[(lh + 1) * 68 + lr] = bfhi(av.x); As[(lh + 2) * 68 + lr] = bflo(av.y); As[(lh + 3) * 68 + lr] = bfhi(av.y);
                    As[(lh + 4) * 68 + lr] = bflo(av.z); As[(lh + 5) * 68 + lr] = bfhi(av.z); As[(lh + 6) * 68 + lr] = bflo(av.w); As[(lh + 7) * 68 + lr] = bfhi(av.w); }
                __syncthreads();
#pragma unroll
                for (int kk = 0; kk < 16; ++kk) {
                    const f32x4 a = *(const LAS f32x4*)(As + kk * 68 + 4 * ty), b0 = *(const LAS f32x4*)(Bs + kk * 260 + 4 * tx), b1 = *(const LAS f32x4*)(Bs + kk * 260 + 128 + 4 * tx);
#pragma unroll
                    for (int r = 0; r < 4; ++r) { ag[r] += a[r] * b0; au[r] += a[r] * b1; }
                }
            }
#pragma unroll
            for (int r = 0; r < 4; ++r) { const int row = sub * 64 + 4 * ty + r;
                if constexpr (Epi::PAIRED) E.st2(u, row, 4 * tx, ag[r], au[r]);
                else { E.st(u, row, 4 * tx, ag[r]); E.st(u, row, 128 + 4 * tx, au[r]); } }
        }
    __syncthreads();
}
template <class Epi, class Sched>
__device__ __forceinline__ void gemm_any(LAS unsigned char* lds, const pg8::Gemm g, const Sched& S, const Epi& E) {
#if USE_PG8
    pg8::gemm_phase<Epi, Sched, true, true>(lds, g, S, E);
#else
    naive_gemm_phase<Epi, Sched>(lds, g, S, E);
#endif
}

__device__ __forceinline__ void transpose_item(const float* W, int N, int K, bf16* WT, int k0, int n0, size_t drow0, LAS unsigned char* scr, int lane) {
    const int lc = lane & 15, lr = lane >> 4;
    f32x4 v[16];
#pragma unroll
    for (int i = 0; i < 16; ++i) v[i] = *(const f32x4*)(W + (size_t)(k0 + 4 * i + lr) * N + n0 + 4 * lc);
#pragma unroll
    for (int i = 0; i < 16; ++i) { const int k = 4 * i + lr;
#pragma unroll
        for (int j = 0; j < 4; ++j) *(LAS bf16*)(scr + (4 * lc + j) * 136 + k * 2) = (bf16)f2bf(v[i][j]); }
    LDS_WAIT(); asm volatile("" ::: "memory");
    const int c = lane & 7;
#pragma unroll
    for (int j = 0; j < 8; ++j) { const int n = (lane >> 3) + 8 * j;
        const v2u lo = *(const LAS v2u*)(scr + n * 136 + c * 16), hi = *(const LAS v2u*)(scr + n * 136 + c * 16 + 8);
        *(v4u*)(WT + (drow0 + n) * (size_t)K + k0 + 8 * c) = (v4u){lo.x, lo.y, hi.x, hi.y}; }
    LDS_WAIT(); asm volatile("" ::: "memory");
}
__device__ __forceinline__ void conv_load(const float* src, int N, int lane, f32x4 (&v)[16]);
struct P;
__device__ __forceinline__ void conv_desc(const P& p, int it, const float*& src, unsigned char*& dst, int& N, int& K);
__device__ __forceinline__ void conv_store(const f32x4 (&v)[16], unsigned char* dst, int K, LAS unsigned char* scr, int lane);
__device__ __forceinline__ void transpose_item_f8(const float* W, int N, int K, unsigned char* WT, int k0, int n0, size_t drow0, LAS unsigned char* scr, int lane) {
    f32x4 v[16]; conv_load(W + (size_t)k0 * N + n0, N, lane, v); conv_store(v, WT + drow0 * (size_t)K + k0, K, scr, lane);
}
constexpr int CONV_ITEMS = 16 * 32 + 16 * 16 + 3 * 512 * NE, CONV_CUT = CONV_ITEMS - 6144;
__device__ __forceinline__ void convert_items(const P& p, LAS unsigned char* lds, int lane, int wave, int first, int last, int gw, int NGW) {
    LAS unsigned char* scr = lds + wave * 16384;
    constexpr int I_IN = 16 * 32, I_OUT = 16 * 16, I_E = 512 * NE;
    for (int it = first + gw; it < last; it += NGW) {
        int r = it;
        if (r < I_IN) { const int kb = r >> 5, nb = r & 31; transpose_item(p.w_in, DIN, D, (bf16*)(p.ws + WS_WIN), 64 * kb, 64 * nb, (size_t)(64 * nb), scr, lane); continue; } r -= I_IN;
        if (r < I_OUT) { const int kb = r >> 4, nb = r & 15; transpose_item(p.w_out, D, D, (bf16*)(p.ws + WS_WOUT), 64 * kb, 64 * nb, (size_t)(64 * nb), scr, lane); continue; } r -= I_OUT;
#if MOE_FP8
        { const float* src_; unsigned char* dst_; int N_, K_; f32x4 v_[16]; conv_desc(p, it, src_, dst_, N_, K_); conv_load(src_, N_, lane, v_); conv_store(v_, dst_, K_, scr, lane); }
#else
        if (r < 2 * I_E) { const int which = r >= I_E; if (which) r -= I_E; const int e = r >> 9, q = r & 511, kb = q >> 5, nb = q & 31, n0 = 64 * nb;
            const float* W = (which ? p.w3 : p.w1) + (size_t)e * D * DE;
#if MOE_FP8
            transpose_item_f8(W, DE, D, p.ws + WS_WG, 64 * kb, n0, (size_t)e * 4096 + (size_t)(n0 >> 7) * 256 + (n0 & 127) + (which ? 128 : 0), scr, lane); continue; } r -= 2 * I_E;
#else
            transpose_item(W, DE, D, (bf16*)(p.ws + WS_WG), 64 * kb, n0, (size_t)e * 4096 + (size_t)(n0 >> 7) * 256 + (n0 & 127) + (which ? 128 : 0), scr, lane); continue; } r -= 2 * I_E;
#endif
        { const int e = r >> 9, q = r & 511, kb = q >> 4, nb = q & 15, n0 = 64 * nb;
#if MOE_FP8
            transpose_item_f8(p.w2 + (size_t)e * DE * D, D, DE, p.ws + WS_W2, 64 * kb, n0, (size_t)e * 1024 + n0, scr, lane); }
#else
            transpose_item(p.w2 + (size_t)e * DE * D, D, DE, (bf16*)(p.ws + WS_W2), 64 * kb, n0, (size_t)e * 1024 + n0, scr, lane); }
#endif
#endif
    }
}

#if MOE_FP8
constexpr int CONV_HEAD = 16 * 32 + 16 * 16;
__device__ __forceinline__ void conv_desc(const P& p, int it, const float*& src, unsigned char*& dst, int& N, int& K) {
    constexpr int I_E = 512 * NE; const int r0 = it - CONV_HEAD;
    const bool isw2 = r0 >= 2 * I_E, which = (!isw2) && r0 >= I_E; const int r = isw2 ? r0 - 2 * I_E : (which ? r0 - I_E : r0);
    const int e = r >> 9, q = r & 511, kb = isw2 ? (q >> 5) : (q >> 6), nb = isw2 ? (q & 31) : (q & 63), n0 = 32 * nb;
    N = isw2 ? D : DE; K = isw2 ? DE : D;
    const float* base = isw2 ? p.w2 : (which ? p.w3 : p.w1);
    src = base + (size_t)e * D * DE + (size_t)(128 * kb) * N + n0;
    const size_t drow = isw2 ? ((size_t)e * 1024 + n0) : ((size_t)e * 4096 + (size_t)(n0 >> 7) * 256 + (n0 & 127) + (which ? 128 : 0));
    dst = p.ws + (isw2 ? WS_W2 : WS_WG) + drow * (size_t)K + 128 * kb;
}
__device__ __forceinline__ void conv_load(const float* src, int N, int lane, f32x4 (&v)[16]) {
    const int lc = lane & 7, lr = lane >> 3;
#pragma unroll
    for (int i = 0; i < 16; ++i) v[i] = __builtin_nontemporal_load((const f32x4*)(src + (size_t)(16 * lr + i) * N + 4 * lc));
}
__device__ __forceinline__ void conv_store(const f32x4 (&v)[16], unsigned char* dst, int K, LAS unsigned char* scr, int lane) {
    const int lc = lane & 7, lr = lane >> 3; (void)scr;
#pragma unroll
    for (int j = 0; j < 4; ++j) { v4u o;
        o.x = pk4_fp8(v[0][j] * WSCALE, v[1][j] * WSCALE, v[2][j] * WSCALE, v[3][j] * WSCALE);
        o.y = pk4_fp8(v[4][j] * WSCALE, v[5][j] * WSCALE, v[6][j] * WSCALE, v[7][j] * WSCALE);
        o.z = pk4_fp8(v[8][j] * WSCALE, v[9][j] * WSCALE, v[10][j] * WSCALE, v[11][j] * WSCALE);
        o.w = pk4_fp8(v[12][j] * WSCALE, v[13][j] * WSCALE, v[14][j] * WSCALE, v[15][j] * WSCALE);
        *(v4u*)(dst + (size_t)(4 * lc + j) * K + 16 * lr) = o; }
}
__device__ __forceinline__ void convert_pipelined(const P& p, LAS unsigned char* lds, int lane, int wave, int first, int last, int gw, int NGW) {
    LAS unsigned char* scr = lds + wave * 16384;
    f32x4 va[16], vb[16], vc[16]; const float* s0; unsigned char* da; unsigned char* db; unsigned char* dc; int N0, Ka, Kb, Kc;
    int it = first + gw; if (it >= last) return;
    const int itl = it + ((last - 1 - it) / NGW) * NGW;
    conv_desc(p, it, s0, da, N0, Ka); conv_load(s0, N0, lane, va);
    { const int i1 = min(it + NGW, itl); conv_desc(p, i1, s0, db, N0, Kb); conv_load(s0, N0, lane, vb); }
    for (; it <= itl; it += 3 * NGW) {
        { const int i2 = min(it + 2 * NGW, itl); conv_desc(p, i2, s0, dc, N0, Kc); conv_load(s0, N0, lane, vc); }
        conv_store(va, da, Ka, scr, lane);
        { const int i3 = min(it + 3 * NGW, itl); conv_desc(p, i3, s0, da, N0, Ka); conv_load(s0, N0, lane, va); }
        conv_store(vb, db, Kb, scr, lane);
        { const int i4 = min(it + 4 * NGW, itl); conv_desc(p, i4, s0, db, N0, Kb); conv_load(s0, N0, lane, vb); }
        conv_store(vc, dc, Kc, scr, lane);
    }
}
#endif
__device__ __forceinline__ void p0_small_copies(const P& p, int tid, int vcu, int G) {
    bf16* GWT = (bf16*)(p.ws + WS_GWT); bf16* SWB = (bf16*)(p.ws + WS_SWB); const int gt = vcu * NTHREADS + tid, NT = G * NTHREADS;
    for (int o = gt; o < 131072; o += NT) { const int i = o & 63, j = (o >> 6) & 63, h = (o >> 12) & 7, g = (o >> 15) & 1, d = o >> 16;
        GWT[o] = (bf16)f2bf((g ? p.rg_wi : p.rg_wa)[(size_t)((d * 8 + h) * 64 + i) * 64 + j]); }
    for (int o = gt; o < 65536; o += NT) SWB[o] = (bf16)f2bf(p.sgu_w[o]);
}
__device__ __forceinline__ void phase_p0(const P& p, LAS unsigned char* lds, int tid, int lane, int wave, int vcu, int G, int conv_last, bool small = true) {
    float* MOD = (float*)(p.ws + WS_MOD);
    {
        LAS float* sc = (LAS float*)lds; LAS float* part = (LAS float*)(lds + 36864);
        if (vcu < 192) {
            float cv[18];
#pragma unroll
            for (int i = 0; i < 18; ++i) { const int e = tid + i * NTHREADS, j = e >> 10, k = e & 1023; cv[i] = j < 8 ? p.c[j * D + k] : p.c_ctx[k]; }
#pragma unroll
            for (int i = 0; i < 18; ++i) sc[tid + i * NTHREADS] = siluf_(cv[i]);
        }
        __syncthreads();
        for (int t = vcu; t < 192; t += G) {
            const int col = lane & 31, kh = lane >> 5, n = t * 32 + col, kbase = wave * 128 + kh * 64; float acc[9];
#pragma unroll
            for (int j = 0; j < 9; ++j) acc[j] = 0.f;
            for (int k0 = 0; k0 < 64; k0 += 16) { float w[16];
#pragma unroll
                for (int i = 0; i < 16; ++i) w[i] = p.w_mod[(size_t)(kbase + k0 + i) * NMOD + n];
#pragma unroll
                for (int i = 0; i < 16; ++i)
#pragma unroll
                    for (int j = 0; j < 9; ++j) acc[j] += sc[j * D + kbase + k0 + i] * w[i]; }
#pragma unroll
            for (int j = 0; j < 9; ++j) { acc[j] += __shfl_xor(acc[j], 32); if (lane < 32) part[(wave * 9 + j) * 32 + lane] = acc[j]; }
            __syncthreads();
            for (int i = tid; i < 9 * 32; i += NTHREADS) { const int j = i >> 5, l = i & 31; float s2 = p.b_mod[t * 32 + l];
#pragma unroll
                for (int w = 0; w < 8; ++w) s2 += part[(w * 9 + j) * 32 + l];
                MOD[j * NMOD + t * 32 + l] = s2; }
            __syncthreads();
        }
    }
    convert_items(p, lds, lane, wave, 0, conv_last, vcu * NWAVES + wave, G * NWAVES);
    if (small) p0_small_copies(p, tid, vcu, G);
}

__device__ __forceinline__ void phase_p1(const P& p, int lane, int wave, int vcu, int G) {
    const float* MOD = (const float*)(p.ws + WS_MOD); bf16* HX = (bf16*)(p.ws + WS_HX);
    const int gw = vcu * NWAVES + wave, NGW = G * NWAVES;
    for (int i = gw; i < BATCH * NE; i += NGW) { const int b = i >> 4, e = i & 15; float a = 0.f;
        for (int k = lane; k < D; k += 64) a += MOD[b * NMOD + 3 * D + k] * p.w_router[k * NE + e];
        a = wave_sum(a); if (lane == 0) ((float*)(p.ws + WS_CB))[i] = a; }
    f32x4 nx[4];
    { const int m = gw; if (m < MT) { const f32x4* xr = (const f32x4*)(m < M ? p.x + (size_t)m * D : p.ctx + (size_t)(m - M) * D) + lane;
#pragma unroll
        for (int jj = 0; jj < 4; ++jj) nx[jj] = xr[64 * jj]; } }
    for (int m = gw; m < MT; m += NGW) {
        const int j = m < M ? (m >> 11) : 8;
        f32x4 v[4]; float s = 0.f;
#pragma unroll
        for (int jj = 0; jj < 4; ++jj) { v[jj] = nx[jj]; s += (v[jj].x * v[jj].x + v[jj].y * v[jj].y) + (v[jj].z * v[jj].z + v[jj].w * v[jj].w); }
        { const int m2 = m + NGW; if (m2 < MT) { const f32x4* xr = (const f32x4*)(m2 < M ? p.x + (size_t)m2 * D : p.ctx + (size_t)(m2 - M) * D) + lane;
#pragma unroll
            for (int jj = 0; jj < 4; ++jj) nx[jj] = xr[64 * jj]; } }
        const float rinv = rsqrtf(wave_sum(s) * (1.f / D) + EPS);
        v2u* o = (v2u*)(HX + (size_t)m * D) + lane;
#pragma unroll
        for (int jj = 0; jj < 4; ++jj) { const int k = 4 * (lane + 64 * jj);
            const f32x4 g = *(const f32x4*)(p.norm1_g + k), sh = *(const f32x4*)(MOD + j * NMOD + k), sc = *(const f32x4*)(MOD + j * NMOD + D + k);
            const f32x4 h = v[jj] * rinv * g * (sc + 1.f) + sh; v2u w; w.x = pk2(h.x, h.y); w.y = pk2(h.z, h.w); o[64 * jj] = w; }
    }
}

__device__ __forceinline__ void phase_lru1(const P& p, LAS unsigned char* lds, int tid, int vcu, int G) {
    LAS float* xt = (LAS float*)lds;
    LAS float* cx = (LAS float*)(lds + 17152);
    LAS float* af = (LAS float*)(lds + 33536);
    LAS float* df = (LAS float*)(lds + 49920);
    LAS float* ab = (LAS float*)(lds + 66304);
    LAS float* db = (LAS float*)(lds + 82688);
    const bf16* UV = (const bf16*)(p.ws + WS_UV); const bf16* XC = (const bf16*)(p.ws + WS_XC);
    bf16* HS = (bf16*)(p.ws + WS_HS); bf16* PF = (bf16*)(p.ws + WS_PF); bf16* PB = (bf16*)(p.ws + WS_PB); float* SUM = (float*)(p.ws + WS_SUM);
    for (int T = vcu; T < BATCH * NSEG * 8; T += G) {
        const int b = T / (NSEG * 8), rem = T % (NSEG * 8), seg = rem >> 3, h = rem & 7;
        for (int i = tid; i < 67 * 64; i += NTHREADS) { const int r = (i >> 6) - 1, ch = i & 63; float v = 0.f;
            if (seg < 4) { const int pos = seg * 64 + r; if (pos >= 0 && pos < CTXL) v = bf2f(XC[(size_t)(b * CTXL + pos) * DLRU + h * 64 + ch]); }
            else { if (r >= 0 && r < 64) v = bf2f(UV[(size_t)(b * SEQ + (seg - 4) * 64 + r) * DIN + 1024 + h * 64 + ch]); }
            xt[i] = v; }
        __syncthreads();
        for (int i = tid; i < 4096; i += NTHREADS) { const int r = i >> 6, ch = i & 63, cch = h * 64 + ch; float v = p.conv_b[cch];
#pragma unroll
            for (int j = 0; j < 4; ++j) v += p.conv_w[j * DLRU + cch] * xt[(r + j) * 64 + ch];
            cx[i] = v; }
        __syncthreads();
        { const int jj = tid & 63, r0 = tid >> 6, cch = h * 64 + jj;
#pragma unroll
          for (int d = 0; d < 2; ++d) {
            float aa[8], ai[8];
#pragma unroll
            for (int q = 0; q < 8; ++q) { aa[q] = 0.f; ai[q] = 0.f; }
            const float* wa = p.rg_wa + (size_t)((d * 8 + h) * 64) * 64 + jj; const float* wi = p.rg_wi + (size_t)((d * 8 + h) * 64) * 64 + jj;
#pragma unroll 2
            for (int i = 0; i < 64; ++i) { const float wav = wa[i * 64], wiv = wi[i * 64];
#pragma unroll
                for (int q = 0; q < 8; ++q) { const float cv = cx[(r0 + 8 * q) * 64 + i]; aa[q] += cv * wav; ai[q] += cv * wiv; } }
            const float ba = p.rg_ba[d * DLRU + cch], bi = p.rg_bi[d * DLRU + cch], c8 = -8.f * log1pf(expf(-p.rg_lam[d * DLRU + cch]));
            LAS float* ao = d ? ab : af; LAS float* dout = d ? db : df;
#pragma unroll
            for (int q = 0; q < 8; ++q) { const int r = r0 + 8 * q; const float rg = sigmoidf_(aa[q] + ba), ig = sigmoidf_(ai[q] + bi), la = c8 * rg;
                ao[r * 64 + jj] = expf(la); dout[r * 64 + jj] = sqrtf(-expm1f(2.f * la)) * ig * cx[r * 64 + jj]; }
          } }
        __syncthreads();
        if (tid < 128) { const int d = tid >> 6, ch = tid & 63; float hh = 0.f, pp = 1.f;
            if (d == 0) {
#pragma unroll 4
                for (int r = 0; r < 64; ++r) { const float a = af[r * 64 + ch]; hh = a * hh + df[r * 64 + ch]; pp *= a; df[r * 64 + ch] = hh; af[r * 64 + ch] = pp; } }
            else {
#pragma unroll 4
                for (int r = 63; r >= 0; --r) { const float a = ab[r * 64 + ch]; hh = a * hh + db[r * 64 + ch]; pp *= a; db[r * 64 + ch] = hh; ab[r * 64 + ch] = pp; } }
            float* s = SUM + ((size_t)((b * NSEG + seg) * 2 + d) * DLRU + h * 64 + ch) * 2; s[0] = pp; s[1] = hh; }
        __syncthreads();
        if (seg >= 4) for (int i = tid; i < 4096; i += NTHREADS) { const int r = i >> 6, ch = i & 63; const size_t o = (size_t)(b * SEQ + (seg - 4) * 64 + r) * DLRU + h * 64 + ch;
            HS[o] = (bf16)f2bf(df[i] + db[i]); PF[o] = (bf16)f2bf(af[i]); PB[o] = (bf16)f2bf(ab[i]); }
        __syncthreads();
    }
}

__device__ __forceinline__ void phase_sgu(const P& p, LAS unsigned char* lds, int tid, int vcu, int G) {
    LAS float* vn = (LAS float*)lds;
    LAS float* wsl = (LAS float*)(lds + 65536);
    const bf16* UV = (const bf16*)(p.ws + WS_UV); bf16* A2 = (bf16*)(p.ws + WS_A2);
    for (int T = vcu; T < 512; T += G) {
        const int b = T >> 6, n = (T >> 2) & 15, h = T & 3; const size_t t0 = (size_t)b * SEQ + n * 128;
        for (int i = tid; i < 16384; i += NTHREADS) { const int q = i >> 7, c = i & 127; vn[i] = bf2f(UV[(t0 + q) * DIN + 512 + h * 128 + c]); wsl[i] = p.sgu_w[h * 16384 + i]; }
        __syncthreads();
        { const int q = tid >> 2, part = tid & 3; float s = 0.f;
          for (int c = part * 32; c < part * 32 + 32; ++c) { const float v = vn[q * 128 + c]; s += v * v; }
          s += __shfl_xor(s, 1); s += __shfl_xor(s, 2);
          const float rinv = rsqrtf(s * (1.f / 128.f) + EPS);
          for (int c = part * 32; c < part * 32 + 32; ++c) vn[q * 128 + c] *= rinv * p.sgu_g[h * 128 + c]; }
        __syncthreads();
        { const int c = tid & 127, p0 = tid >> 7; float acc[32];
#pragma unroll
          for (int i = 0; i < 32; ++i) acc[i] = 0.f;
          for (int q = 0; q < 128; ++q) { const float vq = vn[q * 128 + c];
#pragma unroll
              for (int i = 0; i < 32; ++i) acc[i] += wsl[(p0 + 4 * i) * 128 + q] * vq; }
#pragma unroll
          for (int i = 0; i < 32; ++i) { const int pp = p0 + 4 * i; const float s = acc[i] + p.sgu_b[h * 128 + pp];
              const float uu = bf2f(UV[(t0 + pp) * DIN + h * 128 + c]); A2[(t0 + pp) * D + h * 128 + c] = (bf16)f2bf(uu * s); } }
        __syncthreads();
    }
}


__device__ __forceinline__ void phase_lru1_mfma(const P& p, LAS unsigned char* lds, int tid, int lane, int wave, int vcu, int G) {
    LAS float* xt = (LAS float*)lds;
    LAS float* cxf = (LAS float*)(lds + 17152);
    LAS unsigned char* cxb = lds + 33536;
    LAS float* AD = (LAS float*)(lds + 42752);
    LAS float* SS = (LAS float*)(lds + 108288);
    const bf16* UV = (const bf16*)(p.ws + WS_UV); const bf16* XC = (const bf16*)(p.ws + WS_XC); const bf16* GWT = (const bf16*)(p.ws + WS_GWT);
    bf16* HS = (bf16*)(p.ws + WS_HS); bf16* PF = (bf16*)(p.ws + WS_PF); bf16* PB = (bf16*)(p.ws + WS_PB); float* SUM = (float*)(p.ws + WS_SUM);
    const int fr = lane & 15, fq = lane >> 4;
    const int wd = wave >> 2, jt = wave & 3, wj = 16 * jt + fr, cch_c = tid & 63;
    int hcur = -1; bf16x8 bfr[2][2]; float ba = 0.f, bi = 0.f, c8 = 0.f, cw0 = 0.f, cw1 = 0.f, cw2 = 0.f, cw3 = 0.f, cbias = 0.f;
    auto load_piece = [&](int T, int i) -> v4u { const int b = T / (NSEG * 8), rem = T % (NSEG * 8), seg = rem >> 3, h = rem & 7, r = (i >> 3) - 1, c0 = (i & 7) * 8; v4u w = (v4u){0u, 0u, 0u, 0u};
        if (seg < 4) { const int pos = seg * 64 + r; if (pos >= 0 && pos < CTXL) w = *(const v4u*)(XC + (size_t)(b * CTXL + pos) * DLRU + h * 64 + c0); }
        else { if (r >= 0 && r < 64) w = *(const v4u*)(UV + (size_t)(b * SEQ + (seg - 4) * 64 + r) * DIN + 1024 + h * 64 + c0); }
        return w; };
    v4u pre0 = (v4u){0u, 0u, 0u, 0u}, pre1 = (v4u){0u, 0u, 0u, 0u};
    if (vcu < BATCH * NSEG * 8) { pre0 = load_piece(vcu, tid); if (tid < 24) pre1 = load_piece(vcu, tid + 512); }
    for (int T = vcu; T < BATCH * NSEG * 8; T += G) {
        const int b = T / (NSEG * 8), rem = T % (NSEG * 8), seg = rem >> 3, h = rem & 7;
        { LAS float* o = xt + (tid >> 3) * 64 + (tid & 7) * 8;
          *(LAS f32x4*)o = (f32x4){bflo(pre0.x), bfhi(pre0.x), bflo(pre0.y), bfhi(pre0.y)}; *(LAS f32x4*)(o + 4) = (f32x4){bflo(pre0.z), bfhi(pre0.z), bflo(pre0.w), bfhi(pre0.w)};
          if (tid < 24) { LAS float* o1 = xt + ((tid + 512) >> 3) * 64 + (tid & 7) * 8;
              *(LAS f32x4*)o1 = (f32x4){bflo(pre1.x), bfhi(pre1.x), bflo(pre1.y), bfhi(pre1.y)}; *(LAS f32x4*)(o1 + 4) = (f32x4){bflo(pre1.z), bfhi(pre1.z), bflo(pre1.w), bfhi(pre1.w)}; } }
        if (h != hcur) { hcur = h;
#pragma unroll
            for (int g = 0; g < 2; ++g)
#pragma unroll
                for (int ks = 0; ks < 2; ++ks) bfr[g][ks] = *(const bf16x8*)(GWT + (size_t)((((wd * 2 + g) * 8 + h) * 64 + wj) * 64 + 32 * ks + 8 * fq));
            ba = p.rg_ba[wd * DLRU + h * 64 + wj]; bi = p.rg_bi[wd * DLRU + h * 64 + wj]; c8 = -8.f * log1pf(expf(-p.rg_lam[wd * DLRU + h * 64 + wj]));
            cw0 = p.conv_w[h * 64 + cch_c]; cw1 = p.conv_w[DLRU + h * 64 + cch_c]; cw2 = p.conv_w[2 * DLRU + h * 64 + cch_c]; cw3 = p.conv_w[3 * DLRU + h * 64 + cch_c]; cbias = p.conv_b[h * 64 + cch_c]; }
        __syncthreads();
        if (T + G < BATCH * NSEG * 8) { pre0 = load_piece(T + G, tid); if (tid < 24) pre1 = load_piece(T + G, tid + 512); }
        for (int i = tid; i < 4096; i += NTHREADS) { const int r = i >> 6, ch = i & 63;
            const float v = cbias + cw0 * xt[r * 64 + ch] + cw1 * xt[(r + 1) * 64 + ch] + cw2 * xt[(r + 2) * 64 + ch] + cw3 * xt[(r + 3) * 64 + ch];
            cxf[i] = v; *(LAS bf16*)(cxb + r * 144 + ch * 2) = (bf16)f2bf(v); }
        __syncthreads();
        { const int d = wd, j = wj;
          LAS float* Ad = AD + d * 8192; LAS float* Dd = Ad + 4096;
#pragma unroll
          for (int pt = 0; pt < 4; ++pt) {
              const bf16x8 a0 = *(const LAS bf16x8*)(cxb + (16 * pt + fr) * 144 + 16 * fq), a1 = *(const LAS bf16x8*)(cxb + (16 * pt + fr) * 144 + 64 + 16 * fq);
              f32x4 ca = (f32x4){0.f, 0.f, 0.f, 0.f}, ci = (f32x4){0.f, 0.f, 0.f, 0.f};
              ca = __builtin_amdgcn_mfma_f32_16x16x32_bf16(a0, bfr[0][0], ca, 0, 0, 0); ca = __builtin_amdgcn_mfma_f32_16x16x32_bf16(a1, bfr[0][1], ca, 0, 0, 0);
              ci = __builtin_amdgcn_mfma_f32_16x16x32_bf16(a0, bfr[1][0], ci, 0, 0, 0); ci = __builtin_amdgcn_mfma_f32_16x16x32_bf16(a1, bfr[1][1], ci, 0, 0, 0);
#pragma unroll
              for (int r = 0; r < 4; ++r) { const int pos = 16 * pt + 4 * fq + r; const float rg = sigmoidf_(ca[r] + ba), ig = sigmoidf_(ci[r] + bi), la = c8 * rg;
                  float av, sv; decay_pair(la, av, sv); Ad[pos * 64 + j] = av; Dd[pos * 64 + j] = sv * ig * cxf[pos * 64 + j]; }
          } }
        __syncthreads();
        { const int sub = tid >> 7, d = (tid >> 6) & 1, ch = tid & 63;
          LAS float* Ad = AD + d * 8192; LAS float* Dd = Ad + 4096;
          float hl[16], pc[16]; float hh = 0.f, pp = 1.f;
#pragma unroll
          for (int t = 0; t < 16; ++t) { const int pos = d ? 16 * sub + 15 - t : 16 * sub + t; const float a = Ad[pos * 64 + ch]; hh = a * hh + Dd[pos * 64 + ch]; pp *= a; hl[t] = hh; pc[t] = pp; }
          SS[((sub * 2 + d) * 64 + ch) * 2] = pp; SS[((sub * 2 + d) * 64 + ch) * 2 + 1] = hh;
          __syncthreads();
          float cin = 0.f, cp = 1.f;
          if (d == 0) { for (int s2 = 0; s2 < sub; ++s2) { const float A = SS[((s2 * 2) * 64 + ch) * 2], B = SS[((s2 * 2) * 64 + ch) * 2 + 1]; cin = A * cin + B; cp *= A; } }
          else { for (int s2 = 3; s2 > sub; --s2) { const float A = SS[((s2 * 2 + 1) * 64 + ch) * 2], B = SS[((s2 * 2 + 1) * 64 + ch) * 2 + 1]; cin = A * cin + B; cp *= A; } }
#pragma unroll
          for (int t = 0; t < 16; ++t) { const int pos = d ? 16 * sub + 15 - t : 16 * sub + t; Dd[pos * 64 + ch] = hl[t] + pc[t] * cin; Ad[pos * 64 + ch] = pc[t] * cp; }
          if ((d == 0 && sub == 3) || (d == 1 && sub == 0)) { float* so = SUM + ((size_t)((b * NSEG + seg) * 2 + d) * DLRU + h * 64 + ch) * 2; so[0] = pc[15] * cp; so[1] = hl[15] + pc[15] * cin; }
        }
        __syncthreads();
        if (seg >= 4) { const int pos = tid >> 3, c0 = (tid & 7) * 8; const LAS float* q0 = AD + pos * 64 + c0;
            const f32x4 a0l = *(const LAS f32x4*)(q0), a0h = *(const LAS f32x4*)(q0 + 4), d0l = *(const LAS f32x4*)(q0 + 4096), d0h = *(const LAS f32x4*)(q0 + 4100);
            const f32x4 a1l = *(const LAS f32x4*)(q0 + 8192), a1h = *(const LAS f32x4*)(q0 + 8196), d1l = *(const LAS f32x4*)(q0 + 12288), d1h = *(const LAS f32x4*)(q0 + 12292);
            const f32x4 sl = d0l + d1l, sh = d0h + d1h; const size_t o = (size_t)(b * SEQ + (seg - 4) * 64 + pos) * DLRU + h * 64 + c0;
            *(v4u*)(HS + o) = (v4u){pk2(sl.x, sl.y), pk2(sl.z, sl.w), pk2(sh.x, sh.y), pk2(sh.z, sh.w)};
            *(v4u*)(PF + o) = (v4u){pk2(a0l.x, a0l.y), pk2(a0l.z, a0l.w), pk2(a0h.x, a0h.y), pk2(a0h.z, a0h.w)};
            *(v4u*)(PB + o) = (v4u){pk2(a1l.x, a1l.y), pk2(a1l.z, a1l.w), pk2(a1h.x, a1h.y), pk2(a1h.z, a1h.w)}; }
        __syncthreads();
    }
}


template <int WD>
__device__ __forceinline__ void lru_scan(const float (&ga)[4][4], const float (&gb)[4][4], LAS float* EX, int lane, int fr, int fq, int wj, float& Pin, float& Hin) {
    const int cq = WD ? 3 - fq : fq, l16 = (WD ? lane + 16 : lane - 16) & 63, l32 = (WD ? lane + 32 : lane - 32) & 63, llast = WD ? fr : fr + 48;
    LAS float* Pd = EX + WD * 8192; LAS float* Hd = Pd + 4096;
#pragma unroll
    for (int ptc = 0; ptc < 4; ++ptc) { constexpr int dummy = 0; (void)dummy; const int pt = WD ? 3 - ptc : ptc;
        float pr[4], hr[4]; float hh = 0.f, pp = 1.f;
#pragma unroll
        for (int rc = 0; rc < 4; ++rc) { const int r = WD ? 3 - rc : rc; hh = ga[pt][r] * hh + gb[pt][r]; pp *= ga[pt][r]; pr[r] = pp; hr[r] = hh; }
        float A = pp, B = hh;
        { const float tA = __shfl(A, l16), tB = __shfl(B, l16); if (cq >= 1) { B = A * tB + B; A = tA * A; } }
        { const float tA = __shfl(A, l32), tB = __shfl(B, l32); if (cq >= 2) { B = A * tB + B; A = tA * A; } }
        float eA = __shfl(A, l16), eB = __shfl(B, l16); if (cq == 0) { eA = 1.f; eB = 0.f; }
        const float tAt = __shfl(A, llast), tBt = __shfl(B, llast);
        const float Hc = eA * Hin + eB, Pc = Pin * eA;
#pragma unroll
        for (int r = 0; r < 4; ++r) { const int pos = 16 * pt + 4 * fq + r; Hd[pos * 64 + wj] = pr[r] * Hc + hr[r]; Pd[pos * 64 + wj] = Pc * pr[r]; }
        Hin = tAt * Hin + tBt; Pin *= tAt;
    }
}

__device__ __forceinline__ void phase_lru1_v2(const P& p, LAS unsigned char* lds, int tid, int lane, int wave, int vcu, int G) {
    LAS float* xt = (LAS float*)lds;
    LAS float* cxf = (LAS float*)(lds + 17152);
    LAS unsigned char* cxb = lds + 33536;
    LAS float* EX = (LAS float*)(lds + 42752);
    const bf16* UV = (const bf16*)(p.ws + WS_UV); const bf16* XC = (const bf16*)(p.ws + WS_XC); const bf16* GWT = (const bf16*)(p.ws + WS_GWT);
    bf16* HS = (bf16*)(p.ws + WS_HS); bf16* PF = (bf16*)(p.ws + WS_PF); bf16* PB = (bf16*)(p.ws + WS_PB); float* SUM = (float*)(p.ws + WS_SUM);
    const int fr = lane & 15, fq = lane >> 4;
    const int wd = wave >> 2, jt = wave & 3, wj = 16 * jt + fr, cch_c = tid & 63;
    int hcur = -1; bf16x8 bfr[2][2]; float ba = 0.f, bi = 0.f, c8 = 0.f, cw0 = 0.f, cw1 = 0.f, cw2 = 0.f, cw3 = 0.f, cbias = 0.f;
    auto load_piece = [&](int T, int i) -> v4u { const int b = T / (NSEG * 8), rem = T % (NSEG * 8), seg = rem >> 3, h = rem & 7, r = (i >> 3) - 1, c0 = (i & 7) * 8; v4u w = (v4u){0u, 0u, 0u, 0u};
        if (seg < 4) { const int pos = seg * 64 + r; if (pos >= 0 && pos < CTXL) w = *(const v4u*)(XC + (size_t)(b * CTXL + pos) * DLRU + h * 64 + c0); }
        else { if (r >= 0 && r < 64) w = *(const v4u*)(UV + (size_t)(b * SEQ + (seg - 4) * 64 + r) * DIN + 1024 + h * 64 + c0); }
        return w; };
    v4u pre0 = (v4u){0u, 0u, 0u, 0u}, pre1 = (v4u){0u, 0u, 0u, 0u};
    if (vcu < BATCH * NSEG * 8) { pre0 = load_piece(vcu, tid); if (tid < 24) pre1 = load_piece(vcu, tid + 512); }
    for (int T = vcu; T < BATCH * NSEG * 8; T += G) {
        const int b = T / (NSEG * 8), rem = T % (NSEG * 8), seg = rem >> 3, h = rem & 7;
        { LAS float* o = xt + (tid >> 3) * 64 + (tid & 7) * 8;
          *(LAS f32x4*)o = (f32x4){bflo(pre0.x), bfhi(pre0.x), bflo(pre0.y), bfhi(pre0.y)}; *(LAS f32x4*)(o + 4) = (f32x4){bflo(pre0.z), bfhi(pre0.z), bflo(pre0.w), bfhi(pre0.w)};
          if (tid < 24) { LAS float* o1 = xt + ((tid + 512) >> 3) * 64 + (tid & 7) * 8;
              *(LAS f32x4*)o1 = (f32x4){bflo(pre1.x), bfhi(pre1.x), bflo(pre1.y), bfhi(pre1.y)}; *(LAS f32x4*)(o1 + 4) = (f32x4){bflo(pre1.z), bfhi(pre1.z), bflo(pre1.w), bfhi(pre1.w)}; } }
        if (h != hcur) { hcur = h;
#pragma unroll
            for (int g = 0; g < 2; ++g)
#pragma unroll
                for (int ks = 0; ks < 2; ++ks) bfr[g][ks] = *(const bf16x8*)(GWT + (size_t)((((wd * 2 + g) * 8 + h) * 64 + wj) * 64 + 32 * ks + 8 * fq));
            ba = p.rg_ba[wd * DLRU + h * 64 + wj]; bi = p.rg_bi[wd * DLRU + h * 64 + wj]; c8 = -8.f * log1pf(expf(-p.rg_lam[wd * DLRU + h * 64 + wj]));
            cw0 = p.conv_w[h * 64 + cch_c]; cw1 = p.conv_w[DLRU + h * 64 + cch_c]; cw2 = p.conv_w[2 * DLRU + h * 64 + cch_c]; cw3 = p.conv_w[3 * DLRU + h * 64 + cch_c]; cbias = p.conv_b[h * 64 + cch_c];
            asm volatile("" : "+v"(ba), "+v"(bi), "+v"(c8), "+v"(cw0), "+v"(cw1), "+v"(cw2), "+v"(cw3), "+v"(cbias) :: "memory");
#pragma unroll
            for (int g = 0; g < 2; ++g)
#pragma unroll
                for (int ks = 0; ks < 2; ++ks) asm volatile("" : "+v"(bfr[g][ks]) :: "memory"); }
        __syncthreads();
        if (T + G < BATCH * NSEG * 8) { pre0 = load_piece(T + G, tid); if (tid < 24) pre1 = load_piece(T + G, tid + 512); }
        for (int i = tid; i < 4096; i += NTHREADS) { const int r = i >> 6, ch = i & 63;
            const float v = cbias + cw0 * xt[r * 64 + ch] + cw1 * xt[(r + 1) * 64 + ch] + cw2 * xt[(r + 2) * 64 + ch] + cw3 * xt[(r + 3) * 64 + ch];
            cxf[i] = v; *(LAS bf16*)(cxb + r * 144 + ch * 2) = (bf16)f2bf(v); }
        __syncthreads();
        {
            float ga[4][4], gb[4][4];
#pragma unroll
            for (int pt = 0; pt < 4; ++pt) {
                const bf16x8 a0 = *(const LAS bf16x8*)(cxb + (16 * pt + fr) * 144 + 16 * fq), a1 = *(const LAS bf16x8*)(cxb + (16 * pt + fr) * 144 + 64 + 16 * fq);
                f32x4 ca = (f32x4){0.f, 0.f, 0.f, 0.f}, ci = (f32x4){0.f, 0.f, 0.f, 0.f};
                ca = __builtin_amdgcn_mfma_f32_16x16x32_bf16(a0, bfr[0][0], ca, 0, 0, 0); ca = __builtin_amdgcn_mfma_f32_16x16x32_bf16(a1, bfr[0][1], ca, 0, 0, 0);
                ci = __builtin_amdgcn_mfma_f32_16x16x32_bf16(a0, bfr[1][0], ci, 0, 0, 0); ci = __builtin_amdgcn_mfma_f32_16x16x32_bf16(a1, bfr[1][1], ci, 0, 0, 0);
#pragma unroll
                for (int r = 0; r < 4; r += 2) { const int pos = 16 * pt + 4 * fq + r;
                    const f32x2p rg = sigmoid2_((f32x2p){ca[r], ca[r + 1]} + ba), ig = sigmoid2_((f32x2p){ci[r], ci[r + 1]} + bi); f32x2p av, sv; decay_pair2(rg * c8, av, sv);
                    const f32x2p dv = sv * ig * (f32x2p){cxf[pos * 64 + wj], cxf[(pos + 1) * 64 + wj]}; ga[pt][r] = av.x; ga[pt][r + 1] = av.y; gb[pt][r] = dv.x; gb[pt][r + 1] = dv.y; }
            }
            float Pin = 1.f, Hin = 0.f;
            if (wd == 0) lru_scan<0>(ga, gb, EX, lane, fr, fq, wj, Pin, Hin); else lru_scan<1>(ga, gb, EX, lane, fr, fq, wj, Pin, Hin);
            if (fq == 0) { float* so = SUM + ((size_t)((b * NSEG + seg) * 2 + wd) * DLRU + h * 64 + wj) * 2; so[0] = Pin; so[1] = Hin; }
        }
        __syncthreads();
        if (seg >= 4) { const int pos = tid >> 3, c0 = (tid & 7) * 8; const LAS float* q0 = EX + pos * 64 + c0;
            const f32x4 a0l = *(const LAS f32x4*)(q0), a0h = *(const LAS f32x4*)(q0 + 4), d0l = *(const LAS f32x4*)(q0 + 4096), d0h = *(const LAS f32x4*)(q0 + 4100);
            const f32x4 a1l = *(const LAS f32x4*)(q0 + 8192), a1h = *(const LAS f32x4*)(q0 + 8196), d1l = *(const LAS f32x4*)(q0 + 12288), d1h = *(const LAS f32x4*)(q0 + 12292);
            const f32x4 sl = d0l + d1l, sh = d0h + d1h; const size_t o = (size_t)(b * SEQ + (seg - 4) * 64 + pos) * DLRU + h * 64 + c0;
            *(v4u*)(HS + o) = (v4u){pk2(sl.x, sl.y), pk2(sl.z, sl.w), pk2(sh.x, sh.y), pk2(sh.z, sh.w)};
            *(v4u*)(PF + o) = (v4u){pk2(a0l.x, a0l.y), pk2(a0l.z, a0l.w), pk2(a0h.x, a0h.y), pk2(a0h.z, a0h.w)};
            *(v4u*)(PB + o) = (v4u){pk2(a1l.x, a1l.y), pk2(a1l.z, a1l.w), pk2(a1h.x, a1h.y), pk2(a1h.z, a1h.w)}; }
    }
    __syncthreads();
}

#define SGU_GLD4(r, ptr) asm volatile("global_load_dwordx4 %0, %4, off\n\tglobal_load_dwordx4 %1, %4, off offset:64\n\tglobal_load_dwordx4 %2, %4, off offset:128\n\tglobal_load_dwordx4 %3, %4, off offset:192" \
    : "=&v"(r[0]), "=&v"(r[1]), "=&v"(r[2]), "=&v"(r[3]) : "v"(ptr) : "memory")
__device__ __forceinline__ void phase_sgu_mfma(const P& p, LAS unsigned char* lds, int tid, int lane, int wave, int vcu, int G, int first = 0, int last = 512) {
    LAS unsigned char* vnT = lds;
    LAS unsigned char* ul = lds + 34816;
    const bf16* UV = (const bf16*)(p.ws + WS_UV); const bf16* SWB = (const bf16*)(p.ws + WS_SWB); bf16* A2 = (bf16*)(p.ws + WS_A2);
    const int fr = lane & 15, fq = lane >> 4, q = tid >> 2, part = tid & 3;
    int T = first + vcu; if (T >= last) return;
    v4u vw[4], uw[4];
    auto issue = [&](int TT) { const int b = TT >> 6, n = (TT >> 2) & 15, h = TT & 3; const bf16* row = UV + ((size_t)b * SEQ + n * 128 + q) * DIN + h * 128 + part * 8;
        SGU_GLD4(vw, row + 512); SGU_GLD4(uw, row); };
    issue(T);
    int hcur = -1; f32x4 gs[8]; bf16x8 afr[4]; float bs[4] = {0.f, 0.f, 0.f, 0.f};
    for (; T < last; T += G) {
        const int b = T >> 6, n = (T >> 2) & 15, h = T & 3; const size_t t0 = (size_t)b * SEQ + n * 128;
        if (h != hcur) { hcur = h;
#pragma unroll
            for (int i = 0; i < 4; ++i) { gs[2 * i] = *(const f32x4*)(p.sgu_g + h * 128 + 32 * i + 8 * part); gs[2 * i + 1] = *(const f32x4*)(p.sgu_g + h * 128 + 32 * i + 8 * part + 4); }
#pragma unroll
            for (int ks = 0; ks < 4; ++ks) afr[ks] = *(const bf16x8*)(SWB + (size_t)((h * 128 + 16 * wave + fr) * 128 + 32 * ks + 8 * fq));
#pragma unroll
            for (int r = 0; r < 4; ++r) bs[r] = p.sgu_b[h * 128 + 16 * wave + 4 * fq + r];
#pragma unroll
            for (int i = 0; i < 8; ++i) asm volatile("" : "+v"(gs[i]) :: "memory");
#pragma unroll
            for (int ks = 0; ks < 4; ++ks) asm volatile("" : "+v"(afr[ks]) :: "memory");
            asm volatile("" : "+v"(bs[0]), "+v"(bs[1]), "+v"(bs[2]), "+v"(bs[3]) :: "memory"); }
        asm volatile("s_waitcnt vmcnt(4) ; retires %0 %1 %2 %3 %4 %5 %6 %7" : "+v"(vw[0]), "+v"(vw[1]), "+v"(vw[2]), "+v"(vw[3]), "+v"(uw[0]), "+v"(uw[1]), "+v"(uw[2]), "+v"(uw[3]) :: "memory");
        { float v[32]; float s = 0.f;
#pragma unroll
          for (int i = 0; i < 4; ++i) { const v4u w = vw[i]; v[8 * i] = bflo(w.x); v[8 * i + 1] = bfhi(w.x); v[8 * i + 2] = bflo(w.y); v[8 * i + 3] = bfhi(w.y); v[8 * i + 4] = bflo(w.z); v[8 * i + 5] = bfhi(w.z); v[8 * i + 6] = bflo(w.w); v[8 * i + 7] = bfhi(w.w); }
#pragma unroll
          for (int i = 0; i < 32; ++i) s += v[i] * v[i];
          s += __shfl_xor(s, 1); s += __shfl_xor(s, 2);
          const float rinv = rsqrtf(s * (1.f / 128.f) + EPS);
#pragma unroll
          for (int i = 0; i < 4; ++i)
#pragma unroll
              for (int jx = 0; jx < 8; ++jx) { const int c = 32 * i + 8 * part + jx; *(LAS bf16*)(vnT + c * 272 + q * 2) = (bf16)f2bf(v[8 * i + jx] * rinv * gs[2 * i + (jx >> 2)][jx & 3]); }
#pragma unroll
          for (int i = 0; i < 4; ++i) *(LAS v4u*)(ul + q * 272 + (4 * i + part) * 16) = uw[i]; }
        { const int Tn = (T + G < last) ? T + G : T; issue(Tn); }
        __syncthreads();
        {
#pragma unroll
          for (int ct = 0; ct < 8; ++ct) { f32x4 acc = (f32x4){0.f, 0.f, 0.f, 0.f};
#pragma unroll
              for (int ks = 0; ks < 4; ++ks) { const bf16x8 bv = *(const LAS bf16x8*)(vnT + (16 * ct + fr) * 272 + 64 * ks + 16 * fq); acc = __builtin_amdgcn_mfma_f32_16x16x32_bf16(afr[ks], bv, acc, 0, 0, 0); }
#pragma unroll
              for (int r = 0; r < 4; ++r) { const int pp = 16 * wave + 4 * fq + r, c = 16 * ct + fr; LAS bf16* e = (LAS bf16*)(ul + pp * 272 + c * 2);
                  *e = (bf16)f2bf(bf2f(*e) * (acc[r] + bs[r])); } } }
        __syncthreads();
        { bf16* dst = A2 + (t0 + q) * D + h * 128 + part * 8;
#pragma unroll
          for (int i = 0; i < 4; ++i) *(v4u*)(dst + 32 * i) = *(const LAS v4u*)(ul + q * 272 + (4 * i + part) * 16); }
        __syncthreads();
    }
    asm volatile("s_waitcnt vmcnt(0)" ::: "memory");
}

__device__ __forceinline__ void phase_lru2(const P& p, LAS unsigned char* lds, int tid, int vcu, int G) {
    LAS float* carry = (LAS float*)lds;
    const bf16* UV = (const bf16*)(p.ws + WS_UV); const bf16* HS = (const bf16*)(p.ws + WS_HS); const bf16* PF = (const bf16*)(p.ws + WS_PF); const bf16* PB = (const bf16*)(p.ws + WS_PB);
    const float* SUM = (const float*)(p.ws + WS_SUM); bf16* A2 = (bf16*)(p.ws + WS_A2);
    for (int T = vcu; T < BATCH * 32 * 8; T += G) {
        const int b = T >> 8, gr = (T >> 3) & 31, h = T & 7;
        if (tid < 128) { const int d = tid >> 6, ch = tid & 63; float hc = 0.f;
            const float* S = SUM + ((size_t)b * NSEG * 2 * DLRU + (size_t)d * DLRU + h * 64 + ch) * 2;
            if (d == 0) { for (int s = 0; s < 4 + gr; ++s) { const float A = S[(size_t)s * 2048], B = S[(size_t)s * 2048 + 1]; hc = A * hc + B; } }
            else { for (int s = 3; s >= 0; --s) { const float A = S[(size_t)s * 2048], B = S[(size_t)s * 2048 + 1]; hc = A * hc + B; }
                   for (int s = NSEG - 1; s > 4 + gr; --s) { const float A = S[(size_t)s * 2048], B = S[(size_t)s * 2048 + 1]; hc = A * hc + B; } }
            carry[tid] = hc; }
        __syncthreads();
        for (int i = tid; i < 4096; i += NTHREADS) { const int r = i >> 6, ch = i & 63; const size_t row = (size_t)b * SEQ + gr * 64 + r, o = row * DLRU + h * 64 + ch;
            const float val = bf2f(HS[o]) + bf2f(PF[o]) * carry[ch] + bf2f(PB[o]) * carry[64 + ch];
            A2[row * D + 512 + h * 64 + ch] = (bf16)f2bf(bf2f(UV[row * DIN + 1536 + h * 64 + ch]) * val); }
        __syncthreads();
    }
}


__device__ __forceinline__ void phase_lru2_fast(const P& p, LAS unsigned char* lds, int tid, int vcu, int G) {
    LAS float* carry = (LAS float*)lds;
    constexpr int NQ = LRU2_PARTS, GR = 32 / NQ, GSH = (NQ == 8) ? 2 : 3, CBUF = GR * 2 * 64;
    const bf16* UV = (const bf16*)(p.ws + WS_UV); const bf16* HS = (const bf16*)(p.ws + WS_HS); const bf16* PF = (const bf16*)(p.ws + WS_PF); const bf16* PB = (const bf16*)(p.ws + WS_PB);
    const float* SUM = (const float*)(p.ws + WS_SUM); bf16* A2 = (bf16*)(p.ws + WS_A2);
    typedef float f32x2 __attribute__((ext_vector_type(2)));
    constexpr int NT = 64 * NQ;
    if (vcu >= NT) return;
    const int Tlast = vcu + ((NT - 1 - vcu) / G) * G;
    v4u nhs[GR], npf[GR], npb[GR], ngg[GR]; f32x2 ab[NSEG];
    auto load_rows = [&](int T) { const int b = T / (8 * NQ), h = (T / NQ) & 7, qt = T % NQ;
#pragma unroll
        for (int it = 0; it < GR; ++it) { const int v = it * NTHREADS + tid, pos = v >> 3, c0 = (v & 7) * 8; const size_t row = (size_t)b * SEQ + qt * (64 * GR) + pos, o = row * DLRU + h * 64 + c0;
            nhs[it] = *(const v4u*)(HS + o); npf[it] = *(const v4u*)(PF + o); npb[it] = *(const v4u*)(PB + o); ngg[it] = *(const v4u*)(UV + row * DIN + 1536 + h * 64 + c0); } };
    auto load_sum = [&](int T) { const int b = T / (8 * NQ), h = (T / NQ) & 7; const int d = (tid >> 6) & 1, ch = tid & 63;
        const f32x2* S = (const f32x2*)SUM + ((size_t)b * NSEG * 2 + d) * DLRU + h * 64 + ch;
#pragma unroll
        for (int s2 = 0; s2 < NSEG; ++s2) ab[s2] = S[(size_t)s2 * 2 * DLRU]; };
    auto fold = [&](int T, LAS float* cbuf) { const int qt = T % NQ; const int d = tid >> 6, ch = tid & 63; float hc = 0.f;
        if (d == 0) {
#pragma unroll
            for (int s2 = 0; s2 < NSEG; ++s2) { if (s2 >= 4 && ((s2 - 4) >> GSH) == qt) cbuf[(((s2 - 4) & (GR - 1)) * 2 + 0) * 64 + ch] = hc; hc = ab[s2].x * hc + ab[s2].y; }
        } else {
#pragma unroll
            for (int s2 = 3; s2 >= 0; --s2) hc = ab[s2].x * hc + ab[s2].y;
#pragma unroll
            for (int s2 = NSEG - 1; s2 >= 4; --s2) { if (((s2 - 4) >> GSH) == qt) cbuf[(((s2 - 4) & (GR - 1)) * 2 + 1) * 64 + ch] = hc; hc = ab[s2].x * hc + ab[s2].y; }
        } };
    if (tid < 128) load_sum(vcu);
    load_rows(vcu);
    if (tid < 128) fold(vcu, carry);
    __syncthreads();
    int cb = 0;
    for (int T = vcu; T < NT; T += G) {
        const int b = T / (8 * NQ), h = (T / NQ) & 7, qt = T % NQ, Tn = min(T + G, Tlast);
        v4u hsv[GR], pfv[GR], pbv[GR], ggv[GR];
#pragma unroll
        for (int it = 0; it < GR; ++it) { hsv[it] = nhs[it]; pfv[it] = npf[it]; pbv[it] = npb[it]; ggv[it] = ngg[it]; }
#pragma unroll
        for (int it = 0; it < GR; ++it) asm volatile("" : "+v"(hsv[it]), "+v"(pfv[it]), "+v"(pbv[it]), "+v"(ggv[it]) :: "memory");
        if (tid < 128) load_sum(Tn);
        load_rows(Tn);
        const LAS float* cr = carry + cb * CBUF;
#pragma unroll
        for (int it = 0; it < GR; ++it) { const int v = it * NTHREADS + tid, pos = v >> 3, c0 = (v & 7) * 8, grl = pos >> 6;
            const size_t row = (size_t)b * SEQ + qt * (64 * GR) + pos;
            const v4u hs = hsv[it], pf = pfv[it], pb = pbv[it], gg = ggv[it];
            const f32x4 cf0 = *(const LAS f32x4*)(cr + (grl * 2) * 64 + c0), cf1 = *(const LAS f32x4*)(cr + (grl * 2) * 64 + c0 + 4);
            const f32x4 cb0 = *(const LAS f32x4*)(cr + (grl * 2 + 1) * 64 + c0), cb1 = *(const LAS f32x4*)(cr + (grl * 2 + 1) * 64 + c0 + 4);
            v4u out;
            out.x = pk2(bflo(gg.x) * (bflo(hs.x) + bflo(pf.x) * cf0.x + bflo(pb.x) * cb0.x), bfhi(gg.x) * (bfhi(hs.x) + bfhi(pf.x) * cf0.y + bfhi(pb.x) * cb0.y));
            out.y = pk2(bflo(gg.y) * (bflo(hs.y) + bflo(pf.y) * cf0.z + bflo(pb.y) * cb0.z), bfhi(gg.y) * (bfhi(hs.y) + bfhi(pf.y) * cf0.w + bfhi(pb.y) * cb0.w));
            out.z = pk2(bflo(gg.z) * (bflo(hs.z) + bflo(pf.z) * cf1.x + bflo(pb.z) * cb1.x), bfhi(gg.z) * (bfhi(hs.z) + bfhi(pf.z) * cf1.y + bfhi(pb.z) * cb1.y));
            out.w = pk2(bflo(gg.w) * (bflo(hs.w) + bflo(pf.w) * cf1.z + bflo(pb.w) * cb1.z), bfhi(gg.w) * (bfhi(hs.w) + bfhi(pf.w) * cf1.w + bfhi(pb.w) * cb1.w));
            *(v4u*)(A2 + row * D + 512 + h * 64 + c0) = out; }
        cb ^= 1;
        if (tid < 128) fold(Tn, carry + cb * CBUF);
        __syncthreads();
    }
}

__device__ __forceinline__ void phase_p5(const P& p, LAS unsigned char* lds, int tid, int lane, int wave, int vcu, int G) {
    LAS float* wrT = (LAS float*)lds;
    const float* MOD = (const float*)(p.ws + WS_MOD); const float* X1 = (const float*)(p.ws + WS_X1); bf16* HX2 = (bf16*)(p.ws + WS_HX2); float* AFF = (float*)(p.ws + WS_AFF);
    for (int i = tid; i < D * NE; i += NTHREADS) wrT[(i & 15) * D + (i >> 4)] = p.w_router[i];
    __syncthreads();
    const int gw = vcu * NWAVES + wave, NGW = G * NWAVES;
    f32x4 nx[4];
    if (gw < M) { const f32x4* xr = (const f32x4*)(X1 + (size_t)gw * D) + lane;
#pragma unroll
        for (int jj = 0; jj < 4; ++jj) nx[jj] = xr[64 * jj]; }
    for (int m = gw; m < M; m += NGW) {
        const int b = m >> 11, t = m & 2047;
        f32x4 v[4]; float s = 0.f;
#pragma unroll
        for (int jj = 0; jj < 4; ++jj) { v[jj] = nx[jj]; s += (v[jj].x * v[jj].x + v[jj].y * v[jj].y) + (v[jj].z * v[jj].z + v[jj].w * v[jj].w); }
        if (m + NGW < M) { const f32x4* xr = (const f32x4*)(X1 + (size_t)(m + NGW) * D) + lane;
#pragma unroll
            for (int jj = 0; jj < 4; ++jj) nx[jj] = xr[64 * jj]; }
        const float rinv = rsqrtf(wave_sum(s) * (1.f / D) + EPS);
        v2u* o = (v2u*)(HX2 + (size_t)m * D) + lane;
#pragma unroll
        for (int jj = 0; jj < 4; ++jj) { const int k = 4 * (lane + 64 * jj);
            const f32x4 g = *(const f32x4*)(p.norm2_g + k), sh = *(const f32x4*)(MOD + b * NMOD + 3 * D + k), sc = *(const f32x4*)(MOD + b * NMOD + 4 * D + k);
            v[jj] = v[jj] * rinv * g * (sc + 1.f) + sh;
#if MOE_FP8
            ((unsigned*)(p.ws + WS_HX2) + (size_t)m * (D / 4))[lane + 64 * jj] = pk4_fp8(v[jj].x, v[jj].y, v[jj].z, v[jj].w); }
#else
            v2u w; w.x = pk2(v[jj].x, v[jj].y); w.y = pk2(v[jj].z, v[jj].w); o[64 * jj] = w; }
#endif
        float pa[16];
#pragma unroll
        for (int e = 0; e < 16; ++e) { float a = 0.f;
#pragma unroll
            for (int jj = 0; jj < 4; ++jj) { const f32x4 w = *(const LAS f32x4*)(wrT + e * D + 4 * (lane + 64 * jj)); a += (v[jj].x * w.x + v[jj].y * w.y) + (v[jj].z * w.z + v[jj].w * w.w); }
            pa[e] = a; if (e & 1) asm volatile("" ::: "memory"); }
        { const bool h5 = (lane & 32) != 0; float q8[8];
#pragma unroll
          for (int i = 0; i < 8; ++i) { const float keep = h5 ? pa[8 + i] : pa[i], give = h5 ? pa[i] : pa[8 + i]; q8[i] = keep + __shfl_xor(give, 32); }
          const bool h4 = (lane & 16) != 0; float q4[4];
#pragma unroll
          for (int i = 0; i < 4; ++i) { const float keep = h4 ? q8[4 + i] : q8[i], give = h4 ? q8[i] : q8[4 + i]; q4[i] = keep + __shfl_xor(give, 16); }
          const bool h3 = (lane & 8) != 0; float q2[2];
#pragma unroll
          for (int i = 0; i < 2; ++i) { const float keep = h3 ? q4[2 + i] : q4[i], give = h3 ? q4[i] : q4[2 + i]; q2[i] = keep + __shfl_xor(give, 8); }
          const bool h2 = (lane & 4) != 0;
          float lgt = (h2 ? q2[1] : q2[0]) + __shfl_xor(h2 ? q2[0] : q2[1], 4);
          lgt += __shfl_xor(lgt, 2); lgt += __shfl_xor(lgt, 1);
          float mx = lgt;
#pragma unroll
          for (int o2 = 4; o2 < 64; o2 <<= 1) mx = fmaxf(mx, __shfl_xor(mx, o2));
          const float ex = expf(lgt - mx); float den = ex;
#pragma unroll
          for (int o2 = 4; o2 < 64; o2 <<= 1) den += __shfl_xor(den, o2);
          if ((lane & 3) == 0) AFF[(size_t)(b * NE + (lane >> 2)) * SEQ + t] = ex / den; }
    }
    __syncthreads();
}

__device__ __forceinline__ void phase_p6(const P& p, LAS unsigned char* lds, int tid, int lane, int wave, int vcu, int G) {
    LAS float* a = (LAS float*)lds; LAS int* tok = (LAS int*)(lds + 8192);
    const float* AFF = (const float*)(p.ws + WS_AFF); int* SLOT = (int*)(p.ws + WS_SLOT); float* GATE = (float*)(p.ws + WS_GATE);
    const bf16* HX2 = (const bf16*)(p.ws + WS_HX2); bf16* XE = (bf16*)(p.ws + WS_XE);
    for (int T = vcu; T < BATCH * NE; T += G) {
        const int b = T >> 4, e = T & 15;
        for (int i = tid; i < SEQ; i += NTHREADS) a[i] = AFF[(size_t)(b * NE + e) * SEQ + i];
        __syncthreads();
        float at[4]; int rk[4];
#pragma unroll
        for (int i = 0; i < 4; ++i) { at[i] = a[tid + 512 * i]; rk[i] = 0; }
        for (int t2 = 0; t2 < SEQ; ++t2) { const float av = a[t2];
#pragma unroll
            for (int i = 0; i < 4; ++i) rk[i] += (av > at[i] || (av == at[i] && t2 < tid + 512 * i)) ? 1 : 0; }
#pragma unroll
        for (int i = 0; i < 4; ++i) { const int t = tid + 512 * i; SLOT[(size_t)(b * SEQ + t) * NE + e] = rk[i] < CAP ? rk[i] : -1;
            if (rk[i] < CAP) { tok[rk[i]] = t; GATE[e * 2048 + b * CAP + rk[i]] = at[i]; } }
        __syncthreads();
        for (int r = wave; r < CAP; r += NWAVES) { const v4u* src = (const v4u*)(HX2 + (size_t)(b * SEQ + tok[r]) * D); v4u* dst = (v4u*)(XE + (size_t)(e * 2048 + b * CAP + r) * D);
            dst[lane] = src[lane]; dst[lane + 64] = src[lane + 64]; }
        __syncthreads();
    }
}


__device__ __forceinline__ unsigned block_sum_u(unsigned v, LAS unsigned* red, int lane, int wave) {
    v = (unsigned)wave_sum((float)v);
    if (lane == 0) red[wave] = v;
    __syncthreads();
    unsigned s = 0;
#pragma unroll
    for (int w = 0; w < 8; ++w) s += red[w];
    return s;
}
__device__ __forceinline__ unsigned block_excl_scan(unsigned c, unsigned& total, LAS unsigned* red, int lane, int wave) {
    unsigned inc = c;
#pragma unroll
    for (int o = 1; o < 64; o <<= 1) { const unsigned t = __shfl_up(inc, o); if (lane >= o) inc += t; }
    if (lane == 63) red[wave] = inc;
    __syncthreads();
    unsigned off = 0, tot = 0;
#pragma unroll
    for (int w = 0; w < 8; ++w) { const unsigned x = red[w]; off += (w < wave) ? x : 0u; tot += x; }
    total = tot; return off + inc - c;
}
__device__ __forceinline__ void phase_p6_fast(const P& p, LAS unsigned char* lds, int tid, int lane, int wave, int vcu, int G) {
    LAS unsigned* red = (LAS unsigned*)lds;
    LAS int* tok = (LAS int*)(lds + 2048);
    const float* AFF = (const float*)(p.ws + WS_AFF); int* SLOT = (int*)(p.ws + WS_SLOT); float* GATE = (float*)(p.ws + WS_GATE);
    const bf16* HX2 = (const bf16*)(p.ws + WS_HX2); bf16* XE = (bf16*)(p.ws + WS_XE);
    for (int T = vcu; T < BATCH * NE * 2; T += G) {
        const int half = T & 1, e = (T >> 1) & 15, b = T >> 5;
        const f32x4 av = *(const f32x4*)(AFF + (size_t)(b * NE + e) * SEQ + 4 * tid);
        unsigned bits[4] = {__float_as_uint(av.x), __float_as_uint(av.y), __float_as_uint(av.z), __float_as_uint(av.w)};
        unsigned lo = 0u, hi = 0x3f800000u; int rb = 0;
        while (lo < hi) {
            const unsigned span = hi - lo, q = (span + 3u) >> 2, t1 = lo + q, t2 = min(lo + 2u * q, hi), t3 = min(lo + 3u * q, hi);
            unsigned w = 0;
#pragma unroll
            for (int i = 0; i < 4; ++i) w += (bits[i] >= t1 ? 1u : 0u) + (bits[i] >= t2 ? (1u << 10) : 0u) + (bits[i] >= t3 ? (1u << 20) : 0u);
#pragma unroll
            for (int o = 1; o < 64; o <<= 1) w += __shfl_xor(w, o);
            LAS unsigned* rd = red + 8 * rb; rb = (rb + 1) % 36;
            if (lane == 0) rd[wave] = w;
            __syncthreads();
            unsigned c1 = 0, c2 = 0, c3 = 0;
#pragma unroll
            for (int ww = 0; ww < 8; ++ww) { const unsigned x = rd[ww]; c1 += x & 1023u; c2 += (x >> 10) & 1023u; c3 += x >> 20; }
            if (c3 >= (unsigned)CAP) lo = t3; else if (c2 >= (unsigned)CAP) { lo = t2; hi = t3 - 1u; } else if (c1 >= (unsigned)CAP) { lo = t1; hi = t2 - 1u; } else hi = t1 - 1u;
        }
        const unsigned Tb = lo;
        unsigned cg = 0, ct = 0;
#pragma unroll
        for (int i = 0; i < 4; ++i) { cg += (bits[i] > Tb) ? 1u : 0u; ct += (bits[i] == Tb) ? 1u : 0u; }
        unsigned ngt; const unsigned need = (unsigned)CAP - (ngt = block_sum_u(cg, red + 8 * 36, lane, wave));
        unsigned ttot; unsigned tpre = block_excl_scan(ct, ttot, red + 8 * 37, lane, wave);
        unsigned sel[4], cs = 0;
#pragma unroll
        for (int i = 0; i < 4; ++i) { const bool tie = bits[i] == Tb; sel[i] = (bits[i] > Tb || (tie && tpre < need)) ? 1u : 0u; tpre += tie ? 1u : 0u; cs += sel[i]; }
        unsigned stot; unsigned spre = block_excl_scan(cs, stot, red + 8 * 38, lane, wave);
#pragma unroll
        for (int i = 0; i < 4; ++i) { const int t = 4 * tid + i;
            if ((t >> 10) == half) SLOT[(size_t)(b * SEQ + t) * NE + e] = sel[i] ? (int)spre : -1;
            if (sel[i]) { tok[spre] = t; if ((int)(spre >> 7) == half) GATE[e * 2048 + b * CAP + spre] = __uint_as_float(bits[i]); spre += 1u; } }
        __syncthreads();
#if MOE_FP8
        if (tid < 128) ((int*)(p.ws + WS_TOK))[e * 2048 + b * CAP + half * 128 + tid] = b * SEQ + tok[half * 128 + tid];
#else
        for (int r = half * 128 + wave; r < half * 128 + 128; r += NWAVES) { const v4u* src = (const v4u*)(HX2 + (size_t)(b * SEQ + tok[r]) * D); v4u* dst = (v4u*)(XE + (size_t)(e * 2048 + b * CAP + r) * D);
            dst[lane] = src[lane]; dst[lane + 64] = src[lane + 64]; }
#endif
        __syncthreads();
    }
}

template <bool X1B>
__device__ __forceinline__ void phase_p9(const P& p, int lane, int wave, int vcu, int G) {
    const float* MOD = (const float*)(p.ws + WS_MOD); const float* X1 = (const float*)(p.ws + WS_X1); const int* SLOT = (const int*)(p.ws + WS_SLOT); const bf16* YE = (const bf16*)(p.ws + WS_YE);
    const int gw = vcu * NWAVES + wave, NGW = G * NWAVES;
    f32x4 nx[4]; int nslot = -1;
    auto ldrow = [&](int mm) {
        if constexpr (X1B) { const v2u* xr = (const v2u*)((const bf16*)X1 + (size_t)mm * D) + lane;
#pragma unroll
            for (int jj = 0; jj < 4; ++jj) { const v2u w = xr[64 * jj]; nx[jj] = (f32x4){bflo(w.x), bfhi(w.x), bflo(w.y), bfhi(w.y)}; } }
        else { const f32x4* xr = (const f32x4*)(X1 + (size_t)mm * D) + lane;
#pragma unroll
            for (int jj = 0; jj < 4; ++jj) nx[jj] = xr[64 * jj]; } };
    if (gw < M) { ldrow(gw);
        nslot = SLOT[(size_t)gw * NE + (lane & 15)]; }
    for (int m = gw; m < M; m += NGW) {
        const int b = m >> 11;
        f32x4 v[4], acc[4]; const int myslot = nslot;
#pragma unroll
        for (int jj = 0; jj < 4; ++jj) { v[jj] = nx[jj]; acc[jj] = (f32x4){0.f, 0.f, 0.f, 0.f}; }
        if (m + NGW < M) { ldrow(m + NGW);
            nslot = SLOT[(size_t)(m + NGW) * NE + (lane & 15)]; }
#pragma unroll
        for (int e = 0; e < NE; ++e) { const int sl = __builtin_amdgcn_readlane(myslot, e);
#if MOE_FP8
            if (sl >= 0) { const unsigned* y = (const unsigned*)((const unsigned char*)YE + (size_t)(e * 2048 + b * CAP + sl) * D) + lane;
#pragma unroll
                for (int jj = 0; jj < 4; ++jj) { const unsigned w = y[64 * jj]; const auto lo = __builtin_amdgcn_cvt_pk_f32_fp8((int)w, false), hi = __builtin_amdgcn_cvt_pk_f32_fp8((int)w, true);
                    acc[jj] += (f32x4){lo[0], lo[1], hi[0], hi[1]}; } } }
#else
            if (sl >= 0) { const v2u* y = (const v2u*)(YE + (size_t)(e * 2048 + b * CAP + sl) * D) + lane;
#pragma unroll
                for (int jj = 0; jj < 4; ++jj) { const v2u w = y[64 * jj]; acc[jj] += (f32x4){bflo(w.x), bfhi(w.x), bflo(w.y), bfhi(w.y)}; } } }
#endif
        float s = 0.f;
#pragma unroll
        for (int jj = 0; jj < 4; ++jj) { const int k = 4 * (lane + 64 * jj); const f32x4 g2 = *(const f32x4*)(MOD + b * NMOD + 5 * D + k); v[jj] += g2 * acc[jj] * (MOE_FP8 ? WSCALE_INV : 1.f);
            s += (v[jj].x * v[jj].x + v[jj].y * v[jj].y) + (v[jj].z * v[jj].z + v[jj].w * v[jj].w); }
        const float rinv = rsqrtf(wave_sum(s) * (1.f / D) + EPS);
        f32x4* o = (f32x4*)(p.out + (size_t)m * D) + lane;
#pragma unroll
        for (int jj = 0; jj < 4; ++jj) { const int k = 4 * (lane + 64 * jj); o[64 * jj] = v[jj] * rinv * *(const f32x4*)(p.final_g + k); }
    }
}

__device__ __forceinline__ void p9_finish(const P& p, LAS unsigned char* strip, int lane, int m, const v4u xa, const v4u xb, const f32x2p (&acc)[8], const f32x4 (&g2c)[4], const f32x4 (&fg)[4]) {
    f32x4 v[4];
    v[0] = (f32x4){bflo(xa.x), bfhi(xa.x), bflo(xa.y), bfhi(xa.y)}; v[1] = (f32x4){bflo(xa.z), bfhi(xa.z), bflo(xa.w), bfhi(xa.w)};
    v[2] = (f32x4){bflo(xb.x), bfhi(xb.x), bflo(xb.y), bfhi(xb.y)}; v[3] = (f32x4){bflo(xb.z), bfhi(xb.z), bflo(xb.w), bfhi(xb.w)};
    float s = 0.f;
#pragma unroll
    for (int i = 0; i < 4; ++i) { v[i] += g2c[i] * (f32x4){acc[2 * i].x, acc[2 * i].y, acc[2 * i + 1].x, acc[2 * i + 1].y}; s += (v[i].x * v[i].x + v[i].y * v[i].y) + (v[i].z * v[i].z + v[i].w * v[i].w); }
    const float rinv = rsqrtf(wave_sum(s) * (1.f / D) + EPS);
#pragma unroll
    for (int i = 0; i < 4; ++i) *(LAS f32x4*)(strip + lane * 80 + 16 * i) = v[i] * rinv * fg[i];
    __builtin_amdgcn_fence(__ATOMIC_RELEASE, "wavefront"); __builtin_amdgcn_wave_barrier(); __builtin_amdgcn_fence(__ATOMIC_ACQUIRE, "wavefront");
    f32x4* o = (f32x4*)(p.out + (size_t)m * D) + lane;
#pragma unroll
    for (int jj = 0; jj < 4; ++jj) o[64 * jj] = *(const LAS f32x4*)(strip + ((lane >> 2) + 16 * jj) * 80 + (lane & 3) * 16);
    __builtin_amdgcn_wave_barrier();
}
#define P9_GLD(dst, voff, sbase, OFFS) asm volatile("global_load_dwordx4 %0, %1, %2" OFFS : "=&v"(dst) : "v"(voff), "s"(sbase) : "memory")
__device__ __forceinline__ const unsigned char* uptr(const unsigned char* q) { const unsigned long long v = (unsigned long long)q;
    return (const unsigned char*)(((unsigned long long)(unsigned)__builtin_amdgcn_readfirstlane((int)(v >> 32)) << 32) | (unsigned)__builtin_amdgcn_readfirstlane((int)v)); }
__device__ __forceinline__ void p9_acc(f32x2p (&acc)[8], const v4u w, float sc) {
    const unsigned ww[4] = {w.x, w.y, w.z, w.w};
#pragma unroll
    for (int c = 0; c < 4; ++c) { const f32x2p lo = __builtin_amdgcn_cvt_pk_f32_fp8((int)ww[c], false), hi = __builtin_amdgcn_cvt_pk_f32_fp8((int)ww[c], true); acc[2 * c] += lo * sc; acc[2 * c + 1] += hi * sc; }
}
__device__ __forceinline__ void phase_p9_v2(const P& p, LAS unsigned char* lds, int lane, int wave, int vcu, int G) {
    const float* MOD = (const float*)(p.ws + WS_MOD); const unsigned char* X1b = p.ws + WS_X1; const int* SLOT = (const int*)(p.ws + WS_SLOT); const unsigned char* YE = p.ws + WS_YE;
    const int gw = vcu * NWAVES + wave, m0 = gw * 8, b = m0 >> 11;
    LAS unsigned char* strip = lds + wave * 5120;
    const v2u slv = *(const v2u*)(SLOT + (size_t)m0 * NE + 2 * lane);
    const int sx = (int)slv.x, sy = (int)slv.y;
    f32x4 g2c[4], fg[4];
#pragma unroll
    for (int i = 0; i < 4; ++i) { g2c[i] = *(const f32x4*)(MOD + b * NMOD + 5 * D + 16 * lane + 4 * i) * WSCALE_INV; fg[i] = *(const f32x4*)(p.final_g + 16 * lane + 4 * i); }
    const unsigned long long mk0 = __builtin_amdgcn_ballot_w64(sx >= 0), mk1 = __builtin_amdgcn_ballot_w64(sy >= 0);
#pragma unroll
    for (int i = 0; i < 4; ++i) asm volatile("" : "+v"(g2c[i]), "+v"(fg[i]) :: "memory");
    const int xoff = 32 * lane, yoff = 16 * lane;
    auto entries = [&](int r, int (&yr)[4], float (&sc)[4], unsigned& rest) { unsigned em = ((unsigned)(mk0 >> (8 * r)) & 0xffu) | (((unsigned)(mk1 >> (8 * r)) & 0xffu) << 8);
#pragma unroll
        for (int i = 0; i < 4; ++i) { yr[i] = 0; sc[i] = 0.f;
            if (em) { const int pos = __builtin_ctz(em); em &= em - 1u; const int j = pos & 7, c = pos >> 3; const int sa = __builtin_amdgcn_readlane(sx, 8 * r + j), sb = __builtin_amdgcn_readlane(sy, 8 * r + j);
                yr[i] = (2 * j + c) * 2048 + b * CAP + (c ? sb : sa); sc[i] = 1.f; } }
        rest = em; };
#define P9_ISSUE(S, rr) do { const int r_ = min((rr), 7); int yr_[4]; float sc_[4]; unsigned rest_; entries(r_, yr_, sc_, rest_); \
        const unsigned char* xb_ = uptr(X1b + (size_t)(m0 + r_) * (D * 2)); \
        P9_GLD(X##S##0, xoff, xb_, ""); P9_GLD(X##S##1, xoff, xb_, " offset:16"); \
        P9_GLD(Y##S##0, yoff, uptr(YE + (size_t)yr_[0] * D), ""); P9_GLD(Y##S##1, yoff, uptr(YE + (size_t)yr_[1] * D), ""); \
        P9_GLD(Y##S##2, yoff, uptr(YE + (size_t)yr_[2] * D), ""); P9_GLD(Y##S##3, yoff, uptr(YE + (size_t)yr_[3] * D), ""); } while (0)
#define P9_WAIT(S, n) asm volatile("s_waitcnt vmcnt(%6) ; retires %0 %1 %2 %3 %4 %5" : "+v"(X##S##0), "+v"(X##S##1), "+v"(Y##S##0), "+v"(Y##S##1), "+v"(Y##S##2), "+v"(Y##S##3) : "n"(n) : "memory")
#define P9_PROC(S, rr) do { const int r_ = (rr); int yr_[4]; float sc_[4]; unsigned rest_; entries(r_, yr_, sc_, rest_); \
        f32x2p acc_[8]; _Pragma("unroll") for (int i = 0; i < 8; ++i) acc_[i] = (f32x2p){0.f, 0.f}; \
        p9_acc(acc_, Y##S##0, sc_[0]); p9_acc(acc_, Y##S##1, sc_[1]); p9_acc(acc_, Y##S##2, sc_[2]); p9_acc(acc_, Y##S##3, sc_[3]); \
        while (rest_) { const int pos = __builtin_ctz(rest_); rest_ &= rest_ - 1u; const int j = pos & 7, c = pos >> 3; const int sa = __builtin_amdgcn_readlane(sx, 8 * r_ + j), sb = __builtin_amdgcn_readlane(sy, 8 * r_ + j); \
            const v4u w_ = *(const v4u*)(YE + (size_t)((2 * j + c) * 2048 + b * CAP + (c ? sb : sa)) * D + yoff); p9_acc(acc_, w_, 1.f); } \
        p9_finish(p, strip, lane, m0 + r_, X##S##0, X##S##1, acc_, g2c, fg); } while (0)
    v4u XA0, XA1, YA0, YA1, YA2, YA3, XB0, XB1, YB0, YB1, YB2, YB3, XC0, XC1, YC0, YC1, YC2, YC3;
    P9_ISSUE(A, 0); P9_ISSUE(B, 1);
    for (int it = 0; it < 3; ++it) { const int r = 3 * it;
        P9_ISSUE(C, r + 2); if (it == 0) asm volatile("s_waitcnt vmcnt(12)" ::: "memory"); P9_WAIT(A, 20); P9_PROC(A, r);
        P9_ISSUE(A, r + 3); if (it == 0) asm volatile("s_waitcnt vmcnt(16)" ::: "memory"); P9_WAIT(B, 20); P9_PROC(B, r + 1);
        P9_ISSUE(B, r + 4); P9_WAIT(C, 20); if (r + 2 < 8) P9_PROC(C, r + 2);
    }
    asm volatile("s_waitcnt vmcnt(0)" ::: "memory");
}

#if CONV_CUS && MOE_FP8 && XCD_BAR && LRU1_MFMA && SGU_MFMA && LRU2_FAST && P6_FAST && USE_PG8 && (MK_N_LAUNCHES == 1)
__global__ void __launch_bounds__(NTHREADS, 2) fwd_megakernel(P p) {
    extern __shared__ __attribute__((aligned(16))) unsigned char lds_raw[];
    LAS unsigned char* lds = (LAS unsigned char*)lds_raw;
    const int tid = threadIdx.x, lane = tid & 63, wave = __builtin_amdgcn_readfirstlane(tid >> 6);
    const int G = gridDim.x, bx = blockIdx.x, xg = bx & 7, xl = bx >> 3;
    const int vcu = (G % 8 == 0) ? xg * (G / 8) + xl : bx;
    constexpr int CSH = (NCONV == 64) ? 2 : 3, CPG = 32 >> CSH, WPG = 32 - CPG;
    const bool split = (G == 256), is_conv = split && ((xl & ((1 << CSH) - 1)) == (1 << CSH) - 1);
    const int GW = split ? 8 * WPG : G, wvcu = split ? xg * WPG + (xl - (xl >> CSH)) : vcu, cvcu = xg * CPG + (xl >> CSH);
    volatile LAS unsigned* bst = (volatile LAS unsigned*)(lds + LDS_BYTES - 16);
    if (tid < 4) bst[tid] = 0u;
    __syncthreads();
    unsigned* ctl = (unsigned*)(p.ws + WS_CTL);
    const XcdBarrier barA = xcd_barrier_post(ctl + 4096, bst, (unsigned)G);
    XcdBarrier barW = barA;
    if (split && !is_conv) barW = xcd_barrier_post(ctl + 4096 + XCD_BAR_WORDS, bst + 2, (unsigned)GW);

    if (is_conv) {
        convert_pipelined(p, lds, lane, wave, CONV_HEAD, CONV_ITEMS, cvcu * NWAVES + wave, 8 * CPG * NWAVES);
        if (tid == 0) { XB_SPIN(xb_ld(ctl + 64) == 0u, ctl + 4096); __builtin_amdgcn_fence(__ATOMIC_ACQUIRE, "agent"); asm volatile("s_waitcnt vmcnt(0)" ::: "memory"); }
        __syncthreads();
        phase_sgu_mfma(p, lds, tid, lane, wave, cvcu, 8 * CPG, 0, SGU_CONV_TASKS);
    } else {
        phase_p0(p, lds, tid, lane, wave, wvcu, GW, split ? 16 * 32 : CONV_ITEMS, !split);
        xcd_barrier(barW);
        phase_p1(p, lane, wave, wvcu, GW);
        if (split) { convert_items(p, lds, lane, wave, 16 * 32, CONV_HEAD, wvcu * NWAVES + wave, GW * NWAVES); p0_small_copies(p, tid, wvcu, GW); }
        xcd_barrier(barW);
        { pg8::Gemm g{(const bf16*)(p.ws + WS_HX), (const bf16*)(p.ws + WS_WIN), D}; SchedG1 S{GW, wvcu}; EpiG1 E{(bf16*)(p.ws + WS_UV), (bf16*)(p.ws + WS_XC)};
          pg8::gemm_phase<EpiG1, SchedG1, true, true>(lds, g, S, E); }
        xcd_barrier(barW);
        if (split && wvcu == 0 && tid == 0) __hip_atomic_store(ctl + 64, 1u, __ATOMIC_RELAXED, __HIP_MEMORY_SCOPE_AGENT);
#if LRU1_V2
        phase_lru1_v2(p, lds, tid, lane, wave, wvcu, GW);
#else
        phase_lru1_mfma(p, lds, tid, lane, wave, wvcu, GW);
#endif
        phase_sgu_mfma(p, lds, tid, lane, wave, wvcu, GW, split ? SGU_CONV_TASKS : 0, 512);
        xcd_barrier(barW);
        phase_lru2_fast(p, lds, tid, wvcu, GW);
    }
    xcd_barrier(barA);
    if (split) {
        pg8::Gemm g{(const bf16*)(p.ws + WS_A2), (const bf16*)(p.ws + WS_WOUT), D}; SchedG2 S{G, vcu};
        EpiG2F E{p.x, (const float*)(p.ws + WS_MOD), (float*)(p.ws + WS_X1), p.w_router, p.norm2_g, (const float*)(p.ws + WS_CB), (float*)(p.ws + WS_XCH), ctl + 2048, ctl + 4096, p.ws + WS_HX2, (float*)(p.ws + WS_AFF)};
        pg8::gemm_phase<EpiG2F, SchedG2, true, true>(lds, g, S, E);
    } else {
        { pg8::Gemm g{(const bf16*)(p.ws + WS_A2), (const bf16*)(p.ws + WS_WOUT), D}; SchedG2 S{G, vcu}; EpiG2 E{p.x, (const float*)(p.ws + WS_MOD), (float*)(p.ws + WS_X1)};
          pg8::gemm_phase<EpiG2, SchedG2, true, true>(lds, g, S, E); }
        xcd_barrier(barA);
        phase_p5(p, lds, tid, lane, wave, vcu, G);
    }
    xcd_barrier(barA);
    phase_p6_fast(p, lds, tid, lane, wave, vcu, G);
    xcd_barrier(barA);
    { pg8::Gemm g{(const bf16*)(p.ws + WS_HX2), (const bf16*)(p.ws + WS_WG), D}; SchedG3 S{G, vcu}; EpiG3 E{p.ws + WS_HID};
      pg8::gemm_phase_f8g<EpiG3, SchedG3, true, true>(lds, g, S, E, (const int*)(p.ws + WS_TOK)); }
    xcd_barrier(barA);
    { pg8::Gemm g{(const bf16*)(p.ws + WS_HID), (const bf16*)(p.ws + WS_W2), DE}; SchedG4 S{G, vcu}; EpiG4 E{(const float*)(p.ws + WS_GATE), p.ws + WS_YE};
      pg8::gemm_phase_f8<EpiG4, SchedG4, true, true>(lds, g, S, E); }
    xcd_barrier(barA);
    if (split) phase_p9_v2(p, lds, lane, wave, vcu, G); else phase_p9<false>(p, lane, wave, vcu, G);
}
#else
__global__ void __launch_bounds__(NTHREADS, 2) fwd_megakernel(P p) {
    extern __shared__ __attribute__((aligned(16))) unsigned char lds_raw[];
    LAS unsigned char* lds = (LAS unsigned char*)lds_raw;
    const int tid = threadIdx.x, lane = tid & 63, wave = __builtin_amdgcn_readfirstlane(tid >> 6);
    const int G = gridDim.x, bx = blockIdx.x, vcu = (G % 8 == 0) ? (bx % 8) * (G / 8) + bx / 8 : bx;
    const int lo = p.ph_lo, hi = p.ph_hi;
#if XCD_BAR
    volatile LAS unsigned* bst = (volatile LAS unsigned*)(lds + LDS_BYTES - 16);
    if (tid < 2) bst[tid] = 0u;
    __syncthreads();
    XcdBarrier bar; bar.bar = (unsigned*)(p.ws + WS_CTL) + 4096; bar.x = 0; bar.st = bst; bar.total = (unsigned)G;
    if (hi - lo > 1) bar = xcd_barrier_post((unsigned*)(p.ws + WS_CTL) + 4096, bst, (unsigned)G);
#define GRID_SYNC() xcd_barrier(bar)
#else
    cg::grid_group grid = cg::this_grid();
#define GRID_SYNC() grid.sync()
#endif
#define IN(k) (lo <= (k) && (k) < hi)
#define SEAM(k) do { if (IN(k) && IN((k) + 1)) GRID_SYNC(); } while (0)
#define REP(k) for (int rep_ = 0; rep_ < 1 + ((DUP_MASK >> (k)) & 1); ++rep_)
    if (IN(0)) { REP(0) { phase_p0(p, lds, tid, lane, wave, vcu, G, CONV_CUT); __syncthreads(); } SEAM(0); }
    if (IN(1)) { REP(1) phase_p1(p, lane, wave, vcu, G); SEAM(1); }
    if ((DUP_MASK >> 12) & 1) { for (int xb = 0; xb < 8; ++xb) GRID_SYNC(); }
    if (IN(2)) { pg8::Gemm g{(const bf16*)(p.ws + WS_HX), (const bf16*)(p.ws + WS_WIN), D}; SchedG1 S{G, vcu}; EpiG1 E{(bf16*)(p.ws + WS_UV), (bf16*)(p.ws + WS_XC)};
        REP(2) { gemm_any(lds, g, S, E); if (G > 16 && vcu >= 16) convert_items(p, lds, lane, wave, CONV_CUT, CONV_ITEMS, (vcu - 16) * NWAVES + wave, (G - 16) * NWAVES); }
        if (G <= 16) convert_items(p, lds, lane, wave, CONV_CUT, CONV_ITEMS, vcu * NWAVES + wave, G * NWAVES);
        SEAM(2); }
    if (IN(3)) { REP(3) {
#if LRU1_MFMA
        phase_lru1_mfma(p, lds, tid, lane, wave, vcu, G);
#else
        phase_lru1(p, lds, tid, vcu, G);
#endif
        } REP(11) {
#if SGU_MFMA
        phase_sgu_mfma(p, lds, tid, lane, wave, vcu, G);
#else
        phase_sgu(p, lds, tid, vcu, G);
#endif
        } SEAM(3); }
    if (IN(4)) { REP(4) {
#if LRU2_FAST
        phase_lru2_fast(p, lds, tid, vcu, G);
#else
        phase_lru2(p, lds, tid, vcu, G);
#endif
        } SEAM(4); }
    if (IN(5)) { pg8::Gemm g{(const bf16*)(p.ws + WS_A2), (const bf16*)(p.ws + WS_WOUT), D}; SchedG2 S{G, vcu}; EpiG2 E{p.x, (const float*)(p.ws + WS_MOD), (float*)(p.ws + WS_X1)};
        REP(5) gemm_any(lds, g, S, E); SEAM(5); }
    if (IN(6)) { REP(6) phase_p5(p, lds, tid, lane, wave, vcu, G); SEAM(6); }
    if (IN(7)) { REP(7) {
#if P6_FAST
        phase_p6_fast(p, lds, tid, lane, wave, vcu, G);
#else
        phase_p6(p, lds, tid, lane, wave, vcu, G);
#endif
        } SEAM(7); }
#if MOE_FP8
    if (IN(8)) { pg8::Gemm g{(const bf16*)(p.ws + WS_XE), (const bf16*)(p.ws + WS_WG), D}; SchedG3 S{G, vcu}; EpiG3 E{p.ws + WS_HID};
        REP(8) pg8::gemm_phase_f8<EpiG3, SchedG3, true, true>(lds, g, S, E); SEAM(8); }
    if (IN(9)) { pg8::Gemm g{(const bf16*)(p.ws + WS_HID), (const bf16*)(p.ws + WS_W2), DE}; SchedG4 S{G, vcu}; EpiG4 E{(const float*)(p.ws + WS_GATE), p.ws + WS_YE};
        REP(9) pg8::gemm_phase_f8<EpiG4, SchedG4, true, true>(lds, g, S, E); SEAM(9); }
#else
    if (IN(8)) { pg8::Gemm g{(const bf16*)(p.ws + WS_XE), (const bf16*)(p.ws + WS_WG), D}; SchedG3 S{G, vcu}; EpiG3 E{(bf16*)(p.ws + WS_HID)};
        REP(8) gemm_any(lds, g, S, E); SEAM(8); }
    if (IN(9)) { pg8::Gemm g{(const bf16*)(p.ws + WS_HID), (const bf16*)(p.ws + WS_W2), DE}; SchedG4 S{G, vcu}; EpiG4 E{(const float*)(p.ws + WS_GATE), (bf16*)(p.ws + WS_YE)};
        REP(9) gemm_any(lds, g, S, E); SEAM(9); }
#endif
    if (IN(10)) { REP(10) phase_p9<false>(p, lane, wave, vcu, G); }
#undef IN
#undef REP
#undef SEAM
#undef GRID_SYNC
}

#endif

extern "C" void kernel_launch(void* const* d_in, const int* in_sizes, int n_in, void* d_out, int out_size, void* d_ws, size_t ws_size, hipStream_t stream) {
    static int grid = 0;
    if (grid == 0) {
        if (n_in != 25 || in_sizes[0] != M * D || out_size != M * D || ws_size < WS_END) { fprintf(stderr, "kernel_launch: unexpected shapes (n_in %d, in0 %d, out %d, ws %zu < %zu)\n", n_in, n_in > 0 ? in_sizes[0] : -1, out_size, ws_size, (size_t)WS_END); grid = -1; return; }
        int dev = 0, cus = 0, per_cu = 0;
        if (hipGetDevice(&dev) != hipSuccess || hipDeviceGetAttribute(&cus, hipDeviceAttributeMultiprocessorCount, dev) != hipSuccess) { grid = -1; return; }
        if (hipFuncSetAttribute((const void*)fwd_megakernel, hipFuncAttributeMaxDynamicSharedMemorySize, LDS_BYTES) != hipSuccess) { fprintf(stderr, "kernel_launch: hipFuncSetAttribute failed\n"); grid = -1; return; }
        if (hipOccupancyMaxActiveBlocksPerMultiprocessor(&per_cu, (const void*)fwd_megakernel, NTHREADS, LDS_BYTES) != hipSuccess || per_cu < 1) { fprintf(stderr, "kernel_launch: occupancy query failed (%d)\n", per_cu); (void)hipGetLastError(); grid = -1; return; }
        grid = cus * per_cu;
    }
    if (grid < 0) return;
#if XCD_BAR
    if (hipMemsetAsync((char*)d_ws + WS_CTL, 0, 65536, stream) != hipSuccess) { fprintf(stderr, "kernel_launch: hipMemsetAsync failed\n"); return; }
#endif
    P p{};
    const float** f = (const float**)&p;
    for (int i = 0; i < 25; ++i) f[i] = (const float*)d_in[i];
    p.out = (float*)d_out; p.ws = (unsigned char*)d_ws;
#if MK_N_LAUNCHES == 1
    p.ph_lo = 0; p.ph_hi = NPH; void* args[] = {&p};
    hipError_t e = hipLaunchCooperativeKernel((const void*)fwd_megakernel, dim3(grid), dim3(NTHREADS), args, LDS_BYTES, stream);
    if (e != hipSuccess) fprintf(stderr, "kernel_launch: cooperative launch failed: %s (grid %d)\n", hipGetErrorString(e), grid);
#else
    for (int ph = 0; ph < NPH; ++ph) { p.ph_lo = ph; p.ph_hi = ph + 1; hipLaunchKernelGGL(fwd_megakernel, dim3(grid), dim3(NTHREADS), LDS_BYTES, stream, p); }
#endif
}
```

```cpp
#include <hip/hip_runtime.h>
#include <hip/hip_cooperative_groups.h>
#include <cstdio>
#include <cstdint>
namespace cg = cooperative_groups;

#ifndef MK_N_LAUNCHES
#define MK_N_LAUNCHES 1
#endif
#ifndef XCD_BAR
#define XCD_BAR 1
#endif
#ifndef LRU1_MFMA
#define LRU1_MFMA 1
#endif
#ifndef SGU_MFMA
#define SGU_MFMA 1
#endif
#ifndef P6_FAST
#define P6_FAST 1
#endif
#ifndef DUP_MASK
#define DUP_MASK 0
#endif
#ifndef LRU2_FAST
#define LRU2_FAST 1
#endif
#ifndef MOE_FP8
#define MOE_FP8 1
#endif
#ifndef CONV_CUS
#define CONV_CUS 1
#endif
#ifndef NCONV
#define NCONV 64
#endif
#ifndef LRU1_V2
#define LRU1_V2 1
#endif
#ifndef SGU_CONV_TASKS
#define SGU_CONV_TASKS 128
#endif
#ifndef LRU2_PARTS
#define LRU2_PARTS 8
#endif
#ifndef USE_PG8
#define USE_PG8 1
#endif

namespace pg8 {
#define PG8_LAS __attribute__((address_space(3)))
typedef unsigned short bf16_t;
typedef short bf16x8 __attribute__((ext_vector_type(8)));
typedef float f32x4 __attribute__((ext_vector_type(4)));
typedef unsigned u32x4 __attribute__((ext_vector_type(4)));
typedef int v4i_t __attribute__((ext_vector_type(4)));
typedef int v8i_t __attribute__((ext_vector_type(8)));
constexpr int BM = 256, BK = 64, HALF = 128, HTB = HALF * BK * 2  , STAGE_BYTES = 8 * HTB;

__host__ __device__ __forceinline__ int lds_byte(int r, int c) { const int st = (r >> 4) * 2 + (c >> 5), rr = r & 15, cc = c & 31, ob = rr * 64 + cc * 2; return st * 1024 + (ob ^ (((ob >> 9) & 1) << 5)); }
__host__ __device__ __forceinline__ void stage_rc(int b, int& R, int& C) { const int st = b / 1024, sb = b % 1024, swz = sb ^ (((sb >> 9) & 1) << 5); R = (st >> 1) * 16 + swz / 64; C = (st & 1) * 32 + (swz % 64) / 2; }

struct Unit { int pm, pn, pnB; };
struct Gemm { const bf16_t* A; const bf16_t* Bt; int K; };

template <class Epi>
__device__ __forceinline__ void run_epi8(const Epi& E, const f32x4 (&acc)[2][2][4][2], const Unit& u, int wr, int wc, int fr, int fq) {
#pragma unroll
    for (int ai = 0; ai < 2; ++ai)
#pragma unroll
        for (int m = 0; m < 4; ++m) { const int row = ai * HALF + wr * 64 + m * 16 + fr;
            if constexpr (Epi::PAIRED) E.st2x8(u, row, wc * 32 + 8 * fq, acc[ai][0][m][0], acc[ai][0][m][1], acc[ai][1][m][0], acc[ai][1][m][1]);
            else {
#pragma unroll
                for (int bj = 0; bj < 2; ++bj) E.st8(u, row, bj * HALF + wc * 32 + 8 * fq, acc[ai][bj][m][0], acc[ai][bj][m][1]);
            } }
}
template <class Epi>
__device__ __forceinline__ void run_epi(const Epi& E, const f32x4 (&acc)[2][2][4][2], const Unit& u, int wr, int wc, int fr, int fq) {
#pragma unroll
    for (int ai = 0; ai < 2; ++ai)
#pragma unroll
        for (int m = 0; m < 4; ++m) { const int row = ai * HALF + wr * 64 + m * 16 + fr;
            if constexpr (Epi::PAIRED) {
#pragma unroll
                for (int n = 0; n < 2; ++n) E.st2(u, row, wc * 32 + n * 16 + 4 * fq, acc[ai][0][m][n], acc[ai][1][m][n]);
            } else {
#pragma unroll
                for (int bj = 0; bj < 2; ++bj)
#pragma unroll
                    for (int n = 0; n < 2; ++n) E.st(u, row, bj * HALF + wc * 32 + n * 16 + 4 * fq, acc[ai][bj][m][n]);
            } }
}

template <class Epi, class Sched, bool ALIGN_EPI = false, bool SP2 = false>
__device__ __forceinline__ void gemm_phase(PG8_LAS unsigned char* lds, const Gemm g, const Sched& S, const Epi& E) {
    const int tid = threadIdx.x, wid = __builtin_amdgcn_readfirstlane(tid >> 6), lane = tid & 63, wr = wid >> 2, wc = wid & 3, fr = lane & 15, fq = lane >> 4;
    const int K = g.K, nt = K / BK;
    unsigned voffA[2], voffB[2];
#pragma unroll
    for (int i = 0; i < 2; ++i) { int R, C; stage_rc(tid * 16 + i * 8192, R, C); const int rho = R & 31, Rb = (R & ~31) + 8 * ((rho & 15) >> 2) + 4 * (rho >> 4) + (rho & 3);
        voffA[i] = (unsigned)(R * K + C) * 2u; voffB[i] = (unsigned)(Rb * K + C) * 2u; }
    const size_t kstep = (size_t)(BK * 2);
    const size_t hstep = (size_t)HALF * K * 2;
    const size_t tstep = 2 * hstep;
    const unsigned ldsw = (unsigned)wid * 1024u;
    const int aoff = lds_byte(wr * 64 + fr, fq * 8), boff = lds_byte(wc * 32 + fr, fq * 8);
#define PG8_SA(b, h) (((b) * 2 + (h)) * HTB)
#define PG8_SB(b, h) ((4 + (b) * 2 + (h)) * HTB)
#define PG8_STAGE(bufoff, gbase, voff) do { _Pragma("unroll") for (int _i = 0; _i < 2; ++_i) \
        __builtin_amdgcn_global_load_lds((const unsigned*)((const char*)(gbase) + (voff)[_i]), (PG8_LAS unsigned*)(lds + (bufoff) + ldsw + _i * 8192), 16, 0, 0); } while (0)
#define PG8_LDA(dst, b, h) do { _Pragma("unroll") for (int m = 0; m < 4; ++m) _Pragma("unroll") for (int k = 0; k < 2; ++k) dst[m][k] = *(const PG8_LAS bf16x8*)(lds + PG8_SA(b, h) + aoff + m * 2048 + k * 1024); } while (0)
#define PG8_LDB(dst, b, h) do { _Pragma("unroll") for (int n = 0; n < 2; ++n) _Pragma("unroll") for (int k = 0; k < 2; ++k) dst[n][k] = *(const PG8_LAS bf16x8*)(lds + PG8_SB(b, h) + boff + n * 2048 + k * 1024); } while (0)
#define PG8_MMA(ai, bj, At, Bt) do { __builtin_amdgcn_s_setprio(1); _Pragma("unroll") for (int m = 0; m < 4; ++m) _Pragma("unroll") for (int n = 0; n < 2; ++n) _Pragma("unroll") for (int k = 0; k < 2; ++k) \
        acc[ai][bj][m][n] = __builtin_amdgcn_mfma_f32_16x16x32_bf16(Bt[n][k], At[m][k], acc[ai][bj][m][n], 0, 0, 0); __builtin_amdgcn_s_setprio(0); } while (0)
#define PG8_WAIT_V(n) asm volatile("s_waitcnt vmcnt(" #n ")" ::: "memory")
#define PG8_WAIT_L(n) asm volatile("s_waitcnt lgkmcnt(" #n ")" ::: "memory")
#define PG8_BAR __builtin_amdgcn_s_barrier()
#define PG8_SCHED __builtin_amdgcn_sched_barrier(0)
    Unit cur, nxt; int ui = 0;
    if (!S.next(0, cur)) return;
    f32x4 acc[2][2][4][2];
#pragma unroll
    for (int a = 0; a < 2; ++a)
#pragma unroll
        for (int b = 0; b < 2; ++b)
#pragma unroll
            for (int m = 0; m < 4; ++m)
#pragma unroll
                for (int n = 0; n < 2; ++n) acc[a][b][m][n] = (f32x4){0.f, 0.f, 0.f, 0.f};
    bf16x8 At[4][2], B0[2][2], B1[2][2];
    const char* cA = (const char*)g.A + (size_t)cur.pm * tstep; const char* cB = (const char*)g.Bt + (size_t)cur.pnB * tstep;

    if constexpr (SP2) {
        PG8_STAGE(PG8_SB(0, 0), cB, voffB); PG8_STAGE(PG8_SB(0, 1), cB + hstep, voffB); PG8_STAGE(PG8_SA(0, 0), cA, voffA); PG8_STAGE(PG8_SA(0, 1), cA + hstep, voffA);
        if (wr == 1) PG8_BAR;
        PG8_WAIT_V(2); PG8_BAR;
        PG8_STAGE(PG8_SB(1, 0), cB + kstep, voffB); PG8_STAGE(PG8_SA(1, 0), cA + kstep, voffA); PG8_STAGE(PG8_SB(1, 1), cB + hstep + kstep, voffB);
        PG8_WAIT_V(6); PG8_BAR;
    } else {
        PG8_STAGE(PG8_SB(0, 0), cB, voffB); PG8_STAGE(PG8_SA(0, 0), cA, voffA); PG8_STAGE(PG8_SB(0, 1), cB + hstep, voffB); PG8_STAGE(PG8_SA(0, 1), cA + hstep, voffA);
        if (wr == 1) PG8_BAR;
        PG8_WAIT_V(4); PG8_BAR;
        PG8_STAGE(PG8_SB(1, 0), cB + kstep, voffB); PG8_STAGE(PG8_SA(1, 0), cA + kstep, voffA); PG8_STAGE(PG8_SB(1, 1), cB + hstep + kstep, voffB);
        PG8_WAIT_V(6); PG8_BAR;
    }
    for (;;) {
        const bool has_next = S.next(ui + 1, nxt);
        const char* nA = has_next ? (const char*)g.A + (size_t)nxt.pm * tstep : cA; const char* nB = has_next ? (const char*)g.Bt + (size_t)nxt.pnB * tstep : cB;
        for (int t = 0; t < nt; t += 2) {
            const bool last = (t == nt - 2);
            const char* a1 = cA + (size_t)(t + 1) * kstep;
            const char* a2 = last ? nA : cA + (size_t)(t + 2) * kstep; const char* b2 = last ? nB : cB + (size_t)(t + 2) * kstep;
            const char* a3 = a2 + kstep; const char* b3 = b2 + kstep;

            if constexpr (SP2) {
            PG8_LDB(B0, 0, 0); PG8_LDB(B1, 0, 1); PG8_SCHED; PG8_LDA(At, 0, 0); PG8_STAGE(PG8_SA(1, 1), a1 + hstep, voffA);
            PG8_WAIT_V(8); PG8_WAIT_L(0); PG8_BAR; PG8_MMA(0, 0, At, B0); PG8_MMA(0, 1, At, B1); PG8_BAR; PG8_SCHED;
            PG8_LDA(At, 0, 1); PG8_STAGE(PG8_SB(0, 0), b2, voffB); PG8_STAGE(PG8_SB(0, 1), b2 + hstep, voffB); PG8_STAGE(PG8_SA(0, 0), a2, voffA);
            PG8_WAIT_V(8); PG8_WAIT_L(0); PG8_BAR; PG8_MMA(1, 0, At, B0); PG8_MMA(1, 1, At, B1); PG8_BAR; PG8_SCHED;
            PG8_LDB(B0, 1, 0); PG8_LDB(B1, 1, 1); PG8_SCHED; PG8_LDA(At, 1, 0); PG8_STAGE(PG8_SA(0, 1), a2 + hstep, voffA);
            PG8_WAIT_V(8); PG8_WAIT_L(0); PG8_BAR; PG8_MMA(0, 0, At, B0); PG8_MMA(0, 1, At, B1); PG8_BAR; PG8_SCHED;
            PG8_LDA(At, 1, 1); PG8_STAGE(PG8_SB(1, 0), b3, voffB); PG8_STAGE(PG8_SB(1, 1), b3 + hstep, voffB); PG8_STAGE(PG8_SA(1, 0), a3, voffA);
            PG8_WAIT_V(8); PG8_WAIT_L(0); PG8_BAR; PG8_MMA(1, 0, At, B0); PG8_MMA(1, 1, At, B1); PG8_BAR; PG8_SCHED;
            } else {
            PG8_LDB(B0, 0, 0); PG8_SCHED; PG8_LDA(At, 0, 0); PG8_STAGE(PG8_SA(1, 1), a1 + hstep, voffA);
            PG8_WAIT_L(8); PG8_BAR; PG8_WAIT_L(0); PG8_MMA(0, 0, At, B0); PG8_BAR; PG8_SCHED;
            PG8_LDB(B1, 0, 1); PG8_STAGE(PG8_SB(0, 0), b2, voffB);
            PG8_BAR; PG8_WAIT_L(0); PG8_MMA(0, 1, At, B1); PG8_BAR;
            PG8_LDA(At, 0, 1); PG8_STAGE(PG8_SA(0, 0), a2, voffA);
            PG8_BAR; PG8_WAIT_L(0); PG8_MMA(1, 0, At, B0); PG8_BAR; PG8_SCHED;
            PG8_STAGE(PG8_SB(0, 1), b2 + hstep, voffB);
            PG8_WAIT_V(6); PG8_BAR; PG8_MMA(1, 1, At, B1); PG8_BAR;
            PG8_LDB(B0, 1, 0); PG8_SCHED; PG8_LDA(At, 1, 0); PG8_STAGE(PG8_SA(0, 1), a2 + hstep, voffA);
            PG8_WAIT_L(8); PG8_BAR; PG8_WAIT_L(0); PG8_MMA(0, 0, At, B0); PG8_BAR; PG8_SCHED;
            PG8_LDB(B1, 1, 1); PG8_STAGE(PG8_SB(1, 0), b3, voffB);
            PG8_BAR; PG8_WAIT_L(0); PG8_MMA(0, 1, At, B1); PG8_BAR;
            PG8_LDA(At, 1, 1); PG8_STAGE(PG8_SA(1, 0), a3, voffA);
            PG8_BAR; PG8_WAIT_L(0); PG8_MMA(1, 0, At, B0); PG8_BAR; PG8_SCHED;
            PG8_STAGE(PG8_SB(1, 1), b3 + hstep, voffB);
            PG8_WAIT_V(6); PG8_BAR; PG8_MMA(1, 1, At, B1); PG8_BAR;
            }
        }
        if constexpr (ALIGN_EPI) { if (wr == 0) PG8_BAR; }
        if constexpr (!Epi::FUSED) run_epi8(E, acc, cur, wr, wc, fr, fq);
        if (!has_next) break;
#pragma unroll
        for (int a = 0; a < 2; ++a)
#pragma unroll
            for (int b = 0; b < 2; ++b)
#pragma unroll
                for (int m = 0; m < 4; ++m)
#pragma unroll
                    for (int n = 0; n < 2; ++n) acc[a][b][m][n] = (f32x4){0.f, 0.f, 0.f, 0.f};
        cur = nxt; cA = nA; cB = nB; ++ui;
        if constexpr (ALIGN_EPI) { if (wr == 1) PG8_BAR; }
    }
    PG8_WAIT_V(0);
    if constexpr (!ALIGN_EPI) { if (wr == 0) PG8_BAR; }
    PG8_BAR;
    if constexpr (Epi::FUSED) E.fused(acc, cur, wr, wc, fr, fq, lds, wid, lane);

#undef PG8_SA
#undef PG8_SB
#undef PG8_STAGE
#undef PG8_LDA
#undef PG8_LDB
#undef PG8_MMA
#undef PG8_WAIT_V
#undef PG8_WAIT_L
#undef PG8_BAR
#undef PG8_SCHED
}

template <class Epi, class Sched, bool ALIGN_EPI = false, bool SP2 = false>
__device__ __forceinline__ void gemm_phase_f8(PG8_LAS unsigned char* lds, const Gemm g, const Sched& S, const Epi& E) {
    const int tid = threadIdx.x, wid = __builtin_amdgcn_readfirstlane(tid >> 6), lane = tid & 63, wr = wid >> 2, wc = wid & 3, fr = lane & 15, fq = lane >> 4;
    const int RP = g.K, nt = RP / 128;
    unsigned voffA[2], voffB[2];
#pragma unroll
    for (int i = 0; i < 2; ++i) { const int b_ = tid * 16 + i * 8192, R = b_ >> 7, pp = (b_ >> 4) & 7, rr_ = R & 15, ff = ((rr_ >> 1) & 1) | (((rr_ >> 3) & 1) << 2);
        const int rho = R & 31, Rb = (R & ~31) + 8 * ((rho & 15) >> 2) + 4 * (rho >> 4) + (rho & 3);
        voffA[i] = (unsigned)(R * RP + ((pp ^ ff) * 16)); voffB[i] = (unsigned)(Rb * RP + ((pp ^ ff) * 16)); }
    const size_t kstep = (size_t)(BK * 2);
    const size_t hstep = (size_t)HALF * RP;
    const size_t tstep = 2 * hstep;
    const unsigned ldsw = (unsigned)wid * 1024u;
    const int ffr = ((fr >> 1) & 1) | (((fr >> 3) & 1) << 2);
    const int aoff = (wr * 64 + fr) * 128 + (((2 * fq) ^ ffr) * 16), boff = (wc * 32 + fr) * 128 + (((2 * fq) ^ ffr) * 16), hoff = (ffr & 1) ? -16 : 16;
#define PG8_SA(b, h) (((b) * 2 + (h)) * HTB)
#define PG8_SB(b, h) ((4 + (b) * 2 + (h)) * HTB)
#define PG8_STAGE(bufoff, gbase, voff) do { _Pragma("unroll") for (int _i = 0; _i < 2; ++_i) \
        __builtin_amdgcn_global_load_lds((const unsigned*)((const char*)(gbase) + (voff)[_i]), (PG8_LAS unsigned*)(lds + (bufoff) + ldsw + _i * 8192), 16, 0, 0); } while (0)
#define PG8_LDA(dst, b, h) do { _Pragma("unroll") for (int m = 0; m < 4; ++m) { dst[m].lo = *(const PG8_LAS v4i_t*)(lds + PG8_SA(b, h) + aoff + m * 2048); dst[m].hi = *(const PG8_LAS v4i_t*)(lds + PG8_SA(b, h) + aoff + m * 2048 + hoff); } } while (0)
#define PG8_LDB(dst, b, h) do { _Pragma("unroll") for (int n = 0; n < 2; ++n) { dst[n].lo = *(const PG8_LAS v4i_t*)(lds + PG8_SB(b, h) + boff + n * 2048); dst[n].hi = *(const PG8_LAS v4i_t*)(lds + PG8_SB(b, h) + boff + n * 2048 + hoff); } } while (0)
#define PG8_MMA(ai, bj, At, Bt) do { __builtin_amdgcn_s_setprio(1); _Pragma("unroll") for (int m = 0; m < 4; ++m) _Pragma("unroll") for (int n = 0; n < 2; ++n) \
        asm volatile("v_mfma_f32_16x16x128_f8f6f4 %0, %1, %2, %0" : "+v"(acc[ai][bj][m][n]) : "v"(Bt[n]), "v"(At[m])); __builtin_amdgcn_s_setprio(0); } while (0)
#define PG8_WAIT_V(n) asm volatile("s_waitcnt vmcnt(" #n ")" ::: "memory")
#define PG8_WAIT_L(n) asm volatile("s_waitcnt lgkmcnt(" #n ")" ::: "memory")
#define PG8_BAR __builtin_amdgcn_s_barrier()
#define PG8_SCHED __builtin_amdgcn_sched_barrier(0)
    Unit cur, nxt; int ui = 0;
    if (!S.next(0, cur)) return;
    f32x4 acc[2][2][4][2];
#pragma unroll
    for (int a = 0; a < 2; ++a)
#pragma unroll
        for (int b = 0; b < 2; ++b)
#pragma unroll
            for (int m = 0; m < 4; ++m)
#pragma unroll
                for (int n = 0; n < 2; ++n) acc[a][b][m][n] = (f32x4){0.f, 0.f, 0.f, 0.f};
    v8i_t At[4], B0[2], B1[2];
    const char* cA = (const char*)g.A + (size_t)cur.pm * tstep; const char* cB = (const char*)g.Bt + (size_t)cur.pnB * tstep;

    if constexpr (SP2) {
        PG8_STAGE(PG8_SB(0, 0), cB, voffB); PG8_STAGE(PG8_SB(0, 1), cB + hstep, voffB); PG8_STAGE(PG8_SA(0, 0), cA, voffA); PG8_STAGE(PG8_SA(0, 1), cA + hstep, voffA);
        if (wr == 1) PG8_BAR;
        PG8_WAIT_V(2); PG8_BAR;
        PG8_STAGE(PG8_SB(1, 0), cB + kstep, voffB); PG8_STAGE(PG8_SA(1, 0), cA + kstep, voffA); PG8_STAGE(PG8_SB(1, 1), cB + hstep + kstep, voffB);
        PG8_WAIT_V(6); PG8_BAR;
    } else {
        PG8_STAGE(PG8_SB(0, 0), cB, voffB); PG8_STAGE(PG8_SA(0, 0), cA, voffA); PG8_STAGE(PG8_SB(0, 1), cB + hstep, voffB); PG8_STAGE(PG8_SA(0, 1), cA + hstep, voffA);
        if (wr == 1) PG8_BAR;
        PG8_WAIT_V(4); PG8_BAR;
        PG8_STAGE(PG8_SB(1, 0), cB + kstep, voffB); PG8_STAGE(PG8_SA(1, 0), cA + kstep, voffA); PG8_STAGE(PG8_SB(1, 1), cB + hstep + kstep, voffB);
        PG8_WAIT_V(6); PG8_BAR;
    }
    for (;;) {
        const bool has_next = S.next(ui + 1, nxt);
        const char* nA = has_next ? (const char*)g.A + (size_t)nxt.pm * tstep : cA; const char* nB = has_next ? (const char*)g.Bt + (size_t)nxt.pnB * tstep : cB;
        for (int t = 0; t < nt; t += 2) {
            const bool last = (t == nt - 2);
            const char* a1 = cA + (size_t)(t + 1) * kstep;
            const char* a2 = last ? nA : cA + (size_t)(t + 2) * kstep; const char* b2 = last ? nB : cB + (size_t)(t + 2) * kstep;
            const char* a3 = a2 + kstep; const char* b3 = b2 + kstep;

            if constexpr (SP2) {
            PG8_LDB(B0, 0, 0); PG8_LDB(B1, 0, 1); PG8_SCHED; PG8_LDA(At, 0, 0); PG8_STAGE(PG8_SA(1, 1), a1 + hstep, voffA);
            PG8_WAIT_V(8); PG8_WAIT_L(0); PG8_BAR; PG8_MMA(0, 0, At, B0); PG8_MMA(0, 1, At, B1); PG8_BAR; PG8_SCHED;
            PG8_LDA(At, 0, 1); PG8_STAGE(PG8_SB(0, 0), b2, voffB); PG8_STAGE(PG8_SB(0, 1), b2 + hstep, voffB); PG8_STAGE(PG8_SA(0, 0), a2, voffA);
            PG8_WAIT_V(8); PG8_WAIT_L(0); PG8_BAR; PG8_MMA(1, 0, At, B0); PG8_MMA(1, 1, At, B1); PG8_BAR; PG8_SCHED;
            PG8_LDB(B0, 1, 0); PG8_LDB(B1, 1, 1); PG8_SCHED; PG8_LDA(At, 1, 0); PG8_STAGE(PG8_SA(0, 1), a2 + hstep, voffA);
            PG8_WAIT_V(8); PG8_WAIT_L(0); PG8_BAR; PG8_MMA(0, 0, At, B0); PG8_MMA(0, 1, At, B1); PG8_BAR; PG8_SCHED;
            PG8_LDA(At, 1, 1); PG8_STAGE(PG8_SB(1, 0), b3, voffB); PG8_STAGE(PG8_SB(1, 1), b3 + hstep, voffB); PG8_STAGE(PG8_SA(1, 0), a3, voffA);
            PG8_WAIT_V(8); PG8_WAIT_L(0); PG8_BAR; PG8_MMA(1, 0, At, B0); PG8_MMA(1, 1, At, B1); PG8_BAR; PG8_SCHED;
            } else {
            PG8_LDB(B0, 0, 0); PG8_SCHED; PG8_LDA(At, 0, 0); PG8_STAGE(PG8_SA(1, 1), a1 + hstep, voffA);
            PG8_WAIT_L(8); PG8_BAR; PG8_WAIT_L(0); PG8_MMA(0, 0, At, B0); PG8_BAR; PG8_SCHED;
            PG8_LDB(B1, 0, 1); PG8_STAGE(PG8_SB(0, 0), b2, voffB);
            PG8_BAR; PG8_WAIT_L(0); PG8_MMA(0, 1, At, B1); PG8_BAR;
            PG8_LDA(At, 0, 1); PG8_STAGE(PG8_SA(0, 0), a2, voffA);
            PG8_BAR; PG8_WAIT_L(0); PG8_MMA(1, 0, At, B0); PG8_BAR; PG8_SCHED;
            PG8_STAGE(PG8_SB(0, 1), b2 + hstep, voffB);
            PG8_WAIT_V(6); PG8_BAR; PG8_MMA(1, 1, At, B1); PG8_BAR;
            PG8_LDB(B0, 1, 0); PG8_SCHED; PG8_LDA(At, 1, 0); PG8_STAGE(PG8_SA(0, 1), a2 + hstep, voffA);
            PG8_WAIT_L(8); PG8_BAR; PG8_WAIT_L(0); PG8_MMA(0, 0, At, B0); PG8_BAR; PG8_SCHED;
            PG8_LDB(B1, 1, 1); PG8_STAGE(PG8_SB(1, 0), b3, voffB);
            PG8_BAR; PG8_WAIT_L(0); PG8_MMA(0, 1, At, B1); PG8_BAR;
            PG8_LDA(At, 1, 1); PG8_STAGE(PG8_SA(1, 0), a3, voffA);
            PG8_BAR; PG8_WAIT_L(0); PG8_MMA(1, 0, At, B0); PG8_BAR; PG8_SCHED;
            PG8_STAGE(PG8_SB(1, 1), b3 + hstep, voffB);
            PG8_WAIT_V(6); PG8_BAR; PG8_MMA(1, 1, At, B1); PG8_BAR;
            }
        }
        asm volatile("s_nop 15\n\ts_nop 15" ::: "memory");
        if constexpr (ALIGN_EPI) { if (wr == 0) PG8_BAR; }
        run_epi8(E, acc, cur, wr, wc, fr, fq);
        if (!has_next) break;
#pragma unroll
        for (int a = 0; a < 2; ++a)
#pragma unroll
            for (int b = 0; b < 2; ++b)
#pragma unroll
                for (int m = 0; m < 4; ++m)
#pragma unroll
                    for (int n = 0; n < 2; ++n) acc[a][b][m][n] = (f32x4){0.f, 0.f, 0.f, 0.f};
        cur = nxt; cA = nA; cB = nB; ++ui;
        if constexpr (ALIGN_EPI) { if (wr == 1) PG8_BAR; }
    }
    PG8_WAIT_V(0);
    if constexpr (!ALIGN_EPI) { if (wr == 0) PG8_BAR; }
    PG8_BAR;

#undef PG8_SA
#undef PG8_SB
#undef PG8_STAGE
#undef PG8_LDA
#undef PG8_LDB
#undef PG8_MMA
#undef PG8_WAIT_V
#undef PG8_WAIT_L
#undef PG8_BAR
#undef PG8_SCHED
}

template <class Epi, class Sched, bool ALIGN_EPI = false, bool SP2 = false>
__device__ __forceinline__ void gemm_phase_f8g(PG8_LAS unsigned char* lds, const Gemm g, const Sched& S, const Epi& E, const int* tok) {
    const int tid = threadIdx.x, wid = __builtin_amdgcn_readfirstlane(tid >> 6), lane = tid & 63, wr = wid >> 2, wc = wid & 3, fr = lane & 15, fq = lane >> 4;
    const int RP = g.K, nt = RP / 128;
    unsigned voffA[2], voffB[2]; int rowA[2];
#pragma unroll
    for (int i = 0; i < 2; ++i) { const int b_ = tid * 16 + i * 8192, R = b_ >> 7, pp = (b_ >> 4) & 7, rr_ = R & 15, ff = ((rr_ >> 1) & 1) | (((rr_ >> 3) & 1) << 2);
        const int rho = R & 31, Rb = (R & ~31) + 8 * ((rho & 15) >> 2) + 4 * (rho >> 4) + (rho & 3);
        voffA[i] = (unsigned)((pp ^ ff) * 16); rowA[i] = R; voffB[i] = (unsigned)(Rb * RP + ((pp ^ ff) * 16)); }
    const size_t kstep = (size_t)(BK * 2);
    const size_t hstep = (size_t)HALF * RP;
    const size_t tstep = 2 * hstep;
    const unsigned ldsw = (unsigned)wid * 1024u;
    const int ffr = ((fr >> 1) & 1) | (((fr >> 3) & 1) << 2);
    const int aoff = (wr * 64 + fr) * 128 + (((2 * fq) ^ ffr) * 16), boff = (wc * 32 + fr) * 128 + (((2 * fq) ^ ffr) * 16), hoff = (ffr & 1) ? -16 : 16;
#define PG8_SA(b, h) (((b) * 2 + (h)) * HTB)
#define PG8_SB(b, h) ((4 + (b) * 2 + (h)) * HTB)
#define PG8_STAGE(bufoff, gbase, voff) do { _Pragma("unroll") for (int _i = 0; _i < 2; ++_i) \
        __builtin_amdgcn_global_load_lds((const unsigned*)((const char*)(gbase) + (voff)[_i]), (PG8_LAS unsigned*)(lds + (bufoff) + ldsw + _i * 8192), 16, 0, 0); } while (0)
#define PG8_LDA(dst, b, h) do { _Pragma("unroll") for (int m = 0; m < 4; ++m) { dst[m].lo = *(const PG8_LAS v4i_t*)(lds + PG8_SA(b, h) + aoff + m * 2048); dst[m].hi = *(const PG8_LAS v4i_t*)(lds + PG8_SA(b, h) + aoff + m * 2048 + hoff); } } while (0)
#define PG8_LDB(dst, b, h) do { _Pragma("unroll") for (int n = 0; n < 2; ++n) { dst[n].lo = *(const PG8_LAS v4i_t*)(lds + PG8_SB(b, h) + boff + n * 2048); dst[n].hi = *(const PG8_LAS v4i_t*)(lds + PG8_SB(b, h) + boff + n * 2048 + hoff); } } while (0)
#define PG8_MMA(ai, bj, At, Bt) do { __builtin_amdgcn_s_setprio(1); _Pragma("unroll") for (int m = 0; m < 4; ++m) _Pragma("unroll") for (int n = 0; n < 2; ++n) \
        asm volatile("v_mfma_f32_16x16x128_f8f6f4 %0, %1, %2, %0" : "+v"(acc[ai][bj][m][n]) : "v"(Bt[n]), "v"(At[m])); __builtin_amdgcn_s_setprio(0); } while (0)
#define PG8_WAIT_V(n) asm volatile("s_waitcnt vmcnt(" #n ")" ::: "memory")
#define PG8_WAIT_L(n) asm volatile("s_waitcnt lgkmcnt(" #n ")" ::: "memory")
#define PG8_BAR __builtin_amdgcn_s_barrier()
#define PG8_SCHED __builtin_amdgcn_sched_barrier(0)
    Unit cur, nxt; int ui = 0;
    if (!S.next(0, cur)) return;
    f32x4 acc[2][2][4][2];
#pragma unroll
    for (int a = 0; a < 2; ++a)
#pragma unroll
        for (int b = 0; b < 2; ++b)
#pragma unroll
            for (int m = 0; m < 4; ++m)
#pragma unroll
                for (int n = 0; n < 2; ++n) acc[a][b][m][n] = (f32x4){0.f, 0.f, 0.f, 0.f};
    v8i_t At[4], B0[2], B1[2];
    const char* cA = (const char*)g.A; const char* cB = (const char*)g.Bt + (size_t)cur.pnB * tstep;
    unsigned vC[2][2], vN[2][2] = {{0u, 0u}, {0u, 0u}};
#define PG8_TOKOFF(dst, pm_) do { _Pragma("unroll") for (int h_ = 0; h_ < 2; ++h_) _Pragma("unroll") for (int i_ = 0; i_ < 2; ++i_) dst[h_][i_] = (unsigned)tok[(pm_) * 256 + h_ * 128 + rowA[i_]] * (unsigned)RP + voffA[i_]; } while (0)
    PG8_TOKOFF(vC, cur.pm);

    if constexpr (SP2) {
        PG8_STAGE(PG8_SB(0, 0), cB, voffB); PG8_STAGE(PG8_SB(0, 1), cB + hstep, voffB); PG8_STAGE(PG8_SA(0, 0), cA, vC[0]); PG8_STAGE(PG8_SA(0, 1), cA, vC[1]);
        if (wr == 1) PG8_BAR;
        PG8_WAIT_V(2); PG8_BAR;
        PG8_STAGE(PG8_SB(1, 0), cB + kstep, voffB); PG8_STAGE(PG8_SA(1, 0), cA + kstep, vC[0]); PG8_STAGE(PG8_SB(1, 1), cB + hstep + kstep, voffB);
        PG8_WAIT_V(6); PG8_BAR;
    } else {
        PG8_STAGE(PG8_SB(0, 0), cB, voffB); PG8_STAGE(PG8_SA(0, 0), cA, vC[0]); PG8_STAGE(PG8_SB(0, 1), cB + hstep, voffB); PG8_STAGE(PG8_SA(0, 1), cA, vC[1]);
        if (wr == 1) PG8_BAR;
        PG8_WAIT_V(4); PG8_BAR;
        PG8_STAGE(PG8_SB(1, 0), cB + kstep, voffB); PG8_STAGE(PG8_SA(1, 0), cA + kstep, vC[0]); PG8_STAGE(PG8_SB(1, 1), cB + hstep + kstep, voffB);
        PG8_WAIT_V(6); PG8_BAR;
    }
    for (;;) {
        const bool has_next = S.next(ui + 1, nxt);
        const char* nB = has_next ? (const char*)g.Bt + (size_t)nxt.pnB * tstep : cB;
        int tkN[2][2] = {{0, 0}, {0, 0}};
        if (has_next) { _Pragma("unroll") for (int h_ = 0; h_ < 2; ++h_) _Pragma("unroll") for (int i_ = 0; i_ < 2; ++i_) tkN[h_][i_] = tok[nxt.pm * 256 + h_ * 128 + rowA[i_]]; }
        for (int t = 0; t < nt; t += 2) {
            const bool last = (t == nt - 2);
            const char* a1 = cA + (size_t)(t + 1) * kstep;
            const char* a2 = last ? cA : cA + (size_t)(t + 2) * kstep; const char* b2 = last ? nB : cB + (size_t)(t + 2) * kstep;
            unsigned vs0[2] = {vC[0][0], vC[0][1]}, vs1[2] = {vC[1][0], vC[1][1]};
            if (last && has_next) { asm volatile("" : "+v"(tkN[0][0]), "+v"(tkN[0][1]), "+v"(tkN[1][0]), "+v"(tkN[1][1]));
                _Pragma("unroll") for (int h_ = 0; h_ < 2; ++h_) _Pragma("unroll") for (int i_ = 0; i_ < 2; ++i_) vN[h_][i_] = (unsigned)tkN[h_][i_] * (unsigned)RP + voffA[i_];
                vs0[0] = vN[0][0]; vs0[1] = vN[0][1]; vs1[0] = vN[1][0]; vs1[1] = vN[1][1]; }
            const char* a3 = a2 + kstep; const char* b3 = b2 + kstep;

            if constexpr (SP2) {
            PG8_LDB(B0, 0, 0); PG8_LDB(B1, 0, 1); PG8_SCHED; PG8_LDA(At, 0, 0); PG8_STAGE(PG8_SA(1, 1), a1, vC[1]);
            PG8_WAIT_V(8); PG8_WAIT_L(0); PG8_BAR; PG8_MMA(0, 0, At, B0); PG8_MMA(0, 1, At, B1); PG8_BAR; PG8_SCHED;
            PG8_LDA(At, 0, 1); PG8_STAGE(PG8_SB(0, 0), b2, voffB); PG8_STAGE(PG8_SB(0, 1), b2 + hstep, voffB); PG8_STAGE(PG8_SA(0, 0), a2, vs0);
            PG8_WAIT_V(8); PG8_WAIT_L(0); PG8_BAR; PG8_MMA(1, 0, At, B0); PG8_MMA(1, 1, At, B1); PG8_BAR; PG8_SCHED;
            PG8_LDB(B0, 1, 0); PG8_LDB(B1, 1, 1); PG8_SCHED; PG8_LDA(At, 1, 0); PG8_STAGE(PG8_SA(0, 1), a2, vs1);
            PG8_WAIT_V(8); PG8_WAIT_L(0); PG8_BAR; PG8_MMA(0, 0, At, B0); PG8_MMA(0, 1, At, B1); PG8_BAR; PG8_SCHED;
            PG8_LDA(At, 1, 1); PG8_STAGE(PG8_SB(1, 0), b3, voffB); PG8_STAGE(PG8_SB(1, 1), b3 + hstep, voffB); PG8_STAGE(PG8_SA(1, 0), a3, vs0);
            PG8_WAIT_V(8); PG8_WAIT_L(0); PG8_BAR; PG8_MMA(1, 0, At, B0); PG8_MMA(1, 1, At, B1); PG8_BAR; PG8_SCHED;
            } else {
            PG8_LDB(B0, 0, 0); PG8_SCHED; PG8_LDA(At, 0, 0); PG8_STAGE(PG8_SA(1, 1), a1, vC[1]);
            PG8_WAIT_L(8); PG8_BAR; PG8_WAIT_L(0); PG8_MMA(0, 0, At, B0); PG8_BAR; PG8_SCHED;
            PG8_LDB(B1, 0, 1); PG8_STAGE(PG8_SB(0, 0), b2, voffB);
            PG8_BAR; PG8_WAIT_L(0); PG8_MMA(0, 1, At, B1); PG8_BAR;
            PG8_LDA(At, 0, 1); PG8_STAGE(PG8_SA(0, 0), a2, vs0);
            PG8_BAR; PG8_WAIT_L(0); PG8_MMA(1, 0, At, B0); PG8_BAR; PG8_SCHED;
            PG8_STAGE(PG8_SB(0, 1), b2 + hstep, voffB);
            PG8_WAIT_V(6); PG8_BAR; PG8_MMA(1, 1, At, B1); PG8_BAR;
            PG8_LDB(B0, 1, 0); PG8_SCHED; PG8_LDA(At, 1, 0); PG8_STAGE(PG8_SA(0, 1), a2, vs1);
            PG8_WAIT_L(8); PG8_BAR; PG8_WAIT_L(0); PG8_MMA(0, 0, At, B0); PG8_BAR; PG8_SCHED;
            PG8_LDB(B1, 1, 1); PG8_STAGE(PG8_SB(1, 0), b3, voffB);
            PG8_BAR; PG8_WAIT_L(0); PG8_MMA(0, 1, At, B1); PG8_BAR;
            PG8_LDA(At, 1, 1); PG8_STAGE(PG8_SA(1, 0), a3, vs0);
            PG8_BAR; PG8_WAIT_L(0); PG8_MMA(1, 0, At, B0); PG8_BAR; PG8_SCHED;
            PG8_STAGE(PG8_SB(1, 1), b3 + hstep, voffB);
            PG8_WAIT_V(6); PG8_BAR; PG8_MMA(1, 1, At, B1); PG8_BAR;
            }
        }
        asm volatile("s_nop 15\n\ts_nop 15" ::: "memory");
        if constexpr (ALIGN_EPI) { if (wr == 0) PG8_BAR; }
        run_epi8(E, acc, cur, wr, wc, fr, fq);
        if (!has_next) break;
#pragma unroll
        for (int a = 0; a < 2; ++a)
#pragma unroll
            for (int b = 0; b < 2; ++b)
#pragma unroll
                for (int m = 0; m < 4; ++m)
#pragma unroll
                    for (int n = 0; n < 2; ++n) acc[a][b][m][n] = (f32x4){0.f, 0.f, 0.f, 0.f};
        cur = nxt; cB = nB; ++ui; vC[0][0] = vN[0][0]; vC[0][1] = vN[0][1]; vC[1][0] = vN[1][0]; vC[1][1] = vN[1][1];
        if constexpr (ALIGN_EPI) { if (wr == 1) PG8_BAR; }
    }
    PG8_WAIT_V(0);
    if constexpr (!ALIGN_EPI) { if (wr == 0) PG8_BAR; }
    PG8_BAR;

#undef PG8_TOKOFF
#undef PG8_SA
#undef PG8_SB
#undef PG8_STAGE
#undef PG8_LDA
#undef PG8_LDB
#undef PG8_MMA
#undef PG8_WAIT_V
#undef PG8_WAIT_L
#undef PG8_BAR
#undef PG8_SCHED
}
}

constexpr int D = 1024, BATCH = 8, SEQ = 2048, CTXL = 256;
constexpr int M = BATCH * SEQ;
constexpr int MC = BATCH * CTXL;
constexpr int MT = M + MC;
constexpr int DIN = 2048, DSGU = 512, DLRU = 512, NE = 16, CAP = 256, DE = 2048, NMOD = 6 * D;
constexpr int NSEG = 36;
constexpr float EPS = 1e-6f;
constexpr int NWAVES = 8, NTHREADS = 512;
constexpr int LDS_BYTES = 147456;
constexpr int NPH = 11;

constexpr size_t MiB = 1u << 20;
constexpr size_t WS_CTL = 0;
constexpr size_t WS_MOD = 1 * MiB;
constexpr size_t WS_SUM = 1 * MiB + 512 * 1024;
constexpr size_t WS_AFF = 4 * MiB;
constexpr size_t WS_SLOT = 5 * MiB;
constexpr size_t WS_GATE = 6 * MiB;
constexpr size_t WS_TOK = 6 * MiB + 128 * 1024;
constexpr size_t WS_GWT = 6 * MiB + 512 * 1024;
constexpr size_t WS_SWB = 7 * MiB;
constexpr size_t WS_WIN = 8 * MiB;
constexpr size_t WS_WOUT = 12 * MiB;
constexpr size_t WS_WG = 14 * MiB;
constexpr size_t WS_W2 = 142 * MiB;
constexpr size_t WS_X1 = 206 * MiB;
constexpr size_t WS_HS = 206 * MiB, WS_PF = 222 * MiB, WS_PB = 238 * MiB;
constexpr size_t WS_HX2 = 270 * MiB;
constexpr size_t WS_XCH = 286 * MiB;
constexpr size_t WS_CB = 1 * MiB + 256 * 1024;
constexpr size_t WS_XE = 302 * MiB;
constexpr size_t WS_A2 = 302 * MiB, WS_YE = 302 * MiB;
constexpr size_t WS_HID = 366 * MiB;
constexpr size_t WS_HX = 366 * MiB;
constexpr size_t WS_UV = 402 * MiB;
constexpr size_t WS_XC = 466 * MiB;
constexpr size_t WS_END = 494 * MiB;

#define GAS __attribute__((address_space(1)))
#define LAS __attribute__((address_space(3)))
typedef unsigned short bf16;
typedef unsigned v4u __attribute__((ext_vector_type(4)));
typedef unsigned v2u __attribute__((ext_vector_type(2)));
typedef float f32x4 __attribute__((ext_vector_type(4)));
typedef short bf16x8 __attribute__((ext_vector_type(8)));
#define LDS_WAIT() asm volatile("s_waitcnt lgkmcnt(0)" ::: "memory")

__device__ __forceinline__ float bf2f(bf16 b) { return __uint_as_float(((unsigned)b) << 16); }
__device__ __forceinline__ unsigned f2bf(float f) { unsigned u = __float_as_uint(f); return (u + 0x7fffu + ((u >> 16) & 1u)) >> 16; }
typedef __bf16 bf16x2_hw __attribute__((ext_vector_type(2)));
typedef float f32x2_hw __attribute__((ext_vector_type(2)));
__device__ __forceinline__ unsigned pk2(float lo, float hi) { const f32x2_hw v = {lo, hi}; return __builtin_bit_cast(unsigned, __builtin_convertvector(v, bf16x2_hw)); }
__device__ __forceinline__ float bflo(unsigned w) { return __uint_as_float(w << 16); }
__device__ __forceinline__ float bfhi(unsigned w) { return __uint_as_float(w & 0xffff0000u); }
__device__ __forceinline__ float rcpf_(float x) { return __builtin_amdgcn_rcpf(x); }
__device__ __forceinline__ float exp2f_(float x) { return __builtin_amdgcn_exp2f(x); }
__device__ __forceinline__ float sigmoidf_(float x) { return rcpf_(1.f + exp2f_(-1.4426950408889634f * x)); }
__device__ __forceinline__ float siluf_(float x) { return x * rcpf_(1.f + exp2f_(-1.4426950408889634f * x)); }
__device__ __forceinline__ float geluf_(float x) { const float u = x * (0.7978845608028654f + 0.035677408136300125f * x * x); return x * rcpf_(1.f + exp2f_(-2.8853900817779268f * u)); }
__device__ __forceinline__ void decay_pair(float la, float& a, float& s) {
    const float x = 2.f * la;
    const float p1 = la * (1.f + la * (0.5f + la * (0.16666667f + la * (0.041666668f + la * 0.0083333333f))));
    const float p2 = x * (1.f + x * (0.5f + x * (0.16666667f + x * (0.041666668f + x * (0.0083333333f + x * 0.0013888889f)))));
    const float e1 = exp2f_(1.4426950408889634f * la);
    const bool small = la > -0.15f;
    a = small ? 1.f + p1 : e1;
    s = __builtin_amdgcn_sqrtf(small ? -p2 : 1.f - e1 * e1);
}
typedef float f32x2p __attribute__((ext_vector_type(2)));
__device__ __forceinline__ f32x2p sigmoid2_(f32x2p x) { const f32x2p t = x * -1.4426950408889634f; f32x2p e; e.x = exp2f_(t.x); e.y = exp2f_(t.y); e = e + 1.f; f32x2p r; r.x = rcpf_(e.x); r.y = rcpf_(e.y); return r; }
__device__ __forceinline__ f32x2p gelu2_(f32x2p x) { const f32x2p u = x * (x * x * 0.035677408136300125f + 0.7978845608028654f), t = u * -2.8853900817779268f; f32x2p e; e.x = exp2f_(t.x); e.y = exp2f_(t.y); e = e + 1.f;
    f32x2p r; r.x = rcpf_(e.x); r.y = rcpf_(e.y); return x * r; }
__device__ __forceinline__ void decay_pair2(f32x2p la, f32x2p& a, f32x2p& s) {
    const f32x2p x = la * 2.f;
    const f32x2p p1 = la * (la * (la * (la * (la * 0.0083333333f + 0.041666668f) + 0.16666667f) + 0.5f) + 1.f);
    const f32x2p p2 = x * (x * (x * (x * (x * (x * 0.0013888889f + 0.0083333333f) + 0.041666668f) + 0.16666667f) + 0.5f) + 1.f);
    const f32x2p tt = la * 1.4426950408889634f; f32x2p e1; e1.x = exp2f_(tt.x); e1.y = exp2f_(tt.y);
    const f32x2p big = 1.f - e1 * e1, one = p1 + 1.f;
    a.x = la.x > -0.15f ? one.x : e1.x; a.y = la.y > -0.15f ? one.y : e1.y;
    s.x = __builtin_amdgcn_sqrtf(la.x > -0.15f ? -p2.x : big.x); s.y = __builtin_amdgcn_sqrtf(la.y > -0.15f ? -p2.y : big.y);
}
__device__ __forceinline__ unsigned pk4_fp8(float a, float b, float c, float d) {
    unsigned w = 0u; w = __builtin_amdgcn_cvt_pk_fp8_f32(a, b, w, false); w = __builtin_amdgcn_cvt_pk_fp8_f32(c, d, w, true); return w; }
constexpr float WSCALE = 32.f, WSCALE_INV = 1.f / 32.f;
__device__ __forceinline__ float wave_sum(float v) {
#pragma unroll
    for (int o = 1; o < 64; o <<= 1) v += __shfl_xor(v, o);
    return v;
}


#define XB_TMO      128
#define XB_XCNT(j)  (256  + 64 * (j))
#define XB_XSUB(j)  (1280 + 64 * (j))
#define XB_XGEN(j)  (2304 + 64 * (j))
#define XB_TOP      3328
#define XB_TOPGEN   3392
#define XCD_BAR_WORDS 3456
#define XB_SPIN_CAP (1u << 18)
__device__ __forceinline__ unsigned xb_ld(unsigned* p)              { return __hip_atomic_load(p, __ATOMIC_RELAXED, __HIP_MEMORY_SCOPE_AGENT); }
__device__ __forceinline__ unsigned xb_add(unsigned* p, unsigned v) { return __hip_atomic_fetch_add(p, v, __ATOMIC_RELAXED, __HIP_MEMORY_SCOPE_AGENT); }
__device__ __forceinline__ unsigned xb_xcc_id() { return (unsigned)__builtin_amdgcn_s_getreg((3 << 11) | 20) & 0xFu; }
#define XB_SPIN(cond, bar) do { unsigned _sp = 0; while (cond) { __builtin_amdgcn_s_sleep(1); \
    if ((++_sp & 255u) == 0u) { if (xb_ld(&(bar)[XB_TMO])) break; if (_sp > XB_SPIN_CAP) { atomicAdd(&(bar)[XB_TMO], 1u); break; } } } } while (0)
struct XcdBarrier { unsigned* bar; unsigned x; volatile LAS unsigned* st; unsigned total; };
__device__ __forceinline__ XcdBarrier xcd_barrier_post(unsigned* bar, volatile LAS unsigned* st, unsigned total) {
    XcdBarrier b; b.bar = bar; b.x = xb_xcc_id(); b.st = st; b.total = total;
    if (threadIdx.x == 0) (void)xb_add(&bar[XB_XCNT(b.x)], 1u);
    return b;
}
__device__ __forceinline__ void xcd_barrier_complete(unsigned* bar, unsigned x, unsigned G, unsigned& nloc, unsigned& nx) {
    unsigned sum, cnt, mine, sp = 0u;
    for (;;) {
        sum = 0u; cnt = 0u; mine = 0u;
#pragma unroll
        for (unsigned j = 0; j < 16; ++j) { const unsigned c = xb_ld(&bar[XB_XCNT(j)]); sum += c; cnt += (c > 0u) ? 1u : 0u; mine = (j == x) ? c : mine; }
        if (sum == G) break;
        __builtin_amdgcn_s_sleep(1);
        if ((++sp & 255u) == 0u) { if (xb_ld(&bar[XB_TMO])) break; if (sp > XB_SPIN_CAP) { atomicAdd(&bar[XB_TMO], 1u); break; } }
    }
    nloc = mine > 0u ? mine : 1u; nx = cnt > 0u ? cnt : 1u;
}
__device__ __forceinline__ void xcd_barrier(const XcdBarrier& b) {
    asm volatile("s_waitcnt vmcnt(0)" ::: "memory");
    __syncthreads();
    if (threadIdx.x == 0) {
        unsigned* bar = b.bar;
        __builtin_amdgcn_s_waitcnt(0);
        unsigned nloc = b.st[0], nx = b.st[1];
        if (nloc == 0u) { xcd_barrier_complete(bar, b.x, b.total, nloc, nx); b.st[0] = nloc; b.st[1] = nx; }
        const unsigned old = xb_add(&bar[XB_XSUB(b.x)], 1u);
        const unsigned gen = old / nloc;
        if (old + 1u == (gen + 1u) * nloc) {
            __builtin_amdgcn_fence(__ATOMIC_RELEASE, "agent");
            asm volatile("s_waitcnt vmcnt(0)" ::: "memory");
            const unsigned og = xb_add(&bar[XB_TOP], 1u);
            const unsigned tg = og / nx;
            if (og + 1u == (tg + 1u) * nx) xb_add(&bar[XB_TOPGEN], 1u);
            else XB_SPIN(xb_ld(&bar[XB_TOPGEN]) == tg, bar);
            __builtin_amdgcn_fence(__ATOMIC_ACQUIRE, "agent");
            xb_add(&bar[XB_XGEN(b.x)], 1u);
            asm volatile("s_waitcnt vmcnt(0)" ::: "memory");
        } else {
            XB_SPIN(xb_ld(&bar[XB_XGEN(b.x)]) == gen, bar);
            __builtin_amdgcn_fence(__ATOMIC_ACQUIRE, "agent");
            asm volatile("s_waitcnt vmcnt(0)" ::: "memory");
        }
    }
    __syncthreads();
}

struct P {
    const float *x, *c, *ctx, *c_ctx, *w_mod, *b_mod, *norm1_g, *norm2_g, *w_in, *sgu_g, *sgu_w, *sgu_b, *conv_w, *conv_b,
                *rg_wa, *rg_ba, *rg_wi, *rg_bi, *rg_lam, *w_out, *w_router, *w1, *w3, *w2, *final_g;
    float* out; unsigned char* ws; int ph_lo, ph_hi;
};

struct SchedG1 { int G, c;
    __device__ __forceinline__ bool next(int i, pg8::Unit& u) const { const int L = i * G + c; if (L >= 528) return false;
        if (L < 512) { u.pm = L >> 3; u.pn = L & 7; } else { const int r = L - 512; u.pm = 64 + (r >> 1); u.pn = 4 + (r & 1); } u.pnB = u.pn; return true; } };
struct SchedG2 { int G, c;
    __device__ __forceinline__ bool next(int i, pg8::Unit& u) const { const int L = i * G + c; if (L >= 256) return false; u.pm = L >> 2; u.pn = L & 3; u.pnB = u.pn; return true; } };
struct SchedG3 { int G, c;
    __device__ __forceinline__ bool next(int i, pg8::Unit& u) const { const int L = i * G + c; if (L >= 2048) return false; const int e = L >> 7, loc = L & 127;
        u.pm = e * 8 + (loc & 7); u.pn = loc >> 3; u.pnB = e * 16 + u.pn; return true; } };
struct SchedG4 { int G, c;
    __device__ __forceinline__ bool next(int i, pg8::Unit& u) const { const int L = i * G + c; if (L >= 512) return false; const int e = L >> 5, loc = L & 31;
        u.pm = e * 8 + (loc & 7); u.pn = loc >> 3; u.pnB = e * 4 + u.pn; return true; } };

struct EpiG1 { static constexpr bool PAIRED = false, FUSED = false; bf16* UV; bf16* XC;
    __device__ __forceinline__ void st8(const pg8::Unit& u, int row, int col, f32x4 v0, f32x4 v1) const {
        const int grow = u.pm * 256 + row, gcol = u.pn * 256 + col;
        if (u.pm < 64) {
            if (gcol < 1024 || gcol >= 1536) { const f32x2p a = gelu2_((f32x2p){v0[0], v0[1]}), b = gelu2_((f32x2p){v0[2], v0[3]}), c = gelu2_((f32x2p){v1[0], v1[1]}), d = gelu2_((f32x2p){v1[2], v1[3]});
                v0 = (f32x4){a.x, a.y, b.x, b.y}; v1 = (f32x4){c.x, c.y, d.x, d.y}; }
            *(v4u*)(UV + (size_t)grow * DIN + gcol) = (v4u){pk2(v0[0], v0[1]), pk2(v0[2], v0[3]), pk2(v1[0], v1[1]), pk2(v1[2], v1[3])};
        } else *(v4u*)(XC + (size_t)(grow - M) * DLRU + (gcol - 1024)) = (v4u){pk2(v0[0], v0[1]), pk2(v0[2], v0[3]), pk2(v1[0], v1[1]), pk2(v1[2], v1[3])};
    } };
struct EpiG2 { static constexpr bool PAIRED = false, FUSED = false; const float* x; const float* MOD; float* X1;
    __device__ __forceinline__ void st8(const pg8::Unit& u, int row, int col, f32x4 v0, f32x4 v1) const {
        const int grow = u.pm * 256 + row, gcol = u.pn * 256 + col, b = grow >> 11;
        const f32x4* xp = (const f32x4*)(x + (size_t)grow * D + gcol); const f32x4* gp = (const f32x4*)(MOD + b * NMOD + 2 * D + gcol); f32x4* op = (f32x4*)(X1 + (size_t)grow * D + gcol);
        op[0] = xp[0] + gp[0] * v0; op[1] = xp[1] + gp[1] * v1;
    } };
#if MOE_FP8
typedef float f32x2v __attribute__((ext_vector_type(2)));
__device__ __forceinline__ f32x2v swiglu_scaled2(f32x2v g, f32x2v u) {
    constexpr float K1 = -1.4426950408889634f * WSCALE_INV, S2 = WSCALE * WSCALE;
    const f32x2v t = g * K1; f32x2v e; e.x = exp2f_(t.x); e.y = exp2f_(t.y);
    const f32x2v d = e * S2 + S2; f32x2v r; r.x = rcpf_(d.x); r.y = rcpf_(d.y);
    return (g * u) * r;
}
struct EpiG3 { static constexpr bool PAIRED = true; unsigned char* HID;
    __device__ __forceinline__ void st2x8(const pg8::Unit& u, int row, int col, f32x4 g0, f32x4 g1, f32x4 u0, f32x4 u1) const {
        const int grow = u.pm * 256 + row, hc = u.pn * 128 + col;
        const f32x2v a = swiglu_scaled2((f32x2v){g0[0], g0[1]}, (f32x2v){u0[0], u0[1]}), b = swiglu_scaled2((f32x2v){g0[2], g0[3]}, (f32x2v){u0[2], u0[3]});
        const f32x2v c = swiglu_scaled2((f32x2v){g1[0], g1[1]}, (f32x2v){u1[0], u1[1]}), d = swiglu_scaled2((f32x2v){g1[2], g1[3]}, (f32x2v){u1[2], u1[3]});
        v2u w; w.x = pk4_fp8(a.x, a.y, b.x, b.y); w.y = pk4_fp8(c.x, c.y, d.x, d.y);
        *(v2u*)(HID + (size_t)grow * DE + hc) = w;
    } };
struct EpiG4 { static constexpr bool PAIRED = false; const float* GATE; unsigned char* YE;
    __device__ __forceinline__ void st8(const pg8::Unit& u, int row, int col, f32x4 v0, f32x4 v1) const {
        const int grow = u.pm * 256 + row, gcol = u.pn * 256 + col; const float gt = GATE[grow];
        v2u w; w.x = pk4_fp8(v0[0] * gt, v0[1] * gt, v0[2] * gt, v0[3] * gt); w.y = pk4_fp8(v1[0] * gt, v1[1] * gt, v1[2] * gt, v1[3] * gt);
        *(v2u*)(YE + (size_t)grow * D + gcol) = w;
    } };
#else
struct EpiG3 { static constexpr bool PAIRED = true; bf16* HID;
    __device__ __forceinline__ void st2(const pg8::Unit& u, int row, int col, f32x4 g, f32x4 up) const {
        const int grow = u.pm * 256 + row, hc = u.pn * 128 + col;
        v2u w; w.x = pk2(siluf_(g[0]) * up[0], siluf_(g[1]) * up[1]); w.y = pk2(siluf_(g[2]) * up[2], siluf_(g[3]) * up[3]);
        *(v2u*)(HID + (size_t)grow * DE + hc) = w;
    } };
struct EpiG4 { static constexpr bool PAIRED = false; const float* GATE; bf16* YE;
    __device__ __forceinline__ void st(const pg8::Unit& u, int row, int col, f32x4 v) const {
        const int grow = u.pm * 256 + row, gcol = u.pn * 256 + col; const float gt = GATE[grow];
        v2u w; w.x = pk2(v[0] * gt, v[1] * gt); w.y = pk2(v[2] * gt, v[3] * gt); *(v2u*)(YE + (size_t)grow * D + gcol) = w;
    } };

#endif


struct EpiG2F { static constexpr bool PAIRED = false, FUSED = true;
    const float* x; const float* MOD; float* X1; const float* w_router; const float* norm2_g; const float* CB; float* XCH; unsigned* cnt; unsigned* tmo; unsigned char* HX8; float* AFF;
    __device__ __forceinline__ void fused(f32x4 (&acc)[2][2][4][2], const pg8::Unit& u, int wr, int wc, int fr, int fq, LAS unsigned char* lds, int wid, int lane) const {
        const int tid = wid * 64 + lane, b = u.pm >> 3, grow0 = u.pm * 256, gcol0 = u.pn * 256;
        LAS float* LQ = (LAS float*)lds;
        LAS float* RINV = (LAS float*)(lds + 81920);
        const float* MODb = MOD + b * NMOD;
        float gsc[2][8], shv[2][8], wrv[2][8];
#pragma unroll
        for (int bj = 0; bj < 2; ++bj)
#pragma unroll
            for (int j = 0; j < 8; ++j) { const int c = gcol0 + bj * 128 + wc * 32 + 8 * fq + j; gsc[bj][j] = norm2_g[c] * (1.f + MODb[4 * D + c]); shv[bj][j] = MODb[3 * D + c]; wrv[bj][j] = w_router[c * NE + fr]; }
#pragma unroll
        for (int ai = 0; ai < 2; ++ai)
#pragma unroll
            for (int m = 0; m < 4; ++m) { const int row = ai * 128 + wr * 64 + m * 16 + fr;
#pragma unroll
                for (int bj = 0; bj < 2; ++bj) { const int col = gcol0 + bj * 128 + wc * 32 + 8 * fq; const size_t o = (size_t)(grow0 + row) * D + col;
                    const f32x4 x0 = *(const f32x4*)(x + o), x1v = *(const f32x4*)(x + o + 4), g0 = *(const f32x4*)(MODb + 2 * D + col), g1 = *(const f32x4*)(MODb + 2 * D + col + 4);
                    acc[ai][bj][m][0] = x0 + g0 * acc[ai][bj][m][0]; acc[ai][bj][m][1] = x1v + g1 * acc[ai][bj][m][1];
                    { v4u w; w.x = pk2(acc[ai][bj][m][0].x, acc[ai][bj][m][0].y); w.y = pk2(acc[ai][bj][m][0].z, acc[ai][bj][m][0].w); w.z = pk2(acc[ai][bj][m][1].x, acc[ai][bj][m][1].y); w.w = pk2(acc[ai][bj][m][1].z, acc[ai][bj][m][1].w);
                      *(v4u*)((bf16*)X1 + o) = w; } } }
        float tw[2][2][4];
#pragma unroll
        for (int bj = 0; bj < 2; ++bj)
#pragma unroll
            for (int n = 0; n < 2; ++n)
#pragma unroll
                for (int r = 0; r < 4; ++r) tw[bj][n][r] = wrv[bj][4 * n + r] * gsc[bj][4 * n + r];
#pragma unroll
        for (int ai = 0; ai < 2; ++ai)
#pragma unroll
            for (int m = 0; m < 4; ++m) { const int row = ai * 128 + wr * 64 + m * 16 + fr;
                f32x4 q = (f32x4){0.f, 0.f, 0.f, 0.f}; float s2 = 0.f;
#pragma unroll
                for (int bj = 0; bj < 2; ++bj)
#pragma unroll
                    for (int n = 0; n < 2; ++n)
#pragma unroll
                        for (int r = 0; r < 4; ++r) { const float v = acc[ai][bj][m][n][r]; q = __builtin_amdgcn_mfma_f32_16x16x4f32(tw[bj][n][r], v, q, 0, 0, 0); s2 += v * v; }
                s2 += __shfl_xor(s2, 16); s2 += __shfl_xor(s2, 32);
                LAS float* o = LQ + (row * 4 + wc) * 20;
                o[4 * fq + 0] = q[0]; o[4 * fq + 1] = q[1]; o[4 * fq + 2] = q[2]; o[4 * fq + 3] = q[3]; if (fq == 0) o[16] = s2; }
        __syncthreads();
        float* xo = XCH + (size_t)((u.pm * 4 + u.pn) * 256) * 20;
        for (int i = tid; i < 256 * 9; i += NTHREADS) { const int row = i / 9, q2 = 2 * (i - row * 9); const LAS float* s = LQ + row * 80 + q2;
            const float v0 = (s[0] + s[20]) + (s[40] + s[60]), v1 = q2 < 16 ? (s[1] + s[21]) + (s[41] + s[61]) : 0.f;
            __hip_atomic_store((unsigned long long*)(xo + row * 20 + q2), ((unsigned long long)__float_as_uint(v1) << 32) | __float_as_uint(v0), __ATOMIC_RELAXED, __HIP_MEMORY_SCOPE_AGENT); }
        asm volatile("s_waitcnt vmcnt(0)" ::: "memory");
        __syncthreads();
        if (tid == 0) {
            __hip_atomic_fetch_add(cnt + 16 * u.pm, 1u, __ATOMIC_RELAXED, __HIP_MEMORY_SCOPE_AGENT);
            XB_SPIN(xb_ld(cnt + 16 * u.pm) < 4u, tmo);
        }
        __syncthreads();
        const float* xp = XCH + (size_t)(u.pm * 4 * 256) * 20;
#define XLD(ptr) __hip_atomic_load((ptr), __ATOMIC_RELAXED, __HIP_MEMORY_SCOPE_AGENT)
        if (tid < 256) { const int row = tid; const float S2 = (XLD(xp + row * 20 + 16) + XLD(xp + 5120 + row * 20 + 16)) + (XLD(xp + 10240 + row * 20 + 16) + XLD(xp + 15360 + row * 20 + 16)); RINV[row] = rsqrtf(S2 * (1.f / D) + EPS); }
        else if (tid < 320) { const int row = 64 * u.pn + (tid - 256); const float* r0 = xp + row * 20;
            const float S2 = (XLD(r0 + 16) + XLD(r0 + 5120 + 16)) + (XLD(r0 + 10240 + 16) + XLD(r0 + 15360 + 16)), rinv = rsqrtf(S2 * (1.f / D) + EPS);
            float lg[16]; float mx = -3.0e38f;
#pragma unroll
            for (int e = 0; e < 16; ++e) { lg[e] = rinv * ((XLD(r0 + e) + XLD(r0 + 5120 + e)) + (XLD(r0 + 10240 + e) + XLD(r0 + 15360 + e))) + CB[b * NE + e]; mx = fmaxf(mx, lg[e]); }
            float den = 0.f;
#pragma unroll
            for (int e = 0; e < 16; ++e) { lg[e] = expf(lg[e] - mx); den += lg[e]; }
            const float rd = 1.f / den; const int t = (u.pm & 7) * 256 + row;
#pragma unroll
            for (int e = 0; e < 16; ++e) AFF[(size_t)(b * NE + e) * SEQ + t] = lg[e] * rd; }
#undef XLD
        __syncthreads();
#pragma unroll
        for (int ai = 0; ai < 2; ++ai)
#pragma unroll
            for (int m = 0; m < 4; ++m) { const int row = ai * 128 + wr * 64 + m * 16 + fr; const float rinv = RINV[row];
#pragma unroll
                for (int bj = 0; bj < 2; ++bj) { const f32x4 a0 = acc[ai][bj][m][0], a1 = acc[ai][bj][m][1]; v2u w;
                    w.x = pk4_fp8(a0[0] * rinv * gsc[bj][0] + shv[bj][0], a0[1] * rinv * gsc[bj][1] + shv[bj][1], a0[2] * rinv * gsc[bj][2] + shv[bj][2], a0[3] * rinv * gsc[bj][3] + shv[bj][3]);
                    w.y = pk4_fp8(a1[0] * rinv * gsc[bj][4] + shv[bj][4], a1[1] * rinv * gsc[bj][5] + shv[bj][5], a1[2] * rinv * gsc[bj][6] + shv[bj][6], a1[3] * rinv * gsc[bj][7] + shv[bj][7]);
                    *(v2u*)(HX8 + (size_t)(grow0 + row) * D + gcol0 + bj * 128 + wc * 32 + 8 * fq) = w; } }
    }
    __device__ __forceinline__ void st8(const pg8::Unit&, int, int, f32x4, f32x4) const {}
};

template <class Epi, class Sched>
__device__ __forceinline__ void naive_gemm_phase(LAS unsigned char* lds, const pg8::Gemm g, const Sched& S, const Epi& E) {
    LAS float* As = (LAS float*)lds; LAS float* Bs = (LAS float*)(lds + 4352);
    const int tid = threadIdx.x, ty = tid >> 5, tx = tid & 31, K = g.K, lr = tid >> 1, lh = 8 * (tid & 1);
    pg8::Unit u;
    for (int i = 0; S.next(i, u); ++i)
        for (int sub = 0; sub < 4; ++sub) {
            f32x4 ag[4], au[4];
#pragma unroll
            for (int r = 0; r < 4; ++r) { ag[r] = (f32x4){0.f, 0.f, 0.f, 0.f}; au[r] = (f32x4){0.f, 0.f, 0.f, 0.f}; }
            const bf16* arow = g.A + ((size_t)u.pm * 256 + sub * 64 + (lr & 63)) * K + lh;
            const bf16* brow = g.Bt + ((size_t)u.pnB * 256 + lr) * K + lh;
            for (int k0 = 0; k0 < K; k0 += 16) {
                const v4u bv = *(const v4u*)(brow + k0); v4u av = (v4u){0u, 0u, 0u, 0u}; if (tid < 128) av = *(const v4u*)(arow + k0);
                __syncthreads();
                Bs[(lh + 0) * 260 + lr] = bflo(bv.x); Bs[(lh + 1) * 260 + lr] = bfhi(bv.x); Bs[(lh + 2) * 260 + lr] = bflo(bv.y); Bs[(lh + 3) * 260 + lr] = bfhi(bv.y);
                Bs[(lh + 4) * 260 + lr] = bflo(bv.z); Bs[(lh + 5) * 260 + lr] = bfhi(bv.z); Bs[(lh + 6) * 260 + lr] = bflo(bv.w); Bs[(lh + 7) * 260 + lr] = bfhi(bv.w);
                if (tid < 128) {
                    As[(lh + 0) * 68 + lr] = bflo(av.x); As[(lh + 1) * 68 + lr] = bfhi(av.x); As[(lh + 2) * 68 + lr] = bflo(av.y); As[(lh + 3) * 68 + lr] = bfhi(av.y);
                    As[(lh + 4) * 68 + lr] = bflo(av.z); As[(lh + 5) * 68 + lr] = bfhi(av.z); As[(lh + 6) * 68 + lr] = bflo(av.w); As[(lh + 7) * 68 + lr] = bfhi(av.w); }
                __syncthreads();
#pragma unroll
                for (int kk = 0; kk < 16; ++kk) {
                    const f32x4 a = *(const LAS f32x4*)(As + kk * 68 + 4 * ty), b0 = *(const LAS f32x4*)(Bs + kk * 260 + 4 * tx), b1 = *(const LAS f32x4*)(Bs + kk * 260 + 128 + 4 * tx);
#pragma unroll
                    for (int r = 0; r < 4; ++r) { ag[r] += a[r] * b0; au[r] += a[r] * b1; }
                }
            }
#pragma unroll
            for (int r = 0; r < 4; ++r) { const int row = sub * 64 + 4 * ty + r;
                if constexpr (Epi::PAIRED) E.st2(u, row, 4 * tx, ag[r], au[r]);
                else { E.st(u, row, 4 * tx, ag[r]); E.st(u, row, 128 + 4 * tx, au[r]); } }
        }
    __syncthreads();
}
template <class Epi, class Sched>
__device__ __forceinline__ void gemm_any(LAS unsigned char* lds, const pg8::Gemm g, const Sched& S, const Epi& E) {
#if USE_PG8
    pg8::gemm_phase<Epi, Sched, true, true>(lds, g, S, E);
#else
    naive_gemm_phase<Epi, Sched>(lds, g, S, E);
#endif
}

__device__ __forceinline__ void transpose_item(const float* W, int N, int K, bf16* WT, int k0, int n0, size_t drow0, LAS unsigned char* scr, int lane) {
    const int lc = lane & 15, lr = lane >> 4;
    f32x4 v[16];
#pragma unroll
    for (int i = 0; i < 16; ++i) v[i] = *(const f32x4*)(W + (size_t)(k0 + 4 * i + lr) * N + n0 + 4 * lc);
#pragma unroll
    for (int i = 0; i < 16; ++i) { const int k = 4 * i + lr;
#pragma unroll
        for (int j = 0; j < 4; ++j) *(LAS bf16*)(scr + (4 * lc + j) * 136 + k * 2) = (bf16)f2bf(v[i][j]); }
    LDS_WAIT(); asm volatile("" ::: "memory");
    const int c = lane & 7;
#pragma unroll
    for (int j = 0; j < 8; ++j) { const int n = (lane >> 3) + 8 * j;
        const v2u lo = *(const LAS v2u*)(scr + n * 136 + c * 16), hi = *(const LAS v2u*)(scr + n * 136 + c * 16 + 8);
        *(v4u*)(WT + (drow0 + n) * (size_t)K + k0 + 8 * c) = (v4u){lo.x, lo.y, hi.x, hi.y}; }
    LDS_WAIT(); asm volatile("" ::: "memory");
}
__device__ __forceinline__ void conv_load(const float* src, int N, int lane, f32x4 (&v)[16]);
struct P;
__device__ __forceinline__ void conv_desc(const P& p, int it, const float*& src, unsigned char*& dst, int& N, int& K);
__device__ __forceinline__ void conv_store(const f32x4 (&v)[16], unsigned char* dst, int K, LAS unsigned char* scr, int lane);
__device__ __forceinline__ void transpose_item_f8(const float* W, int N, int K, unsigned char* WT, int k0, int n0, size_t drow0, LAS unsigned char* scr, int lane) {
    f32x4 v[16]; conv_load(W + (size_t)k0 * N + n0, N, lane, v); conv_store(v, WT + drow0 * (size_t)K + k0, K, scr, lane);
}
constexpr int CONV_ITEMS = 16 * 32 + 16 * 16 + 3 * 512 * NE, CONV_CUT = CONV_ITEMS - 6144;
__device__ __forceinline__ void convert_items(const P& p, LAS unsigned char* lds, int lane, int wave, int first, int last, int gw, int NGW) {
    LAS unsigned char* scr = lds + wave * 16384;
    constexpr int I_IN = 16 * 32, I_OUT = 16 * 16, I_E = 512 * NE;
    for (int it = first + gw; it < last; it += NGW) {
        int r = it;
        if (r < I_IN) { const int kb = r >> 5, nb = r & 31; transpose_item(p.w_in, DIN, D, (bf16*)(p.ws + WS_WIN), 64 * kb, 64 * nb, (size_t)(64 * nb), scr, lane); continue; } r -= I_IN;
        if (r < I_OUT) { const int kb = r >> 4, nb = r & 15; transpose_item(p.w_out, D, D, (bf16*)(p.ws + WS_WOUT), 64 * kb, 64 * nb, (size_t)(64 * nb), scr, lane); continue; } r -= I_OUT;
#if MOE_FP8
        { const float* src_; unsigned char* dst_; int N_, K_; f32x4 v_[16]; conv_desc(p, it, src_, dst_, N_, K_); conv_load(src_, N_, lane, v_); conv_store(v_, dst_, K_, scr, lane); }
#else
        if (r < 2 * I_E) { const int which = r >= I_E; if (which) r -= I_E; const int e = r >> 9, q = r & 511, kb = q >> 5, nb = q & 31, n0 = 64 * nb;
            const float* W = (which ? p.w3 : p.w1) + (size_t)e * D * DE;
#if MOE_FP8
            transpose_item_f8(W, DE, D, p.ws + WS_WG, 64 * kb, n0, (size_t)e * 4096 + (size_t)(n0 >> 7) * 256 + (n0 & 127) + (which ? 128 : 0), scr, lane); continue; } r -= 2 * I_E;
#else
            transpose_item(W, DE, D, (bf16*)(p.ws + WS_WG), 64 * kb, n0, (size_t)e * 4096 + (size_t)(n0 >> 7) * 256 + (n0 & 127) + (which ? 128 : 0), scr, lane); continue; } r -= 2 * I_E;
#endif
        { const int e = r >> 9, q = r & 511, kb = q >> 4, nb = q & 15, n0 = 64 * nb;
#if MOE_FP8
            transpose_item_f8(p.w2 + (size_t)e * DE * D, D, DE, p.ws + WS_W2, 64 * kb, n0, (size_t)e * 1024 + n0, scr, lane); }
#else
            transpose_item(p.w2 + (size_t)e * DE * D, D, DE, (bf16*)(p.ws + WS_W2), 64 * kb, n0, (size_t)e * 1024 + n0, scr, lane); }
#endif
#endif
    }
}

#if MOE_FP8
constexpr int CONV_HEAD = 16 * 32 + 16 * 16;
__device__ __forceinline__ void conv_desc(const P& p, int it, const float*& src, unsigned char*& dst, int& N, int& K) {
    constexpr int I_E = 512 * NE; const int r0 = it - CONV_HEAD;
    const bool isw2 = r0 >= 2 * I_E, which = (!isw2) && r0 >= I_E; const int r = isw2 ? r0 - 2 * I_E : (which ? r0 - I_E : r0);
    const int e = r >> 9, q = r & 511, kb = isw2 ? (q >> 5) : (q >> 6), nb = isw2 ? (q & 31) : (q & 63), n0 = 32 * nb;
    N = isw2 ? D : DE; K = isw2 ? DE : D;
    const float* base = isw2 ? p.w2 : (which ? p.w3 : p.w1);
    src = base + (size_t)e * D * DE + (size_t)(128 * kb) * N + n0;
    const size_t drow = isw2 ? ((size_t)e * 1024 + n0) : ((size_t)e * 4096 + (size_t)(n0 >> 7) * 256 + (n0 & 127) + (which ? 128 : 0));
    dst = p.ws + (isw2 ? WS_W2 : WS_WG) + drow * (size_t)K + 128 * kb;
}
__device__ __forceinline__ void conv_load(const float* src, int N, int lane, f32x4 (&v)[16]) {
    const int lc = lane & 7, lr = lane >> 3;
#pragma unroll
    for (int i = 0; i < 16; ++i) v[i] = __builtin_nontemporal_load((const f32x4*)(src + (size_t)(16 * lr + i) * N + 4 * lc));
}
__device__ __forceinline__ void conv_store(const f32x4 (&v)[16], unsigned char* dst, int K, LAS unsigned char* scr, int lane) {
    const int lc = lane & 7, lr = lane >> 3; (void)scr;
#pragma unroll
    for (int j = 0; j < 4; ++j) { v4u o;
        o.x = pk4_fp8(v[0][j] * WSCALE, v[1][j] * WSCALE, v[2][j] * WSCALE, v[3][j] * WSCALE);
        o.y = pk4_fp8(v[4][j] * WSCALE, v[5][j] * WSCALE, v[6][j] * WSCALE, v[7][j] * WSCALE);
        o.z = pk4_fp8(v[8][j] * WSCALE, v[9][j] * WSCALE, v[10][j] * WSCALE, v[11][j] * WSCALE);
        o.w = pk4_fp8(v[12][j] * WSCALE, v[13][j] * WSCALE, v[14][j] * WSCALE, v[15][j] * WSCALE);
        __builtin_nontemporal_store(o, (v4u*)(dst + (size_t)(4 * lc + j) * K + 16 * lr)); }
}
__device__ __forceinline__ void convert_pipelined(const P& p, LAS unsigned char* lds, int lane, int wave, int first, int last, int gw, int NGW) {
    LAS unsigned char* scr = lds + wave * 16384;
    f32x4 va[16], vb[16], vc[16]; const float* s0; unsigned char* da; unsigned char* db; unsigned char* dc; int N0, Ka, Kb, Kc;
    int it = first + gw; if (it >= last) return;
    const int itl = it + ((last - 1 - it) / NGW) * NGW;
    conv_desc(p, it, s0, da, N0, Ka); conv_load(s0, N0, lane, va);
    { const int i1 = min(it + NGW, itl); conv_desc(p, i1, s0, db, N0, Kb); conv_load(s0, N0, lane, vb); }
    for (; it <= itl; it += 3 * NGW) {
        { const int i2 = min(it + 2 * NGW, itl); conv_desc(p, i2, s0, dc, N0, Kc); conv_load(s0, N0, lane, vc); }
        conv_store(va, da, Ka, scr, lane);
        { const int i3 = min(it + 3 * NGW, itl); conv_desc(p, i3, s0, da, N0, Ka); conv_load(s0, N0, lane, va); }
        conv_store(vb, db, Kb, scr, lane);
        { const int i4 = min(it + 4 * NGW, itl); conv_desc(p, i4, s0, db, N0, Kb); conv_load(s0, N0, lane, vb); }
        conv_store(vc, dc, Kc, scr, lane);
    }
}
#endif
__device__ __forceinline__ void p0_small_copies(const P& p, int tid, int vcu, int G) {
    bf16* GWT = (bf16*)(p.ws + WS_GWT); bf16* SWB = (bf16*)(p.ws + WS_SWB); const int gt = vcu * NTHREADS + tid, NT = G * NTHREADS;
    for (int o = gt; o < 131072; o += NT) { const int i = o & 63, j = (o >> 6) & 63, h = (o >> 12) & 7, g = (o >> 15) & 1, d = o >> 16;
        GWT[o] = (bf16)f2bf((g ? p.rg_wi : p.rg_wa)[(size_t)((d * 8 + h) * 64 + i) * 64 + j]); }
    for (int o = gt; o < 65536; o += NT) SWB[o] = (bf16)f2bf(p.sgu_w[o]);
}
__device__ __forceinline__ void phase_p0(const P& p, LAS unsigned char* lds, int tid, int lane, int wave, int vcu, int G, int conv_last, bool small = true) {
    float* MOD = (float*)(p.ws + WS_MOD);
    {
        LAS float* sc = (LAS float*)lds; LAS float* part = (LAS float*)(lds + 36864);
        if (vcu < 192) {
            float cv[18];
#pragma unroll
            for (int i = 0; i < 18; ++i) { const int e = tid + i * NTHREADS, j = e >> 10, k = e & 1023; cv[i] = j < 8 ? p.c[j * D + k] : p.c_ctx[k]; }
#pragma unroll
            for (int i = 0; i < 18; ++i) sc[tid + i * NTHREADS] = siluf_(cv[i]);
        }
        __syncthreads();
        for (int t = vcu; t < 192; t += G) {
            const int col = lane & 31, kh = lane >> 5, n = t * 32 + col, kbase = wave * 128 + kh * 64; float acc[9];
#pragma unroll
            for (int j = 0; j < 9; ++j) acc[j] = 0.f;
            for (int k0 = 0; k0 < 64; k0 += 16) { float w[16];
#pragma unroll
                for (int i = 0; i < 16; ++i) w[i] = p.w_mod[(size_t)(kbase + k0 + i) * NMOD + n];
#pragma unroll
                for (int i = 0; i < 16; ++i)
#pragma unroll
                    for (int j = 0; j < 9; ++j) acc[j] += sc[j * D + kbase + k0 + i] * w[i]; }
#pragma unroll
            for (int j = 0; j < 9; ++j) { acc[j] += __shfl_xor(acc[j], 32); if (lane < 32) part[(wave * 9 + j) * 32 + lane] = acc[j]; }
            __syncthreads();
            for (int i = tid; i < 9 * 32; i += NTHREADS) { const int j = i >> 5, l = i & 31; float s2 = p.b_mod[t * 32 + l];
#pragma unroll
                for (int w = 0; w < 8; ++w) s2 += part[(w * 9 + j) * 32 + l];
                MOD[j * NMOD + t * 32 + l] = s2; }
            __syncthreads();
        }
    }
    convert_items(p, lds, lane, wave, 0, conv_last, vcu * NWAVES + wave, G * NWAVES);
    if (small) p0_small_copies(p, tid, vcu, G);
}

__device__ __forceinline__ void phase_p1(const P& p, int lane, int wave, int vcu, int G) {
    const float* MOD = (const float*)(p.ws + WS_MOD); bf16* HX = (bf16*)(p.ws + WS_HX);
    const int gw = vcu * NWAVES + wave, NGW = G * NWAVES;
    for (int i = gw; i < BATCH * NE; i += NGW) { const int b = i >> 4, e = i & 15; float a = 0.f;
        for (int k = lane; k < D; k += 64) a += MOD[b * NMOD + 3 * D + k] * p.w_router[k * NE + e];
        a = wave_sum(a); if (lane == 0) ((float*)(p.ws + WS_CB))[i] = a; }
    f32x4 nx[4];
    { const int m = gw; if (m < MT) { const f32x4* xr = (const f32x4*)(m < M ? p.x + (size_t)m * D : p.ctx + (size_t)(m - M) * D) + lane;
#pragma unroll
        for (int jj = 0; jj < 4; ++jj) nx[jj] = xr[64 * jj]; } }
    for (int m = gw; m < MT; m += NGW) {
        const int j = m < M ? (m >> 11) : 8;
        f32x4 v[4]; float s = 0.f;
#pragma unroll
        for (int jj = 0; jj < 4; ++jj) { v[jj] = nx[jj]; s += (v[jj].x * v[jj].x + v[jj].y * v[jj].y) + (v[jj].z * v[jj].z + v[jj].w * v[jj].w); }
        { const int m2 = m + NGW; if (m2 < MT) { const f32x4* xr = (const f32x4*)(m2 < M ? p.x + (size_t)m2 * D : p.ctx + (size_t)(m2 - M) * D) + lane;
#pragma unroll
            for (int jj = 0; jj < 4; ++jj) nx[jj] = xr[64 * jj]; } }
        const float rinv = rsqrtf(wave_sum(s) * (1.f / D) + EPS);
        v2u* o = (v2u*)(HX + (size_t)m * D) + lane;
#pragma unroll
        for (int jj = 0; jj < 4; ++jj) { const int k = 4 * (lane + 64 * jj);
            const f32x4 g = *(const f32x4*)(p.norm1_g + k), sh = *(const f32x4*)(MOD + j * NMOD + k), sc = *(const f32x4*)(MOD + j * NMOD + D + k);
            const f32x4 h = v[jj] * rinv * g * (sc + 1.f) + sh; v2u w; w.x = pk2(h.x, h.y); w.y = pk2(h.z, h.w); o[64 * jj] = w; }
    }
}

__device__ __forceinline__ void phase_lru1(const P& p, LAS unsigned char* lds, int tid, int vcu, int G) {
    LAS float* xt = (LAS float*)lds;
    LAS float* cx = (LAS float*)(lds + 17152);
    LAS float* af = (LAS float*)(lds + 33536);
    LAS float* df = (LAS float*)(lds + 49920);
    LAS float* ab = (LAS float*)(lds + 66304);
    LAS float* db = (LAS float*)(lds + 82688);
    const bf16* UV = (const bf16*)(p.ws + WS_UV); const bf16* XC = (const bf16*)(p.ws + WS_XC);
    bf16* HS = (bf16*)(p.ws + WS_HS); bf16* PF = (bf16*)(p.ws + WS_PF); bf16* PB = (bf16*)(p.ws + WS_PB); float* SUM = (float*)(p.ws + WS_SUM);
    for (int T = vcu; T < BATCH * NSEG * 8; T += G) {
        const int b = T / (NSEG * 8), rem = T % (NSEG * 8), seg = rem >> 3, h = rem & 7;
        for (int i = tid; i < 67 * 64; i += NTHREADS) { const int r = (i >> 6) - 1, ch = i & 63; float v = 0.f;
            if (seg < 4) { const int pos = seg * 64 + r; if (pos >= 0 && pos < CTXL) v = bf2f(XC[(size_t)(b * CTXL + pos) * DLRU + h * 64 + ch]); }
            else { if (r >= 0 && r < 64) v = bf2f(UV[(size_t)(b * SEQ + (seg - 4) * 64 + r) * DIN + 1024 + h * 64 + ch]); }
            xt[i] = v; }
        __syncthreads();
        for (int i = tid; i < 4096; i += NTHREADS) { const int r = i >> 6, ch = i & 63, cch = h * 64 + ch; float v = p.conv_b[cch];
#pragma unroll
            for (int j = 0; j < 4; ++j) v += p.conv_w[j * DLRU + cch] * xt[(r + j) * 64 + ch];
            cx[i] = v; }
        __syncthreads();
        { const int jj = tid & 63, r0 = tid >> 6, cch = h * 64 + jj;
#pragma unroll
          for (int d = 0; d < 2; ++d) {
            float aa[8], ai[8];
#pragma unroll
            for (int q = 0; q < 8; ++q) { aa[q] = 0.f; ai[q] = 0.f; }
            const float* wa = p.rg_wa + (size_t)((d * 8 + h) * 64) * 64 + jj; const float* wi = p.rg_wi + (size_t)((d * 8 + h) * 64) * 64 + jj;
#pragma unroll 2
            for (int i = 0; i < 64; ++i) { const float wav = wa[i * 64], wiv = wi[i * 64];
#pragma unroll
                for (int q = 0; q < 8; ++q) { const float cv = cx[(r0 + 8 * q) * 64 + i]; aa[q] += cv * wav; ai[q] += cv * wiv; } }
            const float ba = p.rg_ba[d * DLRU + cch], bi = p.rg_bi[d * DLRU + cch], c8 = -8.f * log1pf(expf(-p.rg_lam[d * DLRU + cch]));
            LAS float* ao = d ? ab : af; LAS float* dout = d ? db : df;
#pragma unroll
            for (int q = 0; q < 8; ++q) { const int r = r0 + 8 * q; const float rg = sigmoidf_(aa[q] + ba), ig = sigmoidf_(ai[q] + bi), la = c8 * rg;
                ao[r * 64 + jj] = expf(la); dout[r * 64 + jj] = sqrtf(-expm1f(2.f * la)) * ig * cx[r * 64 + jj]; }
          } }
        __syncthreads();
        if (tid < 128) { const int d = tid >> 6, ch = tid & 63; float hh = 0.f, pp = 1.f;
            if (d == 0) {
#pragma unroll 4
                for (int r = 0; r < 64; ++r) { const float a = af[r * 64 + ch]; hh = a * hh + df[r * 64 + ch]; pp *= a; df[r * 64 + ch] = hh; af[r * 64 + ch] = pp; } }
            else {
#pragma unroll 4
                for (int r = 63; r >= 0; --r) { const float a = ab[r * 64 + ch]; hh = a * hh + db[r * 64 + ch]; pp *= a; db[r * 64 + ch] = hh; ab[r * 64 + ch] = pp; } }
            float* s = SUM + ((size_t)((b * NSEG + seg) * 2 + d) * DLRU + h * 64 + ch) * 2; s[0] = pp; s[1] = hh; }
        __syncthreads();
        if (seg >= 4) for (int i = tid; i < 4096; i += NTHREADS) { const int r = i >> 6, ch = i & 63; const size_t o = (size_t)(b * SEQ + (seg - 4) * 64 + r) * DLRU + h * 64 + ch;
            HS[o] = (bf16)f2bf(df[i] + db[i]); PF[o] = (bf16)f2bf(af[i]); PB[o] = (bf16)f2bf(ab[i]); }
        __syncthreads();
    }
}

__device__ __forceinline__ void phase_sgu(const P& p, LAS unsigned char* lds, int tid, int vcu, int G) {
    LAS float* vn = (LAS float*)lds;
    LAS float* wsl = (LAS float*)(lds + 65536);
    const bf16* UV = (const bf16*)(p.ws + WS_UV); bf16* A2 = (bf16*)(p.ws + WS_A2);
    for (int T = vcu; T < 512; T += G) {
        const int b = T >> 6, n = (T >> 2) & 15, h = T & 3; const size_t t0 = (size_t)b * SEQ + n * 128;
        for (int i = tid; i < 16384; i += NTHREADS) { const int q = i >> 7, c = i & 127; vn[i] = bf2f(UV[(t0 + q) * DIN + 512 + h * 128 + c]); wsl[i] = p.sgu_w[h * 16384 + i]; }
        __syncthreads();
        { const int q = tid >> 2, part = tid & 3; float s = 0.f;
          for (int c = part * 32; c < part * 32 + 32; ++c) { const float v = vn[q * 128 + c]; s += v * v; }
          s += __shfl_xor(s, 1); s += __shfl_xor(s, 2);
          const float rinv = rsqrtf(s * (1.f / 128.f) + EPS);
          for (int c = part * 32; c < part * 32 + 32; ++c) vn[q * 128 + c] *= rinv * p.sgu_g[h * 128 + c]; }
        __syncthreads();
        { const int c = tid & 127, p0 = tid >> 7; float acc[32];
#pragma unroll
          for (int i = 0; i < 32; ++i) acc[i] = 0.f;
          for (int q = 0; q < 128; ++q) { const float vq = vn[q * 128 + c];
#pragma unroll
              for (int i = 0; i < 32; ++i) acc[i] += wsl[(p0 + 4 * i) * 128 + q] * vq; }
#pragma unroll
          for (int i = 0; i < 32; ++i) { const int pp = p0 + 4 * i; const float s = acc[i] + p.sgu_b[h * 128 + pp];
              const float uu = bf2f(UV[(t0 + pp) * DIN + h * 128 + c]); A2[(t0 + pp) * D + h * 128 + c] = (bf16)f2bf(uu * s); } }
        __syncthreads();
    }
}


__device__ __forceinline__ void phase_lru1_mfma(const P& p, LAS unsigned char* lds, int tid, int lane, int wave, int vcu, int G) {
    LAS float* xt = (LAS float*)lds;
    LAS float* cxf = (LAS float*)(lds + 17152);
    LAS unsigned char* cxb = lds + 33536;
    LAS float* AD = (LAS float*)(lds + 42752);
    LAS float* SS = (LAS float*)(lds + 108288);
    const bf16* UV = (const bf16*)(p.ws + WS_UV); const bf16* XC = (const bf16*)(p.ws + WS_XC); const bf16* GWT = (const bf16*)(p.ws + WS_GWT);
    bf16* HS = (bf16*)(p.ws + WS_HS); bf16* PF = (bf16*)(p.ws + WS_PF); bf16* PB = (bf16*)(p.ws + WS_PB); float* SUM = (float*)(p.ws + WS_SUM);
    const int fr = lane & 15, fq = lane >> 4;
    const int wd = wave >> 2, jt = wave & 3, wj = 16 * jt + fr, cch_c = tid & 63;
    int hcur = -1; bf16x8 bfr[2][2]; float ba = 0.f, bi = 0.f, c8 = 0.f, cw0 = 0.f, cw1 = 0.f, cw2 = 0.f, cw3 = 0.f, cbias = 0.f;
    auto load_piece = [&](int T, int i) -> v4u { const int b = T / (NSEG * 8), rem = T % (NSEG * 8), seg = rem >> 3, h = rem & 7, r = (i >> 3) - 1, c0 = (i & 7) * 8; v4u w = (v4u){0u, 0u, 0u, 0u};
        if (seg < 4) { const int pos = seg * 64 + r; if (pos >= 0 && pos < CTXL) w = *(const v4u*)(XC + (size_t)(b * CTXL + pos) * DLRU + h * 64 + c0); }
        else { if (r >= 0 && r < 64) w = *(const v4u*)(UV + (size_t)(b * SEQ + (seg - 4) * 64 + r) * DIN + 1024 + h * 64 + c0); }
        return w; };
    v4u pre0 = (v4u){0u, 0u, 0u, 0u}, pre1 = (v4u){0u, 0u, 0u, 0u};
    if (vcu < BATCH * NSEG * 8) { pre0 = load_piece(vcu, tid); if (tid < 24) pre1 = load_piece(vcu, tid + 512); }
    for (int T = vcu; T < BATCH * NSEG * 8; T += G) {
        const int b = T / (NSEG * 8), rem = T % (NSEG * 8), seg = rem >> 3, h = rem & 7;
        { LAS float* o = xt + (tid >> 3) * 64 + (tid & 7) * 8;
          *(LAS f32x4*)o = (f32x4){bflo(pre0.x), bfhi(pre0.x), bflo(pre0.y), bfhi(pre0.y)}; *(LAS f32x4*)(o + 4) = (f32x4){bflo(pre0.z), bfhi(pre0.z), bflo(pre0.w), bfhi(pre0.w)};
          if (tid < 24) { LAS float* o1 = xt + ((tid + 512) >> 3) * 64 + (tid & 7) * 8;
              *(LAS f32x4*)o1 = (f32x4){bflo(pre1.x), bfhi(pre1.x), bflo(pre1.y), bfhi(pre1.y)}; *(LAS f32x4*)(o1 + 4) = (f32x4){bflo(pre1.z), bfhi(pre1.z), bflo(pre1.w), bfhi(pre1.w)}; } }
        if (h != hcur) { hcur = h;
#pragma unroll
            for (int g = 0; g < 2; ++g)
#pragma unroll
                for (int ks = 0; ks < 2; ++ks) bfr[g][ks] = *(const bf16x8*)(GWT + (size_t)((((wd * 2 + g) * 8 + h) * 64 + wj) * 64 + 32 * ks + 8 * fq));
            ba = p.rg_ba[wd * DLRU + h * 64 + wj]; bi = p.rg_bi[wd * DLRU + h * 64 + wj]; c8 = -8.f * log1pf(expf(-p.rg_lam[wd * DLRU + h * 64 + wj]));
            cw0 = p.conv_w[h * 64 + cch_c]; cw1 = p.conv_w[DLRU + h * 64 + cch_c]; cw2 = p.conv_w[2 * DLRU + h * 64 + cch_c]; cw3 = p.conv_w[3 * DLRU + h * 64 + cch_c]; cbias = p.conv_b[h * 64 + cch_c]; }
        __syncthreads();
        if (T + G < BATCH * NSEG * 8) { pre0 = load_piece(T + G, tid); if (tid < 24) pre1 = load_piece(T + G, tid + 512); }
        for (int i = tid; i < 4096; i += NTHREADS) { const int r = i >> 6, ch = i & 63;
            const float v = cbias + cw0 * xt[r * 64 + ch] + cw1 * xt[(r + 1) * 64 + ch] + cw2 * xt[(r + 2) * 64 + ch] + cw3 * xt[(r + 3) * 64 + ch];
            cxf[i] = v; *(LAS bf16*)(cxb + r * 144 + ch * 2) = (bf16)f2bf(v); }
        __syncthreads();
        { const int d = wd, j = wj;
          LAS float* Ad = AD + d * 8192; LAS float* Dd = Ad + 4096;
#pragma unroll
          for (int pt = 0; pt < 4; ++pt) {
              const bf16x8 a0 = *(const LAS bf16x8*)(cxb + (16 * pt + fr) * 144 + 16 * fq), a1 = *(const LAS bf16x8*)(cxb + (16 * pt + fr) * 144 + 64 + 16 * fq);
              f32x4 ca = (f32x4){0.f, 0.f, 0.f, 0.f}, ci = (f32x4){0.f, 0.f, 0.f, 0.f};
              ca = __builtin_amdgcn_mfma_f32_16x16x32_bf16(a0, bfr[0][0], ca, 0, 0, 0); ca = __builtin_amdgcn_mfma_f32_16x16x32_bf16(a1, bfr[0][1], ca, 0, 0, 0);
              ci = __builtin_amdgcn_mfma_f32_16x16x32_bf16(a0, bfr[1][0], ci, 0, 0, 0); ci = __builtin_amdgcn_mfma_f32_16x16x32_bf16(a1, bfr[1][1], ci, 0, 0, 0);
#pragma unroll
              for (int r = 0; r < 4; ++r) { const int pos = 16 * pt + 4 * fq + r; const float rg = sigmoidf_(ca[r] + ba), ig = sigmoidf_(ci[r] + bi), la = c8 * rg;
                  float av, sv; decay_pair(la, av, sv); Ad[pos * 64 + j] = av; Dd[pos * 64 + j] = sv * ig * cxf[pos * 64 + j]; }
          } }
        __syncthreads();
        { const int sub = tid >> 7, d = (tid >> 6) & 1, ch = tid & 63;
          LAS float* Ad = AD + d * 8192; LAS float* Dd = Ad + 4096;
          float hl[16], pc[16]; float hh = 0.f, pp = 1.f;
#pragma unroll
          for (int t = 0; t < 16; ++t) { const int pos = d ? 16 * sub + 15 - t : 16 * sub + t; const float a = Ad[pos * 64 + ch]; hh = a * hh + Dd[pos * 64 + ch]; pp *= a; hl[t] = hh; pc[t] = pp; }
          SS[((sub * 2 + d) * 64 + ch) * 2] = pp; SS[((sub * 2 + d) * 64 + ch) * 2 + 1] = hh;
          __syncthreads();
          float cin = 0.f, cp = 1.f;
          if (d == 0) { for (int s2 = 0; s2 < sub; ++s2) { const float A = SS[((s2 * 2) * 64 + ch) * 2], B = SS[((s2 * 2) * 64 + ch) * 2 + 1]; cin = A * cin + B; cp *= A; } }
          else { for (int s2 = 3; s2 > sub; --s2) { const float A = SS[((s2 * 2 + 1) * 64 + ch) * 2], B = SS[((s2 * 2 + 1) * 64 + ch) * 2 + 1]; cin = A * cin + B; cp *= A; } }
#pragma unroll
          for (int t = 0; t < 16; ++t) { const int pos = d ? 16 * sub + 15 - t : 16 * sub + t; Dd[pos * 64 + ch] = hl[t] + pc[t] * cin; Ad[pos * 64 + ch] = pc[t] * cp; }
          if ((d == 0 && sub == 3) || (d == 1 && sub == 0)) { float* so = SUM + ((size_t)((b * NSEG + seg) * 2 + d) * DLRU + h * 64 + ch) * 2; so[0] = pc[15] * cp; so[1] = hl[15] + pc[15] * cin; }
        }
        __syncthreads();
        if (seg >= 4) { const int pos = tid >> 3, c0 = (tid & 7) * 8; const LAS float* q0 = AD + pos * 64 + c0;
            const f32x4 a0l = *(const LAS f32x4*)(q0), a0h = *(const LAS f32x4*)(q0 + 4), d0l = *(const LAS f32x4*)(q0 + 4096), d0h = *(const LAS f32x4*)(q0 + 4100);
            const f32x4 a1l = *(const LAS f32x4*)(q0 + 8192), a1h = *(const LAS f32x4*)(q0 + 8196), d1l = *(const LAS f32x4*)(q0 + 12288), d1h = *(const LAS f32x4*)(q0 + 12292);
            const f32x4 sl = d0l + d1l, sh = d0h + d1h; const size_t o = (size_t)(b * SEQ + (seg - 4) * 64 + pos) * DLRU + h * 64 + c0;
            *(v4u*)(HS + o) = (v4u){pk2(sl.x, sl.y), pk2(sl.z, sl.w), pk2(sh.x, sh.y), pk2(sh.z, sh.w)};
            *(v4u*)(PF + o) = (v4u){pk2(a0l.x, a0l.y), pk2(a0l.z, a0l.w), pk2(a0h.x, a0h.y), pk2(a0h.z, a0h.w)};
            *(v4u*)(PB + o) = (v4u){pk2(a1l.x, a1l.y), pk2(a1l.z, a1l.w), pk2(a1h.x, a1h.y), pk2(a1h.z, a1h.w)}; }
        __syncthreads();
    }
}


template <int WD>
__device__ __forceinline__ void lru_scan(const float (&ga)[4][4], const float (&gb)[4][4], LAS float* EX, int lane, int fr, int fq, int wj, float& Pin, float& Hin) {
    const int cq = WD ? 3 - fq : fq, l16 = (WD ? lane + 16 : lane - 16) & 63, l32 = (WD ? lane + 32 : lane - 32) & 63, llast = WD ? fr : fr + 48;
    LAS float* Pd = EX + WD * 8192; LAS float* Hd = Pd + 4096;
#pragma unroll
    for (int ptc = 0; ptc < 4; ++ptc) { constexpr int dummy = 0; (void)dummy; const int pt = WD ? 3 - ptc : ptc;
        float pr[4], hr[4]; float hh = 0.f, pp = 1.f;
#pragma unroll
        for (int rc = 0; rc < 4; ++rc) { const int r = WD ? 3 - rc : rc; hh = ga[pt][r] * hh + gb[pt][r]; pp *= ga[pt][r]; pr[r] = pp; hr[r] = hh; }
        float A = pp, B = hh;
        { const float tA = __shfl(A, l16), tB = __shfl(B, l16); if (cq >= 1) { B = A * tB + B; A = tA * A; } }
        { const float tA = __shfl(A, l32), tB = __shfl(B, l32); if (cq >= 2) { B = A * tB + B; A = tA * A; } }
        float eA = __shfl(A, l16), eB = __shfl(B, l16); if (cq == 0) { eA = 1.f; eB = 0.f; }
        const float tAt = __shfl(A, llast), tBt = __shfl(B, llast);
        const float Hc = eA * Hin + eB, Pc = Pin * eA;
#pragma unroll
        for (int r = 0; r < 4; ++r) { const int pos = 16 * pt + 4 * fq + r; Hd[pos * 64 + wj] = pr[r] * Hc + hr[r]; Pd[pos * 64 + wj] = Pc * pr[r]; }
        Hin = tAt * Hin + tBt; Pin *= tAt;
    }
}

__device__ __forceinline__ void phase_lru1_v2(const P& p, LAS unsigned char* lds, int tid, int lane, int wave, int vcu, int G) {
    LAS float* xt = (LAS float*)lds;
    LAS float* cxf = (LAS float*)(lds + 17152);
    LAS unsigned char* cxb = lds + 33536;
    LAS float* EX = (LAS float*)(lds + 42752);
    const bf16* UV = (const bf16*)(p.ws + WS_UV); const bf16* XC = (const bf16*)(p.ws + WS_XC); const bf16* GWT = (const bf16*)(p.ws + WS_GWT);
    bf16* HS = (bf16*)(p.ws + WS_HS); bf16* PF = (bf16*)(p.ws + WS_PF); bf16* PB = (bf16*)(p.ws + WS_PB); float* SUM = (float*)(p.ws + WS_SUM);
    const int fr = lane & 15, fq = lane >> 4;
    const int wd = wave >> 2, jt = wave & 3, wj = 16 * jt + fr, cch_c = tid & 63;
    int hcur = -1; bf16x8 bfr[2][2]; float ba = 0.f, bi = 0.f, c8 = 0.f, cw0 = 0.f, cw1 = 0.f, cw2 = 0.f, cw3 = 0.f, cbias = 0.f;
    auto load_piece = [&](int T, int i) -> v4u { const int b = T / (NSEG * 8), rem = T % (NSEG * 8), seg = rem >> 3, h = rem & 7, r = (i >> 3) - 1, c0 = (i & 7) * 8; v4u w = (v4u){0u, 0u, 0u, 0u};
        if (seg < 4) { const int pos = seg * 64 + r; if (pos >= 0 && pos < CTXL) w = *(const v4u*)(XC + (size_t)(b * CTXL + pos) * DLRU + h * 64 + c0); }
        else { if (r >= 0 && r < 64) w = *(const v4u*)(UV + (size_t)(b * SEQ + (seg - 4) * 64 + r) * DIN + 1024 + h * 64 + c0); }
        return w; };
    v4u pre0 = (v4u){0u, 0u, 0u, 0u}, pre1 = (v4u){0u, 0u, 0u, 0u};
    if (vcu < BATCH * NSEG * 8) { pre0 = load_piece(vcu, tid); if (tid < 24) pre1 = load_piece(vcu, tid + 512); }
    for (int T = vcu; T < BATCH * NSEG * 8; T += G) {
        const int b = T / (NSEG * 8), rem = T % (NSEG * 8), seg = rem >> 3, h = rem & 7;
        { LAS float* o = xt + (tid >> 3) * 64 + (tid & 7) * 8;
          *(LAS f32x4*)o = (f32x4){bflo(pre0.x), bfhi(pre0.x), bflo(pre0.y), bfhi(pre0.y)}; *(LAS f32x4*)(o + 4) = (f32x4){bflo(pre0.z), bfhi(pre0.z), bflo(pre0.w), bfhi(pre0.w)};
          if (tid < 24) { LAS float* o1 = xt + ((tid + 512) >> 3) * 64 + (tid & 7) * 8;
              *(LAS f32x4*)o1 = (f32x4){bflo(pre1.x), bfhi(pre1.x), bflo(pre1.y), bfhi(pre1.y)}; *(LAS f32x4*)(o1 + 4) = (f32x4){bflo(pre1.z), bfhi(pre1.z), bflo(pre1.w), bfhi(pre1.w)}; } }
        if (h != hcur) { hcur = h;
#pragma unroll
            for (int g = 0; g < 2; ++g)
#pragma unroll
                for (int ks = 0; ks < 2; ++ks) bfr[g][ks] = *(const bf16x8*)(GWT + (size_t)((((wd * 2 + g) * 8 + h) * 64 + wj) * 64 + 32 * ks + 8 * fq));
            ba = p.rg_ba[wd * DLRU + h * 64 + wj]; bi = p.rg_bi[wd * DLRU + h * 64 + wj]; c8 = -8.f * log1pf(expf(-p.rg_lam[wd * DLRU + h * 64 + wj]));
            cw0 = p.conv_w[h * 64 + cch_c]; cw1 = p.conv_w[DLRU + h * 64 + cch_c]; cw2 = p.conv_w[2 * DLRU + h * 64 + cch_c]; cw3 = p.conv_w[3 * DLRU + h * 64 + cch_c]; cbias = p.conv_b[h * 64 + cch_c];
            asm volatile("" : "+v"(ba), "+v"(bi), "+v"(c8), "+v"(cw0), "+v"(cw1), "+v"(cw2), "+v"(cw3), "+v"(cbias) :: "memory");
#pragma unroll
            for (int g = 0; g < 2; ++g)
#pragma unroll
                for (int ks = 0; ks < 2; ++ks) asm volatile("" : "+v"(bfr[g][ks]) :: "memory"); }
        __syncthreads();
        if (T + G < BATCH * NSEG * 8) { pre0 = load_piece(T + G, tid); if (tid < 24) pre1 = load_piece(T + G, tid + 512); }
        for (int i = tid; i < 4096; i += NTHREADS) { const int r = i >> 6, ch = i & 63;
            const float v = cbias + cw0 * xt[r * 64 + ch] + cw1 * xt[(r + 1) * 64 + ch] + cw2 * xt[(r + 2) * 64 + ch] + cw3 * xt[(r + 3) * 64 + ch];
            cxf[i] = v; *(LAS bf16*)(cxb + r * 144 + ch * 2) = (bf16)f2bf(v); }
        __syncthreads();
        {
            float ga[4][4], gb[4][4];
#pragma unroll
            for (int pt = 0; pt < 4; ++pt) {
                const bf16x8 a0 = *(const LAS bf16x8*)(cxb + (16 * pt + fr) * 144 + 16 * fq), a1 = *(const LAS bf16x8*)(cxb + (16 * pt + fr) * 144 + 64 + 16 * fq);
                f32x4 ca = (f32x4){0.f, 0.f, 0.f, 0.f}, ci = (f32x4){0.f, 0.f, 0.f, 0.f};
                ca = __builtin_amdgcn_mfma_f32_16x16x32_bf16(a0, bfr[0][0], ca, 0, 0, 0); ca = __builtin_amdgcn_mfma_f32_16x16x32_bf16(a1, bfr[0][1], ca, 0, 0, 0);
                ci = __builtin_amdgcn_mfma_f32_16x16x32_bf16(a0, bfr[1][0], ci, 0, 0, 0); ci = __builtin_amdgcn_mfma_f32_16x16x32_bf16(a1, bfr[1][1], ci, 0, 0, 0);
#pragma unroll
                for (int r = 0; r < 4; r += 2) { const int pos = 16 * pt + 4 * fq + r;
                    const f32x2p rg = sigmoid2_((f32x2p){ca[r], ca[r + 1]} + ba), ig = sigmoid2_((f32x2p){ci[r], ci[r + 1]} + bi); f32x2p av, sv; decay_pair2(rg * c8, av, sv);
                    const f32x2p dv = sv * ig * (f32x2p){cxf[pos * 64 + wj], cxf[(pos + 1) * 64 + wj]}; ga[pt][r] = av.x; ga[pt][r + 1] = av.y; gb[pt][r] = dv.x; gb[pt][r + 1] = dv.y; }
            }
            float Pin = 1.f, Hin = 0.f;
            if (wd == 0) lru_scan<0>(ga, gb, EX, lane, fr, fq, wj, Pin, Hin); else lru_scan<1>(ga, gb, EX, lane, fr, fq, wj, Pin, Hin);
            if (fq == 0) { float* so = SUM + ((size_t)((b * NSEG + seg) * 2 + wd) * DLRU + h * 64 + wj) * 2; so[0] = Pin; so[1] = Hin; }
        }
        __syncthreads();
        if (seg >= 4) { const int pos = tid >> 3, c0 = (tid & 7) * 8; const LAS float* q0 = EX + pos * 64 + c0;
            const f32x4 a0l = *(const LAS f32x4*)(q0), a0h = *(const LAS f32x4*)(q0 + 4), d0l = *(const LAS f32x4*)(q0 + 4096), d0h = *(const LAS f32x4*)(q0 + 4100);
            const f32x4 a1l = *(const LAS f32x4*)(q0 + 8192), a1h = *(const LAS f32x4*)(q0 + 8196), d1l = *(const LAS f32x4*)(q0 + 12288), d1h = *(const LAS f32x4*)(q0 + 12292);
            const f32x4 sl = d0l + d1l, sh = d0h + d1h; const size_t o = (size_t)(b * SEQ + (seg - 4) * 64 + pos) * DLRU + h * 64 + c0;
            *(v4u*)(HS + o) = (v4u){pk2(sl.x, sl.y), pk2(sl.z, sl.w), pk2(sh.x, sh.y), pk2(sh.z, sh.w)};
            *(v4u*)(PF + o) = (v4u){pk2(a0l.x, a0l.y), pk2(a0l.z, a0l.w), pk2(a0h.x, a0h.y), pk2(a0h.z, a0h.w)};
            *(v4u*)(PB + o) = (v4u){pk2(a1l.x, a1l.y), pk2(a1l.z, a1l.w), pk2(a1h.x, a1h.y), pk2(a1h.z, a1h.w)}; }
    }
    __syncthreads();
}

#define SGU_GLD4(r, ptr) asm volatile("global_load_dwordx4 %0, %4, off\n\tglobal_load_dwordx4 %1, %4, off offset:64\n\tglobal_load_dwordx4 %2, %4, off offset:128\n\tglobal_load_dwordx4 %3, %4, off offset:192" \
    : "=&v"(r[0]), "=&v"(r[1]), "=&v"(r[2]), "=&v"(r[3]) : "v"(ptr) : "memory")
__device__ __forceinline__ void phase_sgu_mfma(const P& p, LAS unsigned char* lds, int tid, int lane, int wave, int vcu, int G, int first = 0, int last = 512) {
    LAS unsigned char* vnT = lds;
    LAS unsigned char* ul = lds + 34816;
    const bf16* UV = (const bf16*)(p.ws + WS_UV); const bf16* SWB = (const bf16*)(p.ws + WS_SWB); bf16* A2 = (bf16*)(p.ws + WS_A2);
    const int fr = lane & 15, fq = lane >> 4, q = tid >> 2, part = tid & 3;
    int T = first + vcu; if (T >= last) return;
    v4u vw[4], uw[4];
    auto issue = [&](int TT) { const int b = TT >> 6, n = (TT >> 2) & 15, h = TT & 3; const bf16* row = UV + ((size_t)b * SEQ + n * 128 + q) * DIN + h * 128 + part * 8;
        SGU_GLD4(vw, row + 512); SGU_GLD4(uw, row); };
    issue(T);
    int hcur = -1; f32x4 gs[8]; bf16x8 afr[4]; float bs[4] = {0.f, 0.f, 0.f, 0.f};
    for (; T < last; T += G) {
        const int b = T >> 6, n = (T >> 2) & 15, h = T & 3; const size_t t0 = (size_t)b * SEQ + n * 128;
        if (h != hcur) { hcur = h;
#pragma unroll
            for (int i = 0; i < 4; ++i) { gs[2 * i] = *(const f32x4*)(p.sgu_g + h * 128 + 32 * i + 8 * part); gs[2 * i + 1] = *(const f32x4*)(p.sgu_g + h * 128 + 32 * i + 8 * part + 4); }
#pragma unroll
            for (int ks = 0; ks < 4; ++ks) afr[ks] = *(const bf16x8*)(SWB + (size_t)((h * 128 + 16 * wave + fr) * 128 + 32 * ks + 8 * fq));
#pragma unroll
            for (int r = 0; r < 4; ++r) bs[r] = p.sgu_b[h * 128 + 16 * wave + 4 * fq + r];
#pragma unroll
            for (int i = 0; i < 8; ++i) asm volatile("" : "+v"(gs[i]) :: "memory");
#pragma unroll
            for (int ks = 0; ks < 4; ++ks) asm volatile("" : "+v"(afr[ks]) :: "memory");
            asm volatile("" : "+v"(bs[0]), "+v"(bs[1]), "+v"(bs[2]), "+v"(bs[3]) :: "memory"); }
        asm volatile("s_waitcnt vmcnt(4) ; retires %0 %1 %2 %3 %4 %5 %6 %7" : "+v"(vw[0]), "+v"(vw[1]), "+v"(vw[2]), "+v"(vw[3]), "+v"(uw[0]), "+v"(uw[1]), "+v"(uw[2]), "+v"(uw[3]) :: "memory");
        { float v[32]; float s = 0.f;
#pragma unroll
          for (int i = 0; i < 4; ++i) { const v4u w = vw[i]; v[8 * i] = bflo(w.x); v[8 * i + 1] = bfhi(w.x); v[8 * i + 2] = bflo(w.y); v[8 * i + 3] = bfhi(w.y); v[8 * i + 4] = bflo(w.z); v[8 * i + 5] = bfhi(w.z); v[8 * i + 6] = bflo(w.w); v[8 * i + 7] = bfhi(w.w); }
#pragma unroll
          for (int i = 0; i < 32; ++i) s += v[i] * v[i];
          s += __shfl_xor(s, 1); s += __shfl_xor(s, 2);
          const float rinv = rsqrtf(s * (1.f / 128.f) + EPS);
#pragma unroll
          for (int i = 0; i < 4; ++i)
#pragma unroll
              for (int jx = 0; jx < 8; ++jx) { const int c = 32 * i + 8 * part + jx; *(LAS bf16*)(vnT + c * 272 + q * 2) = (bf16)f2bf(v[8 * i + jx] * rinv * gs[2 * i + (jx >> 2)][jx & 3]); }
#pragma unroll
          for (int i = 0; i < 4; ++i) *(LAS v4u*)(ul + q * 272 + (4 * i + part) * 16) = uw[i]; }
        { const int Tn = (T + G < last) ? T + G : T; issue(Tn); }
        __syncthreads();
        {
#pragma unroll
          for (int ct = 0; ct < 8; ++ct) { f32x4 acc = (f32x4){0.f, 0.f, 0.f, 0.f};
#pragma unroll
              for (int ks = 0; ks < 4; ++ks) { const bf16x8 bv = *(const LAS bf16x8*)(vnT + (16 * ct + fr) * 272 + 64 * ks + 16 * fq); acc = __builtin_amdgcn_mfma_f32_16x16x32_bf16(afr[ks], bv, acc, 0, 0, 0); }
#pragma unroll
              for (int r = 0; r < 4; ++r) { const int pp = 16 * wave + 4 * fq + r, c = 16 * ct + fr; LAS bf16* e = (LAS bf16*)(ul + pp * 272 + c * 2);
                  *e = (bf16)f2bf(bf2f(*e) * (acc[r] + bs[r])); } } }
        __syncthreads();
        { bf16* dst = A2 + (t0 + q) * D + h * 128 + part * 8;
#pragma unroll
          for (int i = 0; i < 4; ++i) *(v4u*)(dst + 32 * i) = *(const LAS v4u*)(ul + q * 272 + (4 * i + part) * 16); }
        __syncthreads();
    }
    asm volatile("s_waitcnt vmcnt(0)" ::: "memory");
}

__device__ __forceinline__ void phase_lru2(const P& p, LAS unsigned char* lds, int tid, int vcu, int G) {
    LAS float* carry = (LAS float*)lds;
    const bf16* UV = (const bf16*)(p.ws + WS_UV); const bf16* HS = (const bf16*)(p.ws + WS_HS); const bf16* PF = (const bf16*)(p.ws + WS_PF); const bf16* PB = (const bf16*)(p.ws + WS_PB);
    const float* SUM = (const float*)(p.ws + WS_SUM); bf16* A2 = (bf16*)(p.ws + WS_A2);
    for (int T = vcu; T < BATCH * 32 * 8; T += G) {
        const int b = T >> 8, gr = (T >> 3) & 31, h = T & 7;
        if (tid < 128) { const int d = tid >> 6, ch = tid & 63; float hc = 0.f;
            const float* S = SUM + ((size_t)b * NSEG * 2 * DLRU + (size_t)d * DLRU + h * 64 + ch) * 2;
            if (d == 0) { for (int s = 0; s < 4 + gr; ++s) { const float A = S[(size_t)s * 2048], B = S[(size_t)s * 2048 + 1]; hc = A * hc + B; } }
            else { for (int s = 3; s >= 0; --s) { const float A = S[(size_t)s * 2048], B = S[(size_t)s * 2048 + 1]; hc = A * hc + B; }
                   for (int s = NSEG - 1; s > 4 + gr; --s) { const float A = S[(size_t)s * 2048], B = S[(size_t)s * 2048 + 1]; hc = A * hc + B; } }
            carry[tid] = hc; }
        __syncthreads();
        for (int i = tid; i < 4096; i += NTHREADS) { const int r = i >> 6, ch = i & 63; const size_t row = (size_t)b * SEQ + gr * 64 + r, o = row * DLRU + h * 64 + ch;
            const float val = bf2f(HS[o]) + bf2f(PF[o]) * carry[ch] + bf2f(PB[o]) * carry[64 + ch];
            A2[row * D + 512 + h * 64 + ch] = (bf16)f2bf(bf2f(UV[row * DIN + 1536 + h * 64 + ch]) * val); }
        __syncthreads();
    }
}


__device__ __forceinline__ void phase_lru2_fast(const P& p, LAS unsigned char* lds, int tid, int vcu, int G) {
    LAS float* carry = (LAS float*)lds;
    constexpr int NQ = LRU2_PARTS, GR = 32 / NQ, GSH = (NQ == 8) ? 2 : 3, CBUF = GR * 2 * 64;
    const bf16* UV = (const bf16*)(p.ws + WS_UV); const bf16* HS = (const bf16*)(p.ws + WS_HS); const bf16* PF = (const bf16*)(p.ws + WS_PF); const bf16* PB = (const bf16*)(p.ws + WS_PB);
    const float* SUM = (const float*)(p.ws + WS_SUM); bf16* A2 = (bf16*)(p.ws + WS_A2);
    typedef float f32x2 __attribute__((ext_vector_type(2)));
    constexpr int NT = 64 * NQ;
    if (vcu >= NT) return;
    const int Tlast = vcu + ((NT - 1 - vcu) / G) * G;
    v4u nhs[GR], npf[GR], npb[GR], ngg[GR]; f32x2 ab[NSEG];
    auto load_rows = [&](int T) { const int b = T / (8 * NQ), h = (T / NQ) & 7, qt = T % NQ;
#pragma unroll
        for (int it = 0; it < GR; ++it) { const int v = it * NTHREADS + tid, pos = v >> 3, c0 = (v & 7) * 8; const size_t row = (size_t)b * SEQ + qt * (64 * GR) + pos, o = row * DLRU + h * 64 + c0;
            nhs[it] = *(const v4u*)(HS + o); npf[it] = *(const v4u*)(PF + o); npb[it] = *(const v4u*)(PB + o); ngg[it] = *(const v4u*)(UV + row * DIN + 1536 + h * 64 + c0); } };
    auto load_sum = [&](int T) { const int b = T / (8 * NQ), h = (T / NQ) & 7; const int d = (tid >> 6) & 1, ch = tid & 63;
        const f32x2* S = (const f32x2*)SUM + ((size_t)b * NSEG * 2 + d) * DLRU + h * 64 + ch;
#pragma unroll
        for (int s2 = 0; s2 < NSEG; ++s2) ab[s2] = S[(size_t)s2 * 2 * DLRU]; };
    auto fold = [&](int T, LAS float* cbuf) { const int qt = T % NQ; const int d = tid >> 6, ch = tid & 63; float hc = 0.f;
        if (d == 0) {
#pragma unroll
            for (int s2 = 0; s2 < NSEG; ++s2) { if (s2 >= 4 && ((s2 - 4) >> GSH) == qt) cbuf[(((s2 - 4) & (GR - 1)) * 2 + 0) * 64 + ch] = hc; hc = ab[s2].x * hc + ab[s2].y; }
        } else {
#pragma unroll
            for (int s2 = 3; s2 >= 0; --s2) hc = ab[s2].x * hc + ab[s2].y;
#pragma unroll
            for (int s2 = NSEG - 1; s2 >= 4; --s2) { if (((s2 - 4) >> GSH) == qt) cbuf[(((s2 - 4) & (GR - 1)) * 2 + 1) * 64 + ch] = hc; hc = ab[s2].x * hc + ab[s2].y; }
        } };
    if (tid < 128) load_sum(vcu);
    load_rows(vcu);
    if (tid < 128) fold(vcu, carry);
    __syncthreads();
    int cb = 0;
    for (int T = vcu; T < NT; T += G) {
        const int b = T / (8 * NQ), h = (T / NQ) & 7, qt = T % NQ, Tn = min(T + G, Tlast);
        v4u hsv[GR], pfv[GR], pbv[GR], ggv[GR];
#pragma unroll
        for (int it = 0; it < GR; ++it) { hsv[it] = nhs[it]; pfv[it] = npf[it]; pbv[it] = npb[it]; ggv[it] = ngg[it]; }
#pragma unroll
        for (int it = 0; it < GR; ++it) asm volatile("" : "+v"(hsv[it]), "+v"(pfv[it]), "+v"(pbv[it]), "+v"(ggv[it]) :: "memory");
        if (tid < 128) load_sum(Tn);
        load_rows(Tn);
        const LAS float* cr = carry + cb * CBUF;
#pragma unroll
        for (int it = 0; it < GR; ++it) { const int v = it * NTHREADS + tid, pos = v >> 3, c0 = (v & 7) * 8, grl = pos >> 6;
            const size_t row = (size_t)b * SEQ + qt * (64 * GR) + pos;
            const v4u hs = hsv[it], pf = pfv[it], pb = pbv[it], gg = ggv[it];
            const f32x4 cf0 = *(const LAS f32x4*)(cr + (grl * 2) * 64 + c0), cf1 = *(const LAS f32x4*)(cr + (grl * 2) * 64 + c0 + 4);
            const f32x4 cb0 = *(const LAS f32x4*)(cr + (grl * 2 + 1) * 64 + c0), cb1 = *(const LAS f32x4*)(cr + (grl * 2 + 1) * 64 + c0 + 4);
            v4u out;
            out.x = pk2(bflo(gg.x) * (bflo(hs.x) + bflo(pf.x) * cf0.x + bflo(pb.x) * cb0.x), bfhi(gg.x) * (bfhi(hs.x) + bfhi(pf.x) * cf0.y + bfhi(pb.x) * cb0.y));
            out.y = pk2(bflo(gg.y) * (bflo(hs.y) + bflo(pf.y) * cf0.z + bflo(pb.y) * cb0.z), bfhi(gg.y) * (bfhi(hs.y) + bfhi(pf.y) * cf0.w + bfhi(pb.y) * cb0.w));
            out.z = pk2(bflo(gg.z) * (bflo(hs.z) + bflo(pf.z) * cf1.x + bflo(pb.z) * cb1.x), bfhi(gg.z) * (bfhi(hs.z) + bfhi(pf.z) * cf1.y + bfhi(pb.z) * cb1.y));
            out.w = pk2(bflo(gg.w) * (bflo(hs.w) + bflo(pf.w) * cf1.z + bflo(pb.w) * cb1.z), bfhi(gg.w) * (bfhi(hs.w) + bfhi(pf.w) * cf1.w + bfhi(pb.w) * cb1.w));
            *(v4u*)(A2 + row * D + 512 + h * 64 + c0) = out; }
        cb ^= 1;
        if (tid < 128) fold(Tn, carry + cb * CBUF);
        __syncthreads();
    }
}

__device__ __forceinline__ void phase_p5(const P& p, LAS unsigned char* lds, int tid, int lane, int wave, int vcu, int G) {
    LAS float* wrT = (LAS float*)lds;
    const float* MOD = (const float*)(p.ws + WS_MOD); const float* X1 = (const float*)(p.ws + WS_X1); bf16* HX2 = (bf16*)(p.ws + WS_HX2); float* AFF = (float*)(p.ws + WS_AFF);
    for (int i = tid; i < D * NE; i += NTHREADS) wrT[(i & 15) * D + (i >> 4)] = p.w_router[i];
    __syncthreads();
    const int gw = vcu * NWAVES + wave, NGW = G * NWAVES;
    f32x4 nx[4];
    if (gw < M) { const f32x4* xr = (const f32x4*)(X1 + (size_t)gw * D) + lane;
#pragma unroll
        for (int jj = 0; jj < 4; ++jj) nx[jj] = xr[64 * jj]; }
    for (int m = gw; m < M; m += NGW) {
        const int b = m >> 11, t = m & 2047;
        f32x4 v[4]; float s = 0.f;
#pragma unroll
        for (int jj = 0; jj < 4; ++jj) { v[jj] = nx[jj]; s += (v[jj].x * v[jj].x + v[jj].y * v[jj].y) + (v[jj].z * v[jj].z + v[jj].w * v[jj].w); }
        if (m + NGW < M) { const f32x4* xr = (const f32x4*)(X1 + (size_t)(m + NGW) * D) + lane;
#pragma unroll
            for (int jj = 0; jj < 4; ++jj) nx[jj] = xr[64 * jj]; }
        const float rinv = rsqrtf(wave_sum(s) * (1.f / D) + EPS);
        v2u* o = (v2u*)(HX2 + (size_t)m * D) + lane;
#pragma unroll
        for (int jj = 0; jj < 4; ++jj) { const int k = 4 * (lane + 64 * jj);
            const f32x4 g = *(const f32x4*)(p.norm2_g + k), sh = *(const f32x4*)(MOD + b * NMOD + 3 * D + k), sc = *(const f32x4*)(MOD + b * NMOD + 4 * D + k);
            v[jj] = v[jj] * rinv * g * (sc + 1.f) + sh;
#if MOE_FP8
            ((unsigned*)(p.ws + WS_HX2) + (size_t)m * (D / 4))[lane + 64 * jj] = pk4_fp8(v[jj].x, v[jj].y, v[jj].z, v[jj].w); }
#else
            v2u w; w.x = pk2(v[jj].x, v[jj].y); w.y = pk2(v[jj].z, v[jj].w); o[64 * jj] = w; }
#endif
        float pa[16];
#pragma unroll
        for (int e = 0; e < 16; ++e) { float a = 0.f;
#pragma unroll
            for (int jj = 0; jj < 4; ++jj) { const f32x4 w = *(const LAS f32x4*)(wrT + e * D + 4 * (lane + 64 * jj)); a += (v[jj].x * w.x + v[jj].y * w.y) + (v[jj].z * w.z + v[jj].w * w.w); }
            pa[e] = a; if (e & 1) asm volatile("" ::: "memory"); }
        { const bool h5 = (lane & 32) != 0; float q8[8];
#pragma unroll
          for (int i = 0; i < 8; ++i) { const float keep = h5 ? pa[8 + i] : pa[i], give = h5 ? pa[i] : pa[8 + i]; q8[i] = keep + __shfl_xor(give, 32); }
          const bool h4 = (lane & 16) != 0; float q4[4];
#pragma unroll
          for (int i = 0; i < 4; ++i) { const float keep = h4 ? q8[4 + i] : q8[i], give = h4 ? q8[i] : q8[4 + i]; q4[i] = keep + __shfl_xor(give, 16); }
          const bool h3 = (lane & 8) != 0; float q2[2];
#pragma unroll
          for (int i = 0; i < 2; ++i) { const float keep = h3 ? q4[2 + i] : q4[i], give = h3 ? q4[i] : q4[2 + i]; q2[i] = keep + __shfl_xor(give, 8); }
          const bool h2 = (lane & 4) != 0;
          float lgt = (h2 ? q2[1] : q2[0]) + __shfl_xor(h2 ? q2[0] : q2[1], 4);
          lgt += __shfl_xor(lgt, 2); lgt += __shfl_xor(lgt, 1);
          float mx = lgt;
#pragma unroll
          for (int o2 = 4; o2 < 64; o2 <<= 1) mx = fmaxf(mx, __shfl_xor(mx, o2));
          const float ex = expf(lgt - mx); float den = ex;
#pragma unroll
          for (int o2 = 4; o2 < 64; o2 <<= 1) den += __shfl_xor(den, o2);
          if ((lane & 3) == 0) AFF[(size_t)(b * NE + (lane >> 2)) * SEQ + t] = ex / den; }
    }
    __syncthreads();
}

__device__ __forceinline__ void phase_p6(const P& p, LAS unsigned char* lds, int tid, int lane, int wave, int vcu, int G) {
    LAS float* a = (LAS float*)lds; LAS int* tok = (LAS int*)(lds + 8192);
    const float* AFF = (const float*)(p.ws + WS_AFF); int* SLOT = (int*)(p.ws + WS_SLOT); float* GATE = (float*)(p.ws + WS_GATE);
    const bf16* HX2 = (const bf16*)(p.ws + WS_HX2); bf16* XE = (bf16*)(p.ws + WS_XE);
    for (int T = vcu; T < BATCH * NE; T += G) {
        const int b = T >> 4, e = T & 15;
        for (int i = tid; i < SEQ; i += NTHREADS) a[i] = AFF[(size_t)(b * NE + e) * SEQ + i];
        __syncthreads();
        float at[4]; int rk[4];
#pragma unroll
        for (int i = 0; i < 4; ++i) { at[i] = a[tid + 512 * i]; rk[i] = 0; }
        for (int t2 = 0; t2 < SEQ; ++t2) { const float av = a[t2];
#pragma unroll
            for (int i = 0; i < 4; ++i) rk[i] += (av > at[i] || (av == at[i] && t2 < tid + 512 * i)) ? 1 : 0; }
#pragma unroll
        for (int i = 0; i < 4; ++i) { const int t = tid + 512 * i; SLOT[(size_t)(b * SEQ + t) * NE + e] = rk[i] < CAP ? rk[i] : -1;
            if (rk[i] < CAP) { tok[rk[i]] = t; GATE[e * 2048 + b * CAP + rk[i]] = at[i]; } }
        __syncthreads();
        for (int r = wave; r < CAP; r += NWAVES) { const v4u* src = (const v4u*)(HX2 + (size_t)(b * SEQ + tok[r]) * D); v4u* dst = (v4u*)(XE + (size_t)(e * 2048 + b * CAP + r) * D);
            dst[lane] = src[lane]; dst[lane + 64] = src[lane + 64]; }
        __syncthreads();
    }
}


__device__ __forceinline__ unsigned block_sum_u(unsigned v, LAS unsigned* red, int lane, int wave) {
    v = (unsigned)wave_sum((float)v);
    if (lane == 0) red[wave] = v;
    __syncthreads();
    unsigned s = 0;
#pragma unroll
    for (int w = 0; w < 8; ++w) s += red[w];
    return s;
}
__device__ __forceinline__ unsigned block_excl_scan(unsigned c, unsigned& total, LAS unsigned* red, int lane, int wave) {
    unsigned inc = c;
#pragma unroll
    for (int o = 1; o < 64; o <<= 1) { const unsigned t = __shfl_up(inc, o); if (lane >= o) inc += t; }
    if (lane == 63) red[wave] = inc;
    __syncthreads();
    unsigned off = 0, tot = 0;
#pragma unroll
    for (int w = 0; w < 8; ++w) { const unsigned x = red[w]; off += (w < wave) ? x : 0u; tot += x; }
    total = tot; return off + inc - c;
}
__device__ __forceinline__ void phase_p6_fast(const P& p, LAS unsigned char* lds, int tid, int lane, int wave, int vcu, int G) {
    LAS unsigned* red = (LAS unsigned*)lds;
    LAS int* tok = (LAS int*)(lds + 2048);
    const float* AFF = (const float*)(p.ws + WS_AFF); int* SLOT = (int*)(p.ws + WS_SLOT); float* GATE = (float*)(p.ws + WS_GATE);
    const bf16* HX2 = (const bf16*)(p.ws + WS_HX2); bf16* XE = (bf16*)(p.ws + WS_XE);
    for (int T = vcu; T < BATCH * NE * 2; T += G) {
        const int half = T & 1, e = (T >> 1) & 15, b = T >> 5;
        const f32x4 av = *(const f32x4*)(AFF + (size_t)(b * NE + e) * SEQ + 4 * tid);
        unsigned bits[4] = {__float_as_uint(av.x), __float_as_uint(av.y), __float_as_uint(av.z), __float_as_uint(av.w)};
        unsigned lo = 0u, hi = 0x3f800000u; int rb = 0;
        while (lo < hi) {
            const unsigned span = hi - lo, q = (span + 3u) >> 2, t1 = lo + q, t2 = min(lo + 2u * q, hi), t3 = min(lo + 3u * q, hi);
            unsigned w = 0;
#pragma unroll
            for (int i = 0; i < 4; ++i) w += (bits[i] >= t1 ? 1u : 0u) + (bits[i] >= t2 ? (1u << 10) : 0u) + (bits[i] >= t3 ? (1u << 20) : 0u);
#pragma unroll
            for (int o = 1; o < 64; o <<= 1) w += __shfl_xor(w, o);
            LAS unsigned* rd = red + 8 * rb; rb = (rb + 1) % 36;
            if (lane == 0) rd[wave] = w;
            __syncthreads();
            unsigned c1 = 0, c2 = 0, c3 = 0;
#pragma unroll
            for (int ww = 0; ww < 8; ++ww) { const unsigned x = rd[ww]; c1 += x & 1023u; c2 += (x >> 10) & 1023u; c3 += x >> 20; }
            if (c3 >= (unsigned)CAP) lo = t3; else if (c2 >= (unsigned)CAP) { lo = t2; hi = t3 - 1u; } else if (c1 >= (unsigned)CAP) { lo = t1; hi = t2 - 1u; } else hi = t1 - 1u;
        }
        const unsigned Tb = lo;
        unsigned cg = 0, ct = 0;
#pragma unroll
        for (int i = 0; i < 4; ++i) { cg += (bits[i] > Tb) ? 1u : 0u; ct += (bits[i] == Tb) ? 1u : 0u; }
        unsigned ngt; const unsigned need = (unsigned)CAP - (ngt = block_sum_u(cg, red + 8 * 36, lane, wave));
        unsigned ttot; unsigned tpre = block_excl_scan(ct, ttot, red + 8 * 37, lane, wave);
        unsigned sel[4], cs = 0;
#pragma unroll
        for (int i = 0; i < 4; ++i) { const bool tie = bits[i] == Tb; sel[i] = (bits[i] > Tb || (tie && tpre < need)) ? 1u : 0u; tpre += tie ? 1u : 0u; cs += sel[i]; }
        unsigned stot; unsigned spre = block_excl_scan(cs, stot, red + 8 * 38, lane, wave);
#pragma unroll
        for (int i = 0; i < 4; ++i) { const int t = 4 * tid + i;
            if ((t >> 10) == half) SLOT[(size_t)(b * SEQ + t) * NE + e] = sel[i] ? (int)spre : -1;
            if (sel[i]) { tok[spre] = t; if ((int)(spre >> 7) == half) GATE[e * 2048 + b * CAP + spre] = __uint_as_float(bits[i]); spre += 1u; } }
        __syncthreads();
#if MOE_FP8
        if (tid < 128) ((int*)(p.ws + WS_TOK))[e * 2048 + b * CAP + half * 128 + tid] = b * SEQ + tok[half * 128 + tid];
#else
        for (int r = half * 128 + wave; r < half * 128 + 128; r += NWAVES) { const v4u* src = (const v4u*)(HX2 + (size_t)(b * SEQ + tok[r]) * D); v4u* dst = (v4u*)(XE + (size_t)(e * 2048 + b * CAP + r) * D);
            dst[lane] = src[lane]; dst[lane + 64] = src[lane + 64]; }
#endif
        __syncthreads();
    }
}

template <bool X1B>
__device__ __forceinline__ void phase_p9(const P& p, int lane, int wave, int vcu, int G) {
    const float* MOD = (const float*)(p.ws + WS_MOD); const float* X1 = (const float*)(p.ws + WS_X1); const int* SLOT = (const int*)(p.ws + WS_SLOT); const bf16* YE = (const bf16*)(p.ws + WS_YE);
    const int gw = vcu * NWAVES + wave, NGW = G * NWAVES;
    f32x4 nx[4]; int nslot = -1;
    auto ldrow = [&](int mm) {
        if constexpr (X1B) { const v2u* xr = (const v2u*)((const bf16*)X1 + (size_t)mm * D) + lane;
#pragma unroll
            for (int jj = 0; jj < 4; ++jj) { const v2u w = xr[64 * jj]; nx[jj] = (f32x4){bflo(w.x), bfhi(w.x), bflo(w.y), bfhi(w.y)}; } }
        else { const f32x4* xr = (const f32x4*)(X1 + (size_t)mm * D) + lane;
#pragma unroll
            for (int jj = 0; jj < 4; ++jj) nx[jj] = xr[64 * jj]; } };
    if (gw < M) { ldrow(gw);
        nslot = SLOT[(size_t)gw * NE + (lane & 15)]; }
    for (int m = gw; m < M; m += NGW) {
        const int b = m >> 11;
        f32x4 v[4], acc[4]; const int myslot = nslot;
#pragma unroll
        for (int jj = 0; jj < 4; ++jj) { v[jj] = nx[jj]; acc[jj] = (f32x4){0.f, 0.f, 0.f, 0.f}; }
        if (m + NGW < M) { ldrow(m + NGW);
            nslot = SLOT[(size_t)(m + NGW) * NE + (lane & 15)]; }
#pragma unroll
        for (int e = 0; e < NE; ++e) { const int sl = __builtin_amdgcn_readlane(myslot, e);
#if MOE_FP8
            if (sl >= 0) { const unsigned* y = (const unsigned*)((const unsigned char*)YE + (size_t)(e * 2048 + b * CAP + sl) * D) + lane;
#pragma unroll
                for (int jj = 0; jj < 4; ++jj) { const unsigned w = y[64 * jj]; const auto lo = __builtin_amdgcn_cvt_pk_f32_fp8((int)w, false), hi = __builtin_amdgcn_cvt_pk_f32_fp8((int)w, true);
                    acc[jj] += (f32x4){lo[0], lo[1], hi[0], hi[1]}; } } }
#else
            if (sl >= 0) { const v2u* y = (const v2u*)(YE + (size_t)(e * 2048 + b * CAP + sl) * D) + lane;
#pragma unroll
                for (int jj = 0; jj < 4; ++jj) { const v2u w = y[64 * jj]; acc[jj] += (f32x4){bflo(w.x), bfhi(w.x), bflo(w.y), bfhi(w.y)}; } } }
#endif
        float s = 0.f;
#pragma unroll
        for (int jj = 0; jj < 4; ++jj) { const int k = 4 * (lane + 64 * jj); const f32x4 g2 = *(const f32x4*)(MOD + b * NMOD + 5 * D + k); v[jj] += g2 * acc[jj] * (MOE_FP8 ? WSCALE_INV : 1.f);
            s += (v[jj].x * v[jj].x + v[jj].y * v[jj].y) + (v[jj].z * v[jj].z + v[jj].w * v[jj].w); }
        const float rinv = rsqrtf(wave_sum(s) * (1.f / D) + EPS);
        f32x4* o = (f32x4*)(p.out + (size_t)m * D) + lane;
#pragma unroll
        for (int jj = 0; jj < 4; ++jj) { const int k = 4 * (lane + 64 * jj); o[64 * jj] = v[jj] * rinv * *(const f32x4*)(p.final_g + k); }
    }
}

__device__ __forceinline__ void p9_finish(const P& p, LAS unsigned char* strip, int lane, int m, const v4u xa, const v4u xb, const f32x2p (&acc)[8], const f32x4 (&g2c)[4], const f32x4 (&fg)[4]) {
    f32x4 v[4];
    v[0] = (f32x4){bflo(xa.x), bfhi(xa.x), bflo(xa.y), bfhi(xa.y)}; v[1] = (f32x4){bflo(xa.z), bfhi(xa.z), bflo(xa.w), bfhi(xa.w)};
    v[2] = (f32x4){bflo(xb.x), bfhi(xb.x), bflo(xb.y), bfhi(xb.y)}; v[3] = (f32x4){bflo(xb.z), bfhi(xb.z), bflo(xb.w), bfhi(xb.w)};
    float s = 0.f;
#pragma unroll
    for (int i = 0; i < 4; ++i) { v[i] += g2c[i] * (f32x4){acc[2 * i].x, acc[2 * i].y, acc[2 * i + 1].x, acc[2 * i + 1].y}; s += (v[i].x * v[i].x + v[i].y * v[i].y) + (v[i].z * v[i].z + v[i].w * v[i].w); }
    const float rinv = rsqrtf(wave_sum(s) * (1.f / D) + EPS);
#pragma unroll
    for (int i = 0; i < 4; ++i) *(LAS f32x4*)(strip + lane * 80 + 16 * i) = v[i] * rinv * fg[i];
    __builtin_amdgcn_fence(__ATOMIC_RELEASE, "wavefront"); __builtin_amdgcn_wave_barrier(); __builtin_amdgcn_fence(__ATOMIC_ACQUIRE, "wavefront");
    f32x4* o = (f32x4*)(p.out + (size_t)m * D) + lane;
#pragma unroll
    for (int jj = 0; jj < 4; ++jj) o[64 * jj] = *(const LAS f32x4*)(strip + ((lane >> 2) + 16 * jj) * 80 + (lane & 3) * 16);
    __builtin_amdgcn_wave_barrier();
}
#define P9_GLD(dst, voff, sbase, OFFS) asm volatile("global_load_dwordx4 %0, %1, %2" OFFS : "=&v"(dst) : "v"(voff), "s"(sbase) : "memory")
__device__ __forceinline__ const unsigned char* uptr(const unsigned char* q) { const unsigned long long v = (unsigned long long)q;
    return (const unsigned char*)(((unsigned long long)(unsigned)__builtin_amdgcn_readfirstlane((int)(v >> 32)) << 32) | (unsigned)__builtin_amdgcn_readfirstlane((int)v)); }
__device__ __forceinline__ void p9_acc(f32x2p (&acc)[8], const v4u w, float sc) {
    const unsigned ww[4] = {w.x, w.y, w.z, w.w};
#pragma unroll
    for (int c = 0; c < 4; ++c) { const f32x2p lo = __builtin_amdgcn_cvt_pk_f32_fp8((int)ww[c], false), hi = __builtin_amdgcn_cvt_pk_f32_fp8((int)ww[c], true); acc[2 * c] += lo * sc; acc[2 * c + 1] += hi * sc; }
}
__device__ __forceinline__ void phase_p9_v2(const P& p, LAS unsigned char* lds, int lane, int wave, int vcu, int G) {
    const float* MOD = (const float*)(p.ws + WS_MOD); const unsigned char* X1b = p.ws + WS_X1; const int* SLOT = (const int*)(p.ws + WS_SLOT); const unsigned char* YE = p.ws + WS_YE;
    const int gw = vcu * NWAVES + wave, m0 = gw * 8, b = m0 >> 11;
    LAS unsigned char* strip = lds + wave * 5120;
    const v2u slv = *(const v2u*)(SLOT + (size_t)m0 * NE + 2 * lane);
    const int sx = (int)slv.x, sy = (int)slv.y;
    f32x4 g2c[4], fg[4];
#pragma unroll
    for (int i = 0; i < 4; ++i) { g2c[i] = *(const f32x4*)(MOD + b * NMOD + 5 * D + 16 * lane + 4 * i) * WSCALE_INV; fg[i] = *(const f32x4*)(p.final_g + 16 * lane + 4 * i); }
    const unsigned long long mk0 = __builtin_amdgcn_ballot_w64(sx >= 0), mk1 = __builtin_amdgcn_ballot_w64(sy >= 0);
#pragma unroll
    for (int i = 0; i < 4; ++i) asm volatile("" : "+v"(g2c[i]), "+v"(fg[i]) :: "memory");
    const int xoff = 32 * lane, yoff = 16 * lane;
    auto entries = [&](int r, int (&yr)[4], float (&sc)[4], unsigned& rest) { unsigned em = ((unsigned)(mk0 >> (8 * r)) & 0xffu) | (((unsigned)(mk1 >> (8 * r)) & 0xffu) << 8);
#pragma unroll
        for (int i = 0; i < 4; ++i) { yr[i] = 0; sc[i] = 0.f;
            if (em) { const int pos = __builtin_ctz(em); em &= em - 1u; const int j = pos & 7, c = pos >> 3; const int sa = __builtin_amdgcn_readlane(sx, 8 * r + j), sb = __builtin_amdgcn_readlane(sy, 8 * r + j);
                yr[i] = (2 * j + c) * 2048 + b * CAP + (c ? sb : sa); sc[i] = 1.f; } }
        rest = em; };
#define P9_ISSUE(S, rr) do { const int r_ = min((rr), 7); int yr_[4]; float sc_[4]; unsigned rest_; entries(r_, yr_, sc_, rest_); \
        const unsigned char* xb_ = uptr(X1b + (size_t)(m0 + r_) * (D * 2)); \
        P9_GLD(X##S##0, xoff, xb_, ""); P9_GLD(X##S##1, xoff, xb_, " offset:16"); \
        P9_GLD(Y##S##0, yoff, uptr(YE + (size_t)yr_[0] * D), ""); P9_GLD(Y##S##1, yoff, uptr(YE + (size_t)yr_[1] * D), ""); \
        P9_GLD(Y##S##2, yoff, uptr(YE + (size_t)yr_[2] * D), ""); P9_GLD(Y##S##3, yoff, uptr(YE + (size_t)yr_[3] * D), ""); } while (0)
#define P9_WAIT(S, n) asm volatile("s_waitcnt vmcnt(%6) ; retires %0 %1 %2 %3 %4 %5" : "+v"(X##S##0), "+v"(X##S##1), "+v"(Y##S##0), "+v"(Y##S##1), "+v"(Y##S##2), "+v"(Y##S##3) : "n"(n) : "memory")
#define P9_PROC(S, rr) do { const int r_ = (rr); int yr_[4]; float sc_[4]; unsigned rest_; entries(r_, yr_, sc_, rest_); \
        f32x2p acc_[8]; _Pragma("unroll") for (int i = 0; i < 8; ++i) acc_[i] = (f32x2p){0.f, 0.f}; \
        p9_acc(acc_, Y##S##0, sc_[0]); p9_acc(acc_, Y##S##1, sc_[1]); p9_acc(acc_, Y##S##2, sc_[2]); p9_acc(acc_, Y##S##3, sc_[3]); \
        while (rest_) { const int pos = __builtin_ctz(rest_); rest_ &= rest_ - 1u; const int j = pos & 7, c = pos >> 3; const int sa = __builtin_amdgcn_readlane(sx, 8 * r_ + j), sb = __builtin_amdgcn_readlane(sy, 8 * r_ + j); \
            const v4u w_ = *(const v4u*)(YE + (size_t)((2 * j + c) * 2048 + b * CAP + (c ? sb : sa)) * D + yoff); p9_acc(acc_, w_, 1.f); } \
        p9_finish(p, strip, lane, m0 + r_, X##S##0, X##S##1, acc_, g2c, fg); } while (0)
    v4u XA0, XA1, YA0, YA1, YA2, YA3, XB0, XB1, YB0, YB1, YB2, YB3, XC0, XC1, YC0, YC1, YC2, YC3;
    P9_ISSUE(A, 0); P9_ISSUE(B, 1);
    for (int it = 0; it < 3; ++it) { const int r = 3 * it;
        P9_ISSUE(C, r + 2); if (it == 0) asm volatile("s_waitcnt vmcnt(12)" ::: "memory"); P9_WAIT(A, 20); P9_PROC(A, r);
        P9_ISSUE(A, r + 3); if (it == 0) asm volatile("s_waitcnt vmcnt(16)" ::: "memory"); P9_WAIT(B, 20); P9_PROC(B, r + 1);
        P9_ISSUE(B, r + 4); P9_WAIT(C, 20); if (r + 2 < 8) P9_PROC(C, r + 2);
    }
    asm volatile("s_waitcnt vmcnt(0)" ::: "memory");
}

#if CONV_CUS && MOE_FP8 && XCD_BAR && LRU1_MFMA && SGU_MFMA && LRU2_FAST && P6_FAST && USE_PG8 && (MK_N_LAUNCHES == 1)
__global__ void __launch_bounds__(NTHREADS, 2) fwd_megakernel(P p) {
    extern __shared__ __attribute__((aligned(16))) unsigned char lds_raw[];
    LAS unsigned char* lds = (LAS unsigned char*)lds_raw;
    const int tid = threadIdx.x, lane = tid & 63, wave = __builtin_amdgcn_readfirstlane(tid >> 6);
    const int G = gridDim.x, bx = blockIdx.x, xg = bx & 7, xl = bx >> 3;
    const int vcu = (G % 8 == 0) ? xg * (G / 8) + xl : bx;
    constexpr int CSH = (NCONV == 64) ? 2 : 3, CPG = 32 >> CSH, WPG = 32 - CPG;
    const bool split = (G == 256), is_conv = split && ((xl & ((1 << CSH) - 1)) == (1 << CSH) - 1);
    const int GW = split ? 8 * WPG : G, wvcu = split ? xg * WPG + (xl - (xl >> CSH)) : vcu, cvcu = xg * CPG + (xl >> CSH);
    volatile LAS unsigned* bst = (volatile LAS unsigned*)(lds + LDS_BYTES - 16);
    if (tid < 4) bst[tid] = 0u;
    __syncthreads();
    unsigned* ctl = (unsigned*)(p.ws + WS_CTL);
    const XcdBarrier barA = xcd_barrier_post(ctl + 4096, bst, (unsigned)G);
    XcdBarrier barW = barA;
    if (split && !is_conv) barW = xcd_barrier_post(ctl + 4096 + XCD_BAR_WORDS, bst + 2, (unsigned)GW);

    if (is_conv) {
        convert_pipelined(p, lds, lane, wave, CONV_HEAD, CONV_ITEMS, cvcu * NWAVES + wave, 8 * CPG * NWAVES);
        if (tid == 0) { XB_SPIN(xb_ld(ctl + 64) == 0u, ctl + 4096); __builtin_amdgcn_fence(__ATOMIC_ACQUIRE, "agent"); asm volatile("s_waitcnt vmcnt(0)" ::: "memory"); }
        __syncthreads();
        phase_sgu_mfma(p, lds, tid, lane, wave, cvcu, 8 * CPG, 0, SGU_CONV_TASKS);
    } else {
        phase_p0(p, lds, tid, lane, wave, wvcu, GW, split ? 16 * 32 : CONV_ITEMS, !split);
        xcd_barrier(barW);
        phase_p1(p, lane, wave, wvcu, GW);
        if (split) { convert_items(p, lds, lane, wave, 16 * 32, CONV_HEAD, wvcu * NWAVES + wave, GW * NWAVES); p0_small_copies(p, tid, wvcu, GW); }
        xcd_barrier(barW);
        { pg8::Gemm g{(const bf16*)(p.ws + WS_HX), (const bf16*)(p.ws + WS_WIN), D}; SchedG1 S{GW, wvcu}; EpiG1 E{(bf16*)(p.ws + WS_UV), (bf16*)(p.ws + WS_XC)};
          pg8::gemm_phase<EpiG1, SchedG1, true, true>(lds, g, S, E); }
        xcd_barrier(barW);
        if (split && wvcu == 0 && tid == 0) __hip_atomic_store(ctl + 64, 1u, __ATOMIC_RELAXED, __HIP_MEMORY_SCOPE_AGENT);
#if LRU1_V2
        phase_lru1_v2(p, lds, tid, lane, wave, wvcu, GW);
#else
        phase_lru1_mfma(p, lds, tid, lane, wave, wvcu, GW);
#endif
        phase_sgu_mfma(p, lds, tid, lane, wave, wvcu, GW, split ? SGU_CONV_TASKS : 0, 512);
        xcd_barrier(barW);
        phase_lru2_fast(p, lds, tid, wvcu, GW);
    }
    xcd_barrier(barA);
    if (split) {
        pg8::Gemm g{(const bf16*)(p.ws + WS_A2), (const bf16*)(p.ws + WS_WOUT), D}; SchedG2 S{G, vcu};
        EpiG2F E{p.x, (const float*)(p.ws + WS_MOD), (float*)(p.ws + WS_X1), p.w_router, p.norm2_g, (const float*)(p.ws + WS_CB), (float*)(p.ws + WS_XCH), ctl + 2048, ctl + 4096, p.ws + WS_HX2, (float*)(p.ws + WS_AFF)};
        pg8::gemm_phase<EpiG2F, SchedG2, true, true>(lds, g, S, E);
    } else {
        { pg8::Gemm g{(const bf16*)(p.ws + WS_A2), (const bf16*)(p.ws + WS_WOUT), D}; SchedG2 S{G, vcu}; EpiG2 E{p.x, (const float*)(p.ws + WS_MOD), (float*)(p.ws + WS_X1)};
          pg8::gemm_phase<EpiG2, SchedG2, true, true>(lds, g, S, E); }
        xcd_barrier(barA);
        phase_p5(p, lds, tid, lane, wave, vcu, G);
    }
    xcd_barrier(barA);
    phase_p6_fast(p, lds, tid, lane, wave, vcu, G);
    xcd_barrier(barA);
    { pg8::Gemm g{(const bf16*)(p.ws + WS_HX2), (const bf16*)(p.ws + WS_WG), D}; SchedG3 S{G, vcu}; EpiG3 E{p.ws + WS_HID};
      pg8::gemm_phase_f8g<EpiG3, SchedG3, true, true>(lds, g, S, E, (const int*)(p.ws + WS_TOK)); }
    xcd_barrier(barA);
    { pg8::Gemm g{(const bf16*)(p.ws + WS_HID), (const bf16*)(p.ws + WS_W2), DE}; SchedG4 S{G, vcu}; EpiG4 E{(const float*)(p.ws + WS_GATE), p.ws + WS_YE};
      pg8::gemm_phase_f8<EpiG4, SchedG4, true, true>(lds, g, S, E); }
    xcd_barrier(barA);
    if (split) phase_p9_v2(p, lds, lane, wave, vcu, G); else phase_p9<false>(p, lane, wave, vcu, G);
}
#else
__global__ void __launch_bounds__(NTHREADS, 2) fwd_megakernel(P p) {
    extern __shared__ __attribute__((aligned(16))) unsigned char lds_raw[];
    LAS unsigned char* lds = (LAS unsigned char*)lds_raw;
    const int tid = threadIdx.x, lane = tid & 63, wave = __builtin_amdgcn_readfirstlane(tid >> 6);
    const int G = gridDim.x, bx = blockIdx.x, vcu = (G % 8 == 0) ? (bx % 8) * (G / 8) + bx / 8 : bx;
    const int lo = p.ph_lo, hi = p.ph_hi;
#if XCD_BAR
    volatile LAS unsigned* bst = (volatile LAS unsigned*)(lds + LDS_BYTES - 16);
    if (tid < 2) bst[tid] = 0u;
    __syncthreads();
    XcdBarrier bar; bar.bar = (unsigned*)(p.ws + WS_CTL) + 4096; bar.x = 0; bar.st = bst; bar.total = (unsigned)G;
    if (hi - lo > 1) bar = xcd_barrier_post((unsigned*)(p.ws + WS_CTL) + 4096, bst, (unsigned)G);
#define GRID_SYNC() xcd_barrier(bar)
#else
    cg::grid_group grid = cg::this_grid();
#define GRID_SYNC() grid.sync()
#endif
#define IN(k) (lo <= (k) && (k) < hi)
#define SEAM(k) do { if (IN(k) && IN((k) + 1)) GRID_SYNC(); } while (0)
#define REP(k) for (int rep_ = 0; rep_ < 1 + ((DUP_MASK >> (k)) & 1); ++rep_)
    if (IN(0)) { REP(0) { phase_p0(p, lds, tid, lane, wave, vcu, G, CONV_CUT); __syncthreads(); } SEAM(0); }
    if (IN(1)) { REP(1) phase_p1(p, lane, wave, vcu, G); SEAM(1); }
    if ((DUP_MASK >> 12) & 1) { for (int xb = 0; xb < 8; ++xb) GRID_SYNC(); }
    if (IN(2)) { pg8::Gemm g{(const bf16*)(p.ws + WS_HX), (const bf16*)(p.ws + WS_WIN), D}; SchedG1 S{G, vcu}; EpiG1 E{(bf16*)(p.ws + WS_UV), (bf16*)(p.ws + WS_XC)};
        REP(2) { gemm_any(lds, g, S, E); if (G > 16 && vcu >= 16) convert_items(p, lds, lane, wave, CONV_CUT, CONV_ITEMS, (vcu - 16) * NWAVES + wave, (G - 16) * NWAVES); }
        if (G <= 16) convert_items(p, lds, lane, wave, CONV_CUT, CONV_ITEMS, vcu * NWAVES + wave, G * NWAVES);
        SEAM(2); }
    if (IN(3)) { REP(3) {
#if LRU1_MFMA
        phase_lru1_mfma(p, lds, tid, lane, wave, vcu, G);
#else
        phase_lru1(p, lds, tid, vcu, G);
#endif
        } REP(11) {
#if SGU_MFMA
        phase_sgu_mfma(p, lds, tid, lane, wave, vcu, G);
#else
        phase_sgu(p, lds, tid, vcu, G);
#endif
        } SEAM(3); }
    if (IN(4)) { REP(4) {
#if LRU2_FAST
        phase_lru2_fast(p, lds, tid, vcu, G);
#else
        phase_lru2(p, lds, tid, vcu, G);
#endif
        } SEAM(4); }
    if (IN(5)) { pg8::Gemm g{(const bf16*)(p.ws + WS_A2), (const bf16*)(p.ws + WS_WOUT), D}; SchedG2 S{G, vcu}; EpiG2 E{p.x, (const float*)(p.ws + WS_MOD), (float*)(p.ws + WS_X1)};
        REP(5) gemm_any(lds, g, S, E); SEAM(5); }
    if (IN(6)) { REP(6) phase_p5(p, lds, tid, lane, wave, vcu, G); SEAM(6); }
    if (IN(7)) { REP(7) {
#if P6_FAST
        phase_p6_fast(p, lds, tid, lane, wave, vcu, G);
#else
        phase_p6(p, lds, tid, lane, wave, vcu, G);
#endif
        } SEAM(7); }
#if MOE_FP8
    if (IN(8)) { pg8::Gemm g{(const bf16*)(p.ws + WS_XE), (const bf16*)(p.ws + WS_WG), D}; SchedG3 S{G, vcu}; EpiG3 E{p.ws + WS_HID};
        REP(8) pg8::gemm_phase_f8<EpiG3, SchedG3, true, true>(lds, g, S, E); SEAM(8); }
    if (IN(9)) { pg8::Gemm g{(const bf16*)(p.ws + WS_HID), (const bf16*)(p.ws + WS_W2), DE}; SchedG4 S{G, vcu}; EpiG4 E{(const float*)(p.ws + WS_GATE), p.ws + WS_YE};
        REP(9) pg8::gemm_phase_f8<EpiG4, SchedG4, true, true>(lds, g, S, E); SEAM(9); }
#else
    if (IN(8)) { pg8::Gemm g{(const bf16*)(p.ws + WS_XE), (const bf16*)(p.ws + WS_WG), D}; SchedG3 S{G, vcu}; EpiG3 E{(bf16*)(p.ws + WS_HID)};
        REP(8) gemm_any(lds, g, S, E); SEAM(8); }
    if (IN(9)) { pg8::Gemm g{(const bf16*)(p.ws + WS_HID), (const bf16*)(p.ws + WS_W2), DE}; SchedG4 S{G, vcu}; EpiG4 E{(const float*)(p.ws + WS_GATE), (bf16*)(p.ws + WS_YE)};
        REP(9) gemm_any(lds, g, S, E); SEAM(9); }
#endif
    if (IN(10)) { REP(10) phase_p9<false>(p, lane, wave, vcu, G); }
#undef IN
#undef REP
#undef SEAM
#undef GRID_SYNC
}

#endif

extern "C" void kernel_launch(void* const* d_in, const int* in_sizes, int n_in, void* d_out, int out_size, void* d_ws, size_t ws_size, hipStream_t stream) {
    static int grid = 0;
    if (grid == 0) {
        if (n_in != 25 || in_sizes[0] != M * D || out_size != M * D || ws_size < WS_END) { fprintf(stderr, "kernel_launch: unexpected shapes (n_in %d, in0 %d, out %d, ws %zu < %zu)\n", n_in, n_in > 0 ? in_sizes[0] : -1, out_size, ws_size, (size_t)WS_END); grid = -1; return; }
        int dev = 0, cus = 0, per_cu = 0;
        if (hipGetDevice(&dev) != hipSuccess || hipDeviceGetAttribute(&cus, hipDeviceAttributeMultiprocessorCount, dev) != hipSuccess) { grid = -1; return; }
        if (hipFuncSetAttribute((const void*)fwd_megakernel, hipFuncAttributeMaxDynamicSharedMemorySize, LDS_BYTES) != hipSuccess) { fprintf(stderr, "kernel_launch: hipFuncSetAttribute failed\n"); grid = -1; return; }
        if (hipOccupancyMaxActiveBlocksPerMultiprocessor(&per_cu, (const void*)fwd_megakernel, NTHREADS, LDS_BYTES) != hipSuccess || per_cu < 1) { fprintf(stderr, "kernel_launch: occupancy query failed (%d)\n", per_cu); (void)hipGetLastError(); grid = -1; return; }
        grid = cus * per_cu;
    }
    if (grid < 0) return;
#if XCD_BAR
    if (hipMemsetAsync((char*)d_ws + WS_CTL, 0, 65536, stream) != hipSuccess) { fprintf(stderr, "kernel_launch: hipMemsetAsync failed\n"); return; }
#endif
    P p{};
    const float** f = (const float**)&p;
    for (int i = 0; i < 25; ++i) f[i] = (const float*)d_in[i];
    p.out = (float*)d_out; p.ws = (unsigned char*)d_ws;
#if MK_N_LAUNCHES == 1
    p.ph_lo = 0; p.ph_hi = NPH; void* args[] = {&p};
    hipError_t e = hipLaunchCooperativeKernel((const void*)fwd_megakernel, dim3(grid), dim3(NTHREADS), args, LDS_BYTES, stream);
    if (e != hipSuccess) fprintf(stderr, "kernel_launch: cooperative launch failed: %s (grid %d)\n", hipGetErrorString(e), grid);
#else
    for (int ph = 0; ph < NPH; ++ph) { p.ph_lo = ph; p.ph_hi = ph + 1; hipLaunchKernelGGL(fwd_megakernel, dim3(grid), dim3(NTHREADS), LDS_BYTES, stream, p); }
#endif
}
```

```cpp
#include <hip/hip_runtime.h>
#include <hip/hip_cooperative_groups.h>
#include <cstdio>
#include <cstdint>
namespace cg = cooperative_groups;

#ifndef MK_N_LAUNCHES
#define MK_N_LAUNCHES 1
#endif
#ifndef XCD_BAR
#define XCD_BAR 1
#endif
#ifndef LRU1_MFMA
#define LRU1_MFMA 1
#endif
#ifndef SGU_MFMA
#define SGU_MFMA 1
#endif
#ifndef P6_FAST
#define P6_FAST 1
#endif
#ifndef DUP_MASK
#define DUP_MASK 0
#endif
#ifndef LRU2_FAST
#define LRU2_FAST 1
#endif
#ifndef MOE_FP8
#define MOE_FP8 1
#endif
#ifndef CONV_CUS
#define CONV_CUS 1
#endif
#ifndef NCONV
#define NCONV 64
#endif
#ifndef LRU1_V2
#define LRU1_V2 1
#endif
#ifndef SGU_CONV_TASKS
#define SGU_CONV_TASKS 128
#endif
#ifndef LRU2_PARTS
#define LRU2_PARTS 8
#endif
#ifndef USE_PG8
#define USE_PG8 1
#endif

namespace pg8 {
#define PG8_LAS __attribute__((address_space(3)))
typedef unsigned short bf16_t;
typedef short bf16x8 __attribute__((ext_vector_type(8)));
typedef float f32x4 __attribute__((ext_vector_type(4)));
typedef unsigned u32x4 __attribute__((ext_vector_type(4)));
typedef int v4i_t __attribute__((ext_vector_type(4)));
typedef int v8i_t __attribute__((ext_vector_type(8)));
constexpr int BM = 256, BK = 64, HALF = 128, HTB = HALF * BK * 2  , STAGE_BYTES = 8 * HTB;

__host__ __device__ __forceinline__ int lds_byte(int r, int c) { const int st = (r >> 4) * 2 + (c >> 5), rr = r & 15, cc = c & 31, ob = rr * 64 + cc * 2; return st * 1024 + (ob ^ (((ob >> 9) & 1) << 5)); }
__host__ __device__ __forceinline__ void stage_rc(int b, int& R, int& C) { const int st = b / 1024, sb = b % 1024, swz = sb ^ (((sb >> 9) & 1) << 5); R = (st >> 1) * 16 + swz / 64; C = (st & 1) * 32 + (swz % 64) / 2; }

struct Unit { int pm, pn, pnB; };
struct Gemm { const bf16_t* A; const bf16_t* Bt; int K; };

template <class Epi>
__device__ __forceinline__ void run_epi8(const Epi& E, const f32x4 (&acc)[2][2][4][2], const Unit& u, int wr, int wc, int fr, int fq) {
#pragma unroll
    for (int ai = 0; ai < 2; ++ai)
#pragma unroll
        for (int m = 0; m < 4; ++m) { const int row = ai * HALF + wr * 64 + m * 16 + fr;
            if constexpr (Epi::PAIRED) E.st2x8(u, row, wc * 32 + 8 * fq, acc[ai][0][m][0], acc[ai][0][m][1], acc[ai][1][m][0], acc[ai][1][m][1]);
            else {
#pragma unroll
                for (int bj = 0; bj < 2; ++bj) E.st8(u, row, bj * HALF + wc * 32 + 8 * fq, acc[ai][bj][m][0], acc[ai][bj][m][1]);
            } }
}
template <class Epi>
__device__ __forceinline__ void run_epi(const Epi& E, const f32x4 (&acc)[2][2][4][2], const Unit& u, int wr, int wc, int fr, int fq) {
#pragma unroll
    for (int ai = 0; ai < 2; ++ai)
#pragma unroll
        for (int m = 0; m < 4; ++m) { const int row = ai * HALF + wr * 64 + m * 16 + fr;
            if constexpr (Epi::PAIRED) {
#pragma unroll
                for (int n = 0; n < 2; ++n) E.st2(u, row, wc * 32 + n * 16 + 4 * fq, acc[ai][0][m][n], acc[ai][1][m][n]);
            } else {
#pragma unroll
                for (int bj = 0; bj < 2; ++bj)
#pragma unroll
                    for (int n = 0; n < 2; ++n) E.st(u, row, bj * HALF + wc * 32 + n * 16 + 4 * fq, acc[ai][bj][m][n]);
            } }
}

template <class Epi, class Sched, bool ALIGN_EPI = false, bool SP2 = false>
__device__ __forceinline__ void gemm_phase(PG8_LAS unsigned char* lds, const Gemm g, const Sched& S, const Epi& E) {
    const int tid = threadIdx.x, wid = __builtin_amdgcn_readfirstlane(tid >> 6), lane = tid & 63, wr = wid >> 2, wc = wid & 3, fr = lane & 15, fq = lane >> 4;
    const int K = g.K, nt = K / BK;
    unsigned voffA[2], voffB[2];
#pragma unroll
    for (int i = 0; i < 2; ++i) { int R, C; stage_rc(tid * 16 + i * 8192, R, C); const int rho = R & 31, Rb = (R & ~31) + 8 * ((rho & 15) >> 2) + 4 * (rho >> 4) + (rho & 3);
        voffA[i] = (unsigned)(R * K + C) * 2u; voffB[i] = (unsigned)(Rb * K + C) * 2u; }
    const size_t kstep = (size_t)(BK * 2);
    const size_t hstep = (size_t)HALF * K * 2;
    const size_t tstep = 2 * hstep;
    const unsigned ldsw = (unsigned)wid * 1024u;
    const int aoff = lds_byte(wr * 64 + fr, fq * 8), boff = lds_byte(wc * 32 + fr, fq * 8);
#define PG8_SA(b, h) (((b) * 2 + (h)) * HTB)
#define PG8_SB(b, h) ((4 + (b) * 2 + (h)) * HTB)
#define PG8_STAGE(bufoff, gbase, voff) do { _Pragma("unroll") for (int _i = 0; _i < 2; ++_i) \
        __builtin_amdgcn_global_load_lds((const unsigned*)((const char*)(gbase) + (voff)[_i]), (PG8_LAS unsigned*)(lds + (bufoff) + ldsw + _i * 8192), 16, 0, 0); } while (0)
#define PG8_LDA(dst, b, h) do { _Pragma("unroll") for (int m = 0; m < 4; ++m) _Pragma("unroll") for (int k = 0; k < 2; ++k) dst[m][k] = *(const PG8_LAS bf16x8*)(lds + PG8_SA(b, h) + aoff + m * 2048 + k * 1024); } while (0)
#define PG8_LDB(dst, b, h) do { _Pragma("unroll") for (int n = 0; n < 2; ++n) _Pragma("unroll") for (int k = 0; k < 2; ++k) dst[n][k] = *(const PG8_LAS bf16x8*)(lds + PG8_SB(b, h) + boff + n * 2048 + k * 1024); } while (0)
#define PG8_MMA(ai, bj, At, Bt) do { __builtin_amdgcn_s_setprio(1); _Pragma("unroll") for (int m = 0; m < 4; ++m) _Pragma("unroll") for (int n = 0; n < 2; ++n) _Pragma("unroll") for (int k = 0; k < 2; ++k) \
        acc[ai][bj][m][n] = __builtin_amdgcn_mfma_f32_16x16x32_bf16(Bt[n][k], At[m][k], acc[ai][bj][m][n], 0, 0, 0); __builtin_amdgcn_s_setprio(0); } while (0)
#define PG8_WAIT_V(n) asm volatile("s_waitcnt vmcnt(" #n ")" ::: "memory")
#define PG8_WAIT_L(n) asm volatile("s_waitcnt lgkmcnt(" #n ")" ::: "memory")
#define PG8_BAR __builtin_amdgcn_s_barrier()
#define PG8_SCHED __builtin_amdgcn_sched_barrier(0)
    Unit cur, nxt; int ui = 0;
    if (!S.next(0, cur)) return;
    f32x4 acc[2][2][4][2];
#pragma unroll
    for (int a = 0; a < 2; ++a)
#pragma unroll
        for (int b = 0; b < 2; ++b)
#pragma unroll
            for (int m = 0; m < 4; ++m)
#pragma unroll
                for (int n = 0; n < 2; ++n) acc[a][b][m][n] = (f32x4){0.f, 0.f, 0.f, 0.f};
    bf16x8 At[4][2], B0[2][2], B1[2][2];
    const char* cA = (const char*)g.A + (size_t)cur.pm * tstep; const char* cB = (const char*)g.Bt + (size_t)cur.pnB * tstep;

    if constexpr (SP2) {
        PG8_STAGE(PG8_SB(0, 0), cB, voffB); PG8_STAGE(PG8_SB(0, 1), cB + hstep, voffB); PG8_STAGE(PG8_SA(0, 0), cA, voffA); PG8_STAGE(PG8_SA(0, 1), cA + hstep, voffA);
        if (wr == 1) PG8_BAR;
        PG8_WAIT_V(2); PG8_BAR;
        PG8_STAGE(PG8_SB(1, 0), cB + kstep, voffB); PG8_STAGE(PG8_SA(1, 0), cA + kstep, voffA); PG8_STAGE(PG8_SB(1, 1), cB + hstep + kstep, voffB);
        PG8_WAIT_V(6); PG8_BAR;
    } else {
        PG8_STAGE(PG8_SB(0, 0), cB, voffB); PG8_STAGE(PG8_SA(0, 0), cA, voffA); PG8_STAGE(PG8_SB(0, 1), cB + hstep, voffB); PG8_STAGE(PG8_SA(0, 1), cA + hstep, voffA);
        if (wr == 1) PG8_BAR;
        PG8_WAIT_V(4); PG8_BAR;
        PG8_STAGE(PG8_SB(1, 0), cB + kstep, voffB); PG8_STAGE(PG8_SA(1, 0), cA + kstep, voffA); PG8_STAGE(PG8_SB(1, 1), cB + hstep + kstep, voffB);
        PG8_WAIT_V(6); PG8_BAR;
    }
    for (;;) {
        const bool has_next = S.next(ui + 1, nxt);
        const char* nA = has_next ? (const char*)g.A + (size_t)nxt.pm * tstep : cA; const char* nB = has_next ? (const char*)g.Bt + (size_t)nxt.pnB * tstep : cB;
        for (int t = 0; t < nt; t += 2) {
            const bool last = (t == nt - 2);
            const char* a1 = cA + (size_t)(t + 1) * kstep;
            const char* a2 = last ? nA : cA + (size_t)(t + 2) * kstep; const char* b2 = last ? nB : cB + (size_t)(t + 2) * kstep;
            const char* a3 = a2 + kstep; const char* b3 = b2 + kstep;

            if constexpr (SP2) {
            PG8_LDB(B0, 0, 0); PG8_LDB(B1, 0, 1); PG8_SCHED; PG8_LDA(At, 0, 0); PG8_STAGE(PG8_SA(1, 1), a1 + hstep, voffA);
            PG8_WAIT_V(8); PG8_WAIT_L(0); PG8_BAR; PG8_MMA(0, 0, At, B0); PG8_MMA(0, 1, At, B1); PG8_BAR; PG8_SCHED;
            PG8_LDA(At, 0, 1); PG8_STAGE(PG8_SB(0, 0), b2, voffB); PG8_STAGE(PG8_SB(0, 1), b2 + hstep, voffB); PG8_STAGE(PG8_SA(0, 0), a2, voffA);
            PG8_WAIT_V(8); PG8_WAIT_L(0); PG8_BAR; PG8_MMA(1, 0, At, B0); PG8_MMA(1, 1, At, B1); PG8_BAR; PG8_SCHED;
            PG8_LDB(B0, 1, 0); PG8_LDB(B1, 1, 1); PG8_SCHED; PG8_LDA(At, 1, 0); PG8_STAGE(PG8_SA(0, 1), a2 + hstep, voffA);
            PG8_WAIT_V(8); PG8_WAIT_L(0); PG8_BAR; PG8_MMA(0, 0, At, B0); PG8_MMA(0, 1, At, B1); PG8_BAR; PG8_SCHED;
            PG8_LDA(At, 1, 1); PG8_STAGE(PG8_SB(1, 0), b3, voffB); PG8_STAGE(PG8_SB(1, 1), b3 + hstep, voffB); PG8_STAGE(PG8_SA(1, 0), a3, voffA);
            PG8_WAIT_V(8); PG8_WAIT_L(0); PG8_BAR; PG8_MMA(1, 0, At, B0); PG8_MMA(1, 1, At, B1); PG8_BAR; PG8_SCHED;
            } else {
            PG8_LDB(B0, 0, 0); PG8_SCHED; PG8_LDA(At, 0, 0); PG8_STAGE(PG8_SA(1, 1), a1 + hstep, voffA);
            PG8_WAIT_L(8); PG8_BAR; PG8_WAIT_L(0); PG8_MMA(0, 0, At, B0); PG8_BAR; PG8_SCHED;
            PG8_LDB(B1, 0, 1); PG8_STAGE(PG8_SB(0, 0), b2, voffB);
            PG8_BAR; PG8_WAIT_L(0); PG8_MMA(0, 1, At, B1); PG8_BAR;
            PG8_LDA(At, 0, 1); PG8_STAGE(PG8_SA(0, 0), a2, voffA);
            PG8_BAR; PG8_WAIT_L(0); PG8_MMA(1, 0, At, B0); PG8_BAR; PG8_SCHED;
            PG8_STAGE(PG8_SB(0, 1), b2 + hstep, voffB);
            PG8_WAIT_V(6); PG8_BAR; PG8_MMA(1, 1, At, B1); PG8_BAR;
            PG8_LDB(B0, 1, 0); PG8_SCHED; PG8_LDA(At, 1, 0); PG8_STAGE(PG8_SA(0, 1), a2 + hstep, voffA);
            PG8_WAIT_L(8); PG8_BAR; PG8_WAIT_L(0); PG8_MMA(0, 0, At, B0); PG8_BAR; PG8_SCHED;
            PG8_LDB(B1, 1, 1); PG8_STAGE(PG8_SB(1, 0), b3, voffB);
            PG8_BAR; PG8_WAIT_L(0); PG8_MMA(0, 1, At, B1); PG8_BAR;
            PG8_LDA(At, 1, 1); PG8_STAGE(PG8_SA(1, 0), a3, voffA);
            PG8_BAR; PG8_WAIT_L(0); PG8_MMA(1, 0, At, B0); PG8_BAR; PG8_SCHED;
            PG8_STAGE(PG8_SB(1, 1), b3 + hstep, voffB);
            PG8_WAIT_V(6); PG8_BAR; PG8_MMA(1, 1, At, B1); PG8_BAR;
            }
        }
        if constexpr (ALIGN_EPI) { if (wr == 0) PG8_BAR; }
        if constexpr (!Epi::FUSED) run_epi8(E, acc, cur, wr, wc, fr, fq);
        if (!has_next) break;
#pragma unroll
        for (int a = 0; a < 2; ++a)
#pragma unroll
            for (int b = 0; b < 2; ++b)
#pragma unroll
                for (int m = 0; m < 4; ++m)
#pragma unroll
                    for (int n = 0; n < 2; ++n) acc[a][b][m][n] = (f32x4){0.f, 0.f, 0.f, 0.f};
        cur = nxt; cA = nA; cB = nB; ++ui;
        if constexpr (ALIGN_EPI) { if (wr == 1) PG8_BAR; }
    }
    PG8_WAIT_V(0);
    if constexpr (!ALIGN_EPI) { if (wr == 0) PG8_BAR; }
    PG8_BAR;
    if constexpr (Epi::FUSED) E.fused(acc, cur, wr, wc, fr, fq, lds, wid, lane);

#undef PG8_SA
#undef PG8_SB
#undef PG8_STAGE
#undef PG8_LDA
#undef PG8_LDB
#undef PG8_MMA
#undef PG8_WAIT_V
#undef PG8_WAIT_L
#undef PG8_BAR
#undef PG8_SCHED
}

template <class Epi, class Sched, bool ALIGN_EPI = false, bool SP2 = false>
__device__ __forceinline__ void gemm_phase_f8(PG8_LAS unsigned char* lds, const Gemm g, const Sched& S, const Epi& E) {
    const int tid = threadIdx.x, wid = __builtin_amdgcn_readfirstlane(tid >> 6), lane = tid & 63, wr = wid >> 2, wc = wid & 3, fr = lane & 15, fq = lane >> 4;
    const int RP = g.K, nt = RP / 128;
    unsigned voffA[2], voffB[2];
#pragma unroll
    for (int i = 0; i < 2; ++i) { const int b_ = tid * 16 + i * 8192, R = b_ >> 7, pp = (b_ >> 4) & 7, rr_ = R & 15, ff = ((rr_ >> 1) & 1) | (((rr_ >> 3) & 1) << 2);
        const int rho = R & 31, Rb = (R & ~31) + 8 * ((rho & 15) >> 2) + 4 * (rho >> 4) + (rho & 3);
        voffA[i] = (unsigned)(R * RP + ((pp ^ ff) * 16)); voffB[i] = (unsigned)(Rb * RP + ((pp ^ ff) * 16)); }
    const size_t kstep = (size_t)(BK * 2);
    const size_t hstep = (size_t)HALF * RP;
    const size_t tstep = 2 * hstep;
    const unsigned ldsw = (unsigned)wid * 1024u;
    const int ffr = ((fr >> 1) & 1) | (((fr >> 3) & 1) << 2);
    const int aoff = (wr * 64 + fr) * 128 + (((2 * fq) ^ ffr) * 16), boff = (wc * 32 + fr) * 128 + (((2 * fq) ^ ffr) * 16), hoff = (ffr & 1) ? -16 : 16;
#define PG8_SA(b, h) (((b) * 2 + (h)) * HTB)
#define PG8_SB(b, h) ((4 + (b) * 2 + (h)) * HTB)
#define PG8_STAGE(bufoff, gbase, voff) do { _Pragma("unroll") for (int _i = 0; _i < 2; ++_i) \
        __builtin_amdgcn_global_load_lds((const unsigned*)((const char*)(gbase) + (voff)[_i]), (PG8_LAS unsigned*)(lds + (bufoff) + ldsw + _i * 8192), 16, 0, 0); } while (0)
#define PG8_LDA(dst, b, h) do { _Pragma("unroll") for (int m = 0; m < 4; ++m) { dst[m].lo = *(const PG8_LAS v4i_t*)(lds + PG8_SA(b, h) + aoff + m * 2048); dst[m].hi = *(const PG8_LAS v4i_t*)(lds + PG8_SA(b, h) + aoff + m * 2048 + hoff); } } while (0)
#define PG8_LDB(dst, b, h) do { _Pragma("unroll") for (int n = 0; n < 2; ++n) { dst[n].lo = *(const PG8_LAS v4i_t*)(lds + PG8_SB(b, h) + boff + n * 2048); dst[n].hi = *(const PG8_LAS v4i_t*)(lds + PG8_SB(b, h) + boff + n * 2048 + hoff); } } while (0)
#define PG8_MMA(ai, bj, At, Bt) do { __builtin_amdgcn_s_setprio(1); _Pragma("unroll") for (int m = 0; m < 4; ++m) _Pragma("unroll") for (int n = 0; n < 2; ++n) \
        asm volatile("v_mfma_f32_16x16x128_f8f6f4 %0, %1, %2, %0" : "+v"(acc[ai][bj][m][n]) : "v"(Bt[n]), "v"(At[m])); __builtin_amdgcn_s_setprio(0); } while (0)
#define PG8_WAIT_V(n) asm volatile("s_waitcnt vmcnt(" #n ")" ::: "memory")
#define PG8_WAIT_L(n) asm volatile("s_waitcnt lgkmcnt(" #n ")" ::: "memory")
#define PG8_BAR __builtin_amdgcn_s_barrier()
#define PG8_SCHED __builtin_amdgcn_sched_barrier(0)
    Unit cur, nxt; int ui = 0;
    if (!S.next(0, cur)) return;
    f32x4 acc[2][2][4][2];
#pragma unroll
    for (int a = 0; a < 2; ++a)
#pragma unroll
        for (int b = 0; b < 2; ++b)
#pragma unroll
            for (int m = 0; m < 4; ++m)
#pragma unroll
                for (int n = 0; n < 2; ++n) acc[a][b][m][n] = (f32x4){0.f, 0.f, 0.f, 0.f};
    v8i_t At[4], B0[2], B1[2];
    const char* cA = (const char*)g.A + (size_t)cur.pm * tstep; const char* cB = (const char*)g.Bt + (size_t)cur.pnB * tstep;

    if constexpr (SP2) {
        PG8_STAGE(PG8_SB(0, 0), cB, voffB); PG8_STAGE(PG8_SB(0, 1), cB + hstep, voffB); PG8_STAGE(PG8_SA(0, 0), cA, voffA); PG8_STAGE(PG8_SA(0, 1), cA + hstep, voffA);
        if (wr == 1) PG8_BAR;
        PG8_WAIT_V(2); PG8_BAR;
        PG8_STAGE(PG8_SB(1, 0), cB + kstep, voffB); PG8_STAGE(PG8_SA(1, 0), cA + kstep, voffA); PG8_STAGE(PG8_SB(1, 1), cB + hstep + kstep, voffB);
        PG8_WAIT_V(6); PG8_BAR;
    } else {
        PG8_STAGE(PG8_SB(0, 0), cB, voffB); PG8_STAGE(PG8_SA(0, 0), cA, voffA); PG8_STAGE(PG8_SB(0, 1), cB + hstep, voffB); PG8_STAGE(PG8_SA(0, 1), cA + hstep, voffA);
        if (wr == 1) PG8_BAR;
        PG8_WAIT_V(4); PG8_BAR;
        PG8_STAGE(PG8_SB(1, 0), cB + kstep, voffB); PG8_STAGE(PG8_SA(1, 0), cA + kstep, voffA); PG8_STAGE(PG8_SB(1, 1), cB + hstep + kstep, voffB);
        PG8_WAIT_V(6); PG8_BAR;
    }
    for (;;) {
        const bool has_next = S.next(ui + 1, nxt);
        const char* nA = has_next ? (const char*)g.A + (size_t)nxt.pm * tstep : cA; const char* nB = has_next ? (const char*)g.Bt + (size_t)nxt.pnB * tstep : cB;
        for (int t = 0; t < nt; t += 2) {
            const bool last = (t == nt - 2);
            const char* a1 = cA + (size_t)(t + 1) * kstep;
            const char* a2 = last ? nA : cA + (size_t)(t + 2) * kstep; const char* b2 = last ? nB : cB + (size_t)(t + 2) * kstep;
            const char* a3 = a2 + kstep; const char* b3 = b2 + kstep;

            if constexpr (SP2) {
            PG8_LDB(B0, 0, 0); PG8_LDB(B1, 0, 1); PG8_SCHED; PG8_LDA(At, 0, 0); PG8_STAGE(PG8_SA(1, 1), a1 + hstep, voffA);
            PG8_WAIT_V(8); PG8_WAIT_L(0); PG8_BAR; PG8_MMA(0, 0, At, B0); PG8_MMA(0, 1, At, B1); PG8_BAR; PG8_SCHED;
            PG8_LDA(At, 0, 1); PG8_STAGE(PG8_SB(0, 0), b2, voffB); PG8_STAGE(PG8_SB(0, 1), b2 + hstep, voffB); PG8_STAGE(PG8_SA(0, 0), a2, voffA);
            PG8_WAIT_V(8); PG8_WAIT_L(0); PG8_BAR; PG8_MMA(1, 0, At, B0); PG8_MMA(1, 1, At, B1); PG8_BAR; PG8_SCHED;
            PG8_LDB(B0, 1, 0); PG8_LDB(B1, 1, 1); PG8_SCHED; PG8_LDA(At, 1, 0); PG8_STAGE(PG8_SA(0, 1), a2 + hstep, voffA);
            PG8_WAIT_V(8); PG8_WAIT_L(0); PG8_BAR; PG8_MMA(0, 0, At, B0); PG8_MMA(0, 1, At, B1); PG8_BAR; PG8_SCHED;
            PG8_LDA(At, 1, 1); PG8_STAGE(PG8_SB(1, 0), b3, voffB); PG8_STAGE(PG8_SB(1, 1), b3 + hstep, voffB); PG8_STAGE(PG8_SA(1, 0), a3, voffA);
            PG8_WAIT_V(8); PG8_WAIT_L(0); PG8_BAR; PG8_MMA(1, 0, At, B0); PG8_MMA(1, 1, At, B1); PG8_BAR; PG8_SCHED;
            } else {
            PG8_LDB(B0, 0, 0); PG8_SCHED; PG8_LDA(At, 0, 0); PG8_STAGE(PG8_SA(1, 1), a1 + hstep, voffA);
            PG8_WAIT_L(8); PG8_BAR; PG8_WAIT_L(0); PG8_MMA(0, 0, At, B0); PG8_BAR; PG8_SCHED;
            PG8_LDB(B1, 0, 1); PG8_STAGE(PG8_SB(0, 0), b2, voffB);
            PG8_BAR; PG8_WAIT_L(0); PG8_MMA(0, 1, At, B1); PG8_BAR;
            PG8_LDA(At, 0, 1); PG8_STAGE(PG8_SA(0, 0), a2, voffA);
            PG8_BAR; PG8_WAIT_L(0); PG8_MMA(1, 0, At, B0); PG8_BAR; PG8_SCHED;
            PG8_STAGE(PG8_SB(0, 1), b2 + hstep, voffB);
            PG8_WAIT_V(6); PG8_BAR; PG8_MMA(1, 1, At, B1); PG8_BAR;
            PG8_LDB(B0, 1, 0); PG8_SCHED; PG8_LDA(At, 1, 0); PG8_STAGE(PG8_SA(0, 1), a2 + hstep, voffA);
            PG8_WAIT_L(8); PG8_BAR; PG8_WAIT_L(0); PG8_MMA(0, 0, At, B0); PG8_BAR; PG8_SCHED;
            PG8_LDB(B1, 1, 1); PG8_STAGE(PG8_SB(1, 0), b3, voffB);
            PG8_BAR; PG8_WAIT_L(0); PG8_MMA(0, 1, At, B1); PG8_BAR;
            PG8_LDA(At, 1, 1); PG8_STAGE(PG8_SA(1, 0), a3, voffA);
            PG8_BAR; PG8_WAIT_L(0); PG8_MMA(1, 0, At, B0); PG8_BAR; PG8_SCHED;
            PG8_STAGE(PG8_SB(1, 1), b3 + hstep, voffB);
            PG8_WAIT_V(6); PG8_BAR; PG8_MMA(1, 1, At, B1); PG8_BAR;
            }
        }
        asm volatile("s_nop 15\n\ts_nop 15" ::: "memory");
        if constexpr (ALIGN_EPI) { if (wr == 0) PG8_BAR; }
        run_epi8(E, acc, cur, wr, wc, fr, fq);
        if (!has_next) break;
#pragma unroll
        for (int a = 0; a < 2; ++a)
#pragma unroll
            for (int b = 0; b < 2; ++b)
#pragma unroll
                for (int m = 0; m < 4; ++m)
#pragma unroll
                    for (int n = 0; n < 2; ++n) acc[a][b][m][n] = (f32x4){0.f, 0.f, 0.f, 0.f};
        cur = nxt; cA = nA; cB = nB; ++ui;
        if constexpr (ALIGN_EPI) { if (wr == 1) PG8_BAR; }
    }
    PG8_WAIT_V(0);
    if constexpr (!ALIGN_EPI) { if (wr == 0) PG8_BAR; }
    PG8_BAR;

#undef PG8_SA
#undef PG8_SB
#undef PG8_STAGE
#undef PG8_LDA
#undef PG8_LDB
#undef PG8_MMA
#undef PG8_WAIT_V
#undef PG8_WAIT_L
#undef PG8_BAR
#undef PG8_SCHED
}

template <class Epi, class Sched, bool ALIGN_EPI = false, bool SP2 = false>
__device__ __forceinline__ void gemm_phase_f8g(PG8_LAS unsigned char* lds, const Gemm g, const Sched& S, const Epi& E, const int* tok) {
    const int tid = threadIdx.x, wid = __builtin_amdgcn_readfirstlane(tid >> 6), lane = tid & 63, wr = wid >> 2, wc = wid & 3, fr = lane & 15, fq = lane >> 4;
    const int RP = g.K, nt = RP / 128;
    unsigned voffA[2], voffB[2]; int rowA[2];
#pragma unroll
    for (int i = 0; i < 2; ++i) { const int b_ = tid * 16 + i * 8192, R = b_ >> 7, pp = (b_ >> 4) & 7, rr_ = R & 15, ff = ((rr_ >> 1) & 1) | (((rr_ >> 3) & 1) << 2);
        const int rho = R & 31, Rb = (R & ~31) + 8 * ((rho & 15) >> 2) + 4 * (rho >> 4) + (rho & 3);
        voffA[i] = (unsigned)((pp ^ ff) * 16); rowA[i] = R; voffB[i] = (unsigned)(Rb * RP + ((pp ^ ff) * 16)); }
    const size_t kstep = (size_t)(BK * 2);
    const size_t hstep = (size_t)HALF * RP;
    const size_t tstep = 2 * hstep;
    const unsigned ldsw = (unsigned)wid * 1024u;
    const int ffr = ((fr >> 1) & 1) | (((fr >> 3) & 1) << 2);
    const int aoff = (wr * 64 + fr) * 128 + (((2 * fq) ^ ffr) * 16), boff = (wc * 32 + fr) * 128 + (((2 * fq) ^ ffr) * 16), hoff = (ffr & 1) ? -16 : 16;
#define PG8_SA(b, h) (((b) * 2 + (h)) * HTB)
#define PG8_SB(b, h) ((4 + (b) * 2 + (h)) * HTB)
#define PG8_STAGE(bufoff, gbase, voff) do { _Pragma("unroll") for (int _i = 0; _i < 2; ++_i) \
        __builtin_amdgcn_global_load_lds((const unsigned*)((const char*)(gbase) + (voff)[_i]), (PG8_LAS unsigned*)(lds + (bufoff) + ldsw + _i * 8192), 16, 0, 0); } while (0)
#define PG8_LDA(dst, b, h) do { _Pragma("unroll") for (int m = 0; m < 4; ++m) { dst[m].lo = *(const PG8_LAS v4i_t*)(lds + PG8_SA(b, h) + aoff + m * 2048); dst[m].hi = *(const PG8_LAS v4i_t*)(lds + PG8_SA(b, h) + aoff + m * 2048 + hoff); } } while (0)
#define PG8_LDB(dst, b, h) do { _Pragma("unroll") for (int n = 0; n < 2; ++n) { dst[n].lo = *(const PG8_LAS v4i_t*)(lds + PG8_SB(b, h) + boff + n * 2048); dst[n].hi = *(const PG8_LAS v4i_t*)(lds + PG8_SB(b, h) + boff + n * 2048 + hoff); } } while (0)
#define PG8_MMA(ai, bj, At, Bt) do { __builtin_amdgcn_s_setprio(1); _Pragma("unroll") for (int m = 0; m < 4; ++m) _Pragma("unroll") for (int n = 0; n < 2; ++n) \
        asm volatile("v_mfma_f32_16x16x128_f8f6f4 %0, %1, %2, %0" : "+v"(acc[ai][bj][m][n]) : "v"(Bt[n]), "v"(At[m])); __builtin_amdgcn_s_setprio(0); } while (0)
#define PG8_WAIT_V(n) asm volatile("s_waitcnt vmcnt(" #n ")" ::: "memory")
#define PG8_WAIT_L(n) asm volatile("s_waitcnt lgkmcnt(" #n ")" ::: "memory")
#define PG8_BAR __builtin_amdgcn_s_barrier()
#define PG8_SCHED __builtin_amdgcn_sched_barrier(0)
    Unit cur, nxt; int ui = 0;
    if (!S.next(0, cur)) return;
    f32x4 acc[2][2][4][2];
#pragma unroll
    for (int a = 0; a < 2; ++a)
#pragma unroll
        for (int b = 0; b < 2; ++b)
#pragma unroll
            for (int m = 0; m < 4; ++m)
#pragma unroll
                for (int n = 0; n < 2; ++n) acc[a][b][m][n] = (f32x4){0.f, 0.f, 0.f, 0.f};
    v8i_t At[4], B0[2], B1[2];
    const char* cA = (const char*)g.A; const char* cB = (const char*)g.Bt + (size_t)cur.pnB * tstep;
    unsigned vC[2][2], vN[2][2] = {{0u, 0u}, {0u, 0u}};
#define PG8_TOKOFF(dst, pm_) do { _Pragma("unroll") for (int h_ = 0; h_ < 2; ++h_) _Pragma("unroll") for (int i_ = 0; i_ < 2; ++i_) dst[h_][i_] = (unsigned)tok[(pm_) * 256 + h_ * 128 + rowA[i_]] * (unsigned)RP + voffA[i_]; } while (0)
    PG8_TOKOFF(vC, cur.pm);

    if constexpr (SP2) {
        PG8_STAGE(PG8_SB(0, 0), cB, voffB); PG8_STAGE(PG8_SB(0, 1), cB + hstep, voffB); PG8_STAGE(PG8_SA(0, 0), cA, vC[0]); PG8_STAGE(PG8_SA(0, 1), cA, vC[1]);
        if (wr == 1) PG8_BAR;
        PG8_WAIT_V(2); PG8_BAR;
        PG8_STAGE(PG8_SB(1, 0), cB + kstep, voffB); PG8_STAGE(PG8_SA(1, 0), cA + kstep, vC[0]); PG8_STAGE(PG8_SB(1, 1), cB + hstep + kstep, voffB);
        PG8_WAIT_V(6); PG8_BAR;
    } else {
        PG8_STAGE(PG8_SB(0, 0), cB, voffB); PG8_STAGE(PG8_SA(0, 0), cA, vC[0]); PG8_STAGE(PG8_SB(0, 1), cB + hstep, voffB); PG8_STAGE(PG8_SA(0, 1), cA, vC[1]);
        if (wr == 1) PG8_BAR;
        PG8_WAIT_V(4); PG8_BAR;
        PG8_STAGE(PG8_SB(1, 0), cB + kstep, voffB); PG8_STAGE(PG8_SA(1, 0), cA + kstep, vC[0]); PG8_STAGE(PG8_SB(1, 1), cB + hstep + kstep, voffB);
        PG8_WAIT_V(6); PG8_BAR;
    }
    for (;;) {
        const bool has_next = S.next(ui + 1, nxt);
        const char* nB = has_next ? (const char*)g.Bt + (size_t)nxt.pnB * tstep : cB;
        int tkN[2][2] = {{0, 0}, {0, 0}};
        if (has_next) { _Pragma("unroll") for (int h_ = 0; h_ < 2; ++h_) _Pragma("unroll") for (int i_ = 0; i_ < 2; ++i_) tkN[h_][i_] = tok[nxt.pm * 256 + h_ * 128 + rowA[i_]]; }
        for (int t = 0; t < nt; t += 2) {
            const bool last = (t == nt - 2);
            const char* a1 = cA + (size_t)(t + 1) * kstep;
            const char* a2 = last ? cA : cA + (size_t)(t + 2) * kstep; const char* b2 = last ? nB : cB + (size_t)(t + 2) * kstep;
            unsigned vs0[2] = {vC[0][0], vC[0][1]}, vs1[2] = {vC[1][0], vC[1][1]};
            if (last && has_next) { asm volatile("" : "+v"(tkN[0][0]), "+v"(tkN[0][1]), "+v"(tkN[1][0]), "+v"(tkN[1][1]));
                _Pragma("unroll") for (int h_ = 0; h_ < 2; ++h_) _Pragma("unroll") for (int i_ = 0; i_ < 2; ++i_) vN[h_][i_] = (unsigned)tkN[h_][i_] * (unsigned)RP + voffA[i_];
                vs0[0] = vN[0][0]; vs0[1] = vN[0][1]; vs1[0] = vN[1][0]; vs1[1] = vN[1][1]; }
            const char* a3 = a2 + kstep; const char* b3 = b2 + kstep;

            if constexpr (SP2) {
            PG8_LDB(B0, 0, 0); PG8_LDB(B1, 0, 1); PG8_SCHED; PG8_LDA(At, 0, 0); PG8_STAGE(PG8_SA(1, 1), a1, vC[1]);
            PG8_WAIT_V(8); PG8_WAIT_L(0); PG8_BAR; PG8_MMA(0, 0, At, B0); PG8_MMA(0, 1, At, B1); PG8_BAR; PG8_SCHED;
            PG8_LDA(At, 0, 1); PG8_STAGE(PG8_SB(0, 0), b2, voffB); PG8_STAGE(PG8_SB(0, 1), b2 + hstep, voffB); PG8_STAGE(PG8_SA(0, 0), a2, vs0);
            PG8_WAIT_V(8); PG8_WAIT_L(0); PG8_BAR; PG8_MMA(1, 0, At, B0); PG8_MMA(1, 1, At, B1); PG8_BAR; PG8_SCHED;
            PG8_LDB(B0, 1, 0); PG8_LDB(B1, 1, 1); PG8_SCHED; PG8_LDA(At, 1, 0); PG8_STAGE(PG8_SA(0, 1), a2, vs1);
            PG8_WAIT_V(8); PG8_WAIT_L(0); PG8_BAR; PG8_MMA(0, 0, At, B0); PG8_MMA(0, 1, At, B1); PG8_BAR; PG8_SCHED;
            PG8_LDA(At, 1, 1); PG8_STAGE(PG8_SB(1, 0), b3, voffB); PG8_STAGE(PG8_SB(1, 1), b3 + hstep, voffB); PG8_STAGE(PG8_SA(1, 0), a3, vs0);
            PG8_WAIT_V(8); PG8_WAIT_L(0); PG8_BAR; PG8_MMA(1, 0, At, B0); PG8_MMA(1, 1, At, B1); PG8_BAR; PG8_SCHED;
            } else {
            PG8_LDB(B0, 0, 0); PG8_SCHED; PG8_LDA(At, 0, 0); PG8_STAGE(PG8_SA(1, 1), a1, vC[1]);
            PG8_WAIT_L(8); PG8_BAR; PG8_WAIT_L(0); PG8_MMA(0, 0, At, B0); PG8_BAR; PG8_SCHED;
            PG8_LDB(B1, 0, 1); PG8_STAGE(PG8_SB(0, 0), b2, voffB);
            PG8_BAR; PG8_WAIT_L(0); PG8_MMA(0, 1, At, B1); PG8_BAR;
            PG8_LDA(At, 0, 1); PG8_STAGE(PG8_SA(0, 0), a2, vs0);
            PG8_BAR; PG8_WAIT_L(0); PG8_MMA(1, 0, At, B0); PG8_BAR; PG8_SCHED;
            PG8_STAGE(PG8_SB(0, 1), b2 + hstep, voffB);
            PG8_WAIT_V(6); PG8_BAR; PG8_MMA(1, 1, At, B1); PG8_BAR;
            PG8_LDB(B0, 1, 0); PG8_SCHED; PG8_LDA(At, 1, 0); PG8_STAGE(PG8_SA(0, 1), a2, vs1);
            PG8_WAIT_L(8); PG8_BAR; PG8_WAIT_L(0); PG8_MMA(0, 0, At, B0); PG8_BAR; PG8_SCHED;
            PG8_LDB(B1, 1, 1); PG8_STAGE(PG8_SB(1, 0), b3, voffB);
            PG8_BAR; PG8_WAIT_L(0); PG8_MMA(0, 1, At, B1); PG8_BAR;
            PG8_LDA(At, 1, 1); PG8_STAGE(PG8_SA(1, 0), a3, vs0);
            PG8_BAR; PG8_WAIT_L(0); PG8_MMA(1, 0, At, B0); PG8_BAR; PG8_SCHED;
            PG8_STAGE(PG8_SB(1, 1), b3 + hstep, voffB);
            PG8_WAIT_V(6); PG8_BAR; PG8_MMA(1, 1, At, B1); PG8_BAR;
            }
        }
        asm volatile("s_nop 15\n\ts_nop 15" ::: "memory");
        if constexpr (ALIGN_EPI) { if (wr == 0) PG8_BAR; }
        run_epi8(E, acc, cur, wr, wc, fr, fq);
        if (!has_next) break;
#pragma unroll
        for (int a = 0; a < 2; ++a)
#pragma unroll
            for (int b = 0; b < 2; ++b)
#pragma unroll
                for (int m = 0; m < 4; ++m)
#pragma unroll
                    for (int n = 0; n < 2; ++n) acc[a][b][m][n] = (f32x4){0.f, 0.f, 0.f, 0.f};
        cur = nxt; cB = nB; ++ui; vC[0][0] = vN[0][0]; vC[0][1] = vN[0][1]; vC[1][0] = vN[1][0]; vC[1][1] = vN[1][1];
        if constexpr (ALIGN_EPI) { if (wr == 1) PG8_BAR; }
    }
    PG8_WAIT_V(0);
    if constexpr (!ALIGN_EPI) { if (wr == 0) PG8_BAR; }
    PG8_BAR;

#undef PG8_TOKOFF
#undef PG8_SA
#undef PG8_SB
#undef PG8_STAGE
#undef PG8_LDA
#undef PG8_LDB
#undef PG8_MMA
#undef PG8_WAIT_V
#undef PG8_WAIT_L
#undef PG8_BAR
#undef PG8_SCHED
}
}

constexpr int D = 1024, BATCH = 8, SEQ = 2048, CTXL = 256;
constexpr int M = BATCH * SEQ;
constexpr int MC = BATCH * CTXL;
constexpr int MT = M + MC;
constexpr int DIN = 2048, DSGU = 512, DLRU = 512, NE = 16, CAP = 256, DE = 2048, NMOD = 6 * D;
constexpr int NSEG = 36;
constexpr float EPS = 1e-6f;
constexpr int NWAVES = 8, NTHREADS = 512;
constexpr int LDS_BYTES = 147456;
constexpr int NPH = 11;

constexpr size_t MiB = 1u << 20;
constexpr size_t WS_CTL = 0;
constexpr size_t WS_MOD = 1 * MiB;
constexpr size_t WS_SUM = 1 * MiB + 512 * 1024;
constexpr size_t WS_AFF = 4 * MiB;
constexpr size_t WS_SLOT = 5 * MiB;
constexpr size_t WS_GATE = 6 * MiB;
constexpr size_t WS_TOK = 6 * MiB + 128 * 1024;
constexpr size_t WS_GWT = 6 * MiB + 512 * 1024;
constexpr size_t WS_SWB = 7 * MiB;
constexpr size_t WS_WIN = 8 * MiB;
constexpr size_t WS_WOUT = 12 * MiB;
constexpr size_t WS_WG = 14 * MiB;
constexpr size_t WS_W2 = 142 * MiB;
constexpr size_t WS_X1 = 206 * MiB;
constexpr size_t WS_HS = 206 * MiB, WS_PF = 222 * MiB, WS_PB = 238 * MiB;
constexpr size_t WS_HX2 = 270 * MiB;
constexpr size_t WS_XCH = 286 * MiB;
constexpr size_t WS_CB = 1 * MiB + 256 * 1024;
constexpr size_t WS_XE = 302 * MiB;
constexpr size_t WS_A2 = 302 * MiB, WS_YE = 302 * MiB;
constexpr size_t WS_HID = 366 * MiB;
constexpr size_t WS_HX = 366 * MiB;
constexpr size_t WS_UV = 402 * MiB;
constexpr size_t WS_XC = 466 * MiB;
constexpr size_t WS_END = 494 * MiB;

#define GAS __attribute__((address_space(1)))
#define LAS __attribute__((address_space(3)))
typedef unsigned short bf16;
typedef unsigned v4u __attribute__((ext_vector_type(4)));
typedef unsigned v2u __attribute__((ext_vector_type(2)));
typedef float f32x4 __attribute__((ext_vector_type(4)));
typedef short bf16x8 __attribute__((ext_vector_type(8)));
#define LDS_WAIT() asm volatile("s_waitcnt lgkmcnt(0)" ::: "memory")

__device__ __forceinline__ float bf2f(bf16 b) { return __uint_as_float(((unsigned)b) << 16); }
__device__ __forceinline__ unsigned f2bf(float f) { unsigned u = __float_as_uint(f); return (u + 0x7fffu + ((u >> 16) & 1u)) >> 16; }
typedef __bf16 bf16x2_hw __attribute__((ext_vector_type(2)));
typedef float f32x2_hw __attribute__((ext_vector_type(2)));
__device__ __forceinline__ unsigned pk2(float lo, float hi) { const f32x2_hw v = {lo, hi}; return __builtin_bit_cast(unsigned, __builtin_convertvector(v, bf16x2_hw)); }
__device__ __forceinline__ float bflo(unsigned w) { return __uint_as_float(w << 16); }
__device__ __forceinline__ float bfhi(unsigned w) { return __uint_as_float(w & 0xffff0000u); }
__device__ __forceinline__ float rcpf_(float x) { return __builtin_amdgcn_rcpf(x); }
__device__ __forceinline__ float exp2f_(float x) { return __builtin_amdgcn_exp2f(x); }
__device__ __forceinline__ float sigmoidf_(float x) { return rcpf_(1.f + exp2f_(-1.4426950408889634f * x)); }
__device__ __forceinline__ float siluf_(float x) { return x * rcpf_(1.f + exp2f_(-1.4426950408889634f * x)); }
__device__ __forceinline__ float geluf_(float x) { const float u = x * (0.7978845608028654f + 0.035677408136300125f * x * x); return x * rcpf_(1.f + exp2f_(-2.8853900817779268f * u)); }
__device__ __forceinline__ void decay_pair(float la, float& a, float& s) {
    const float x = 2.f * la;
    const float p1 = la * (1.f + la * (0.5f + la * (0.16666667f + la * (0.041666668f + la * 0.0083333333f))));
    const float p2 = x * (1.f + x * (0.5f + x * (0.16666667f + x * (0.041666668f + x * (0.0083333333f + x * 0.0013888889f)))));
    const float e1 = exp2f_(1.4426950408889634f * la);
    const bool small = la > -0.15f;
    a = small ? 1.f + p1 : e1;
    s = __builtin_amdgcn_sqrtf(small ? -p2 : 1.f - e1 * e1);
}
typedef float f32x2p __attribute__((ext_vector_type(2)));
__device__ __forceinline__ f32x2p sigmoid2_(f32x2p x) { const f32x2p t = x * -1.4426950408889634f; f32x2p e; e.x = exp2f_(t.x); e.y = exp2f_(t.y); e = e + 1.f; f32x2p r; r.x = rcpf_(e.x); r.y = rcpf_(e.y); return r; }
__device__ __forceinline__ f32x2p gelu2_(f32x2p x) { const f32x2p u = x * (x * x * 0.035677408136300125f + 0.7978845608028654f), t = u * -2.8853900817779268f; f32x2p e; e.x = exp2f_(t.x); e.y = exp2f_(t.y); e = e + 1.f;
    f32x2p r; r.x = rcpf_(e.x); r.y = rcpf_(e.y); return x * r; }
__device__ __forceinline__ void decay_pair2(f32x2p la, f32x2p& a, f32x2p& s) {
    const f32x2p x = la * 2.f;
    const f32x2p p1 = la * (la * (la * (la * (la * 0.0083333333f + 0.041666668f) + 0.16666667f) + 0.5f) + 1.f);
    const f32x2p p2 = x * (x * (x * (x * (x * (x * 0.0013888889f + 0.0083333333f) + 0.041666668f) + 0.16666667f) + 0.5f) + 1.f);
    const f32x2p tt = la * 1.4426950408889634f; f32x2p e1; e1.x = exp2f_(tt.x); e1.y = exp2f_(tt.y);
    const f32x2p big = 1.f - e1 * e1, one = p1 + 1.f;
    a.x = la.x > -0.15f ? one.x : e1.x; a.y = la.y > -0.15f ? one.y : e1.y;
    s.x = __builtin_amdgcn_sqrtf(la.x > -0.15f ? -p2.x : big.x); s.y = __builtin_amdgcn_sqrtf(la.y > -0.15f ? -p2.y : big.y);
}
__device__ __forceinline__ unsigned pk4_fp8(float a, float b, float c, float d) {
    unsigned w = 0u; w = __builtin_amdgcn_cvt_pk_fp8_f32(a, b, w, false); w = __builtin_amdgcn_cvt_pk_fp8_f32(c, d, w, true); return w; }
constexpr float WSCALE = 32.f, WSCALE_INV = 1.f / 32.f;
__device__ __forceinline__ float wave_sum(float v) {
#pragma unroll
    for (int o = 1; o < 64; o <<= 1) v += __shfl_xor(v, o);
    return v;
}


#define XB_TMO      128
#define XB_XCNT(j)  (256  + 64 * (j))
#define XB_XSUB(j)  (1280 + 64 * (j))
#define XB_XGEN(j)  (2304 + 64 * (j))
#define XB_TOP      3328
#define XB_TOPGEN   3392
#define XCD_BAR_WORDS 3456
#define XB_SPIN_CAP (1u << 18)
__device__ __forceinline__ unsigned xb_ld(unsigned* p)              { return __hip_atomic_load(p, __ATOMIC_RELAXED, __HIP_MEMORY_SCOPE_AGENT); }
__device__ __forceinline__ unsigned xb_add(unsigned* p, unsigned v) { return __hip_atomic_fetch_add(p, v, __ATOMIC_RELAXED, __HIP_MEMORY_SCOPE_AGENT); }
__device__ __forceinline__ unsigned xb_xcc_id() { return (unsigned)__builtin_amdgcn_s_getreg((3 << 11) | 20) & 0xFu; }
#define XB_SPIN(cond, bar) do { unsigned _sp = 0; while (cond) { __builtin_amdgcn_s_sleep(1); \
    if ((++_sp & 255u) == 0u) { if (xb_ld(&(bar)[XB_TMO])) break; if (_sp > XB_SPIN_CAP) { atomicAdd(&(bar)[XB_TMO], 1u); break; } } } } while (0)
struct XcdBarrier { unsigned* bar; unsigned x; volatile LAS unsigned* st; unsigned total; };
__device__ __forceinline__ XcdBarrier xcd_barrier_post(unsigned* bar, volatile LAS unsigned* st, unsigned total) {
    XcdBarrier b; b.bar = bar; b.x = xb_xcc_id(); b.st = st; b.total = total;
    if (threadIdx.x == 0) (void)xb_add(&bar[XB_XCNT(b.x)], 1u);
    return b;
}
__device__ __forceinline__ void xcd_barrier_complete(unsigned* bar, unsigned x, unsigned G, unsigned& nloc, unsigned& nx) {
    unsigned sum, cnt, mine, sp = 0u;
    for (;;) {
        sum = 0u; cnt = 0u; mine = 0u;
#pragma unroll
        for (unsigned j = 0; j < 16; ++j) { const unsigned c = xb_ld(&bar[XB_XCNT(j)]); sum += c; cnt += (c > 0u) ? 1u : 0u; mine = (j == x) ? c : mine; }
        if (sum == G) break;
        __builtin_amdgcn_s_sleep(1);
        if ((++sp & 255u) == 0u) { if (xb_ld(&bar[XB_TMO])) break; if (sp > XB_SPIN_CAP) { atomicAdd(&bar[XB_TMO], 1u); break; } }
    }
    nloc = mine > 0u ? mine : 1u; nx = cnt > 0u ? cnt : 1u;
}
__device__ __forceinline__ void xcd_barrier(const XcdBarrier& b) {
    asm volatile("s_waitcnt vmcnt(0)" ::: "memory");
    __syncthreads();
    if (threadIdx.x == 0) {
        unsigned* bar = b.bar;
        __builtin_amdgcn_s_waitcnt(0);
        unsigned nloc = b.st[0], nx = b.st[1];
        if (nloc == 0u) { xcd_barrier_complete(bar, b.x, b.total, nloc, nx); b.st[0] = nloc; b.st[1] = nx; }
        const unsigned old = xb_add(&bar[XB_XSUB(b.x)], 1u);
        const unsigned gen = old / nloc;
        if (old + 1u == (gen + 1u) * nloc) {
            __builtin_amdgcn_fence(__ATOMIC_RELEASE, "agent");
            asm volatile("s_waitcnt vmcnt(0)" ::: "memory");
            const unsigned og = xb_add(&bar[XB_TOP], 1u);
            const unsigned tg = og / nx;
            if (og + 1u == (tg + 1u) * nx) xb_add(&bar[XB_TOPGEN], 1u);
            else XB_SPIN(xb_ld(&bar[XB_TOPGEN]) == tg, bar);
            __builtin_amdgcn_fence(__ATOMIC_ACQUIRE, "agent");
            xb_add(&bar[XB_XGEN(b.x)], 1u);
            asm volatile("s_waitcnt vmcnt(0)" ::: "memory");
        } else {
            XB_SPIN(xb_ld(&bar[XB_XGEN(b.x)]) == gen, bar);
            __builtin_amdgcn_fence(__ATOMIC_ACQUIRE, "agent");
            asm volatile("s_waitcnt vmcnt(0)" ::: "memory");
        }
    }
    __syncthreads();
}

struct P {
    const float *x, *c, *ctx, *c_ctx, *w_mod, *b_mod, *norm1_g, *norm2_g, *w_in, *sgu_g, *sgu_w, *sgu_b, *conv_w, *conv_b,
                *rg_wa, *rg_ba, *rg_wi, *rg_bi, *rg_lam, *w_out, *w_router, *w1, *w3, *w2, *final_g;
    float* out; unsigned char* ws; int ph_lo, ph_hi;
};

struct SchedG1 { int G, c;
    __device__ __forceinline__ bool next(int i, pg8::Unit& u) const { const int L = i * G + c; if (L >= 528) return false;
        if (L < 512) { u.pm = L >> 3; u.pn = L & 7; } else { const int r = L - 512; u.pm = 64 + (r >> 1); u.pn = 4 + (r & 1); } u.pnB = u.pn; return true; } };
struct SchedG2 { int G, c;
    __device__ __forceinline__ bool next(int i, pg8::Unit& u) const { const int L = i * G + c; if (L >= 256) return false; u.pm = L >> 2; u.pn = L & 3; u.pnB = u.pn; return true; } };
struct SchedG3 { int G, c;
    __device__ __forceinline__ bool next(int i, pg8::Unit& u) const { const int L = i * G + c; if (L >= 2048) return false; const int e = L >> 7, loc = L & 127;
        u.pm = e * 8 + (loc & 7); u.pn = loc >> 3; u.pnB = e * 16 + u.pn; return true; } };
struct SchedG4 { int G, c;
    __device__ __forceinline__ bool next(int i, pg8::Unit& u) const { const int L = i * G + c; if (L >= 512) return false; const int e = L >> 5, loc = L & 31;
        u.pm = e * 8 + (loc & 7); u.pn = loc >> 3; u.pnB = e * 4 + u.pn; return true; } };

struct EpiG1 { static constexpr bool PAIRED = false, FUSED = false; bf16* UV; bf16* XC;
    __device__ __forceinline__ void st8(const pg8::Unit& u, int row, int col, f32x4 v0, f32x4 v1) const {
        const int grow = u.pm * 256 + row, gcol = u.pn * 256 + col;
        if (u.pm < 64) {
            if (gcol < 1024 || gcol >= 1536) { const f32x2p a = gelu2_((f32x2p){v0[0], v0[1]}), b = gelu2_((f32x2p){v0[2], v0[3]}), c = gelu2_((f32x2p){v1[0], v1[1]}), d = gelu2_((f32x2p){v1[2], v1[3]});
                v0 = (f32x4){a.x, a.y, b.x, b.y}; v1 = (f32x4){c.x, c.y, d.x, d.y}; }
            *(v4u*)(UV + (size_t)grow * DIN + gcol) = (v4u){pk2(v0[0], v0[1]), pk2(v0[2], v0[3]), pk2(v1[0], v1[1]), pk2(v1[2], v1[3])};
        } else *(v4u*)(XC + (size_t)(grow - M) * DLRU + (gcol - 1024)) = (v4u){pk2(v0[0], v0[1]), pk2(v0[2], v0[3]), pk2(v1[0], v1[1]), pk2(v1[2], v1[3])};
    } };
struct EpiG2 { static constexpr bool PAIRED = false, FUSED = false; const float* x; const float* MOD; float* X1;
    __device__ __forceinline__ void st8(const pg8::Unit& u, int row, int col, f32x4 v0, f32x4 v1) const {
        const int grow = u.pm * 256 + row, gcol = u.pn * 256 + col, b = grow >> 11;
        const f32x4* xp = (const f32x4*)(x + (size_t)grow * D + gcol); const f32x4* gp = (const f32x4*)(MOD + b * NMOD + 2 * D + gcol); f32x4* op = (f32x4*)(X1 + (size_t)grow * D + gcol);
        op[0] = xp[0] + gp[0] * v0; op[1] = xp[1] + gp[1] * v1;
    } };
#if MOE_FP8
typedef float f32x2v __attribute__((ext_vector_type(2)));
__device__ __forceinline__ f32x2v swiglu_scaled2(f32x2v g, f32x2v u) {
    constexpr float K1 = -1.4426950408889634f * WSCALE_INV, S2 = WSCALE * WSCALE;
    const f32x2v t = g * K1; f32x2v e; e.x = exp2f_(t.x); e.y = exp2f_(t.y);
    const f32x2v d = e * S2 + S2; f32x2v r; r.x = rcpf_(d.x); r.y = rcpf_(d.y);
    return (g * u) * r;
}
struct EpiG3 { static constexpr bool PAIRED = true; unsigned char* HID;
    __device__ __forceinline__ void st2x8(const pg8::Unit& u, int row, int col, f32x4 g0, f32x4 g1, f32x4 u0, f32x4 u1) const {
        const int grow = u.pm * 256 + row, hc = u.pn * 128 + col;
        const f32x2v a = swiglu_scaled2((f32x2v){g0[0], g0[1]}, (f32x2v){u0[0], u0[1]}), b = swiglu_scaled2((f32x2v){g0[2], g0[3]}, (f32x2v){u0[2], u0[3]});
        const f32x2v c = swiglu_scaled2((f32x2v){g1[0], g1[1]}, (f32x2v){u1[0], u1[1]}), d = swiglu_scaled2((f32x2v){g1[2], g1[3]}, (f32x2v){u1[2], u1[3]});
        v2u w; w.x = pk4_fp8(a.x, a.y, b.x, b.y); w.y = pk4_fp8(c.x, c.y, d.x, d.y);
        *(v2u*)(HID + (size_t)grow * DE + hc) = w;
    } };
struct EpiG4 { static constexpr bool PAIRED = false; const float* GATE; unsigned char* YE;
    __device__ __forceinline__ void st8(const pg8::Unit& u, int row, int col, f32x4 v0, f32x4 v1) const {
        const int grow = u.pm * 256 + row, gcol = u.pn * 256 + col; const float gt = GATE[grow];
        v2u w; w.x = pk4_fp8(v0[0] * gt, v0[1] * gt, v0[2] * gt, v0[3] * gt); w.y = pk4_fp8(v1[0] * gt, v1[1] * gt, v1[2] * gt, v1[3] * gt);
        *(v2u*)(YE + (size_t)grow * D + gcol) = w;
    } };
#else
struct EpiG3 { static constexpr bool PAIRED = true; bf16* HID;
    __device__ __forceinline__ void st2(const pg8::Unit& u, int row, int col, f32x4 g, f32x4 up) const {
        const int grow = u.pm * 256 + row, hc = u.pn * 128 + col;
        v2u w; w.x = pk2(siluf_(g[0]) * up[0], siluf_(g[1]) * up[1]); w.y = pk2(siluf_(g[2]) * up[2], siluf_(g[3]) * up[3]);
        *(v2u*)(HID + (size_t)grow * DE + hc) = w;
    } };
struct EpiG4 { static constexpr bool PAIRED = false; const float* GATE; bf16* YE;
    __device__ __forceinline__ void st(const pg8::Unit& u, int row, int col, f32x4 v) const {
        const int grow = u.pm * 256 + row, gcol = u.pn * 256 + col; const float gt = GATE[grow];
        v2u w; w.x = pk2(v[0] * gt, v[1] * gt); w.y = pk2(v[2] * gt, v[3] * gt); *(v2u*)(YE + (size_t)grow * D + gcol) = w;
    } };

#endif


struct EpiG2F { static constexpr bool PAIRED = false, FUSED = true;
    const float* x; const float* MOD; float* X1; const float* w_router; const float* norm2_g; const float* CB; float* XCH; unsigned* cnt; unsigned* tmo; unsigned char* HX8; float* AFF;
    __device__ __forceinline__ void fused(f32x4 (&acc)[2][2][4][2], const pg8::Unit& u, int wr, int wc, int fr, int fq, LAS unsigned char* lds, int wid, int lane) const {
        const int tid = wid * 64 + lane, b = u.pm >> 3, grow0 = u.pm * 256, gcol0 = u.pn * 256;
        LAS float* LQ = (LAS float*)lds;
        LAS float* RINV = (LAS float*)(lds + 81920);
        const float* MODb = MOD + b * NMOD;
        float gsc[2][8], shv[2][8], wrv[2][8];
#pragma unroll
        for (int bj = 0; bj < 2; ++bj)
#pragma unroll
            for (int j = 0; j < 8; ++j) { const int c = gcol0 + bj * 128 + wc * 32 + 8 * fq + j; gsc[bj][j] = norm2_g[c] * (1.f + MODb[4 * D + c]); shv[bj][j] = MODb[3 * D + c]; wrv[bj][j] = w_router[c * NE + fr]; }
#pragma unroll
        for (int ai = 0; ai < 2; ++ai)
#pragma unroll
            for (int m = 0; m < 4; ++m) { const int row = ai * 128 + wr * 64 + m * 16 + fr;
#pragma unroll
                for (int bj = 0; bj < 2; ++bj) { const int col = gcol0 + bj * 128 + wc * 32 + 8 * fq; const size_t o = (size_t)(grow0 + row) * D + col;
                    const f32x4 x0 = *(const f32x4*)(x + o), x1v = *(const f32x4*)(x + o + 4), g0 = *(const f32x4*)(MODb + 2 * D + col), g1 = *(const f32x4*)(MODb + 2 * D + col + 4);
                    acc[ai][bj][m][0] = x0 + g0 * acc[ai][bj][m][0]; acc[ai][bj][m][1] = x1v + g1 * acc[ai][bj][m][1];
                    { v4u w; w.x = pk2(acc[ai][bj][m][0].x, acc[ai][bj][m][0].y); w.y = pk2(acc[ai][bj][m][0].z, acc[ai][bj][m][0].w); w.z = pk2(acc[ai][bj][m][1].x, acc[ai][bj][m][1].y); w.w = pk2(acc[ai][bj][m][1].z, acc[ai][bj][m][1].w);
                      *(v4u*)((bf16*)X1 + o) = w; } } }
        float tw[2][2][4];
#pragma unroll
        for (int bj = 0; bj < 2; ++bj)
#pragma unroll
            for (int n = 0; n < 2; ++n)
#pragma unroll
                for (int r = 0; r < 4; ++r) tw[bj][n][r] = wrv[bj][4 * n + r] * gsc[bj][4 * n + r];
#pragma unroll
        for (int ai = 0; ai < 2; ++ai)
#pragma unroll
            for (int m = 0; m < 4; ++m) { const int row = ai * 128 + wr * 64 + m * 16 + fr;
                f32x4 q = (f32x4){0.f, 0.f, 0.f, 0.f}; float s2 = 0.f;
#pragma unroll
                for (int bj = 0; bj < 2; ++bj)
#pragma unroll
                    for (int n = 0; n < 2; ++n)
#pragma unroll
                        for (int r = 0; r < 4; ++r) { const float v = acc[ai][bj][m][n][r]; q = __builtin_amdgcn_mfma_f32_16x16x4f32(tw[bj][n][r], v, q, 0, 0, 0); s2 += v * v; }
                s2 += __shfl_xor(s2, 16); s2 += __shfl_xor(s2, 32);
                LAS float* o = LQ + (row * 4 + wc) * 20;
                o[4 * fq + 0] = q[0]; o[4 * fq + 1] = q[1]; o[4 * fq + 2] = q[2]; o[4 * fq + 3] = q[3]; if (fq == 0) o[16] = s2; }
        __syncthreads();
        float* xo = XCH + (size_t)((u.pm * 4 + u.pn) * 256) * 20;
        for (int i = tid; i < 256 * 9; i += NTHREADS) { const int row = i / 9, q2 = 2 * (i - row * 9); const LAS float* s = LQ + row * 80 + q2;
            const float v0 = (s[0] + s[20]) + (s[40] + s[60]), v1 = q2 < 16 ? (s[1] + s[21]) + (s[41] + s[61]) : 0.f;
            __hip_atomic_store((unsigned long long*)(xo + row * 20 + q2), ((unsigned long long)__float_as_uint(v1) << 32) | __float_as_uint(v0), __ATOMIC_RELAXED, __HIP_MEMORY_SCOPE_AGENT); }
        asm volatile("s_waitcnt vmcnt(0)" ::: "memory");
        __syncthreads();
        if (tid == 0) {
            __hip_atomic_fetch_add(cnt + 16 * u.pm, 1u, __ATOMIC_RELAXED, __HIP_MEMORY_SCOPE_AGENT);
            XB_SPIN(xb_ld(cnt + 16 * u.pm) < 4u, tmo);
        }
        __syncthreads();
        const float* xp = XCH + (size_t)(u.pm * 4 * 256) * 20;
#define XLD(ptr) __hip_atomic_load((ptr), __ATOMIC_RELAXED, __HIP_MEMORY_SCOPE_AGENT)
        if (tid < 256) { const int row = tid; const float S2 = (XLD(xp + row * 20 + 16) + XLD(xp + 5120 + row * 20 + 16)) + (XLD(xp + 10240 + row * 20 + 16) + XLD(xp + 15360 + row * 20 + 16)); RINV[row] = rsqrtf(S2 * (1.f / D) + EPS); }
        else if (tid < 320) { const int row = 64 * u.pn + (tid - 256); const float* r0 = xp + row * 20;
            const float S2 = (XLD(r0 + 16) + XLD(r0 + 5120 + 16)) + (XLD(r0 + 10240 + 16) + XLD(r0 + 15360 + 16)), rinv = rsqrtf(S2 * (1.f / D) + EPS);
            float lg[16]; float mx = -3.0e38f;
#pragma unroll
            for (int e = 0; e < 16; ++e) { lg[e] = rinv * ((XLD(r0 + e) + XLD(r0 + 5120 + e)) + (XLD(r0 + 10240 + e) + XLD(r0 + 15360 + e))) + CB[b * NE + e]; mx = fmaxf(mx, lg[e]); }
            float den = 0.f;
#pragma unroll
            for (int e = 0; e < 16; ++e) { lg[e] = expf(lg[e] - mx); den += lg[e]; }
            const float rd = 1.f / den; const int t = (u.pm & 7) * 256 + row;
#pragma unroll
            for (int e = 0; e < 16; ++e) AFF[(size_t)(b * NE + e) * SEQ + t] = lg[e] * rd; }
#undef XLD
        __syncthreads();
#pragma unroll
        for (int ai = 0; ai < 2; ++ai)
#pragma unroll
            for (int m = 0; m < 4; ++m) { const int row = ai * 128 + wr * 64 + m * 16 + fr; const float rinv = RINV[row];
#pragma unroll
                for (int bj = 0; bj < 2; ++bj) { const f32x4 a0 = acc[ai][bj][m][0], a1 = acc[ai][bj][m][1]; v2u w;
                    w.x = pk4_fp8(a0[0] * rinv * gsc[bj][0] + shv[bj][0], a0[1] * rinv * gsc[bj][1] + shv[bj][1], a0[2] * rinv * gsc[bj][2] + shv[bj][2], a0[3] * rinv * gsc[bj][3] + shv[bj][3]);
                    w.y = pk4_fp8(a1[0] * rinv * gsc[bj][4] + shv[bj][4], a1[1] * rinv * gsc[bj][5] + shv[bj][5], a1[2] * rinv * gsc[bj][6] + shv[bj][6], a1[3] * rinv * gsc[bj][7] + shv[bj][7]);
                    *(v2u*)(HX8 + (size_t)(grow0 + row) * D + gcol0 + bj * 128 + wc * 32 + 8 * fq) = w; } }
    }
    __device__ __forceinline__ void st8(const pg8::Unit&, int, int, f32x4, f32x4) const {}
};

template <class Epi, class Sched>
__device__ __forceinline__ void naive_gemm_phase(LAS unsigned char* lds, const pg8::Gemm g, const Sched& S, const Epi& E) {
    LAS float* As = (LAS float*)lds; LAS float* Bs = (LAS float*)(lds + 4352);
    const int tid = threadIdx.x, ty = tid >> 5, tx = tid & 31, K = g.K, lr = tid >> 1, lh = 8 * (tid & 1);
    pg8::Unit u;
    for (int i = 0; S.next(i, u); ++i)
        for (int sub = 0; sub < 4; ++sub) {
            f32x4 ag[4], au[4];
#pragma unroll
            for (int r = 0; r < 4; ++r) { ag[r] = (f32x4){0.f, 0.f, 0.f, 0.f}; au[r] = (f32x4){0.f, 0.f, 0.f, 0.f}; }
            const bf16* arow = g.A + ((size_t)u.pm * 256 + sub * 64 + (lr & 63)) * K + lh;
            const bf16* brow = g.Bt + ((size_t)u.pnB * 256 + lr) * K + lh;
            for (int k0 = 0; k0 < K; k0 += 16) {
                const v4u bv = *(const v4u*)(brow + k0); v4u av = (v4u){0u, 0u, 0u, 0u}; if (tid < 128) av = *(const v4u*)(arow + k0);
                __syncthreads();
                Bs[(lh + 0) * 260 + lr] = bflo(bv.x); Bs[(lh + 1) * 260 + lr] = bfhi(bv.x); Bs[(lh + 2) * 260 + lr] = bflo(bv.y); Bs[(lh + 3) * 260 + lr] = bfhi(bv.y);
                Bs[(lh + 4) * 260 + lr] = bflo(bv.z); Bs[(lh + 5) * 260 + lr] = bfhi(bv.z); Bs[(lh + 6) * 260 + lr] = bflo(bv.w); Bs[(lh + 7) * 260 + lr] = bfhi(bv.w);
                if (tid < 128) {
                    As[(lh + 0) * 68 + lr] = bflo(av.x); As[(lh + 1) * 68 + lr] = bfhi(av.x); As[(lh + 2) * 68 + lr] = bflo(av.y); As[(lh + 3) * 68 + lr] = bfhi(av.y);
                    As[(lh + 4) * 68 + lr] = bflo(av.z); As[(lh + 5) * 68 + lr] = bfhi(av.z); As[(lh + 6) * 68 + lr] = bflo(av.w); As[(lh + 7) * 68 + lr] = bfhi(av.w); }
                __syncthreads();
#pragma unroll
                for (int kk = 0; kk < 16; ++kk) {
                    const f32x4 a = *(const LAS f32x4*)(As + kk * 68 + 4 * ty), b0 = *(const LAS f32x4*)(Bs + kk * 260 + 4 * tx), b1 = *(const LAS f32x4*)(Bs + kk * 260 + 128 + 4 * tx);
#pragma unroll
                    for (int r = 0; r < 4; ++r) { ag[r] += a[r] * b0; au[r] += a[r] * b1; }
                }
            }
#pragma unroll
            for (int r = 0; r < 4; ++r) { const int row = sub * 64 + 4 * ty + r;
                if constexpr (Epi::PAIRED) E.st2(u, row, 4 * tx, ag[r], au[r]);
                else { E.st(u, row, 4 * tx, ag[r]); E.st(u, row, 128 + 4 * tx, au[r]); } }
        }
    __syncthreads();
}
template <class Epi, class Sched>
__device__ __forceinline__ void gemm_any(LAS unsigned char* lds, const pg8::Gemm g, const Sched& S, const Epi& E) {
#if USE_PG8
    pg8::gemm_phase<Epi, Sched, true, true>(lds, g, S, E);
#else
    naive_gemm_phase<Epi, Sched>(lds, g, S, E);
#endif
}

__device__ __forceinline__ void transpose_item(const float* W, int N, int K, bf16* WT, int k0, int n0, size_t drow0, LAS unsigned char* scr, int lane) {
    const int lc = lane & 15, lr = lane >> 4;
    f32x4 v[16];
#pragma unroll
    for (int i = 0; i < 16; ++i) v[i] = __builtin_nontemporal_load((const f32x4*)(W + (size_t)(k0 + 4 * i + lr) * N + n0 + 4 * lc));
#pragma unroll
    for (int i = 0; i < 16; ++i) { const int k = 4 * i + lr;
#pragma unroll
        for (int j = 0; j < 4; ++j) *(LAS bf16*)(scr + (4 * lc + j) * 136 + k * 2) = (bf16)f2bf(v[i][j]); }
    LDS_WAIT(); asm volatile("" ::: "memory");
    const int c = lane & 7;
#pragma unroll
    for (int j = 0; j < 8; ++j) { const int n = (lane >> 3) + 8 * j;
        const v2u lo = *(const LAS v2u*)(scr + n * 136 + c * 16), hi = *(const LAS v2u*)(scr + n * 136 + c * 16 + 8);
        *(v4u*)(WT + (drow0 + n) * (size_t)K + k0 + 8 * c) = (v4u){lo.x, lo.y, hi.x, hi.y}; }
    LDS_WAIT(); asm volatile("" ::: "memory");
}
__device__ __forceinline__ void conv_load(const float* src, int N, int lane, f32x4 (&v)[16]);
struct P;
__device__ __forceinline__ void conv_desc(const P& p, int it, const float*& src, unsigned char*& dst, int& N, int& K);
__device__ __forceinline__ void conv_store(const f32x4 (&v)[16], unsigned char* dst, int K, LAS unsigned char* scr, int lane);
__device__ __forceinline__ void transpose_item_f8(const float* W, int N, int K, unsigned char* WT, int k0, int n0, size_t drow0, LAS unsigned char* scr, int lane) {
    f32x4 v[16]; conv_load(W + (size_t)k0 * N + n0, N, lane, v); conv_store(v, WT + drow0 * (size_t)K + k0, K, scr, lane);
}
constexpr int CONV_ITEMS = 16 * 32 + 16 * 16 + 3 * 512 * NE, CONV_CUT = CONV_ITEMS - 6144;
__device__ __forceinline__ void convert_items(const P& p, LAS unsigned char* lds, int lane, int wave, int first, int last, int gw, int NGW) {
    LAS unsigned char* scr = lds + wave * 16384;
    constexpr int I_IN = 16 * 32, I_OUT = 16 * 16, I_E = 512 * NE;
    for (int it = first + gw; it < last; it += NGW) {
        int r = it;
        if (r < I_IN) { const int kb = r >> 5, nb = r & 31; transpose_item(p.w_in, DIN, D, (bf16*)(p.ws + WS_WIN), 64 * kb, 64 * nb, (size_t)(64 * nb), scr, lane); continue; } r -= I_IN;
        if (r < I_OUT) { const int kb = r >> 4, nb = r & 15; transpose_item(p.w_out, D, D, (bf16*)(p.ws + WS_WOUT), 64 * kb, 64 * nb, (size_t)(64 * nb), scr, lane); continue; } r -= I_OUT;
#if MOE_FP8
        { const float* src_; unsigned char* dst_; int N_, K_; f32x4 v_[16]; conv_desc(p, it, src_, dst_, N_, K_); conv_load(src_, N_, lane, v_); conv_store(v_, dst_, K_, scr, lane); }
#else
        if (r < 2 * I_E) { const int which = r >= I_E; if (which) r -= I_E; const int e = r >> 9, q = r & 511, kb = q >> 5, nb = q & 31, n0 = 64 * nb;
            const float* W = (which ? p.w3 : p.w1) + (size_t)e * D * DE;
#if MOE_FP8
            transpose_item_f8(W, DE, D, p.ws + WS_WG, 64 * kb, n0, (size_t)e * 4096 + (size_t)(n0 >> 7) * 256 + (n0 & 127) + (which ? 128 : 0), scr, lane); continue; } r -= 2 * I_E;
#else
            transpose_item(W, DE, D, (bf16*)(p.ws + WS_WG), 64 * kb, n0, (size_t)e * 4096 + (size_t)(n0 >> 7) * 256 + (n0 & 127) + (which ? 128 : 0), scr, lane); continue; } r -= 2 * I_E;
#endif
        { const int e = r >> 9, q = r & 511, kb = q >> 4, nb = q & 15, n0 = 64 * nb;
#if MOE_FP8
            transpose_item_f8(p.w2 + (size_t)e * DE * D, D, DE, p.ws + WS_W2, 64 * kb, n0, (size_t)e * 1024 + n0, scr, lane); }
#else
            transpose_item(p.w2 + (size_t)e * DE * D, D, DE, (bf16*)(p.ws + WS_W2), 64 * kb, n0, (size_t)e * 1024 + n0, scr, lane); }
#endif
#endif
    }
}

#if MOE_FP8
constexpr int CONV_HEAD = 16 * 32 + 16 * 16;
__device__ __forceinline__ void conv_desc(const P& p, int it, const float*& src, unsigned char*& dst, int& N, int& K) {
    constexpr int I_E = 512 * NE; const int r0 = it - CONV_HEAD;
    const bool isw2 = r0 >= 2 * I_E, which = (!isw2) && r0 >= I_E; const int r = isw2 ? r0 - 2 * I_E : (which ? r0 - I_E : r0);
    const int e = r >> 9, q = r & 511, kb = isw2 ? (q >> 5) : (q >> 6), nb = isw2 ? (q & 31) : (q & 63), n0 = 32 * nb;
    N = isw2 ? D : DE; K = isw2 ? DE : D;
    const float* base = isw2 ? p.w2 : (which ? p.w3 : p.w1);
    src = base + (size_t)e * D * DE + (size_t)(128 * kb) * N + n0;
    const size_t drow = isw2 ? ((size_t)e * 1024 + n0) : ((size_t)e * 4096 + (size_t)(n0 >> 7) * 256 + (n0 & 127) + (which ? 128 : 0));
    dst = p.ws + (isw2 ? WS_W2 : WS_WG) + drow * (size_t)K + 128 * kb;
}
__device__ __forceinline__ void conv_load(const float* src, int N, int lane, f32x4 (&v)[16]) {
    const int lc = lane & 7, lr = lane >> 3;
#pragma unroll
    for (int i = 0; i < 16; ++i) v[i] = __builtin_nontemporal_load((const f32x4*)(src + (size_t)(16 * lr + i) * N + 4 * lc));
}
__device__ __forceinline__ void conv_store(const f32x4 (&v)[16], unsigned char* dst, int K, LAS unsigned char* scr, int lane) {
    const int lc = lane & 7, lr = lane >> 3; (void)scr;
#pragma unroll
    for (int j = 0; j < 4; ++j) { v4u o;
        o.x = pk4_fp8(v[0][j] * WSCALE, v[1][j] * WSCALE, v[2][j] * WSCALE, v[3][j] * WSCALE);
        o.y = pk4_fp8(v[4][j] * WSCALE, v[5][j] * WSCALE, v[6][j] * WSCALE, v[7][j] * WSCALE);
        o.z = pk4_fp8(v[8][j] * WSCALE, v[9][j] * WSCALE, v[10][j] * WSCALE, v[11][j] * WSCALE);
        o.w = pk4_fp8(v[12][j] * WSCALE, v[13][j] * WSCALE, v[14][j] * WSCALE, v[15][j] * WSCALE);
        __builtin_nontemporal_store(o, (v4u*)(dst + (size_t)(4 * lc + j) * K + 16 * lr)); }
}
__device__ __forceinline__ void convert_pipelined(const P& p, LAS unsigned char* lds, int lane, int wave, int first, int last, int gw, int NGW) {
    LAS unsigned char* scr = lds + wave * 16384;
    f32x4 va[16], vb[16], vc[16]; const float* s0; unsigned char* da; unsigned char* db; unsigned char* dc; int N0, Ka, Kb, Kc;
    int it = first + gw; if (it >= last) return;
    const int itl = it + ((last - 1 - it) / NGW) * NGW;
    conv_desc(p, it, s0, da, N0, Ka); conv_load(s0, N0, lane, va);
    { const int i1 = min(it + NGW, itl); conv_desc(p, i1, s0, db, N0, Kb); conv_load(s0, N0, lane, vb); }
    for (; it <= itl; it += 3 * NGW) {
        { const int i2 = min(it + 2 * NGW, itl); conv_desc(p, i2, s0, dc, N0, Kc); conv_load(s0, N0, lane, vc); }
        conv_store(va, da, Ka, scr, lane);
        { const int i3 = min(it + 3 * NGW, itl); conv_desc(p, i3, s0, da, N0, Ka); conv_load(s0, N0, lane, va); }
        conv_store(vb, db, Kb, scr, lane);
        { const int i4 = min(it + 4 * NGW, itl); conv_desc(p, i4, s0, db, N0, Kb); conv_load(s0, N0, lane, vb); }
        conv_store(vc, dc, Kc, scr, lane);
    }
}
#endif
__device__ __forceinline__ void p0_small_copies(const P& p, int tid, int vcu, int G) {
    bf16* GWT = (bf16*)(p.ws + WS_GWT); bf16* SWB = (bf16*)(p.ws + WS_SWB); const int gt = vcu * NTHREADS + tid, NT = G * NTHREADS;
    for (int o = gt; o < 131072; o += NT) { const int i = o & 63, j = (o >> 6) & 63, h = (o >> 12) & 7, g = (o >> 15) & 1, d = o >> 16;
        GWT[o] = (bf16)f2bf((g ? p.rg_wi : p.rg_wa)[(size_t)((d * 8 + h) * 64 + i) * 64 + j]); }
    for (int o = gt; o < 65536; o += NT) SWB[o] = (bf16)f2bf(p.sgu_w[o]);
}
__device__ __forceinline__ void phase_p0(const P& p, LAS unsigned char* lds, int tid, int lane, int wave, int vcu, int G, int conv_last, bool small = true) {
    float* MOD = (float*)(p.ws + WS_MOD);
    {
        LAS float* sc = (LAS float*)lds; LAS float* part = (LAS float*)(lds + 36864);
        if (vcu < 192) {
            float cv[18];
#pragma unroll
            for (int i = 0; i < 18; ++i) { const int e = tid + i * NTHREADS, j = e >> 10, k = e & 1023; cv[i] = j < 8 ? p.c[j * D + k] : p.c_ctx[k]; }
#pragma unroll
            for (int i = 0; i < 18; ++i) sc[tid + i * NTHREADS] = siluf_(cv[i]);
        }
        __syncthreads();
        for (int t = vcu; t < 192; t += G) {
            const int col = lane & 31, kh = lane >> 5, n = t * 32 + col, kbase = wave * 128 + kh * 64; float acc[9];
#pragma unroll
            for (int j = 0; j < 9; ++j) acc[j] = 0.f;
            for (int k0 = 0; k0 < 64; k0 += 16) { float w[16];
#pragma unroll
                for (int i = 0; i < 16; ++i) w[i] = __builtin_nontemporal_load(p.w_mod + (size_t)(kbase + k0 + i) * NMOD + n);
#pragma unroll
                for (int i = 0; i < 16; ++i)
#pragma unroll
                    for (int j = 0; j < 9; ++j) acc[j] += sc[j * D + kbase + k0 + i] * w[i]; }
#pragma unroll
            for (int j = 0; j < 9; ++j) { acc[j] += __shfl_xor(acc[j], 32); if (lane < 32) part[(wave * 9 + j) * 32 + lane] = acc[j]; }
            __syncthreads();
            for (int i = tid; i < 9 * 32; i += NTHREADS) { const int j = i >> 5, l = i & 31; float s2 = p.b_mod[t * 32 + l];
#pragma unroll
                for (int w = 0; w < 8; ++w) s2 += part[(w * 9 + j) * 32 + l];
                MOD[j * NMOD + t * 32 + l] = s2; }
            __syncthreads();
        }
    }
    convert_items(p, lds, lane, wave, 0, conv_last, vcu * NWAVES + wave, G * NWAVES);
    if (small) p0_small_copies(p, tid, vcu, G);
}

__device__ __forceinline__ void phase_p1(const P& p, int lane, int wave, int vcu, int G) {
    const float* MOD = (const float*)(p.ws + WS_MOD); bf16* HX = (bf16*)(p.ws + WS_HX);
    const int gw = vcu * NWAVES + wave, NGW = G * NWAVES;
    for (int i = gw; i < BATCH * NE; i += NGW) { const int b = i >> 4, e = i & 15; float a = 0.f;
        for (int k = lane; k < D; k += 64) a += MOD[b * NMOD + 3 * D + k] * p.w_router[k * NE + e];
        a = wave_sum(a); if (lane == 0) ((float*)(p.ws + WS_CB))[i] = a; }
    f32x4 nx[4];
    { const int m = gw; if (m < MT) { const f32x4* xr = (const f32x4*)(m < M ? p.x + (size_t)m * D : p.ctx + (size_t)(m - M) * D) + lane;
#pragma unroll
        for (int jj = 0; jj < 4; ++jj) nx[jj] = __builtin_nontemporal_load(xr + 64 * jj); } }
    for (int m = gw; m < MT; m += NGW) {
        const int j = m < M ? (m >> 11) : 8;
        f32x4 v[4]; float s = 0.f;
#pragma unroll
        for (int jj = 0; jj < 4; ++jj) { v[jj] = nx[jj]; s += (v[jj].x * v[jj].x + v[jj].y * v[jj].y) + (v[jj].z * v[jj].z + v[jj].w * v[jj].w); }
        { const int m2 = m + NGW; if (m2 < MT) { const f32x4* xr = (const f32x4*)(m2 < M ? p.x + (size_t)m2 * D : p.ctx + (size_t)(m2 - M) * D) + lane;
#pragma unroll
            for (int jj = 0; jj < 4; ++jj) nx[jj] = __builtin_nontemporal_load(xr + 64 * jj); } }
        const float rinv = rsqrtf(wave_sum(s) * (1.f / D) + EPS);
        v2u* o = (v2u*)(HX + (size_t)m * D) + lane;
#pragma unroll
        for (int jj = 0; jj < 4; ++jj) { const int k = 4 * (lane + 64 * jj);
            const f32x4 g = *(const f32x4*)(p.norm1_g + k), sh = *(const f32x4*)(MOD + j * NMOD + k), sc = *(const f32x4*)(MOD + j * NMOD + D + k);
            const f32x4 h = v[jj] * rinv * g * (sc + 1.f) + sh; v2u w; w.x = pk2(h.x, h.y); w.y = pk2(h.z, h.w); o[64 * jj] = w; }
    }
}

__device__ __forceinline__ void phase_lru1(const P& p, LAS unsigned char* lds, int tid, int vcu, int G) {
    LAS float* xt = (LAS float*)lds;
    LAS float* cx = (LAS float*)(lds + 17152);
    LAS float* af = (LAS float*)(lds + 33536);
    LAS float* df = (LAS float*)(lds + 49920);
    LAS float* ab = (LAS float*)(lds + 66304);
    LAS float* db = (LAS float*)(lds + 82688);
    const bf16* UV = (const bf16*)(p.ws + WS_UV); const bf16* XC = (const bf16*)(p.ws + WS_XC);
    bf16* HS = (bf16*)(p.ws + WS_HS); bf16* PF = (bf16*)(p.ws + WS_PF); bf16* PB = (bf16*)(p.ws + WS_PB); float* SUM = (float*)(p.ws + WS_SUM);
    for (int T = vcu; T < BATCH * NSEG * 8; T += G) {
        const int b = T / (NSEG * 8), rem = T % (NSEG * 8), seg = rem >> 3, h = rem & 7;
        for (int i = tid; i < 67 * 64; i += NTHREADS) { const int r = (i >> 6) - 1, ch = i & 63; float v = 0.f;
            if (seg < 4) { const int pos = seg * 64 + r; if (pos >= 0 && pos < CTXL) v = bf2f(XC[(size_t)(b * CTXL + pos) * DLRU + h * 64 + ch]); }
            else { if (r >= 0 && r < 64) v = bf2f(UV[(size_t)(b * SEQ + (seg - 4) * 64 + r) * DIN + 1024 + h * 64 + ch]); }
            xt[i] = v; }
        __syncthreads();
        for (int i = tid; i < 4096; i += NTHREADS) { const int r = i >> 6, ch = i & 63, cch = h * 64 + ch; float v = p.conv_b[cch];
#pragma unroll
            for (int j = 0; j < 4; ++j) v += p.conv_w[j * DLRU + cch] * xt[(r + j) * 64 + ch];
            cx[i] = v; }
        __syncthreads();
        { const int jj = tid & 63, r0 = tid >> 6, cch = h * 64 + jj;
#pragma unroll
          for (int d = 0; d < 2; ++d) {
            float aa[8], ai[8];
#pragma unroll
            for (int q = 0; q < 8; ++q) { aa[q] = 0.f; ai[q] = 0.f; }
            const float* wa = p.rg_wa + (size_t)((d * 8 + h) * 64) * 64 + jj; const float* wi = p.rg_wi + (size_t)((d * 8 + h) * 64) * 64 + jj;
#pragma unroll 2
            for (int i = 0; i < 64; ++i) { const float wav = wa[i * 64], wiv = wi[i * 64];
#pragma unroll
                for (int q = 0; q < 8; ++q) { const float cv = cx[(r0 + 8 * q) * 64 + i]; aa[q] += cv * wav; ai[q] += cv * wiv; } }
            const float ba = p.rg_ba[d * DLRU + cch], bi = p.rg_bi[d * DLRU + cch], c8 = -8.f * log1pf(expf(-p.rg_lam[d * DLRU + cch]));
            LAS float* ao = d ? ab : af; LAS float* dout = d ? db : df;
#pragma unroll
            for (int q = 0; q < 8; ++q) { const int r = r0 + 8 * q; const float rg = sigmoidf_(aa[q] + ba), ig = sigmoidf_(ai[q] + bi), la = c8 * rg;
                ao[r * 64 + jj] = expf(la); dout[r * 64 + jj] = sqrtf(-expm1f(2.f * la)) * ig * cx[r * 64 + jj]; }
          } }
        __syncthreads();
        if (tid < 128) { const int d = tid >> 6, ch = tid & 63; float hh = 0.f, pp = 1.f;
            if (d == 0) {
#pragma unroll 4
                for (int r = 0; r < 64; ++r) { const float a = af[r * 64 + ch]; hh = a * hh + df[r * 64 + ch]; pp *= a; df[r * 64 + ch] = hh; af[r * 64 + ch] = pp; } }
            else {
#pragma unroll 4
                for (int r = 63; r >= 0; --r) { const float a = ab[r * 64 + ch]; hh = a * hh + db[r * 64 + ch]; pp *= a; db[r * 64 + ch] = hh; ab[r * 64 + ch] = pp; } }
            float* s = SUM + ((size_t)((b * NSEG + seg) * 2 + d) * DLRU + h * 64 + ch) * 2; s[0] = pp; s[1] = hh; }
        __syncthreads();
        if (seg >= 4) for (int i = tid; i < 4096; i += NTHREADS) { const int r = i >> 6, ch = i & 63; const size_t o = (size_t)(b * SEQ + (seg - 4) * 64 + r) * DLRU + h * 64 + ch;
            HS[o] = (bf16)f2bf(df[i] + db[i]); PF[o] = (bf16)f2bf(af[i]); PB[o] = (bf16)f2bf(ab[i]); }
        __syncthreads();
    }
}

__device__ __forceinline__ void phase_sgu(const P& p, LAS unsigned char* lds, int tid, int vcu, int G) {
    LAS float* vn = (LAS float*)lds;
    LAS float* wsl = (LAS float*)(lds + 65536);
    const bf16* UV = (const bf16*)(p.ws + WS_UV); bf16* A2 = (bf16*)(p.ws + WS_A2);
    for (int T = vcu; T < 512; T += G) {
        const int b = T >> 6, n = (T >> 2) & 15, h = T & 3; const size_t t0 = (size_t)b * SEQ + n * 128;
        for (int i = tid; i < 16384; i += NTHREADS) { const int q = i >> 7, c = i & 127; vn[i] = bf2f(UV[(t0 + q) * DIN + 512 + h * 128 + c]); wsl[i] = p.sgu_w[h * 16384 + i]; }
        __syncthreads();
        { const int q = tid >> 2, part = tid & 3; float s = 0.f;
          for (int c = part * 32; c < part * 32 + 32; ++c) { const float v = vn[q * 128 + c]; s += v * v; }
          s += __shfl_xor(s, 1); s += __shfl_xor(s, 2);
          const float rinv = rsqrtf(s * (1.f / 128.f) + EPS);
          for (int c = part * 32; c < part * 32 + 32; ++c) vn[q * 128 + c] *= rinv * p.sgu_g[h * 128 + c]; }
        __syncthreads();
        { const int c = tid & 127, p0 = tid >> 7; float acc[32];
#pragma unroll
          for (int i = 0; i < 32; ++i) acc[i] = 0.f;
          for (int q = 0; q < 128; ++q) { const float vq = vn[q * 128 + c];
#pragma unroll
              for (int i = 0; i < 32; ++i) acc[i] += wsl[(p0 + 4 * i) * 128 + q] * vq; }
#pragma unroll
          for (int i = 0; i < 32; ++i) { const int pp = p0 + 4 * i; const float s = acc[i] + p.sgu_b[h * 128 + pp];
              const float uu = bf2f(UV[(t0 + pp) * DIN + h * 128 + c]); A2[(t0 + pp) * D + h * 128 + c] = (bf16)f2bf(uu * s); } }
        __syncthreads();
    }
}


__device__ __forceinline__ void phase_lru1_mfma(const P& p, LAS unsigned char* lds, int tid, int lane, int wave, int vcu, int G) {
    LAS float* xt = (LAS float*)lds;
    LAS float* cxf = (LAS float*)(lds + 17152);
    LAS unsigned char* cxb = lds + 33536;
    LAS float* AD = (LAS float*)(lds + 42752);
    LAS float* SS = (LAS float*)(lds + 108288);
    const bf16* UV = (const bf16*)(p.ws + WS_UV); const bf16* XC = (const bf16*)(p.ws + WS_XC); const bf16* GWT = (const bf16*)(p.ws + WS_GWT);
    bf16* HS = (bf16*)(p.ws + WS_HS); bf16* PF = (bf16*)(p.ws + WS_PF); bf16* PB = (bf16*)(p.ws + WS_PB); float* SUM = (float*)(p.ws + WS_SUM);
    const int fr = lane & 15, fq = lane >> 4;
    const int wd = wave >> 2, jt = wave & 3, wj = 16 * jt + fr, cch_c = tid & 63;
    int hcur = -1; bf16x8 bfr[2][2]; float ba = 0.f, bi = 0.f, c8 = 0.f, cw0 = 0.f, cw1 = 0.f, cw2 = 0.f, cw3 = 0.f, cbias = 0.f;
    auto load_piece = [&](int T, int i) -> v4u { const int b = T / (NSEG * 8), rem = T % (NSEG * 8), seg = rem >> 3, h = rem & 7, r = (i >> 3) - 1, c0 = (i & 7) * 8; v4u w = (v4u){0u, 0u, 0u, 0u};
        if (seg < 4) { const int pos = seg * 64 + r; if (pos >= 0 && pos < CTXL) w = *(const v4u*)(XC + (size_t)(b * CTXL + pos) * DLRU + h * 64 + c0); }
        else { if (r >= 0 && r < 64) w = *(const v4u*)(UV + (size_t)(b * SEQ + (seg - 4) * 64 + r) * DIN + 1024 + h * 64 + c0); }
        return w; };
    v4u pre0 = (v4u){0u, 0u, 0u, 0u}, pre1 = (v4u){0u, 0u, 0u, 0u};
    if (vcu < BATCH * NSEG * 8) { pre0 = load_piece(vcu, tid); if (tid < 24) pre1 = load_piece(vcu, tid + 512); }
    for (int T = vcu; T < BATCH * NSEG * 8; T += G) {
        const int b = T / (NSEG * 8), rem = T % (NSEG * 8), seg = rem >> 3, h = rem & 7;
        { LAS float* o = xt + (tid >> 3) * 64 + (tid & 7) * 8;
          *(LAS f32x4*)o = (f32x4){bflo(pre0.x), bfhi(pre0.x), bflo(pre0.y), bfhi(pre0.y)}; *(LAS f32x4*)(o + 4) = (f32x4){bflo(pre0.z), bfhi(pre0.z), bflo(pre0.w), bfhi(pre0.w)};
          if (tid < 24) { LAS float* o1 = xt + ((tid + 512) >> 3) * 64 + (tid & 7) * 8;
              *(LAS f32x4*)o1 = (f32x4){bflo(pre1.x), bfhi(pre1.x), bflo(pre1.y), bfhi(pre1.y)}; *(LAS f32x4*)(o1 + 4) = (f32x4){bflo(pre1.z), bfhi(pre1.z), bflo(pre1.w), bfhi(pre1.w)}; } }
        if (h != hcur) { hcur = h;
#pragma unroll
            for (int g = 0; g < 2; ++g)
#pragma unroll
                for (int ks = 0; ks < 2; ++ks) bfr[g][ks] = *(const bf16x8*)(GWT + (size_t)((((wd * 2 + g) * 8 + h) * 64 + wj) * 64 + 32 * ks + 8 * fq));
            ba = p.rg_ba[wd * DLRU + h * 64 + wj]; bi = p.rg_bi[wd * DLRU + h * 64 + wj]; c8 = -8.f * log1pf(expf(-p.rg_lam[wd * DLRU + h * 64 + wj]));
            cw0 = p.conv_w[h * 64 + cch_c]; cw1 = p.conv_w[DLRU + h * 64 + cch_c]; cw2 = p.conv_w[2 * DLRU + h * 64 + cch_c]; cw3 = p.conv_w[3 * DLRU + h * 64 + cch_c]; cbias = p.conv_b[h * 64 + cch_c]; }
        __syncthreads();
        if (T + G < BATCH * NSEG * 8) { pre0 = load_piece(T + G, tid); if (tid < 24) pre1 = load_piece(T + G, tid + 512); }
        for (int i = tid; i < 4096; i += NTHREADS) { const int r = i >> 6, ch = i & 63;
            const float v = cbias + cw0 * xt[r * 64 + ch] + cw1 * xt[(r + 1) * 64 + ch] + cw2 * xt[(r + 2) * 64 + ch] + cw3 * xt[(r + 3) * 64 + ch];
            cxf[i] = v; *(LAS bf16*)(cxb + r * 144 + ch * 2) = (bf16)f2bf(v); }
        __syncthreads();
        { const int d = wd, j = wj;
          LAS float* Ad = AD + d * 8192; LAS float* Dd = Ad + 4096;
#pragma unroll
          for (int pt = 0; pt < 4; ++pt) {
              const bf16x8 a0 = *(const LAS bf16x8*)(cxb + (16 * pt + fr) * 144 + 16 * fq), a1 = *(const LAS bf16x8*)(cxb + (16 * pt + fr) * 144 + 64 + 16 * fq);
              f32x4 ca = (f32x4){0.f, 0.f, 0.f, 0.f}, ci = (f32x4){0.f, 0.f, 0.f, 0.f};
              ca = __builtin_amdgcn_mfma_f32_16x16x32_bf16(a0, bfr[0][0], ca, 0, 0, 0); ca = __builtin_amdgcn_mfma_f32_16x16x32_bf16(a1, bfr[0][1], ca, 0, 0, 0);
              ci = __builtin_amdgcn_mfma_f32_16x16x32_bf16(a0, bfr[1][0], ci, 0, 0, 0); ci = __builtin_amdgcn_mfma_f32_16x16x32_bf16(a1, bfr[1][1], ci, 0, 0, 0);
#pragma unroll
              for (int r = 0; r < 4; ++r) { const int pos = 16 * pt + 4 * fq + r; const float rg = sigmoidf_(ca[r] + ba), ig = sigmoidf_(ci[r] + bi), la = c8 * rg;
                  float av, sv; decay_pair(la, av, sv); Ad[pos * 64 + j] = av; Dd[pos * 64 + j] = sv * ig * cxf[pos * 64 + j]; }
          } }
        __syncthreads();
        { const int sub = tid >> 7, d = (tid >> 6) & 1, ch = tid & 63;
          LAS float* Ad = AD + d * 8192; LAS float* Dd = Ad + 4096;
          float hl[16], pc[16]; float hh = 0.f, pp = 1.f;
#pragma unroll
          for (int t = 0; t < 16; ++t) { const int pos = d ? 16 * sub + 15 - t : 16 * sub + t; const float a = Ad[pos * 64 + ch]; hh = a * hh + Dd[pos * 64 + ch]; pp *= a; hl[t] = hh; pc[t] = pp; }
          SS[((sub * 2 + d) * 64 + ch) * 2] = pp; SS[((sub * 2 + d) * 64 + ch) * 2 + 1] = hh;
          __syncthreads();
          float cin = 0.f, cp = 1.f;
          if (d == 0) { for (int s2 = 0; s2 < sub; ++s2) { const float A = SS[((s2 * 2) * 64 + ch) * 2], B = SS[((s2 * 2) * 64 + ch) * 2 + 1]; cin = A * cin + B; cp *= A; } }
          else { for (int s2 = 3; s2 > sub; --s2) { const float A = SS[((s2 * 2 + 1) * 64 + ch) * 2], B = SS[((s2 * 2 + 1) * 64 + ch) * 2 + 1]; cin = A * cin + B; cp *= A; } }
#pragma unroll
          for (int t = 0; t < 16; ++t) { const int pos = d ? 16 * sub + 15 - t : 16 * sub + t; Dd[pos * 64 + ch] = hl[t] + pc[t] * cin; Ad[pos * 64 + ch] = pc[t] * cp; }
          if ((d == 0 && sub == 3) || (d == 1 && sub == 0)) { float* so = SUM + ((size_t)((b * NSEG + seg) * 2 + d) * DLRU + h * 64 + ch) * 2; so[0] = pc[15] * cp; so[1] = hl[15] + pc[15] * cin; }
        }
        __syncthreads();
        if (seg >= 4) { const int pos = tid >> 3, c0 = (tid & 7) * 8; const LAS float* q0 = AD + pos * 64 + c0;
            const f32x4 a0l = *(const LAS f32x4*)(q0), a0h = *(const LAS f32x4*)(q0 + 4), d0l = *(const LAS f32x4*)(q0 + 4096), d0h = *(const LAS f32x4*)(q0 + 4100);
            const f32x4 a1l = *(const LAS f32x4*)(q0 + 8192), a1h = *(const LAS f32x4*)(q0 + 8196), d1l = *(const LAS f32x4*)(q0 + 12288), d1h = *(const LAS f32x4*)(q0 + 12292);
            const f32x4 sl = d0l + d1l, sh = d0h + d1h; const size_t o = (size_t)(b * SEQ + (seg - 4) * 64 + pos) * DLRU + h * 64 + c0;
            *(v4u*)(HS + o) = (v4u){pk2(sl.x, sl.y), pk2(sl.z, sl.w), pk2(sh.x, sh.y), pk2(sh.z, sh.w)};
            *(v4u*)(PF + o) = (v4u){pk2(a0l.x, a0l.y), pk2(a0l.z, a0l.w), pk2(a0h.x, a0h.y), pk2(a0h.z, a0h.w)};
            *(v4u*)(PB + o) = (v4u){pk2(a1l.x, a1l.y), pk2(a1l.z, a1l.w), pk2(a1h.x, a1h.y), pk2(a1h.z, a1h.w)}; }
        __syncthreads();
    }
}


template <int WD>
__device__ __forceinline__ void lru_scan(const float (&ga)[4][4], const float (&gb)[4][4], LAS float* EX, int lane, int fr, int fq, int wj, float& Pin, float& Hin) {
    const int cq = WD ? 3 - fq : fq, l16 = (WD ? lane + 16 : lane - 16) & 63, l32 = (WD ? lane + 32 : lane - 32) & 63, llast = WD ? fr : fr + 48;
    LAS float* Pd = EX + WD * 8192; LAS float* Hd = Pd + 4096;
#pragma unroll
    for (int ptc = 0; ptc < 4; ++ptc) { constexpr int dummy = 0; (void)dummy; const int pt = WD ? 3 - ptc : ptc;
        float pr[4], hr[4]; float hh = 0.f, pp = 1.f;
#pragma unroll
        for (int rc = 0; rc < 4; ++rc) { const int r = WD ? 3 - rc : rc; hh = ga[pt][r] * hh + gb[pt][r]; pp *= ga[pt][r]; pr[r] = pp; hr[r] = hh; }
        float A = pp, B = hh;
        { const float tA = __shfl(A, l16), tB = __shfl(B, l16); if (cq >= 1) { B = A * tB + B; A = tA * A; } }
        { const float tA = __shfl(A, l32), tB = __shfl(B, l32); if (cq >= 2) { B = A * tB + B; A = tA * A; } }
        float eA = __shfl(A, l16), eB = __shfl(B, l16); if (cq == 0) { eA = 1.f; eB = 0.f; }
        const float tAt = __shfl(A, llast), tBt = __shfl(B, llast);
        const float Hc = eA * Hin + eB, Pc = Pin * eA;
#pragma unroll
        for (int r = 0; r < 4; ++r) { const int pos = 16 * pt + 4 * fq + r; Hd[pos * 64 + wj] = pr[r] * Hc + hr[r]; Pd[pos * 64 + wj] = Pc * pr[r]; }
        Hin = tAt * Hin + tBt; Pin *= tAt;
    }
}

__device__ __forceinline__ void phase_lru1_v2(const P& p, LAS unsigned char* lds, int tid, int lane, int wave, int vcu, int G) {
    LAS float* xt = (LAS float*)lds;
    LAS float* cxf = (LAS float*)(lds + 17152);
    LAS unsigned char* cxb = lds + 33536;
    LAS float* EX = (LAS float*)(lds + 42752);
    const bf16* UV = (const bf16*)(p.ws + WS_UV); const bf16* XC = (const bf16*)(p.ws + WS_XC); const bf16* GWT = (const bf16*)(p.ws + WS_GWT);
    bf16* HS = (bf16*)(p.ws + WS_HS); bf16* PF = (bf16*)(p.ws + WS_PF); bf16* PB = (bf16*)(p.ws + WS_PB); float* SUM = (float*)(p.ws + WS_SUM);
    const int fr = lane & 15, fq = lane >> 4;
    const int wd = wave >> 2, jt = wave & 3, wj = 16 * jt + fr, cch_c = tid & 63;
    int hcur = -1; bf16x8 bfr[2][2]; float ba = 0.f, bi = 0.f, c8 = 0.f, cw0 = 0.f, cw1 = 0.f, cw2 = 0.f, cw3 = 0.f, cbias = 0.f;
    auto load_piece = [&](int T, int i) -> v4u { const int b = T / (NSEG * 8), rem = T % (NSEG * 8), seg = rem >> 3, h = rem & 7, r = (i >> 3) - 1, c0 = (i & 7) * 8; v4u w = (v4u){0u, 0u, 0u, 0u};
        if (seg < 4) { const int pos = seg * 64 + r; if (pos >= 0 && pos < CTXL) w = *(const v4u*)(XC + (size_t)(b * CTXL + pos) * DLRU + h * 64 + c0); }
        else { if (r >= 0 && r < 64) w = *(const v4u*)(UV + (size_t)(b * SEQ + (seg - 4) * 64 + r) * DIN + 1024 + h * 64 + c0); }
        return w; };
    v4u pre0 = (v4u){0u, 0u, 0u, 0u}, pre1 = (v4u){0u, 0u, 0u, 0u};
    if (vcu < BATCH * NSEG * 8) { pre0 = load_piece(vcu, tid); if (tid < 24) pre1 = load_piece(vcu, tid + 512); }
    for (int T = vcu; T < BATCH * NSEG * 8; T += G) {
        const int b = T / (NSEG * 8), rem = T % (NSEG * 8), seg = rem >> 3, h = rem & 7;
        { LAS float* o = xt + (tid >> 3) * 64 + (tid & 7) * 8;
          *(LAS f32x4*)o = (f32x4){bflo(pre0.x), bfhi(pre0.x), bflo(pre0.y), bfhi(pre0.y)}; *(LAS f32x4*)(o + 4) = (f32x4){bflo(pre0.z), bfhi(pre0.z), bflo(pre0.w), bfhi(pre0.w)};
          if (tid < 24) { LAS float* o1 = xt + ((tid + 512) >> 3) * 64 + (tid & 7) * 8;
              *(LAS f32x4*)o1 = (f32x4){bflo(pre1.x), bfhi(pre1.x), bflo(pre1.y), bfhi(pre1.y)}; *(LAS f32x4*)(o1 + 4) = (f32x4){bflo(pre1.z), bfhi(pre1.z), bflo(pre1.w), bfhi(pre1.w)}; } }
        if (h != hcur) { hcur = h;
#pragma unroll
            for (int g = 0; g < 2; ++g)
#pragma unroll
                for (int ks = 0; ks < 2; ++ks) bfr[g][ks] = *(const bf16x8*)(GWT + (size_t)((((wd * 2 + g) * 8 + h) * 64 + wj) * 64 + 32 * ks + 8 * fq));
            ba = p.rg_ba[wd * DLRU + h * 64 + wj]; bi = p.rg_bi[wd * DLRU + h * 64 + wj]; c8 = -8.f * log1pf(expf(-p.rg_lam[wd * DLRU + h * 64 + wj]));
            cw0 = p.conv_w[h * 64 + cch_c]; cw1 = p.conv_w[DLRU + h * 64 + cch_c]; cw2 = p.conv_w[2 * DLRU + h * 64 + cch_c]; cw3 = p.conv_w[3 * DLRU + h * 64 + cch_c]; cbias = p.conv_b[h * 64 + cch_c];
            asm volatile("" : "+v"(ba), "+v"(bi), "+v"(c8), "+v"(cw0), "+v"(cw1), "+v"(cw2), "+v"(cw3), "+v"(cbias) :: "memory");
#pragma unroll
            for (int g = 0; g < 2; ++g)
#pragma unroll
                for (int ks = 0; ks < 2; ++ks) asm volatile("" : "+v"(bfr[g][ks]) :: "memory"); }
        __syncthreads();
        if (T + G < BATCH * NSEG * 8) { pre0 = load_piece(T + G, tid); if (tid < 24) pre1 = load_piece(T + G, tid + 512); }
        for (int i = tid; i < 4096; i += NTHREADS) { const int r = i >> 6, ch = i & 63;
            const float v = cbias + cw0 * xt[r * 64 + ch] + cw1 * xt[(r + 1) * 64 + ch] + cw2 * xt[(r + 2) * 64 + ch] + cw3 * xt[(r + 3) * 64 + ch];
            cxf[i] = v; *(LAS bf16*)(cxb + r * 144 + ch * 2) = (bf16)f2bf(v); }
        __syncthreads();
        {
            float ga[4][4], gb[4][4];
#pragma unroll
            for (int pt = 0; pt < 4; ++pt) {
                const bf16x8 a0 = *(const LAS bf16x8*)(cxb + (16 * pt + fr) * 144 + 16 * fq), a1 = *(const LAS bf16x8*)(cxb + (16 * pt + fr) * 144 + 64 + 16 * fq);
                f32x4 ca = (f32x4){0.f, 0.f, 0.f, 0.f}, ci = (f32x4){0.f, 0.f, 0.f, 0.f};
                ca = __builtin_amdgcn_mfma_f32_16x16x32_bf16(a0, bfr[0][0], ca, 0, 0, 0); ca = __builtin_amdgcn_mfma_f32_16x16x32_bf16(a1, bfr[0][1], ca, 0, 0, 0);
                ci = __builtin_amdgcn_mfma_f32_16x16x32_bf16(a0, bfr[1][0], ci, 0, 0, 0); ci = __builtin_amdgcn_mfma_f32_16x16x32_bf16(a1, bfr[1][1], ci, 0, 0, 0);
#pragma unroll
                for (int r = 0; r < 4; r += 2) { const int pos = 16 * pt + 4 * fq + r;
                    const f32x2p rg = sigmoid2_((f32x2p){ca[r], ca[r + 1]} + ba), ig = sigmoid2_((f32x2p){ci[r], ci[r + 1]} + bi); f32x2p av, sv; decay_pair2(rg * c8, av, sv);
                    const f32x2p dv = sv * ig * (f32x2p){cxf[pos * 64 + wj], cxf[(pos + 1) * 64 + wj]}; ga[pt][r] = av.x; ga[pt][r + 1] = av.y; gb[pt][r] = dv.x; gb[pt][r + 1] = dv.y; }
            }
            float Pin = 1.f, Hin = 0.f;
            if (wd == 0) lru_scan<0>(ga, gb, EX, lane, fr, fq, wj, Pin, Hin); else lru_scan<1>(ga, gb, EX, lane, fr, fq, wj, Pin, Hin);
            if (fq == 0) { float* so = SUM + ((size_t)((b * NSEG + seg) * 2 + wd) * DLRU + h * 64 + wj) * 2; so[0] = Pin; so[1] = Hin; }
        }
        __syncthreads();
        if (seg >= 4) { const int pos = tid >> 3, c0 = (tid & 7) * 8; const LAS float* q0 = EX + pos * 64 + c0;
            const f32x4 a0l = *(const LAS f32x4*)(q0), a0h = *(const LAS f32x4*)(q0 + 4), d0l = *(const LAS f32x4*)(q0 + 4096), d0h = *(const LAS f32x4*)(q0 + 4100);
            const f32x4 a1l = *(const LAS f32x4*)(q0 + 8192), a1h = *(const LAS f32x4*)(q0 + 8196), d1l = *(const LAS f32x4*)(q0 + 12288), d1h = *(const LAS f32x4*)(q0 + 12292);
            const f32x4 sl = d0l + d1l, sh = d0h + d1h; const size_t o = (size_t)(b * SEQ + (seg - 4) * 64 + pos) * DLRU + h * 64 + c0;
            *(v4u*)(HS + o) = (v4u){pk2(sl.x, sl.y), pk2(sl.z, sl.w), pk2(sh.x, sh.y), pk2(sh.z, sh.w)};
            *(v4u*)(PF + o) = (v4u){pk2(a0l.x, a0l.y), pk2(a0l.z, a0l.w), pk2(a0h.x, a0h.y), pk2(a0h.z, a0h.w)};
            *(v4u*)(PB + o) = (v4u){pk2(a1l.x, a1l.y), pk2(a1l.z, a1l.w), pk2(a1h.x, a1h.y), pk2(a1h.z, a1h.w)}; }
    }
    __syncthreads();
}

#define SGU_GLD4(r, ptr) asm volatile("global_load_dwordx4 %0, %4, off\n\tglobal_load_dwordx4 %1, %4, off offset:64\n\tglobal_load_dwordx4 %2, %4, off offset:128\n\tglobal_load_dwordx4 %3, %4, off offset:192" \
    : "=&v"(r[0]), "=&v"(r[1]), "=&v"(r[2]), "=&v"(r[3]) : "v"(ptr) : "memory")
__device__ __forceinline__ void phase_sgu_mfma(const P& p, LAS unsigned char* lds, int tid, int lane, int wave, int vcu, int G, int first = 0, int last = 512) {
    LAS unsigned char* vnT = lds;
    LAS unsigned char* ul = lds + 34816;
    const bf16* UV = (const bf16*)(p.ws + WS_UV); const bf16* SWB = (const bf16*)(p.ws + WS_SWB); bf16* A2 = (bf16*)(p.ws + WS_A2);
    const int fr = lane & 15, fq = lane >> 4, q = tid >> 2, part = tid & 3;
    int T = first + vcu; if (T >= last) return;
    v4u vw[4], uw[4];
    auto issue = [&](int TT) { const int b = TT >> 6, n = (TT >> 2) & 15, h = TT & 3; const bf16* row = UV + ((size_t)b * SEQ + n * 128 + q) * DIN + h * 128 + part * 8;
        SGU_GLD4(vw, row + 512); SGU_GLD4(uw, row); };
    issue(T);
    int hcur = -1; f32x4 gs[8]; bf16x8 afr[4]; float bs[4] = {0.f, 0.f, 0.f, 0.f};
    for (; T < last; T += G) {
        const int b = T >> 6, n = (T >> 2) & 15, h = T & 3; const size_t t0 = (size_t)b * SEQ + n * 128;
        if (h != hcur) { hcur = h;
#pragma unroll
            for (int i = 0; i < 4; ++i) { gs[2 * i] = *(const f32x4*)(p.sgu_g + h * 128 + 32 * i + 8 * part); gs[2 * i + 1] = *(const f32x4*)(p.sgu_g + h * 128 + 32 * i + 8 * part + 4); }
#pragma unroll
            for (int ks = 0; ks < 4; ++ks) afr[ks] = *(const bf16x8*)(SWB + (size_t)((h * 128 + 16 * wave + fr) * 128 + 32 * ks + 8 * fq));
#pragma unroll
            for (int r = 0; r < 4; ++r) bs[r] = p.sgu_b[h * 128 + 16 * wave + 4 * fq + r];
#pragma unroll
            for (int i = 0; i < 8; ++i) asm volatile("" : "+v"(gs[i]) :: "memory");
#pragma unroll
            for (int ks = 0; ks < 4; ++ks) asm volatile("" : "+v"(afr[ks]) :: "memory");
            asm volatile("" : "+v"(bs[0]), "+v"(bs[1]), "+v"(bs[2]), "+v"(bs[3]) :: "memory"); }
        asm volatile("s_waitcnt vmcnt(4) ; retires %0 %1 %2 %3 %4 %5 %6 %7" : "+v"(vw[0]), "+v"(vw[1]), "+v"(vw[2]), "+v"(vw[3]), "+v"(uw[0]), "+v"(uw[1]), "+v"(uw[2]), "+v"(uw[3]) :: "memory");
        { float v[32]; float s = 0.f;
#pragma unroll
          for (int i = 0; i < 4; ++i) { const v4u w = vw[i]; v[8 * i] = bflo(w.x); v[8 * i + 1] = bfhi(w.x); v[8 * i + 2] = bflo(w.y); v[8 * i + 3] = bfhi(w.y); v[8 * i + 4] = bflo(w.z); v[8 * i + 5] = bfhi(w.z); v[8 * i + 6] = bflo(w.w); v[8 * i + 7] = bfhi(w.w); }
#pragma unroll
          for (int i = 0; i < 32; ++i) s += v[i] * v[i];
          s += __shfl_xor(s, 1); s += __shfl_xor(s, 2);
          const float rinv = rsqrtf(s * (1.f / 128.f) + EPS);
#pragma unroll
          for (int i = 0; i < 4; ++i)
#pragma unroll
              for (int jx = 0; jx < 8; ++jx) { const int c = 32 * i + 8 * part + jx; *(LAS bf16*)(vnT + c * 272 + q * 2) = (bf16)f2bf(v[8 * i + jx] * rinv * gs[2 * i + (jx >> 2)][jx & 3]); }
#pragma unroll
          for (int i = 0; i < 4; ++i) *(LAS v4u*)(ul + q * 272 + (4 * i + part) * 16) = uw[i]; }
        { const int Tn = (T + G < last) ? T + G : T; issue(Tn); }
        __syncthreads();
        {
#pragma unroll
          for (int ct = 0; ct < 8; ++ct) { f32x4 acc = (f32x4){0.f, 0.f, 0.f, 0.f};
#pragma unroll
              for (int ks = 0; ks < 4; ++ks) { const bf16x8 bv = *(const LAS bf16x8*)(vnT + (16 * ct + fr) * 272 + 64 * ks + 16 * fq); acc = __builtin_amdgcn_mfma_f32_16x16x32_bf16(afr[ks], bv, acc, 0, 0, 0); }
#pragma unroll
              for (int r = 0; r < 4; ++r) { const int pp = 16 * wave + 4 * fq + r, c = 16 * ct + fr; LAS bf16* e = (LAS bf16*)(ul + pp * 272 + c * 2);
                  *e = (bf16)f2bf(bf2f(*e) * (acc[r] + bs[r])); } } }
        __syncthreads();
        { bf16* dst = A2 + (t0 + q) * D + h * 128 + part * 8;
#pragma unroll
          for (int i = 0; i < 4; ++i) *(v4u*)(dst + 32 * i) = *(const LAS v4u*)(ul + q * 272 + (4 * i + part) * 16); }
        __syncthreads();
    }
    asm volatile("s_waitcnt vmcnt(0)" ::: "memory");
}

__device__ __forceinline__ void phase_lru2(const P& p, LAS unsigned char* lds, int tid, int vcu, int G) {
    LAS float* carry = (LAS float*)lds;
    const bf16* UV = (const bf16*)(p.ws + WS_UV); const bf16* HS = (const bf16*)(p.ws + WS_HS); const bf16* PF = (const bf16*)(p.ws + WS_PF); const bf16* PB = (const bf16*)(p.ws + WS_PB);
    const float* SUM = (const float*)(p.ws + WS_SUM); bf16* A2 = (bf16*)(p.ws + WS_A2);
    for (int T = vcu; T < BATCH * 32 * 8; T += G) {
        const int b = T >> 8, gr = (T >> 3) & 31, h = T & 7;
        if (tid < 128) { const int d = tid >> 6, ch = tid & 63; float hc = 0.f;
            const float* S = SUM + ((size_t)b * NSEG * 2 * DLRU + (size_t)d * DLRU + h * 64 + ch) * 2;
            if (d == 0) { for (int s = 0; s < 4 + gr; ++s) { const float A = S[(size_t)s * 2048], B = S[(size_t)s * 2048 + 1]; hc = A * hc + B; } }
            else { for (int s = 3; s >= 0; --s) { const float A = S[(size_t)s * 2048], B = S[(size_t)s * 2048 + 1]; hc = A * hc + B; }
                   for (int s = NSEG - 1; s > 4 + gr; --s) { const float A = S[(size_t)s * 2048], B = S[(size_t)s * 2048 + 1]; hc = A * hc + B; } }
            carry[tid] = hc; }
        __syncthreads();
        for (int i = tid; i < 4096; i += NTHREADS) { const int r = i >> 6, ch = i & 63; const size_t row = (size_t)b * SEQ + gr * 64 + r, o = row * DLRU + h * 64 + ch;
            const float val = bf2f(HS[o]) + bf2f(PF[o]) * carry[ch] + bf2f(PB[o]) * carry[64 + ch];
            A2[row * D + 512 + h * 64 + ch] = (bf16)f2bf(bf2f(UV[row * DIN + 1536 + h * 64 + ch]) * val); }
        __syncthreads();
    }
}


__device__ __forceinline__ void phase_lru2_fast(const P& p, LAS unsigned char* lds, int tid, int vcu, int G) {
    LAS float* carry = (LAS float*)lds;
    constexpr int NQ = LRU2_PARTS, GR = 32 / NQ, GSH = (NQ == 8) ? 2 : 3, CBUF = GR * 2 * 64;
    const bf16* UV = (const bf16*)(p.ws + WS_UV); const bf16* HS = (const bf16*)(p.ws + WS_HS); const bf16* PF = (const bf16*)(p.ws + WS_PF); const bf16* PB = (const bf16*)(p.ws + WS_PB);
    const float* SUM = (const float*)(p.ws + WS_SUM); bf16* A2 = (bf16*)(p.ws + WS_A2);
    typedef float f32x2 __attribute__((ext_vector_type(2)));
    constexpr int NT = 64 * NQ;
    if (vcu >= NT) return;
    const int Tlast = vcu + ((NT - 1 - vcu) / G) * G;
    v4u nhs[GR], npf[GR], npb[GR], ngg[GR]; f32x2 ab[NSEG];
    auto load_rows = [&](int T) { const int b = T / (8 * NQ), h = (T / NQ) & 7, qt = T % NQ;
#pragma unroll
        for (int it = 0; it < GR; ++it) { const int v = it * NTHREADS + tid, pos = v >> 3, c0 = (v & 7) * 8; const size_t row = (size_t)b * SEQ + qt * (64 * GR) + pos, o = row * DLRU + h * 64 + c0;
            nhs[it] = *(const v4u*)(HS + o); npf[it] = *(const v4u*)(PF + o); npb[it] = *(const v4u*)(PB + o); ngg[it] = *(const v4u*)(UV + row * DIN + 1536 + h * 64 + c0); } };
    auto load_sum = [&](int T) { const int b = T / (8 * NQ), h = (T / NQ) & 7; const int d = (tid >> 6) & 1, ch = tid & 63;
        const f32x2* S = (const f32x2*)SUM + ((size_t)b * NSEG * 2 + d) * DLRU + h * 64 + ch;
#pragma unroll
        for (int s2 = 0; s2 < NSEG; ++s2) ab[s2] = S[(size_t)s2 * 2 * DLRU]; };
    auto fold = [&](int T, LAS float* cbuf) { const int qt = T % NQ; const int d = tid >> 6, ch = tid & 63; float hc = 0.f;
        if (d == 0) {
#pragma unroll
            for (int s2 = 0; s2 < NSEG; ++s2) { if (s2 >= 4 && ((s2 - 4) >> GSH) == qt) cbuf[(((s2 - 4) & (GR - 1)) * 2 + 0) * 64 + ch] = hc; hc = ab[s2].x * hc + ab[s2].y; }
        } else {
#pragma unroll
            for (int s2 = 3; s2 >= 0; --s2) hc = ab[s2].x * hc + ab[s2].y;
#pragma unroll
            for (int s2 = NSEG - 1; s2 >= 4; --s2) { if (((s2 - 4) >> GSH) == qt) cbuf[(((s2 - 4) & (GR - 1)) * 2 + 1) * 64 + ch] = hc; hc = ab[s2].x * hc + ab[s2].y; }
        } };
    if (tid < 128) load_sum(vcu);
    load_rows(vcu);
    if (tid < 128) fold(vcu, carry);
    __syncthreads();
    int cb = 0;
    for (int T = vcu; T < NT; T += G) {
        const int b = T / (8 * NQ), h = (T / NQ) & 7, qt = T % NQ, Tn = min(T + G, Tlast);
        v4u hsv[GR], pfv[GR], pbv[GR], ggv[GR];
#pragma unroll
        for (int it = 0; it < GR; ++it) { hsv[it] = nhs[it]; pfv[it] = npf[it]; pbv[it] = npb[it]; ggv[it] = ngg[it]; }
#pragma unroll
        for (int it = 0; it < GR; ++it) asm volatile("" : "+v"(hsv[it]), "+v"(pfv[it]), "+v"(pbv[it]), "+v"(ggv[it]) :: "memory");
        if (tid < 128) load_sum(Tn);
        load_rows(Tn);
        const LAS float* cr = carry + cb * CBUF;
#pragma unroll
        for (int it = 0; it < GR; ++it) { const int v = it * NTHREADS + tid, pos = v >> 3, c0 = (v & 7) * 8, grl = pos >> 6;
            const size_t row = (size_t)b * SEQ + qt * (64 * GR) + pos;
            const v4u hs = hsv[it], pf = pfv[it], pb = pbv[it], gg = ggv[it];
            const f32x4 cf0 = *(const LAS f32x4*)(cr + (grl * 2) * 64 + c0), cf1 = *(const LAS f32x4*)(cr + (grl * 2) * 64 + c0 + 4);
            const f32x4 cb0 = *(const LAS f32x4*)(cr + (grl * 2 + 1) * 64 + c0), cb1 = *(const LAS f32x4*)(cr + (grl * 2 + 1) * 64 + c0 + 4);
            v4u out;
            out.x = pk2(bflo(gg.x) * (bflo(hs.x) + bflo(pf.x) * cf0.x + bflo(pb.x) * cb0.x), bfhi(gg.x) * (bfhi(hs.x) + bfhi(pf.x) * cf0.y + bfhi(pb.x) * cb0.y));
            out.y = pk2(bflo(gg.y) * (bflo(hs.y) + bflo(pf.y) * cf0.z + bflo(pb.y) * cb0.z), bfhi(gg.y) * (bfhi(hs.y) + bfhi(pf.y) * cf0.w + bfhi(pb.y) * cb0.w));
            out.z = pk2(bflo(gg.z) * (bflo(hs.z) + bflo(pf.z) * cf1.x + bflo(pb.z) * cb1.x), bfhi(gg.z) * (bfhi(hs.z) + bfhi(pf.z) * cf1.y + bfhi(pb.z) * cb1.y));
            out.w = pk2(bflo(gg.w) * (bflo(hs.w) + bflo(pf.w) * cf1.z + bflo(pb.w) * cb1.z), bfhi(gg.w) * (bfhi(hs.w) + bfhi(pf.w) * cf1.w + bfhi(pb.w) * cb1.w));
            *(v4u*)(A2 + row * D + 512 + h * 64 + c0) = out; }
        cb ^= 1;
        if (tid < 128) fold(Tn, carry + cb * CBUF);
        __syncthreads();
    }
}

__device__ __forceinline__ void phase_p5(const P& p, LAS unsigned char* lds, int tid, int lane, int wave, int vcu, int G) {
    LAS float* wrT = (LAS float*)lds;
    const float* MOD = (const float*)(p.ws + WS_MOD); const float* X1 = (const float*)(p.ws + WS_X1); bf16* HX2 = (bf16*)(p.ws + WS_HX2); float* AFF = (float*)(p.ws + WS_AFF);
    for (int i = tid; i < D * NE; i += NTHREADS) wrT[(i & 15) * D + (i >> 4)] = p.w_router[i];
    __syncthreads();
    const int gw = vcu * NWAVES + wave, NGW = G * NWAVES;
    f32x4 nx[4];
    if (gw < M) { const f32x4* xr = (const f32x4*)(X1 + (size_t)gw * D) + lane;
#pragma unroll
        for (int jj = 0; jj < 4; ++jj) nx[jj] = xr[64 * jj]; }
    for (int m = gw; m < M; m += NGW) {
        const int b = m >> 11, t = m & 2047;
        f32x4 v[4]; float s = 0.f;
#pragma unroll
        for (int jj = 0; jj < 4; ++jj) { v[jj] = nx[jj]; s += (v[jj].x * v[jj].x + v[jj].y * v[jj].y) + (v[jj].z * v[jj].z + v[jj].w * v[jj].w); }
        if (m + NGW < M) { const f32x4* xr = (const f32x4*)(X1 + (size_t)(m + NGW) * D) + lane;
#pragma unroll
            for (int jj = 0; jj < 4; ++jj) nx[jj] = xr[64 * jj]; }
        const float rinv = rsqrtf(wave_sum(s) * (1.f / D) + EPS);
        v2u* o = (v2u*)(HX2 + (size_t)m * D) + lane;
#pragma unroll
        for (int jj = 0; jj < 4; ++jj) { const int k = 4 * (lane + 64 * jj);
            const f32x4 g = *(const f32x4*)(p.norm2_g + k), sh = *(const f32x4*)(MOD + b * NMOD + 3 * D + k), sc = *(const f32x4*)(MOD + b * NMOD + 4 * D + k);
            v[jj] = v[jj] * rinv * g * (sc + 1.f) + sh;
#if MOE_FP8
            ((unsigned*)(p.ws + WS_HX2) + (size_t)m * (D / 4))[lane + 64 * jj] = pk4_fp8(v[jj].x, v[jj].y, v[jj].z, v[jj].w); }
#else
            v2u w; w.x = pk2(v[jj].x, v[jj].y); w.y = pk2(v[jj].z, v[jj].w); o[64 * jj] = w; }
#endif
        float pa[16];
#pragma unroll
        for (int e = 0; e < 16; ++e) { float a = 0.f;
#pragma unroll
            for (int jj = 0; jj < 4; ++jj) { const f32x4 w = *(const LAS f32x4*)(wrT + e * D + 4 * (lane + 64 * jj)); a += (v[jj].x * w.x + v[jj].y * w.y) + (v[jj].z * w.z + v[jj].w * w.w); }
            pa[e] = a; if (e & 1) asm volatile("" ::: "memory"); }
        { const bool h5 = (lane & 32) != 0; float q8[8];
#pragma unroll
          for (int i = 0; i < 8; ++i) { const float keep = h5 ? pa[8 + i] : pa[i], give = h5 ? pa[i] : pa[8 + i]; q8[i] = keep + __shfl_xor(give, 32); }
          const bool h4 = (lane & 16) != 0; float q4[4];
#pragma unroll
          for (int i = 0; i < 4; ++i) { const float keep = h4 ? q8[4 + i] : q8[i], give = h4 ? q8[i] : q8[4 + i]; q4[i] = keep + __shfl_xor(give, 16); }
          const bool h3 = (lane & 8) != 0; float q2[2];
#pragma unroll
          for (int i = 0; i < 2; ++i) { const float keep = h3 ? q4[2 + i] : q4[i], give = h3 ? q4[i] : q4[2 + i]; q2[i] = keep + __shfl_xor(give, 8); }
          const bool h2 = (lane & 4) != 0;
          float lgt = (h2 ? q2[1] : q2[0]) + __shfl_xor(h2 ? q2[0] : q2[1], 4);
          lgt += __shfl_xor(lgt, 2); lgt += __shfl_xor(lgt, 1);
          float mx = lgt;
#pragma unroll
          for (int o2 = 4; o2 < 64; o2 <<= 1) mx = fmaxf(mx, __shfl_xor(mx, o2));
          const float ex = expf(lgt - mx); float den = ex;
#pragma unroll
          for (int o2 = 4; o2 < 64; o2 <<= 1) den += __shfl_xor(den, o2);
          if ((lane & 3) == 0) AFF[(size_t)(b * NE + (lane >> 2)) * SEQ + t] = ex / den; }
    }
    __syncthreads();
}

__device__ __forceinline__ void phase_p6(const P& p, LAS unsigned char* lds, int tid, int lane, int wave, int vcu, int G) {
    LAS float* a = (LAS float*)lds; LAS int* tok = (LAS int*)(lds + 8192);
    const float* AFF = (const float*)(p.ws + WS_AFF); int* SLOT = (int*)(p.ws + WS_SLOT); float* GATE = (float*)(p.ws + WS_GATE);
    const bf16* HX2 = (const bf16*)(p.ws + WS_HX2); bf16* XE = (bf16*)(p.ws + WS_XE);
    for (int T = vcu; T < BATCH * NE; T += G) {
        const int b = T >> 4, e = T & 15;
        for (int i = tid; i < SEQ; i += NTHREADS) a[i] = AFF[(size_t)(b * NE + e) * SEQ + i];
        __syncthreads();
        float at[4]; int rk[4];
#pragma unroll
        for (int i = 0; i < 4; ++i) { at[i] = a[tid + 512 * i]; rk[i] = 0; }
        for (int t2 = 0; t2 < SEQ; ++t2) { const float av = a[t2];
#pragma unroll
            for (int i = 0; i < 4; ++i) rk[i] += (av > at[i] || (av == at[i] && t2 < tid + 512 * i)) ? 1 : 0; }
#pragma unroll
        for (int i = 0; i < 4; ++i) { const int t = tid + 512 * i; SLOT[(size_t)(b * SEQ + t) * NE + e] = rk[i] < CAP ? rk[i] : -1;
            if (rk[i] < CAP) { tok[rk[i]] = t; GATE[e * 2048 + b * CAP + rk[i]] = at[i]; } }
        __syncthreads();
        for (int r = wave; r < CAP; r += NWAVES) { const v4u* src = (const v4u*)(HX2 + (size_t)(b * SEQ + tok[r]) * D); v4u* dst = (v4u*)(XE + (size_t)(e * 2048 + b * CAP + r) * D);
            dst[lane] = src[lane]; dst[lane + 64] = src[lane + 64]; }
        __syncthreads();
    }
}


__device__ __forceinline__ unsigned block_sum_u(unsigned v, LAS unsigned* red, int lane, int wave) {
    v = (unsigned)wave_sum((float)v);
    if (lane == 0) red[wave] = v;
    __syncthreads();
    unsigned s = 0;
#pragma unroll
    for (int w = 0; w < 8; ++w) s += red[w];
    return s;
}
__device__ __forceinline__ unsigned block_excl_scan(unsigned c, unsigned& total, LAS unsigned* red, int lane, int wave) {
    unsigned inc = c;
#pragma unroll
    for (int o = 1; o < 64; o <<= 1) { const unsigned t = __shfl_up(inc, o); if (lane >= o) inc += t; }
    if (lane == 63) red[wave] = inc;
    __syncthreads();
    unsigned off = 0, tot = 0;
#pragma unroll
    for (int w = 0; w < 8; ++w) { const unsigned x = red[w]; off += (w < wave) ? x : 0u; tot += x; }
    total = tot; return off + inc - c;
}
__device__ __forceinline__ void phase_p6_fast(const P& p, LAS unsigned char* lds, int tid, int lane, int wave, int vcu, int G) {
    LAS unsigned* red = (LAS unsigned*)lds;
    LAS int* tok = (LAS int*)(lds + 2048);
    const float* AFF = (const float*)(p.ws + WS_AFF); int* SLOT = (int*)(p.ws + WS_SLOT); float* GATE = (float*)(p.ws + WS_GATE);
    const bf16* HX2 = (const bf16*)(p.ws + WS_HX2); bf16* XE = (bf16*)(p.ws + WS_XE);
    for (int T = vcu; T < BATCH * NE * 2; T += G) {
        const int half = T & 1, e = (T >> 1) & 15, b = T >> 5;
        const f32x4 av = *(const f32x4*)(AFF + (size_t)(b * NE + e) * SEQ + 4 * tid);
        unsigned bits[4] = {__float_as_uint(av.x), __float_as_uint(av.y), __float_as_uint(av.z), __float_as_uint(av.w)};
        unsigned lo = 0u, hi = 0x3f800000u; int rb = 0;
        while (lo < hi) {
            const unsigned span = hi - lo, q = (span + 3u) >> 2, t1 = lo + q, t2 = min(lo + 2u * q, hi), t3 = min(lo + 3u * q, hi);
            unsigned w = 0;
#pragma unroll
            for (int i = 0; i < 4; ++i) w += (bits[i] >= t1 ? 1u : 0u) + (bits[i] >= t2 ? (1u << 10) : 0u) + (bits[i] >= t3 ? (1u << 20) : 0u);
#pragma unroll
            for (int o = 1; o < 64; o <<= 1) w += __shfl_xor(w, o);
            LAS unsigned* rd = red + 8 * rb; rb = (rb + 1) % 36;
            if (lane == 0) rd[wave] = w;
            __syncthreads();
            unsigned c1 = 0, c2 = 0, c3 = 0;
#pragma unroll
            for (int ww = 0; ww < 8; ++ww) { const unsigned x = rd[ww]; c1 += x & 1023u; c2 += (x >> 10) & 1023u; c3 += x >> 20; }
            if (c3 >= (unsigned)CAP) lo = t3; else if (c2 >= (unsigned)CAP) { lo = t2; hi = t3 - 1u; } else if (c1 >= (unsigned)CAP) { lo = t1; hi = t2 - 1u; } else hi = t1 - 1u;
        }
        const unsigned Tb = lo;
        unsigned cg = 0, ct = 0;
#pragma unroll
        for (int i = 0; i < 4; ++i) { cg += (bits[i] > Tb) ? 1u : 0u; ct += (bits[i] == Tb) ? 1u : 0u; }
        unsigned ngt; const unsigned need = (unsigned)CAP - (ngt = block_sum_u(cg, red + 8 * 36, lane, wave));
        unsigned ttot; unsigned tpre = block_excl_scan(ct, ttot, red + 8 * 37, lane, wave);
        unsigned sel[4], cs = 0;
#pragma unroll
        for (int i = 0; i < 4; ++i) { const bool tie = bits[i] == Tb; sel[i] = (bits[i] > Tb || (tie && tpre < need)) ? 1u : 0u; tpre += tie ? 1u : 0u; cs += sel[i]; }
        unsigned stot; unsigned spre = block_excl_scan(cs, stot, red + 8 * 38, lane, wave);
#pragma unroll
        for (int i = 0; i < 4; ++i) { const int t = 4 * tid + i;
            if ((t >> 10) == half) SLOT[(size_t)(b * SEQ + t) * NE + e] = sel[i] ? (int)spre : -1;
            if (sel[i]) { tok[spre] = t; if ((int)(spre >> 7) == half) GATE[e * 2048 + b * CAP + spre] = __uint_as_float(bits[i]); spre += 1u; } }
        __syncthreads();
#if MOE_FP8
        if (tid < 128) ((int*)(p.ws + WS_TOK))[e * 2048 + b * CAP + half * 128 + tid] = b * SEQ + tok[half * 128 + tid];
#else
        for (int r = half * 128 + wave; r < half * 128 + 128; r += NWAVES) { const v4u* src = (const v4u*)(HX2 + (size_t)(b * SEQ + tok[r]) * D); v4u* dst = (v4u*)(XE + (size_t)(e * 2048 + b * CAP + r) * D);
            dst[lane] = src[lane]; dst[lane + 64] = src[lane + 64]; }
#endif
        __syncthreads();
    }
}

template <bool X1B>
__device__ __forceinline__ void phase_p9(const P& p, int lane, int wave, int vcu, int G) {
    const float* MOD = (const float*)(p.ws + WS_MOD); const float* X1 = (const float*)(p.ws + WS_X1); const int* SLOT = (const int*)(p.ws + WS_SLOT); const bf16* YE = (const bf16*)(p.ws + WS_YE);
    const int gw = vcu * NWAVES + wave, NGW = G * NWAVES;
    f32x4 nx[4]; int nslot = -1;
    auto ldrow = [&](int mm) {
        if constexpr (X1B) { const v2u* xr = (const v2u*)((const bf16*)X1 + (size_t)mm * D) + lane;
#pragma unroll
            for (int jj = 0; jj < 4; ++jj) { const v2u w = xr[64 * jj]; nx[jj] = (f32x4){bflo(w.x), bfhi(w.x), bflo(w.y), bfhi(w.y)}; } }
        else { const f32x4* xr = (const f32x4*)(X1 + (size_t)mm * D) + lane;
#pragma unroll
            for (int jj = 0; jj < 4; ++jj) nx[jj] = xr[64 * jj]; } };
    if (gw < M) { ldrow(gw);
        nslot = SLOT[(size_t)gw * NE + (lane & 15)]; }
    for (int m = gw; m < M; m += NGW) {
        const int b = m >> 11;
        f32x4 v[4], acc[4]; const int myslot = nslot;
#pragma unroll
        for (int jj = 0; jj < 4; ++jj) { v[jj] = nx[jj]; acc[jj] = (f32x4){0.f, 0.f, 0.f, 0.f}; }
        if (m + NGW < M) { ldrow(m + NGW);
            nslot = SLOT[(size_t)(m + NGW) * NE + (lane & 15)]; }
#pragma unroll
        for (int e = 0; e < NE; ++e) { const int sl = __builtin_amdgcn_readlane(myslot, e);
#if MOE_FP8
            if (sl >= 0) { const unsigned* y = (const unsigned*)((const unsigned char*)YE + (size_t)(e * 2048 + b * CAP + sl) * D) + lane;
#pragma unroll
                for (int jj = 0; jj < 4; ++jj) { const unsigned w = y[64 * jj]; const auto lo = __builtin_amdgcn_cvt_pk_f32_fp8((int)w, false), hi = __builtin_amdgcn_cvt_pk_f32_fp8((int)w, true);
                    acc[jj] += (f32x4){lo[0], lo[1], hi[0], hi[1]}; } } }
#else
            if (sl >= 0) { const v2u* y = (const v2u*)(YE + (size_t)(e * 2048 + b * CAP + sl) * D) + lane;
#pragma unroll
                for (int jj = 0; jj < 4; ++jj) { const v2u w = y[64 * jj]; acc[jj] += (f32x4){bflo(w.x), bfhi(w.x), bflo(w.y), bfhi(w.y)}; } } }
#endif
        float s = 0.f;
#pragma unroll
        for (int jj = 0; jj < 4; ++jj) { const int k = 4 * (lane + 64 * jj); const f32x4 g2 = *(const f32x4*)(MOD + b * NMOD + 5 * D + k); v[jj] += g2 * acc[jj] * (MOE_FP8 ? WSCALE_INV : 1.f);
            s += (v[jj].x * v[jj].x + v[jj].y * v[jj].y) + (v[jj].z * v[jj].z + v[jj].w * v[jj].w); }
        const float rinv = rsqrtf(wave_sum(s) * (1.f / D) + EPS);
        f32x4* o = (f32x4*)(p.out + (size_t)m * D) + lane;
#pragma unroll
        for (int jj = 0; jj < 4; ++jj) { const int k = 4 * (lane + 64 * jj); o[64 * jj] = v[jj] * rinv * *(const f32x4*)(p.final_g + k); }
    }
}

__device__ __forceinline__ void p9_finish(const P& p, LAS unsigned char* strip, int lane, int m, const v4u xa, const v4u xb, const f32x2p (&acc)[8], const f32x4 (&g2c)[4], const f32x4 (&fg)[4]) {
    f32x4 v[4];
    v[0] = (f32x4){bflo(xa.x), bfhi(xa.x), bflo(xa.y), bfhi(xa.y)}; v[1] = (f32x4){bflo(xa.z), bfhi(xa.z), bflo(xa.w), bfhi(xa.w)};
    v[2] = (f32x4){bflo(xb.x), bfhi(xb.x), bflo(xb.y), bfhi(xb.y)}; v[3] = (f32x4){bflo(xb.z), bfhi(xb.z), bflo(xb.w), bfhi(xb.w)};
    float s = 0.f;
#pragma unroll
    for (int i = 0; i < 4; ++i) { v[i] += g2c[i] * (f32x4){acc[2 * i].x, acc[2 * i].y, acc[2 * i + 1].x, acc[2 * i + 1].y}; s += (v[i].x * v[i].x + v[i].y * v[i].y) + (v[i].z * v[i].z + v[i].w * v[i].w); }
    const float rinv = rsqrtf(wave_sum(s) * (1.f / D) + EPS);
#pragma unroll
    for (int i = 0; i < 4; ++i) *(LAS f32x4*)(strip + lane * 80 + 16 * i) = v[i] * rinv * fg[i];
    __builtin_amdgcn_fence(__ATOMIC_RELEASE, "wavefront"); __builtin_amdgcn_wave_barrier(); __builtin_amdgcn_fence(__ATOMIC_ACQUIRE, "wavefront");
    f32x4* o = (f32x4*)(p.out + (size_t)m * D) + lane;
#pragma unroll
    for (int jj = 0; jj < 4; ++jj) o[64 * jj] = *(const LAS f32x4*)(strip + ((lane >> 2) + 16 * jj) * 80 + (lane & 3) * 16);
    __builtin_amdgcn_wave_barrier();
}
#define P9_GLD(dst, voff, sbase, OFFS) asm volatile("global_load_dwordx4 %0, %1, %2" OFFS : "=&v"(dst) : "v"(voff), "s"(sbase) : "memory")
__device__ __forceinline__ const unsigned char* uptr(const unsigned char* q) { const unsigned long long v = (unsigned long long)q;
    return (const unsigned char*)(((unsigned long long)(unsigned)__builtin_amdgcn_readfirstlane((int)(v >> 32)) << 32) | (unsigned)__builtin_amdgcn_readfirstlane((int)v)); }
__device__ __forceinline__ void p9_acc(f32x2p (&acc)[8], const v4u w, float sc) {
    const unsigned ww[4] = {w.x, w.y, w.z, w.w};
#pragma unroll
    for (int c = 0; c < 4; ++c) { const f32x2p lo = __builtin_amdgcn_cvt_pk_f32_fp8((int)ww[c], false), hi = __builtin_amdgcn_cvt_pk_f32_fp8((int)ww[c], true); acc[2 * c] += lo * sc; acc[2 * c + 1] += hi * sc; }
}
__device__ __forceinline__ void phase_p9_v2(const P& p, LAS unsigned char* lds, int lane, int wave, int vcu, int G) {
    const float* MOD = (const float*)(p.ws + WS_MOD); const unsigned char* X1b = p.ws + WS_X1; const int* SLOT = (const int*)(p.ws + WS_SLOT); const unsigned char* YE = p.ws + WS_YE;
    const int gw = vcu * NWAVES + wave, m0 = gw * 8, b = m0 >> 11;
    LAS unsigned char* strip = lds + wave * 5120;
    const v2u slv = *(const v2u*)(SLOT + (size_t)m0 * NE + 2 * lane);
    const int sx = (int)slv.x, sy = (int)slv.y;
    f32x4 g2c[4], fg[4];
#pragma unroll
    for (int i = 0; i < 4; ++i) { g2c[i] = *(const f32x4*)(MOD + b * NMOD + 5 * D + 16 * lane + 4 * i) * WSCALE_INV; fg[i] = *(const f32x4*)(p.final_g + 16 * lane + 4 * i); }
    const unsigned long long mk0 = __builtin_amdgcn_ballot_w64(sx >= 0), mk1 = __builtin_amdgcn_ballot_w64(sy >= 0);
#pragma unroll
    for (int i = 0; i < 4; ++i) asm volatile("" : "+v"(g2c[i]), "+v"(fg[i]) :: "memory");
    const int xoff = 32 * lane, yoff = 16 * lane;
    auto entries = [&](int r, int (&yr)[4], float (&sc)[4], unsigned& rest) { unsigned em = ((unsigned)(mk0 >> (8 * r)) & 0xffu) | (((unsigned)(mk1 >> (8 * r)) & 0xffu) << 8);
#pragma unroll
        for (int i = 0; i < 4; ++i) { yr[i] = 0; sc[i] = 0.f;
            if (em) { const int pos = __builtin_ctz(em); em &= em - 1u; const int j = pos & 7, c = pos >> 3; const int sa = __builtin_amdgcn_readlane(sx, 8 * r + j), sb = __builtin_amdgcn_readlane(sy, 8 * r + j);
                yr[i] = (2 * j + c) * 2048 + b * CAP + (c ? sb : sa); sc[i] = 1.f; } }
        rest = em; };
#define P9_ISSUE(S, rr) do { const int r_ = min((rr), 7); int yr_[4]; float sc_[4]; unsigned rest_; entries(r_, yr_, sc_, rest_); \
        const unsigned char* xb_ = uptr(X1b + (size_t)(m0 + r_) * (D * 2)); \
        P9_GLD(X##S##0, xoff, xb_, ""); P9_GLD(X##S##1, xoff, xb_, " offset:16"); \
        P9_GLD(Y##S##0, yoff, uptr(YE + (size_t)yr_[0] * D), ""); P9_GLD(Y##S##1, yoff, uptr(YE + (size_t)yr_[1] * D), ""); \
        P9_GLD(Y##S##2, yoff, uptr(YE + (size_t)yr_[2] * D), ""); P9_GLD(Y##S##3, yoff, uptr(YE + (size_t)yr_[3] * D), ""); } while (0)
#define P9_WAIT(S, n) asm volatile("s_waitcnt vmcnt(%6) ; retires %0 %1 %2 %3 %4 %5" : "+v"(X##S##0), "+v"(X##S##1), "+v"(Y##S##0), "+v"(Y##S##1), "+v"(Y##S##2), "+v"(Y##S##3) : "n"(n) : "memory")
#define P9_PROC(S, rr) do { const int r_ = (rr); int yr_[4]; float sc_[4]; unsigned rest_; entries(r_, yr_, sc_, rest_); \
        f32x2p acc_[8]; _Pragma("unroll") for (int i = 0; i < 8; ++i) acc_[i] = (f32x2p){0.f, 0.f}; \
        p9_acc(acc_, Y##S##0, sc_[0]); p9_acc(acc_, Y##S##1, sc_[1]); p9_acc(acc_, Y##S##2, sc_[2]); p9_acc(acc_, Y##S##3, sc_[3]); \
        while (rest_) { const int pos = __builtin_ctz(rest_); rest_ &= rest_ - 1u; const int j = pos & 7, c = pos >> 3; const int sa = __builtin_amdgcn_readlane(sx, 8 * r_ + j), sb = __builtin_amdgcn_readlane(sy, 8 * r_ + j); \
            const v4u w_ = *(const v4u*)(YE + (size_t)((2 * j + c) * 2048 + b * CAP + (c ? sb : sa)) * D + yoff); p9_acc(acc_, w_, 1.f); } \
        p9_finish(p, strip, lane, m0 + r_, X##S##0, X##S##1, acc_, g2c, fg); } while (0)
    v4u XA0, XA1, YA0, YA1, YA2, YA3, XB0, XB1, YB0, YB1, YB2, YB3, XC0, XC1, YC0, YC1, YC2, YC3;
    P9_ISSUE(A, 0); P9_ISSUE(B, 1);
    for (int it = 0; it < 3; ++it) { const int r = 3 * it;
        P9_ISSUE(C, r + 2); if (it == 0) asm volatile("s_waitcnt vmcnt(12)" ::: "memory"); P9_WAIT(A, 20); P9_PROC(A, r);
        P9_ISSUE(A, r + 3); if (it == 0) asm volatile("s_waitcnt vmcnt(16)" ::: "memory"); P9_WAIT(B, 20); P9_PROC(B, r + 1);
        P9_ISSUE(B, r + 4); P9_WAIT(C, 20); if (r + 2 < 8) P9_PROC(C, r + 2);
    }
    asm volatile("s_waitcnt vmcnt(0)" ::: "memory");
}

#if CONV_CUS && MOE_FP8 && XCD_BAR && LRU1_MFMA && SGU_MFMA && LRU2_FAST && P6_FAST && USE_PG8 && (MK_N_LAUNCHES == 1)
__global__ void __launch_bounds__(NTHREADS, 2) fwd_megakernel(P p) {
    extern __shared__ __attribute__((aligned(16))) unsigned char lds_raw[];
    LAS unsigned char* lds = (LAS unsigned char*)lds_raw;
    const int tid = threadIdx.x, lane = tid & 63, wave = __builtin_amdgcn_readfirstlane(tid >> 6);
    const int G = gridDim.x, bx = blockIdx.x, xg = bx & 7, xl = bx >> 3;
    const int vcu = (G % 8 == 0) ? xg * (G / 8) + xl : bx;
    constexpr int CSH = (NCONV == 64) ? 2 : 3, CPG = 32 >> CSH, WPG = 32 - CPG;
    const bool split = (G == 256), is_conv = split && ((xl & ((1 << CSH) - 1)) == (1 << CSH) - 1);
    const int GW = split ? 8 * WPG : G, wvcu = split ? xg * WPG + (xl - (xl >> CSH)) : vcu, cvcu = xg * CPG + (xl >> CSH);
    volatile LAS unsigned* bst = (volatile LAS unsigned*)(lds + LDS_BYTES - 16);
    if (tid < 4) bst[tid] = 0u;
    __syncthreads();
    unsigned* ctl = (unsigned*)(p.ws + WS_CTL);
    const XcdBarrier barA = xcd_barrier_post(ctl + 4096, bst, (unsigned)G);
    XcdBarrier barW = barA;
    if (split && !is_conv) barW = xcd_barrier_post(ctl + 4096 + XCD_BAR_WORDS, bst + 2, (unsigned)GW);

    if (is_conv) {
        convert_pipelined(p, lds, lane, wave, CONV_HEAD, CONV_ITEMS, cvcu * NWAVES + wave, 8 * CPG * NWAVES);
        if (tid == 0) { XB_SPIN(xb_ld(ctl + 64) == 0u, ctl + 4096); __builtin_amdgcn_fence(__ATOMIC_ACQUIRE, "agent"); asm volatile("s_waitcnt vmcnt(0)" ::: "memory"); }
        __syncthreads();
        phase_sgu_mfma(p, lds, tid, lane, wave, cvcu, 8 * CPG, 0, SGU_CONV_TASKS);
    } else {
        phase_p0(p, lds, tid, lane, wave, wvcu, GW, split ? 16 * 32 : CONV_ITEMS, !split);
        xcd_barrier(barW);
        phase_p1(p, lane, wave, wvcu, GW);
        if (split) { convert_items(p, lds, lane, wave, 16 * 32, CONV_HEAD, wvcu * NWAVES + wave, GW * NWAVES); p0_small_copies(p, tid, wvcu, GW); }
        xcd_barrier(barW);
        { pg8::Gemm g{(const bf16*)(p.ws + WS_HX), (const bf16*)(p.ws + WS_WIN), D}; SchedG1 S{GW, wvcu}; EpiG1 E{(bf16*)(p.ws + WS_UV), (bf16*)(p.ws + WS_XC)};
          pg8::gemm_phase<EpiG1, SchedG1, true, true>(lds, g, S, E); }
        xcd_barrier(barW);
        if (split && wvcu == 0 && tid == 0) __hip_atomic_store(ctl + 64, 1u, __ATOMIC_RELAXED, __HIP_MEMORY_SCOPE_AGENT);
#if LRU1_V2
        phase_lru1_v2(p, lds, tid, lane, wave, wvcu, GW);
#else
        phase_lru1_mfma(p, lds, tid, lane, wave, wvcu, GW);
#endif
        phase_sgu_mfma(p, lds, tid, lane, wave, wvcu, GW, split ? SGU_CONV_TASKS : 0, 512);
        xcd_barrier(barW);
        phase_lru2_fast(p, lds, tid, wvcu, GW);
    }
    xcd_barrier(barA);
    if (split) {
        pg8::Gemm g{(const bf16*)(p.ws + WS_A2), (const bf16*)(p.ws + WS_WOUT), D}; SchedG2 S{G, vcu};
        EpiG2F E{p.x, (const float*)(p.ws + WS_MOD), (float*)(p.ws + WS_X1), p.w_router, p.norm2_g, (const float*)(p.ws + WS_CB), (float*)(p.ws + WS_XCH), ctl + 2048, ctl + 4096, p.ws + WS_HX2, (float*)(p.ws + WS_AFF)};
        pg8::gemm_phase<EpiG2F, SchedG2, true, true>(lds, g, S, E);
    } else {
        { pg8::Gemm g{(const bf16*)(p.ws + WS_A2), (const bf16*)(p.ws + WS_WOUT), D}; SchedG2 S{G, vcu}; EpiG2 E{p.x, (const float*)(p.ws + WS_MOD), (float*)(p.ws + WS_X1)};
          pg8::gemm_phase<EpiG2, SchedG2, true, true>(lds, g, S, E); }
        xcd_barrier(barA);
        phase_p5(p, lds, tid, lane, wave, vcu, G);
    }
    xcd_barrier(barA);
    phase_p6_fast(p, lds, tid, lane, wave, vcu, G);
    xcd_barrier(barA);
    { pg8::Gemm g{(const bf16*)(p.ws + WS_HX2), (const bf16*)(p.ws + WS_WG), D}; SchedG3 S{G, vcu}; EpiG3 E{p.ws + WS_HID};
      pg8::gemm_phase_f8g<EpiG3, SchedG3, true, true>(lds, g, S, E, (const int*)(p.ws + WS_TOK)); }
    xcd_barrier(barA);
    { pg8::Gemm g{(const bf16*)(p.ws + WS_HID), (const bf16*)(p.ws + WS_W2), DE}; SchedG4 S{G, vcu}; EpiG4 E{(const float*)(p.ws + WS_GATE), p.ws + WS_YE};
      pg8::gemm_phase_f8<EpiG4, SchedG4, true, true>(lds, g, S, E); }
    xcd_barrier(barA);
    if (split) phase_p9_v2(p, lds, lane, wave, vcu, G); else phase_p9<false>(p, lane, wave, vcu, G);
}
#else
__global__ void __launch_bounds__(NTHREADS, 2) fwd_megakernel(P p) {
    extern __shared__ __attribute__((aligned(16))) unsigned char lds_raw[];
    LAS unsigned char* lds = (LAS unsigned char*)lds_raw;
    const int tid = threadIdx.x, lane = tid & 63, wave = __builtin_amdgcn_readfirstlane(tid >> 6);
    const int G = gridDim.x, bx = blockIdx.x, vcu = (G % 8 == 0) ? (bx % 8) * (G / 8) + bx / 8 : bx;
    const int lo = p.ph_lo, hi = p.ph_hi;
#if XCD_BAR
    volatile LAS unsigned* bst = (volatile LAS unsigned*)(lds + LDS_BYTES - 16);
    if (tid < 2) bst[tid] = 0u;
    __syncthreads();
    XcdBarrier bar; bar.bar = (unsigned*)(p.ws + WS_CTL) + 4096; bar.x = 0; bar.st = bst; bar.total = (unsigned)G;
    if (hi - lo > 1) bar = xcd_barrier_post((unsigned*)(p.ws + WS_CTL) + 4096, bst, (unsigned)G);
#define GRID_SYNC() xcd_barrier(bar)
#else
    cg::grid_group grid = cg::this_grid();
#define GRID_SYNC() grid.sync()
#endif
#define IN(k) (lo <= (k) && (k) < hi)
#define SEAM(k) do { if (IN(k) && IN((k) + 1)) GRID_SYNC(); } while (0)
#define REP(k) for (int rep_ = 0; rep_ < 1 + ((DUP_MASK >> (k)) & 1); ++rep_)
    if (IN(0)) { REP(0) { phase_p0(p, lds, tid, lane, wave, vcu, G, CONV_CUT); __syncthreads(); } SEAM(0); }
    if (IN(1)) { REP(1) phase_p1(p, lane, wave, vcu, G); SEAM(1); }
    if ((DUP_MASK >> 12) & 1) { for (int xb = 0; xb < 8; ++xb) GRID_SYNC(); }
    if (IN(2)) { pg8::Gemm g{(const bf16*)(p.ws + WS_HX), (const bf16*)(p.ws + WS_WIN), D}; SchedG1 S{G, vcu}; EpiG1 E{(bf16*)(p.ws + WS_UV), (bf16*)(p.ws + WS_XC)};
        REP(2) { gemm_any(lds, g, S, E); if (G > 16 && vcu >= 16) convert_items(p, lds, lane, wave, CONV_CUT, CONV_ITEMS, (vcu - 16) * NWAVES + wave, (G - 16) * NWAVES); }
        if (G <= 16) convert_items(p, lds, lane, wave, CONV_CUT, CONV_ITEMS, vcu * NWAVES + wave, G * NWAVES);
        SEAM(2); }
    if (IN(3)) { REP(3) {
#if LRU1_MFMA
        phase_lru1_mfma(p, lds, tid, lane, wave, vcu, G);
#else
        phase_lru1(p, lds, tid, vcu, G);
#endif
        } REP(11) {
#if SGU_MFMA
        phase_sgu_mfma(p, lds, tid, lane, wave, vcu, G);
#else
        phase_sgu(p, lds, tid, vcu, G);
#endif
        } SEAM(3); }
    if (IN(4)) { REP(4) {
#if LRU2_FAST
        phase_lru2_fast(p, lds, tid, vcu, G);
#else
        phase_lru2(p, lds, tid, vcu, G);
#endif
        } SEAM(4); }
    if (IN(5)) { pg8::Gemm g{(const bf16*)(p.ws + WS_A2), (const bf16*)(p.ws + WS_WOUT), D}; SchedG2 S{G, vcu}; EpiG2 E{p.x, (const float*)(p.ws + WS_MOD), (float*)(p.ws + WS_X1)};
        REP(5) gemm_any(lds, g, S, E); SEAM(5); }
    if (IN(6)) { REP(6) phase_p5(p, lds, tid, lane, wave, vcu, G); SEAM(6); }
    if (IN(7)) { REP(7) {
#if P6_FAST
        phase_p6_fast(p, lds, tid, lane, wave, vcu, G);
#else
        phase_p6(p, lds, tid, lane, wave, vcu, G);
#endif
        } SEAM(7); }
#if MOE_FP8
    if (IN(8)) { pg8::Gemm g{(const bf16*)(p.ws + WS_XE), (const bf16*)(p.ws + WS_WG), D}; SchedG3 S{G, vcu}; EpiG3 E{p.ws + WS_HID};
        REP(8) pg8::gemm_phase_f8<EpiG3, SchedG3, true, true>(lds, g, S, E); SEAM(8); }
    if (IN(9)) { pg8::Gemm g{(const bf16*)(p.ws + WS_HID), (const bf16*)(p.ws + WS_W2), DE}; SchedG4 S{G, vcu}; EpiG4 E{(const float*)(p.ws + WS_GATE), p.ws + WS_YE};
        REP(9) pg8::gemm_phase_f8<EpiG4, SchedG4, true, true>(lds, g, S, E); SEAM(9); }
#else
    if (IN(8)) { pg8::Gemm g{(const bf16*)(p.ws + WS_XE), (const bf16*)(p.ws + WS_WG), D}; SchedG3 S{G, vcu}; EpiG3 E{(bf16*)(p.ws + WS_HID)};
        REP(8) gemm_any(lds, g, S, E); SEAM(8); }
    if (IN(9)) { pg8::Gemm g{(const bf16*)(p.ws + WS_HID), (const bf16*)(p.ws + WS_W2), DE}; SchedG4 S{G, vcu}; EpiG4 E{(const float*)(p.ws + WS_GATE), (bf16*)(p.ws + WS_YE)};
        REP(9) gemm_any(lds, g, S, E); SEAM(9); }
#endif
    if (IN(10)) { REP(10) phase_p9<false>(p, lane, wave, vcu, G); }
#undef IN
#undef REP
#undef SEAM
#undef GRID_SYNC
}

#endif

extern "C" void kernel_launch(void* const* d_in, const int* in_sizes, int n_in, void* d_out, int out_size, void* d_ws, size_t ws_size, hipStream_t stream) {
    static int grid = 0;
    if (grid == 0) {
        if (n_in != 25 || in_sizes[0] != M * D || out_size != M * D || ws_size < WS_END) { fprintf(stderr, "kernel_launch: unexpected shapes (n_in %d, in0 %d, out %d, ws %zu < %zu)\n", n_in, n_in > 0 ? in_sizes[0] : -1, out_size, ws_size, (size_t)WS_END); grid = -1; return; }
        int dev = 0, cus = 0, per_cu = 0;
        if (hipGetDevice(&dev) != hipSuccess || hipDeviceGetAttribute(&cus, hipDeviceAttributeMultiprocessorCount, dev) != hipSuccess) { grid = -1; return; }
        if (hipFuncSetAttribute((const void*)fwd_megakernel, hipFuncAttributeMaxDynamicSharedMemorySize, LDS_BYTES) != hipSuccess) { fprintf(stderr, "kernel_launch: hipFuncSetAttribute failed\n"); grid = -1; return; }
        if (hipOccupancyMaxActiveBlocksPerMultiprocessor(&per_cu, (const void*)fwd_megakernel, NTHREADS, LDS_BYTES) != hipSuccess || per_cu < 1) { fprintf(stderr, "kernel_launch: occupancy query failed (%d)\n", per_cu); (void)hipGetLastError(); grid = -1; return; }
        grid = cus * per_cu;
    }
    if (grid < 0) return;
#if XCD_BAR
    if (hipMemsetAsync((char*)d_ws + WS_CTL, 0, 65536, stream) != hipSuccess) { fprintf(stderr, "kernel_launch: hipMemsetAsync failed\n"); return; }
#endif
    P p{};
    const float** f = (const float**)&p;
    for (int i = 0; i < 25; ++i) f[i] = (const float*)d_in[i];
    p.out = (float*)d_out; p.ws = (unsigned char*)d_ws;
#if MK_N_LAUNCHES == 1
    p.ph_lo = 0; p.ph_hi = NPH; void* args[] = {&p};
    hipError_t e = hipLaunchCooperativeKernel((const void*)fwd_megakernel, dim3(grid), dim3(NTHREADS), args, LDS_BYTES, stream);
    if (e != hipSuccess) fprintf(stderr, "kernel_launch: cooperative launch failed: %s (grid %d)\n", hipGetErrorString(e), grid);
#else
    for (int ph = 0; ph < NPH; ++ph) { p.ph_lo = ph; p.ph_hi = ph + 1; hipLaunchKernelGGL(fwd_megakernel, dim3(grid), dim3(NTHREADS), LDS_BYTES, stream, p); }
#endif
}
```

```cpp
#include <hip/hip_runtime.h>
#include <hip/hip_cooperative_groups.h>
#include <cstdio>
#include <cstdint>
namespace cg = cooperative_groups;

#ifndef MK_N_LAUNCHES
#define MK_N_LAUNCHES 1
#endif
#ifndef XCD_BAR
#define XCD_BAR 1
#endif
#ifndef LRU1_MFMA
#define LRU1_MFMA 1
#endif
#ifndef SGU_MFMA
#define SGU_MFMA 1
#endif
#ifndef P6_FAST
#define P6_FAST 1
#endif
#ifndef DUP_MASK
#define DUP_MASK 0
#endif
#ifndef LRU2_FAST
#define LRU2_FAST 1
#endif
#ifndef MOE_FP8
#define MOE_FP8 1
#endif
#ifndef CONV_CUS
#define CONV_CUS 1
#endif
#ifndef NCONV
#define NCONV 64
#endif
#ifndef LRU1_V2
#define LRU1_V2 1
#endif
#ifndef SGU_CONV_TASKS
#define SGU_CONV_TASKS 128
#endif
#ifndef LRU2_PARTS
#define LRU2_PARTS 8
#endif
#ifndef USE_PG8
#define USE_PG8 1
#endif

namespace pg8 {
#define PG8_LAS __attribute__((address_space(3)))
typedef unsigned short bf16_t;
typedef short bf16x8 __attribute__((ext_vector_type(8)));
typedef float f32x4 __attribute__((ext_vector_type(4)));
typedef unsigned u32x4 __attribute__((ext_vector_type(4)));
typedef int v4i_t __attribute__((ext_vector_type(4)));
typedef int v8i_t __attribute__((ext_vector_type(8)));
constexpr int BM = 256, BK = 64, HALF = 128, HTB = HALF * BK * 2  , STAGE_BYTES = 8 * HTB;

__host__ __device__ __forceinline__ int lds_byte(int r, int c) { const int st = (r >> 4) * 2 + (c >> 5), rr = r & 15, cc = c & 31, ob = rr * 64 + cc * 2; return st * 1024 + (ob ^ (((ob >> 9) & 1) << 5)); }
__host__ __device__ __forceinline__ void stage_rc(int b, int& R, int& C) { const int st = b / 1024, sb = b % 1024, swz = sb ^ (((sb >> 9) & 1) << 5); R = (st >> 1) * 16 + swz / 64; C = (st & 1) * 32 + (swz % 64) / 2; }

struct Unit { int pm, pn, pnB; };
struct Gemm { const bf16_t* A; const bf16_t* Bt; int K; };

template <class Epi>
__device__ __forceinline__ void run_epi8(const Epi& E, const f32x4 (&acc)[2][2][4][2], const Unit& u, int wr, int wc, int fr, int fq) {
#pragma unroll
    for (int ai = 0; ai < 2; ++ai)
#pragma unroll
        for (int m = 0; m < 4; ++m) { const int row = ai * HALF + wr * 64 + m * 16 + fr;
            if constexpr (Epi::PAIRED) E.st2x8(u, row, wc * 32 + 8 * fq, acc[ai][0][m][0], acc[ai][0][m][1], acc[ai][1][m][0], acc[ai][1][m][1]);
            else {
#pragma unroll
                for (int bj = 0; bj < 2; ++bj) E.st8(u, row, bj * HALF + wc * 32 + 8 * fq, acc[ai][bj][m][0], acc[ai][bj][m][1]);
            } }
}
template <class Epi>
__device__ __forceinline__ void run_epi(const Epi& E, const f32x4 (&acc)[2][2][4][2], const Unit& u, int wr, int wc, int fr, int fq) {
#pragma unroll
    for (int ai = 0; ai < 2; ++ai)
#pragma unroll
        for (int m = 0; m < 4; ++m) { const int row = ai * HALF + wr * 64 + m * 16 + fr;
            if constexpr (Epi::PAIRED) {
#pragma unroll
                for (int n = 0; n < 2; ++n) E.st2(u, row, wc * 32 + n * 16 + 4 * fq, acc[ai][0][m][n], acc[ai][1][m][n]);
            } else {
#pragma unroll
                for (int bj = 0; bj < 2; ++bj)
#pragma unroll
                    for (int n = 0; n < 2; ++n) E.st(u, row, bj * HALF + wc * 32 + n * 16 + 4 * fq, acc[ai][bj][m][n]);
            } }
}

template <class Epi, class Sched, bool ALIGN_EPI = false, bool SP2 = false>
__device__ __forceinline__ void gemm_phase(PG8_LAS unsigned char* lds, const Gemm g, const Sched& S, const Epi& E) {
    const int tid = threadIdx.x, wid = __builtin_amdgcn_readfirstlane(tid >> 6), lane = tid & 63, wr = wid >> 2, wc = wid & 3, fr = lane & 15, fq = lane >> 4;
    const int K = g.K, nt = K / BK;
    unsigned voffA[2], voffB[2];
#pragma unroll
    for (int i = 0; i < 2; ++i) { int R, C; stage_rc(tid * 16 + i * 8192, R, C); const int rho = R & 31, Rb = (R & ~31) + 8 * ((rho & 15) >> 2) + 4 * (rho >> 4) + (rho & 3);
        voffA[i] = (unsigned)(R * K + C) * 2u; voffB[i] = (unsigned)(Rb * K + C) * 2u; }
    const size_t kstep = (size_t)(BK * 2);
    const size_t hstep = (size_t)HALF * K * 2;
    const size_t tstep = 2 * hstep;
    const unsigned ldsw = (unsigned)wid * 1024u;
    const int aoff = lds_byte(wr * 64 + fr, fq * 8), boff = lds_byte(wc * 32 + fr, fq * 8);
#define PG8_SA(b, h) (((b) * 2 + (h)) * HTB)
#define PG8_SB(b, h) ((4 + (b) * 2 + (h)) * HTB)
#define PG8_STAGE(bufoff, gbase, voff) do { _Pragma("unroll") for (int _i = 0; _i < 2; ++_i) \
        __builtin_amdgcn_global_load_lds((const unsigned*)((const char*)(gbase) + (voff)[_i]), (PG8_LAS unsigned*)(lds + (bufoff) + ldsw + _i * 8192), 16, 0, 0); } while (0)
#define PG8_LDA(dst, b, h) do { _Pragma("unroll") for (int m = 0; m < 4; ++m) _Pragma("unroll") for (int k = 0; k < 2; ++k) dst[m][k] = *(const PG8_LAS bf16x8*)(lds + PG8_SA(b, h) + aoff + m * 2048 + k * 1024); } while (0)
#define PG8_LDB(dst, b, h) do { _Pragma("unroll") for (int n = 0; n < 2; ++n) _Pragma("unroll") for (int k = 0; k < 2; ++k) dst[n][k] = *(const PG8_LAS bf16x8*)(lds + PG8_SB(b, h) + boff + n * 2048 + k * 1024); } while (0)
#define PG8_MMA(ai, bj, At, Bt) do { __builtin_amdgcn_s_setprio(1); _Pragma("unroll") for (int m = 0; m < 4; ++m) _Pragma("unroll") for (int n = 0; n < 2; ++n) _Pragma("unroll") for (int k = 0; k < 2; ++k) \
        acc[ai][bj][m][n] = __builtin_amdgcn_mfma_f32_16x16x32_bf16(Bt[n][k], At[m][k], acc[ai][bj][m][n], 0, 0, 0); __builtin_amdgcn_s_setprio(0); } while (0)
#define PG8_WAIT_V(n) asm volatile("s_waitcnt vmcnt(" #n ")" ::: "memory")
#define PG8_WAIT_L(n) asm volatile("s_waitcnt lgkmcnt(" #n ")" ::: "memory")
#define PG8_BAR __builtin_amdgcn_s_barrier()
#define PG8_SCHED __builtin_amdgcn_sched_barrier(0)
    Unit cur, nxt; int ui = 0;
    if (!S.next(0, cur)) return;
    f32x4 acc[2][2][4][2];
#pragma unroll
    for (int a = 0; a < 2; ++a)
#pragma unroll
        for (int b = 0; b < 2; ++b)
#pragma unroll
            for (int m = 0; m < 4; ++m)
#pragma unroll
                for (int n = 0; n < 2; ++n) acc[a][b][m][n] = (f32x4){0.f, 0.f, 0.f, 0.f};
    bf16x8 At[4][2], B0[2][2], B1[2][2];
    const char* cA = (const char*)g.A + (size_t)cur.pm * tstep; const char* cB = (const char*)g.Bt + (size_t)cur.pnB * tstep;

    if constexpr (SP2) {
        PG8_STAGE(PG8_SB(0, 0), cB, voffB); PG8_STAGE(PG8_SB(0, 1), cB + hstep, voffB); PG8_STAGE(PG8_SA(0, 0), cA, voffA); PG8_STAGE(PG8_SA(0, 1), cA + hstep, voffA);
        if (wr == 1) PG8_BAR;
        PG8_WAIT_V(2); PG8_BAR;
        PG8_STAGE(PG8_SB(1, 0), cB + kstep, voffB); PG8_STAGE(PG8_SA(1, 0), cA + kstep, voffA); PG8_STAGE(PG8_SB(1, 1), cB + hstep + kstep, voffB);
        PG8_WAIT_V(6); PG8_BAR;
    } else {
        PG8_STAGE(PG8_SB(0, 0), cB, voffB); PG8_STAGE(PG8_SA(0, 0), cA, voffA); PG8_STAGE(PG8_SB(0, 1), cB + hstep, voffB); PG8_STAGE(PG8_SA(0, 1), cA + hstep, voffA);
        if (wr == 1) PG8_BAR;
        PG8_WAIT_V(4); PG8_BAR;
        PG8_STAGE(PG8_SB(1, 0), cB + kstep, voffB); PG8_STAGE(PG8_SA(1, 0), cA + kstep, voffA); PG8_STAGE(PG8_SB(1, 1), cB + hstep + kstep, voffB);
        PG8_WAIT_V(6); PG8_BAR;
    }
    for (;;) {
        const bool has_next = S.next(ui + 1, nxt);
        const char* nA = has_next ? (const char*)g.A + (size_t)nxt.pm * tstep : cA; const char* nB = has_next ? (const char*)g.Bt + (size_t)nxt.pnB * tstep : cB;
        for (int t = 0; t < nt; t += 2) {
            const bool last = (t == nt - 2);
            const char* a1 = cA + (size_t)(t + 1) * kstep;
            const char* a2 = last ? nA : cA + (size_t)(t + 2) * kstep; const char* b2 = last ? nB : cB + (size_t)(t + 2) * kstep;
            const char* a3 = a2 + kstep; const char* b3 = b2 + kstep;

            if constexpr (SP2) {
            PG8_LDB(B0, 0, 0); PG8_LDB(B1, 0, 1); PG8_SCHED; PG8_LDA(At, 0, 0); PG8_STAGE(PG8_SA(1, 1), a1 + hstep, voffA);
            PG8_WAIT_V(8); PG8_WAIT_L(0); PG8_BAR; PG8_MMA(0, 0, At, B0); PG8_MMA(0, 1, At, B1); PG8_BAR; PG8_SCHED;
            PG8_LDA(At, 0, 1); PG8_STAGE(PG8_SB(0, 0), b2, voffB); PG8_STAGE(PG8_SB(0, 1), b2 + hstep, voffB); PG8_STAGE(PG8_SA(0, 0), a2, voffA);
            PG8_WAIT_V(8); PG8_WAIT_L(0); PG8_BAR; PG8_MMA(1, 0, At, B0); PG8_MMA(1, 1, At, B1); PG8_BAR; PG8_SCHED;
            PG8_LDB(B0, 1, 0); PG8_LDB(B1, 1, 1); PG8_SCHED; PG8_LDA(At, 1, 0); PG8_STAGE(PG8_SA(0, 1), a2 + hstep, voffA);
            PG8_WAIT_V(8); PG8_WAIT_L(0); PG8_BAR; PG8_MMA(0, 0, At, B0); PG8_MMA(0, 1, At, B1); PG8_BAR; PG8_SCHED;
            PG8_LDA(At, 1, 1); PG8_STAGE(PG8_SB(1, 0), b3, voffB); PG8_STAGE(PG8_SB(1, 1), b3 + hstep, voffB); PG8_STAGE(PG8_SA(1, 0), a3, voffA);
            PG8_WAIT_V(8); PG8_WAIT_L(0); PG8_BAR; PG8_MMA(1, 0, At, B0); PG8_MMA(1, 1, At, B1); PG8_BAR; PG8_SCHED;
            } else {
            PG8_LDB(B0, 0, 0); PG8_SCHED; PG8_LDA(At, 0, 0); PG8_STAGE(PG8_SA(1, 1), a1 + hstep, voffA);
            PG8_WAIT_L(8); PG8_BAR; PG8_WAIT_L(0); PG8_MMA(0, 0, At, B0); PG8_BAR; PG8_SCHED;
            PG8_LDB(B1, 0, 1); PG8_STAGE(PG8_SB(0, 0), b2, voffB);
            PG8_BAR; PG8_WAIT_L(0); PG8_MMA(0, 1, At, B1); PG8_BAR;
            PG8_LDA(At, 0, 1); PG8_STAGE(PG8_SA(0, 0), a2, voffA);
            PG8_BAR; PG8_WAIT_L(0); PG8_MMA(1, 0, At, B0); PG8_BAR; PG8_SCHED;
            PG8_STAGE(PG8_SB(0, 1), b2 + hstep, voffB);
            PG8_WAIT_V(6); PG8_BAR; PG8_MMA(1, 1, At, B1); PG8_BAR;
            PG8_LDB(B0, 1, 0); PG8_SCHED; PG8_LDA(At, 1, 0); PG8_STAGE(PG8_SA(0, 1), a2 + hstep, voffA);
            PG8_WAIT_L(8); PG8_BAR; PG8_WAIT_L(0); PG8_MMA(0, 0, At, B0); PG8_BAR; PG8_SCHED;
            PG8_LDB(B1, 1, 1); PG8_STAGE(PG8_SB(1, 0), b3, voffB);
            PG8_BAR; PG8_WAIT_L(0); PG8_MMA(0, 1, At, B1); PG8_BAR;
            PG8_LDA(At, 1, 1); PG8_STAGE(PG8_SA(1, 0), a3, voffA);
            PG8_BAR; PG8_WAIT_L(0); PG8_MMA(1, 0, At, B0); PG8_BAR; PG8_SCHED;
            PG8_STAGE(PG8_SB(1, 1), b3 + hstep, voffB);
            PG8_WAIT_V(6); PG8_BAR; PG8_MMA(1, 1, At, B1); PG8_BAR;
            }
        }
        if constexpr (ALIGN_EPI) { if (wr == 0) PG8_BAR; }
        if constexpr (!Epi::FUSED) run_epi8(E, acc, cur, wr, wc, fr, fq);
        if (!has_next) break;
#pragma unroll
        for (int a = 0; a < 2; ++a)
#pragma unroll
            for (int b = 0; b < 2; ++b)
#pragma unroll
                for (int m = 0; m < 4; ++m)
#pragma unroll
                    for (int n = 0; n < 2; ++n) acc[a][b][m][n] = (f32x4){0.f, 0.f, 0.f, 0.f};
        cur = nxt; cA = nA; cB = nB; ++ui;
        if constexpr (ALIGN_EPI) { if (wr == 1) PG8_BAR; }
    }
    PG8_WAIT_V(0);
    if constexpr (!ALIGN_EPI) { if (wr == 0) PG8_BAR; }
    PG8_BAR;
    if constexpr (Epi::FUSED) E.fused(acc, cur, wr, wc, fr, fq, lds, wid, lane);

#undef PG8_SA
#undef PG8_SB
#undef PG8_STAGE
#undef PG8_LDA
#undef PG8_LDB
#undef PG8_MMA
#undef PG8_WAIT_V
#undef PG8_WAIT_L
#undef PG8_BAR
#undef PG8_SCHED
}

template <class Epi, class Sched, bool ALIGN_EPI = false, bool SP2 = false>
__device__ __forceinline__ void gemm_phase_f8(PG8_LAS unsigned char* lds, const Gemm g, const Sched& S, const Epi& E) {
    const int tid = threadIdx.x, wid = __builtin_amdgcn_readfirstlane(tid >> 6), lane = tid & 63, wr = wid >> 2, wc = wid & 3, fr = lane & 15, fq = lane >> 4;
    const int RP = g.K, nt = RP / 128;
    unsigned voffA[2], voffB[2];
#pragma unroll
    for (int i = 0; i < 2; ++i) { const int b_ = tid * 16 + i * 8192, R = b_ >> 7, pp = (b_ >> 4) & 7, rr_ = R & 15, ff = ((rr_ >> 1) & 1) | (((rr_ >> 3) & 1) << 2);
        const int rho = R & 31, Rb = (R & ~31) + 8 * ((rho & 15) >> 2) + 4 * (rho >> 4) + (rho & 3);
        voffA[i] = (unsigned)(R * RP + ((pp ^ ff) * 16)); voffB[i] = (unsigned)(Rb * RP + ((pp ^ ff) * 16)); }
    const size_t kstep = (size_t)(BK * 2);
    const size_t hstep = (size_t)HALF * RP;
    const size_t tstep = 2 * hstep;
    const unsigned ldsw = (unsigned)wid * 1024u;
    const int ffr = ((fr >> 1) & 1) | (((fr >> 3) & 1) << 2);
    const int aoff = (wr * 64 + fr) * 128 + (((2 * fq) ^ ffr) * 16), boff = (wc * 32 + fr) * 128 + (((2 * fq) ^ ffr) * 16), hoff = (ffr & 1) ? -16 : 16;
#define PG8_SA(b, h) (((b) * 2 + (h)) * HTB)
#define PG8_SB(b, h) ((4 + (b) * 2 + (h)) * HTB)
#define PG8_STAGE(bufoff, gbase, voff) do { _Pragma("unroll") for (int _i = 0; _i < 2; ++_i) \
        __builtin_amdgcn_global_load_lds((const unsigned*)((const char*)(gbase) + (voff)[_i]), (PG8_LAS unsigned*)(lds + (bufoff) + ldsw + _i * 8192), 16, 0, 0); } while (0)
#define PG8_LDA(dst, b, h) do { _Pragma("unroll") for (int m = 0; m < 4; ++m) { dst[m].lo = *(const PG8_LAS v4i_t*)(lds + PG8_SA(b, h) + aoff + m * 2048); dst[m].hi = *(const PG8_LAS v4i_t*)(lds + PG8_SA(b, h) + aoff + m * 2048 + hoff); } } while (0)
#define PG8_LDB(dst, b, h) do { _Pragma("unroll") for (int n = 0; n < 2; ++n) { dst[n].lo = *(const PG8_LAS v4i_t*)(lds + PG8_SB(b, h) + boff + n * 2048); dst[n].hi = *(const PG8_LAS v4i_t*)(lds + PG8_SB(b, h) + boff + n * 2048 + hoff); } } while (0)
#define PG8_MMA(ai, bj, At, Bt) do { __builtin_amdgcn_s_setprio(1); _Pragma("unroll") for (int m = 0; m < 4; ++m) _Pragma("unroll") for (int n = 0; n < 2; ++n) \
        asm volatile("v_mfma_f32_16x16x128_f8f6f4 %0, %1, %2, %0" : "+v"(acc[ai][bj][m][n]) : "v"(Bt[n]), "v"(At[m])); __builtin_amdgcn_s_setprio(0); } while (0)
#define PG8_WAIT_V(n) asm volatile("s_waitcnt vmcnt(" #n ")" ::: "memory")
#define PG8_WAIT_L(n) asm volatile("s_waitcnt lgkmcnt(" #n ")" ::: "memory")
#define PG8_BAR __builtin_amdgcn_s_barrier()
#define PG8_SCHED __builtin_amdgcn_sched_barrier(0)
    Unit cur, nxt; int ui = 0;
    if (!S.next(0, cur)) return;
    f32x4 acc[2][2][4][2];
#pragma unroll
    for (int a = 0; a < 2; ++a)
#pragma unroll
        for (int b = 0; b < 2; ++b)
#pragma unroll
            for (int m = 0; m < 4; ++m)
#pragma unroll
                for (int n = 0; n < 2; ++n) acc[a][b][m][n] = (f32x4){0.f, 0.f, 0.f, 0.f};
    v8i_t At[4], B0[2], B1[2];
    const char* cA = (const char*)g.A + (size_t)cur.pm * tstep; const char* cB = (const char*)g.Bt + (size_t)cur.pnB * tstep;

    if constexpr (SP2) {
        PG8_STAGE(PG8_SB(0, 0), cB, voffB); PG8_STAGE(PG8_SB(0, 1), cB + hstep, voffB); PG8_STAGE(PG8_SA(0, 0), cA, voffA); PG8_STAGE(PG8_SA(0, 1), cA + hstep, voffA);
        if (wr == 1) PG8_BAR;
        PG8_WAIT_V(2); PG8_BAR;
        PG8_STAGE(PG8_SB(1, 0), cB + kstep, voffB); PG8_STAGE(PG8_SA(1, 0), cA + kstep, voffA); PG8_STAGE(PG8_SB(1, 1), cB + hstep + kstep, voffB);
        PG8_WAIT_V(6); PG8_BAR;
    } else {
        PG8_STAGE(PG8_SB(0, 0), cB, voffB); PG8_STAGE(PG8_SA(0, 0), cA, voffA); PG8_STAGE(PG8_SB(0, 1), cB + hstep, voffB); PG8_STAGE(PG8_SA(0, 1), cA + hstep, voffA);
        if (wr == 1) PG8_BAR;
        PG8_WAIT_V(4); PG8_BAR;
        PG8_STAGE(PG8_SB(1, 0), cB + kstep, voffB); PG8_STAGE(PG8_SA(1, 0), cA + kstep, voffA); PG8_STAGE(PG8_SB(1, 1), cB + hstep + kstep, voffB);
        PG8_WAIT_V(6); PG8_BAR;
    }
    for (;;) {
        const bool has_next = S.next(ui + 1, nxt);
        const char* nA = has_next ? (const char*)g.A + (size_t)nxt.pm * tstep : cA; const char* nB = has_next ? (const char*)g.Bt + (size_t)nxt.pnB * tstep : cB;
        for (int t = 0; t < nt; t += 2) {
            const bool last = (t == nt - 2);
            const char* a1 = cA + (size_t)(t + 1) * kstep;
            const char* a2 = last ? nA : cA + (size_t)(t + 2) * kstep; const char* b2 = last ? nB : cB + (size_t)(t + 2) * kstep;
            const char* a3 = a2 + kstep; const char* b3 = b2 + kstep;

            if constexpr (SP2) {
            PG8_LDB(B0, 0, 0); PG8_LDB(B1, 0, 1); PG8_SCHED; PG8_LDA(At, 0, 0); PG8_STAGE(PG8_SA(1, 1), a1 + hstep, voffA);
            PG8_WAIT_V(8); PG8_WAIT_L(0); PG8_BAR; PG8_MMA(0, 0, At, B0); PG8_MMA(0, 1, At, B1); PG8_BAR; PG8_SCHED;
            PG8_LDA(At, 0, 1); PG8_STAGE(PG8_SB(0, 0), b2, voffB); PG8_STAGE(PG8_SB(0, 1), b2 + hstep, voffB); PG8_STAGE(PG8_SA(0, 0), a2, voffA);
            PG8_WAIT_V(8); PG8_WAIT_L(0); PG8_BAR; PG8_MMA(1, 0, At, B0); PG8_MMA(1, 1, At, B1); PG8_BAR; PG8_SCHED;
            PG8_LDB(B0, 1, 0); PG8_LDB(B1, 1, 1); PG8_SCHED; PG8_LDA(At, 1, 0); PG8_STAGE(PG8_SA(0, 1), a2 + hstep, voffA);
            PG8_WAIT_V(8); PG8_WAIT_L(0); PG8_BAR; PG8_MMA(0, 0, At, B0); PG8_MMA(0, 1, At, B1); PG8_BAR; PG8_SCHED;
            PG8_LDA(At, 1, 1); PG8_STAGE(PG8_SB(1, 0), b3, voffB); PG8_STAGE(PG8_SB(1, 1), b3 + hstep, voffB); PG8_STAGE(PG8_SA(1, 0), a3, voffA);
            PG8_WAIT_V(8); PG8_WAIT_L(0); PG8_BAR; PG8_MMA(1, 0, At, B0); PG8_MMA(1, 1, At, B1); PG8_BAR; PG8_SCHED;
            } else {
            PG8_LDB(B0, 0, 0); PG8_SCHED; PG8_LDA(At, 0, 0); PG8_STAGE(PG8_SA(1, 1), a1 + hstep, voffA);
            PG8_WAIT_L(8); PG8_BAR; PG8_WAIT_L(0); PG8_MMA(0, 0, At, B0); PG8_BAR; PG8_SCHED;
            PG8_LDB(B1, 0, 1); PG8_STAGE(PG8_SB(0, 0), b2, voffB);
            PG8_BAR; PG8_WAIT_L(0); PG8_MMA(0, 1, At, B1); PG8_BAR;
            PG8_LDA(At, 0, 1); PG8_STAGE(PG8_SA(0, 0), a2, voffA);
            PG8_BAR; PG8_WAIT_L(0); PG8_MMA(1, 0, At, B0); PG8_BAR; PG8_SCHED;
            PG8_STAGE(PG8_SB(0, 1), b2 + hstep, voffB);
            PG8_WAIT_V(6); PG8_BAR; PG8_MMA(1, 1, At, B1); PG8_BAR;
            PG8_LDB(B0, 1, 0); PG8_SCHED; PG8_LDA(At, 1, 0); PG8_STAGE(PG8_SA(0, 1), a2 + hstep, voffA);
            PG8_WAIT_L(8); PG8_BAR; PG8_WAIT_L(0); PG8_MMA(0, 0, At, B0); PG8_BAR; PG8_SCHED;
            PG8_LDB(B1, 1, 1); PG8_STAGE(PG8_SB(1, 0), b3, voffB);
            PG8_BAR; PG8_WAIT_L(0); PG8_MMA(0, 1, At, B1); PG8_BAR;
            PG8_LDA(At, 1, 1); PG8_STAGE(PG8_SA(1, 0), a3, voffA);
            PG8_BAR; PG8_WAIT_L(0); PG8_MMA(1, 0, At, B0); PG8_BAR; PG8_SCHED;
            PG8_STAGE(PG8_SB(1, 1), b3 + hstep, voffB);
            PG8_WAIT_V(6); PG8_BAR; PG8_MMA(1, 1, At, B1); PG8_BAR;
            }
        }
        asm volatile("s_nop 15\n\ts_nop 15" ::: "memory");
        if constexpr (ALIGN_EPI) { if (wr == 0) PG8_BAR; }
        run_epi8(E, acc, cur, wr, wc, fr, fq);
        if (!has_next) break;
#pragma unroll
        for (int a = 0; a < 2; ++a)
#pragma unroll
            for (int b = 0; b < 2; ++b)
#pragma unroll
                for (int m = 0; m < 4; ++m)
#pragma unroll
                    for (int n = 0; n < 2; ++n) acc[a][b][m][n] = (f32x4){0.f, 0.f, 0.f, 0.f};
        cur = nxt; cA = nA; cB = nB; ++ui;
        if constexpr (ALIGN_EPI) { if (wr == 1) PG8_BAR; }
    }
    PG8_WAIT_V(0);
    if constexpr (!ALIGN_EPI) { if (wr == 0) PG8_BAR; }
    PG8_BAR;

#undef PG8_SA
#undef PG8_SB
#undef PG8_STAGE
#undef PG8_LDA
#undef PG8_LDB
#undef PG8_MMA
#undef PG8_WAIT_V
#undef PG8_WAIT_L
#undef PG8_BAR
#undef PG8_SCHED
}

template <class Epi, class Sched, bool ALIGN_EPI = false, bool SP2 = false>
__device__ __forceinline__ void gemm_phase_f8g(PG8_LAS unsigned char* lds, const Gemm g, const Sched& S, const Epi& E, const int* tok) {
    const int tid = threadIdx.x, wid = __builtin_amdgcn_readfirstlane(tid >> 6), lane = tid & 63, wr = wid >> 2, wc = wid & 3, fr = lane & 15, fq = lane >> 4;
    const int RP = g.K, nt = RP / 128;
    unsigned voffA[2], voffB[2]; int rowA[2];
#pragma unroll
    for (int i = 0; i < 2; ++i) { const int b_ = tid * 16 + i * 8192, R = b_ >> 7, pp = (b_ >> 4) & 7, rr_ = R & 15, ff = ((rr_ >> 1) & 1) | (((rr_ >> 3) & 1) << 2);
        const int rho = R & 31, Rb = (R & ~31) + 8 * ((rho & 15) >> 2) + 4 * (rho >> 4) + (rho & 3);
        voffA[i] = (unsigned)((pp ^ ff) * 16); rowA[i] = R; voffB[i] = (unsigned)(Rb * RP + ((pp ^ ff) * 16)); }
    const size_t kstep = (size_t)(BK * 2);
    const size_t hstep = (size_t)HALF * RP;
    const size_t tstep = 2 * hstep;
    const unsigned ldsw = (unsigned)wid * 1024u;
    const int ffr = ((fr >> 1) & 1) | (((fr >> 3) & 1) << 2);
    const int aoff = (wr * 64 + fr) * 128 + (((2 * fq) ^ ffr) * 16), boff = (wc * 32 + fr) * 128 + (((2 * fq) ^ ffr) * 16), hoff = (ffr & 1) ? -16 : 16;
#define PG8_SA(b, h) (((b) * 2 + (h)) * HTB)
#define PG8_SB(b, h) ((4 + (b) * 2 + (h)) * HTB)
#define PG8_STAGE(bufoff, gbase, voff) do { _Pragma("unroll") for (int _i = 0; _i < 2; ++_i) \
        __builtin_amdgcn_global_load_lds((const unsigned*)((const char*)(gbase) + (voff)[_i]), (PG8_LAS unsigned*)(lds + (bufoff) + ldsw + _i * 8192), 16, 0, 0); } while (0)
#define PG8_LDA(dst, b, h) do { _Pragma("unroll") for (int m = 0; m < 4; ++m) { dst[m].lo = *(const PG8_LAS v4i_t*)(lds + PG8_SA(b, h) + aoff + m * 2048); dst[m].hi = *(const PG8_LAS v4i_t*)(lds + PG8_SA(b, h) + aoff + m * 2048 + hoff); } } while (0)
#define PG8_LDB(dst, b, h) do { _Pragma("unroll") for (int n = 0; n < 2; ++n) { dst[n].lo = *(const PG8_LAS v4i_t*)(lds + PG8_SB(b, h) + boff + n * 2048); dst[n].hi = *(const PG8_LAS v4i_t*)(lds + PG8_SB(b, h) + boff + n * 2048 + hoff); } } while (0)
#define PG8_MMA(ai, bj, At, Bt) do { __builtin_amdgcn_s_setprio(1); _Pragma("unroll") for (int m = 0; m < 4; ++m) _Pragma("unroll") for (int n = 0; n < 2; ++n) \
        asm volatile("v_mfma_f32_16x16x128_f8f6f4 %0, %1, %2, %0" : "+v"(acc[ai][bj][m][n]) : "v"(Bt[n]), "v"(At[m])); __builtin_amdgcn_s_setprio(0); } while (0)
#define PG8_WAIT_V(n) asm volatile("s_waitcnt vmcnt(" #n ")" ::: "memory")
#define PG8_WAIT_L(n) asm volatile("s_waitcnt lgkmcnt(" #n ")" ::: "memory")
#define PG8_BAR __builtin_amdgcn_s_barrier()
#define PG8_SCHED __builtin_amdgcn_sched_barrier(0)
    Unit cur, nxt; int ui = 0;
    if (!S.next(0, cur)) return;
    f32x4 acc[2][2][4][2];
#pragma unroll
    for (int a = 0; a < 2; ++a)
#pragma unroll
        for (int b = 0; b < 2; ++b)
#pragma unroll
            for (int m = 0; m < 4; ++m)
#pragma unroll
                for (int n = 0; n < 2; ++n) acc[a][b][m][n] = (f32x4){0.f, 0.f, 0.f, 0.f};
    v8i_t At[4], B0[2], B1[2];
    const char* cA = (const char*)g.A; const char* cB = (const char*)g.Bt + (size_t)cur.pnB * tstep;
    unsigned vC[2][2], vN[2][2] = {{0u, 0u}, {0u, 0u}};
#define PG8_TOKOFF(dst, pm_) do { _Pragma("unroll") for (int h_ = 0; h_ < 2; ++h_) _Pragma("unroll") for (int i_ = 0; i_ < 2; ++i_) dst[h_][i_] = (unsigned)tok[(pm_) * 256 + h_ * 128 + rowA[i_]] * (unsigned)RP + voffA[i_]; } while (0)
    PG8_TOKOFF(vC, cur.pm);

    if constexpr (SP2) {
        PG8_STAGE(PG8_SB(0, 0), cB, voffB); PG8_STAGE(PG8_SB(0, 1), cB + hstep, voffB); PG8_STAGE(PG8_SA(0, 0), cA, vC[0]); PG8_STAGE(PG8_SA(0, 1), cA, vC[1]);
        if (wr == 1) PG8_BAR;
        PG8_WAIT_V(2); PG8_BAR;
        PG8_STAGE(PG8_SB(1, 0), cB + kstep, voffB); PG8_STAGE(PG8_SA(1, 0), cA + kstep, vC[0]); PG8_STAGE(PG8_SB(1, 1), cB + hstep + kstep, voffB);
        PG8_WAIT_V(6); PG8_BAR;
    } else {
        PG8_STAGE(PG8_SB(0, 0), cB, voffB); PG8_STAGE(PG8_SA(0, 0), cA, vC[0]); PG8_STAGE(PG8_SB(0, 1), cB + hstep, voffB); PG8_STAGE(PG8_SA(0, 1), cA, vC[1]);
        if (wr == 1) PG8_BAR;
        PG8_WAIT_V(4); PG8_BAR;
        PG8_STAGE(PG8_SB(1, 0), cB + kstep, voffB); PG8_STAGE(PG8_SA(1, 0), cA + kstep, vC[0]); PG8_STAGE(PG8_SB(1, 1), cB + hstep + kstep, voffB);
        PG8_WAIT_V(6); PG8_BAR;
    }
    for (;;) {
        const bool has_next = S.next(ui + 1, nxt);
        const char* nB = has_next ? (const char*)g.Bt + (size_t)nxt.pnB * tstep : cB;
        int tkN[2][2] = {{0, 0}, {0, 0}};
        if (has_next) { _Pragma("unroll") for (int h_ = 0; h_ < 2; ++h_) _Pragma("unroll") for (int i_ = 0; i_ < 2; ++i_) tkN[h_][i_] = tok[nxt.pm * 256 + h_ * 128 + rowA[i_]]; }
        for (int t = 0; t < nt; t += 2) {
            const bool last = (t == nt - 2);
            const char* a1 = cA + (size_t)(t + 1) * kstep;
            const char* a2 = last ? cA : cA + (size_t)(t + 2) * kstep; const char* b2 = last ? nB : cB + (size_t)(t + 2) * kstep;
            unsigned vs0[2] = {vC[0][0], vC[0][1]}, vs1[2] = {vC[1][0], vC[1][1]};
            if (last && has_next) { asm volatile("" : "+v"(tkN[0][0]), "+v"(tkN[0][1]), "+v"(tkN[1][0]), "+v"(tkN[1][1]));
                _Pragma("unroll") for (int h_ = 0; h_ < 2; ++h_) _Pragma("unroll") for (int i_ = 0; i_ < 2; ++i_) vN[h_][i_] = (unsigned)tkN[h_][i_] * (unsigned)RP + voffA[i_];
                vs0[0] = vN[0][0]; vs0[1] = vN[0][1]; vs1[0] = vN[1][0]; vs1[1] = vN[1][1]; }
            const char* a3 = a2 + kstep; const char* b3 = b2 + kstep;

            if constexpr (SP2) {
            PG8_LDB(B0, 0, 0); PG8_LDB(B1, 0, 1); PG8_SCHED; PG8_LDA(At, 0, 0); PG8_STAGE(PG8_SA(1, 1), a1, vC[1]);
            PG8_WAIT_V(8); PG8_WAIT_L(0); PG8_BAR; PG8_MMA(0, 0, At, B0); PG8_MMA(0, 1, At, B1); PG8_BAR; PG8_SCHED;
            PG8_LDA(At, 0, 1); PG8_STAGE(PG8_SB(0, 0), b2, voffB); PG8_STAGE(PG8_SB(0, 1), b2 + hstep, voffB); PG8_STAGE(PG8_SA(0, 0), a2, vs0);
            PG8_WAIT_V(8); PG8_WAIT_L(0); PG8_BAR; PG8_MMA(1, 0, At, B0); PG8_MMA(1, 1, At, B1); PG8_BAR; PG8_SCHED;
            PG8_LDB(B0, 1, 0); PG8_LDB(B1, 1, 1); PG8_SCHED; PG8_LDA(At, 1, 0); PG8_STAGE(PG8_SA(0, 1), a2, vs1);
            PG8_WAIT_V(8); PG8_WAIT_L(0); PG8_BAR; PG8_MMA(0, 0, At, B0); PG8_MMA(0, 1, At, B1); PG8_BAR; PG8_SCHED;
            PG8_LDA(At, 1, 1); PG8_STAGE(PG8_SB(1, 0), b3, voffB); PG8_STAGE(PG8_SB(1, 1), b3 + hstep, voffB); PG8_STAGE(PG8_SA(1, 0), a3, vs0);
            PG8_WAIT_V(8); PG8_WAIT_L(0); PG8_BAR; PG8_MMA(1, 0, At, B0); PG8_MMA(1, 1, At, B1); PG8_BAR; PG8_SCHED;
            } else {
            PG8_LDB(B0, 0, 0); PG8_SCHED; PG8_LDA(At, 0, 0); PG8_STAGE(PG8_SA(1, 1), a1, vC[1]);
            PG8_WAIT_L(8); PG8_BAR; PG8_WAIT_L(0); PG8_MMA(0, 0, At, B0); PG8_BAR; PG8_SCHED;
            PG8_LDB(B1, 0, 1); PG8_STAGE(PG8_SB(0, 0), b2, voffB);
            PG8_BAR; PG8_WAIT_L(0); PG8_MMA(0, 1, At, B1); PG8_BAR;
            PG8_LDA(At, 0, 1); PG8_STAGE(PG8_SA(0, 0), a2, vs0);
            PG8_BAR; PG8_WAIT_L(0); PG8_MMA(1, 0, At, B0); PG8_BAR; PG8_SCHED;
            PG8_STAGE(PG8_SB(0, 1), b2 + hstep, voffB);
            PG8_WAIT_V(6); PG8_BAR; PG8_MMA(1, 1, At, B1); PG8_BAR;
            PG8_LDB(B0, 1, 0); PG8_SCHED; PG8_LDA(At, 1, 0); PG8_STAGE(PG8_SA(0, 1), a2, vs1);
            PG8_WAIT_L(8); PG8_BAR; PG8_WAIT_L(0); PG8_MMA(0, 0, At, B0); PG8_BAR; PG8_SCHED;
            PG8_LDB(B1, 1, 1); PG8_STAGE(PG8_SB(1, 0), b3, voffB);
            PG8_BAR; PG8_WAIT_L(0); PG8_MMA(0, 1, At, B1); PG8_BAR;
            PG8_LDA(At, 1, 1); PG8_STAGE(PG8_SA(1, 0), a3, vs0);
            PG8_BAR; PG8_WAIT_L(0); PG8_MMA(1, 0, At, B0); PG8_BAR; PG8_SCHED;
            PG8_STAGE(PG8_SB(1, 1), b3 + hstep, voffB);
            PG8_WAIT_V(6); PG8_BAR; PG8_MMA(1, 1, At, B1); PG8_BAR;
            }
        }
        asm volatile("s_nop 15\n\ts_nop 15" ::: "memory");
        if constexpr (ALIGN_EPI) { if (wr == 0) PG8_BAR; }
        run_epi8(E, acc, cur, wr, wc, fr, fq);
        if (!has_next) break;
#pragma unroll
        for (int a = 0; a < 2; ++a)
#pragma unroll
            for (int b = 0; b < 2; ++b)
#pragma unroll
                for (int m = 0; m < 4; ++m)
#pragma unroll
                    for (int n = 0; n < 2; ++n) acc[a][b][m][n] = (f32x4){0.f, 0.f, 0.f, 0.f};
        cur = nxt; cB = nB; ++ui; vC[0][0] = vN[0][0]; vC[0][1] = vN[0][1]; vC[1][0] = vN[1][0]; vC[1][1] = vN[1][1];
        if constexpr (ALIGN_EPI) { if (wr == 1) PG8_BAR; }
    }
    PG8_WAIT_V(0);
    if constexpr (!ALIGN_EPI) { if (wr == 0) PG8_BAR; }
    PG8_BAR;

#undef PG8_TOKOFF
#undef PG8_SA
#undef PG8_SB
#undef PG8_STAGE
#undef PG8_LDA
#undef PG8_LDB
#undef PG8_MMA
#undef PG8_WAIT_V
#undef PG8_WAIT_L
#undef PG8_BAR
#undef PG8_SCHED
}
}

constexpr int D = 1024, BATCH = 8, SEQ = 2048, CTXL = 256;
constexpr int M = BATCH * SEQ;
constexpr int MC = BATCH * CTXL;
constexpr int MT = M + MC;
constexpr int DIN = 2048, DSGU = 512, DLRU = 512, NE = 16, CAP = 256, DE = 2048, NMOD = 6 * D;
constexpr int NSEG = 36;
constexpr float EPS = 1e-6f;
constexpr int NWAVES = 8, NTHREADS = 512;
constexpr int LDS_BYTES = 147456;
constexpr int NPH = 11;

constexpr size_t MiB = 1u << 20;
constexpr size_t WS_CTL = 0;
constexpr size_t WS_MOD = 1 * MiB;
constexpr size_t WS_SUM = 1 * MiB + 512 * 1024;
constexpr size_t WS_AFF = 4 * MiB;
constexpr size_t WS_SLOT = 5 * MiB;
constexpr size_t WS_GATE = 6 * MiB;
constexpr size_t WS_TOK = 6 * MiB + 128 * 1024;
constexpr size_t WS_GWT = 6 * MiB + 512 * 1024;
constexpr size_t WS_SWB = 7 * MiB;
constexpr size_t WS_WIN = 8 * MiB;
constexpr size_t WS_WOUT = 12 * MiB;
constexpr size_t WS_WG = 14 * MiB;
constexpr size_t WS_W2 = 142 * MiB;
constexpr size_t WS_X1 = 206 * MiB;
constexpr size_t WS_HS = 206 * MiB, WS_PF = 222 * MiB, WS_PB = 238 * MiB;
constexpr size_t WS_HX2 = 270 * MiB;
constexpr size_t WS_XCH = 286 * MiB;
constexpr size_t WS_CB = 1 * MiB + 256 * 1024;
constexpr size_t WS_XE = 302 * MiB;
constexpr size_t WS_A2 = 302 * MiB, WS_YE = 302 * MiB;
constexpr size_t WS_HID = 366 * MiB;
constexpr size_t WS_HX = 366 * MiB;
constexpr size_t WS_UV = 402 * MiB;
constexpr size_t WS_XC = 466 * MiB;
constexpr size_t WS_END = 494 * MiB;

#define GAS __attribute__((address_space(1)))
#define LAS __attribute__((address_space(3)))
typedef unsigned short bf16;
typedef unsigned v4u __attribute__((ext_vector_type(4)));
typedef unsigned v2u __attribute__((ext_vector_type(2)));
typedef float f32x4 __attribute__((ext_vector_type(4)));
typedef short bf16x8 __attribute__((ext_vector_type(8)));
#define LDS_WAIT() asm volatile("s_waitcnt lgkmcnt(0)" ::: "memory")

__device__ __forceinline__ float bf2f(bf16 b) { return __uint_as_float(((unsigned)b) << 16); }
__device__ __forceinline__ unsigned f2bf(float f) { unsigned u = __float_as_uint(f); return (u + 0x7fffu + ((u >> 16) & 1u)) >> 16; }
typedef __bf16 bf16x2_hw __attribute__((ext_vector_type(2)));
typedef float f32x2_hw __attribute__((ext_vector_type(2)));
__device__ __forceinline__ unsigned pk2(float lo, float hi) { const f32x2_hw v = {lo, hi}; return __builtin_bit_cast(unsigned, __builtin_convertvector(v, bf16x2_hw)); }
__device__ __forceinline__ float bflo(unsigned w) { return __uint_as_float(w << 16); }
__device__ __forceinline__ float bfhi(unsigned w) { return __uint_as_float(w & 0xffff0000u); }
__device__ __forceinline__ float rcpf_(float x) { return __builtin_amdgcn_rcpf(x); }
__device__ __forceinline__ float exp2f_(float x) { return __builtin_amdgcn_exp2f(x); }
__device__ __forceinline__ float sigmoidf_(float x) { return rcpf_(1.f + exp2f_(-1.4426950408889634f * x)); }
__device__ __forceinline__ float siluf_(float x) { return x * rcpf_(1.f + exp2f_(-1.4426950408889634f * x)); }
__device__ __forceinline__ float geluf_(float x) { const float u = x * (0.7978845608028654f + 0.035677408136300125f * x * x); return x * rcpf_(1.f + exp2f_(-2.8853900817779268f * u)); }
__device__ __forceinline__ void decay_pair(float la, float& a, float& s) {
    const float x = 2.f * la;
    const float p1 = la * (1.f + la * (0.5f + la * (0.16666667f + la * (0.041666668f + la * 0.0083333333f))));
    const float p2 = x * (1.f + x * (0.5f + x * (0.16666667f + x * (0.041666668f + x * (0.0083333333f + x * 0.0013888889f)))));
    const float e1 = exp2f_(1.4426950408889634f * la);
    const bool small = la > -0.15f;
    a = small ? 1.f + p1 : e1;
    s = __builtin_amdgcn_sqrtf(small ? -p2 : 1.f - e1 * e1);
}
typedef float f32x2p __attribute__((ext_vector_type(2)));
__device__ __forceinline__ f32x2p sigmoid2_(f32x2p x) { const f32x2p t = x * -1.4426950408889634f; f32x2p e; e.x = exp2f_(t.x); e.y = exp2f_(t.y); e = e + 1.f; f32x2p r; r.x = rcpf_(e.x); r.y = rcpf_(e.y); return r; }
__device__ __forceinline__ f32x2p gelu2_(f32x2p x) { const f32x2p u = x * (x * x * 0.035677408136300125f + 0.7978845608028654f), t = u * -2.8853900817779268f; f32x2p e; e.x = exp2f_(t.x); e.y = exp2f_(t.y); e = e + 1.f;
    f32x2p r; r.x = rcpf_(e.x); r.y = rcpf_(e.y); return x * r; }
__device__ __forceinline__ void decay_pair2(f32x2p la, f32x2p& a, f32x2p& s) {
    const f32x2p x = la * 2.f;
    const f32x2p p1 = la * (la * (la * (la * (la * 0.0083333333f + 0.041666668f) + 0.16666667f) + 0.5f) + 1.f);
    const f32x2p p2 = x * (x * (x * (x * (x * (x * 0.0013888889f + 0.0083333333f) + 0.041666668f) + 0.16666667f) + 0.5f) + 1.f);
    const f32x2p tt = la * 1.4426950408889634f; f32x2p e1; e1.x = exp2f_(tt.x); e1.y = exp2f_(tt.y);
    const f32x2p big = 1.f - e1 * e1, one = p1 + 1.f;
    a.x = la.x > -0.15f ? one.x : e1.x; a.y = la.y > -0.15f ? one.y : e1.y;
    s.x = __builtin_amdgcn_sqrtf(la.x > -0.15f ? -p2.x : big.x); s.y = __builtin_amdgcn_sqrtf(la.y > -0.15f ? -p2.y : big.y);
}
__device__ __forceinline__ unsigned pk4_fp8(float a, float b, float c, float d) {
    unsigned w = 0u; w = __builtin_amdgcn_cvt_pk_fp8_f32(a, b, w, false); w = __builtin_amdgcn_cvt_pk_fp8_f32(c, d, w, true); return w; }
constexpr float WSCALE = 32.f, WSCALE_INV = 1.f / 32.f;
__device__ __forceinline__ float wave_sum(float v) {
#pragma unroll
    for (int o = 1; o < 64; o <<= 1) v += __shfl_xor(v, o);
    return v;
}


#define XB_TMO      128
#define XB_XCNT(j)  (256  + 64 * (j))
#define XB_XSUB(j)  (1280 + 64 * (j))
#define XB_XGEN(j)  (2304 + 64 * (j))
#define XB_TOP      3328
#define XB_TOPGEN   3392
#define XCD_BAR_WORDS 3456
#define XB_SPIN_CAP (1u << 18)
__device__ __forceinline__ unsigned xb_ld(unsigned* p)              { return __hip_atomic_load(p, __ATOMIC_RELAXED, __HIP_MEMORY_SCOPE_AGENT); }
__device__ __forceinline__ unsigned xb_add(unsigned* p, unsigned v) { return __hip_atomic_fetch_add(p, v, __ATOMIC_RELAXED, __HIP_MEMORY_SCOPE_AGENT); }
__device__ __forceinline__ unsigned xb_xcc_id() { return (unsigned)__builtin_amdgcn_s_getreg((3 << 11) | 20) & 0xFu; }
#define XB_SPIN(cond, bar) do { unsigned _sp = 0; while (cond) { __builtin_amdgcn_s_sleep(1); \
    if ((++_sp & 255u) == 0u) { if (xb_ld(&(bar)[XB_TMO])) break; if (_sp > XB_SPIN_CAP) { atomicAdd(&(bar)[XB_TMO], 1u); break; } } } } while (0)
struct XcdBarrier { unsigned* bar; unsigned x; volatile LAS unsigned* st; unsigned total; };
__device__ __forceinline__ XcdBarrier xcd_barrier_post(unsigned* bar, volatile LAS unsigned* st, unsigned total) {
    XcdBarrier b; b.bar = bar; b.x = xb_xcc_id(); b.st = st; b.total = total;
    if (threadIdx.x == 0) (void)xb_add(&bar[XB_XCNT(b.x)], 1u);
    return b;
}
__device__ __forceinline__ void xcd_barrier_complete(unsigned* bar, unsigned x, unsigned G, unsigned& nloc, unsigned& nx) {
    unsigned sum, cnt, mine, sp = 0u;
    for (;;) {
        sum = 0u; cnt = 0u; mine = 0u;
#pragma unroll
        for (unsigned j = 0; j < 16; ++j) { const unsigned c = xb_ld(&bar[XB_XCNT(j)]); sum += c; cnt += (c > 0u) ? 1u : 0u; mine = (j == x) ? c : mine; }
        if (sum == G) break;
        __builtin_amdgcn_s_sleep(1);
        if ((++sp & 255u) == 0u) { if (xb_ld(&bar[XB_TMO])) break; if (sp > XB_SPIN_CAP) { atomicAdd(&bar[XB_TMO], 1u); break; } }
    }
    nloc = mine > 0u ? mine : 1u; nx = cnt > 0u ? cnt : 1u;
}
__device__ __forceinline__ void xcd_barrier(const XcdBarrier& b) {
    asm volatile("s_waitcnt vmcnt(0)" ::: "memory");
    __syncthreads();
    if (threadIdx.x == 0) {
        unsigned* bar = b.bar;
        __builtin_amdgcn_s_waitcnt(0);
        unsigned nloc = b.st[0], nx = b.st[1];
        if (nloc == 0u) { xcd_barrier_complete(bar, b.x, b.total, nloc, nx); b.st[0] = nloc; b.st[1] = nx; }
        const unsigned old = xb_add(&bar[XB_XSUB(b.x)], 1u);
        const unsigned gen = old / nloc;
        if (old + 1u == (gen + 1u) * nloc) {
            __builtin_amdgcn_fence(__ATOMIC_RELEASE, "agent");
            asm volatile("s_waitcnt vmcnt(0)" ::: "memory");
            const unsigned og = xb_add(&bar[XB_TOP], 1u);
            const unsigned tg = og / nx;
            if (og + 1u == (tg + 1u) * nx) xb_add(&bar[XB_TOPGEN], 1u);
            else XB_SPIN(xb_ld(&bar[XB_TOPGEN]) == tg, bar);
            __builtin_amdgcn_fence(__ATOMIC_ACQUIRE, "agent");
            xb_add(&bar[XB_XGEN(b.x)], 1u);
            asm volatile("s_waitcnt vmcnt(0)" ::: "memory");
        } else {
            XB_SPIN(xb_ld(&bar[XB_XGEN(b.x)]) == gen, bar);
            __builtin_amdgcn_fence(__ATOMIC_ACQUIRE, "agent");
            asm volatile("s_waitcnt vmcnt(0)" ::: "memory");
        }
    }
    __syncthreads();
}

#define XS_SUB(j)   (32 * (j))
#define XS_TOP      512
#define XS_DONE     576
#define XS_WORDS    640
#define SB_BASE     11264
__device__ __forceinline__ void split_arrive(unsigned* w, unsigned x, volatile LAS unsigned* st) {
    asm volatile("s_waitcnt vmcnt(0)" ::: "memory");
    __syncthreads();
    if (threadIdx.x == 0) {
        const unsigned nloc = st[0], nx = st[1];
        const unsigned old = xb_add(&w[XS_SUB(x)], 1u);
        if (old + 1u == nloc) {
            __builtin_amdgcn_fence(__ATOMIC_RELEASE, "agent");
            asm volatile("s_waitcnt vmcnt(0)" ::: "memory");
            const unsigned og = xb_add(&w[XS_TOP], 1u);
            if (og + 1u == nx) xb_add(&w[XS_DONE], 1u);
        }
    }
}
__device__ __forceinline__ void split_wait(unsigned* w, unsigned* tmo) {
    if (threadIdx.x == 0) {
        XB_SPIN(xb_ld(&w[XS_DONE]) == 0u, tmo);
        __builtin_amdgcn_fence(__ATOMIC_ACQUIRE, "agent");
        asm volatile("s_waitcnt vmcnt(0)" ::: "memory");
    }
    __syncthreads();
}

struct P {
    const float *x, *c, *ctx, *c_ctx, *w_mod, *b_mod, *norm1_g, *norm2_g, *w_in, *sgu_g, *sgu_w, *sgu_b, *conv_w, *conv_b,
                *rg_wa, *rg_ba, *rg_wi, *rg_bi, *rg_lam, *w_out, *w_router, *w1, *w3, *w2, *final_g;
    float* out; unsigned char* ws; int ph_lo, ph_hi;
};

struct SchedG1 { int G, c;
    __device__ __forceinline__ bool next(int i, pg8::Unit& u) const { const int L = i * G + c; if (L >= 528) return false;
        if (L < 512) { u.pm = L >> 3; u.pn = L & 7; } else { const int r = L - 512; u.pm = 64 + (r >> 1); u.pn = 4 + (r & 1); } u.pnB = u.pn; return true; } };
struct SchedG2 { int G, c;
    __device__ __forceinline__ bool next(int i, pg8::Unit& u) const { const int L = i * G + c; if (L >= 256) return false; u.pm = L >> 2; u.pn = L & 3; u.pnB = u.pn; return true; } };
struct SchedG3 { int G, c;
    __device__ __forceinline__ bool next(int i, pg8::Unit& u) const { const int L = i * G + c; if (L >= 2048) return false; const int e = L >> 7, loc = L & 127;
        u.pm = e * 8 + (loc & 7); u.pn = loc >> 3; u.pnB = e * 16 + u.pn; return true; } };
struct SchedG4 { int G, c;
    __device__ __forceinline__ bool next(int i, pg8::Unit& u) const { const int L = i * G + c; if (L >= 512) return false; const int e = L >> 5, loc = L & 31;
        u.pm = e * 8 + (loc & 7); u.pn = loc >> 3; u.pnB = e * 4 + u.pn; return true; } };

struct EpiG1 { static constexpr bool PAIRED = false, FUSED = false; bf16* UV; bf16* XC;
    __device__ __forceinline__ void st8(const pg8::Unit& u, int row, int col, f32x4 v0, f32x4 v1) const {
        const int grow = u.pm * 256 + row, gcol = u.pn * 256 + col;
        if (u.pm < 64) {
            if (gcol < 1024 || gcol >= 1536) { const f32x2p a = gelu2_((f32x2p){v0[0], v0[1]}), b = gelu2_((f32x2p){v0[2], v0[3]}), c = gelu2_((f32x2p){v1[0], v1[1]}), d = gelu2_((f32x2p){v1[2], v1[3]});
                v0 = (f32x4){a.x, a.y, b.x, b.y}; v1 = (f32x4){c.x, c.y, d.x, d.y}; }
            *(v4u*)(UV + (size_t)grow * DIN + gcol) = (v4u){pk2(v0[0], v0[1]), pk2(v0[2], v0[3]), pk2(v1[0], v1[1]), pk2(v1[2], v1[3])};
        } else *(v4u*)(XC + (size_t)(grow - M) * DLRU + (gcol - 1024)) = (v4u){pk2(v0[0], v0[1]), pk2(v0[2], v0[3]), pk2(v1[0], v1[1]), pk2(v1[2], v1[3])};
    } };
struct EpiG2 { static constexpr bool PAIRED = false, FUSED = false; const float* x; const float* MOD; float* X1;
    __device__ __forceinline__ void st8(const pg8::Unit& u, int row, int col, f32x4 v0, f32x4 v1) const {
        const int grow = u.pm * 256 + row, gcol = u.pn * 256 + col, b = grow >> 11;
        const f32x4* xp = (const f32x4*)(x + (size_t)grow * D + gcol); const f32x4* gp = (const f32x4*)(MOD + b * NMOD + 2 * D + gcol); f32x4* op = (f32x4*)(X1 + (size_t)grow * D + gcol);
        op[0] = xp[0] + gp[0] * v0; op[1] = xp[1] + gp[1] * v1;
    } };
#if MOE_FP8
typedef float f32x2v __attribute__((ext_vector_type(2)));
__device__ __forceinline__ f32x2v swiglu_scaled2(f32x2v g, f32x2v u) {
    constexpr float K1 = -1.4426950408889634f * WSCALE_INV, S2 = WSCALE * WSCALE;
    const f32x2v t = g * K1; f32x2v e; e.x = exp2f_(t.x); e.y = exp2f_(t.y);
    const f32x2v d = e * S2 + S2; f32x2v r; r.x = rcpf_(d.x); r.y = rcpf_(d.y);
    return (g * u) * r;
}
struct EpiG3 { static constexpr bool PAIRED = true; unsigned char* HID;
    __device__ __forceinline__ void st2x8(const pg8::Unit& u, int row, int col, f32x4 g0, f32x4 g1, f32x4 u0, f32x4 u1) const {
        const int grow = u.pm * 256 + row, hc = u.pn * 128 + col;
        const f32x2v a = swiglu_scaled2((f32x2v){g0[0], g0[1]}, (f32x2v){u0[0], u0[1]}), b = swiglu_scaled2((f32x2v){g0[2], g0[3]}, (f32x2v){u0[2], u0[3]});
        const f32x2v c = swiglu_scaled2((f32x2v){g1[0], g1[1]}, (f32x2v){u1[0], u1[1]}), d = swiglu_scaled2((f32x2v){g1[2], g1[3]}, (f32x2v){u1[2], u1[3]});
        v2u w; w.x = pk4_fp8(a.x, a.y, b.x, b.y); w.y = pk4_fp8(c.x, c.y, d.x, d.y);
        *(v2u*)(HID + (size_t)grow * DE + hc) = w;
    } };
struct EpiG4 { static constexpr bool PAIRED = false; const float* GATE; unsigned char* YE;
    __device__ __forceinline__ void st8(const pg8::Unit& u, int row, int col, f32x4 v0, f32x4 v1) const {
        const int grow = u.pm * 256 + row, gcol = u.pn * 256 + col; const float gt = GATE[grow];
        v2u w; w.x = pk4_fp8(v0[0] * gt, v0[1] * gt, v0[2] * gt, v0[3] * gt); w.y = pk4_fp8(v1[0] * gt, v1[1] * gt, v1[2] * gt, v1[3] * gt);
        *(v2u*)(YE + (size_t)grow * D + gcol) = w;
    } };
#else
struct EpiG3 { static constexpr bool PAIRED = true; bf16* HID;
    __device__ __forceinline__ void st2(const pg8::Unit& u, int row, int col, f32x4 g, f32x4 up) const {
        const int grow = u.pm * 256 + row, hc = u.pn * 128 + col;
        v2u w; w.x = pk2(siluf_(g[0]) * up[0], siluf_(g[1]) * up[1]); w.y = pk2(siluf_(g[2]) * up[2], siluf_(g[3]) * up[3]);
        *(v2u*)(HID + (size_t)grow * DE + hc) = w;
    } };
struct EpiG4 { static constexpr bool PAIRED = false; const float* GATE; bf16* YE;
    __device__ __forceinline__ void st(const pg8::Unit& u, int row, int col, f32x4 v) const {
        const int grow = u.pm * 256 + row, gcol = u.pn * 256 + col; const float gt = GATE[grow];
        v2u w; w.x = pk2(v[0] * gt, v[1] * gt); w.y = pk2(v[2] * gt, v[3] * gt); *(v2u*)(YE + (size_t)grow * D + gcol) = w;
    } };

#endif


struct EpiG2F { static constexpr bool PAIRED = false, FUSED = true;
    const float* x; const float* MOD; float* X1; const float* w_router; const float* norm2_g; const float* CB; float* XCH; unsigned* cnt; unsigned* tmo; unsigned char* HX8; float* AFF;
    __device__ __forceinline__ void fused(f32x4 (&acc)[2][2][4][2], const pg8::Unit& u, int wr, int wc, int fr, int fq, LAS unsigned char* lds, int wid, int lane) const {
        const int tid = wid * 64 + lane, b = u.pm >> 3, grow0 = u.pm * 256, gcol0 = u.pn * 256;
        LAS float* LQ = (LAS float*)lds;
        LAS float* RINV = (LAS float*)(lds + 81920);
        const float* MODb = MOD + b * NMOD;
        float gsc[2][8], shv[2][8], wrv[2][8];
#pragma unroll
        for (int bj = 0; bj < 2; ++bj)
#pragma unroll
            for (int j = 0; j < 8; ++j) { const int c = gcol0 + bj * 128 + wc * 32 + 8 * fq + j; gsc[bj][j] = norm2_g[c] * (1.f + MODb[4 * D + c]); shv[bj][j] = MODb[3 * D + c]; wrv[bj][j] = w_router[c * NE + fr]; }
#pragma unroll
        for (int ai = 0; ai < 2; ++ai)
#pragma unroll
            for (int m = 0; m < 4; ++m) { const int row = ai * 128 + wr * 64 + m * 16 + fr;
#pragma unroll
                for (int bj = 0; bj < 2; ++bj) { const int col = gcol0 + bj * 128 + wc * 32 + 8 * fq; const size_t o = (size_t)(grow0 + row) * D + col;
                    const f32x4 x0 = *(const f32x4*)(x + o), x1v = *(const f32x4*)(x + o + 4), g0 = *(const f32x4*)(MODb + 2 * D + col), g1 = *(const f32x4*)(MODb + 2 * D + col + 4);
                    acc[ai][bj][m][0] = x0 + g0 * acc[ai][bj][m][0]; acc[ai][bj][m][1] = x1v + g1 * acc[ai][bj][m][1];
                    { v4u w; w.x = pk2(acc[ai][bj][m][0].x, acc[ai][bj][m][0].y); w.y = pk2(acc[ai][bj][m][0].z, acc[ai][bj][m][0].w); w.z = pk2(acc[ai][bj][m][1].x, acc[ai][bj][m][1].y); w.w = pk2(acc[ai][bj][m][1].z, acc[ai][bj][m][1].w);
                      *(v4u*)((bf16*)X1 + o) = w; } } }
        float tw[2][2][4];
#pragma unroll
        for (int bj = 0; bj < 2; ++bj)
#pragma unroll
            for (int n = 0; n < 2; ++n)
#pragma unroll
                for (int r = 0; r < 4; ++r) tw[bj][n][r] = wrv[bj][4 * n + r] * gsc[bj][4 * n + r];
#pragma unroll
        for (int ai = 0; ai < 2; ++ai)
#pragma unroll
            for (int m = 0; m < 4; ++m) { const int row = ai * 128 + wr * 64 + m * 16 + fr;
                f32x4 q = (f32x4){0.f, 0.f, 0.f, 0.f}; float s2 = 0.f;
#pragma unroll
                for (int bj = 0; bj < 2; ++bj)
#pragma unroll
                    for (int n = 0; n < 2; ++n)
#pragma unroll
                        for (int r = 0; r < 4; ++r) { const float v = acc[ai][bj][m][n][r]; q = __builtin_amdgcn_mfma_f32_16x16x4f32(tw[bj][n][r], v, q, 0, 0, 0); s2 += v * v; }
                s2 += __shfl_xor(s2, 16); s2 += __shfl_xor(s2, 32);
                LAS float* o = LQ + (row * 4 + wc) * 20;
                o[4 * fq + 0] = q[0]; o[4 * fq + 1] = q[1]; o[4 * fq + 2] = q[2]; o[4 * fq + 3] = q[3]; if (fq == 0) o[16] = s2; }
        __syncthreads();
        float* xo = XCH + (size_t)((u.pm * 4 + u.pn) * 256) * 20;
        for (int i = tid; i < 256 * 9; i += NTHREADS) { const int row = i / 9, q2 = 2 * (i - row * 9); const LAS float* s = LQ + row * 80 + q2;
            const float v0 = (s[0] + s[20]) + (s[40] + s[60]), v1 = q2 < 16 ? (s[1] + s[21]) + (s[41] + s[61]) : 0.f;
            __hip_atomic_store((unsigned long long*)(xo + row * 20 + q2), ((unsigned long long)__float_as_uint(v1) << 32) | __float_as_uint(v0), __ATOMIC_RELAXED, __HIP_MEMORY_SCOPE_AGENT); }
        asm volatile("s_waitcnt vmcnt(0)" ::: "memory");
        __syncthreads();
        if (tid == 0) {
            __hip_atomic_fetch_add(cnt + 16 * u.pm, 1u, __ATOMIC_RELAXED, __HIP_MEMORY_SCOPE_AGENT);
            XB_SPIN(xb_ld(cnt + 16 * u.pm) < 4u, tmo);
        }
        __syncthreads();
        const float* xp = XCH + (size_t)(u.pm * 4 * 256) * 20;
#define XLD(ptr) __hip_atomic_load((ptr), __ATOMIC_RELAXED, __HIP_MEMORY_SCOPE_AGENT)
        if (tid < 256) { const int row = tid; const float S2 = (XLD(xp + row * 20 + 16) + XLD(xp + 5120 + row * 20 + 16)) + (XLD(xp + 10240 + row * 20 + 16) + XLD(xp + 15360 + row * 20 + 16)); RINV[row] = rsqrtf(S2 * (1.f / D) + EPS); }
        else if (tid < 320) { const int row = 64 * u.pn + (tid - 256); const float* r0 = xp + row * 20;
            const float S2 = (XLD(r0 + 16) + XLD(r0 + 5120 + 16)) + (XLD(r0 + 10240 + 16) + XLD(r0 + 15360 + 16)), rinv = rsqrtf(S2 * (1.f / D) + EPS);
            float lg[16]; float mx = -3.0e38f;
#pragma unroll
            for (int e = 0; e < 16; ++e) { lg[e] = rinv * ((XLD(r0 + e) + XLD(r0 + 5120 + e)) + (XLD(r0 + 10240 + e) + XLD(r0 + 15360 + e))) + CB[b * NE + e]; mx = fmaxf(mx, lg[e]); }
            float den = 0.f;
#pragma unroll
            for (int e = 0; e < 16; ++e) { lg[e] = expf(lg[e] - mx); den += lg[e]; }
            const float rd = 1.f / den; const int t = (u.pm & 7) * 256 + row;
#pragma unroll
            for (int e = 0; e < 16; ++e) AFF[(size_t)(b * NE + e) * SEQ + t] = lg[e] * rd; }
#undef XLD
        __syncthreads();
#pragma unroll
        for (int ai = 0; ai < 2; ++ai)
#pragma unroll
            for (int m = 0; m < 4; ++m) { const int row = ai * 128 + wr * 64 + m * 16 + fr; const float rinv = RINV[row];
#pragma unroll
                for (int bj = 0; bj < 2; ++bj) { const f32x4 a0 = acc[ai][bj][m][0], a1 = acc[ai][bj][m][1]; v2u w;
                    w.x = pk4_fp8(a0[0] * rinv * gsc[bj][0] + shv[bj][0], a0[1] * rinv * gsc[bj][1] + shv[bj][1], a0[2] * rinv * gsc[bj][2] + shv[bj][2], a0[3] * rinv * gsc[bj][3] + shv[bj][3]);
                    w.y = pk4_fp8(a1[0] * rinv * gsc[bj][4] + shv[bj][4], a1[1] * rinv * gsc[bj][5] + shv[bj][5], a1[2] * rinv * gsc[bj][6] + shv[bj][6], a1[3] * rinv * gsc[bj][7] + shv[bj][7]);
                    *(v2u*)(HX8 + (size_t)(grow0 + row) * D + gcol0 + bj * 128 + wc * 32 + 8 * fq) = w; } }
    }
    __device__ __forceinline__ void st8(const pg8::Unit&, int, int, f32x4, f32x4) const {}
};

template <class Epi, class Sched>
__device__ __forceinline__ void naive_gemm_phase(LAS unsigned char* lds, const pg8::Gemm g, const Sched& S, const Epi& E) {
    LAS float* As = (LAS float*)lds; LAS float* Bs = (LAS float*)(lds + 4352);
    const int tid = threadIdx.x, ty = tid >> 5, tx = tid & 31, K = g.K, lr = tid >> 1, lh = 8 * (tid & 1);
    pg8::Unit u;
    for (int i = 0; S.next(i, u); ++i)
        for (int sub = 0; sub < 4; ++sub) {
            f32x4 ag[4], au[4];
#pragma unroll
            for (int r = 0; r < 4; ++r) { ag[r] = (f32x4){0.f, 0.f, 0.f, 0.f}; au[r] = (f32x4){0.f, 0.f, 0.f, 0.f}; }
            const bf16* arow = g.A + ((size_t)u.pm * 256 + sub * 64 + (lr & 63)) * K + lh;
            const bf16* brow = g.Bt + ((size_t)u.pnB * 256 + lr) * K + lh;
            for (int k0 = 0; k0 < K; k0 += 16) {
                const v4u bv = *(const v4u*)(brow + k0); v4u av = (v4u){0u, 0u, 0u, 0u}; if (tid < 128) av = *(const v4u*)(arow + k0);
                __syncthreads();
                Bs[(lh + 0) * 260 + lr] = bflo(bv.x); Bs[(lh + 1) * 260 + lr] = bfhi(bv.x); Bs[(lh + 2) * 260 + lr] = bflo(bv.y); Bs[(lh + 3) * 260 + lr] = bfhi(bv.y);
                Bs[(lh + 4) * 260 + lr] = bflo(bv.z); Bs[(lh + 5) * 260 + lr] = bfhi(bv.z); Bs[(lh + 6) * 260 + lr] = bflo(bv.w); Bs[(lh + 7) * 260 + lr] = bfhi(bv.w);
                if (tid < 128) {
                    As[(lh + 0) * 68 + lr] = bflo(av.x); As[(lh + 1) * 68 + lr] = bfhi(av.x); As[(lh + 2) * 68 + lr] = bflo(av.y); As[(lh + 3) * 68 + lr] = bfhi(av.y);
                    As[(lh + 4) * 68 + lr] = bflo(av.z); As[(lh + 5) * 68 + lr] = bfhi(av.z); As[(lh + 6) * 68 + lr] = bflo(av.w); As[(lh + 7) * 68 + lr] = bfhi(av.w); }
                __syncthreads();
#pragma unroll
                for (int kk = 0; kk < 16; ++kk) {
                    const f32x4 a = *(const LAS f32x4*)(As + kk * 68 + 4 * ty), b0 = *(const LAS f32x4*)(Bs + kk * 260 + 4 * tx), b1 = *(const LAS f32x4*)(Bs + kk * 260 + 128 + 4 * tx);
#pragma unroll
                    for (int r = 0; r < 4; ++r) { ag[r] += a[r] * b0; au[r] += a[r] * b1; }
                }
            }
#pragma unroll
            for (int r = 0; r < 4; ++r) { const int row = sub * 64 + 4 * ty + r;
                if constexpr (Epi::PAIRED) E.st2(u, row, 4 * tx, ag[r], au[r]);
                else { E.st(u, row, 4 * tx, ag[r]); E.st(u, row, 128 + 4 * tx, au[r]); } }
        }
    __syncthreads();
}
template <class Epi, class Sched>
__device__ __forceinline__ void gemm_any(LAS unsigned char* lds, const pg8::Gemm g, const Sched& S, const Epi& E) {
#if USE_PG8
    pg8::gemm_phase<Epi, Sched, true, true>(lds, g, S, E);
#else
    naive_gemm_phase<Epi, Sched>(lds, g, S, E);
#endif
}

__device__ __forceinline__ void transpose_item(const float* W, int N, int K, bf16* WT, int k0, int n0, size_t drow0, LAS unsigned char* scr, int lane) {
    const int lc = lane & 15, lr = lane >> 4;
    f32x4 v[16];
#pragma unroll
    for (int i = 0; i < 16; ++i) v[i] = __builtin_nontemporal_load((const f32x4*)(W + (size_t)(k0 + 4 * i + lr) * N + n0 + 4 * lc));
#pragma unroll
    for (int i = 0; i < 16; ++i) { const int k = 4 * i + lr;
#pragma unroll
        for (int j = 0; j < 4; ++j) *(LAS bf16*)(scr + (4 * lc + j) * 136 + k * 2) = (bf16)f2bf(v[i][j]); }
    LDS_WAIT(); asm volatile("" ::: "memory");
    const int c = lane & 7;
#pragma unroll
    for (int j = 0; j < 8; ++j) { const int n = (lane >> 3) + 8 * j;
        const v2u lo = *(const LAS v2u*)(scr + n * 136 + c * 16), hi = *(const LAS v2u*)(scr + n * 136 + c * 16 + 8);
        *(v4u*)(WT + (drow0 + n) * (size_t)K + k0 + 8 * c) = (v4u){lo.x, lo.y, hi.x, hi.y}; }
    LDS_WAIT(); asm volatile("" ::: "memory");
}
__device__ __forceinline__ void conv_load(const float* src, int N, int lane, f32x4 (&v)[16]);
struct P;
__device__ __forceinline__ void conv_desc(const P& p, int it, const float*& src, unsigned char*& dst, int& N, int& K);
__device__ __forceinline__ void conv_store(const f32x4 (&v)[16], unsigned char* dst, int K, LAS unsigned char* scr, int lane);
__device__ __forceinline__ void transpose_item_f8(const float* W, int N, int K, unsigned char* WT, int k0, int n0, size_t drow0, LAS unsigned char* scr, int lane) {
    f32x4 v[16]; conv_load(W + (size_t)k0 * N + n0, N, lane, v); conv_store(v, WT + drow0 * (size_t)K + k0, K, scr, lane);
}
constexpr int CONV_ITEMS = 16 * 32 + 16 * 16 + 3 * 512 * NE, CONV_CUT = CONV_ITEMS - 6144;
__device__ __forceinline__ void convert_items(const P& p, LAS unsigned char* lds, int lane, int wave, int first, int last, int gw, int NGW) {
    LAS unsigned char* scr = lds + wave * 16384;
    constexpr int I_IN = 16 * 32, I_OUT = 16 * 16, I_E = 512 * NE;
    for (int it = first + gw; it < last; it += NGW) {
        int r = it;
        if (r < I_IN) { const int kb = r >> 5, nb = r & 31; transpose_item(p.w_in, DIN, D, (bf16*)(p.ws + WS_WIN), 64 * kb, 64 * nb, (size_t)(64 * nb), scr, lane); continue; } r -= I_IN;
        if (r < I_OUT) { const int kb = r >> 4, nb = r & 15; transpose_item(p.w_out, D, D, (bf16*)(p.ws + WS_WOUT), 64 * kb, 64 * nb, (size_t)(64 * nb), scr, lane); continue; } r -= I_OUT;
#if MOE_FP8
        { const float* src_; unsigned char* dst_; int N_, K_; f32x4 v_[16]; conv_desc(p, it, src_, dst_, N_, K_); conv_load(src_, N_, lane, v_); conv_store(v_, dst_, K_, scr, lane); }
#else
        if (r < 2 * I_E) { const int which = r >= I_E; if (which) r -= I_E; const int e = r >> 9, q = r & 511, kb = q >> 5, nb = q & 31, n0 = 64 * nb;
            const float* W = (which ? p.w3 : p.w1) + (size_t)e * D * DE;
#if MOE_FP8
            transpose_item_f8(W, DE, D, p.ws + WS_WG, 64 * kb, n0, (size_t)e * 4096 + (size_t)(n0 >> 7) * 256 + (n0 & 127) + (which ? 128 : 0), scr, lane); continue; } r -= 2 * I_E;
#else
            transpose_item(W, DE, D, (bf16*)(p.ws + WS_WG), 64 * kb, n0, (size_t)e * 4096 + (size_t)(n0 >> 7) * 256 + (n0 & 127) + (which ? 128 : 0), scr, lane); continue; } r -= 2 * I_E;
#endif
        { const int e = r >> 9, q = r & 511, kb = q >> 4, nb = q & 15, n0 = 64 * nb;
#if MOE_FP8
            transpose_item_f8(p.w2 + (size_t)e * DE * D, D, DE, p.ws + WS_W2, 64 * kb, n0, (size_t)e * 1024 + n0, scr, lane); }
#else
            transpose_item(p.w2 + (size_t)e * DE * D, D, DE, (bf16*)(p.ws + WS_W2), 64 * kb, n0, (size_t)e * 1024 + n0, scr, lane); }
#endif
#endif
    }
}

#if MOE_FP8
constexpr int CONV_HEAD = 16 * 32 + 16 * 16;
__device__ __forceinline__ void conv_desc(const P& p, int it, const float*& src, unsigned char*& dst, int& N, int& K) {
    constexpr int I_E = 512 * NE; const int r0 = it - CONV_HEAD;
    const bool isw2 = r0 >= 2 * I_E, which = (!isw2) && r0 >= I_E; const int r = isw2 ? r0 - 2 * I_E : (which ? r0 - I_E : r0);
    const int e = r >> 9, q = r & 511, kb = isw2 ? (q >> 5) : (q >> 6), nb = isw2 ? (q & 31) : (q & 63), n0 = 32 * nb;
    N = isw2 ? D : DE; K = isw2 ? DE : D;
    const float* base = isw2 ? p.w2 : (which ? p.w3 : p.w1);
    src = base + (size_t)e * D * DE + (size_t)(128 * kb) * N + n0;
    const size_t drow = isw2 ? ((size_t)e * 1024 + n0) : ((size_t)e * 4096 + (size_t)(n0 >> 7) * 256 + (n0 & 127) + (which ? 128 : 0));
    dst = p.ws + (isw2 ? WS_W2 : WS_WG) + drow * (size_t)K + 128 * kb;
}
__device__ __forceinline__ void conv_load(const float* src, int N, int lane, f32x4 (&v)[16]) {
    const int lc = lane & 7, lr = lane >> 3;
#pragma unroll
    for (int i = 0; i < 16; ++i) v[i] = __builtin_nontemporal_load((const f32x4*)(src + (size_t)(16 * lr + i) * N + 4 * lc));
}
__device__ __forceinline__ void conv_store(const f32x4 (&v)[16], unsigned char* dst, int K, LAS unsigned char* scr, int lane) {
    const int lc = lane & 7, lr = lane >> 3; (void)scr;
#pragma unroll
    for (int j = 0; j < 4; ++j) { v4u o;
        o.x = pk4_fp8(v[0][j] * WSCALE, v[1][j] * WSCALE, v[2][j] * WSCALE, v[3][j] * WSCALE);
        o.y = pk4_fp8(v[4][j] * WSCALE, v[5][j] * WSCALE, v[6][j] * WSCALE, v[7][j] * WSCALE);
        o.z = pk4_fp8(v[8][j] * WSCALE, v[9][j] * WSCALE, v[10][j] * WSCALE, v[11][j] * WSCALE);
        o.w = pk4_fp8(v[12][j] * WSCALE, v[13][j] * WSCALE, v[14][j] * WSCALE, v[15][j] * WSCALE);
        __builtin_nontemporal_store(o, (v4u*)(dst + (size_t)(4 * lc + j) * K + 16 * lr)); }
}
__device__ __forceinline__ void convert_pipelined(const P& p, LAS unsigned char* lds, int lane, int wave, int first, int last, int gw, int NGW) {
    LAS unsigned char* scr = lds + wave * 16384;
    f32x4 va[16], vb[16], vc[16]; const float* s0; unsigned char* da; unsigned char* db; unsigned char* dc; int N0, Ka, Kb, Kc;
    int it = first + gw; if (it >= last) return;
    const int itl = it + ((last - 1 - it) / NGW) * NGW;
    conv_desc(p, it, s0, da, N0, Ka); conv_load(s0, N0, lane, va);
    { const int i1 = min(it + NGW, itl); conv_desc(p, i1, s0, db, N0, Kb); conv_load(s0, N0, lane, vb); }
    for (; it <= itl; it += 3 * NGW) {
        { const int i2 = min(it + 2 * NGW, itl); conv_desc(p, i2, s0, dc, N0, Kc); conv_load(s0, N0, lane, vc); }
        conv_store(va, da, Ka, scr, lane);
        { const int i3 = min(it + 3 * NGW, itl); conv_desc(p, i3, s0, da, N0, Ka); conv_load(s0, N0, lane, va); }
        conv_store(vb, db, Kb, scr, lane);
        { const int i4 = min(it + 4 * NGW, itl); conv_desc(p, i4, s0, db, N0, Kb); conv_load(s0, N0, lane, vb); }
        conv_store(vc, dc, Kc, scr, lane);
    }
}
#endif
__device__ __forceinline__ void p0_small_copies(const P& p, int tid, int vcu, int G) {
    bf16* GWT = (bf16*)(p.ws + WS_GWT); bf16* SWB = (bf16*)(p.ws + WS_SWB); const int gt = vcu * NTHREADS + tid, NT = G * NTHREADS;
    for (int o = gt; o < 131072; o += NT) { const int i = o & 63, j = (o >> 6) & 63, h = (o >> 12) & 7, g = (o >> 15) & 1, d = o >> 16;
        GWT[o] = (bf16)f2bf((g ? p.rg_wi : p.rg_wa)[(size_t)((d * 8 + h) * 64 + i) * 64 + j]); }
    for (int o = gt; o < 65536; o += NT) SWB[o] = (bf16)f2bf(p.sgu_w[o]);
}
__device__ __forceinline__ void phase_p0(const P& p, LAS unsigned char* lds, int tid, int lane, int wave, int vcu, int G, int conv_last, bool small = true) {
    float* MOD = (float*)(p.ws + WS_MOD);
    {
        LAS float* sc = (LAS float*)lds; LAS float* part = (LAS float*)(lds + 36864);
        if (vcu < 192) {
            float cv[18];
#pragma unroll
            for (int i = 0; i < 18; ++i) { const int e = tid + i * NTHREADS, j = e >> 10, k = e & 1023; cv[i] = j < 8 ? p.c[j * D + k] : p.c_ctx[k]; }
#pragma unroll
            for (int i = 0; i < 18; ++i) sc[tid + i * NTHREADS] = siluf_(cv[i]);
        }
        __syncthreads();
        for (int t = vcu; t < 192; t += G) {
            const int col = lane & 31, kh = lane >> 5, n = t * 32 + col, kbase = wave * 128 + kh * 64; float acc[9];
#pragma unroll
            for (int j = 0; j < 9; ++j) acc[j] = 0.f;
            for (int k0 = 0; k0 < 64; k0 += 16) { float w[16];
#pragma unroll
                for (int i = 0; i < 16; ++i) w[i] = __builtin_nontemporal_load(p.w_mod + (size_t)(kbase + k0 + i) * NMOD + n);
#pragma unroll
                for (int i = 0; i < 16; ++i)
#pragma unroll
                    for (int j = 0; j < 9; ++j) acc[j] += sc[j * D + kbase + k0 + i] * w[i]; }
#pragma unroll
            for (int j = 0; j < 9; ++j) { acc[j] += __shfl_xor(acc[j], 32); if (lane < 32) part[(wave * 9 + j) * 32 + lane] = acc[j]; }
            __syncthreads();
            for (int i = tid; i < 9 * 32; i += NTHREADS) { const int j = i >> 5, l = i & 31; float s2 = p.b_mod[t * 32 + l];
#pragma unroll
                for (int w = 0; w < 8; ++w) s2 += part[(w * 9 + j) * 32 + l];
                MOD[j * NMOD + t * 32 + l] = s2; }
            __syncthreads();
        }
    }
    convert_items(p, lds, lane, wave, 0, conv_last, vcu * NWAVES + wave, G * NWAVES);
    if (small) p0_small_copies(p, tid, vcu, G);
}

__device__ __forceinline__ void phase_p1(const P& p, int lane, int wave, int vcu, int G) {
    const float* MOD = (const float*)(p.ws + WS_MOD); bf16* HX = (bf16*)(p.ws + WS_HX);
    const int gw = vcu * NWAVES + wave, NGW = G * NWAVES;
    for (int i = gw; i < BATCH * NE; i += NGW) { const int b = i >> 4, e = i & 15; float a = 0.f;
        for (int k = lane; k < D; k += 64) a += MOD[b * NMOD + 3 * D + k] * p.w_router[k * NE + e];
        a = wave_sum(a); if (lane == 0) ((float*)(p.ws + WS_CB))[i] = a; }
    f32x4 nx[4];
    { const int m = gw; if (m < MT) { const f32x4* xr = (const f32x4*)(m < M ? p.x + (size_t)m * D : p.ctx + (size_t)(m - M) * D) + lane;
#pragma unroll
        for (int jj = 0; jj < 4; ++jj) nx[jj] = __builtin_nontemporal_load(xr + 64 * jj); } }
    for (int m = gw; m < MT; m += NGW) {
        const int j = m < M ? (m >> 11) : 8;
        f32x4 v[4]; float s = 0.f;
#pragma unroll
        for (int jj = 0; jj < 4; ++jj) { v[jj] = nx[jj]; s += (v[jj].x * v[jj].x + v[jj].y * v[jj].y) + (v[jj].z * v[jj].z + v[jj].w * v[jj].w); }
        { const int m2 = m + NGW; if (m2 < MT) { const f32x4* xr = (const f32x4*)(m2 < M ? p.x + (size_t)m2 * D : p.ctx + (size_t)(m2 - M) * D) + lane;
#pragma unroll
            for (int jj = 0; jj < 4; ++jj) nx[jj] = __builtin_nontemporal_load(xr + 64 * jj); } }
        const float rinv = rsqrtf(wave_sum(s) * (1.f / D) + EPS);
        v2u* o = (v2u*)(HX + (size_t)m * D) + lane;
#pragma unroll
        for (int jj = 0; jj < 4; ++jj) { const int k = 4 * (lane + 64 * jj);
            const f32x4 g = *(const f32x4*)(p.norm1_g + k), sh = *(const f32x4*)(MOD + j * NMOD + k), sc = *(const f32x4*)(MOD + j * NMOD + D + k);
            const f32x4 h = v[jj] * rinv * g * (sc + 1.f) + sh; v2u w; w.x = pk2(h.x, h.y); w.y = pk2(h.z, h.w); o[64 * jj] = w; }
    }
}

__device__ __forceinline__ void phase_lru1(const P& p, LAS unsigned char* lds, int tid, int vcu, int G) {
    LAS float* xt = (LAS float*)lds;
    LAS float* cx = (LAS float*)(lds + 17152);
    LAS float* af = (LAS float*)(lds + 33536);
    LAS float* df = (LAS float*)(lds + 49920);
    LAS float* ab = (LAS float*)(lds + 66304);
    LAS float* db = (LAS float*)(lds + 82688);
    const bf16* UV = (const bf16*)(p.ws + WS_UV); const bf16* XC = (const bf16*)(p.ws + WS_XC);
    bf16* HS = (bf16*)(p.ws + WS_HS); bf16* PF = (bf16*)(p.ws + WS_PF); bf16* PB = (bf16*)(p.ws + WS_PB); float* SUM = (float*)(p.ws + WS_SUM);
    for (int T = vcu; T < BATCH * NSEG * 8; T += G) {
        const int b = T / (NSEG * 8), rem = T % (NSEG * 8), seg = rem >> 3, h = rem & 7;
        for (int i = tid; i < 67 * 64; i += NTHREADS) { const int r = (i >> 6) - 1, ch = i & 63; float v = 0.f;
            if (seg < 4) { const int pos = seg * 64 + r; if (pos >= 0 && pos < CTXL) v = bf2f(XC[(size_t)(b * CTXL + pos) * DLRU + h * 64 + ch]); }
            else { if (r >= 0 && r < 64) v = bf2f(UV[(size_t)(b * SEQ + (seg - 4) * 64 + r) * DIN + 1024 + h * 64 + ch]); }
            xt[i] = v; }
        __syncthreads();
        for (int i = tid; i < 4096; i += NTHREADS) { const int r = i >> 6, ch = i & 63, cch = h * 64 + ch; float v = p.conv_b[cch];
#pragma unroll
            for (int j = 0; j < 4; ++j) v += p.conv_w[j * DLRU + cch] * xt[(r + j) * 64 + ch];
            cx[i] = v; }
        __syncthreads();
        { const int jj = tid & 63, r0 = tid >> 6, cch = h * 64 + jj;
#pragma unroll
          for (int d = 0; d < 2; ++d) {
            float aa[8], ai[8];
#pragma unroll
            for (int q = 0; q < 8; ++q) { aa[q] = 0.f; ai[q] = 0.f; }
            const float* wa = p.rg_wa + (size_t)((d * 8 + h) * 64) * 64 + jj; const float* wi = p.rg_wi + (size_t)((d * 8 + h) * 64) * 64 + jj;
#pragma unroll 2
            for (int i = 0; i < 64; ++i) { const float wav = wa[i * 64], wiv = wi[i * 64];
#pragma unroll
                for (int q = 0; q < 8; ++q) { const float cv = cx[(r0 + 8 * q) * 64 + i]; aa[q] += cv * wav; ai[q] += cv * wiv; } }
            const float ba = p.rg_ba[d * DLRU + cch], bi = p.rg_bi[d * DLRU + cch], c8 = -8.f * log1pf(expf(-p.rg_lam[d * DLRU + cch]));
            LAS float* ao = d ? ab : af; LAS float* dout = d ? db : df;
#pragma unroll
            for (int q = 0; q < 8; ++q) { const int r = r0 + 8 * q; const float rg = sigmoidf_(aa[q] + ba), ig = sigmoidf_(ai[q] + bi), la = c8 * rg;
                ao[r * 64 + jj] = expf(la); dout[r * 64 + jj] = sqrtf(-expm1f(2.f * la)) * ig * cx[r * 64 + jj]; }
          } }
        __syncthreads();
        if (tid < 128) { const int d = tid >> 6, ch = tid & 63; float hh = 0.f, pp = 1.f;
            if (d == 0) {
#pragma unroll 4
                for (int r = 0; r < 64; ++r) { const float a = af[r * 64 + ch]; hh = a * hh + df[r * 64 + ch]; pp *= a; df[r * 64 + ch] = hh; af[r * 64 + ch] = pp; } }
            else {
#pragma unroll 4
                for (int r = 63; r >= 0; --r) { const float a = ab[r * 64 + ch]; hh = a * hh + db[r * 64 + ch]; pp *= a; db[r * 64 + ch] = hh; ab[r * 64 + ch] = pp; } }
            float* s = SUM + ((size_t)((b * NSEG + seg) * 2 + d) * DLRU + h * 64 + ch) * 2; s[0] = pp; s[1] = hh; }
        __syncthreads();
        if (seg >= 4) for (int i = tid; i < 4096; i += NTHREADS) { const int r = i >> 6, ch = i & 63; const size_t o = (size_t)(b * SEQ + (seg - 4) * 64 + r) * DLRU + h * 64 + ch;
            HS[o] = (bf16)f2bf(df[i] + db[i]); PF[o] = (bf16)f2bf(af[i]); PB[o] = (bf16)f2bf(ab[i]); }
        __syncthreads();
    }
}

__device__ __forceinline__ void phase_sgu(const P& p, LAS unsigned char* lds, int tid, int vcu, int G) {
    LAS float* vn = (LAS float*)lds;
    LAS float* wsl = (LAS float*)(lds + 65536);
    const bf16* UV = (const bf16*)(p.ws + WS_UV); bf16* A2 = (bf16*)(p.ws + WS_A2);
    for (int T = vcu; T < 512; T += G) {
        const int b = T >> 6, n = (T >> 2) & 15, h = T & 3; const size_t t0 = (size_t)b * SEQ + n * 128;
        for (int i = tid; i < 16384; i += NTHREADS) { const int q = i >> 7, c = i & 127; vn[i] = bf2f(UV[(t0 + q) * DIN + 512 + h * 128 + c]); wsl[i] = p.sgu_w[h * 16384 + i]; }
        __syncthreads();
        { const int q = tid >> 2, part = tid & 3; float s = 0.f;
          for (int c = part * 32; c < part * 32 + 32; ++c) { const float v = vn[q * 128 + c]; s += v * v; }
          s += __shfl_xor(s, 1); s += __shfl_xor(s, 2);
          const float rinv = rsqrtf(s * (1.f / 128.f) + EPS);
          for (int c = part * 32; c < part * 32 + 32; ++c) vn[q * 128 + c] *= rinv * p.sgu_g[h * 128 + c]; }
        __syncthreads();
        { const int c = tid & 127, p0 = tid >> 7; float acc[32];
#pragma unroll
          for (int i = 0; i < 32; ++i) acc[i] = 0.f;
          for (int q = 0; q < 128; ++q) { const float vq = vn[q * 128 + c];
#pragma unroll
              for (int i = 0; i < 32; ++i) acc[i] += wsl[(p0 + 4 * i) * 128 + q] * vq; }
#pragma unroll
          for (int i = 0; i < 32; ++i) { const int pp = p0 + 4 * i; const float s = acc[i] + p.sgu_b[h * 128 + pp];
              const float uu = bf2f(UV[(t0 + pp) * DIN + h * 128 + c]); A2[(t0 + pp) * D + h * 128 + c] = (bf16)f2bf(uu * s); } }
        __syncthreads();
    }
}


__device__ __forceinline__ void phase_lru1_mfma(const P& p, LAS unsigned char* lds, int tid, int lane, int wave, int vcu, int G) {
    LAS float* xt = (LAS float*)lds;
    LAS float* cxf = (LAS float*)(lds + 17152);
    LAS unsigned char* cxb = lds + 33536;
    LAS float* AD = (LAS float*)(lds + 42752);
    LAS float* SS = (LAS float*)(lds + 108288);
    const bf16* UV = (const bf16*)(p.ws + WS_UV); const bf16* XC = (const bf16*)(p.ws + WS_XC); const bf16* GWT = (const bf16*)(p.ws + WS_GWT);
    bf16* HS = (bf16*)(p.ws + WS_HS); bf16* PF = (bf16*)(p.ws + WS_PF); bf16* PB = (bf16*)(p.ws + WS_PB); float* SUM = (float*)(p.ws + WS_SUM);
    const int fr = lane & 15, fq = lane >> 4;
    const int wd = wave >> 2, jt = wave & 3, wj = 16 * jt + fr, cch_c = tid & 63;
    int hcur = -1; bf16x8 bfr[2][2]; float ba = 0.f, bi = 0.f, c8 = 0.f, cw0 = 0.f, cw1 = 0.f, cw2 = 0.f, cw3 = 0.f, cbias = 0.f;
    auto load_piece = [&](int T, int i) -> v4u { const int b = T / (NSEG * 8), rem = T % (NSEG * 8), seg = rem >> 3, h = rem & 7, r = (i >> 3) - 1, c0 = (i & 7) * 8; v4u w = (v4u){0u, 0u, 0u, 0u};
        if (seg < 4) { const int pos = seg * 64 + r; if (pos >= 0 && pos < CTXL) w = *(const v4u*)(XC + (size_t)(b * CTXL + pos) * DLRU + h * 64 + c0); }
        else { if (r >= 0 && r < 64) w = *(const v4u*)(UV + (size_t)(b * SEQ + (seg - 4) * 64 + r) * DIN + 1024 + h * 64 + c0); }
        return w; };
    v4u pre0 = (v4u){0u, 0u, 0u, 0u}, pre1 = (v4u){0u, 0u, 0u, 0u};
    if (vcu < BATCH * NSEG * 8) { pre0 = load_piece(vcu, tid); if (tid < 24) pre1 = load_piece(vcu, tid + 512); }
    for (int T = vcu; T < BATCH * NSEG * 8; T += G) {
        const int b = T / (NSEG * 8), rem = T % (NSEG * 8), seg = rem >> 3, h = rem & 7;
        { LAS float* o = xt + (tid >> 3) * 64 + (tid & 7) * 8;
          *(LAS f32x4*)o = (f32x4){bflo(pre0.x), bfhi(pre0.x), bflo(pre0.y), bfhi(pre0.y)}; *(LAS f32x4*)(o + 4) = (f32x4){bflo(pre0.z), bfhi(pre0.z), bflo(pre0.w), bfhi(pre0.w)};
          if (tid < 24) { LAS float* o1 = xt + ((tid + 512) >> 3) * 64 + (tid & 7) * 8;
              *(LAS f32x4*)o1 = (f32x4){bflo(pre1.x), bfhi(pre1.x), bflo(pre1.y), bfhi(pre1.y)}; *(LAS f32x4*)(o1 + 4) = (f32x4){bflo(pre1.z), bfhi(pre1.z), bflo(pre1.w), bfhi(pre1.w)}; } }
        if (h != hcur) { hcur = h;
#pragma unroll
            for (int g = 0; g < 2; ++g)
#pragma unroll
                for (int ks = 0; ks < 2; ++ks) bfr[g][ks] = *(const bf16x8*)(GWT + (size_t)((((wd * 2 + g) * 8 + h) * 64 + wj) * 64 + 32 * ks + 8 * fq));
            ba = p.rg_ba[wd * DLRU + h * 64 + wj]; bi = p.rg_bi[wd * DLRU + h * 64 + wj]; c8 = -8.f * log1pf(expf(-p.rg_lam[wd * DLRU + h * 64 + wj]));
            cw0 = p.conv_w[h * 64 + cch_c]; cw1 = p.conv_w[DLRU + h * 64 + cch_c]; cw2 = p.conv_w[2 * DLRU + h * 64 + cch_c]; cw3 = p.conv_w[3 * DLRU + h * 64 + cch_c]; cbias = p.conv_b[h * 64 + cch_c]; }
        __syncthreads();
        if (T + G < BATCH * NSEG * 8) { pre0 = load_piece(T + G, tid); if (tid < 24) pre1 = load_piece(T + G, tid + 512); }
        for (int i = tid; i < 4096; i += NTHREADS) { const int r = i >> 6, ch = i & 63;
            const float v = cbias + cw0 * xt[r * 64 + ch] + cw1 * xt[(r + 1) * 64 + ch] + cw2 * xt[(r + 2) * 64 + ch] + cw3 * xt[(r + 3) * 64 + ch];
            cxf[i] = v; *(LAS bf16*)(cxb + r * 144 + ch * 2) = (bf16)f2bf(v); }
        __syncthreads();
        { const int d = wd, j = wj;
          LAS float* Ad = AD + d * 8192; LAS float* Dd = Ad + 4096;
#pragma unroll
          for (int pt = 0; pt < 4; ++pt) {
              const bf16x8 a0 = *(const LAS bf16x8*)(cxb + (16 * pt + fr) * 144 + 16 * fq), a1 = *(const LAS bf16x8*)(cxb + (16 * pt + fr) * 144 + 64 + 16 * fq);
              f32x4 ca = (f32x4){0.f, 0.f, 0.f, 0.f}, ci = (f32x4){0.f, 0.f, 0.f, 0.f};
              ca = __builtin_amdgcn_mfma_f32_16x16x32_bf16(a0, bfr[0][0], ca, 0, 0, 0); ca = __builtin_amdgcn_mfma_f32_16x16x32_bf16(a1, bfr[0][1], ca, 0, 0, 0);
              ci = __builtin_amdgcn_mfma_f32_16x16x32_bf16(a0, bfr[1][0], ci, 0, 0, 0); ci = __builtin_amdgcn_mfma_f32_16x16x32_bf16(a1, bfr[1][1], ci, 0, 0, 0);
#pragma unroll
              for (int r = 0; r < 4; ++r) { const int pos = 16 * pt + 4 * fq + r; const float rg = sigmoidf_(ca[r] + ba), ig = sigmoidf_(ci[r] + bi), la = c8 * rg;
                  float av, sv; decay_pair(la, av, sv); Ad[pos * 64 + j] = av; Dd[pos * 64 + j] = sv * ig * cxf[pos * 64 + j]; }
          } }
        __syncthreads();
        { const int sub = tid >> 7, d = (tid >> 6) & 1, ch = tid & 63;
          LAS float* Ad = AD + d * 8192; LAS float* Dd = Ad + 4096;
          float hl[16], pc[16]; float hh = 0.f, pp = 1.f;
#pragma unroll
          for (int t = 0; t < 16; ++t) { const int pos = d ? 16 * sub + 15 - t : 16 * sub + t; const float a = Ad[pos * 64 + ch]; hh = a * hh + Dd[pos * 64 + ch]; pp *= a; hl[t] = hh; pc[t] = pp; }
          SS[((sub * 2 + d) * 64 + ch) * 2] = pp; SS[((sub * 2 + d) * 64 + ch) * 2 + 1] = hh;
          __syncthreads();
          float cin = 0.f, cp = 1.f;
          if (d == 0) { for (int s2 = 0; s2 < sub; ++s2) { const float A = SS[((s2 * 2) * 64 + ch) * 2], B = SS[((s2 * 2) * 64 + ch) * 2 + 1]; cin = A * cin + B; cp *= A; } }
          else { for (int s2 = 3; s2 > sub; --s2) { const float A = SS[((s2 * 2 + 1) * 64 + ch) * 2], B = SS[((s2 * 2 + 1) * 64 + ch) * 2 + 1]; cin = A * cin + B; cp *= A; } }
#pragma unroll
          for (int t = 0; t < 16; ++t) { const int pos = d ? 16 * sub + 15 - t : 16 * sub + t; Dd[pos * 64 + ch] = hl[t] + pc[t] * cin; Ad[pos * 64 + ch] = pc[t] * cp; }
          if ((d == 0 && sub == 3) || (d == 1 && sub == 0)) { float* so = SUM + ((size_t)((b * NSEG + seg) * 2 + d) * DLRU + h * 64 + ch) * 2; so[0] = pc[15] * cp; so[1] = hl[15] + pc[15] * cin; }
        }
        __syncthreads();
        if (seg >= 4) { const int pos = tid >> 3, c0 = (tid & 7) * 8; const LAS float* q0 = AD + pos * 64 + c0;
            const f32x4 a0l = *(const LAS f32x4*)(q0), a0h = *(const LAS f32x4*)(q0 + 4), d0l = *(const LAS f32x4*)(q0 + 4096), d0h = *(const LAS f32x4*)(q0 + 4100);
            const f32x4 a1l = *(const LAS f32x4*)(q0 + 8192), a1h = *(const LAS f32x4*)(q0 + 8196), d1l = *(const LAS f32x4*)(q0 + 12288), d1h = *(const LAS f32x4*)(q0 + 12292);
            const f32x4 sl = d0l + d1l, sh = d0h + d1h; const size_t o = (size_t)(b * SEQ + (seg - 4) * 64 + pos) * DLRU + h * 64 + c0;
            *(v4u*)(HS + o) = (v4u){pk2(sl.x, sl.y), pk2(sl.z, sl.w), pk2(sh.x, sh.y), pk2(sh.z, sh.w)};
            *(v4u*)(PF + o) = (v4u){pk2(a0l.x, a0l.y), pk2(a0l.z, a0l.w), pk2(a0h.x, a0h.y), pk2(a0h.z, a0h.w)};
            *(v4u*)(PB + o) = (v4u){pk2(a1l.x, a1l.y), pk2(a1l.z, a1l.w), pk2(a1h.x, a1h.y), pk2(a1h.z, a1h.w)}; }
        __syncthreads();
    }
}


template <int WD>
__device__ __forceinline__ void lru_scan(const float (&ga)[4][4], const float (&gb)[4][4], LAS float* EX, int lane, int fr, int fq, int wj, float& Pin, float& Hin) {
    const int cq = WD ? 3 - fq : fq, l16 = (WD ? lane + 16 : lane - 16) & 63, l32 = (WD ? lane + 32 : lane - 32) & 63, llast = WD ? fr : fr + 48;
    LAS float* Pd = EX + WD * 8192; LAS float* Hd = Pd + 4096;
#pragma unroll
    for (int ptc = 0; ptc < 4; ++ptc) { constexpr int dummy = 0; (void)dummy; const int pt = WD ? 3 - ptc : ptc;
        float pr[4], hr[4]; float hh = 0.f, pp = 1.f;
#pragma unroll
        for (int rc = 0; rc < 4; ++rc) { const int r = WD ? 3 - rc : rc; hh = ga[pt][r] * hh + gb[pt][r]; pp *= ga[pt][r]; pr[r] = pp; hr[r] = hh; }
        float A = pp, B = hh;
        { const float tA = __shfl(A, l16), tB = __shfl(B, l16); if (cq >= 1) { B = A * tB + B; A = tA * A; } }
        { const float tA = __shfl(A, l32), tB = __shfl(B, l32); if (cq >= 2) { B = A * tB + B; A = tA * A; } }
        float eA = __shfl(A, l16), eB = __shfl(B, l16); if (cq == 0) { eA = 1.f; eB = 0.f; }
        const float tAt = __shfl(A, llast), tBt = __shfl(B, llast);
        const float Hc = eA * Hin + eB, Pc = Pin * eA;
#pragma unroll
        for (int r = 0; r < 4; ++r) { const int pos = 16 * pt + 4 * fq + r; Hd[pos * 64 + wj] = pr[r] * Hc + hr[r]; Pd[pos * 64 + wj] = Pc * pr[r]; }
        Hin = tAt * Hin + tBt; Pin *= tAt;
    }
}

__device__ __forceinline__ void phase_lru1_v2(const P& p, LAS unsigned char* lds, int tid, int lane, int wave, int vcu, int G) {
    LAS float* xt = (LAS float*)lds;
    LAS float* cxf = (LAS float*)(lds + 17152);
    LAS unsigned char* cxb = lds + 33536;
    LAS float* EX = (LAS float*)(lds + 42752);
    const bf16* UV = (const bf16*)(p.ws + WS_UV); const bf16* XC = (const bf16*)(p.ws + WS_XC); const bf16* GWT = (const bf16*)(p.ws + WS_GWT);
    bf16* HS = (bf16*)(p.ws + WS_HS); bf16* PF = (bf16*)(p.ws + WS_PF); bf16* PB = (bf16*)(p.ws + WS_PB); float* SUM = (float*)(p.ws + WS_SUM);
    const int fr = lane & 15, fq = lane >> 4;
    const int wd = wave >> 2, jt = wave & 3, wj = 16 * jt + fr, cch_c = tid & 63;
    int hcur = -1; bf16x8 bfr[2][2]; float ba = 0.f, bi = 0.f, c8 = 0.f, cw0 = 0.f, cw1 = 0.f, cw2 = 0.f, cw3 = 0.f, cbias = 0.f;
    auto load_piece = [&](int T, int i) -> v4u { const int b = T / (NSEG * 8), rem = T % (NSEG * 8), seg = rem >> 3, h = rem & 7, r = (i >> 3) - 1, c0 = (i & 7) * 8; v4u w = (v4u){0u, 0u, 0u, 0u};
        if (seg < 4) { const int pos = seg * 64 + r; if (pos >= 0 && pos < CTXL) w = *(const v4u*)(XC + (size_t)(b * CTXL + pos) * DLRU + h * 64 + c0); }
        else { if (r >= 0 && r < 64) w = *(const v4u*)(UV + (size_t)(b * SEQ + (seg - 4) * 64 + r) * DIN + 1024 + h * 64 + c0); }
        return w; };
    v4u pre0 = (v4u){0u, 0u, 0u, 0u}, pre1 = (v4u){0u, 0u, 0u, 0u};
    if (vcu < BATCH * NSEG * 8) { pre0 = load_piece(vcu, tid); if (tid < 24) pre1 = load_piece(vcu, tid + 512); }
    for (int T = vcu; T < BATCH * NSEG * 8; T += G) {
        const int b = T / (NSEG * 8), rem = T % (NSEG * 8), seg = rem >> 3, h = rem & 7;
        { LAS float* o = xt + (tid >> 3) * 64 + (tid & 7) * 8;
          *(LAS f32x4*)o = (f32x4){bflo(pre0.x), bfhi(pre0.x), bflo(pre0.y), bfhi(pre0.y)}; *(LAS f32x4*)(o + 4) = (f32x4){bflo(pre0.z), bfhi(pre0.z), bflo(pre0.w), bfhi(pre0.w)};
          if (tid < 24) { LAS float* o1 = xt + ((tid + 512) >> 3) * 64 + (tid & 7) * 8;
              *(LAS f32x4*)o1 = (f32x4){bflo(pre1.x), bfhi(pre1.x), bflo(pre1.y), bfhi(pre1.y)}; *(LAS f32x4*)(o1 + 4) = (f32x4){bflo(pre1.z), bfhi(pre1.z), bflo(pre1.w), bfhi(pre1.w)}; } }
        if (h != hcur) { hcur = h;
#pragma unroll
            for (int g = 0; g < 2; ++g)
#pragma unroll
                for (int ks = 0; ks < 2; ++ks) bfr[g][ks] = *(const bf16x8*)(GWT + (size_t)((((wd * 2 + g) * 8 + h) * 64 + wj) * 64 + 32 * ks + 8 * fq));
            ba = p.rg_ba[wd * DLRU + h * 64 + wj]; bi = p.rg_bi[wd * DLRU + h * 64 + wj]; c8 = -8.f * log1pf(expf(-p.rg_lam[wd * DLRU + h * 64 + wj]));
            cw0 = p.conv_w[h * 64 + cch_c]; cw1 = p.conv_w[DLRU + h * 64 + cch_c]; cw2 = p.conv_w[2 * DLRU + h * 64 + cch_c]; cw3 = p.conv_w[3 * DLRU + h * 64 + cch_c]; cbias = p.conv_b[h * 64 + cch_c];
            asm volatile("" : "+v"(ba), "+v"(bi), "+v"(c8), "+v"(cw0), "+v"(cw1), "+v"(cw2), "+v"(cw3), "+v"(cbias) :: "memory");
#pragma unroll
            for (int g = 0; g < 2; ++g)
#pragma unroll
                for (int ks = 0; ks < 2; ++ks) asm volatile("" : "+v"(bfr[g][ks]) :: "memory"); }
        __syncthreads();
        if (T + G < BATCH * NSEG * 8) { pre0 = load_piece(T + G, tid); if (tid < 24) pre1 = load_piece(T + G, tid + 512); }
        for (int i = tid; i < 4096; i += NTHREADS) { const int r = i >> 6, ch = i & 63;
            const float v = cbias + cw0 * xt[r * 64 + ch] + cw1 * xt[(r + 1) * 64 + ch] + cw2 * xt[(r + 2) * 64 + ch] + cw3 * xt[(r + 3) * 64 + ch];
            cxf[i] = v; *(LAS bf16*)(cxb + r * 144 + ch * 2) = (bf16)f2bf(v); }
        __syncthreads();
        {
            float ga[4][4], gb[4][4];
#pragma unroll
            for (int pt = 0; pt < 4; ++pt) {
                const bf16x8 a0 = *(const LAS bf16x8*)(cxb + (16 * pt + fr) * 144 + 16 * fq), a1 = *(const LAS bf16x8*)(cxb + (16 * pt + fr) * 144 + 64 + 16 * fq);
                f32x4 ca = (f32x4){0.f, 0.f, 0.f, 0.f}, ci = (f32x4){0.f, 0.f, 0.f, 0.f};
                ca = __builtin_amdgcn_mfma_f32_16x16x32_bf16(a0, bfr[0][0], ca, 0, 0, 0); ca = __builtin_amdgcn_mfma_f32_16x16x32_bf16(a1, bfr[0][1], ca, 0, 0, 0);
                ci = __builtin_amdgcn_mfma_f32_16x16x32_bf16(a0, bfr[1][0], ci, 0, 0, 0); ci = __builtin_amdgcn_mfma_f32_16x16x32_bf16(a1, bfr[1][1], ci, 0, 0, 0);
#pragma unroll
                for (int r = 0; r < 4; r += 2) { const int pos = 16 * pt + 4 * fq + r;
                    const f32x2p rg = sigmoid2_((f32x2p){ca[r], ca[r + 1]} + ba), ig = sigmoid2_((f32x2p){ci[r], ci[r + 1]} + bi); f32x2p av, sv; decay_pair2(rg * c8, av, sv);
                    const f32x2p dv = sv * ig * (f32x2p){cxf[pos * 64 + wj], cxf[(pos + 1) * 64 + wj]}; ga[pt][r] = av.x; ga[pt][r + 1] = av.y; gb[pt][r] = dv.x; gb[pt][r + 1] = dv.y; }
            }
            float Pin = 1.f, Hin = 0.f;
            if (wd == 0) lru_scan<0>(ga, gb, EX, lane, fr, fq, wj, Pin, Hin); else lru_scan<1>(ga, gb, EX, lane, fr, fq, wj, Pin, Hin);
            if (fq == 0) { float* so = SUM + ((size_t)((b * NSEG + seg) * 2 + wd) * DLRU + h * 64 + wj) * 2; so[0] = Pin; so[1] = Hin; }
        }
        __syncthreads();
        if (seg >= 4) { const int pos = tid >> 3, c0 = (tid & 7) * 8; const LAS float* q0 = EX + pos * 64 + c0;
            const f32x4 a0l = *(const LAS f32x4*)(q0), a0h = *(const LAS f32x4*)(q0 + 4), d0l = *(const LAS f32x4*)(q0 + 4096), d0h = *(const LAS f32x4*)(q0 + 4100);
            const f32x4 a1l = *(const LAS f32x4*)(q0 + 8192), a1h = *(const LAS f32x4*)(q0 + 8196), d1l = *(const LAS f32x4*)(q0 + 12288), d1h = *(const LAS f32x4*)(q0 + 12292);
            const f32x4 sl = d0l + d1l, sh = d0h + d1h; const size_t o = (size_t)(b * SEQ + (seg - 4) * 64 + pos) * DLRU + h * 64 + c0;
            *(v4u*)(HS + o) = (v4u){pk2(sl.x, sl.y), pk2(sl.z, sl.w), pk2(sh.x, sh.y), pk2(sh.z, sh.w)};
            *(v4u*)(PF + o) = (v4u){pk2(a0l.x, a0l.y), pk2(a0l.z, a0l.w), pk2(a0h.x, a0h.y), pk2(a0h.z, a0h.w)};
            *(v4u*)(PB + o) = (v4u){pk2(a1l.x, a1l.y), pk2(a1l.z, a1l.w), pk2(a1h.x, a1h.y), pk2(a1h.z, a1h.w)}; }
    }
    __syncthreads();
}

#define SGU_GLD4(r, ptr) asm volatile("global_load_dwordx4 %0, %4, off\n\tglobal_load_dwordx4 %1, %4, off offset:64\n\tglobal_load_dwordx4 %2, %4, off offset:128\n\tglobal_load_dwordx4 %3, %4, off offset:192" \
    : "=&v"(r[0]), "=&v"(r[1]), "=&v"(r[2]), "=&v"(r[3]) : "v"(ptr) : "memory")
__device__ __forceinline__ void phase_sgu_mfma(const P& p, LAS unsigned char* lds, int tid, int lane, int wave, int vcu, int G, int first = 0, int last = 512) {
    LAS unsigned char* vnT = lds;
    LAS unsigned char* ul = lds + 34816;
    const bf16* UV = (const bf16*)(p.ws + WS_UV); const bf16* SWB = (const bf16*)(p.ws + WS_SWB); bf16* A2 = (bf16*)(p.ws + WS_A2);
    const int fr = lane & 15, fq = lane >> 4, q = tid >> 2, part = tid & 3;
    int T = first + vcu; if (T >= last) return;
    v4u vw[4], uw[4];
    auto issue = [&](int TT) { const int b = TT >> 6, n = (TT >> 2) & 15, h = TT & 3; const bf16* row = UV + ((size_t)b * SEQ + n * 128 + q) * DIN + h * 128 + part * 8;
        SGU_GLD4(vw, row + 512); SGU_GLD4(uw, row); };
    issue(T);
    int hcur = -1; f32x4 gs[8]; bf16x8 afr[4]; float bs[4] = {0.f, 0.f, 0.f, 0.f};
    for (; T < last; T += G) {
        const int b = T >> 6, n = (T >> 2) & 15, h = T & 3; const size_t t0 = (size_t)b * SEQ + n * 128;
        if (h != hcur) { hcur = h;
#pragma unroll
            for (int i = 0; i < 4; ++i) { gs[2 * i] = *(const f32x4*)(p.sgu_g + h * 128 + 32 * i + 8 * part); gs[2 * i + 1] = *(const f32x4*)(p.sgu_g + h * 128 + 32 * i + 8 * part + 4); }
#pragma unroll
            for (int ks = 0; ks < 4; ++ks) afr[ks] = *(const bf16x8*)(SWB + (size_t)((h * 128 + 16 * wave + fr) * 128 + 32 * ks + 8 * fq));
#pragma unroll
            for (int r = 0; r < 4; ++r) bs[r] = p.sgu_b[h * 128 + 16 * wave + 4 * fq + r];
#pragma unroll
            for (int i = 0; i < 8; ++i) asm volatile("" : "+v"(gs[i]) :: "memory");
#pragma unroll
            for (int ks = 0; ks < 4; ++ks) asm volatile("" : "+v"(afr[ks]) :: "memory");
            asm volatile("" : "+v"(bs[0]), "+v"(bs[1]), "+v"(bs[2]), "+v"(bs[3]) :: "memory"); }
        asm volatile("s_waitcnt vmcnt(4) ; retires %0 %1 %2 %3 %4 %5 %6 %7" : "+v"(vw[0]), "+v"(vw[1]), "+v"(vw[2]), "+v"(vw[3]), "+v"(uw[0]), "+v"(uw[1]), "+v"(uw[2]), "+v"(uw[3]) :: "memory");
        { float v[32]; float s = 0.f;
#pragma unroll
          for (int i = 0; i < 4; ++i) { const v4u w = vw[i]; v[8 * i] = bflo(w.x); v[8 * i + 1] = bfhi(w.x); v[8 * i + 2] = bflo(w.y); v[8 * i + 3] = bfhi(w.y); v[8 * i + 4] = bflo(w.z); v[8 * i + 5] = bfhi(w.z); v[8 * i + 6] = bflo(w.w); v[8 * i + 7] = bfhi(w.w); }
#pragma unroll
          for (int i = 0; i < 32; ++i) s += v[i] * v[i];
          s += __shfl_xor(s, 1); s += __shfl_xor(s, 2);
          const float rinv = rsqrtf(s * (1.f / 128.f) + EPS);
#pragma unroll
          for (int i = 0; i < 4; ++i)
#pragma unroll
              for (int jx = 0; jx < 8; ++jx) { const int c = 32 * i + 8 * part + jx; *(LAS bf16*)(vnT + c * 272 + q * 2) = (bf16)f2bf(v[8 * i + jx] * rinv * gs[2 * i + (jx >> 2)][jx & 3]); }
#pragma unroll
          for (int i = 0; i < 4; ++i) *(LAS v4u*)(ul + q * 272 + (4 * i + part) * 16) = uw[i]; }
        { const int Tn = (T + G < last) ? T + G : T; issue(Tn); }
        __syncthreads();
        {
#pragma unroll
          for (int ct = 0; ct < 8; ++ct) { f32x4 acc = (f32x4){0.f, 0.f, 0.f, 0.f};
#pragma unroll
              for (int ks = 0; ks < 4; ++ks) { const bf16x8 bv = *(const LAS bf16x8*)(vnT + (16 * ct + fr) * 272 + 64 * ks + 16 * fq); acc = __builtin_amdgcn_mfma_f32_16x16x32_bf16(afr[ks], bv, acc, 0, 0, 0); }
#pragma unroll
              for (int r = 0; r < 4; ++r) { const int pp = 16 * wave + 4 * fq + r, c = 16 * ct + fr; LAS bf16* e = (LAS bf16*)(ul + pp * 272 + c * 2);
                  *e = (bf16)f2bf(bf2f(*e) * (acc[r] + bs[r])); } } }
        __syncthreads();
        { bf16* dst = A2 + (t0 + q) * D + h * 128 + part * 8;
#pragma unroll
          for (int i = 0; i < 4; ++i) *(v4u*)(dst + 32 * i) = *(const LAS v4u*)(ul + q * 272 + (4 * i + part) * 16); }
        __syncthreads();
    }
    asm volatile("s_waitcnt vmcnt(0)" ::: "memory");
}

__device__ __forceinline__ void phase_lru2(const P& p, LAS unsigned char* lds, int tid, int vcu, int G) {
    LAS float* carry = (LAS float*)lds;
    const bf16* UV = (const bf16*)(p.ws + WS_UV); const bf16* HS = (const bf16*)(p.ws + WS_HS); const bf16* PF = (const bf16*)(p.ws + WS_PF); const bf16* PB = (const bf16*)(p.ws + WS_PB);
    const float* SUM = (const float*)(p.ws + WS_SUM); bf16* A2 = (bf16*)(p.ws + WS_A2);
    for (int T = vcu; T < BATCH * 32 * 8; T += G) {
        const int b = T >> 8, gr = (T >> 3) & 31, h = T & 7;
        if (tid < 128) { const int d = tid >> 6, ch = tid & 63; float hc = 0.f;
            const float* S = SUM + ((size_t)b * NSEG * 2 * DLRU + (size_t)d * DLRU + h * 64 + ch) * 2;
            if (d == 0) { for (int s = 0; s < 4 + gr; ++s) { const float A = S[(size_t)s * 2048], B = S[(size_t)s * 2048 + 1]; hc = A * hc + B; } }
            else { for (int s = 3; s >= 0; --s) { const float A = S[(size_t)s * 2048], B = S[(size_t)s * 2048 + 1]; hc = A * hc + B; }
                   for (int s = NSEG - 1; s > 4 + gr; --s) { const float A = S[(size_t)s * 2048], B = S[(size_t)s * 2048 + 1]; hc = A * hc + B; } }
            carry[tid] = hc; }
        __syncthreads();
        for (int i = tid; i < 4096; i += NTHREADS) { const int r = i >> 6, ch = i & 63; const size_t row = (size_t)b * SEQ + gr * 64 + r, o = row * DLRU + h * 64 + ch;
            const float val = bf2f(HS[o]) + bf2f(PF[o]) * carry[ch] + bf2f(PB[o]) * carry[64 + ch];
            A2[row * D + 512 + h * 64 + ch] = (bf16)f2bf(bf2f(UV[row * DIN + 1536 + h * 64 + ch]) * val); }
        __syncthreads();
    }
}


__device__ __forceinline__ void phase_lru2_fast(const P& p, LAS unsigned char* lds, int tid, int vcu, int G) {
    LAS float* carry = (LAS float*)lds;
    constexpr int NQ = LRU2_PARTS, GR = 32 / NQ, GSH = (NQ == 8) ? 2 : 3, CBUF = GR * 2 * 64;
    const bf16* UV = (const bf16*)(p.ws + WS_UV); const bf16* HS = (const bf16*)(p.ws + WS_HS); const bf16* PF = (const bf16*)(p.ws + WS_PF); const bf16* PB = (const bf16*)(p.ws + WS_PB);
    const float* SUM = (const float*)(p.ws + WS_SUM); bf16* A2 = (bf16*)(p.ws + WS_A2);
    typedef float f32x2 __attribute__((ext_vector_type(2)));
    constexpr int NT = 64 * NQ;
    if (vcu >= NT) return;
    const int Tlast = vcu + ((NT - 1 - vcu) / G) * G;
    v4u nhs[GR], npf[GR], npb[GR], ngg[GR]; f32x2 ab[NSEG];
    auto load_rows = [&](int T) { const int b = T / (8 * NQ), h = (T / NQ) & 7, qt = T % NQ;
#pragma unroll
        for (int it = 0; it < GR; ++it) { const int v = it * NTHREADS + tid, pos = v >> 3, c0 = (v & 7) * 8; const size_t row = (size_t)b * SEQ + qt * (64 * GR) + pos, o = row * DLRU + h * 64 + c0;
            nhs[it] = *(const v4u*)(HS + o); npf[it] = *(const v4u*)(PF + o); npb[it] = *(const v4u*)(PB + o); ngg[it] = *(const v4u*)(UV + row * DIN + 1536 + h * 64 + c0); } };
    auto load_sum = [&](int T) { const int b = T / (8 * NQ), h = (T / NQ) & 7; const int d = (tid >> 6) & 1, ch = tid & 63;
        const f32x2* S = (const f32x2*)SUM + ((size_t)b * NSEG * 2 + d) * DLRU + h * 64 + ch;
#pragma unroll
        for (int s2 = 0; s2 < NSEG; ++s2) ab[s2] = S[(size_t)s2 * 2 * DLRU]; };
    auto fold = [&](int T, LAS float* cbuf) { const int qt = T % NQ; const int d = tid >> 6, ch = tid & 63; float hc = 0.f;
        if (d == 0) {
#pragma unroll
            for (int s2 = 0; s2 < NSEG; ++s2) { if (s2 >= 4 && ((s2 - 4) >> GSH) == qt) cbuf[(((s2 - 4) & (GR - 1)) * 2 + 0) * 64 + ch] = hc; hc = ab[s2].x * hc + ab[s2].y; }
        } else {
#pragma unroll
            for (int s2 = 3; s2 >= 0; --s2) hc = ab[s2].x * hc + ab[s2].y;
#pragma unroll
            for (int s2 = NSEG - 1; s2 >= 4; --s2) { if (((s2 - 4) >> GSH) == qt) cbuf[(((s2 - 4) & (GR - 1)) * 2 + 1) * 64 + ch] = hc; hc = ab[s2].x * hc + ab[s2].y; }
        } };
    if (tid < 128) load_sum(vcu);
    load_rows(vcu);
    if (tid < 128) fold(vcu, carry);
    __syncthreads();
    int cb = 0;
    for (int T = vcu; T < NT; T += G) {
        const int b = T / (8 * NQ), h = (T / NQ) & 7, qt = T % NQ, Tn = min(T + G, Tlast);
        v4u hsv[GR], pfv[GR], pbv[GR], ggv[GR];
#pragma unroll
        for (int it = 0; it < GR; ++it) { hsv[it] = nhs[it]; pfv[it] = npf[it]; pbv[it] = npb[it]; ggv[it] = ngg[it]; }
#pragma unroll
        for (int it = 0; it < GR; ++it) asm volatile("" : "+v"(hsv[it]), "+v"(pfv[it]), "+v"(pbv[it]), "+v"(ggv[it]) :: "memory");
        if (tid < 128) load_sum(Tn);
        load_rows(Tn);
        const LAS float* cr = carry + cb * CBUF;
#pragma unroll
        for (int it = 0; it < GR; ++it) { const int v = it * NTHREADS + tid, pos = v >> 3, c0 = (v & 7) * 8, grl = pos >> 6;
            const size_t row = (size_t)b * SEQ + qt * (64 * GR) + pos;
            const v4u hs = hsv[it], pf = pfv[it], pb = pbv[it], gg = ggv[it];
            const f32x4 cf0 = *(const LAS f32x4*)(cr + (grl * 2) * 64 + c0), cf1 = *(const LAS f32x4*)(cr + (grl * 2) * 64 + c0 + 4);
            const f32x4 cb0 = *(const LAS f32x4*)(cr + (grl * 2 + 1) * 64 + c0), cb1 = *(const LAS f32x4*)(cr + (grl * 2 + 1) * 64 + c0 + 4);
            v4u out;
            out.x = pk2(bflo(gg.x) * (bflo(hs.x) + bflo(pf.x) * cf0.x + bflo(pb.x) * cb0.x), bfhi(gg.x) * (bfhi(hs.x) + bfhi(pf.x) * cf0.y + bfhi(pb.x) * cb0.y));
            out.y = pk2(bflo(gg.y) * (bflo(hs.y) + bflo(pf.y) * cf0.z + bflo(pb.y) * cb0.z), bfhi(gg.y) * (bfhi(hs.y) + bfhi(pf.y) * cf0.w + bfhi(pb.y) * cb0.w));
            out.z = pk2(bflo(gg.z) * (bflo(hs.z) + bflo(pf.z) * cf1.x + bflo(pb.z) * cb1.x), bfhi(gg.z) * (bfhi(hs.z) + bfhi(pf.z) * cf1.y + bfhi(pb.z) * cb1.y));
            out.w = pk2(bflo(gg.w) * (bflo(hs.w) + bflo(pf.w) * cf1.z + bflo(pb.w) * cb1.z), bfhi(gg.w) * (bfhi(hs.w) + bfhi(pf.w) * cf1.w + bfhi(pb.w) * cb1.w));
            *(v4u*)(A2 + row * D + 512 + h * 64 + c0) = out; }
        cb ^= 1;
        if (tid < 128) fold(Tn, carry + cb * CBUF);
        __syncthreads();
    }
}

__device__ __forceinline__ void phase_p5(const P& p, LAS unsigned char* lds, int tid, int lane, int wave, int vcu, int G) {
    LAS float* wrT = (LAS float*)lds;
    const float* MOD = (const float*)(p.ws + WS_MOD); const float* X1 = (const float*)(p.ws + WS_X1); bf16* HX2 = (bf16*)(p.ws + WS_HX2); float* AFF = (float*)(p.ws + WS_AFF);
    for (int i = tid; i < D * NE; i += NTHREADS) wrT[(i & 15) * D + (i >> 4)] = p.w_router[i];
    __syncthreads();
    const int gw = vcu * NWAVES + wave, NGW = G * NWAVES;
    f32x4 nx[4];
    if (gw < M) { const f32x4* xr = (const f32x4*)(X1 + (size_t)gw * D) + lane;
#pragma unroll
        for (int jj = 0; jj < 4; ++jj) nx[jj] = xr[64 * jj]; }
    for (int m = gw; m < M; m += NGW) {
        const int b = m >> 11, t = m & 2047;
        f32x4 v[4]; float s = 0.f;
#pragma unroll
        for (int jj = 0; jj < 4; ++jj) { v[jj] = nx[jj]; s += (v[jj].x * v[jj].x + v[jj].y * v[jj].y) + (v[jj].z * v[jj].z + v[jj].w * v[jj].w); }
        if (m + NGW < M) { const f32x4* xr = (const f32x4*)(X1 + (size_t)(m + NGW) * D) + lane;
#pragma unroll
            for (int jj = 0; jj < 4; ++jj) nx[jj] = xr[64 * jj]; }
        const float rinv = rsqrtf(wave_sum(s) * (1.f / D) + EPS);
        v2u* o = (v2u*)(HX2 + (size_t)m * D) + lane;
#pragma unroll
        for (int jj = 0; jj < 4; ++jj) { const int k = 4 * (lane + 64 * jj);
            const f32x4 g = *(const f32x4*)(p.norm2_g + k), sh = *(const f32x4*)(MOD + b * NMOD + 3 * D + k), sc = *(const f32x4*)(MOD + b * NMOD + 4 * D + k);
            v[jj] = v[jj] * rinv * g * (sc + 1.f) + sh;
#if MOE_FP8
            ((unsigned*)(p.ws + WS_HX2) + (size_t)m * (D / 4))[lane + 64 * jj] = pk4_fp8(v[jj].x, v[jj].y, v[jj].z, v[jj].w); }
#else
            v2u w; w.x = pk2(v[jj].x, v[jj].y); w.y = pk2(v[jj].z, v[jj].w); o[64 * jj] = w; }
#endif
        float pa[16];
#pragma unroll
        for (int e = 0; e < 16; ++e) { float a = 0.f;
#pragma unroll
            for (int jj = 0; jj < 4; ++jj) { const f32x4 w = *(const LAS f32x4*)(wrT + e * D + 4 * (lane + 64 * jj)); a += (v[jj].x * w.x + v[jj].y * w.y) + (v[jj].z * w.z + v[jj].w * w.w); }
            pa[e] = a; if (e & 1) asm volatile("" ::: "memory"); }
        { const bool h5 = (lane & 32) != 0; float q8[8];
#pragma unroll
          for (int i = 0; i < 8; ++i) { const float keep = h5 ? pa[8 + i] : pa[i], give = h5 ? pa[i] : pa[8 + i]; q8[i] = keep + __shfl_xor(give, 32); }
          const bool h4 = (lane & 16) != 0; float q4[4];
#pragma unroll
          for (int i = 0; i < 4; ++i) { const float keep = h4 ? q8[4 + i] : q8[i], give = h4 ? q8[i] : q8[4 + i]; q4[i] = keep + __shfl_xor(give, 16); }
          const bool h3 = (lane & 8) != 0; float q2[2];
#pragma unroll
          for (int i = 0; i < 2; ++i) { const float keep = h3 ? q4[2 + i] : q4[i], give = h3 ? q4[i] : q4[2 + i]; q2[i] = keep + __shfl_xor(give, 8); }
          const bool h2 = (lane & 4) != 0;
          float lgt = (h2 ? q2[1] : q2[0]) + __shfl_xor(h2 ? q2[0] : q2[1], 4);
          lgt += __shfl_xor(lgt, 2); lgt += __shfl_xor(lgt, 1);
          float mx = lgt;
#pragma unroll
          for (int o2 = 4; o2 < 64; o2 <<= 1) mx = fmaxf(mx, __shfl_xor(mx, o2));
          const float ex = expf(lgt - mx); float den = ex;
#pragma unroll
          for (int o2 = 4; o2 < 64; o2 <<= 1) den += __shfl_xor(den, o2);
          if ((lane & 3) == 0) AFF[(size_t)(b * NE + (lane >> 2)) * SEQ + t] = ex / den; }
    }
    __syncthreads();
}

__device__ __forceinline__ void phase_p6(const P& p, LAS unsigned char* lds, int tid, int lane, int wave, int vcu, int G) {
    LAS float* a = (LAS float*)lds; LAS int* tok = (LAS int*)(lds + 8192);
    const float* AFF = (const float*)(p.ws + WS_AFF); int* SLOT = (int*)(p.ws + WS_SLOT); float* GATE = (float*)(p.ws + WS_GATE);
    const bf16* HX2 = (const bf16*)(p.ws + WS_HX2); bf16* XE = (bf16*)(p.ws + WS_XE);
    for (int T = vcu; T < BATCH * NE; T += G) {
        const int b = T >> 4, e = T & 15;
        for (int i = tid; i < SEQ; i += NTHREADS) a[i] = AFF[(size_t)(b * NE + e) * SEQ + i];
        __syncthreads();
        float at[4]; int rk[4];
#pragma unroll
        for (int i = 0; i < 4; ++i) { at[i] = a[tid + 512 * i]; rk[i] = 0; }
        for (int t2 = 0; t2 < SEQ; ++t2) { const float av = a[t2];
#pragma unroll
            for (int i = 0; i < 4; ++i) rk[i] += (av > at[i] || (av == at[i] && t2 < tid + 512 * i)) ? 1 : 0; }
#pragma unroll
        for (int i = 0; i < 4; ++i) { const int t = tid + 512 * i; SLOT[(size_t)(b * SEQ + t) * NE + e] = rk[i] < CAP ? rk[i] : -1;
            if (rk[i] < CAP) { tok[rk[i]] = t; GATE[e * 2048 + b * CAP + rk[i]] = at[i]; } }
        __syncthreads();
        for (int r = wave; r < CAP; r += NWAVES) { const v4u* src = (const v4u*)(HX2 + (size_t)(b * SEQ + tok[r]) * D); v4u* dst = (v4u*)(XE + (size_t)(e * 2048 + b * CAP + r) * D);
            dst[lane] = src[lane]; dst[lane + 64] = src[lane + 64]; }
        __syncthreads();
    }
}


__device__ __forceinline__ unsigned block_sum_u(unsigned v, LAS unsigned* red, int lane, int wave) {
    v = (unsigned)wave_sum((float)v);
    if (lane == 0) red[wave] = v;
    __syncthreads();
    unsigned s = 0;
#pragma unroll
    for (int w = 0; w < 8; ++w) s += red[w];
    return s;
}
__device__ __forceinline__ unsigned block_excl_scan(unsigned c, unsigned& total, LAS unsigned* red, int lane, int wave) {
    unsigned inc = c;
#pragma unroll
    for (int o = 1; o < 64; o <<= 1) { const unsigned t = __shfl_up(inc, o); if (lane >= o) inc += t; }
    if (lane == 63) red[wave] = inc;
    __syncthreads();
    unsigned off = 0, tot = 0;
#pragma unroll
    for (int w = 0; w < 8; ++w) { const unsigned x = red[w]; off += (w < wave) ? x : 0u; tot += x; }
    total = tot; return off + inc - c;
}
__device__ __forceinline__ void phase_p6_fast(const P& p, LAS unsigned char* lds, int tid, int lane, int wave, int vcu, int G) {
    LAS unsigned* red = (LAS unsigned*)lds;
    LAS int* tok = (LAS int*)(lds + 2048);
    const float* AFF = (const float*)(p.ws + WS_AFF); int* SLOT = (int*)(p.ws + WS_SLOT); float* GATE = (float*)(p.ws + WS_GATE);
    const bf16* HX2 = (const bf16*)(p.ws + WS_HX2); bf16* XE = (bf16*)(p.ws + WS_XE);
    for (int T = vcu; T < BATCH * NE * 2; T += G) {
        const int half = T & 1, e = (T >> 1) & 15, b = T >> 5;
        const f32x4 av = *(const f32x4*)(AFF + (size_t)(b * NE + e) * SEQ + 4 * tid);
        unsigned bits[4] = {__float_as_uint(av.x), __float_as_uint(av.y), __float_as_uint(av.z), __float_as_uint(av.w)};
        unsigned lo = 0u, hi = 0x3f800000u; int rb = 0;
        while (lo < hi) {
            const unsigned span = hi - lo, q = (span + 3u) >> 2, t1 = lo + q, t2 = min(lo + 2u * q, hi), t3 = min(lo + 3u * q, hi);
            unsigned w = 0;
#pragma unroll
            for (int i = 0; i < 4; ++i) w += (bits[i] >= t1 ? 1u : 0u) + (bits[i] >= t2 ? (1u << 10) : 0u) + (bits[i] >= t3 ? (1u << 20) : 0u);
#pragma unroll
            for (int o = 1; o < 64; o <<= 1) w += __shfl_xor(w, o);
            LAS unsigned* rd = red + 8 * rb; rb = (rb + 1) % 36;
            if (lane == 0) rd[wave] = w;
            __syncthreads();
            unsigned c1 = 0, c2 = 0, c3 = 0;
#pragma unroll
            for (int ww = 0; ww < 8; ++ww) { const unsigned x = rd[ww]; c1 += x & 1023u; c2 += (x >> 10) & 1023u; c3 += x >> 20; }
            if (c3 >= (unsigned)CAP) lo = t3; else if (c2 >= (unsigned)CAP) { lo = t2; hi = t3 - 1u; } else if (c1 >= (unsigned)CAP) { lo = t1; hi = t2 - 1u; } else hi = t1 - 1u;
        }
        const unsigned Tb = lo;
        unsigned cg = 0, ct = 0;
#pragma unroll
        for (int i = 0; i < 4; ++i) { cg += (bits[i] > Tb) ? 1u : 0u; ct += (bits[i] == Tb) ? 1u : 0u; }
        unsigned ngt; const unsigned need = (unsigned)CAP - (ngt = block_sum_u(cg, red + 8 * 36, lane, wave));
        unsigned ttot; unsigned tpre = block_excl_scan(ct, ttot, red + 8 * 37, lane, wave);
        unsigned sel[4], cs = 0;
#pragma unroll
        for (int i = 0; i < 4; ++i) { const bool tie = bits[i] == Tb; sel[i] = (bits[i] > Tb || (tie && tpre < need)) ? 1u : 0u; tpre += tie ? 1u : 0u; cs += sel[i]; }
        unsigned stot; unsigned spre = block_excl_scan(cs, stot, red + 8 * 38, lane, wave);
#pragma unroll
        for (int i = 0; i < 4; ++i) { const int t = 4 * tid + i;
            if ((t >> 10) == half) SLOT[(size_t)(b * SEQ + t) * NE + e] = sel[i] ? (int)spre : -1;
            if (sel[i]) { tok[spre] = t; if ((int)(spre >> 7) == half) GATE[e * 2048 + b * CAP + spre] = __uint_as_float(bits[i]); spre += 1u; } }
        __syncthreads();
#if MOE_FP8
        if (tid < 128) ((int*)(p.ws + WS_TOK))[e * 2048 + b * CAP + half * 128 + tid] = b * SEQ + tok[half * 128 + tid];
#else
        for (int r = half * 128 + wave; r < half * 128 + 128; r += NWAVES) { const v4u* src = (const v4u*)(HX2 + (size_t)(b * SEQ + tok[r]) * D); v4u* dst = (v4u*)(XE + (size_t)(e * 2048 + b * CAP + r) * D);
            dst[lane] = src[lane]; dst[lane + 64] = src[lane + 64]; }
#endif
        __syncthreads();
    }
}

template <bool X1B>
__device__ __forceinline__ void phase_p9(const P& p, int lane, int wave, int vcu, int G) {
    const float* MOD = (const float*)(p.ws + WS_MOD); const float* X1 = (const float*)(p.ws + WS_X1); const int* SLOT = (const int*)(p.ws + WS_SLOT); const bf16* YE = (const bf16*)(p.ws + WS_YE);
    const int gw = vcu * NWAVES + wave, NGW = G * NWAVES;
    f32x4 nx[4]; int nslot = -1;
    auto ldrow = [&](int mm) {
        if constexpr (X1B) { const v2u* xr = (const v2u*)((const bf16*)X1 + (size_t)mm * D) + lane;
#pragma unroll
            for (int jj = 0; jj < 4; ++jj) { const v2u w = xr[64 * jj]; nx[jj] = (f32x4){bflo(w.x), bfhi(w.x), bflo(w.y), bfhi(w.y)}; } }
        else { const f32x4* xr = (const f32x4*)(X1 + (size_t)mm * D) + lane;
#pragma unroll
            for (int jj = 0; jj < 4; ++jj) nx[jj] = xr[64 * jj]; } };
    if (gw < M) { ldrow(gw);
        nslot = SLOT[(size_t)gw * NE + (lane & 15)]; }
    for (int m = gw; m < M; m += NGW) {
        const int b = m >> 11;
        f32x4 v[4], acc[4]; const int myslot = nslot;
#pragma unroll
        for (int jj = 0; jj < 4; ++jj) { v[jj] = nx[jj]; acc[jj] = (f32x4){0.f, 0.f, 0.f, 0.f}; }
        if (m + NGW < M) { ldrow(m + NGW);
            nslot = SLOT[(size_t)(m + NGW) * NE + (lane & 15)]; }
#pragma unroll
        for (int e = 0; e < NE; ++e) { const int sl = __builtin_amdgcn_readlane(myslot, e);
#if MOE_FP8
            if (sl >= 0) { const unsigned* y = (const unsigned*)((const unsigned char*)YE + (size_t)(e * 2048 + b * CAP + sl) * D) + lane;
#pragma unroll
                for (int jj = 0; jj < 4; ++jj) { const unsigned w = y[64 * jj]; const auto lo = __builtin_amdgcn_cvt_pk_f32_fp8((int)w, false), hi = __builtin_amdgcn_cvt_pk_f32_fp8((int)w, true);
                    acc[jj] += (f32x4){lo[0], lo[1], hi[0], hi[1]}; } } }
#else
            if (sl >= 0) { const v2u* y = (const v2u*)(YE + (size_t)(e * 2048 + b * CAP + sl) * D) + lane;
#pragma unroll
                for (int jj = 0; jj < 4; ++jj) { const v2u w = y[64 * jj]; acc[jj] += (f32x4){bflo(w.x), bfhi(w.x), bflo(w.y), bfhi(w.y)}; } } }
#endif
        float s = 0.f;
#pragma unroll
        for (int jj = 0; jj < 4; ++jj) { const int k = 4 * (lane + 64 * jj); const f32x4 g2 = *(const f32x4*)(MOD + b * NMOD + 5 * D + k); v[jj] += g2 * acc[jj] * (MOE_FP8 ? WSCALE_INV : 1.f);
            s += (v[jj].x * v[jj].x + v[jj].y * v[jj].y) + (v[jj].z * v[jj].z + v[jj].w * v[jj].w); }
        const float rinv = rsqrtf(wave_sum(s) * (1.f / D) + EPS);
        f32x4* o = (f32x4*)(p.out + (size_t)m * D) + lane;
#pragma unroll
        for (int jj = 0; jj < 4; ++jj) { const int k = 4 * (lane + 64 * jj); o[64 * jj] = v[jj] * rinv * *(const f32x4*)(p.final_g + k); }
    }
}

__device__ __forceinline__ void p9_finish(const P& p, LAS unsigned char* strip, int lane, int m, const v4u xa, const v4u xb, const f32x2p (&acc)[8], const f32x4 (&g2c)[4], const f32x4 (&fg)[4]) {
    f32x4 v[4];
    v[0] = (f32x4){bflo(xa.x), bfhi(xa.x), bflo(xa.y), bfhi(xa.y)}; v[1] = (f32x4){bflo(xa.z), bfhi(xa.z), bflo(xa.w), bfhi(xa.w)};
    v[2] = (f32x4){bflo(xb.x), bfhi(xb.x), bflo(xb.y), bfhi(xb.y)}; v[3] = (f32x4){bflo(xb.z), bfhi(xb.z), bflo(xb.w), bfhi(xb.w)};
    float s = 0.f;
#pragma unroll
    for (int i = 0; i < 4; ++i) { v[i] += g2c[i] * (f32x4){acc[2 * i].x, acc[2 * i].y, acc[2 * i + 1].x, acc[2 * i + 1].y}; s += (v[i].x * v[i].x + v[i].y * v[i].y) + (v[i].z * v[i].z + v[i].w * v[i].w); }
    const float rinv = rsqrtf(wave_sum(s) * (1.f / D) + EPS);
#pragma unroll
    for (int i = 0; i < 4; ++i) *(LAS f32x4*)(strip + lane * 80 + 16 * i) = v[i] * rinv * fg[i];
    __builtin_amdgcn_fence(__ATOMIC_RELEASE, "wavefront"); __builtin_amdgcn_wave_barrier(); __builtin_amdgcn_fence(__ATOMIC_ACQUIRE, "wavefront");
    f32x4* o = (f32x4*)(p.out + (size_t)m * D) + lane;
#pragma unroll
    for (int jj = 0; jj < 4; ++jj) o[64 * jj] = *(const LAS f32x4*)(strip + ((lane >> 2) + 16 * jj) * 80 + (lane & 3) * 16);
    __builtin_amdgcn_wave_barrier();
}
#define P9_GLD(dst, voff, sbase, OFFS) asm volatile("global_load_dwordx4 %0, %1, %2" OFFS : "=&v"(dst) : "v"(voff), "s"(sbase) : "memory")
__device__ __forceinline__ const unsigned char* uptr(const unsigned char* q) { const unsigned long long v = (unsigned long long)q;
    return (const unsigned char*)(((unsigned long long)(unsigned)__builtin_amdgcn_readfirstlane((int)(v >> 32)) << 32) | (unsigned)__builtin_amdgcn_readfirstlane((int)v)); }
__device__ __forceinline__ void p9_acc(f32x2p (&acc)[8], const v4u w, float sc) {
    const unsigned ww[4] = {w.x, w.y, w.z, w.w};
#pragma unroll
    for (int c = 0; c < 4; ++c) { const f32x2p lo = __builtin_amdgcn_cvt_pk_f32_fp8((int)ww[c], false), hi = __builtin_amdgcn_cvt_pk_f32_fp8((int)ww[c], true); acc[2 * c] += lo * sc; acc[2 * c + 1] += hi * sc; }
}
__device__ __forceinline__ void phase_p9_v2(const P& p, LAS unsigned char* lds, int lane, int wave, int vcu, int G) {
    const float* MOD = (const float*)(p.ws + WS_MOD); const unsigned char* X1b = p.ws + WS_X1; const int* SLOT = (const int*)(p.ws + WS_SLOT); const unsigned char* YE = p.ws + WS_YE;
    const int gw = vcu * NWAVES + wave, m0 = gw * 8, b = m0 >> 11;
    LAS unsigned char* strip = lds + wave * 5120;
    const v2u slv = *(const v2u*)(SLOT + (size_t)m0 * NE + 2 * lane);
    const int sx = (int)slv.x, sy = (int)slv.y;
    f32x4 g2c[4], fg[4];
#pragma unroll
    for (int i = 0; i < 4; ++i) { g2c[i] = *(const f32x4*)(MOD + b * NMOD + 5 * D + 16 * lane + 4 * i) * WSCALE_INV; fg[i] = *(const f32x4*)(p.final_g + 16 * lane + 4 * i); }
    const unsigned long long mk0 = __builtin_amdgcn_ballot_w64(sx >= 0), mk1 = __builtin_amdgcn_ballot_w64(sy >= 0);
#pragma unroll
    for (int i = 0; i < 4; ++i) asm volatile("" : "+v"(g2c[i]), "+v"(fg[i]) :: "memory");
    const int xoff = 32 * lane, yoff = 16 * lane;
    auto entries = [&](int r, int (&yr)[4], float (&sc)[4], unsigned& rest) { unsigned em = ((unsigned)(mk0 >> (8 * r)) & 0xffu) | (((unsigned)(mk1 >> (8 * r)) & 0xffu) << 8);
#pragma unroll
        for (int i = 0; i < 4; ++i) { yr[i] = 0; sc[i] = 0.f;
            if (em) { const int pos = __builtin_ctz(em); em &= em - 1u; const int j = pos & 7, c = pos >> 3; const int sa = __builtin_amdgcn_readlane(sx, 8 * r + j), sb = __builtin_amdgcn_readlane(sy, 8 * r + j);
                yr[i] = (2 * j + c) * 2048 + b * CAP + (c ? sb : sa); sc[i] = 1.f; } }
        rest = em; };
#define P9_ISSUE(S, rr) do { const int r_ = min((rr), 7); int yr_[4]; float sc_[4]; unsigned rest_; entries(r_, yr_, sc_, rest_); \
        const unsigned char* xb_ = uptr(X1b + (size_t)(m0 + r_) * (D * 2)); \
        P9_GLD(X##S##0, xoff, xb_, ""); P9_GLD(X##S##1, xoff, xb_, " offset:16"); \
        P9_GLD(Y##S##0, yoff, uptr(YE + (size_t)yr_[0] * D), ""); P9_GLD(Y##S##1, yoff, uptr(YE + (size_t)yr_[1] * D), ""); \
        P9_GLD(Y##S##2, yoff, uptr(YE + (size_t)yr_[2] * D), ""); P9_GLD(Y##S##3, yoff, uptr(YE + (size_t)yr_[3] * D), ""); } while (0)
#define P9_WAIT(S, n) asm volatile("s_waitcnt vmcnt(%6) ; retires %0 %1 %2 %3 %4 %5" : "+v"(X##S##0), "+v"(X##S##1), "+v"(Y##S##0), "+v"(Y##S##1), "+v"(Y##S##2), "+v"(Y##S##3) : "n"(n) : "memory")
#define P9_PROC(S, rr) do { const int r_ = (rr); int yr_[4]; float sc_[4]; unsigned rest_; entries(r_, yr_, sc_, rest_); \
        f32x2p acc_[8]; _Pragma("unroll") for (int i = 0; i < 8; ++i) acc_[i] = (f32x2p){0.f, 0.f}; \
        p9_acc(acc_, Y##S##0, sc_[0]); p9_acc(acc_, Y##S##1, sc_[1]); p9_acc(acc_, Y##S##2, sc_[2]); p9_acc(acc_, Y##S##3, sc_[3]); \
        while (rest_) { const int pos = __builtin_ctz(rest_); rest_ &= rest_ - 1u; const int j = pos & 7, c = pos >> 3; const int sa = __builtin_amdgcn_readlane(sx, 8 * r_ + j), sb = __builtin_amdgcn_readlane(sy, 8 * r_ + j); \
            const v4u w_ = *(const v4u*)(YE + (size_t)((2 * j + c) * 2048 + b * CAP + (c ? sb : sa)) * D + yoff); p9_acc(acc_, w_, 1.f); } \
        p9_finish(p, strip, lane, m0 + r_, X##S##0, X##S##1, acc_, g2c, fg); } while (0)
    v4u XA0, XA1, YA0, YA1, YA2, YA3, XB0, XB1, YB0, YB1, YB2, YB3, XC0, XC1, YC0, YC1, YC2, YC3;
    P9_ISSUE(A, 0); P9_ISSUE(B, 1);
    for (int it = 0; it < 3; ++it) { const int r = 3 * it;
        P9_ISSUE(C, r + 2); if (it == 0) asm volatile("s_waitcnt vmcnt(12)" ::: "memory"); P9_WAIT(A, 20); P9_PROC(A, r);
        P9_ISSUE(A, r + 3); if (it == 0) asm volatile("s_waitcnt vmcnt(16)" ::: "memory"); P9_WAIT(B, 20); P9_PROC(B, r + 1);
        P9_ISSUE(B, r + 4); P9_WAIT(C, 20); if (r + 2 < 8) P9_PROC(C, r + 2);
    }
    asm volatile("s_waitcnt vmcnt(0)" ::: "memory");
}

#if CONV_CUS && MOE_FP8 && XCD_BAR && LRU1_MFMA && SGU_MFMA && LRU2_FAST && P6_FAST && USE_PG8 && (MK_N_LAUNCHES == 1)
__global__ void __launch_bounds__(NTHREADS, 2) fwd_megakernel(P p) {
    extern __shared__ __attribute__((aligned(16))) unsigned char lds_raw[];
    LAS unsigned char* lds = (LAS unsigned char*)lds_raw;
    const int tid = threadIdx.x, lane = tid & 63, wave = __builtin_amdgcn_readfirstlane(tid >> 6);
    const int G = gridDim.x, bx = blockIdx.x, xg = bx & 7, xl = bx >> 3;
    const int vcu = (G % 8 == 0) ? xg * (G / 8) + xl : bx;
    constexpr int CSH = (NCONV == 64) ? 2 : 3, CPG = 32 >> CSH, WPG = 32 - CPG;
    const bool split = (G == 256), is_conv = split && ((xl & ((1 << CSH) - 1)) == (1 << CSH) - 1);
    const int GW = split ? 8 * WPG : G, wvcu = split ? xg * WPG + (xl - (xl >> CSH)) : vcu, cvcu = xg * CPG + (xl >> CSH);
    volatile LAS unsigned* bst = (volatile LAS unsigned*)(lds + LDS_BYTES - 16);
    if (tid < 4) bst[tid] = 0u;
    __syncthreads();
    unsigned* ctl = (unsigned*)(p.ws + WS_CTL);
    const XcdBarrier barA = xcd_barrier_post(ctl + 4096, bst, (unsigned)G);
    XcdBarrier barW = barA;
    if (split && !is_conv) barW = xcd_barrier_post(ctl + 4096 + XCD_BAR_WORDS, bst + 2, (unsigned)GW);

    if (is_conv) {
        convert_pipelined(p, lds, lane, wave, CONV_HEAD, CONV_ITEMS, cvcu * NWAVES + wave, 8 * CPG * NWAVES);
        if (tid == 0) { XB_SPIN(xb_ld(ctl + 64) == 0u, ctl + 4096); __builtin_amdgcn_fence(__ATOMIC_ACQUIRE, "agent"); asm volatile("s_waitcnt vmcnt(0)" ::: "memory"); }
        __syncthreads();
        phase_sgu_mfma(p, lds, tid, lane, wave, cvcu, 8 * CPG, 0, SGU_CONV_TASKS);
    } else {
        phase_p0(p, lds, tid, lane, wave, wvcu, GW, split ? 16 * 32 : CONV_ITEMS, !split);
        xcd_barrier(barW);
        phase_p1(p, lane, wave, wvcu, GW);
        if (split) {
            split_arrive(ctl + SB_BASE, barW.x, bst + 2);
            convert_items(p, lds, lane, wave, 16 * 32, CONV_HEAD, wvcu * NWAVES + wave, GW * NWAVES); p0_small_copies(p, tid, wvcu, GW);
            split_wait(ctl + SB_BASE, ctl + 4096);
        } else xcd_barrier(barW);
        { pg8::Gemm g{(const bf16*)(p.ws + WS_HX), (const bf16*)(p.ws + WS_WIN), D}; SchedG1 S{GW, wvcu}; EpiG1 E{(bf16*)(p.ws + WS_UV), (bf16*)(p.ws + WS_XC)};
          pg8::gemm_phase<EpiG1, SchedG1, true, true>(lds, g, S, E); }
        xcd_barrier(barW);
        if (split && wvcu == 0 && tid == 0) __hip_atomic_store(ctl + 64, 1u, __ATOMIC_RELAXED, __HIP_MEMORY_SCOPE_AGENT);
#if LRU1_V2
        phase_lru1_v2(p, lds, tid, lane, wave, wvcu, GW);
#else
        phase_lru1_mfma(p, lds, tid, lane, wave, wvcu, GW);
#endif
        if (split) split_arrive(ctl + SB_BASE + XS_WORDS, barW.x, bst + 2);
        phase_sgu_mfma(p, lds, tid, lane, wave, wvcu, GW, split ? SGU_CONV_TASKS : 0, 512);
        if (split) split_wait(ctl + SB_BASE + XS_WORDS, ctl + 4096); else xcd_barrier(barW);
        phase_lru2_fast(p, lds, tid, wvcu, GW);
    }
    xcd_barrier(barA);
    if (split) {
        pg8::Gemm g{(const bf16*)(p.ws + WS_A2), (const bf16*)(p.ws + WS_WOUT), D}; SchedG2 S{G, vcu};
        EpiG2F E{p.x, (const float*)(p.ws + WS_MOD), (float*)(p.ws + WS_X1), p.w_router, p.norm2_g, (const float*)(p.ws + WS_CB), (float*)(p.ws + WS_XCH), ctl + 2048, ctl + 4096, p.ws + WS_HX2, (float*)(p.ws + WS_AFF)};
        pg8::gemm_phase<EpiG2F, SchedG2, true, true>(lds, g, S, E);
    } else {
        { pg8::Gemm g{(const bf16*)(p.ws + WS_A2), (const bf16*)(p.ws + WS_WOUT), D}; SchedG2 S{G, vcu}; EpiG2 E{p.x, (const float*)(p.ws + WS_MOD), (float*)(p.ws + WS_X1)};
          pg8::gemm_phase<EpiG2, SchedG2, true, true>(lds, g, S, E); }
        xcd_barrier(barA);
        phase_p5(p, lds, tid, lane, wave, vcu, G);
    }
    xcd_barrier(barA);
    phase_p6_fast(p, lds, tid, lane, wave, vcu, G);
    xcd_barrier(barA);
    { pg8::Gemm g{(const bf16*)(p.ws + WS_HX2), (const bf16*)(p.ws + WS_WG), D}; SchedG3 S{G, vcu}; EpiG3 E{p.ws + WS_HID};
      pg8::gemm_phase_f8g<EpiG3, SchedG3, true, true>(lds, g, S, E, (const int*)(p.ws + WS_TOK)); }
    xcd_barrier(barA);
    { pg8::Gemm g{(const bf16*)(p.ws + WS_HID), (const bf16*)(p.ws + WS_W2), DE}; SchedG4 S{G, vcu}; EpiG4 E{(const float*)(p.ws + WS_GATE), p.ws + WS_YE};
      pg8::gemm_phase_f8<EpiG4, SchedG4, true, true>(lds, g, S, E); }
    xcd_barrier(barA);
    if (split) phase_p9_v2(p, lds, lane, wave, vcu, G); else phase_p9<false>(p, lane, wave, vcu, G);
}
#else
__global__ void __launch_bounds__(NTHREADS, 2) fwd_megakernel(P p) {
    extern __shared__ __attribute__((aligned(16))) unsigned char lds_raw[];
    LAS unsigned char* lds = (LAS unsigned char*)lds_raw;
    const int tid = threadIdx.x, lane = tid & 63, wave = __builtin_amdgcn_readfirstlane(tid >> 6);
    const int G = gridDim.x, bx = blockIdx.x, vcu = (G % 8 == 0) ? (bx % 8) * (G / 8) + bx / 8 : bx;
    const int lo = p.ph_lo, hi = p.ph_hi;
#if XCD_BAR
    volatile LAS unsigned* bst = (volatile LAS unsigned*)(lds + LDS_BYTES - 16);
    if (tid < 2) bst[tid] = 0u;
    __syncthreads();
    XcdBarrier bar; bar.bar = (unsigned*)(p.ws + WS_CTL) + 4096; bar.x = 0; bar.st = bst; bar.total = (unsigned)G;
    if (hi - lo > 1) bar = xcd_barrier_post((unsigned*)(p.ws + WS_CTL) + 4096, bst, (unsigned)G);
#define GRID_SYNC() xcd_barrier(bar)
#else
    cg::grid_group grid = cg::this_grid();
#define GRID_SYNC() grid.sync()
#endif
#define IN(k) (lo <= (k) && (k) < hi)
#define SEAM(k) do { if (IN(k) && IN((k) + 1)) GRID_SYNC(); } while (0)
#define REP(k) for (int rep_ = 0; rep_ < 1 + ((DUP_MASK >> (k)) & 1); ++rep_)
    if (IN(0)) { REP(0) { phase_p0(p, lds, tid, lane, wave, vcu, G, CONV_CUT); __syncthreads(); } SEAM(0); }
    if (IN(1)) { REP(1) phase_p1(p, lane, wave, vcu, G); SEAM(1); }
    if ((DUP_MASK >> 12) & 1) { for (int xb = 0; xb < 8; ++xb) GRID_SYNC(); }
    if (IN(2)) { pg8::Gemm g{(const bf16*)(p.ws + WS_HX), (const bf16*)(p.ws + WS_WIN), D}; SchedG1 S{G, vcu}; EpiG1 E{(bf16*)(p.ws + WS_UV), (bf16*)(p.ws + WS_XC)};
        REP(2) { gemm_any(lds, g, S, E); if (G > 16 && vcu >= 16) convert_items(p, lds, lane, wave, CONV_CUT, CONV_ITEMS, (vcu - 16) * NWAVES + wave, (G - 16) * NWAVES); }
        if (G <= 16) convert_items(p, lds, lane, wave, CONV_CUT, CONV_ITEMS, vcu * NWAVES + wave, G * NWAVES);
        SEAM(2); }
    if (IN(3)) { REP(3) {
#if LRU1_MFMA
        phase_lru1_mfma(p, lds, tid, lane, wave, vcu, G);
#else
        phase_lru1(p, lds, tid, vcu, G);
#endif
        } REP(11) {
#if SGU_MFMA
        phase_sgu_mfma(p, lds, tid, lane, wave, vcu, G);
#else
        phase_sgu(p, lds, tid, vcu, G);
#endif
        } SEAM(3); }
    if (IN(4)) { REP(4) {
#if LRU2_FAST
        phase_lru2_fast(p, lds, tid, vcu, G);
#else
        phase_lru2(p, lds, tid, vcu, G);
#endif
        } SEAM(4); }
    if (IN(5)) { pg8::Gemm g{(const bf16*)(p.ws + WS_A2), (const bf16*)(p.ws + WS_WOUT), D}; SchedG2 S{G, vcu}; EpiG2 E{p.x, (const float*)(p.ws + WS_MOD), (float*)(p.ws + WS_X1)};
        REP(5) gemm_any(lds, g, S, E); SEAM(5); }
    if (IN(6)) { REP(6) phase_p5(p, lds, tid, lane, wave, vcu, G); SEAM(6); }
    if (IN(7)) { REP(7) {
#if P6_FAST
        phase_p6_fast(p, lds, tid, lane, wave, vcu, G);
#else
        phase_p6(p, lds, tid, lane, wave, vcu, G);
#endif
        } SEAM(7); }
#if MOE_FP8
    if (IN(8)) { pg8::Gemm g{(const bf16*)(p.ws + WS_XE), (const bf16*)(p.ws + WS_WG), D}; SchedG3 S{G, vcu}; EpiG3 E{p.ws + WS_HID};
        REP(8) pg8::gemm_phase_f8<EpiG3, SchedG3, true, true>(lds, g, S, E); SEAM(8); }
    if (IN(9)) { pg8::Gemm g{(const bf16*)(p.ws + WS_HID), (const bf16*)(p.ws + WS_W2), DE}; SchedG4 S{G, vcu}; EpiG4 E{(const float*)(p.ws + WS_GATE), p.ws + WS_YE};
        REP(9) pg8::gemm_phase_f8<EpiG4, SchedG4, true, true>(lds, g, S, E); SEAM(9); }
#else
    if (IN(8)) { pg8::Gemm g{(const bf16*)(p.ws + WS_XE), (const bf16*)(p.ws + WS_WG), D}; SchedG3 S{G, vcu}; EpiG3 E{(bf16*)(p.ws + WS_HID)};
        REP(8) gemm_any(lds, g, S, E); SEAM(8); }
    if (IN(9)) { pg8::Gemm g{(const bf16*)(p.ws + WS_HID), (const bf16*)(p.ws + WS_W2), DE}; SchedG4 S{G, vcu}; EpiG4 E{(const float*)(p.ws + WS_GATE), (bf16*)(p.ws + WS_YE)};
        REP(9) gemm_any(lds, g, S, E); SEAM(9); }
#endif
    if (IN(10)) { REP(10) phase_p9<false>(p, lane, wave, vcu, G); }
#undef IN
#undef REP
#undef SEAM
#undef GRID_SYNC
}

#endif

extern "C" void kernel_launch(void* const* d_in, const int* in_sizes, int n_in, void* d_out, int out_size, void* d_ws, size_t ws_size, hipStream_t stream) {
    static int grid = 0;
    if (grid == 0) {
        if (n_in != 25 || in_sizes[0] != M * D || out_size != M * D || ws_size < WS_END) { fprintf(stderr, "kernel_launch: unexpected shapes (n_in %d, in0 %d, out %d, ws %zu < %zu)\n", n_in, n_in > 0 ? in_sizes[0] : -1, out_size, ws_size, (size_t)WS_END); grid = -1; return; }
        int dev = 0, cus = 0, per_cu = 0;
        if (hipGetDevice(&dev) != hipSuccess || hipDeviceGetAttribute(&cus, hipDeviceAttributeMultiprocessorCount, dev) != hipSuccess) { grid = -1; return; }
        if (hipFuncSetAttribute((const void*)fwd_megakernel, hipFuncAttributeMaxDynamicSharedMemorySize, LDS_BYTES) != hipSuccess) { fprintf(stderr, "kernel_launch: hipFuncSetAttribute failed\n"); grid = -1; return; }
        if (hipOccupancyMaxActiveBlocksPerMultiprocessor(&per_cu, (const void*)fwd_megakernel, NTHREADS, LDS_BYTES) != hipSuccess || per_cu < 1) { fprintf(stderr, "kernel_launch: occupancy query failed (%d)\n", per_cu); (void)hipGetLastError(); grid = -1; return; }
        grid = cus * per_cu;
    }
    if (grid < 0) return;
#if XCD_BAR
    if (hipMemsetAsync((char*)d_ws + WS_CTL, 0, 65536, stream) != hipSuccess) { fprintf(stderr, "kernel_launch: hipMemsetAsync failed\n"); return; }
#endif
    P p{};
    const float** f = (const float**)&p;
    for (int i = 0; i < 25; ++i) f[i] = (const float*)d_in[i];
    p.out = (float*)d_out; p.ws = (unsigned char*)d_ws;
#if MK_N_LAUNCHES == 1
    p.ph_lo = 0; p.ph_hi = NPH; void* args[] = {&p};
    hipError_t e = hipLaunchCooperativeKernel((const void*)fwd_megakernel, dim3(grid), dim3(NTHREADS), args, LDS_BYTES, stream);
    if (e != hipSuccess) fprintf(stderr, "kernel_launch: cooperative launch failed: %s (grid %d)\n", hipGetErrorString(e), grid);
#else
    for (int ph = 0; ph < NPH; ++ph) { p.ph_lo = ph; p.ph_hi = ph + 1; hipLaunchKernelGGL(fwd_megakernel, dim3(grid), dim3(NTHREADS), LDS_BYTES, stream, p); }
#endif
}
```

```cpp
#include <hip/hip_runtime.h>
#include <hip/hip_cooperative_groups.h>
#include <cstdio>
#include <cstdint>
namespace cg = cooperative_groups;

#ifndef MK_N_LAUNCHES
#define MK_N_LAUNCHES 1
#endif
#ifndef XCD_BAR
#define XCD_BAR 1
#endif
#ifndef LRU1_MFMA
#define LRU1_MFMA 1
#endif
#ifndef SGU_MFMA
#define SGU_MFMA 1
#endif
#ifndef P6_FAST
#define P6_FAST 1
#endif
#ifndef DUP_MASK
#define DUP_MASK 0
#endif
#ifndef LRU2_FAST
#define LRU2_FAST 1
#endif
#ifndef MOE_FP8
#define MOE_FP8 1
#endif
#ifndef CONV_CUS
#define CONV_CUS 1
#endif
#ifndef NCONV
#define NCONV 64
#endif
#ifndef LRU1_V2
#define LRU1_V2 1
#endif
#ifndef SGU_CONV_TASKS
#define SGU_CONV_TASKS 320
#endif
#ifndef LRU2_PARTS
#define LRU2_PARTS 8
#endif
#ifndef USE_PG8
#define USE_PG8 1
#endif

namespace pg8 {
#define PG8_LAS __attribute__((address_space(3)))
typedef unsigned short bf16_t;
typedef short bf16x8 __attribute__((ext_vector_type(8)));
typedef float f32x4 __attribute__((ext_vector_type(4)));
typedef unsigned u32x4 __attribute__((ext_vector_type(4)));
typedef int v4i_t __attribute__((ext_vector_type(4)));
typedef int v8i_t __attribute__((ext_vector_type(8)));
constexpr int BM = 256, BK = 64, HALF = 128, HTB = HALF * BK * 2  , STAGE_BYTES = 8 * HTB;

__host__ __device__ __forceinline__ int lds_byte(int r, int c) { const int st = (r >> 4) * 2 + (c >> 5), rr = r & 15, cc = c & 31, ob = rr * 64 + cc * 2; return st * 1024 + (ob ^ (((ob >> 9) & 1) << 5)); }
__host__ __device__ __forceinline__ void stage_rc(int b, int& R, int& C) { const int st = b / 1024, sb = b % 1024, swz = sb ^ (((sb >> 9) & 1) << 5); R = (st >> 1) * 16 + swz / 64; C = (st & 1) * 32 + (swz % 64) / 2; }

struct Unit { int pm, pn, pnB; };
struct NoGate { __device__ __forceinline__ void operator()() const {} };
struct Gemm { const bf16_t* A; const bf16_t* Bt; int K; };

template <class Epi>
__device__ __forceinline__ void run_epi8(const Epi& E, const f32x4 (&acc)[2][2][4][2], const Unit& u, int wr, int wc, int fr, int fq) {
#pragma unroll
    for (int ai = 0; ai < 2; ++ai)
#pragma unroll
        for (int m = 0; m < 4; ++m) { const int row = ai * HALF + wr * 64 + m * 16 + fr;
            if constexpr (Epi::PAIRED) E.st2x8(u, row, wc * 32 + 8 * fq, acc[ai][0][m][0], acc[ai][0][m][1], acc[ai][1][m][0], acc[ai][1][m][1]);
            else {
#pragma unroll
                for (int bj = 0; bj < 2; ++bj) E.st8(u, row, bj * HALF + wc * 32 + 8 * fq, acc[ai][bj][m][0], acc[ai][bj][m][1]);
            } }
}
template <class Epi>
__device__ __forceinline__ void run_epi(const Epi& E, const f32x4 (&acc)[2][2][4][2], const Unit& u, int wr, int wc, int fr, int fq) {
#pragma unroll
    for (int ai = 0; ai < 2; ++ai)
#pragma unroll
        for (int m = 0; m < 4; ++m) { const int row = ai * HALF + wr * 64 + m * 16 + fr;
            if constexpr (Epi::PAIRED) {
#pragma unroll
                for (int n = 0; n < 2; ++n) E.st2(u, row, wc * 32 + n * 16 + 4 * fq, acc[ai][0][m][n], acc[ai][1][m][n]);
            } else {
#pragma unroll
                for (int bj = 0; bj < 2; ++bj)
#pragma unroll
                    for (int n = 0; n < 2; ++n) E.st(u, row, bj * HALF + wc * 32 + n * 16 + 4 * fq, acc[ai][bj][m][n]);
            } }
}

template <class Epi, class Sched, bool ALIGN_EPI = false, bool SP2 = false, class Gate = NoGate>
__device__ __forceinline__ void gemm_phase(PG8_LAS unsigned char* lds, const Gemm g, const Sched& S, const Epi& E, const Gate& gate = Gate()) {
    const int tid = threadIdx.x, wid = __builtin_amdgcn_readfirstlane(tid >> 6), lane = tid & 63, wr = wid >> 2, wc = wid & 3, fr = lane & 15, fq = lane >> 4;
    const int K = g.K, nt = K / BK;
    unsigned voffA[2], voffB[2];
#pragma unroll
    for (int i = 0; i < 2; ++i) { int R, C; stage_rc(tid * 16 + i * 8192, R, C); const int rho = R & 31, Rb = (R & ~31) + 8 * ((rho & 15) >> 2) + 4 * (rho >> 4) + (rho & 3);
        voffA[i] = (unsigned)(R * K + C) * 2u; voffB[i] = (unsigned)(Rb * K + C) * 2u; }
    const size_t kstep = (size_t)(BK * 2);
    const size_t hstep = (size_t)HALF * K * 2;
    const size_t tstep = 2 * hstep;
    const unsigned ldsw = (unsigned)wid * 1024u;
    const int aoff = lds_byte(wr * 64 + fr, fq * 8), boff = lds_byte(wc * 32 + fr, fq * 8);
#define PG8_SA(b, h) (((b) * 2 + (h)) * HTB)
#define PG8_SB(b, h) ((4 + (b) * 2 + (h)) * HTB)
#define PG8_STAGE(bufoff, gbase, voff) do { _Pragma("unroll") for (int _i = 0; _i < 2; ++_i) \
        __builtin_amdgcn_global_load_lds((const unsigned*)((const char*)(gbase) + (voff)[_i]), (PG8_LAS unsigned*)(lds + (bufoff) + ldsw + _i * 8192), 16, 0, 0); } while (0)
#define PG8_LDA(dst, b, h) do { _Pragma("unroll") for (int m = 0; m < 4; ++m) _Pragma("unroll") for (int k = 0; k < 2; ++k) dst[m][k] = *(const PG8_LAS bf16x8*)(lds + PG8_SA(b, h) + aoff + m * 2048 + k * 1024); } while (0)
#define PG8_LDB(dst, b, h) do { _Pragma("unroll") for (int n = 0; n < 2; ++n) _Pragma("unroll") for (int k = 0; k < 2; ++k) dst[n][k] = *(const PG8_LAS bf16x8*)(lds + PG8_SB(b, h) + boff + n * 2048 + k * 1024); } while (0)
#define PG8_MMA(ai, bj, At, Bt) do { __builtin_amdgcn_s_setprio(1); _Pragma("unroll") for (int m = 0; m < 4; ++m) _Pragma("unroll") for (int n = 0; n < 2; ++n) _Pragma("unroll") for (int k = 0; k < 2; ++k) \
        acc[ai][bj][m][n] = __builtin_amdgcn_mfma_f32_16x16x32_bf16(Bt[n][k], At[m][k], acc[ai][bj][m][n], 0, 0, 0); __builtin_amdgcn_s_setprio(0); } while (0)
#define PG8_WAIT_V(n) asm volatile("s_waitcnt vmcnt(" #n ")" ::: "memory")
#define PG8_WAIT_L(n) asm volatile("s_waitcnt lgkmcnt(" #n ")" ::: "memory")
#define PG8_BAR __builtin_amdgcn_s_barrier()
#define PG8_SCHED __builtin_amdgcn_sched_barrier(0)
    Unit cur, nxt; int ui = 0;
    if (!S.next(0, cur)) return;
    f32x4 acc[2][2][4][2];
#pragma unroll
    for (int a = 0; a < 2; ++a)
#pragma unroll
        for (int b = 0; b < 2; ++b)
#pragma unroll
            for (int m = 0; m < 4; ++m)
#pragma unroll
                for (int n = 0; n < 2; ++n) acc[a][b][m][n] = (f32x4){0.f, 0.f, 0.f, 0.f};
    bf16x8 At[4][2], B0[2][2], B1[2][2];
    const char* cA = (const char*)g.A + (size_t)cur.pm * tstep; const char* cB = (const char*)g.Bt + (size_t)cur.pnB * tstep;

    if constexpr (SP2) {
        PG8_STAGE(PG8_SB(0, 0), cB, voffB); PG8_STAGE(PG8_SB(0, 1), cB + hstep, voffB); gate(); PG8_STAGE(PG8_SA(0, 0), cA, voffA); PG8_STAGE(PG8_SA(0, 1), cA + hstep, voffA);
        if (wr == 1) PG8_BAR;
        PG8_WAIT_V(2); PG8_BAR;
        PG8_STAGE(PG8_SB(1, 0), cB + kstep, voffB); PG8_STAGE(PG8_SA(1, 0), cA + kstep, voffA); PG8_STAGE(PG8_SB(1, 1), cB + hstep + kstep, voffB);
        PG8_WAIT_V(6); PG8_BAR;
    } else {
        gate(); PG8_STAGE(PG8_SB(0, 0), cB, voffB); PG8_STAGE(PG8_SA(0, 0), cA, voffA); PG8_STAGE(PG8_SB(0, 1), cB + hstep, voffB); PG8_STAGE(PG8_SA(0, 1), cA + hstep, voffA);
        if (wr == 1) PG8_BAR;
        PG8_WAIT_V(4); PG8_BAR;
        PG8_STAGE(PG8_SB(1, 0), cB + kstep, voffB); PG8_STAGE(PG8_SA(1, 0), cA + kstep, voffA); PG8_STAGE(PG8_SB(1, 1), cB + hstep + kstep, voffB);
        PG8_WAIT_V(6); PG8_BAR;
    }
    for (;;) {
        const bool has_next = S.next(ui + 1, nxt);
        const char* nA = has_next ? (const char*)g.A + (size_t)nxt.pm * tstep : cA; const char* nB = has_next ? (const char*)g.Bt + (size_t)nxt.pnB * tstep : cB;
        for (int t = 0; t < nt; t += 2) {
            const bool last = (t == nt - 2);
            const char* a1 = cA + (size_t)(t + 1) * kstep;
            const char* a2 = last ? nA : cA + (size_t)(t + 2) * kstep; const char* b2 = last ? nB : cB + (size_t)(t + 2) * kstep;
            const char* a3 = a2 + kstep; const char* b3 = b2 + kstep;

            if constexpr (SP2) {
            PG8_LDB(B0, 0, 0); PG8_LDB(B1, 0, 1); PG8_SCHED; PG8_LDA(At, 0, 0); PG8_STAGE(PG8_SA(1, 1), a1 + hstep, voffA);
            PG8_WAIT_V(8); PG8_WAIT_L(0); PG8_BAR; PG8_MMA(0, 0, At, B0); PG8_MMA(0, 1, At, B1); PG8_BAR; PG8_SCHED;
            PG8_LDA(At, 0, 1); PG8_STAGE(PG8_SB(0, 0), b2, voffB); PG8_STAGE(PG8_SB(0, 1), b2 + hstep, voffB); PG8_STAGE(PG8_SA(0, 0), a2, voffA);
            PG8_WAIT_V(8); PG8_WAIT_L(0); PG8_BAR; PG8_MMA(1, 0, At, B0); PG8_MMA(1, 1, At, B1); PG8_BAR; PG8_SCHED;
            PG8_LDB(B0, 1, 0); PG8_LDB(B1, 1, 1); PG8_SCHED; PG8_LDA(At, 1, 0); PG8_STAGE(PG8_SA(0, 1), a2 + hstep, voffA);
            PG8_WAIT_V(8); PG8_WAIT_L(0); PG8_BAR; PG8_MMA(0, 0, At, B0); PG8_MMA(0, 1, At, B1); PG8_BAR; PG8_SCHED;
            PG8_LDA(At, 1, 1); PG8_STAGE(PG8_SB(1, 0), b3, voffB); PG8_STAGE(PG8_SB(1, 1), b3 + hstep, voffB); PG8_STAGE(PG8_SA(1, 0), a3, voffA);
            PG8_WAIT_V(8); PG8_WAIT_L(0); PG8_BAR; PG8_MMA(1, 0, At, B0); PG8_MMA(1, 1, At, B1); PG8_BAR; PG8_SCHED;
            } else {
            PG8_LDB(B0, 0, 0); PG8_SCHED; PG8_LDA(At, 0, 0); PG8_STAGE(PG8_SA(1, 1), a1 + hstep, voffA);
            PG8_WAIT_L(8); PG8_BAR; PG8_WAIT_L(0); PG8_MMA(0, 0, At, B0); PG8_BAR; PG8_SCHED;
            PG8_LDB(B1, 0, 1); PG8_STAGE(PG8_SB(0, 0), b2, voffB);
            PG8_BAR; PG8_WAIT_L(0); PG8_MMA(0, 1, At, B1); PG8_BAR;
            PG8_LDA(At, 0, 1); PG8_STAGE(PG8_SA(0, 0), a2, voffA);
            PG8_BAR; PG8_WAIT_L(0); PG8_MMA(1, 0, At, B0); PG8_BAR; PG8_SCHED;
            PG8_STAGE(PG8_SB(0, 1), b2 + hstep, voffB);
            PG8_WAIT_V(6); PG8_BAR; PG8_MMA(1, 1, At, B1); PG8_BAR;
            PG8_LDB(B0, 1, 0); PG8_SCHED; PG8_LDA(At, 1, 0); PG8_STAGE(PG8_SA(0, 1), a2 + hstep, voffA);
            PG8_WAIT_L(8); PG8_BAR; PG8_WAIT_L(0); PG8_MMA(0, 0, At, B0); PG8_BAR; PG8_SCHED;
            PG8_LDB(B1, 1, 1); PG8_STAGE(PG8_SB(1, 0), b3, voffB);
            PG8_BAR; PG8_WAIT_L(0); PG8_MMA(0, 1, At, B1); PG8_BAR;
            PG8_LDA(At, 1, 1); PG8_STAGE(PG8_SA(1, 0), a3, voffA);
            PG8_BAR; PG8_WAIT_L(0); PG8_MMA(1, 0, At, B0); PG8_BAR; PG8_SCHED;
            PG8_STAGE(PG8_SB(1, 1), b3 + hstep, voffB);
            PG8_WAIT_V(6); PG8_BAR; PG8_MMA(1, 1, At, B1); PG8_BAR;
            }
        }
        if constexpr (ALIGN_EPI) { if (wr == 0) PG8_BAR; }
        if constexpr (!Epi::FUSED) run_epi8(E, acc, cur, wr, wc, fr, fq);
        if (!has_next) break;
#pragma unroll
        for (int a = 0; a < 2; ++a)
#pragma unroll
            for (int b = 0; b < 2; ++b)
#pragma unroll
                for (int m = 0; m < 4; ++m)
#pragma unroll
                    for (int n = 0; n < 2; ++n) acc[a][b][m][n] = (f32x4){0.f, 0.f, 0.f, 0.f};
        cur = nxt; cA = nA; cB = nB; ++ui;
        if constexpr (ALIGN_EPI) { if (wr == 1) PG8_BAR; }
    }
    PG8_WAIT_V(0);
    if constexpr (!ALIGN_EPI) { if (wr == 0) PG8_BAR; }
    PG8_BAR;
    if constexpr (Epi::FUSED) E.fused(acc, cur, wr, wc, fr, fq, lds, wid, lane);

#undef PG8_SA
#undef PG8_SB
#undef PG8_STAGE
#undef PG8_LDA
#undef PG8_LDB
#undef PG8_MMA
#undef PG8_WAIT_V
#undef PG8_WAIT_L
#undef PG8_BAR
#undef PG8_SCHED
}

template <class Epi, class Sched, bool ALIGN_EPI = false, bool SP2 = false, class Gate = NoGate>
__device__ __forceinline__ void gemm_phase_f8(PG8_LAS unsigned char* lds, const Gemm g, const Sched& S, const Epi& E, const Gate& gate = Gate()) {
    const int tid = threadIdx.x, wid = __builtin_amdgcn_readfirstlane(tid >> 6), lane = tid & 63, wr = wid >> 2, wc = wid & 3, fr = lane & 15, fq = lane >> 4;
    const int RP = g.K, nt = RP / 128;
    unsigned voffA[2], voffB[2];
#pragma unroll
    for (int i = 0; i < 2; ++i) { const int b_ = tid * 16 + i * 8192, R = b_ >> 7, pp = (b_ >> 4) & 7, rr_ = R & 15, ff = ((rr_ >> 1) & 1) | (((rr_ >> 3) & 1) << 2);
        const int rho = R & 31, Rb = (R & ~31) + 8 * ((rho & 15) >> 2) + 4 * (rho >> 4) + (rho & 3);
        voffA[i] = (unsigned)(R * RP + ((pp ^ ff) * 16)); voffB[i] = (unsigned)(Rb * RP + ((pp ^ ff) * 16)); }
    const size_t kstep = (size_t)(BK * 2);
    const size_t hstep = (size_t)HALF * RP;
    const size_t tstep = 2 * hstep;
    const unsigned ldsw = (unsigned)wid * 1024u;
    const int ffr = ((fr >> 1) & 1) | (((fr >> 3) & 1) << 2);
    const int aoff = (wr * 64 + fr) * 128 + (((2 * fq) ^ ffr) * 16), boff = (wc * 32 + fr) * 128 + (((2 * fq) ^ ffr) * 16), hoff = (ffr & 1) ? -16 : 16;
#define PG8_SA(b, h) (((b) * 2 + (h)) * HTB)
#define PG8_SB(b, h) ((4 + (b) * 2 + (h)) * HTB)
#define PG8_STAGE(bufoff, gbase, voff) do { _Pragma("unroll") for (int _i = 0; _i < 2; ++_i) \
        __builtin_amdgcn_global_load_lds((const unsigned*)((const char*)(gbase) + (voff)[_i]), (PG8_LAS unsigned*)(lds + (bufoff) + ldsw + _i * 8192), 16, 0, 0); } while (0)
#define PG8_LDA(dst, b, h) do { _Pragma("unroll") for (int m = 0; m < 4; ++m) { dst[m].lo = *(const PG8_LAS v4i_t*)(lds + PG8_SA(b, h) + aoff + m * 2048); dst[m].hi = *(const PG8_LAS v4i_t*)(lds + PG8_SA(b, h) + aoff + m * 2048 + hoff); } } while (0)
#define PG8_LDB(dst, b, h) do { _Pragma("unroll") for (int n = 0; n < 2; ++n) { dst[n].lo = *(const PG8_LAS v4i_t*)(lds + PG8_SB(b, h) + boff + n * 2048); dst[n].hi = *(const PG8_LAS v4i_t*)(lds + PG8_SB(b, h) + boff + n * 2048 + hoff); } } while (0)
#define PG8_MMA(ai, bj, At, Bt) do { __builtin_amdgcn_s_setprio(1); _Pragma("unroll") for (int m = 0; m < 4; ++m) _Pragma("unroll") for (int n = 0; n < 2; ++n) \
        asm volatile("v_mfma_f32_16x16x128_f8f6f4 %0, %1, %2, %0" : "+v"(acc[ai][bj][m][n]) : "v"(Bt[n]), "v"(At[m])); __builtin_amdgcn_s_setprio(0); } while (0)
#define PG8_WAIT_V(n) asm volatile("s_waitcnt vmcnt(" #n ")" ::: "memory")
#define PG8_WAIT_L(n) asm volatile("s_waitcnt lgkmcnt(" #n ")" ::: "memory")
#define PG8_BAR __builtin_amdgcn_s_barrier()
#define PG8_SCHED __builtin_amdgcn_sched_barrier(0)
    Unit cur, nxt; int ui = 0;
    if (!S.next(0, cur)) return;
    f32x4 acc[2][2][4][2];
#pragma unroll
    for (int a = 0; a < 2; ++a)
#pragma unroll
        for (int b = 0; b < 2; ++b)
#pragma unroll
            for (int m = 0; m < 4; ++m)
#pragma unroll
                for (int n = 0; n < 2; ++n) acc[a][b][m][n] = (f32x4){0.f, 0.f, 0.f, 0.f};
    v8i_t At[4], B0[2], B1[2];
    const char* cA = (const char*)g.A + (size_t)cur.pm * tstep; const char* cB = (const char*)g.Bt + (size_t)cur.pnB * tstep;

    if constexpr (SP2) {
        PG8_STAGE(PG8_SB(0, 0), cB, voffB); PG8_STAGE(PG8_SB(0, 1), cB + hstep, voffB); gate(); PG8_STAGE(PG8_SA(0, 0), cA, voffA); PG8_STAGE(PG8_SA(0, 1), cA + hstep, voffA);
        if (wr == 1) PG8_BAR;
        PG8_WAIT_V(2); PG8_BAR;
        PG8_STAGE(PG8_SB(1, 0), cB + kstep, voffB); PG8_STAGE(PG8_SA(1, 0), cA + kstep, voffA); PG8_STAGE(PG8_SB(1, 1), cB + hstep + kstep, voffB);
        PG8_WAIT_V(6); PG8_BAR;
    } else {
        gate(); PG8_STAGE(PG8_SB(0, 0), cB, voffB); PG8_STAGE(PG8_SA(0, 0), cA, voffA); PG8_STAGE(PG8_SB(0, 1), cB + hstep, voffB); PG8_STAGE(PG8_SA(0, 1), cA + hstep, voffA);
        if (wr == 1) PG8_BAR;
        PG8_WAIT_V(4); PG8_BAR;
        PG8_STAGE(PG8_SB(1, 0), cB + kstep, voffB); PG8_STAGE(PG8_SA(1, 0), cA + kstep, voffA); PG8_STAGE(PG8_SB(1, 1), cB + hstep + kstep, voffB);
        PG8_WAIT_V(6); PG8_BAR;
    }
    for (;;) {
        const bool has_next = S.next(ui + 1, nxt);
        const char* nA = has_next ? (const char*)g.A + (size_t)nxt.pm * tstep : cA; const char* nB = has_next ? (const char*)g.Bt + (size_t)nxt.pnB * tstep : cB;
        for (int t = 0; t < nt; t += 2) {
            const bool last = (t == nt - 2);
            const char* a1 = cA + (size_t)(t + 1) * kstep;
            const char* a2 = last ? nA : cA + (size_t)(t + 2) * kstep; const char* b2 = last ? nB : cB + (size_t)(t + 2) * kstep;
            const char* a3 = a2 + kstep; const char* b3 = b2 + kstep;

            if constexpr (SP2) {
            PG8_LDB(B0, 0, 0); PG8_LDB(B1, 0, 1); PG8_SCHED; PG8_LDA(At, 0, 0); PG8_STAGE(PG8_SA(1, 1), a1 + hstep, voffA);
            PG8_WAIT_V(8); PG8_WAIT_L(0); PG8_BAR; PG8_MMA(0, 0, At, B0); PG8_MMA(0, 1, At, B1); PG8_BAR; PG8_SCHED;
            PG8_LDA(At, 0, 1); PG8_STAGE(PG8_SB(0, 0), b2, voffB); PG8_STAGE(PG8_SB(0, 1), b2 + hstep, voffB); PG8_STAGE(PG8_SA(0, 0), a2, voffA);
            PG8_WAIT_V(8); PG8_WAIT_L(0); PG8_BAR; PG8_MMA(1, 0, At, B0); PG8_MMA(1, 1, At, B1); PG8_BAR; PG8_SCHED;
            PG8_LDB(B0, 1, 0); PG8_LDB(B1, 1, 1); PG8_SCHED; PG8_LDA(At, 1, 0); PG8_STAGE(PG8_SA(0, 1), a2 + hstep, voffA);
            PG8_WAIT_V(8); PG8_WAIT_L(0); PG8_BAR; PG8_MMA(0, 0, At, B0); PG8_MMA(0, 1, At, B1); PG8_BAR; PG8_SCHED;
            PG8_LDA(At, 1, 1); PG8_STAGE(PG8_SB(1, 0), b3, voffB); PG8_STAGE(PG8_SB(1, 1), b3 + hstep, voffB); PG8_STAGE(PG8_SA(1, 0), a3, voffA);
            PG8_WAIT_V(8); PG8_WAIT_L(0); PG8_BAR; PG8_MMA(1, 0, At, B0); PG8_MMA(1, 1, At, B1); PG8_BAR; PG8_SCHED;
            } else {
            PG8_LDB(B0, 0, 0); PG8_SCHED; PG8_LDA(At, 0, 0); PG8_STAGE(PG8_SA(1, 1), a1 + hstep, voffA);
            PG8_WAIT_L(8); PG8_BAR; PG8_WAIT_L(0); PG8_MMA(0, 0, At, B0); PG8_BAR; PG8_SCHED;
            PG8_LDB(B1, 0, 1); PG8_STAGE(PG8_SB(0, 0), b2, voffB);
            PG8_BAR; PG8_WAIT_L(0); PG8_MMA(0, 1, At, B1); PG8_BAR;
            PG8_LDA(At, 0, 1); PG8_STAGE(PG8_SA(0, 0), a2, voffA);
            PG8_BAR; PG8_WAIT_L(0); PG8_MMA(1, 0, At, B0); PG8_BAR; PG8_SCHED;
            PG8_STAGE(PG8_SB(0, 1), b2 + hstep, voffB);
            PG8_WAIT_V(6); PG8_BAR; PG8_MMA(1, 1, At, B1); PG8_BAR;
            PG8_LDB(B0, 1, 0); PG8_SCHED; PG8_LDA(At, 1, 0); PG8_STAGE(PG8_SA(0, 1), a2 + hstep, voffA);
            PG8_WAIT_L(8); PG8_BAR; PG8_WAIT_L(0); PG8_MMA(0, 0, At, B0); PG8_BAR; PG8_SCHED;
            PG8_LDB(B1, 1, 1); PG8_STAGE(PG8_SB(1, 0), b3, voffB);
            PG8_BAR; PG8_WAIT_L(0); PG8_MMA(0, 1, At, B1); PG8_BAR;
            PG8_LDA(At, 1, 1); PG8_STAGE(PG8_SA(1, 0), a3, voffA);
            PG8_BAR; PG8_WAIT_L(0); PG8_MMA(1, 0, At, B0); PG8_BAR; PG8_SCHED;
            PG8_STAGE(PG8_SB(1, 1), b3 + hstep, voffB);
            PG8_WAIT_V(6); PG8_BAR; PG8_MMA(1, 1, At, B1); PG8_BAR;
            }
        }
        asm volatile("s_nop 15\n\ts_nop 15" ::: "memory");
        if constexpr (ALIGN_EPI) { if (wr == 0) PG8_BAR; }
        run_epi8(E, acc, cur, wr, wc, fr, fq);
        if (!has_next) break;
#pragma unroll
        for (int a = 0; a < 2; ++a)
#pragma unroll
            for (int b = 0; b < 2; ++b)
#pragma unroll
                for (int m = 0; m < 4; ++m)
#pragma unroll
                    for (int n = 0; n < 2; ++n) acc[a][b][m][n] = (f32x4){0.f, 0.f, 0.f, 0.f};
        cur = nxt; cA = nA; cB = nB; ++ui;
        if constexpr (ALIGN_EPI) { if (wr == 1) PG8_BAR; }
    }
    PG8_WAIT_V(0);
    if constexpr (!ALIGN_EPI) { if (wr == 0) PG8_BAR; }
    PG8_BAR;

#undef PG8_SA
#undef PG8_SB
#undef PG8_STAGE
#undef PG8_LDA
#undef PG8_LDB
#undef PG8_MMA
#undef PG8_WAIT_V
#undef PG8_WAIT_L
#undef PG8_BAR
#undef PG8_SCHED
}

template <class Epi, class Sched, bool ALIGN_EPI = false, bool SP2 = false>
__device__ __forceinline__ void gemm_phase_f8g(PG8_LAS unsigned char* lds, const Gemm g, const Sched& S, const Epi& E, const int* tok) {
    const int tid = threadIdx.x, wid = __builtin_amdgcn_readfirstlane(tid >> 6), lane = tid & 63, wr = wid >> 2, wc = wid & 3, fr = lane & 15, fq = lane >> 4;
    const int RP = g.K, nt = RP / 128;
    unsigned voffA[2], voffB[2]; int rowA[2];
#pragma unroll
    for (int i = 0; i < 2; ++i) { const int b_ = tid * 16 + i * 8192, R = b_ >> 7, pp = (b_ >> 4) & 7, rr_ = R & 15, ff = ((rr_ >> 1) & 1) | (((rr_ >> 3) & 1) << 2);
        const int rho = R & 31, Rb = (R & ~31) + 8 * ((rho & 15) >> 2) + 4 * (rho >> 4) + (rho & 3);
        voffA[i] = (unsigned)((pp ^ ff) * 16); rowA[i] = R; voffB[i] = (unsigned)(Rb * RP + ((pp ^ ff) * 16)); }
    const size_t kstep = (size_t)(BK * 2);
    const size_t hstep = (size_t)HALF * RP;
    const size_t tstep = 2 * hstep;
    const unsigned ldsw = (unsigned)wid * 1024u;
    const int ffr = ((fr >> 1) & 1) | (((fr >> 3) & 1) << 2);
    const int aoff = (wr * 64 + fr) * 128 + (((2 * fq) ^ ffr) * 16), boff = (wc * 32 + fr) * 128 + (((2 * fq) ^ ffr) * 16), hoff = (ffr & 1) ? -16 : 16;
#define PG8_SA(b, h) (((b) * 2 + (h)) * HTB)
#define PG8_SB(b, h) ((4 + (b) * 2 + (h)) * HTB)
#define PG8_STAGE(bufoff, gbase, voff) do { _Pragma("unroll") for (int _i = 0; _i < 2; ++_i) \
        __builtin_amdgcn_global_load_lds((const unsigned*)((const char*)(gbase) + (voff)[_i]), (PG8_LAS unsigned*)(lds + (bufoff) + ldsw + _i * 8192), 16, 0, 0); } while (0)
#define PG8_LDA(dst, b, h) do { _Pragma("unroll") for (int m = 0; m < 4; ++m) { dst[m].lo = *(const PG8_LAS v4i_t*)(lds + PG8_SA(b, h) + aoff + m * 2048); dst[m].hi = *(const PG8_LAS v4i_t*)(lds + PG8_SA(b, h) + aoff + m * 2048 + hoff); } } while (0)
#define PG8_LDB(dst, b, h) do { _Pragma("unroll") for (int n = 0; n < 2; ++n) { dst[n].lo = *(const PG8_LAS v4i_t*)(lds + PG8_SB(b, h) + boff + n * 2048); dst[n].hi = *(const PG8_LAS v4i_t*)(lds + PG8_SB(b, h) + boff + n * 2048 + hoff); } } while (0)
#define PG8_MMA(ai, bj, At, Bt) do { __builtin_amdgcn_s_setprio(1); _Pragma("unroll") for (int m = 0; m < 4; ++m) _Pragma("unroll") for (int n = 0; n < 2; ++n) \
        asm volatile("v_mfma_f32_16x16x128_f8f6f4 %0, %1, %2, %0" : "+v"(acc[ai][bj][m][n]) : "v"(Bt[n]), "v"(At[m])); __builtin_amdgcn_s_setprio(0); } while (0)
#define PG8_WAIT_V(n) asm volatile("s_waitcnt vmcnt(" #n ")" ::: "memory")
#define PG8_WAIT_L(n) asm volatile("s_waitcnt lgkmcnt(" #n ")" ::: "memory")
#define PG8_BAR __builtin_amdgcn_s_barrier()
#define PG8_SCHED __builtin_amdgcn_sched_barrier(0)
    Unit cur, nxt; int ui = 0;
    if (!S.next(0, cur)) return;
    f32x4 acc[2][2][4][2];
#pragma unroll
    for (int a = 0; a < 2; ++a)
#pragma unroll
        for (int b = 0; b < 2; ++b)
#pragma unroll
            for (int m = 0; m < 4; ++m)
#pragma unroll
                for (int n = 0; n < 2; ++n) acc[a][b][m][n] = (f32x4){0.f, 0.f, 0.f, 0.f};
    v8i_t At[4], B0[2], B1[2];
    const char* cA = (const char*)g.A; const char* cB = (const char*)g.Bt + (size_t)cur.pnB * tstep;
    unsigned vC[2][2], vN[2][2] = {{0u, 0u}, {0u, 0u}};
#define PG8_TOKOFF(dst, pm_) do { _Pragma("unroll") for (int h_ = 0; h_ < 2; ++h_) _Pragma("unroll") for (int i_ = 0; i_ < 2; ++i_) dst[h_][i_] = (unsigned)tok[(pm_) * 256 + h_ * 128 + rowA[i_]] * (unsigned)RP + voffA[i_]; } while (0)
    PG8_TOKOFF(vC, cur.pm);

    if constexpr (SP2) {
        PG8_STAGE(PG8_SB(0, 0), cB, voffB); PG8_STAGE(PG8_SB(0, 1), cB + hstep, voffB); PG8_STAGE(PG8_SA(0, 0), cA, vC[0]); PG8_STAGE(PG8_SA(0, 1), cA, vC[1]);
        if (wr == 1) PG8_BAR;
        PG8_WAIT_V(2); PG8_BAR;
        PG8_STAGE(PG8_SB(1, 0), cB + kstep, voffB); PG8_STAGE(PG8_SA(1, 0), cA + kstep, vC[0]); PG8_STAGE(PG8_SB(1, 1), cB + hstep + kstep, voffB);
        PG8_WAIT_V(6); PG8_BAR;
    } else {
        PG8_STAGE(PG8_SB(0, 0), cB, voffB); PG8_STAGE(PG8_SA(0, 0), cA, vC[0]); PG8_STAGE(PG8_SB(0, 1), cB + hstep, voffB); PG8_STAGE(PG8_SA(0, 1), cA, vC[1]);
        if (wr == 1) PG8_BAR;
        PG8_WAIT_V(4); PG8_BAR;
        PG8_STAGE(PG8_SB(1, 0), cB + kstep, voffB); PG8_STAGE(PG8_SA(1, 0), cA + kstep, vC[0]); PG8_STAGE(PG8_SB(1, 1), cB + hstep + kstep, voffB);
        PG8_WAIT_V(6); PG8_BAR;
    }
    for (;;) {
        const bool has_next = S.next(ui + 1, nxt);
        const char* nB = has_next ? (const char*)g.Bt + (size_t)nxt.pnB * tstep : cB;
        int tkN[2][2] = {{0, 0}, {0, 0}};
        if (has_next) { _Pragma("unroll") for (int h_ = 0; h_ < 2; ++h_) _Pragma("unroll") for (int i_ = 0; i_ < 2; ++i_) tkN[h_][i_] = tok[nxt.pm * 256 + h_ * 128 + rowA[i_]]; }
        for (int t = 0; t < nt; t += 2) {
            const bool last = (t == nt - 2);
            const char* a1 = cA + (size_t)(t + 1) * kstep;
            const char* a2 = last ? cA : cA + (size_t)(t + 2) * kstep; const char* b2 = last ? nB : cB + (size_t)(t + 2) * kstep;
            unsigned vs0[2] = {vC[0][0], vC[0][1]}, vs1[2] = {vC[1][0], vC[1][1]};
            if (last && has_next) { asm volatile("" : "+v"(tkN[0][0]), "+v"(tkN[0][1]), "+v"(tkN[1][0]), "+v"(tkN[1][1]));
                _Pragma("unroll") for (int h_ = 0; h_ < 2; ++h_) _Pragma("unroll") for (int i_ = 0; i_ < 2; ++i_) vN[h_][i_] = (unsigned)tkN[h_][i_] * (unsigned)RP + voffA[i_];
                vs0[0] = vN[0][0]; vs0[1] = vN[0][1]; vs1[0] = vN[1][0]; vs1[1] = vN[1][1]; }
            const char* a3 = a2 + kstep; const char* b3 = b2 + kstep;

            if constexpr (SP2) {
            PG8_LDB(B0, 0, 0); PG8_LDB(B1, 0, 1); PG8_SCHED; PG8_LDA(At, 0, 0); PG8_STAGE(PG8_SA(1, 1), a1, vC[1]);
            PG8_WAIT_V(8); PG8_WAIT_L(0); PG8_BAR; PG8_MMA(0, 0, At, B0); PG8_MMA(0, 1, At, B1); PG8_BAR; PG8_SCHED;
            PG8_LDA(At, 0, 1); PG8_STAGE(PG8_SB(0, 0), b2, voffB); PG8_STAGE(PG8_SB(0, 1), b2 + hstep, voffB); PG8_STAGE(PG8_SA(0, 0), a2, vs0);
            PG8_WAIT_V(8); PG8_WAIT_L(0); PG8_BAR; PG8_MMA(1, 0, At, B0); PG8_MMA(1, 1, At, B1); PG8_BAR; PG8_SCHED;
            PG8_LDB(B0, 1, 0); PG8_LDB(B1, 1, 1); PG8_SCHED; PG8_LDA(At, 1, 0); PG8_STAGE(PG8_SA(0, 1), a2, vs1);
            PG8_WAIT_V(8); PG8_WAIT_L(0); PG8_BAR; PG8_MMA(0, 0, At, B0); PG8_MMA(0, 1, At, B1); PG8_BAR; PG8_SCHED;
            PG8_LDA(At, 1, 1); PG8_STAGE(PG8_SB(1, 0), b3, voffB); PG8_STAGE(PG8_SB(1, 1), b3 + hstep, voffB); PG8_STAGE(PG8_SA(1, 0), a3, vs0);
            PG8_WAIT_V(8); PG8_WAIT_L(0); PG8_BAR; PG8_MMA(1, 0, At, B0); PG8_MMA(1, 1, At, B1); PG8_BAR; PG8_SCHED;
            } else {
            PG8_LDB(B0, 0, 0); PG8_SCHED; PG8_LDA(At, 0, 0); PG8_STAGE(PG8_SA(1, 1), a1, vC[1]);
            PG8_WAIT_L(8); PG8_BAR; PG8_WAIT_L(0); PG8_MMA(0, 0, At, B0); PG8_BAR; PG8_SCHED;
            PG8_LDB(B1, 0, 1); PG8_STAGE(PG8_SB(0, 0), b2, voffB);
            PG8_BAR; PG8_WAIT_L(0); PG8_MMA(0, 1, At, B1); PG8_BAR;
            PG8_LDA(At, 0, 1); PG8_STAGE(PG8_SA(0, 0), a2, vs0);
            PG8_BAR; PG8_WAIT_L(0); PG8_MMA(1, 0, At, B0); PG8_BAR; PG8_SCHED;
            PG8_STAGE(PG8_SB(0, 1), b2 + hstep, voffB);
            PG8_WAIT_V(6); PG8_BAR; PG8_MMA(1, 1, At, B1); PG8_BAR;
            PG8_LDB(B0, 1, 0); PG8_SCHED; PG8_LDA(At, 1, 0); PG8_STAGE(PG8_SA(0, 1), a2, vs1);
            PG8_WAIT_L(8); PG8_BAR; PG8_WAIT_L(0); PG8_MMA(0, 0, At, B0); PG8_BAR; PG8_SCHED;
            PG8_LDB(B1, 1, 1); PG8_STAGE(PG8_SB(1, 0), b3, voffB);
            PG8_BAR; PG8_WAIT_L(0); PG8_MMA(0, 1, At, B1); PG8_BAR;
            PG8_LDA(At, 1, 1); PG8_STAGE(PG8_SA(1, 0), a3, vs0);
            PG8_BAR; PG8_WAIT_L(0); PG8_MMA(1, 0, At, B0); PG8_BAR; PG8_SCHED;
            PG8_STAGE(PG8_SB(1, 1), b3 + hstep, voffB);
            PG8_WAIT_V(6); PG8_BAR; PG8_MMA(1, 1, At, B1); PG8_BAR;
            }
        }
        asm volatile("s_nop 15\n\ts_nop 15" ::: "memory");
        if constexpr (ALIGN_EPI) { if (wr == 0) PG8_BAR; }
        run_epi8(E, acc, cur, wr, wc, fr, fq);
        if (!has_next) break;
#pragma unroll
        for (int a = 0; a < 2; ++a)
#pragma unroll
            for (int b = 0; b < 2; ++b)
#pragma unroll
                for (int m = 0; m < 4; ++m)
#pragma unroll
                    for (int n = 0; n < 2; ++n) acc[a][b][m][n] = (f32x4){0.f, 0.f, 0.f, 0.f};
        cur = nxt; cB = nB; ++ui; vC[0][0] = vN[0][0]; vC[0][1] = vN[0][1]; vC[1][0] = vN[1][0]; vC[1][1] = vN[1][1];
        if constexpr (ALIGN_EPI) { if (wr == 1) PG8_BAR; }
    }
    PG8_WAIT_V(0);
    if constexpr (!ALIGN_EPI) { if (wr == 0) PG8_BAR; }
    PG8_BAR;

#undef PG8_TOKOFF
#undef PG8_SA
#undef PG8_SB
#undef PG8_STAGE
#undef PG8_LDA
#undef PG8_LDB
#undef PG8_MMA
#undef PG8_WAIT_V
#undef PG8_WAIT_L
#undef PG8_BAR
#undef PG8_SCHED
}
}

constexpr int D = 1024, BATCH = 8, SEQ = 2048, CTXL = 256;
constexpr int M = BATCH * SEQ;
constexpr int MC = BATCH * CTXL;
constexpr int MT = M + MC;
constexpr int DIN = 2048, DSGU = 512, DLRU = 512, NE = 16, CAP = 256, DE = 2048, NMOD = 6 * D;
constexpr int NSEG = 36;
constexpr float EPS = 1e-6f;
constexpr int NWAVES = 8, NTHREADS = 512;
constexpr int LDS_BYTES = 147456;
constexpr int NPH = 11;

constexpr size_t MiB = 1u << 20;
constexpr size_t WS_CTL = 0;
constexpr size_t WS_MOD = 1 * MiB;
constexpr size_t WS_SUM = 1 * MiB + 512 * 1024;
constexpr size_t WS_AFF = 4 * MiB;
constexpr size_t WS_SLOT = 5 * MiB;
constexpr size_t WS_GATE = 6 * MiB;
constexpr size_t WS_TOK = 6 * MiB + 128 * 1024;
constexpr size_t WS_GWT = 6 * MiB + 512 * 1024;
constexpr size_t WS_SWB = 7 * MiB;
constexpr size_t WS_WIN = 8 * MiB;
constexpr size_t WS_WOUT = 12 * MiB;
constexpr size_t WS_WG = 14 * MiB;
constexpr size_t WS_W2 = 142 * MiB;
constexpr size_t WS_X1 = 206 * MiB;
constexpr size_t WS_HS = 206 * MiB, WS_PF = 222 * MiB, WS_PB = 238 * MiB;
constexpr size_t WS_HX2 = 270 * MiB;
constexpr size_t WS_XCH = 286 * MiB;
constexpr size_t WS_CB = 1 * MiB + 256 * 1024;
constexpr size_t WS_XE = 302 * MiB;
constexpr size_t WS_A2 = 302 * MiB, WS_YE = 302 * MiB;
constexpr size_t WS_HID = 366 * MiB;
constexpr size_t WS_HX = 366 * MiB;
constexpr size_t WS_UV = 402 * MiB;
constexpr size_t WS_XC = 466 * MiB;
constexpr size_t WS_END = 494 * MiB;

#define GAS __attribute__((address_space(1)))
#define LAS __attribute__((address_space(3)))
typedef unsigned short bf16;
typedef unsigned v4u __attribute__((ext_vector_type(4)));
typedef unsigned v2u __attribute__((ext_vector_type(2)));
typedef float f32x4 __attribute__((ext_vector_type(4)));
typedef short bf16x8 __attribute__((ext_vector_type(8)));
#define LDS_WAIT() asm volatile("s_waitcnt lgkmcnt(0)" ::: "memory")

__device__ __forceinline__ float bf2f(bf16 b) { return __uint_as_float(((unsigned)b) << 16); }
__device__ __forceinline__ unsigned f2bf(float f) { unsigned u = __float_as_uint(f); return (u + 0x7fffu + ((u >> 16) & 1u)) >> 16; }
typedef __bf16 bf16x2_hw __attribute__((ext_vector_type(2)));
typedef float f32x2_hw __attribute__((ext_vector_type(2)));
__device__ __forceinline__ unsigned pk2(float lo, float hi) { const f32x2_hw v = {lo, hi}; return __builtin_bit_cast(unsigned, __builtin_convertvector(v, bf16x2_hw)); }
__device__ __forceinline__ float bflo(unsigned w) { return __uint_as_float(w << 16); }
__device__ __forceinline__ float bfhi(unsigned w) { return __uint_as_float(w & 0xffff0000u); }
__device__ __forceinline__ float rcpf_(float x) { return __builtin_amdgcn_rcpf(x); }
__device__ __forceinline__ float exp2f_(float x) { return __builtin_amdgcn_exp2f(x); }
__device__ __forceinline__ float sigmoidf_(float x) { return rcpf_(1.f + exp2f_(-1.4426950408889634f * x)); }
__device__ __forceinline__ float siluf_(float x) { return x * rcpf_(1.f + exp2f_(-1.4426950408889634f * x)); }
__device__ __forceinline__ float geluf_(float x) { const float u = x * (0.7978845608028654f + 0.035677408136300125f * x * x); return x * rcpf_(1.f + exp2f_(-2.8853900817779268f * u)); }
__device__ __forceinline__ void decay_pair(float la, float& a, float& s) {
    const float x = 2.f * la;
    const float p1 = la * (1.f + la * (0.5f + la * (0.16666667f + la * (0.041666668f + la * 0.0083333333f))));
    const float p2 = x * (1.f + x * (0.5f + x * (0.16666667f + x * (0.041666668f + x * (0.0083333333f + x * 0.0013888889f)))));
    const float e1 = exp2f_(1.4426950408889634f * la);
    const bool small = la > -0.15f;
    a = small ? 1.f + p1 : e1;
    s = __builtin_amdgcn_sqrtf(small ? -p2 : 1.f - e1 * e1);
}
typedef float f32x2p __attribute__((ext_vector_type(2)));
__device__ __forceinline__ f32x2p sigmoid2_(f32x2p x) { const f32x2p t = x * -1.4426950408889634f; f32x2p e; e.x = exp2f_(t.x); e.y = exp2f_(t.y); e = e + 1.f; f32x2p r; r.x = rcpf_(e.x); r.y = rcpf_(e.y); return r; }
__device__ __forceinline__ f32x2p gelu2_(f32x2p x) { const f32x2p u = x * (x * x * 0.035677408136300125f + 0.7978845608028654f), t = u * -2.8853900817779268f; f32x2p e; e.x = exp2f_(t.x); e.y = exp2f_(t.y); e = e + 1.f;
    f32x2p r; r.x = rcpf_(e.x); r.y = rcpf_(e.y); return x * r; }
__device__ __forceinline__ void decay_pair2(f32x2p la, f32x2p& a, f32x2p& s) {
    const f32x2p x = la * 2.f;
    const f32x2p p1 = la * (la * (la * (la * (la * 0.0083333333f + 0.041666668f) + 0.16666667f) + 0.5f) + 1.f);
    const f32x2p p2 = x * (x * (x * (x * (x * (x * 0.0013888889f + 0.0083333333f) + 0.041666668f) + 0.16666667f) + 0.5f) + 1.f);
    const f32x2p tt = la * 1.4426950408889634f; f32x2p e1; e1.x = exp2f_(tt.x); e1.y = exp2f_(tt.y);
    const f32x2p big = 1.f - e1 * e1, one = p1 + 1.f;
    a.x = la.x > -0.15f ? one.x : e1.x; a.y = la.y > -0.15f ? one.y : e1.y;
    s.x = __builtin_amdgcn_sqrtf(la.x > -0.15f ? -p2.x : big.x); s.y = __builtin_amdgcn_sqrtf(la.y > -0.15f ? -p2.y : big.y);
}
__device__ __forceinline__ unsigned pk4_fp8(float a, float b, float c, float d) {
    unsigned w = 0u; w = __builtin_amdgcn_cvt_pk_fp8_f32(a, b, w, false); w = __builtin_amdgcn_cvt_pk_fp8_f32(c, d, w, true); return w; }
constexpr float WSCALE = 32.f, WSCALE_INV = 1.f / 32.f;
__device__ __forceinline__ float wave_sum(float v) {
    v += __int_as_float(__builtin_amdgcn_update_dpp(0, __float_as_int(v), 0xB1, 0xf, 0xf, true));
    v += __int_as_float(__builtin_amdgcn_update_dpp(0, __float_as_int(v), 0x4E, 0xf, 0xf, true));
    v += __int_as_float(__builtin_amdgcn_update_dpp(0, __float_as_int(v), 0x141, 0xf, 0xf, true));
    v += __int_as_float(__builtin_amdgcn_update_dpp(0, __float_as_int(v), 0x140, 0xf, 0xf, true));
    const int iv = __float_as_int(v);
    return (__int_as_float(__builtin_amdgcn_readlane(iv, 0)) + __int_as_float(__builtin_amdgcn_readlane(iv, 16))) + (__int_as_float(__builtin_amdgcn_readlane(iv, 32)) + __int_as_float(__builtin_amdgcn_readlane(iv, 48)));
}


#define XB_TMO      128
#define XB_XCNT(j)  (256  + 64 * (j))
#define XB_XSUB(j)  (1280 + 64 * (j))
#define XB_XGEN(j)  (2304 + 64 * (j))
#define XB_TOP      3328
#define XB_TOPGEN   3392
#define XCD_BAR_WORDS 3456
#define XB_SPIN_CAP (1u << 18)
__device__ __forceinline__ unsigned xb_ld(unsigned* p)              { return __hip_atomic_load(p, __ATOMIC_RELAXED, __HIP_MEMORY_SCOPE_AGENT); }
__device__ __forceinline__ unsigned xb_add(unsigned* p, unsigned v) { return __hip_atomic_fetch_add(p, v, __ATOMIC_RELAXED, __HIP_MEMORY_SCOPE_AGENT); }
__device__ __forceinline__ unsigned xb_xcc_id() { return (unsigned)__builtin_amdgcn_s_getreg((3 << 11) | 20) & 0xFu; }
#define XB_SPIN(cond, bar) do { unsigned _sp = 0; while (cond) { __builtin_amdgcn_s_sleep(1); \
    if ((++_sp & 255u) == 0u) { if (xb_ld(&(bar)[XB_TMO])) break; if (_sp > XB_SPIN_CAP) { atomicAdd(&(bar)[XB_TMO], 1u); break; } } } } while (0)
struct XcdBarrier { unsigned* bar; unsigned x; volatile LAS unsigned* st; unsigned total; };
__device__ __forceinline__ XcdBarrier xcd_barrier_post(unsigned* bar, volatile LAS unsigned* st, unsigned total) {
    XcdBarrier b; b.bar = bar; b.x = xb_xcc_id(); b.st = st; b.total = total;
    if (threadIdx.x == 0) (void)xb_add(&bar[XB_XCNT(b.x)], 1u);
    return b;
}
__device__ __forceinline__ void xcd_barrier_complete(unsigned* bar, unsigned x, unsigned G, unsigned& nloc, unsigned& nx) {
    unsigned sum, cnt, mine, sp = 0u;
    for (;;) {
        sum = 0u; cnt = 0u; mine = 0u;
#pragma unroll
        for (unsigned j = 0; j < 16; ++j) { const unsigned c = xb_ld(&bar[XB_XCNT(j)]); sum += c; cnt += (c > 0u) ? 1u : 0u; mine = (j == x) ? c : mine; }
        if (sum == G) break;
        __builtin_amdgcn_s_sleep(1);
        if ((++sp & 255u) == 0u) { if (xb_ld(&bar[XB_TMO])) break; if (sp > XB_SPIN_CAP) { atomicAdd(&bar[XB_TMO], 1u); break; } }
    }
    nloc = mine > 0u ? mine : 1u; nx = cnt > 0u ? cnt : 1u;
}
__device__ __forceinline__ void xcd_barrier(const XcdBarrier& b) {
    asm volatile("s_waitcnt vmcnt(0)" ::: "memory");
    __syncthreads();
    if (threadIdx.x == 0) {
        unsigned* bar = b.bar;
        __builtin_amdgcn_s_waitcnt(0);
        unsigned nloc = b.st[0], nx = b.st[1];
        if (nloc == 0u) { xcd_barrier_complete(bar, b.x, b.total, nloc, nx); b.st[0] = nloc; b.st[1] = nx; }
        const unsigned old = xb_add(&bar[XB_XSUB(b.x)], 1u);
        const unsigned gen = old / nloc;
        if (old + 1u == (gen + 1u) * nloc) {
            __builtin_amdgcn_fence(__ATOMIC_RELEASE, "agent");
            asm volatile("s_waitcnt vmcnt(0)" ::: "memory");
            const unsigned og = xb_add(&bar[XB_TOP], 1u);
            const unsigned tg = og / nx;
            asm volatile("buffer_inv sc1" ::: "memory");
            if (og + 1u == (tg + 1u) * nx) xb_add(&bar[XB_TOPGEN], 1u);
            else XB_SPIN(xb_ld(&bar[XB_TOPGEN]) == tg, bar);
            xb_add(&bar[XB_XGEN(b.x)], 1u);
            asm volatile("s_waitcnt vmcnt(0)" ::: "memory");
        } else {
            asm volatile("buffer_inv sc1" ::: "memory");
            XB_SPIN(xb_ld(&bar[XB_XGEN(b.x)]) == gen, bar);
            asm volatile("s_waitcnt vmcnt(0)" ::: "memory");
        }
    }
    __syncthreads();
}

#define XS_SUB(j)   (32 * (j))
#define XS_TOP      512
#define XS_DONE     576
#define XS_WORDS    640
#define SB_BASE     11264
__device__ __forceinline__ void split_arrive(unsigned* w, const XcdBarrier& b) {
    asm volatile("s_waitcnt vmcnt(0)" ::: "memory");
    __syncthreads();
    if (threadIdx.x == 0) {
        const unsigned x = b.x; unsigned nloc = b.st[0], nx = b.st[1];
        if (nloc == 0u) { xcd_barrier_complete(b.bar, b.x, b.total, nloc, nx); b.st[0] = nloc; b.st[1] = nx; }
        const unsigned old = xb_add(&w[XS_SUB(x)], 1u);
        if (old + 1u == nloc) {
            __builtin_amdgcn_fence(__ATOMIC_RELEASE, "agent");
            asm volatile("s_waitcnt vmcnt(0)" ::: "memory");
            const unsigned og = xb_add(&w[XS_TOP], 1u);
            if (og + 1u == nx) xb_add(&w[XS_DONE], 1u);
        }
        asm volatile("buffer_inv sc1" ::: "memory");
    }
}
__device__ __forceinline__ void split_wait(unsigned* w, unsigned* tmo) {
    if (threadIdx.x == 0) {
        XB_SPIN(xb_ld(&w[XS_DONE]) == 0u, tmo);
        asm volatile("s_waitcnt vmcnt(0)" ::: "memory");
    }
    __syncthreads();
}

struct P {
    const float *x, *c, *ctx, *c_ctx, *w_mod, *b_mod, *norm1_g, *norm2_g, *w_in, *sgu_g, *sgu_w, *sgu_b, *conv_w, *conv_b,
                *rg_wa, *rg_ba, *rg_wi, *rg_bi, *rg_lam, *w_out, *w_router, *w1, *w3, *w2, *final_g;
    float* out; unsigned char* ws; int ph_lo, ph_hi;
};

struct SchedG1 { int G, c;
    __device__ __forceinline__ bool next(int i, pg8::Unit& u) const { const int L = i * G + c; if (L >= 528) return false;
        if (L < 512) { u.pm = L >> 3; u.pn = L & 7; } else { const int r = L - 512; u.pm = 64 + (r >> 1); u.pn = 4 + (r & 1); } u.pnB = u.pn; return true; } };
struct SchedG1L { int xg, wl;
    __device__ __forceinline__ bool next(int i, pg8::Unit& u) const { const int j = wl + 24 * i; if (j >= 66) return false;
        if (j < 64) { u.pm = 8 * xg + (j >> 3); u.pn = j & 7; } else { u.pm = 64 + xg; u.pn = 4 + (j - 64); } u.pnB = u.pn; return true; } };
struct SchedG2 { int G, c;
    __device__ __forceinline__ bool next(int i, pg8::Unit& u) const { const int L = i * G + c; if (L >= 256) return false; u.pm = L >> 2; u.pn = L & 3; u.pnB = u.pn; return true; } };
struct SchedG3 { int G, c;
    __device__ __forceinline__ bool next(int i, pg8::Unit& u) const { const int L = i * G + c; if (L >= 2048) return false; const int e = L >> 7, loc = L & 127;
        u.pm = e * 8 + (loc & 7); u.pn = loc >> 3; u.pnB = e * 16 + u.pn; return true; } };
struct SchedG4 { int G, c;
    __device__ __forceinline__ bool next(int i, pg8::Unit& u) const { const int L = i * G + c; if (L >= 512) return false; const int e = L >> 5, loc = L & 31;
        u.pm = e * 8 + (loc & 7); u.pn = loc >> 3; u.pnB = e * 4 + u.pn; return true; } };

struct EpiG1 { static constexpr bool PAIRED = false, FUSED = false; bf16* UV; bf16* XC;
    __device__ __forceinline__ void st8(const pg8::Unit& u, int row, int col, f32x4 v0, f32x4 v1) const {
        const int grow = u.pm * 256 + row, gcol = u.pn * 256 + col;
        if (u.pm < 64) {
            if (gcol < 1024 || gcol >= 1536) { const f32x2p a = gelu2_((f32x2p){v0[0], v0[1]}), b = gelu2_((f32x2p){v0[2], v0[3]}), c = gelu2_((f32x2p){v1[0], v1[1]}), d = gelu2_((f32x2p){v1[2], v1[3]});
                v0 = (f32x4){a.x, a.y, b.x, b.y}; v1 = (f32x4){c.x, c.y, d.x, d.y}; }
            *(v4u*)(UV + (size_t)grow * DIN + gcol) = (v4u){pk2(v0[0], v0[1]), pk2(v0[2], v0[3]), pk2(v1[0], v1[1]), pk2(v1[2], v1[3])};
        } else *(v4u*)(XC + (size_t)(grow - M) * DLRU + (gcol - 1024)) = (v4u){pk2(v0[0], v0[1]), pk2(v0[2], v0[3]), pk2(v1[0], v1[1]), pk2(v1[2], v1[3])};
    } };
struct EpiG2 { static constexpr bool PAIRED = false, FUSED = false; const float* x; const float* MOD; float* X1;
    __device__ __forceinline__ void st8(const pg8::Unit& u, int row, int col, f32x4 v0, f32x4 v1) const {
        const int grow = u.pm * 256 + row, gcol = u.pn * 256 + col, b = grow >> 11;
        const f32x4* xp = (const f32x4*)(x + (size_t)grow * D + gcol); const f32x4* gp = (const f32x4*)(MOD + b * NMOD + 2 * D + gcol); f32x4* op = (f32x4*)(X1 + (size_t)grow * D + gcol);
        op[0] = xp[0] + gp[0] * v0; op[1] = xp[1] + gp[1] * v1;
    } };
#if MOE_FP8
typedef float f32x2v __attribute__((ext_vector_type(2)));
__device__ __forceinline__ f32x2v swiglu_scaled2(f32x2v g, f32x2v u) {
    constexpr float K1 = -1.4426950408889634f * WSCALE_INV, S2 = WSCALE * WSCALE;
    const f32x2v t = g * K1; f32x2v e; e.x = exp2f_(t.x); e.y = exp2f_(t.y);
    const f32x2v d = e * S2 + S2; f32x2v r; r.x = rcpf_(d.x); r.y = rcpf_(d.y);
    return (g * u) * r;
}
struct EpiG3 { static constexpr bool PAIRED = true; unsigned char* HID;
    __device__ __forceinline__ void st2x8(const pg8::Unit& u, int row, int col, f32x4 g0, f32x4 g1, f32x4 u0, f32x4 u1) const {
        const int grow = u.pm * 256 + row, hc = u.pn * 128 + col;
        const f32x2v a = swiglu_scaled2((f32x2v){g0[0], g0[1]}, (f32x2v){u0[0], u0[1]}), b = swiglu_scaled2((f32x2v){g0[2], g0[3]}, (f32x2v){u0[2], u0[3]});
        const f32x2v c = swiglu_scaled2((f32x2v){g1[0], g1[1]}, (f32x2v){u1[0], u1[1]}), d = swiglu_scaled2((f32x2v){g1[2], g1[3]}, (f32x2v){u1[2], u1[3]});
        v2u w; w.x = pk4_fp8(a.x, a.y, b.x, b.y); w.y = pk4_fp8(c.x, c.y, d.x, d.y);
        *(v2u*)(HID + (size_t)grow * DE + hc) = w;
    } };
struct EpiG4 { static constexpr bool PAIRED = false; const float* GATE; unsigned char* YE;
    __device__ __forceinline__ void st8(const pg8::Unit& u, int row, int col, f32x4 v0, f32x4 v1) const {
        const int grow = u.pm * 256 + row, gcol = u.pn * 256 + col; const float gt = GATE[grow];
        v2u w; w.x = pk4_fp8(v0[0] * gt, v0[1] * gt, v0[2] * gt, v0[3] * gt); w.y = pk4_fp8(v1[0] * gt, v1[1] * gt, v1[2] * gt, v1[3] * gt);
        *(v2u*)(YE + (size_t)grow * D + gcol) = w;
    } };
#else
struct EpiG3 { static constexpr bool PAIRED = true; bf16* HID;
    __device__ __forceinline__ void st2(const pg8::Unit& u, int row, int col, f32x4 g, f32x4 up) const {
        const int grow = u.pm * 256 + row, hc = u.pn * 128 + col;
        v2u w; w.x = pk2(siluf_(g[0]) * up[0], siluf_(g[1]) * up[1]); w.y = pk2(siluf_(g[2]) * up[2], siluf_(g[3]) * up[3]);
        *(v2u*)(HID + (size_t)grow * DE + hc) = w;
    } };
struct EpiG4 { static constexpr bool PAIRED = false; const float* GATE; bf16* YE;
    __device__ __forceinline__ void st(const pg8::Unit& u, int row, int col, f32x4 v) const {
        const int grow = u.pm * 256 + row, gcol = u.pn * 256 + col; const float gt = GATE[grow];
        v2u w; w.x = pk2(v[0] * gt, v[1] * gt); w.y = pk2(v[2] * gt, v[3] * gt); *(v2u*)(YE + (size_t)grow * D + gcol) = w;
    } };

#endif


struct EpiG2F { static constexpr bool PAIRED = false, FUSED = true;
    const float* x; const float* MOD; float* X1; const float* w_router; const float* norm2_g; const float* CB; float* XCH; unsigned* cnt; unsigned* tmo; unsigned char* HX8; float* AFF;
    __device__ __forceinline__ void fused(f32x4 (&acc)[2][2][4][2], const pg8::Unit& u, int wr, int wc, int fr, int fq, LAS unsigned char* lds, int wid, int lane) const {
        const int tid = wid * 64 + lane, b = u.pm >> 3, grow0 = u.pm * 256, gcol0 = u.pn * 256;
        LAS float* LQ = (LAS float*)lds;
        LAS float* RINV = (LAS float*)(lds + 81920);
        const float* MODb = MOD + b * NMOD;
        f32x4 gv[2][2];
#pragma unroll
        for (int bj = 0; bj < 2; ++bj) { const int col = gcol0 + bj * 128 + wc * 32 + 8 * fq; gv[bj][0] = *(const f32x4*)(MODb + 2 * D + col); gv[bj][1] = *(const f32x4*)(MODb + 2 * D + col + 4); }
#pragma unroll
        for (int ai = 0; ai < 2; ++ai)
#pragma unroll
            for (int mp = 0; mp < 4; mp += 2) { f32x4 xv[2][2][2];
#pragma unroll
                for (int mm = 0; mm < 2; ++mm)
#pragma unroll
                    for (int bj = 0; bj < 2; ++bj) { const int row = ai * 128 + wr * 64 + (mp + mm) * 16 + fr, col = gcol0 + bj * 128 + wc * 32 + 8 * fq; const size_t o = (size_t)(grow0 + row) * D + col;
                        xv[mm][bj][0] = *(const f32x4*)(x + o); xv[mm][bj][1] = *(const f32x4*)(x + o + 4); }
#pragma unroll
                for (int mm = 0; mm < 2; ++mm)
#pragma unroll
                    for (int bj = 0; bj < 2; ++bj) { const int m = mp + mm, row = ai * 128 + wr * 64 + m * 16 + fr, col = gcol0 + bj * 128 + wc * 32 + 8 * fq; const size_t o = (size_t)(grow0 + row) * D + col;
                        acc[ai][bj][m][0] = xv[mm][bj][0] + gv[bj][0] * acc[ai][bj][m][0]; acc[ai][bj][m][1] = xv[mm][bj][1] + gv[bj][1] * acc[ai][bj][m][1];
                        v4u w; w.x = pk2(acc[ai][bj][m][0].x, acc[ai][bj][m][0].y); w.y = pk2(acc[ai][bj][m][0].z, acc[ai][bj][m][0].w); w.z = pk2(acc[ai][bj][m][1].x, acc[ai][bj][m][1].y); w.w = pk2(acc[ai][bj][m][1].z, acc[ai][bj][m][1].w);
                        *(v4u*)((bf16*)X1 + o) = w; } }
        float gsc[2][8], shv[2][8], wrv[2][8];
#pragma unroll
        for (int bj = 0; bj < 2; ++bj)
#pragma unroll
            for (int j = 0; j < 8; ++j) { const int c = gcol0 + bj * 128 + wc * 32 + 8 * fq + j; gsc[bj][j] = norm2_g[c] * (1.f + MODb[4 * D + c]); shv[bj][j] = MODb[3 * D + c]; wrv[bj][j] = w_router[c * NE + fr]; }
        float tw[2][2][4];
#pragma unroll
        for (int bj = 0; bj < 2; ++bj)
#pragma unroll
            for (int n = 0; n < 2; ++n)
#pragma unroll
                for (int r = 0; r < 4; ++r) tw[bj][n][r] = wrv[bj][4 * n + r] * gsc[bj][4 * n + r];
#pragma unroll
        for (int ai = 0; ai < 2; ++ai)
#pragma unroll
            for (int m = 0; m < 4; ++m) { const int row = ai * 128 + wr * 64 + m * 16 + fr;
                f32x4 q = (f32x4){0.f, 0.f, 0.f, 0.f}; float s2 = 0.f;
#pragma unroll
                for (int bj = 0; bj < 2; ++bj)
#pragma unroll
                    for (int n = 0; n < 2; ++n)
#pragma unroll
                        for (int r = 0; r < 4; ++r) { const float v = acc[ai][bj][m][n][r]; q = __builtin_amdgcn_mfma_f32_16x16x4f32(tw[bj][n][r], v, q, 0, 0, 0); s2 += v * v; }
                s2 += __shfl_xor(s2, 16); s2 += __shfl_xor(s2, 32);
                LAS float* o = LQ + (row * 4 + wc) * 20;
                o[4 * fq + 0] = q[0]; o[4 * fq + 1] = q[1]; o[4 * fq + 2] = q[2]; o[4 * fq + 3] = q[3]; if (fq == 0) o[16] = s2; }
        __syncthreads();
        float* xo = XCH + (size_t)((u.pm * 4 + u.pn) * 256) * 20;
        for (int i = tid; i < 256 * 9; i += NTHREADS) { const int row = i / 9, q2 = 2 * (i - row * 9); const LAS float* s = LQ + row * 80 + q2;
            const float v0 = (s[0] + s[20]) + (s[40] + s[60]), v1 = q2 < 16 ? (s[1] + s[21]) + (s[41] + s[61]) : 0.f;
            __hip_atomic_store((unsigned long long*)(xo + row * 20 + q2), ((unsigned long long)__float_as_uint(v1) << 32) | __float_as_uint(v0), __ATOMIC_RELAXED, __HIP_MEMORY_SCOPE_AGENT); }
        asm volatile("s_waitcnt vmcnt(0)" ::: "memory");
        __syncthreads();
        if (tid == 0) {
            __hip_atomic_fetch_add(cnt + 16 * u.pm, 1u, __ATOMIC_RELAXED, __HIP_MEMORY_SCOPE_AGENT);
            XB_SPIN(xb_ld(cnt + 16 * u.pm) < 4u, tmo);
        }
        __syncthreads();
        const float* xp = XCH + (size_t)(u.pm * 4 * 256) * 20;
#define XLD(ptr) __hip_atomic_load((ptr), __ATOMIC_RELAXED, __HIP_MEMORY_SCOPE_AGENT)
        if (tid < 256) { const int row = tid; const float S2 = (XLD(xp + row * 20 + 16) + XLD(xp + 5120 + row * 20 + 16)) + (XLD(xp + 10240 + row * 20 + 16) + XLD(xp + 15360 + row * 20 + 16)); RINV[row] = rsqrtf(S2 * (1.f / D) + EPS); }
        else if (tid < 320) { const int row = 64 * u.pn + (tid - 256); const float* r0 = xp + row * 20;
            const float S2 = (XLD(r0 + 16) + XLD(r0 + 5120 + 16)) + (XLD(r0 + 10240 + 16) + XLD(r0 + 15360 + 16)), rinv = rsqrtf(S2 * (1.f / D) + EPS);
            float lg[16]; float mx = -3.0e38f;
#pragma unroll
            for (int e = 0; e < 16; ++e) { lg[e] = rinv * ((XLD(r0 + e) + XLD(r0 + 5120 + e)) + (XLD(r0 + 10240 + e) + XLD(r0 + 15360 + e))) + CB[b * NE + e]; mx = fmaxf(mx, lg[e]); }
            float den = 0.f;
#pragma unroll
            for (int e = 0; e < 16; ++e) { lg[e] = expf(lg[e] - mx); den += lg[e]; }
            const float rd = 1.f / den; const int t = (u.pm & 7) * 256 + row;
#pragma unroll
            for (int e = 0; e < 16; ++e) AFF[(size_t)(b * NE + e) * SEQ + t] = lg[e] * rd; }
#undef XLD
        __syncthreads();
#pragma unroll
        for (int ai = 0; ai < 2; ++ai)
#pragma unroll
            for (int m = 0; m < 4; ++m) { const int row = ai * 128 + wr * 64 + m * 16 + fr; const float rinv = RINV[row];
#pragma unroll
                for (int bj = 0; bj < 2; ++bj) { const f32x4 a0 = acc[ai][bj][m][0], a1 = acc[ai][bj][m][1]; v2u w;
                    w.x = pk4_fp8(a0[0] * rinv * gsc[bj][0] + shv[bj][0], a0[1] * rinv * gsc[bj][1] + shv[bj][1], a0[2] * rinv * gsc[bj][2] + shv[bj][2], a0[3] * rinv * gsc[bj][3] + shv[bj][3]);
                    w.y = pk4_fp8(a1[0] * rinv * gsc[bj][4] + shv[bj][4], a1[1] * rinv * gsc[bj][5] + shv[bj][5], a1[2] * rinv * gsc[bj][6] + shv[bj][6], a1[3] * rinv * gsc[bj][7] + shv[bj][7]);
                    *(v2u*)(HX8 + (size_t)(grow0 + row) * D + gcol0 + bj * 128 + wc * 32 + 8 * fq) = w; } }
    }
    __device__ __forceinline__ void st8(const pg8::Unit&, int, int, f32x4, f32x4) const {}
};

template <class Epi, class Sched>
__device__ __forceinline__ void naive_gemm_phase(LAS unsigned char* lds, const pg8::Gemm g, const Sched& S, const Epi& E) {
    LAS float* As = (LAS float*)lds; LAS float* Bs = (LAS float*)(lds + 4352);
    const int tid = threadIdx.x, ty = tid >> 5, tx = tid & 31, K = g.K, lr = tid >> 1, lh = 8 * (tid & 1);
    pg8::Unit u;
    for (int i = 0; S.next(i, u); ++i)
        for (int sub = 0; sub < 4; ++sub) {
            f32x4 ag[4], au[4];
#pragma unroll
            for (int r = 0; r < 4; ++r) { ag[r] = (f32x4){0.f, 0.f, 0.f, 0.f}; au[r] = (f32x4){0.f, 0.f, 0.f, 0.f}; }
            const bf16* arow = g.A + ((size_t)u.pm * 256 + sub * 64 + (lr & 63)) * K + lh;
            const bf16* brow = g.Bt + ((size_t)u.pnB * 256 + lr) * K + lh;
            for (int k0 = 0; k0 < K; k0 += 16) {
                const v4u bv = *(const v4u*)(brow + k0); v4u av = (v4u){0u, 0u, 0u, 0u}; if (tid < 128) av = *(const v4u*)(arow + k0);
                __syncthreads();
                Bs[(lh + 0) * 260 + lr] = bflo(bv.x); Bs[(lh + 1) * 260 + lr] = bfhi(bv.x); Bs[(lh + 2) * 260 + lr] = bflo(bv.y); Bs[(lh + 3) * 260 + lr] = bfhi(bv.y);
                Bs[(lh + 4) * 260 + lr] = bflo(bv.z); Bs[(lh + 5) * 260 + lr] = bfhi(bv.z); Bs[(lh + 6) * 260 + lr] = bflo(bv.w); Bs[(lh + 7) * 260 + lr] = bfhi(bv.w);
                if (tid < 128) {
                    As[(lh + 0) * 68 + lr] = bflo(av.x); As[(lh + 1) * 68 + lr] = bfhi(av.x); As[(lh + 2) * 68 + lr] = bflo(av.y); As[(lh + 3) * 68 + lr] = bfhi(av.y);
                    As[(lh + 4) * 68 + lr] = bflo(av.z); As[(lh + 5) * 68 + lr] = bfhi(av.z); As[(lh + 6) * 68 + lr] = bflo(av.w); As[(lh + 7) * 68 + lr] = bfhi(av.w); }
                __syncthreads();
#pragma unroll
                for (int kk = 0; kk < 16; ++kk) {
                    const f32x4 a = *(const LAS f32x4*)(As + kk * 68 + 4 * ty), b0 = *(const LAS f32x4*)(Bs + kk * 260 + 4 * tx), b1 = *(const LAS f32x4*)(Bs + kk * 260 + 128 + 4 * tx);
#pragma unroll
                    for (int r = 0; r < 4; ++r) { ag[r] += a[r] * b0; au[r] += a[r] * b1; }
                }
            }
#pragma unroll
            for (int r = 0; r < 4; ++r) { const int row = sub * 64 + 4 * ty + r;
                if constexpr (Epi::PAIRED) E.st2(u, row, 4 * tx, ag[r], au[r]);
                else { E.st(u, row, 4 * tx, ag[r]); E.st(u, row, 128 + 4 * tx, au[r]); } }
        }
    __syncthreads();
}
template <class Epi, class Sched>
__device__ __forceinline__ void gemm_any(LAS unsigned char* lds, const pg8::Gemm g, const Sched& S, const Epi& E) {
#if USE_PG8
    pg8::gemm_phase<Epi, Sched, true, true>(lds, g, S, E);
#else
    naive_gemm_phase<Epi, Sched>(lds, g, S, E);
#endif
}

__device__ __forceinline__ void transpose_item(const float* W, int N, int K, bf16* WT, int k0, int n0, size_t drow0, LAS unsigned char* scr, int lane) {
    const int lc = lane & 15, lr = lane >> 4;
    f32x4 v[16];
#pragma unroll
    for (int i = 0; i < 16; ++i) v[i] = __builtin_nontemporal_load((const f32x4*)(W + (size_t)(k0 + 4 * i + lr) * N + n0 + 4 * lc));
#pragma unroll
    for (int i = 0; i < 16; ++i) { const int k = 4 * i + lr;
#pragma unroll
        for (int j = 0; j < 4; ++j) *(LAS bf16*)(scr + (4 * lc + j) * 136 + k * 2) = (bf16)f2bf(v[i][j]); }
    LDS_WAIT(); asm volatile("" ::: "memory");
    const int c = lane & 7;
#pragma unroll
    for (int j = 0; j < 8; ++j) { const int n = (lane >> 3) + 8 * j;
        const v2u lo = *(const LAS v2u*)(scr + n * 136 + c * 16), hi = *(const LAS v2u*)(scr + n * 136 + c * 16 + 8);
        *(v4u*)(WT + (drow0 + n) * (size_t)K + k0 + 8 * c) = (v4u){lo.x, lo.y, hi.x, hi.y}; }
    LDS_WAIT(); asm volatile("" ::: "memory");
}
__device__ __forceinline__ void conv_load(const float* src, int N, int lane, f32x4 (&v)[16]);
struct P;
__device__ __forceinline__ void conv_desc(const P& p, int it, const float*& src, unsigned char*& dst, int& N, int& K);
__device__ __forceinline__ void conv_store(const f32x4 (&v)[16], unsigned char* dst, int K, LAS unsigned char* scr, int lane);
__device__ __forceinline__ void transpose_item_f8(const float* W, int N, int K, unsigned char* WT, int k0, int n0, size_t drow0, LAS unsigned char* scr, int lane) {
    f32x4 v[16]; conv_load(W + (size_t)k0 * N + n0, N, lane, v); conv_store(v, WT + drow0 * (size_t)K + k0, K, scr, lane);
}
constexpr int CONV_ITEMS = 16 * 32 + 16 * 16 + 3 * 512 * NE, CONV_CUT = CONV_ITEMS - 6144;
__device__ __forceinline__ void convert_items(const P& p, LAS unsigned char* lds, int lane, int wave, int first, int last, int gw, int NGW) {
    LAS unsigned char* scr = lds + wave * 16384;
    constexpr int I_IN = 16 * 32, I_OUT = 16 * 16, I_E = 512 * NE;
    for (int it = first + gw; it < last; it += NGW) {
        int r = it;
        if (r < I_IN) { const int kb = r >> 5, nb = r & 31; transpose_item(p.w_in, DIN, D, (bf16*)(p.ws + WS_WIN), 64 * kb, 64 * nb, (size_t)(64 * nb), scr, lane); continue; } r -= I_IN;
        if (r < I_OUT) { const int kb = r >> 4, nb = r & 15; transpose_item(p.w_out, D, D, (bf16*)(p.ws + WS_WOUT), 64 * kb, 64 * nb, (size_t)(64 * nb), scr, lane); continue; } r -= I_OUT;
#if MOE_FP8
        { const float* src_; unsigned char* dst_; int N_, K_; f32x4 v_[16]; conv_desc(p, it, src_, dst_, N_, K_); conv_load(src_, N_, lane, v_); conv_store(v_, dst_, K_, scr, lane); }
#else
        if (r < 2 * I_E) { const int which = r >= I_E; if (which) r -= I_E; const int e = r >> 9, q = r & 511, kb = q >> 5, nb = q & 31, n0 = 64 * nb;
            const float* W = (which ? p.w3 : p.w1) + (size_t)e * D * DE;
#if MOE_FP8
            transpose_item_f8(W, DE, D, p.ws + WS_WG, 64 * kb, n0, (size_t)e * 4096 + (size_t)(n0 >> 7) * 256 + (n0 & 127) + (which ? 128 : 0), scr, lane); continue; } r -= 2 * I_E;
#else
            transpose_item(W, DE, D, (bf16*)(p.ws + WS_WG), 64 * kb, n0, (size_t)e * 4096 + (size_t)(n0 >> 7) * 256 + (n0 & 127) + (which ? 128 : 0), scr, lane); continue; } r -= 2 * I_E;
#endif
        { const int e = r >> 9, q = r & 511, kb = q >> 4, nb = q & 15, n0 = 64 * nb;
#if MOE_FP8
            transpose_item_f8(p.w2 + (size_t)e * DE * D, D, DE, p.ws + WS_W2, 64 * kb, n0, (size_t)e * 1024 + n0, scr, lane); }
#else
            transpose_item(p.w2 + (size_t)e * DE * D, D, DE, (bf16*)(p.ws + WS_W2), 64 * kb, n0, (size_t)e * 1024 + n0, scr, lane); }
#endif
#endif
    }
}

template <int KIND>
__device__ __forceinline__ void convert_small(const P& p, LAS unsigned char* lds, int lane, int wave, int gw, int NGW) {
    LAS unsigned char* scr = lds + wave * 16384;
    constexpr int NI = KIND == 0 ? 16 * 32 : 16 * 16;
    for (int r = gw; r < NI; r += NGW) {
        if constexpr (KIND == 0) { const int kb = r >> 5, nb = r & 31; transpose_item(p.w_in, DIN, D, (bf16*)(p.ws + WS_WIN), 64 * kb, 64 * nb, (size_t)(64 * nb), scr, lane); }
        else { const int kb = r >> 4, nb = r & 15; transpose_item(p.w_out, D, D, (bf16*)(p.ws + WS_WOUT), 64 * kb, 64 * nb, (size_t)(64 * nb), scr, lane); }
    }
}
#if MOE_FP8
constexpr int CONV_HEAD = 16 * 32 + 16 * 16;
__device__ __forceinline__ void conv_desc(const P& p, int it, const float*& src, unsigned char*& dst, int& N, int& K) {
    constexpr int I_E = 512 * NE; const int r0 = it - CONV_HEAD;
    const bool isw2 = r0 >= 2 * I_E, which = (!isw2) && r0 >= I_E; const int r = isw2 ? r0 - 2 * I_E : (which ? r0 - I_E : r0);
    const int e = r >> 9, q = r & 511, kb = isw2 ? (q >> 5) : (q >> 6), nb = isw2 ? (q & 31) : (q & 63), n0 = 32 * nb;
    N = isw2 ? D : DE; K = isw2 ? DE : D;
    const float* base = isw2 ? p.w2 : (which ? p.w3 : p.w1);
    src = base + (size_t)e * D * DE + (size_t)(128 * kb) * N + n0;
    const size_t drow = isw2 ? ((size_t)e * 1024 + n0) : ((size_t)e * 4096 + (size_t)(n0 >> 7) * 256 + (n0 & 127) + (which ? 128 : 0));
    dst = p.ws + (isw2 ? WS_W2 : WS_WG) + drow * (size_t)K + 128 * kb;
}
__device__ __forceinline__ void conv_load(const float* src, int N, int lane, f32x4 (&v)[16]) {
    const int lc = lane & 7, lr = lane >> 3;
#pragma unroll
    for (int i = 0; i < 16; ++i) v[i] = __builtin_nontemporal_load((const f32x4*)(src + (size_t)(16 * lr + i) * N + 4 * lc));
}
__device__ __forceinline__ void conv_store(const f32x4 (&v)[16], unsigned char* dst, int K, LAS unsigned char* scr, int lane) {
    const int lc = lane & 7, lr = lane >> 3; (void)scr;
#pragma unroll
    for (int j = 0; j < 4; ++j) { v4u o;
        o.x = pk4_fp8(v[0][j] * WSCALE, v[1][j] * WSCALE, v[2][j] * WSCALE, v[3][j] * WSCALE);
        o.y = pk4_fp8(v[4][j] * WSCALE, v[5][j] * WSCALE, v[6][j] * WSCALE, v[7][j] * WSCALE);
        o.z = pk4_fp8(v[8][j] * WSCALE, v[9][j] * WSCALE, v[10][j] * WSCALE, v[11][j] * WSCALE);
        o.w = pk4_fp8(v[12][j] * WSCALE, v[13][j] * WSCALE, v[14][j] * WSCALE, v[15][j] * WSCALE);
        __builtin_nontemporal_store(o, (v4u*)(dst + (size_t)(4 * lc + j) * K + 16 * lr)); }
}
__device__ __forceinline__ void convert_pipelined(const P& p, LAS unsigned char* lds, int lane, int wave, int first, int last, int gw, int NGW) {
    LAS unsigned char* scr = lds + wave * 16384;
    f32x4 va[16], vb[16], vc[16]; const float* s0; unsigned char* da; unsigned char* db; unsigned char* dc; int N0, Ka, Kb, Kc;
    int it = first + gw; if (it >= last) return;
    const int itl = it + ((last - 1 - it) / NGW) * NGW;
    conv_desc(p, it, s0, da, N0, Ka); conv_load(s0, N0, lane, va);
    { const int i1 = min(it + NGW, itl); conv_desc(p, i1, s0, db, N0, Kb); conv_load(s0, N0, lane, vb); }
    for (; it <= itl; it += 3 * NGW) {
        { const int i2 = min(it + 2 * NGW, itl); conv_desc(p, i2, s0, dc, N0, Kc); conv_load(s0, N0, lane, vc); }
        conv_store(va, da, Ka, scr, lane);
        { const int i3 = min(it + 3 * NGW, itl); conv_desc(p, i3, s0, da, N0, Ka); conv_load(s0, N0, lane, va); }
        conv_store(vb, db, Kb, scr, lane);
        { const int i4 = min(it + 4 * NGW, itl); conv_desc(p, i4, s0, db, N0, Kb); conv_load(s0, N0, lane, vb); }
        conv_store(vc, dc, Kc, scr, lane);
    }
}
#endif
constexpr int CONV_WSEAM = 2 * 1536;
constexpr int CONV_NV = CONV_ITEMS - CONV_HEAD - CONV_WSEAM;
__device__ __forceinline__ int conv_map(int v) { return CONV_HEAD + CONV_WSEAM + v; }
__device__ __forceinline__ void convert_one(const P& p, int it, int lane) {
    const float* s; unsigned char* d; int N, K; f32x4 v[16]; conv_desc(p, it, s, d, N, K); conv_load(s, N, lane, v); conv_store(v, d, K, (LAS unsigned char*)0, lane);
}
__device__ __forceinline__ void p0_small_copies(const P& p, int tid, int vcu, int G) {
    bf16* GWT = (bf16*)(p.ws + WS_GWT); bf16* SWB = (bf16*)(p.ws + WS_SWB); const int gt = vcu * NTHREADS + tid, NT = G * NTHREADS;
    for (int o = gt; o < 131072; o += NT) { const int i = o & 63, j = (o >> 6) & 63, h = (o >> 12) & 7, g = (o >> 15) & 1, d = o >> 16;
        GWT[o] = (bf16)f2bf((g ? p.rg_wi : p.rg_wa)[(size_t)((d * 8 + h) * 64 + i) * 64 + j]); }
    for (int o = gt; o < 65536; o += NT) SWB[o] = (bf16)f2bf(p.sgu_w[o]);
}
__device__ __forceinline__ void phase_p0(const P& p, LAS unsigned char* lds, int tid, int lane, int wave, int vcu, int G, int conv_last, bool small = true) {
    float* MOD = (float*)(p.ws + WS_MOD);
    {
        LAS float* sc = (LAS float*)lds; LAS float* part = (LAS float*)(lds + 36864);
        if (vcu < 192) {
            float cv[18];
#pragma unroll
            for (int i = 0; i < 18; ++i) { const int e = tid + i * NTHREADS, j = e >> 10, k = e & 1023; cv[i] = j < 8 ? p.c[j * D + k] : p.c_ctx[k]; }
#pragma unroll
            for (int i = 0; i < 18; ++i) sc[tid + i * NTHREADS] = siluf_(cv[i]);
        }
        __syncthreads();
        for (int t = vcu; t < 192; t += G) {
            const int c4 = lane & 7, kr = lane >> 3, kbase = wave * 128 + kr; f32x4 acc[9];
#pragma unroll
            for (int j = 0; j < 9; ++j) acc[j] = (f32x4){0.f, 0.f, 0.f, 0.f};
            f32x4 w[16];
#pragma unroll
            for (int i = 0; i < 16; ++i) w[i] = __builtin_nontemporal_load((const f32x4*)(p.w_mod + (size_t)(kbase + 8 * i) * NMOD + t * 32 + 4 * c4));
#pragma unroll
            for (int i = 0; i < 16; ++i)
#pragma unroll
                for (int j = 0; j < 9; ++j) acc[j] += w[i] * sc[j * D + kbase + 8 * i];
#pragma unroll
            for (int j = 0; j < 9; ++j) {
#pragma unroll
                for (int q = 0; q < 4; ++q) { float a = acc[j][q]; a += __shfl_xor(a, 8); a += __shfl_xor(a, 16); a += __shfl_xor(a, 32); acc[j][q] = a; }
                if (lane < 8) *(LAS f32x4*)(part + (wave * 9 + j) * 32 + 4 * c4) = acc[j]; }
            __syncthreads();
            for (int i = tid; i < 9 * 32; i += NTHREADS) { const int j = i >> 5, l = i & 31; float s2 = p.b_mod[t * 32 + l];
#pragma unroll
                for (int w = 0; w < 8; ++w) s2 += part[(w * 9 + j) * 32 + l];
                MOD[j * NMOD + t * 32 + l] = s2; }
            __syncthreads();
        }
    }
    convert_items(p, lds, lane, wave, 0, conv_last, vcu * NWAVES + wave, G * NWAVES);
    if (small) p0_small_copies(p, tid, vcu, G);
}

__device__ __forceinline__ void phase_p1(const P& p, int lane, int wave, int vcu, int G, int xgl = -1) {
    const float* MOD = (const float*)(p.ws + WS_MOD); bf16* HX = (bf16*)(p.ws + WS_HX);
    const int gwc = (xgl >= 0 ? xgl * G + vcu : vcu) * NWAVES + wave, NGWC = (xgl >= 0 ? 8 * G : G) * NWAVES;
    for (int i = gwc; i < BATCH * NE; i += NGWC) { const int b = i >> 4, e = i & 15; float a = 0.f;
        for (int k = lane; k < D; k += 64) a += MOD[b * NMOD + 3 * D + k] * p.w_router[k * NE + e];
        a = wave_sum(a); if (lane == 0) ((float*)(p.ws + WS_CB))[i] = a; }
    const int gw = vcu * NWAVES + wave, NGW = G * NWAVES, NR = xgl >= 0 ? SEQ + CTXL : MT;
    auto rowmap = [&](int r) -> int { return xgl >= 0 ? (r < SEQ ? xgl * SEQ + r : M + xgl * CTXL + (r - SEQ)) : r; };
    f32x4 nx[4];
    { if (gw < NR) { const int m = rowmap(gw); const f32x4* xr = (const f32x4*)(m < M ? p.x + (size_t)m * D : p.ctx + (size_t)(m - M) * D) + lane;
#pragma unroll
        for (int jj = 0; jj < 4; ++jj) nx[jj] = __builtin_nontemporal_load(xr + 64 * jj); } }
    for (int r = gw; r < NR; r += NGW) {
        const int m = rowmap(r), j = m < M ? (m >> 11) : 8;
        f32x4 v[4]; float s = 0.f;
#pragma unroll
        for (int jj = 0; jj < 4; ++jj) { v[jj] = nx[jj]; s += (v[jj].x * v[jj].x + v[jj].y * v[jj].y) + (v[jj].z * v[jj].z + v[jj].w * v[jj].w); }
        { if (r + NGW < NR) { const int m2 = rowmap(r + NGW); const f32x4* xr = (const f32x4*)(m2 < M ? p.x + (size_t)m2 * D : p.ctx + (size_t)(m2 - M) * D) + lane;
#pragma unroll
            for (int jj = 0; jj < 4; ++jj) nx[jj] = __builtin_nontemporal_load(xr + 64 * jj); } }
        const float rinv = rsqrtf(wave_sum(s) * (1.f / D) + EPS);
        v2u* o = (v2u*)(HX + (size_t)m * D) + lane;
#pragma unroll
        for (int jj = 0; jj < 4; ++jj) { const int k = 4 * (lane + 64 * jj);
            const f32x4 g = *(const f32x4*)(p.norm1_g + k), sh = *(const f32x4*)(MOD + j * NMOD + k), sc = *(const f32x4*)(MOD + j * NMOD + D + k);
            const f32x4 h = v[jj] * rinv * g * (sc + 1.f) + sh; v2u w; w.x = pk2(h.x, h.y); w.y = pk2(h.z, h.w); o[64 * jj] = w; }
    }
}

__device__ __forceinline__ void phase_lru1(const P& p, LAS unsigned char* lds, int tid, int vcu, int G) {
    LAS float* xt = (LAS float*)lds;
    LAS float* cx = (LAS float*)(lds + 17152);
    LAS float* af = (LAS float*)(lds + 33536);
    LAS float* df = (LAS float*)(lds + 49920);
    LAS float* ab = (LAS float*)(lds + 66304);
    LAS float* db = (LAS float*)(lds + 82688);
    const bf16* UV = (const bf16*)(p.ws + WS_UV); const bf16* XC = (const bf16*)(p.ws + WS_XC);
    bf16* HS = (bf16*)(p.ws + WS_HS); bf16* PF = (bf16*)(p.ws + WS_PF); bf16* PB = (bf16*)(p.ws + WS_PB); float* SUM = (float*)(p.ws + WS_SUM);
    for (int T = vcu; T < BATCH * NSEG * 8; T += G) {
        const int b = T / (NSEG * 8), rem = T % (NSEG * 8), seg = rem >> 3, h = rem & 7;
        for (int i = tid; i < 67 * 64; i += NTHREADS) { const int r = (i >> 6) - 1, ch = i & 63; float v = 0.f;
            if (seg < 4) { const int pos = seg * 64 + r; if (pos >= 0 && pos < CTXL) v = bf2f(XC[(size_t)(b * CTXL + pos) * DLRU + h * 64 + ch]); }
            else { if (r >= 0 && r < 64) v = bf2f(UV[(size_t)(b * SEQ + (seg - 4) * 64 + r) * DIN + 1024 + h * 64 + ch]); }
            xt[i] = v; }
        __syncthreads();
        for (int i = tid; i < 4096; i += NTHREADS) { const int r = i >> 6, ch = i & 63, cch = h * 64 + ch; float v = p.conv_b[cch];
#pragma unroll
            for (int j = 0; j < 4; ++j) v += p.conv_w[j * DLRU + cch] * xt[(r + j) * 64 + ch];
            cx[i] = v; }
        __syncthreads();
        { const int jj = tid & 63, r0 = tid >> 6, cch = h * 64 + jj;
#pragma unroll
          for (int d = 0; d < 2; ++d) {
            float aa[8], ai[8];
#pragma unroll
            for (int q = 0; q < 8; ++q) { aa[q] = 0.f; ai[q] = 0.f; }
            const float* wa = p.rg_wa + (size_t)((d * 8 + h) * 64) * 64 + jj; const float* wi = p.rg_wi + (size_t)((d * 8 + h) * 64) * 64 + jj;
#pragma unroll 2
            for (int i = 0; i < 64; ++i) { const float wav = wa[i * 64], wiv = wi[i * 64];
#pragma unroll
                for (int q = 0; q < 8; ++q) { const float cv = cx[(r0 + 8 * q) * 64 + i]; aa[q] += cv * wav; ai[q] += cv * wiv; } }
            const float ba = p.rg_ba[d * DLRU + cch], bi = p.rg_bi[d * DLRU + cch], c8 = -8.f * log1pf(expf(-p.rg_lam[d * DLRU + cch]));
            LAS float* ao = d ? ab : af; LAS float* dout = d ? db : df;
#pragma unroll
            for (int q = 0; q < 8; ++q) { const int r = r0 + 8 * q; const float rg = sigmoidf_(aa[q] + ba), ig = sigmoidf_(ai[q] + bi), la = c8 * rg;
                ao[r * 64 + jj] = expf(la); dout[r * 64 + jj] = sqrtf(-expm1f(2.f * la)) * ig * cx[r * 64 + jj]; }
          } }
        __syncthreads();
        if (tid < 128) { const int d = tid >> 6, ch = tid & 63; float hh = 0.f, pp = 1.f;
            if (d == 0) {
#pragma unroll 4
                for (int r = 0; r < 64; ++r) { const float a = af[r * 64 + ch]; hh = a * hh + df[r * 64 + ch]; pp *= a; df[r * 64 + ch] = hh; af[r * 64 + ch] = pp; } }
            else {
#pragma unroll 4
                for (int r = 63; r >= 0; --r) { const float a = ab[r * 64 + ch]; hh = a * hh + db[r * 64 + ch]; pp *= a; db[r * 64 + ch] = hh; ab[r * 64 + ch] = pp; } }
            float* s = SUM + ((size_t)((b * NSEG + seg) * 2 + d) * DLRU + h * 64 + ch) * 2; s[0] = pp; s[1] = hh; }
        __syncthreads();
        if (seg >= 4) for (int i = tid; i < 4096; i += NTHREADS) { const int r = i >> 6, ch = i & 63; const size_t o = (size_t)(b * SEQ + (seg - 4) * 64 + r) * DLRU + h * 64 + ch;
            HS[o] = (bf16)f2bf(df[i] + db[i]); PF[o] = (bf16)f2bf(af[i]); PB[o] = (bf16)f2bf(ab[i]); }
        __syncthreads();
    }
}

__device__ __forceinline__ void phase_sgu(const P& p, LAS unsigned char* lds, int tid, int vcu, int G) {
    LAS float* vn = (LAS float*)lds;
    LAS float* wsl = (LAS float*)(lds + 65536);
    const bf16* UV = (const bf16*)(p.ws + WS_UV); bf16* A2 = (bf16*)(p.ws + WS_A2);
    for (int T = vcu; T < 512; T += G) {
        const int b = T >> 6, n = (T >> 2) & 15, h = T & 3; const size_t t0 = (size_t)b * SEQ + n * 128;
        for (int i = tid; i < 16384; i += NTHREADS) { const int q = i >> 7, c = i & 127; vn[i] = bf2f(UV[(t0 + q) * DIN + 512 + h * 128 + c]); wsl[i] = p.sgu_w[h * 16384 + i]; }
        __syncthreads();
        { const int q = tid >> 2, part = tid & 3; float s = 0.f;
          for (int c = part * 32; c < part * 32 + 32; ++c) { const float v = vn[q * 128 + c]; s += v * v; }
          s += __shfl_xor(s, 1); s += __shfl_xor(s, 2);
          const float rinv = rsqrtf(s * (1.f / 128.f) + EPS);
          for (int c = part * 32; c < part * 32 + 32; ++c) vn[q * 128 + c] *= rinv * p.sgu_g[h * 128 + c]; }
        __syncthreads();
        { const int c = tid & 127, p0 = tid >> 7; float acc[32];
#pragma unroll
          for (int i = 0; i < 32; ++i) acc[i] = 0.f;
          for (int q = 0; q < 128; ++q) { const float vq = vn[q * 128 + c];
#pragma unroll
              for (int i = 0; i < 32; ++i) acc[i] += wsl[(p0 + 4 * i) * 128 + q] * vq; }
#pragma unroll
          for (int i = 0; i < 32; ++i) { const int pp = p0 + 4 * i; const float s = acc[i] + p.sgu_b[h * 128 + pp];
              const float uu = bf2f(UV[(t0 + pp) * DIN + h * 128 + c]); A2[(t0 + pp) * D + h * 128 + c] = (bf16)f2bf(uu * s); } }
        __syncthreads();
    }
}


__device__ __forceinline__ void phase_lru1_mfma(const P& p, LAS unsigned char* lds, int tid, int lane, int wave, int vcu, int G) {
    LAS float* xt = (LAS float*)lds;
    LAS float* cxf = (LAS float*)(lds + 17152);
    LAS unsigned char* cxb = lds + 33536;
    LAS float* AD = (LAS float*)(lds + 42752);
    LAS float* SS = (LAS float*)(lds + 108288);
    const bf16* UV = (const bf16*)(p.ws + WS_UV); const bf16* XC = (const bf16*)(p.ws + WS_XC); const bf16* GWT = (const bf16*)(p.ws + WS_GWT);
    bf16* HS = (bf16*)(p.ws + WS_HS); bf16* PF = (bf16*)(p.ws + WS_PF); bf16* PB = (bf16*)(p.ws + WS_PB); float* SUM = (float*)(p.ws + WS_SUM);
    const int fr = lane & 15, fq = lane >> 4;
    const int wd = wave >> 2, jt = wave & 3, wj = 16 * jt + fr, cch_c = tid & 63;
    int hcur = -1; bf16x8 bfr[2][2]; float ba = 0.f, bi = 0.f, c8 = 0.f, cw0 = 0.f, cw1 = 0.f, cw2 = 0.f, cw3 = 0.f, cbias = 0.f;
    auto load_piece = [&](int T, int i) -> v4u { const int b = T / (NSEG * 8), rem = T % (NSEG * 8), seg = rem >> 3, h = rem & 7, r = (i >> 3) - 1, c0 = (i & 7) * 8; v4u w = (v4u){0u, 0u, 0u, 0u};
        if (seg < 4) { const int pos = seg * 64 + r; if (pos >= 0 && pos < CTXL) w = *(const v4u*)(XC + (size_t)(b * CTXL + pos) * DLRU + h * 64 + c0); }
        else { if (r >= 0 && r < 64) w = *(const v4u*)(UV + (size_t)(b * SEQ + (seg - 4) * 64 + r) * DIN + 1024 + h * 64 + c0); }
        return w; };
    v4u pre0 = (v4u){0u, 0u, 0u, 0u}, pre1 = (v4u){0u, 0u, 0u, 0u};
    if (vcu < BATCH * NSEG * 8) { pre0 = load_piece(vcu, tid); if (tid < 24) pre1 = load_piece(vcu, tid + 512); }
    for (int T = vcu; T < BATCH * NSEG * 8; T += G) {
        const int b = T / (NSEG * 8), rem = T % (NSEG * 8), seg = rem >> 3, h = rem & 7;
        { LAS float* o = xt + (tid >> 3) * 64 + (tid & 7) * 8;
          *(LAS f32x4*)o = (f32x4){bflo(pre0.x), bfhi(pre0.x), bflo(pre0.y), bfhi(pre0.y)}; *(LAS f32x4*)(o + 4) = (f32x4){bflo(pre0.z), bfhi(pre0.z), bflo(pre0.w), bfhi(pre0.w)};
          if (tid < 24) { LAS float* o1 = xt + ((tid + 512) >> 3) * 64 + (tid & 7) * 8;
              *(LAS f32x4*)o1 = (f32x4){bflo(pre1.x), bfhi(pre1.x), bflo(pre1.y), bfhi(pre1.y)}; *(LAS f32x4*)(o1 + 4) = (f32x4){bflo(pre1.z), bfhi(pre1.z), bflo(pre1.w), bfhi(pre1.w)}; } }
        if (h != hcur) { hcur = h;
#pragma unroll
            for (int g = 0; g < 2; ++g)
#pragma unroll
                for (int ks = 0; ks < 2; ++ks) bfr[g][ks] = *(const bf16x8*)(GWT + (size_t)((((wd * 2 + g) * 8 + h) * 64 + wj) * 64 + 32 * ks + 8 * fq));
            ba = p.rg_ba[wd * DLRU + h * 64 + wj]; bi = p.rg_bi[wd * DLRU + h * 64 + wj]; c8 = -8.f * log1pf(expf(-p.rg_lam[wd * DLRU + h * 64 + wj]));
            cw0 = p.conv_w[h * 64 + cch_c]; cw1 = p.conv_w[DLRU + h * 64 + cch_c]; cw2 = p.conv_w[2 * DLRU + h * 64 + cch_c]; cw3 = p.conv_w[3 * DLRU + h * 64 + cch_c]; cbias = p.conv_b[h * 64 + cch_c]; }
        __syncthreads();
        if (T + G < BATCH * NSEG * 8) { pre0 = load_piece(T + G, tid); if (tid < 24) pre1 = load_piece(T + G, tid + 512); }
        for (int i = tid; i < 4096; i += NTHREADS) { const int r = i >> 6, ch = i & 63;
            const float v = cbias + cw0 * xt[r * 64 + ch] + cw1 * xt[(r + 1) * 64 + ch] + cw2 * xt[(r + 2) * 64 + ch] + cw3 * xt[(r + 3) * 64 + ch];
            cxf[i] = v; *(LAS bf16*)(cxb + r * 144 + ch * 2) = (bf16)f2bf(v); }
        __syncthreads();
        { const int d = wd, j = wj;
          LAS float* Ad = AD + d * 8192; LAS float* Dd = Ad + 4096;
#pragma unroll
          for (int pt = 0; pt < 4; ++pt) {
              const bf16x8 a0 = *(const LAS bf16x8*)(cxb + (16 * pt + fr) * 144 + 16 * fq), a1 = *(const LAS bf16x8*)(cxb + (16 * pt + fr) * 144 + 64 + 16 * fq);
              f32x4 ca = (f32x4){0.f, 0.f, 0.f, 0.f}, ci = (f32x4){0.f, 0.f, 0.f, 0.f};
              ca = __builtin_amdgcn_mfma_f32_16x16x32_bf16(a0, bfr[0][0], ca, 0, 0, 0); ca = __builtin_amdgcn_mfma_f32_16x16x32_bf16(a1, bfr[0][1], ca, 0, 0, 0);
              ci = __builtin_amdgcn_mfma_f32_16x16x32_bf16(a0, bfr[1][0], ci, 0, 0, 0); ci = __builtin_amdgcn_mfma_f32_16x16x32_bf16(a1, bfr[1][1], ci, 0, 0, 0);
#pragma unroll
              for (int r = 0; r < 4; ++r) { const int pos = 16 * pt + 4 * fq + r; const float rg = sigmoidf_(ca[r] + ba), ig = sigmoidf_(ci[r] + bi), la = c8 * rg;
                  float av, sv; decay_pair(la, av, sv); Ad[pos * 64 + j] = av; Dd[pos * 64 + j] = sv * ig * cxf[pos * 64 + j]; }
          } }
        __syncthreads();
        { const int sub = tid >> 7, d = (tid >> 6) & 1, ch = tid & 63;
          LAS float* Ad = AD + d * 8192; LAS float* Dd = Ad + 4096;
          float hl[16], pc[16]; float hh = 0.f, pp = 1.f;
#pragma unroll
          for (int t = 0; t < 16; ++t) { const int pos = d ? 16 * sub + 15 - t : 16 * sub + t; const float a = Ad[pos * 64 + ch]; hh = a * hh + Dd[pos * 64 + ch]; pp *= a; hl[t] = hh; pc[t] = pp; }
          SS[((sub * 2 + d) * 64 + ch) * 2] = pp; SS[((sub * 2 + d) * 64 + ch) * 2 + 1] = hh;
          __syncthreads();
          float cin = 0.f, cp = 1.f;
          if (d == 0) { for (int s2 = 0; s2 < sub; ++s2) { const float A = SS[((s2 * 2) * 64 + ch) * 2], B = SS[((s2 * 2) * 64 + ch) * 2 + 1]; cin = A * cin + B; cp *= A; } }
          else { for (int s2 = 3; s2 > sub; --s2) { const float A = SS[((s2 * 2 + 1) * 64 + ch) * 2], B = SS[((s2 * 2 + 1) * 64 + ch) * 2 + 1]; cin = A * cin + B; cp *= A; } }
#pragma unroll
          for (int t = 0; t < 16; ++t) { const int pos = d ? 16 * sub + 15 - t : 16 * sub + t; Dd[pos * 64 + ch] = hl[t] + pc[t] * cin; Ad[pos * 64 + ch] = pc[t] * cp; }
          if ((d == 0 && sub == 3) || (d == 1 && sub == 0)) { float* so = SUM + ((size_t)((b * NSEG + seg) * 2 + d) * DLRU + h * 64 + ch) * 2; so[0] = pc[15] * cp; so[1] = hl[15] + pc[15] * cin; }
        }
        __syncthreads();
        if (seg >= 4) { const int pos = tid >> 3, c0 = (tid & 7) * 8; const LAS float* q0 = AD + pos * 64 + c0;
            const f32x4 a0l = *(const LAS f32x4*)(q0), a0h = *(const LAS f32x4*)(q0 + 4), d0l = *(const LAS f32x4*)(q0 + 4096), d0h = *(const LAS f32x4*)(q0 + 4100);
            const f32x4 a1l = *(const LAS f32x4*)(q0 + 8192), a1h = *(const LAS f32x4*)(q0 + 8196), d1l = *(const LAS f32x4*)(q0 + 12288), d1h = *(const LAS f32x4*)(q0 + 12292);
            const f32x4 sl = d0l + d1l, sh = d0h + d1h; const size_t o = (size_t)(b * SEQ + (seg - 4) * 64 + pos) * DLRU + h * 64 + c0;
            *(v4u*)(HS + o) = (v4u){pk2(sl.x, sl.y), pk2(sl.z, sl.w), pk2(sh.x, sh.y), pk2(sh.z, sh.w)};
            *(v4u*)(PF + o) = (v4u){pk2(a0l.x, a0l.y), pk2(a0l.z, a0l.w), pk2(a0h.x, a0h.y), pk2(a0h.z, a0h.w)};
            *(v4u*)(PB + o) = (v4u){pk2(a1l.x, a1l.y), pk2(a1l.z, a1l.w), pk2(a1h.x, a1h.y), pk2(a1h.z, a1h.w)}; }
        __syncthreads();
    }
}


template <int WD>
__device__ __forceinline__ void lru_scan(const float (&ga)[4][4], const float (&gb)[4][4], LAS float* EX, int lane, int fr, int fq, int wj, float& Pin, float& Hin) {
    const int cq = WD ? 3 - fq : fq, l16 = (WD ? lane + 16 : lane - 16) & 63, l32 = (WD ? lane + 32 : lane - 32) & 63, llast = WD ? fr : fr + 48;
    LAS float* Pd = EX + WD * 8192; LAS float* Hd = Pd + 4096;
#pragma unroll
    for (int ptc = 0; ptc < 4; ++ptc) { constexpr int dummy = 0; (void)dummy; const int pt = WD ? 3 - ptc : ptc;
        float pr[4], hr[4]; float hh = 0.f, pp = 1.f;
#pragma unroll
        for (int rc = 0; rc < 4; ++rc) { const int r = WD ? 3 - rc : rc; hh = ga[pt][r] * hh + gb[pt][r]; pp *= ga[pt][r]; pr[r] = pp; hr[r] = hh; }
        float A = pp, B = hh;
        { const float tA = __shfl(A, l16), tB = __shfl(B, l16); if (cq >= 1) { B = A * tB + B; A = tA * A; } }
        { const float tA = __shfl(A, l32), tB = __shfl(B, l32); if (cq >= 2) { B = A * tB + B; A = tA * A; } }
        float eA = __shfl(A, l16), eB = __shfl(B, l16); if (cq == 0) { eA = 1.f; eB = 0.f; }
        const float tAt = __shfl(A, llast), tBt = __shfl(B, llast);
        const float Hc = eA * Hin + eB, Pc = Pin * eA;
#pragma unroll
        for (int r = 0; r < 4; ++r) { const int pos = 16 * pt + 4 * fq + r; Hd[pos * 64 + wj] = pr[r] * Hc + hr[r]; Pd[pos * 64 + wj] = Pc * pr[r]; }
        Hin = tAt * Hin + tBt; Pin *= tAt;
    }
}

__device__ __forceinline__ void phase_lru1_v2(const P& p, LAS unsigned char* lds, int tid, int lane, int wave, int vcu, int G, int first = 0, int last = BATCH * NSEG * 8) {
    LAS float* xt = (LAS float*)lds;
    LAS float* cxf = (LAS float*)(lds + 17152);
    LAS unsigned char* cxb = lds + 33536;
    LAS float* EX = (LAS float*)(lds + 42752);
    const bf16* UV = (const bf16*)(p.ws + WS_UV); const bf16* XC = (const bf16*)(p.ws + WS_XC); const bf16* GWT = (const bf16*)(p.ws + WS_GWT);
    bf16* HS = (bf16*)(p.ws + WS_HS); bf16* PF = (bf16*)(p.ws + WS_PF); bf16* PB = (bf16*)(p.ws + WS_PB); float* SUM = (float*)(p.ws + WS_SUM);
    const int fr = lane & 15, fq = lane >> 4;
    const int wd = wave >> 2, jt = wave & 3, wj = 16 * jt + fr, cch_c = tid & 63;
    int hcur = -1; bf16x8 bfr[2][2]; float ba = 0.f, bi = 0.f, c8 = 0.f, cw0 = 0.f, cw1 = 0.f, cw2 = 0.f, cw3 = 0.f, cbias = 0.f;
    auto load_piece = [&](int T, int i) -> v4u { const int b = T / (NSEG * 8), rem = T % (NSEG * 8), seg = rem >> 3, h = rem & 7, r = (i >> 3) - 1, c0 = (i & 7) * 8; v4u w = (v4u){0u, 0u, 0u, 0u};
        if (seg < 4) { const int pos = seg * 64 + r; if (pos >= 0 && pos < CTXL) w = *(const v4u*)(XC + (size_t)(b * CTXL + pos) * DLRU + h * 64 + c0); }
        else { if (r >= 0 && r < 64) w = *(const v4u*)(UV + (size_t)(b * SEQ + (seg - 4) * 64 + r) * DIN + 1024 + h * 64 + c0); }
        return w; };
    v4u pre0 = (v4u){0u, 0u, 0u, 0u}, pre1 = (v4u){0u, 0u, 0u, 0u};
    if (first + vcu < last) { pre0 = load_piece(first + vcu, tid); if (tid < 24) pre1 = load_piece(first + vcu, tid + 512); }
    for (int T = first + vcu; T < last; T += G) {
        const int b = T / (NSEG * 8), rem = T % (NSEG * 8), seg = rem >> 3, h = rem & 7;
        { LAS float* o = xt + (tid >> 3) * 64 + (tid & 7) * 8;
          *(LAS f32x4*)o = (f32x4){bflo(pre0.x), bfhi(pre0.x), bflo(pre0.y), bfhi(pre0.y)}; *(LAS f32x4*)(o + 4) = (f32x4){bflo(pre0.z), bfhi(pre0.z), bflo(pre0.w), bfhi(pre0.w)};
          if (tid < 24) { LAS float* o1 = xt + ((tid + 512) >> 3) * 64 + (tid & 7) * 8;
              *(LAS f32x4*)o1 = (f32x4){bflo(pre1.x), bfhi(pre1.x), bflo(pre1.y), bfhi(pre1.y)}; *(LAS f32x4*)(o1 + 4) = (f32x4){bflo(pre1.z), bfhi(pre1.z), bflo(pre1.w), bfhi(pre1.w)}; } }
        if (h != hcur) { hcur = h;
#pragma unroll
            for (int g = 0; g < 2; ++g)
#pragma unroll
                for (int ks = 0; ks < 2; ++ks) bfr[g][ks] = *(const bf16x8*)(GWT + (size_t)((((wd * 2 + g) * 8 + h) * 64 + wj) * 64 + 32 * ks + 8 * fq));
            ba = p.rg_ba[wd * DLRU + h * 64 + wj]; bi = p.rg_bi[wd * DLRU + h * 64 + wj]; c8 = -8.f * log1pf(expf(-p.rg_lam[wd * DLRU + h * 64 + wj]));
            cw0 = p.conv_w[h * 64 + cch_c]; cw1 = p.conv_w[DLRU + h * 64 + cch_c]; cw2 = p.conv_w[2 * DLRU + h * 64 + cch_c]; cw3 = p.conv_w[3 * DLRU + h * 64 + cch_c]; cbias = p.conv_b[h * 64 + cch_c];
            asm volatile("" : "+v"(ba), "+v"(bi), "+v"(c8), "+v"(cw0), "+v"(cw1), "+v"(cw2), "+v"(cw3), "+v"(cbias) :: "memory");
#pragma unroll
            for (int g = 0; g < 2; ++g)
#pragma unroll
                for (int ks = 0; ks < 2; ++ks) asm volatile("" : "+v"(bfr[g][ks]) :: "memory"); }
        __syncthreads();
        if (T + G < last) { pre0 = load_piece(T + G, tid); if (tid < 24) pre1 = load_piece(T + G, tid + 512); }
        for (int i = tid; i < 4096; i += NTHREADS) { const int r = i >> 6, ch = i & 63;
            const float v = cbias + cw0 * xt[r * 64 + ch] + cw1 * xt[(r + 1) * 64 + ch] + cw2 * xt[(r + 2) * 64 + ch] + cw3 * xt[(r + 3) * 64 + ch];
            cxf[i] = v; *(LAS bf16*)(cxb + r * 144 + ch * 2) = (bf16)f2bf(v); }
        __syncthreads();
        {
            float ga[4][4], gb[4][4];
#pragma unroll
            for (int pt = 0; pt < 4; ++pt) {
                const bf16x8 a0 = *(const LAS bf16x8*)(cxb + (16 * pt + fr) * 144 + 16 * fq), a1 = *(const LAS bf16x8*)(cxb + (16 * pt + fr) * 144 + 64 + 16 * fq);
                f32x4 ca = (f32x4){0.f, 0.f, 0.f, 0.f}, ci = (f32x4){0.f, 0.f, 0.f, 0.f};
                ca = __builtin_amdgcn_mfma_f32_16x16x32_bf16(a0, bfr[0][0], ca, 0, 0, 0); ca = __builtin_amdgcn_mfma_f32_16x16x32_bf16(a1, bfr[0][1], ca, 0, 0, 0);
                ci = __builtin_amdgcn_mfma_f32_16x16x32_bf16(a0, bfr[1][0], ci, 0, 0, 0); ci = __builtin_amdgcn_mfma_f32_16x16x32_bf16(a1, bfr[1][1], ci, 0, 0, 0);
#pragma unroll
                for (int r = 0; r < 4; r += 2) { const int pos = 16 * pt + 4 * fq + r;
                    const f32x2p rg = sigmoid2_((f32x2p){ca[r], ca[r + 1]} + ba), ig = sigmoid2_((f32x2p){ci[r], ci[r + 1]} + bi); f32x2p av, sv; decay_pair2(rg * c8, av, sv);
                    const f32x2p dv = sv * ig * (f32x2p){cxf[pos * 64 + wj], cxf[(pos + 1) * 64 + wj]}; ga[pt][r] = av.x; ga[pt][r + 1] = av.y; gb[pt][r] = dv.x; gb[pt][r + 1] = dv.y; }
            }
            float Pin = 1.f, Hin = 0.f;
            if (wd == 0) lru_scan<0>(ga, gb, EX, lane, fr, fq, wj, Pin, Hin); else lru_scan<1>(ga, gb, EX, lane, fr, fq, wj, Pin, Hin);
            if (fq == 0) { float* so = SUM + ((size_t)((b * NSEG + seg) * 2 + wd) * DLRU + h * 64 + wj) * 2; so[0] = Pin; so[1] = Hin; }
        }
        __syncthreads();
        if (seg >= 4) { const int pos = tid >> 3, c0 = (tid & 7) * 8; const LAS float* q0 = EX + pos * 64 + c0;
            const f32x4 a0l = *(const LAS f32x4*)(q0), a0h = *(const LAS f32x4*)(q0 + 4), d0l = *(const LAS f32x4*)(q0 + 4096), d0h = *(const LAS f32x4*)(q0 + 4100);
            const f32x4 a1l = *(const LAS f32x4*)(q0 + 8192), a1h = *(const LAS f32x4*)(q0 + 8196), d1l = *(const LAS f32x4*)(q0 + 12288), d1h = *(const LAS f32x4*)(q0 + 12292);
            const f32x4 sl = d0l + d1l, sh = d0h + d1h; const size_t o = (size_t)(b * SEQ + (seg - 4) * 64 + pos) * DLRU + h * 64 + c0;
            *(v4u*)(HS + o) = (v4u){pk2(sl.x, sl.y), pk2(sl.z, sl.w), pk2(sh.x, sh.y), pk2(sh.z, sh.w)};
            *(v4u*)(PF + o) = (v4u){pk2(a0l.x, a0l.y), pk2(a0l.z, a0l.w), pk2(a0h.x, a0h.y), pk2(a0h.z, a0h.w)};
            *(v4u*)(PB + o) = (v4u){pk2(a1l.x, a1l.y), pk2(a1l.z, a1l.w), pk2(a1h.x, a1h.y), pk2(a1h.z, a1h.w)}; }
    }
    __syncthreads();
}

#define LDS_ONLY_SYNC() asm volatile("s_waitcnt lgkmcnt(0)\n\ts_barrier" ::: "memory")
#define SGU_GLD4(r, ptr) asm volatile("global_load_dwordx4 %0, %4, off\n\tglobal_load_dwordx4 %1, %4, off offset:64\n\tglobal_load_dwordx4 %2, %4, off offset:128\n\tglobal_load_dwordx4 %3, %4, off offset:192" \
    : "=&v"(r[0]), "=&v"(r[1]), "=&v"(r[2]), "=&v"(r[3]) : "v"(ptr) : "memory")
__device__ __forceinline__ void phase_sgu_mfma(const P& p, LAS unsigned char* lds, int tid, int lane, int wave, int vcu, int G, int first = 0, int last = 512) {
    LAS unsigned char* vnT = lds;
    LAS unsigned char* ul = lds + 34816;
    const bf16* UV = (const bf16*)(p.ws + WS_UV); const bf16* SWB = (const bf16*)(p.ws + WS_SWB); bf16* A2 = (bf16*)(p.ws + WS_A2);
    const int fr = lane & 15, fq = lane >> 4, q = tid >> 2, part = tid & 3;
    int T = first + vcu; if (T >= last) return;
    v4u vw[4], uw[4];
    auto issue = [&](int TT) { const int b = TT >> 6, n = (TT >> 2) & 15, h = TT & 3; const bf16* row = UV + ((size_t)b * SEQ + n * 128 + q) * DIN + h * 128 + part * 8;
        SGU_GLD4(vw, row + 512); SGU_GLD4(uw, row); };
    issue(T);
    int hcur = -1; f32x4 gs[8]; bf16x8 afr[4]; float bs[4] = {0.f, 0.f, 0.f, 0.f};
    for (; T < last; T += G) {
        const int b = T >> 6, n = (T >> 2) & 15, h = T & 3; const size_t t0 = (size_t)b * SEQ + n * 128;
        if (h != hcur) { hcur = h;
#pragma unroll
            for (int i = 0; i < 4; ++i) { gs[2 * i] = *(const f32x4*)(p.sgu_g + h * 128 + 32 * i + 8 * part); gs[2 * i + 1] = *(const f32x4*)(p.sgu_g + h * 128 + 32 * i + 8 * part + 4); }
#pragma unroll
            for (int ks = 0; ks < 4; ++ks) afr[ks] = *(const bf16x8*)(SWB + (size_t)((h * 128 + 16 * wave + fr) * 128 + 32 * ks + 8 * fq));
#pragma unroll
            for (int r = 0; r < 4; ++r) bs[r] = p.sgu_b[h * 128 + 16 * wave + 4 * fq + r];
#pragma unroll
            for (int i = 0; i < 8; ++i) asm volatile("" : "+v"(gs[i]) :: "memory");
#pragma unroll
            for (int ks = 0; ks < 4; ++ks) asm volatile("" : "+v"(afr[ks]) :: "memory");
            asm volatile("" : "+v"(bs[0]), "+v"(bs[1]), "+v"(bs[2]), "+v"(bs[3]) :: "memory"); }
        asm volatile("s_waitcnt vmcnt(4) ; retires %0 %1 %2 %3 %4 %5 %6 %7" : "+v"(vw[0]), "+v"(vw[1]), "+v"(vw[2]), "+v"(vw[3]), "+v"(uw[0]), "+v"(uw[1]), "+v"(uw[2]), "+v"(uw[3]) :: "memory");
        { float v[32]; float s = 0.f;
#pragma unroll
          for (int i = 0; i < 4; ++i) { const v4u w = vw[i]; v[8 * i] = bflo(w.x); v[8 * i + 1] = bfhi(w.x); v[8 * i + 2] = bflo(w.y); v[8 * i + 3] = bfhi(w.y); v[8 * i + 4] = bflo(w.z); v[8 * i + 5] = bfhi(w.z); v[8 * i + 6] = bflo(w.w); v[8 * i + 7] = bfhi(w.w); }
#pragma unroll
          for (int i = 0; i < 32; ++i) s += v[i] * v[i];
          s += __shfl_xor(s, 1); s += __shfl_xor(s, 2);
          const float rinv = rsqrtf(s * (1.f / 128.f) + EPS);
#pragma unroll
          for (int i = 0; i < 4; ++i)
#pragma unroll
              for (int jx = 0; jx < 8; ++jx) { const int c = 32 * i + 8 * part + jx; *(LAS bf16*)(vnT + c * 272 + q * 2) = (bf16)f2bf(v[8 * i + jx] * rinv * gs[2 * i + (jx >> 2)][jx & 3]); }
#pragma unroll
          for (int i = 0; i < 4; ++i) *(LAS v4u*)(ul + q * 272 + (4 * i + part) * 16) = uw[i]; }
        { const int Tn = (T + G < last) ? T + G : T; issue(Tn); }
        LDS_ONLY_SYNC();
        {
#pragma unroll
          for (int ct = 0; ct < 8; ++ct) { f32x4 acc = (f32x4){0.f, 0.f, 0.f, 0.f};
#pragma unroll
              for (int ks = 0; ks < 4; ++ks) { const bf16x8 bv = *(const LAS bf16x8*)(vnT + (16 * ct + fr) * 272 + 64 * ks + 16 * fq); acc = __builtin_amdgcn_mfma_f32_16x16x32_bf16(afr[ks], bv, acc, 0, 0, 0); }
#pragma unroll
              for (int r = 0; r < 4; ++r) { const int pp = 16 * wave + 4 * fq + r, c = 16 * ct + fr; LAS bf16* e = (LAS bf16*)(ul + pp * 272 + c * 2);
                  *e = (bf16)f2bf(bf2f(*e) * (acc[r] + bs[r])); } } }
        LDS_ONLY_SYNC();
        { bf16* dst = A2 + (t0 + q) * D + h * 128 + part * 8;
#pragma unroll
          for (int i = 0; i < 4; ++i) *(v4u*)(dst + 32 * i) = *(const LAS v4u*)(ul + q * 272 + (4 * i + part) * 16); }
        LDS_ONLY_SYNC();
    }
    asm volatile("s_waitcnt vmcnt(0)" ::: "memory");
}

__device__ __forceinline__ void phase_lru2(const P& p, LAS unsigned char* lds, int tid, int vcu, int G) {
    LAS float* carry = (LAS float*)lds;
    const bf16* UV = (const bf16*)(p.ws + WS_UV); const bf16* HS = (const bf16*)(p.ws + WS_HS); const bf16* PF = (const bf16*)(p.ws + WS_PF); const bf16* PB = (const bf16*)(p.ws + WS_PB);
    const float* SUM = (const float*)(p.ws + WS_SUM); bf16* A2 = (bf16*)(p.ws + WS_A2);
    for (int T = vcu; T < BATCH * 32 * 8; T += G) {
        const int b = T >> 8, gr = (T >> 3) & 31, h = T & 7;
        if (tid < 128) { const int d = tid >> 6, ch = tid & 63; float hc = 0.f;
            const float* S = SUM + ((size_t)b * NSEG * 2 * DLRU + (size_t)d * DLRU + h * 64 + ch) * 2;
            if (d == 0) { for (int s = 0; s < 4 + gr; ++s) { const float A = S[(size_t)s * 2048], B = S[(size_t)s * 2048 + 1]; hc = A * hc + B; } }
            else { for (int s = 3; s >= 0; --s) { const float A = S[(size_t)s * 2048], B = S[(size_t)s * 2048 + 1]; hc = A * hc + B; }
                   for (int s = NSEG - 1; s > 4 + gr; --s) { const float A = S[(size_t)s * 2048], B = S[(size_t)s * 2048 + 1]; hc = A * hc + B; } }
            carry[tid] = hc; }
        __syncthreads();
        for (int i = tid; i < 4096; i += NTHREADS) { const int r = i >> 6, ch = i & 63; const size_t row = (size_t)b * SEQ + gr * 64 + r, o = row * DLRU + h * 64 + ch;
            const float val = bf2f(HS[o]) + bf2f(PF[o]) * carry[ch] + bf2f(PB[o]) * carry[64 + ch];
            A2[row * D + 512 + h * 64 + ch] = (bf16)f2bf(bf2f(UV[row * DIN + 1536 + h * 64 + ch]) * val); }
        __syncthreads();
    }
}


__device__ __forceinline__ void phase_lru2_fast(const P& p, LAS unsigned char* lds, int tid, int vcu0, int G, int first = 0, int last = 64 * LRU2_PARTS) {
    LAS float* carry = (LAS float*)lds;
    constexpr int NQ = LRU2_PARTS, GR = 32 / NQ, GSH = (NQ == 8) ? 2 : 3, CBUF = GR * 2 * 64;
    const bf16* UV = (const bf16*)(p.ws + WS_UV); const bf16* HS = (const bf16*)(p.ws + WS_HS); const bf16* PF = (const bf16*)(p.ws + WS_PF); const bf16* PB = (const bf16*)(p.ws + WS_PB);
    const float* SUM = (const float*)(p.ws + WS_SUM); bf16* A2 = (bf16*)(p.ws + WS_A2);
    typedef float f32x2 __attribute__((ext_vector_type(2)));
    const int NT = last, vcu = first + vcu0;
    if (vcu >= NT) return;
    const int Tlast = vcu + ((NT - 1 - vcu) / G) * G;
    v4u nhs[GR], npf[GR], npb[GR], ngg[GR]; f32x2 ab[NSEG];
    auto load_rows = [&](int T) { const int b = T / (8 * NQ), h = (T / NQ) & 7, qt = T % NQ;
#pragma unroll
        for (int it = 0; it < GR; ++it) { const int v = it * NTHREADS + tid, pos = v >> 3, c0 = (v & 7) * 8; const size_t row = (size_t)b * SEQ + qt * (64 * GR) + pos, o = row * DLRU + h * 64 + c0;
            nhs[it] = *(const v4u*)(HS + o); npf[it] = *(const v4u*)(PF + o); npb[it] = *(const v4u*)(PB + o); ngg[it] = *(const v4u*)(UV + row * DIN + 1536 + h * 64 + c0); } };
    auto load_sum = [&](int T) { const int b = T / (8 * NQ), h = (T / NQ) & 7; const int d = (tid >> 6) & 1, ch = tid & 63;
        const f32x2* S = (const f32x2*)SUM + ((size_t)b * NSEG * 2 + d) * DLRU + h * 64 + ch;
#pragma unroll
        for (int s2 = 0; s2 < NSEG; ++s2) ab[s2] = S[(size_t)s2 * 2 * DLRU]; };
    auto fold = [&](int T, LAS float* cbuf) { const int qt = T % NQ; const int d = tid >> 6, ch = tid & 63; float hc = 0.f;
        if (d == 0) {
#pragma unroll
            for (int s2 = 0; s2 < NSEG; ++s2) { if (s2 >= 4 && ((s2 - 4) >> GSH) == qt) cbuf[(((s2 - 4) & (GR - 1)) * 2 + 0) * 64 + ch] = hc; hc = ab[s2].x * hc + ab[s2].y; }
        } else {
#pragma unroll
            for (int s2 = 3; s2 >= 0; --s2) hc = ab[s2].x * hc + ab[s2].y;
#pragma unroll
            for (int s2 = NSEG - 1; s2 >= 4; --s2) { if (((s2 - 4) >> GSH) == qt) cbuf[(((s2 - 4) & (GR - 1)) * 2 + 1) * 64 + ch] = hc; hc = ab[s2].x * hc + ab[s2].y; }
        } };
    if (tid < 128) load_sum(vcu);
    load_rows(vcu);
    if (tid < 128) fold(vcu, carry);
    LDS_ONLY_SYNC();
    int cb = 0;
    for (int T = vcu; T < NT; T += G) {
        const int b = T / (8 * NQ), h = (T / NQ) & 7, qt = T % NQ, Tn = min(T + G, Tlast);
        v4u hsv[GR], pfv[GR], pbv[GR], ggv[GR];
#pragma unroll
        for (int it = 0; it < GR; ++it) { hsv[it] = nhs[it]; pfv[it] = npf[it]; pbv[it] = npb[it]; ggv[it] = ngg[it]; }
#pragma unroll
        for (int it = 0; it < GR; ++it) asm volatile("" : "+v"(hsv[it]), "+v"(pfv[it]), "+v"(pbv[it]), "+v"(ggv[it]) :: "memory");
        if (tid < 128) load_sum(Tn);
        load_rows(Tn);
        const LAS float* cr = carry + cb * CBUF;
#pragma unroll
        for (int it = 0; it < GR; ++it) { const int v = it * NTHREADS + tid, pos = v >> 3, c0 = (v & 7) * 8, grl = pos >> 6;
            const size_t row = (size_t)b * SEQ + qt * (64 * GR) + pos;
            const v4u hs = hsv[it], pf = pfv[it], pb = pbv[it], gg = ggv[it];
            const f32x4 cf0 = *(const LAS f32x4*)(cr + (grl * 2) * 64 + c0), cf1 = *(const LAS f32x4*)(cr + (grl * 2) * 64 + c0 + 4);
            const f32x4 cb0 = *(const LAS f32x4*)(cr + (grl * 2 + 1) * 64 + c0), cb1 = *(const LAS f32x4*)(cr + (grl * 2 + 1) * 64 + c0 + 4);
            v4u out;
            out.x = pk2(bflo(gg.x) * (bflo(hs.x) + bflo(pf.x) * cf0.x + bflo(pb.x) * cb0.x), bfhi(gg.x) * (bfhi(hs.x) + bfhi(pf.x) * cf0.y + bfhi(pb.x) * cb0.y));
            out.y = pk2(bflo(gg.y) * (bflo(hs.y) + bflo(pf.y) * cf0.z + bflo(pb.y) * cb0.z), bfhi(gg.y) * (bfhi(hs.y) + bfhi(pf.y) * cf0.w + bfhi(pb.y) * cb0.w));
            out.z = pk2(bflo(gg.z) * (bflo(hs.z) + bflo(pf.z) * cf1.x + bflo(pb.z) * cb1.x), bfhi(gg.z) * (bfhi(hs.z) + bfhi(pf.z) * cf1.y + bfhi(pb.z) * cb1.y));
            out.w = pk2(bflo(gg.w) * (bflo(hs.w) + bflo(pf.w) * cf1.z + bflo(pb.w) * cb1.z), bfhi(gg.w) * (bfhi(hs.w) + bfhi(pf.w) * cf1.w + bfhi(pb.w) * cb1.w));
            *(v4u*)(A2 + row * D + 512 + h * 64 + c0) = out; }
        cb ^= 1;
        if (tid < 128) fold(Tn, carry + cb * CBUF);
        LDS_ONLY_SYNC();
    }
}

__device__ __forceinline__ void phase_p5(const P& p, LAS unsigned char* lds, int tid, int lane, int wave, int vcu, int G) {
    LAS float* wrT = (LAS float*)lds;
    const float* MOD = (const float*)(p.ws + WS_MOD); const float* X1 = (const float*)(p.ws + WS_X1); bf16* HX2 = (bf16*)(p.ws + WS_HX2); float* AFF = (float*)(p.ws + WS_AFF);
    for (int i = tid; i < D * NE; i += NTHREADS) wrT[(i & 15) * D + (i >> 4)] = p.w_router[i];
    __syncthreads();
    const int gw = vcu * NWAVES + wave, NGW = G * NWAVES;
    f32x4 nx[4];
    if (gw < M) { const f32x4* xr = (const f32x4*)(X1 + (size_t)gw * D) + lane;
#pragma unroll
        for (int jj = 0; jj < 4; ++jj) nx[jj] = xr[64 * jj]; }
    for (int m = gw; m < M; m += NGW) {
        const int b = m >> 11, t = m & 2047;
        f32x4 v[4]; float s = 0.f;
#pragma unroll
        for (int jj = 0; jj < 4; ++jj) { v[jj] = nx[jj]; s += (v[jj].x * v[jj].x + v[jj].y * v[jj].y) + (v[jj].z * v[jj].z + v[jj].w * v[jj].w); }
        if (m + NGW < M) { const f32x4* xr = (const f32x4*)(X1 + (size_t)(m + NGW) * D) + lane;
#pragma unroll
            for (int jj = 0; jj < 4; ++jj) nx[jj] = xr[64 * jj]; }
        const float rinv = rsqrtf(wave_sum(s) * (1.f / D) + EPS);
        v2u* o = (v2u*)(HX2 + (size_t)m * D) + lane;
#pragma unroll
        for (int jj = 0; jj < 4; ++jj) { const int k = 4 * (lane + 64 * jj);
            const f32x4 g = *(const f32x4*)(p.norm2_g + k), sh = *(const f32x4*)(MOD + b * NMOD + 3 * D + k), sc = *(const f32x4*)(MOD + b * NMOD + 4 * D + k);
            v[jj] = v[jj] * rinv * g * (sc + 1.f) + sh;
#if MOE_FP8
            ((unsigned*)(p.ws + WS_HX2) + (size_t)m * (D / 4))[lane + 64 * jj] = pk4_fp8(v[jj].x, v[jj].y, v[jj].z, v[jj].w); }
#else
            v2u w; w.x = pk2(v[jj].x, v[jj].y); w.y = pk2(v[jj].z, v[jj].w); o[64 * jj] = w; }
#endif
        float pa[16];
#pragma unroll
        for (int e = 0; e < 16; ++e) { float a = 0.f;
#pragma unroll
            for (int jj = 0; jj < 4; ++jj) { const f32x4 w = *(const LAS f32x4*)(wrT + e * D + 4 * (lane + 64 * jj)); a += (v[jj].x * w.x + v[jj].y * w.y) + (v[jj].z * w.z + v[jj].w * w.w); }
            pa[e] = a; if (e & 1) asm volatile("" ::: "memory"); }
        { const bool h5 = (lane & 32) != 0; float q8[8];
#pragma unroll
          for (int i = 0; i < 8; ++i) { const float keep = h5 ? pa[8 + i] : pa[i], give = h5 ? pa[i] : pa[8 + i]; q8[i] = keep + __shfl_xor(give, 32); }
          const bool h4 = (lane & 16) != 0; float q4[4];
#pragma unroll
          for (int i = 0; i < 4; ++i) { const float keep = h4 ? q8[4 + i] : q8[i], give = h4 ? q8[i] : q8[4 + i]; q4[i] = keep + __shfl_xor(give, 16); }
          const bool h3 = (lane & 8) != 0; float q2[2];
#pragma unroll
          for (int i = 0; i < 2; ++i) { const float keep = h3 ? q4[2 + i] : q4[i], give = h3 ? q4[i] : q4[2 + i]; q2[i] = keep + __shfl_xor(give, 8); }
          const bool h2 = (lane & 4) != 0;
          float lgt = (h2 ? q2[1] : q2[0]) + __shfl_xor(h2 ? q2[0] : q2[1], 4);
          lgt += __shfl_xor(lgt, 2); lgt += __shfl_xor(lgt, 1);
          float mx = lgt;
#pragma unroll
          for (int o2 = 4; o2 < 64; o2 <<= 1) mx = fmaxf(mx, __shfl_xor(mx, o2));
          const float ex = expf(lgt - mx); float den = ex;
#pragma unroll
          for (int o2 = 4; o2 < 64; o2 <<= 1) den += __shfl_xor(den, o2);
          if ((lane & 3) == 0) AFF[(size_t)(b * NE + (lane >> 2)) * SEQ + t] = ex / den; }
    }
    __syncthreads();
}

__device__ __forceinline__ void phase_p6(const P& p, LAS unsigned char* lds, int tid, int lane, int wave, int vcu, int G) {
    LAS float* a = (LAS float*)lds; LAS int* tok = (LAS int*)(lds + 8192);
    const float* AFF = (const float*)(p.ws + WS_AFF); int* SLOT = (int*)(p.ws + WS_SLOT); float* GATE = (float*)(p.ws + WS_GATE);
    const bf16* HX2 = (const bf16*)(p.ws + WS_HX2); bf16* XE = (bf16*)(p.ws + WS_XE);
    for (int T = vcu; T < BATCH * NE; T += G) {
        const int b = T >> 4, e = T & 15;
        for (int i = tid; i < SEQ; i += NTHREADS) a[i] = AFF[(size_t)(b * NE + e) * SEQ + i];
        __syncthreads();
        float at[4]; int rk[4];
#pragma unroll
        for (int i = 0; i < 4; ++i) { at[i] = a[tid + 512 * i]; rk[i] = 0; }
        for (int t2 = 0; t2 < SEQ; ++t2) { const float av = a[t2];
#pragma unroll
            for (int i = 0; i < 4; ++i) rk[i] += (av > at[i] || (av == at[i] && t2 < tid + 512 * i)) ? 1 : 0; }
#pragma unroll
        for (int i = 0; i < 4; ++i) { const int t = tid + 512 * i; SLOT[(size_t)(b * NE + e) * SEQ + t] = rk[i] < CAP ? rk[i] : -1;
            if (rk[i] < CAP) { tok[rk[i]] = t; GATE[e * 2048 + b * CAP + rk[i]] = at[i]; } }
        __syncthreads();
        for (int r = wave; r < CAP; r += NWAVES) { const v4u* src = (const v4u*)(HX2 + (size_t)(b * SEQ + tok[r]) * D); v4u* dst = (v4u*)(XE + (size_t)(e * 2048 + b * CAP + r) * D);
            dst[lane] = src[lane]; dst[lane + 64] = src[lane + 64]; }
        __syncthreads();
    }
}


__device__ __forceinline__ unsigned block_sum_u(unsigned v, LAS unsigned* red, int lane, int wave) {
    v = (unsigned)wave_sum((float)v);
    if (lane == 0) red[wave] = v;
    __syncthreads();
    unsigned s = 0;
#pragma unroll
    for (int w = 0; w < 8; ++w) s += red[w];
    return s;
}
__device__ __forceinline__ unsigned block_excl_scan(unsigned c, unsigned& total, LAS unsigned* red, int lane, int wave) {
    unsigned inc = c;
#pragma unroll
    for (int o = 1; o < 64; o <<= 1) { const unsigned t = __shfl_up(inc, o); if (lane >= o) inc += t; }
    if (lane == 63) red[wave] = inc;
    __syncthreads();
    unsigned off = 0, tot = 0;
#pragma unroll
    for (int w = 0; w < 8; ++w) { const unsigned x = red[w]; off += (w < wave) ? x : 0u; tot += x; }
    total = tot; return off + inc - c;
}
__device__ __forceinline__ void phase_p6_fast(const P& p, LAS unsigned char* lds, int tid, int lane, int wave, int vcu, int G) {
    LAS unsigned* red = (LAS unsigned*)lds;
    LAS int* tok = (LAS int*)(lds + 2048);
    const float* AFF = (const float*)(p.ws + WS_AFF); int* SLOT = (int*)(p.ws + WS_SLOT); float* GATE = (float*)(p.ws + WS_GATE);
    const bf16* HX2 = (const bf16*)(p.ws + WS_HX2); bf16* XE = (bf16*)(p.ws + WS_XE);
    for (int T = vcu; T < BATCH * NE * 2; T += G) {
        const int half = T & 1, e = (T >> 1) & 15, b = T >> 5;
        const f32x4 av = *(const f32x4*)(AFF + (size_t)(b * NE + e) * SEQ + 4 * tid);
        unsigned bits[4] = {__float_as_uint(av.x), __float_as_uint(av.y), __float_as_uint(av.z), __float_as_uint(av.w)};
        unsigned lo = 0u, hi = 0x3f800000u; int rb = 0;
        while (lo < hi) {
            const unsigned span = hi - lo, q = (span + 3u) >> 2, t1 = lo + q, t2 = min(lo + 2u * q, hi), t3 = min(lo + 3u * q, hi);
            unsigned w = 0;
#pragma unroll
            for (int i = 0; i < 4; ++i) w += (unsigned)__builtin_popcountll(__builtin_amdgcn_ballot_w64(bits[i] >= t1)) + ((unsigned)__builtin_popcountll(__builtin_amdgcn_ballot_w64(bits[i] >= t2)) << 10)
                                           + ((unsigned)__builtin_popcountll(__builtin_amdgcn_ballot_w64(bits[i] >= t3)) << 20);
            LAS unsigned* rd = red + 8 * rb; rb = (rb + 1) % 36;
            if (lane == 0) rd[wave] = w;
            __syncthreads();
            unsigned c1 = 0, c2 = 0, c3 = 0;
#pragma unroll
            for (int ww = 0; ww < 8; ++ww) { const unsigned x = rd[ww]; c1 += x & 1023u; c2 += (x >> 10) & 1023u; c3 += x >> 20; }
            if (c3 >= (unsigned)CAP) lo = t3; else if (c2 >= (unsigned)CAP) { lo = t2; hi = t3 - 1u; } else if (c1 >= (unsigned)CAP) { lo = t1; hi = t2 - 1u; } else hi = t1 - 1u;
        }
        const unsigned Tb = lo;
        auto lowcnt = [&](unsigned long long m) -> unsigned { return __builtin_amdgcn_mbcnt_hi((unsigned)(m >> 32), __builtin_amdgcn_mbcnt_lo((unsigned)m, 0u)); };
        auto block_tot_pre = [&](unsigned wtot, unsigned wpre, unsigned& total, LAS unsigned* rd) -> unsigned {
            if (lane == 0) rd[wave] = wtot;
            __syncthreads();
            unsigned off = 0, tot = 0;
#pragma unroll
            for (int w2 = 0; w2 < 8; ++w2) { const unsigned x = rd[w2]; off += (w2 < wave) ? x : 0u; tot += x; }
            total = tot; return off + wpre; };
        unsigned wg = 0, wt = 0, pt = 0;
#pragma unroll
        for (int i = 0; i < 4; ++i) { const unsigned long long mg = __builtin_amdgcn_ballot_w64(bits[i] > Tb), mt = __builtin_amdgcn_ballot_w64(bits[i] == Tb);
            wg += (unsigned)__builtin_popcountll(mg); wt += (unsigned)__builtin_popcountll(mt); pt += lowcnt(mt); }
        unsigned ngt; (void)block_tot_pre(wg, 0u, ngt, red + 8 * 36); const unsigned need = (unsigned)CAP - ngt;
        unsigned ttot; unsigned tpre = block_tot_pre(wt, pt, ttot, red + 8 * 37);
        unsigned sel[4], ws2 = 0, ps = 0;
#pragma unroll
        for (int i = 0; i < 4; ++i) { const bool tie = bits[i] == Tb; sel[i] = (bits[i] > Tb || (tie && tpre < need)) ? 1u : 0u; tpre += tie ? 1u : 0u; }
#pragma unroll
        for (int i = 0; i < 4; ++i) { const unsigned long long ms = __builtin_amdgcn_ballot_w64(sel[i] != 0u); ws2 += (unsigned)__builtin_popcountll(ms); ps += lowcnt(ms); }
        unsigned stot; unsigned spre = block_tot_pre(ws2, ps, stot, red + 8 * 38);
        int slo[4];
#pragma unroll
        for (int i = 0; i < 4; ++i) { const int t = 4 * tid + i;
            slo[i] = sel[i] ? (int)spre : -1;
            if (sel[i]) { tok[spre] = t; if ((int)(spre >> 7) == half) GATE[e * 2048 + b * CAP + spre] = __uint_as_float(bits[i]); spre += 1u; } }
        if ((tid >> 8) == half) *(v4u*)(SLOT + (size_t)(b * NE + e) * SEQ + 4 * tid) = (v4u){(unsigned)slo[0], (unsigned)slo[1], (unsigned)slo[2], (unsigned)slo[3]};
        __syncthreads();
#if MOE_FP8
        if (tid < 128) ((int*)(p.ws + WS_TOK))[e * 2048 + b * CAP + half * 128 + tid] = b * SEQ + tok[half * 128 + tid];
#else
        for (int r = half * 128 + wave; r < half * 128 + 128; r += NWAVES) { const v4u* src = (const v4u*)(HX2 + (size_t)(b * SEQ + tok[r]) * D); v4u* dst = (v4u*)(XE + (size_t)(e * 2048 + b * CAP + r) * D);
            dst[lane] = src[lane]; dst[lane + 64] = src[lane + 64]; }
#endif
        __syncthreads();
    }
}

template <bool X1B>
__device__ __forceinline__ void phase_p9(const P& p, int lane, int wave, int vcu, int G) {
    const float* MOD = (const float*)(p.ws + WS_MOD); const float* X1 = (const float*)(p.ws + WS_X1); const int* SLOT = (const int*)(p.ws + WS_SLOT); const bf16* YE = (const bf16*)(p.ws + WS_YE);
    const int gw = vcu * NWAVES + wave, NGW = G * NWAVES;
    f32x4 nx[4]; int nslot = -1;
    auto ldrow = [&](int mm) {
        if constexpr (X1B) { const v2u* xr = (const v2u*)((const bf16*)X1 + (size_t)mm * D) + lane;
#pragma unroll
            for (int jj = 0; jj < 4; ++jj) { const v2u w = xr[64 * jj]; nx[jj] = (f32x4){bflo(w.x), bfhi(w.x), bflo(w.y), bfhi(w.y)}; } }
        else { const f32x4* xr = (const f32x4*)(X1 + (size_t)mm * D) + lane;
#pragma unroll
            for (int jj = 0; jj < 4; ++jj) nx[jj] = xr[64 * jj]; } };
    if (gw < M) { ldrow(gw);
        nslot = SLOT[(size_t)((gw >> 11) * NE + (lane & 15)) * SEQ + (gw & 2047)]; }
    for (int m = gw; m < M; m += NGW) {
        const int b = m >> 11;
        f32x4 v[4], acc[4]; const int myslot = nslot;
#pragma unroll
        for (int jj = 0; jj < 4; ++jj) { v[jj] = nx[jj]; acc[jj] = (f32x4){0.f, 0.f, 0.f, 0.f}; }
        if (m + NGW < M) { ldrow(m + NGW);
            nslot = SLOT[(size_t)(((m + NGW) >> 11) * NE + (lane & 15)) * SEQ + ((m + NGW) & 2047)]; }
#pragma unroll
        for (int e = 0; e < NE; ++e) { const int sl = __builtin_amdgcn_readlane(myslot, e);
#if MOE_FP8
            if (sl >= 0) { const unsigned* y = (const unsigned*)((const unsigned char*)YE + (size_t)(e * 2048 + b * CAP + sl) * D) + lane;
#pragma unroll
                for (int jj = 0; jj < 4; ++jj) { const unsigned w = y[64 * jj]; const auto lo = __builtin_amdgcn_cvt_pk_f32_fp8((int)w, false), hi = __builtin_amdgcn_cvt_pk_f32_fp8((int)w, true);
                    acc[jj] += (f32x4){lo[0], lo[1], hi[0], hi[1]}; } } }
#else
            if (sl >= 0) { const v2u* y = (const v2u*)(YE + (size_t)(e * 2048 + b * CAP + sl) * D) + lane;
#pragma unroll
                for (int jj = 0; jj < 4; ++jj) { const v2u w = y[64 * jj]; acc[jj] += (f32x4){bflo(w.x), bfhi(w.x), bflo(w.y), bfhi(w.y)}; } } }
#endif
        float s = 0.f;
#pragma unroll
        for (int jj = 0; jj < 4; ++jj) { const int k = 4 * (lane + 64 * jj); const f32x4 g2 = *(const f32x4*)(MOD + b * NMOD + 5 * D + k); v[jj] += g2 * acc[jj] * (MOE_FP8 ? WSCALE_INV : 1.f);
            s += (v[jj].x * v[jj].x + v[jj].y * v[jj].y) + (v[jj].z * v[jj].z + v[jj].w * v[jj].w); }
        const float rinv = rsqrtf(wave_sum(s) * (1.f / D) + EPS);
        f32x4* o = (f32x4*)(p.out + (size_t)m * D) + lane;
#pragma unroll
        for (int jj = 0; jj < 4; ++jj) { const int k = 4 * (lane + 64 * jj); o[64 * jj] = v[jj] * rinv * *(const f32x4*)(p.final_g + k); }
    }
}

__device__ __forceinline__ void p9_finish(const P& p, LAS unsigned char* strip, int lane, int m, const v4u xa, const v4u xb, const f32x2p (&acc)[8], const f32x4 (&g2c)[4], const f32x4 (&fg)[4]) {
    f32x4 v[4];
    v[0] = (f32x4){bflo(xa.x), bfhi(xa.x), bflo(xa.y), bfhi(xa.y)}; v[1] = (f32x4){bflo(xa.z), bfhi(xa.z), bflo(xa.w), bfhi(xa.w)};
    v[2] = (f32x4){bflo(xb.x), bfhi(xb.x), bflo(xb.y), bfhi(xb.y)}; v[3] = (f32x4){bflo(xb.z), bfhi(xb.z), bflo(xb.w), bfhi(xb.w)};
    float s = 0.f;
#pragma unroll
    for (int i = 0; i < 4; ++i) { v[i] += g2c[i] * (f32x4){acc[2 * i].x, acc[2 * i].y, acc[2 * i + 1].x, acc[2 * i + 1].y}; s += (v[i].x * v[i].x + v[i].y * v[i].y) + (v[i].z * v[i].z + v[i].w * v[i].w); }
    const float rinv = rsqrtf(wave_sum(s) * (1.f / D) + EPS);
#pragma unroll
    for (int i = 0; i < 4; ++i) *(LAS f32x4*)(strip + lane * 80 + 16 * i) = v[i] * rinv * fg[i];
    __builtin_amdgcn_fence(__ATOMIC_RELEASE, "wavefront"); __builtin_amdgcn_wave_barrier(); __builtin_amdgcn_fence(__ATOMIC_ACQUIRE, "wavefront");
    f32x4* o = (f32x4*)(p.out + (size_t)m * D) + lane;
#pragma unroll
    for (int jj = 0; jj < 4; ++jj) o[64 * jj] = *(const LAS f32x4*)(strip + ((lane >> 2) + 16 * jj) * 80 + (lane & 3) * 16);
    __builtin_amdgcn_wave_barrier();
}
#define P9_GLD(dst, voff, sbase, OFFS) asm volatile("global_load_dwordx4 %0, %1, %2" OFFS : "=&v"(dst) : "v"(voff), "s"(sbase) : "memory")
__device__ __forceinline__ const unsigned char* uptr(const unsigned char* q) { const unsigned long long v = (unsigned long long)q;
    return (const unsigned char*)(((unsigned long long)(unsigned)__builtin_amdgcn_readfirstlane((int)(v >> 32)) << 32) | (unsigned)__builtin_amdgcn_readfirstlane((int)v)); }
__device__ __forceinline__ void p9_acc(f32x2p (&acc)[8], const v4u w, float sc) {
    const unsigned ww[4] = {w.x, w.y, w.z, w.w};
#pragma unroll
    for (int c = 0; c < 4; ++c) { const f32x2p lo = __builtin_amdgcn_cvt_pk_f32_fp8((int)ww[c], false), hi = __builtin_amdgcn_cvt_pk_f32_fp8((int)ww[c], true); acc[2 * c] += lo * sc; acc[2 * c + 1] += hi * sc; }
}
template <class Gate>
__device__ __forceinline__ void phase_p9_v2(const P& p, LAS unsigned char* lds, int lane, int wave, int vcu, int G, const Gate& gate) {
    const float* MOD = (const float*)(p.ws + WS_MOD); const unsigned char* X1b = p.ws + WS_X1; const int* SLOT = (const int*)(p.ws + WS_SLOT); const unsigned char* YE = p.ws + WS_YE;
    const int gw = vcu * NWAVES + wave, m0 = gw * 8, b = m0 >> 11;
    LAS unsigned char* strip = lds + wave * 5120;
    const int* slp = SLOT + (size_t)(b * NE + 2 * (lane & 7)) * SEQ + (m0 & 2047) + (lane >> 3);
    const int sx = slp[0], sy = slp[SEQ];
    f32x4 g2c[4], fg[4];
#pragma unroll
    for (int i = 0; i < 4; ++i) { g2c[i] = *(const f32x4*)(MOD + b * NMOD + 5 * D + 16 * lane + 4 * i); fg[i] = *(const f32x4*)(p.final_g + 16 * lane + 4 * i); }
    gate();
#pragma unroll
    for (int i = 0; i < 4; ++i) g2c[i] = g2c[i] * WSCALE_INV;
    const unsigned long long mk0 = __builtin_amdgcn_ballot_w64(sx >= 0), mk1 = __builtin_amdgcn_ballot_w64(sy >= 0);
#pragma unroll
    for (int i = 0; i < 4; ++i) asm volatile("" : "+v"(g2c[i]), "+v"(fg[i]) :: "memory");
    const int xoff = 32 * lane, yoff = 16 * lane;
    auto entries = [&](int r, int (&yr)[4], float (&sc)[4], unsigned& rest) { unsigned em = ((unsigned)(mk0 >> (8 * r)) & 0xffu) | (((unsigned)(mk1 >> (8 * r)) & 0xffu) << 8);
#pragma unroll
        for (int i = 0; i < 4; ++i) { yr[i] = 0; sc[i] = 0.f;
            if (em) { const int pos = __builtin_ctz(em); em &= em - 1u; const int j = pos & 7, c = pos >> 3; const int sa = __builtin_amdgcn_readlane(sx, 8 * r + j), sb = __builtin_amdgcn_readlane(sy, 8 * r + j);
                yr[i] = (2 * j + c) * 2048 + b * CAP + (c ? sb : sa); sc[i] = 1.f; } }
        rest = em; };
#define P9_ISSUE(S, rr) do { const int r_ = min((rr), 7); int yr_[4]; float sc_[4]; unsigned rest_; entries(r_, yr_, sc_, rest_); \
        const unsigned char* xb_ = uptr(X1b + (size_t)(m0 + r_) * (D * 2)); \
        P9_GLD(X##S##0, xoff, xb_, ""); P9_GLD(X##S##1, xoff, xb_, " offset:16"); \
        P9_GLD(Y##S##0, yoff, uptr(YE + (size_t)yr_[0] * D), ""); P9_GLD(Y##S##1, yoff, uptr(YE + (size_t)yr_[1] * D), ""); \
        P9_GLD(Y##S##2, yoff, uptr(YE + (size_t)yr_[2] * D), ""); P9_GLD(Y##S##3, yoff, uptr(YE + (size_t)yr_[3] * D), ""); } while (0)
#define P9_WAIT(S, n) asm volatile("s_waitcnt vmcnt(%6) ; retires %0 %1 %2 %3 %4 %5" : "+v"(X##S##0), "+v"(X##S##1), "+v"(Y##S##0), "+v"(Y##S##1), "+v"(Y##S##2), "+v"(Y##S##3) : "n"(n) : "memory")
#define P9_PROC(S, rr) do { const int r_ = (rr); int yr_[4]; float sc_[4]; unsigned rest_; entries(r_, yr_, sc_, rest_); \
        f32x2p acc_[8]; _Pragma("unroll") for (int i = 0; i < 8; ++i) acc_[i] = (f32x2p){0.f, 0.f}; \
        p9_acc(acc_, Y##S##0, sc_[0]); p9_acc(acc_, Y##S##1, sc_[1]); p9_acc(acc_, Y##S##2, sc_[2]); p9_acc(acc_, Y##S##3, sc_[3]); \
        while (rest_) { const int pos = __builtin_ctz(rest_); rest_ &= rest_ - 1u; const int j = pos & 7, c = pos >> 3; const int sa = __builtin_amdgcn_readlane(sx, 8 * r_ + j), sb = __builtin_amdgcn_readlane(sy, 8 * r_ + j); \
            const v4u w_ = *(const v4u*)(YE + (size_t)((2 * j + c) * 2048 + b * CAP + (c ? sb : sa)) * D + yoff); p9_acc(acc_, w_, 1.f); } \
        p9_finish(p, strip, lane, m0 + r_, X##S##0, X##S##1, acc_, g2c, fg); } while (0)
    v4u XA0, XA1, YA0, YA1, YA2, YA3, XB0, XB1, YB0, YB1, YB2, YB3, XC0, XC1, YC0, YC1, YC2, YC3;
    P9_ISSUE(A, 0); P9_ISSUE(B, 1);
    for (int it = 0; it < 3; ++it) { const int r = 3 * it;
        P9_ISSUE(C, r + 2); if (it == 0) asm volatile("s_waitcnt vmcnt(12)" ::: "memory"); P9_WAIT(A, 20); P9_PROC(A, r);
        P9_ISSUE(A, r + 3); if (it == 0) asm volatile("s_waitcnt vmcnt(16)" ::: "memory"); P9_WAIT(B, 20); P9_PROC(B, r + 1);
        P9_ISSUE(B, r + 4); P9_WAIT(C, 20); if (r + 2 < 8) P9_PROC(C, r + 2);
    }
    asm volatile("s_waitcnt vmcnt(0)" ::: "memory");
}

#if CONV_CUS && MOE_FP8 && XCD_BAR && LRU1_MFMA && SGU_MFMA && LRU2_FAST && P6_FAST && USE_PG8 && (MK_N_LAUNCHES == 1)
__global__ void __launch_bounds__(NTHREADS, 2) fwd_megakernel(P p) {
    extern __shared__ __attribute__((aligned(16))) unsigned char lds_raw[];
    LAS unsigned char* lds = (LAS unsigned char*)lds_raw;
    const int tid = threadIdx.x, lane = tid & 63, wave = __builtin_amdgcn_readfirstlane(tid >> 6);
    const int G = gridDim.x, bx = blockIdx.x, xg = bx & 7, xl = bx >> 3;
    const int vcu = (G % 8 == 0) ? xg * (G / 8) + xl : bx;
    constexpr int CSH = (NCONV == 64) ? 2 : 3, CPG = 32 >> CSH, WPG = 32 - CPG;
    const bool split = (G == 256), is_conv = split && ((xl & ((1 << CSH) - 1)) == (1 << CSH) - 1);
    const int GW = split ? 8 * WPG : G, wvcu = split ? xg * WPG + (xl - (xl >> CSH)) : vcu, cvcu = xg * CPG + (xl >> CSH);
    volatile LAS unsigned* bst = (volatile LAS unsigned*)(lds + LDS_BYTES - 16);
    volatile LAS unsigned* bstg = (volatile LAS unsigned*)(lds + LDS_BYTES - 32);
    volatile LAS unsigned* bstgw = (volatile LAS unsigned*)(lds + LDS_BYTES - 48);
    if (tid < 12) bstgw[tid] = 0u;
    __syncthreads();
    unsigned* ctl = (unsigned*)(p.ws + WS_CTL);
    const XcdBarrier barA = xcd_barrier_post(ctl + 4096, bst, (unsigned)G);
    XcdBarrier barW = barA;
    if (split && !is_conv) barW = xcd_barrier_post(ctl + 4096 + XCD_BAR_WORDS, bst + 2, (unsigned)GW);
    XcdBarrier barG = barA;
    if (split) barG = xcd_barrier_post(ctl + 16384 + xg * XCD_BAR_WORDS, bstg, 32u);
    XcdBarrier barGW = barW;
    if (split && !is_conv) barGW = xcd_barrier_post(ctl + 16384 + (8 + xg) * XCD_BAR_WORDS, bstgw, (unsigned)WPG);
    unsigned* sgw = ctl + 16384 + 16 * XCD_BAR_WORDS + xg * 3 * XS_WORDS;

    if (is_conv) {
        convert_pipelined(p, lds, lane, wave, conv_map(0), conv_map(0) + CONV_NV, cvcu * NWAVES + wave, 8 * CPG * NWAVES);
        if (tid == 0) { asm volatile("s_waitcnt vmcnt(0)\n\tbuffer_inv sc1" ::: "memory"); XB_SPIN(xb_ld(ctl + 64 + 16 * xg) == 0u, ctl + 4096); asm volatile("s_waitcnt vmcnt(0)" ::: "memory"); }
        __syncthreads();
        phase_sgu_mfma(p, lds, tid, lane, wave, cvcu % CPG, CPG, (cvcu / CPG) * 64, (cvcu / CPG) * 64 + SGU_CONV_TASKS / 8);
    } else {
        if (split) {
            unsigned* sb = ctl + SB_BASE;
            phase_p0(p, lds, tid, lane, wave, wvcu, GW, 0, false);
            split_arrive(sb + 2 * XS_WORDS, barW);
            convert_small<0>(p, lds, lane, wave, wvcu * NWAVES + wave, GW * NWAVES);
            convert_small<1>(p, lds, lane, wave, wvcu * NWAVES + wave, GW * NWAVES);
            p0_small_copies(p, tid, wvcu, GW);
            split_wait(sb + 2 * XS_WORDS, ctl + 4096);
            phase_p1(p, lane, wave, wvcu % WPG, WPG, wvcu / WPG);
            split_arrive(sb, barW);
            convert_one(p, CONV_HEAD + 1536 + wvcu * NWAVES + wave, lane);
            split_wait(sb, ctl + 4096);
        } else {
            phase_p0(p, lds, tid, lane, wave, wvcu, GW, CONV_ITEMS, true);
            xcd_barrier(barW);
            phase_p1(p, lane, wave, wvcu, GW);
            xcd_barrier(barW);
        }
        { pg8::Gemm g{(const bf16*)(p.ws + WS_HX), (const bf16*)(p.ws + WS_WIN), D}; EpiG1 E{(bf16*)(p.ws + WS_UV), (bf16*)(p.ws + WS_XC)};
          if (split && WPG == 24) { SchedG1L S{wvcu / WPG, wvcu % WPG}; pg8::gemm_phase<EpiG1, SchedG1L, true, true>(lds, g, S, E); }
          else { SchedG1 S{GW, wvcu}; pg8::gemm_phase<EpiG1, SchedG1, true, true>(lds, g, S, E); } }
        if (split) {
            split_arrive(sgw, barGW);
            convert_one(p, CONV_HEAD + wvcu * NWAVES + wave, lane);
            split_wait(sgw, ctl + 4096);
        } else xcd_barrier(barW);
        if (split && wvcu % WPG == 0 && tid == 0) __hip_atomic_store(ctl + 64 + 16 * xg, 1u, __ATOMIC_RELAXED, __HIP_MEMORY_SCOPE_AGENT);
#if LRU1_V2
        if (split) phase_lru1_v2(p, lds, tid, lane, wave, wvcu % WPG, WPG, (wvcu / WPG) * (NSEG * 8), (wvcu / WPG + 1) * (NSEG * 8));
        else phase_lru1_v2(p, lds, tid, lane, wave, wvcu, GW);
#else
        phase_lru1_mfma(p, lds, tid, lane, wave, wvcu, GW);
#endif
        if (split) split_arrive(sgw + XS_WORDS, barGW);
        if (split) phase_sgu_mfma(p, lds, tid, lane, wave, wvcu % WPG, WPG, (wvcu / WPG) * 64 + SGU_CONV_TASKS / 8, (wvcu / WPG + 1) * 64);
        else phase_sgu_mfma(p, lds, tid, lane, wave, wvcu, GW, 0, 512);
        if (split) split_wait(sgw + XS_WORDS, ctl + 4096); else xcd_barrier(barW);
        if (split) phase_lru2_fast(p, lds, tid, wvcu % WPG, WPG, (wvcu / WPG) * 64, (wvcu / WPG + 1) * 64);
        else phase_lru2_fast(p, lds, tid, wvcu, GW);
    }
    if (split) split_arrive(sgw + 2 * XS_WORDS, barG); else xcd_barrier(barA);
    if (split) {
        pg8::Gemm g{(const bf16*)(p.ws + WS_A2), (const bf16*)(p.ws + WS_WOUT), D}; SchedG2 S{G, vcu};
        EpiG2F E{p.x, (const float*)(p.ws + WS_MOD), (float*)(p.ws + WS_X1), p.w_router, p.norm2_g, (const float*)(p.ws + WS_CB), (float*)(p.ws + WS_XCH), ctl + 2048, ctl + 4096, p.ws + WS_HX2, (float*)(p.ws + WS_AFF)};
        auto gate2 = [&]() { split_wait(sgw + 2 * XS_WORDS, ctl + 4096); };
        pg8::gemm_phase<EpiG2F, SchedG2, true, true>(lds, g, S, E, gate2);
    } else {
        { pg8::Gemm g{(const bf16*)(p.ws + WS_A2), (const bf16*)(p.ws + WS_WOUT), D}; SchedG2 S{G, vcu}; EpiG2 E{p.x, (const float*)(p.ws + WS_MOD), (float*)(p.ws + WS_X1)};
          pg8::gemm_phase<EpiG2, SchedG2, true, true>(lds, g, S, E); }
        xcd_barrier(barA);
        phase_p5(p, lds, tid, lane, wave, vcu, G);
    }
    xcd_barrier(split ? barG : barA);
    phase_p6_fast(p, lds, tid, lane, wave, vcu, G);
    xcd_barrier(barA);
    { pg8::Gemm g{(const bf16*)(p.ws + WS_HX2), (const bf16*)(p.ws + WS_WG), D}; SchedG3 S{G, vcu}; EpiG3 E{p.ws + WS_HID};
      pg8::gemm_phase_f8g<EpiG3, SchedG3, true, true>(lds, g, S, E, (const int*)(p.ws + WS_TOK)); }
    if (split) split_arrive(ctl + SB_BASE + 3 * XS_WORDS, barA); else xcd_barrier(barA);
    { pg8::Gemm g{(const bf16*)(p.ws + WS_HID), (const bf16*)(p.ws + WS_W2), DE}; SchedG4 S{G, vcu}; EpiG4 E{(const float*)(p.ws + WS_GATE), p.ws + WS_YE};
      auto gate4 = [&]() { if (split) split_wait(ctl + SB_BASE + 3 * XS_WORDS, ctl + 4096); };
      pg8::gemm_phase_f8<EpiG4, SchedG4, true, true>(lds, g, S, E, gate4); }
    if (split) { split_arrive(ctl + SB_BASE + XS_WORDS, barA);
        auto gate9 = [&]() { split_wait(ctl + SB_BASE + XS_WORDS, ctl + 4096); }; phase_p9_v2(p, lds, lane, wave, vcu, G, gate9); }
    else { xcd_barrier(barA); phase_p9<false>(p, lane, wave, vcu, G); }
}
#else
__global__ void __launch_bounds__(NTHREADS, 2) fwd_megakernel(P p) {
    extern __shared__ __attribute__((aligned(16))) unsigned char lds_raw[];
    LAS unsigned char* lds = (LAS unsigned char*)lds_raw;
    const int tid = threadIdx.x, lane = tid & 63, wave = __builtin_amdgcn_readfirstlane(tid >> 6);
    const int G = gridDim.x, bx = blockIdx.x, vcu = (G % 8 == 0) ? (bx % 8) * (G / 8) + bx / 8 : bx;
    const int lo = p.ph_lo, hi = p.ph_hi;
#if XCD_BAR
    volatile LAS unsigned* bst = (volatile LAS unsigned*)(lds + LDS_BYTES - 16);
    if (tid < 2) bst[tid] = 0u;
    __syncthreads();
    XcdBarrier bar; bar.bar = (unsigned*)(p.ws + WS_CTL) + 4096; bar.x = 0; bar.st = bst; bar.total = (unsigned)G;
    if (hi - lo > 1) bar = xcd_barrier_post((unsigned*)(p.ws + WS_CTL) + 4096, bst, (unsigned)G);
#define GRID_SYNC() xcd_barrier(bar)
#else
    cg::grid_group grid = cg::this_grid();
#define GRID_SYNC() grid.sync()
#endif
#define IN(k) (lo <= (k) && (k) < hi)
#define SEAM(k) do { if (IN(k) && IN((k) + 1)) GRID_SYNC(); } while (0)
#define REP(k) for (int rep_ = 0; rep_ < 1 + ((DUP_MASK >> (k)) & 1); ++rep_)
    if (IN(0)) { REP(0) { phase_p0(p, lds, tid, lane, wave, vcu, G, CONV_CUT); __syncthreads(); } SEAM(0); }
    if (IN(1)) { REP(1) phase_p1(p, lane, wave, vcu, G); SEAM(1); }
    if ((DUP_MASK >> 12) & 1) { for (int xb = 0; xb < 8; ++xb) GRID_SYNC(); }
    if (IN(2)) { pg8::Gemm g{(const bf16*)(p.ws + WS_HX), (const bf16*)(p.ws + WS_WIN), D}; SchedG1 S{G, vcu}; EpiG1 E{(bf16*)(p.ws + WS_UV), (bf16*)(p.ws + WS_XC)};
        REP(2) { gemm_any(lds, g, S, E); if (G > 16 && vcu >= 16) convert_items(p, lds, lane, wave, CONV_CUT, CONV_ITEMS, (vcu - 16) * NWAVES + wave, (G - 16) * NWAVES); }
        if (G <= 16) convert_items(p, lds, lane, wave, CONV_CUT, CONV_ITEMS, vcu * NWAVES + wave, G * NWAVES);
        SEAM(2); }
    if (IN(3)) { REP(3) {
#if LRU1_MFMA
        phase_lru1_mfma(p, lds, tid, lane, wave, vcu, G);
#else
        phase_lru1(p, lds, tid, vcu, G);
#endif
        } REP(11) {
#if SGU_MFMA
        phase_sgu_mfma(p, lds, tid, lane, wave, vcu, G);
#else
        phase_sgu(p, lds, tid, vcu, G);
#endif
        } SEAM(3); }
    if (IN(4)) { REP(4) {
#if LRU2_FAST
        phase_lru2_fast(p, lds, tid, vcu, G);
#else
        phase_lru2(p, lds, tid, vcu, G);
#endif
        } SEAM(4); }
    if (IN(5)) { pg8::Gemm g{(const bf16*)(p.ws + WS_A2), (const bf16*)(p.ws + WS_WOUT), D}; SchedG2 S{G, vcu}; EpiG2 E{p.x, (const float*)(p.ws + WS_MOD), (float*)(p.ws + WS_X1)};
        REP(5) gemm_any(lds, g, S, E); SEAM(5); }
    if (IN(6)) { REP(6) phase_p5(p, lds, tid, lane, wave, vcu, G); SEAM(6); }
    if (IN(7)) { REP(7) {
#if P6_FAST
        phase_p6_fast(p, lds, tid, lane, wave, vcu, G);
#else
        phase_p6(p, lds, tid, lane, wave, vcu, G);
#endif
        } SEAM(7); }
#if MOE_FP8
    if (IN(8)) { pg8::Gemm g{(const bf16*)(p.ws + WS_XE), (const bf16*)(p.ws + WS_WG), D}; SchedG3 S{G, vcu}; EpiG3 E{p.ws + WS_HID};
        REP(8) pg8::gemm_phase_f8<EpiG3, SchedG3, true, true>(lds, g, S, E); SEAM(8); }
    if (IN(9)) { pg8::Gemm g{(const bf16*)(p.ws + WS_HID), (const bf16*)(p.ws + WS_W2), DE}; SchedG4 S{G, vcu}; EpiG4 E{(const float*)(p.ws + WS_GATE), p.ws + WS_YE};
        REP(9) pg8::gemm_phase_f8<EpiG4, SchedG4, true, true>(lds, g, S, E); SEAM(9); }
#else
    if (IN(8)) { pg8::Gemm g{(const bf16*)(p.ws + WS_XE), (const bf16*)(p.ws + WS_WG), D}; SchedG3 S{G, vcu}; EpiG3 E{(bf16*)(p.ws + WS_HID)};
        REP(8) gemm_any(lds, g, S, E); SEAM(8); }
    if (IN(9)) { pg8::Gemm g{(const bf16*)(p.ws + WS_HID), (const bf16*)(p.ws + WS_W2), DE}; SchedG4 S{G, vcu}; EpiG4 E{(const float*)(p.ws + WS_GATE), (bf16*)(p.ws + WS_YE)};
        REP(9) gemm_any(lds, g, S, E); SEAM(9); }
#endif
    if (IN(10)) { REP(10) phase_p9<false>(p, lane, wave, vcu, G); }
#undef IN
#undef REP
#undef SEAM
#undef GRID_SYNC
}

#endif

extern "C" void kernel_launch(void* const* d_in, const int* in_sizes, int n_in, void* d_out, int out_size, void* d_ws, size_t ws_size, hipStream_t stream) {
    static int grid = 0;
    if (grid == 0) {
        if (n_in != 25 || in_sizes[0] != M * D || out_size != M * D || ws_size < WS_END) { fprintf(stderr, "kernel_launch: unexpected shapes (n_in %d, in0 %d, out %d, ws %zu < %zu)\n", n_in, n_in > 0 ? in_sizes[0] : -1, out_size, ws_size, (size_t)WS_END); grid = -1; return; }
        int dev = 0, cus = 0, per_cu = 0;
        if (hipGetDevice(&dev) != hipSuccess || hipDeviceGetAttribute(&cus, hipDeviceAttributeMultiprocessorCount, dev) != hipSuccess) { grid = -1; return; }
        if (hipFuncSetAttribute((const void*)fwd_megakernel, hipFuncAttributeMaxDynamicSharedMemorySize, LDS_BYTES) != hipSuccess) { fprintf(stderr, "kernel_launch: hipFuncSetAttribute failed\n"); grid = -1; return; }
        if (hipOccupancyMaxActiveBlocksPerMultiprocessor(&per_cu, (const void*)fwd_megakernel, NTHREADS, LDS_BYTES) != hipSuccess || per_cu < 1) { fprintf(stderr, "kernel_launch: occupancy query failed (%d)\n", per_cu); (void)hipGetLastError(); grid = -1; return; }
        grid = cus * per_cu;
    }
    if (grid < 0) return;
#if XCD_BAR
    if (hipMemsetAsync((char*)d_ws + WS_CTL, 0, 393216, stream) != hipSuccess) { fprintf(stderr, "kernel_launch: hipMemsetAsync failed\n"); return; }
#endif
    P p{};
    const float** f = (const float**)&p;
    for (int i = 0; i < 25; ++i) f[i] = (const float*)d_in[i];
    p.out = (float*)d_out; p.ws = (unsigned char*)d_ws;
#if MK_N_LAUNCHES == 1
    p.ph_lo = 0; p.ph_hi = NPH; void* args[] = {&p};
    hipError_t e = hipLaunchCooperativeKernel((const void*)fwd_megakernel, dim3(grid), dim3(NTHREADS), args, LDS_BYTES, stream);
    if (e != hipSuccess) fprintf(stderr, "kernel_launch: cooperative launch failed: %s (grid %d)\n", hipGetErrorString(e), grid);
#else
    for (int ph = 0; ph < NPH; ++ph) { p.ph_lo = ph; p.ph_hi = ph + 1; hipLaunchKernelGGL(fwd_megakernel, dim3(grid), dim3(NTHREADS), LDS_BYTES, stream, p); }
#endif
}
```
